# Optimizing an MI355X kernel written in HIP

```python
import jax
import jax.numpy as jnp
from jax import lax
import numpy as np

D_MODEL = 2048
BATCH = 2
SEQ = 16384
DEPTH = 1

CHUNK = 64
MEM_LEN = 256
Q_BLOCK = 128
TOKEN_BLOCK = 128
EPS = 1e-6
ROPE_THETA = 10000.0

A_WIDTH = D_MODEL // 2
A_HEADS = 8
A_HEAD_DIM = A_WIDTH // A_HEADS
IDX_HEADS = 16
IDX_DIM = 64
TOP_K_MAX = 256

POOL_WIDTH = D_MODEL // 4
POOL_WINDOWS = (2, 4, 8, 16)
POOL_GROUP = POOL_WIDTH // 4

M_WIDTH = D_MODEL // 4
M_HEADS = 4
M_HEAD_DIM = M_WIDTH // M_HEADS

IN_SPLITS = (A_WIDTH, A_WIDTH, A_WIDTH, IDX_HEADS * IDX_DIM, IDX_DIM, IDX_HEADS, POOL_WIDTH, M_WIDTH)
IN_WIDTH = 3 * A_WIDTH + IDX_HEADS * IDX_DIM + IDX_DIM + IDX_HEADS + POOL_WIDTH + M_WIDTH
MIX_WIDTH = A_WIDTH + POOL_WIDTH + M_WIDTH

PEER_HEADS = 8
N_KEYS = 128
N_EXPERTS = N_KEYS * N_KEYS
PEER_TOPK = 16
PEER_KEY_DIM = 256

kernel_name = 'hybrid_dsa_pool_mem_peer_block'


def rms_norm(x, g):
    xf = x.astype(jnp.float32)
    y = xf * lax.rsqrt(jnp.mean(xf * xf, axis=-1, keepdims=True) + EPS)
    return (y * g.astype(jnp.float32)).astype(x.dtype)


def apply_rope(x, pos):
    half = x.shape[-1] // 2
    inv_freq = ROPE_THETA ** (-jnp.arange(half, dtype=jnp.float32) / half)
    ang = pos.astype(jnp.float32)[:, None] * inv_freq[None, :]
    cos = jnp.cos(ang)[None, :, None, :]
    sin = jnp.sin(ang)[None, :, None, :]
    xf = x.astype(jnp.float32)
    x1, x2 = xf[..., :half], xf[..., half:]
    return jnp.concatenate([x1 * cos - x2 * sin, x2 * cos + x1 * sin], axis=-1).astype(x.dtype)


def split_columns(z, widths):
    outs = []
    start = 0
    for w in widths:
        outs.append(z[..., start:start + w])
        start += w
    return outs


def dsa_sparse_attention(q, k, v, q_idx, k_idx, w_idx, pos):
    b, s, h, dh = q.shape
    top_k = min(TOP_K_MAX, s // 4)
    n_blk = s // Q_BLOCK
    key_chunk = pos // CHUNK
    scale = dh ** -0.5
    idx_scale = IDX_DIM ** -0.5

    def to_blocks(t):
        return jnp.swapaxes(t.reshape((b, n_blk, Q_BLOCK) + t.shape[2:]), 0, 1)

    def block(args):
        qb, qib, wb, qpos = args
        q_chunk = qpos // CHUNK
        raw = jnp.einsum('bqhd,bsd->bqhs', qib, k_idx) * idx_scale
        score = jnp.einsum('bqhs,bqh->bqs', jax.nn.relu(raw), wb).astype(jnp.float32)
        admissible = key_chunk[None, :] <= q_chunk[:, None]
        score = jnp.where(admissible[None], score, -jnp.inf)
        _, sel = lax.top_k(score, top_k)
        kg = jax.vmap(lambda kk, ii: kk[ii])(k, sel)
        vg = jax.vmap(lambda vv, ii: vv[ii])(v, sel)
        valid = (sel // CHUNK) <= q_chunk[None, :, None]
        logits = jnp.einsum('bqhd,bqkhd->bhqk', qb, kg).astype(jnp.float32) * scale
        logits = jnp.where(valid[:, None], logits, -jnp.inf)
        p = jax.nn.softmax(logits, axis=-1).astype(vg.dtype)
        return jnp.einsum('bhqk,bqkhd->bqhd', p, vg)

    out = lax.map(block, (to_blocks(q), to_blocks(q_idx), to_blocks(w_idx),
                          pos.reshape(n_blk, Q_BLOCK)))
    return jnp.swapaxes(out, 0, 1).reshape(b, s, h * dh)


def multiscale_pool_mixer(u, pool_w, pool_scale):
    b, s, c = u.shape
    uf = u.astype(jnp.float32)
    cs = jnp.concatenate([jnp.zeros((b, 1, c), jnp.float32), jnp.cumsum(uf, axis=1)], axis=1)
    t1 = jnp.arange(1, s + 1)
    outs = []
    for g, w in enumerate(POOL_WINDOWS):
        lo_c, hi_c = g * POOL_GROUP, (g + 1) * POOL_GROUP
        lo = jnp.maximum(t1 - w, 0)
        cnt = (t1 - lo).astype(jnp.float32)[None, :, None]
        csg = cs[:, :, lo_c:hi_c]
        mean = (csg[:, 1:] - csg[:, lo]) / cnt
        d = (mean - uf[:, :, lo_c:hi_c]).astype(u.dtype)
        outs.append(jnp.einsum('bsc,ce->bse', d, pool_w[g]))
    return jnp.concatenate(outs, axis=-1) * pool_scale


def memory_cross_attention(qm, km, vm):
    logits = jnp.einsum('bshd,bmhd->bhsm', qm, km).astype(jnp.float32) * (qm.shape[-1] ** -0.5)
    p = jax.nn.softmax(logits, axis=-1).astype(vm.dtype)
    out = jnp.einsum('bhsm,bmhd->bshd', p, vm)
    return out.reshape(qm.shape[0], qm.shape[1], -1)


def peer_ffn(x, w_q, sub_keys_1, sub_keys_2, u_tab, v_tab):
    b, s, d = x.shape
    n_tok = b * s
    t = x.reshape(n_tok, d)
    q = (t @ w_q).reshape(n_tok, PEER_HEADS, PEER_KEY_DIM)
    half = PEER_KEY_DIM // 2
    s1 = jnp.einsum('thd,nd->thn', q[..., :half], sub_keys_1).astype(jnp.float32)
    s2 = jnp.einsum('thd,nd->thn', q[..., half:], sub_keys_2).astype(jnp.float32)
    v1, i1 = lax.top_k(s1, PEER_TOPK)
    v2, i2 = lax.top_k(s2, PEER_TOPK)
    cand = (v1[..., :, None] + v2[..., None, :]).reshape(n_tok, PEER_HEADS, PEER_TOPK * PEER_TOPK)
    sc, ci = lax.top_k(cand, PEER_TOPK)
    e = (jnp.take_along_axis(i1, ci // PEER_TOPK, axis=-1) * N_KEYS
         + jnp.take_along_axis(i2, ci % PEER_TOPK, axis=-1))
    g = jax.nn.softmax(sc, axis=-1).astype(x.dtype)
    n_blk = n_tok // TOKEN_BLOCK

    def block(args):
        tb, eb, gb = args
        h = jnp.einsum('td,ted->te', tb, u_tab[eb])
        a = gb * jax.nn.gelu(h, approximate=False)
        return jnp.einsum('te,ted->td', a, v_tab[eb])

    out = lax.map(block, (t.reshape(n_blk, TOKEN_BLOCK, d),
                          e.reshape(n_blk, TOKEN_BLOCK, PEER_HEADS * PEER_TOPK),
                          g.reshape(n_blk, TOKEN_BLOCK, PEER_HEADS * PEER_TOPK)))
    return out.reshape(b, s, d)


def setup_inputs(seed: int = 0) -> dict:
    key = jax.random.key(seed)
    ks = jax.random.split(key, 20)
    f32 = jnp.float32

    def nrm(k, shape, scale):
        return jax.random.normal(k, shape, f32) * scale

    def gain(k, shape):
        return 1.0 + 0.02 * jax.random.normal(k, shape, f32)

    L = DEPTH
    return {
        'x': jax.random.normal(ks[0], (BATCH, SEQ, D_MODEL), f32),
        'mem': jax.random.normal(ks[1], (BATCH, MEM_LEN, D_MODEL), f32),
        'attn_norm_gain': gain(ks[2], (L, D_MODEL)),
        'w_in': nrm(ks[3], (L, D_MODEL, IN_WIDTH), D_MODEL ** -0.5),
        'q_norm_gain': gain(ks[4], (L, A_HEAD_DIM)),
        'k_norm_gain': gain(ks[5], (L, A_HEAD_DIM)),
        'pool_w': nrm(ks[6], (L, len(POOL_WINDOWS), POOL_GROUP, POOL_GROUP), POOL_GROUP ** -0.5),
        'pool_scale': gain(ks[7], (L, POOL_WIDTH)),
        'mem_norm_gain': gain(ks[8], (L, D_MODEL)),
        'w_mem_kv': nrm(ks[9], (L, D_MODEL, 2 * M_WIDTH), D_MODEL ** -0.5),
        'mq_norm_gain': gain(ks[10], (L, M_HEAD_DIM)),
        'mk_norm_gain': gain(ks[11], (L, M_HEAD_DIM)),
        'w_out': nrm(ks[12], (L, MIX_WIDTH, D_MODEL), MIX_WIDTH ** -0.5),
        'ffn_norm_gain': gain(ks[13], (L, D_MODEL)),
        'peer_w_q': nrm(ks[14], (L, D_MODEL, PEER_HEADS * PEER_KEY_DIM), D_MODEL ** -0.5),
        'peer_sub_keys_1': nrm(ks[15], (L, N_KEYS, PEER_KEY_DIM // 2), (PEER_KEY_DIM // 2) ** -0.5),
        'peer_sub_keys_2': nrm(ks[16], (L, N_KEYS, PEER_KEY_DIM // 2), (PEER_KEY_DIM // 2) ** -0.5),
        'peer_u': nrm(ks[17], (L, N_EXPERTS, D_MODEL), D_MODEL ** -0.5),
        'peer_v': nrm(ks[18], (L, N_EXPERTS, D_MODEL), 0.5),
    }


def reference(x, mem, attn_norm_gain, w_in, q_norm_gain, k_norm_gain, pool_w, pool_scale,
              mem_norm_gain, w_mem_kv, mq_norm_gain, mk_norm_gain, w_out,
              ffn_norm_gain, peer_w_q, peer_sub_keys_1, peer_sub_keys_2, peer_u, peer_v):
    b, s, _ = x.shape
    m = mem.shape[1]
    pos = jnp.arange(s)
    for l in range(DEPTH):
        xn = rms_norm(x, attn_norm_gain[l])
        z = jnp.einsum('bsd,de->bse', xn, w_in[l])
        q, k, v, qi, ki, wi, pu, qm = split_columns(z, IN_SPLITS)

        q = apply_rope(rms_norm(q.reshape(b, s, A_HEADS, A_HEAD_DIM), q_norm_gain[l]), pos)
        k = apply_rope(rms_norm(k.reshape(b, s, A_HEADS, A_HEAD_DIM), k_norm_gain[l]), pos)
        v = v.reshape(b, s, A_HEADS, A_HEAD_DIM)
        qi = apply_rope(qi.reshape(b, s, IDX_HEADS, IDX_DIM), pos)
        ki = apply_rope(ki[:, :, None, :], pos)[:, :, 0, :]
        wi = wi * (IDX_HEADS ** -0.5)
        a_out = dsa_sparse_attention(q, k, v, qi, ki, wi, pos)

        p_out = multiscale_pool_mixer(pu, pool_w[l], pool_scale[l])

        mn = rms_norm(mem, mem_norm_gain[l])
        kvm = jnp.einsum('bmd,de->bme', mn, w_mem_kv[l])
        km, vm = split_columns(kvm, (M_WIDTH, M_WIDTH))
        qm = rms_norm(qm.reshape(b, s, M_HEADS, M_HEAD_DIM), mq_norm_gain[l])
        km = rms_norm(km.reshape(b, m, M_HEADS, M_HEAD_DIM), mk_norm_gain[l])
        vm = vm.reshape(b, m, M_HEADS, M_HEAD_DIM)
        m_out = memory_cross_attention(qm, km, vm)

        mixed = jnp.concatenate([a_out, p_out, m_out], axis=-1)
        x = x + jnp.einsum('bse,ed->bsd', mixed, w_out[l])

        hn = rms_norm(x, ffn_norm_gain[l])
        x = x + peer_ffn(hn, peer_w_q[l], peer_sub_keys_1[l], peer_sub_keys_2[l], peer_u[l], peer_v[l])
    return x
```

```cpp
#include <hip/hip_runtime.h>
#include <hip/hip_bf16.h>
#include <cstdio>
#include <cstdint>

#ifndef IX_VERIFY
#define IX_VERIFY 0
#endif
#ifndef ATT_VERIFY
#define ATT_VERIFY 0
#endif
#ifndef MK_ONE_LAUNCH
#define MK_ONE_LAUNCH 1
#endif

#define GAS __attribute__((address_space(1)))
#define LAS __attribute__((address_space(3)))
typedef unsigned short bf16_t;
typedef short bf16x8 __attribute__((ext_vector_type(8)));
typedef short s16x4 __attribute__((ext_vector_type(4)));
typedef float f32x4 __attribute__((ext_vector_type(4)));
typedef float f32x2 __attribute__((ext_vector_type(2)));
typedef float f32x16 __attribute__((ext_vector_type(16)));
typedef unsigned u32x4 __attribute__((ext_vector_type(4)));
typedef unsigned u32x2 __attribute__((ext_vector_type(2)));
typedef __bf16 bf16x2_t __attribute__((ext_vector_type(2)));

constexpr int BATCH = 2, SEQ = 16384, DM = 2048, NTOK = BATCH * SEQ, MEMLEN = 256;
constexpr int IN_W = 5200, ZLD = 5376;
constexpr int ZC_Q = 0, ZC_K = 1024, ZC_V = 2048, ZC_QI = 3072, ZC_PU = 4096, ZC_QM = 4608, ZC_KI = 5120, ZC_WI = 5184;
constexpr int NEXP = 16384;
constexpr float EPS = 1e-6f;
constexpr int MASK_WPR = 512;

constexpr size_t MiB = 1u << 20;
constexpr size_t WS_CTL = 0, CTL_ZERO_BYTES = 1 * MiB;
constexpr size_t WS_BT_IN = 2 * MiB;
constexpr size_t WS_BT_OUT = 24 * MiB;
constexpr size_t WS_BT_Q = 32 * MiB;
constexpr size_t WS_BT_KV = 40 * MiB;
constexpr size_t WS_MN = 44 * MiB;
constexpr size_t WS_KVM = 46 * MiB;
constexpr size_t WS_PK = 47 * MiB;
constexpr size_t WS_PWT = 47 * MiB + 512 * 1024;
constexpr size_t WS_XN = 48 * MiB;
constexpr size_t WS_Z = 176 * MiB;
constexpr size_t WS_MASK = 512 * MiB;
constexpr size_t WS_UB = 576 * MiB;
constexpr size_t WS_VB = 640 * MiB;
constexpr size_t WS_RSU = 47 * MiB + 128 * 1024, WS_RSV = 47 * MiB + 256 * 1024;
constexpr size_t WS_ROPE = 704 * MiB;
constexpr size_t WS_CAND = 720 * MiB;
constexpr size_t WS_END = 848 * MiB;
constexpr int CW_BAR = 4096;

#define LDS_WAIT() asm volatile("s_waitcnt lgkmcnt(0)" ::: "memory")
#define VM_WAIT() asm volatile("s_waitcnt vmcnt(0)" ::: "memory")
__device__ __forceinline__ unsigned cvtpk(float lo, float hi) { f32x2 v = {lo, hi}; bf16x2_t b = __builtin_convertvector(v, bf16x2_t); return __builtin_bit_cast(unsigned, b); }
__device__ __forceinline__ float bflo(unsigned w) { return __uint_as_float(w << 16); }
__device__ __forceinline__ float bfhi(unsigned w) { return __uint_as_float(w & 0xffff0000u); }
__device__ __forceinline__ float wave_sum(float v) {
#pragma unroll
    for (int o = 1; o < 64; o <<= 1) v += __shfl_xor(v, o);
    return v;
}
__device__ __forceinline__ unsigned f2ord(float s) { unsigned u = __float_as_uint(s); return u ^ (((unsigned)((int)u >> 31)) | 0x80000000u); }

namespace pg8 {
#define PG8_LAS __attribute__((address_space(3)))
constexpr int BM = 256, BK = 64, HALF = 128, HTB = HALF * BK * 2, STAGE_BYTES = 8 * HTB, NXCD = 8, WGM = 8;
__host__ __device__ __forceinline__ int lds_byte(int r, int c) { const int st = (r >> 4) * 2 + (c >> 5), rr = r & 15, cc = c & 31, ob = rr * 64 + cc * 2; return st * 1024 + (ob ^ (((ob >> 9) & 1) << 5)); }
__host__ __device__ __forceinline__ void stage_rc(int b, int& R, int& C) { const int st = b / 1024, sb = b % 1024, swz = sb ^ (((sb >> 9) & 1) << 5); R = (st >> 1) * 16 + swz / 64; C = (st & 1) * 32 + (swz % 64) / 2; }
__host__ __device__ __forceinline__ int perm32(int rho) { const int n = rho >> 4, i = rho & 15; return 8 * (i >> 2) + 4 * n + (i & 3); }
struct Unit { int pm, pn; };
struct Gemm { const bf16_t* A; const bf16_t* Bt; int M, N, K; };
struct StaticOrder {
    int nM, nN, nwg, G, c;
    __host__ __device__ void init(int M, int N, int G_, int c_) { nM = M / BM; nN = N / BM; nwg = nM * nN; G = G_; c = c_; }
    __host__ __device__ bool next(int i, Unit& u) const {
        const long L = (long)i * G + c; if (L >= nwg) return false;
        int wgid = (int)L; { const int q = nwg / NXCD, r = nwg % NXCD, xcd = wgid % NXCD, off = wgid / NXCD; wgid = (xcd < r ? xcd * (q + 1) : r * (q + 1) + (xcd - r) * q) + off; }
        const int nig = WGM * nN, gid = wgid / nig, fm = gid * WGM, gsz = (nM - fm) < WGM ? (nM - fm) : WGM;
        u.pm = fm + ((wgid % nig) % gsz); u.pn = (wgid % nig) / gsz; return true;
    }
    __device__ __forceinline__ void a_ready(const Unit&) const {}
    __device__ __forceinline__ void done(const Unit&) const {}
};
struct EpiBf16 {
    static constexpr bool PERM = true, AFTER_DRAIN = false;
    bf16_t* O; int ldc;
    __device__ __forceinline__ void operator()(const f32x4 (&acc)[2][2][4][2], const Unit& u, int wr, int wc, int fr, int fq) const {
        const int row0 = u.pm * BM + wr * 64 + fr; const int col0 = u.pn * BM + wc * 32 + 8 * fq;
#pragma unroll
        for (int ai = 0; ai < 2; ++ai)
#pragma unroll
            for (int m = 0; m < 4; ++m) { bf16_t* rowp = O + (size_t)(row0 + ai * HALF + m * 16) * ldc + col0;
#pragma unroll
                for (int bj = 0; bj < 2; ++bj) { const f32x4 v0 = acc[ai][bj][m][0], v1 = acc[ai][bj][m][1];
                    u32x4 w; w.x = cvtpk(v0[0], v0[1]); w.y = cvtpk(v0[2], v0[3]); w.z = cvtpk(v1[0], v1[1]); w.w = cvtpk(v1[2], v1[3]);
                    *(u32x4*)(rowp + bj * HALF) = w; } }
    }
};
struct EpiF32Res {
    static constexpr bool PERM = false, AFTER_DRAIN = false;
    const float* R; float* C; int ldc;
    __device__ __forceinline__ void operator()(const f32x4 (&acc)[2][2][4][2], const Unit& u, int wr, int wc, int fr, int fq) const {
        const int row0 = u.pm * BM + wr * 64 + fr, col0 = u.pn * BM + wc * 32 + 4 * fq;
#pragma unroll
        for (int ai = 0; ai < 2; ++ai)
#pragma unroll
            for (int m = 0; m < 4; ++m) { const size_t off = (size_t)(row0 + ai * HALF + m * 16) * ldc + col0;
#pragma unroll
                for (int bj = 0; bj < 2; ++bj)
#pragma unroll
                    for (int n = 0; n < 2; ++n) *(f32x4*)(C + off + bj * HALF + n * 16) = acc[ai][bj][m][n] + *(const f32x4*)(R + off + bj * HALF + n * 16); }
    }
};

template <class Epi, class Sched, bool ALIGN_EPI = false, bool SP2 = false>
__device__ __forceinline__ void gemm_phase(PG8_LAS unsigned char* lds, const Gemm g, const Sched& S, const Epi& E) {
    const int tid = threadIdx.x, wid = __builtin_amdgcn_readfirstlane(tid >> 6), lane = tid & 63, wr = wid >> 2, wc = wid & 3, fr = lane & 15, fq = lane >> 4;
    const int K = g.K, nt = K / BK;
    unsigned voffA[2], voffB[2];
#pragma unroll
    for (int i = 0; i < 2; ++i) { int R, C; stage_rc(tid * 16 + i * 8192, R, C); const int Rb = Epi::PERM ? ((R & ~31) + perm32(R & 31)) : R;
        voffA[i] = (unsigned)(R * K + C) * 2u; voffB[i] = (unsigned)(Rb * K + C) * 2u; }
    const size_t kstep = (size_t)(BK * 2);
    const size_t hstep = (size_t)HALF * K * 2;
    const size_t tstep = 2 * hstep;
    const unsigned ldsw = (unsigned)wid * 1024u;
    const int aoff = lds_byte(wr * 64 + fr, fq * 8), boff = lds_byte(wc * 32 + fr, fq * 8);
#define PG8_SA(b, h) (((b) * 2 + (h)) * HTB)
#define PG8_SB(b, h) ((4 + (b) * 2 + (h)) * HTB)
#define PG8_STAGE(bufoff, gbase, voff) do { _Pragma("unroll") for (int _i = 0; _i < 2; ++_i) \
        __builtin_amdgcn_global_load_lds((const unsigned*)((const char*)(gbase) + (voff)[_i]), (PG8_LAS unsigned*)(lds + (bufoff) + ldsw + _i * 8192), 16, 0, 0); } while (0)
#define PG8_LDA(dst, b, h) do { _Pragma("unroll") for (int m = 0; m < 4; ++m) _Pragma("unroll") for (int k = 0; k < 2; ++k) dst[m][k] = *(const PG8_LAS bf16x8*)(lds + PG8_SA(b, h) + aoff + m * 2048 + k * 1024); } while (0)
#define PG8_LDB(dst, b, h) do { _Pragma("unroll") for (int n = 0; n < 2; ++n) _Pragma("unroll") for (int k = 0; k < 2; ++k) dst[n][k] = *(const PG8_LAS bf16x8*)(lds + PG8_SB(b, h) + boff + n * 2048 + k * 1024); } while (0)
#define PG8_MMA(ai, bj, At, Bt) do { __builtin_amdgcn_s_setprio(1); _Pragma("unroll") for (int m = 0; m < 4; ++m) _Pragma("unroll") for (int n = 0; n < 2; ++n) _Pragma("unroll") for (int k = 0; k < 2; ++k) \
        acc[ai][bj][m][n] = __builtin_amdgcn_mfma_f32_16x16x32_bf16(Bt[n][k], At[m][k], acc[ai][bj][m][n], 0, 0, 0); __builtin_amdgcn_s_setprio(0); } while (0)
#define PG8_WAIT_V(n) asm volatile("s_waitcnt vmcnt(" #n ")" ::: "memory")
#define PG8_WAIT_L(n) asm volatile("s_waitcnt lgkmcnt(" #n ")" ::: "memory")
#define PG8_BAR __builtin_amdgcn_s_barrier()
#define PG8_SCHED __builtin_amdgcn_sched_barrier(0)
    Unit cur, nxt; int ui = 0;
    if (!S.next(0, cur)) return;
    f32x4 acc[2][2][4][2];
#pragma unroll
    for (int a = 0; a < 2; ++a)
#pragma unroll
        for (int b = 0; b < 2; ++b)
#pragma unroll
            for (int m = 0; m < 4; ++m)
#pragma unroll
                for (int n = 0; n < 2; ++n) acc[a][b][m][n] = (f32x4){0.f, 0.f, 0.f, 0.f};
    bf16x8 At[4][2], B0[2][2], B1[2][2];
    const char* cA = (const char*)g.A + (size_t)cur.pm * tstep; const char* cB = (const char*)g.Bt + (size_t)cur.pn * tstep;
    S.a_ready(cur);
    if constexpr (SP2) {
        PG8_STAGE(PG8_SB(0, 0), cB, voffB); PG8_STAGE(PG8_SB(0, 1), cB + hstep, voffB); PG8_STAGE(PG8_SA(0, 0), cA, voffA); PG8_STAGE(PG8_SA(0, 1), cA + hstep, voffA);
        if (wr == 1) PG8_BAR;
        PG8_WAIT_V(2); PG8_BAR;
        PG8_STAGE(PG8_SB(1, 0), cB + kstep, voffB); PG8_STAGE(PG8_SA(1, 0), cA + kstep, voffA); PG8_STAGE(PG8_SB(1, 1), cB + hstep + kstep, voffB);
        PG8_WAIT_V(6); PG8_BAR;
    } else {
        PG8_STAGE(PG8_SB(0, 0), cB, voffB); PG8_STAGE(PG8_SA(0, 0), cA, voffA); PG8_STAGE(PG8_SB(0, 1), cB + hstep, voffB); PG8_STAGE(PG8_SA(0, 1), cA + hstep, voffA);
        if (wr == 1) PG8_BAR;
        PG8_WAIT_V(4); PG8_BAR;
        PG8_STAGE(PG8_SB(1, 0), cB + kstep, voffB); PG8_STAGE(PG8_SA(1, 0), cA + kstep, voffA); PG8_STAGE(PG8_SB(1, 1), cB + hstep + kstep, voffB);
        PG8_WAIT_V(6); PG8_BAR;
    }
    for (;;) {
        const bool has_next = S.next(ui + 1, nxt);
        const char* nA = has_next ? (const char*)g.A + (size_t)nxt.pm * tstep : cA; const char* nB = has_next ? (const char*)g.Bt + (size_t)nxt.pn * tstep : cB;
        for (int t = 0; t < nt; t += 2) {
            const bool last = (t == nt - 2);
            const char* a1 = cA + (size_t)(t + 1) * kstep;
            const char* a2 = last ? nA : cA + (size_t)(t + 2) * kstep; const char* b2 = last ? nB : cB + (size_t)(t + 2) * kstep;
            const char* a3 = a2 + kstep; const char* b3 = b2 + kstep;
            if (last && has_next) S.a_ready(nxt);
            if constexpr (SP2) {
            PG8_LDB(B0, 0, 0); PG8_LDB(B1, 0, 1); PG8_SCHED; PG8_LDA(At, 0, 0); PG8_STAGE(PG8_SA(1, 1), a1 + hstep, voffA);
            PG8_WAIT_V(8); PG8_WAIT_L(0); PG8_BAR; PG8_MMA(0, 0, At, B0); PG8_MMA(0, 1, At, B1); PG8_BAR; PG8_SCHED;
            PG8_LDA(At, 0, 1); PG8_STAGE(PG8_SB(0, 0), b2, voffB); PG8_STAGE(PG8_SB(0, 1), b2 + hstep, voffB); PG8_STAGE(PG8_SA(0, 0), a2, voffA);
            PG8_WAIT_V(8); PG8_WAIT_L(0); PG8_BAR; PG8_MMA(1, 0, At, B0); PG8_MMA(1, 1, At, B1); PG8_BAR; PG8_SCHED;
            PG8_LDB(B0, 1, 0); PG8_LDB(B1, 1, 1); PG8_SCHED; PG8_LDA(At, 1, 0); PG8_STAGE(PG8_SA(0, 1), a2 + hstep, voffA);
            PG8_WAIT_V(8); PG8_WAIT_L(0); PG8_BAR; PG8_MMA(0, 0, At, B0); PG8_MMA(0, 1, At, B1); PG8_BAR; PG8_SCHED;
            PG8_LDA(At, 1, 1); PG8_STAGE(PG8_SB(1, 0), b3, voffB); PG8_STAGE(PG8_SB(1, 1), b3 + hstep, voffB); PG8_STAGE(PG8_SA(1, 0), a3, voffA);
            PG8_WAIT_V(8); PG8_WAIT_L(0); PG8_BAR; PG8_MMA(1, 0, At, B0); PG8_MMA(1, 1, At, B1); PG8_BAR; PG8_SCHED;
            } else {
            PG8_LDB(B0, 0, 0); PG8_SCHED; PG8_LDA(At, 0, 0); PG8_STAGE(PG8_SA(1, 1), a1 + hstep, voffA);
            PG8_WAIT_L(8); PG8_BAR; PG8_WAIT_L(0); PG8_MMA(0, 0, At, B0); PG8_BAR; PG8_SCHED;
            PG8_LDB(B1, 0, 1); PG8_STAGE(PG8_SB(0, 0), b2, voffB);
            PG8_BAR; PG8_WAIT_L(0); PG8_MMA(0, 1, At, B1); PG8_BAR;
            PG8_LDA(At, 0, 1); PG8_STAGE(PG8_SA(0, 0), a2, voffA);
            PG8_BAR; PG8_WAIT_L(0); PG8_MMA(1, 0, At, B0); PG8_BAR; PG8_SCHED;
            PG8_STAGE(PG8_SB(0, 1), b2 + hstep, voffB);
            PG8_WAIT_V(6); PG8_BAR; PG8_MMA(1, 1, At, B1); PG8_BAR;
            PG8_LDB(B0, 1, 0); PG8_SCHED; PG8_LDA(At, 1, 0); PG8_STAGE(PG8_SA(0, 1), a2 + hstep, voffA);
            PG8_WAIT_L(8); PG8_BAR; PG8_WAIT_L(0); PG8_MMA(0, 0, At, B0); PG8_BAR; PG8_SCHED;
            PG8_LDB(B1, 1, 1); PG8_STAGE(PG8_SB(1, 0), b3, voffB);
            PG8_BAR; PG8_WAIT_L(0); PG8_MMA(0, 1, At, B1); PG8_BAR;
            PG8_LDA(At, 1, 1); PG8_STAGE(PG8_SA(1, 0), a3, voffA);
            PG8_BAR; PG8_WAIT_L(0); PG8_MMA(1, 0, At, B0); PG8_BAR; PG8_SCHED;
            PG8_STAGE(PG8_SB(1, 1), b3 + hstep, voffB);
            PG8_WAIT_V(6); PG8_BAR; PG8_MMA(1, 1, At, B1); PG8_BAR;
            }
        }
        if constexpr (ALIGN_EPI) { if (wr == 0) PG8_BAR; }
        if constexpr (!Epi::AFTER_DRAIN) { E(acc, cur, wr, wc, fr, fq); S.done(cur); }
        if (!has_next) break;
#pragma unroll
        for (int a = 0; a < 2; ++a)
#pragma unroll
            for (int b = 0; b < 2; ++b)
#pragma unroll
                for (int m = 0; m < 4; ++m)
#pragma unroll
                    for (int n = 0; n < 2; ++n) acc[a][b][m][n] = (f32x4){0.f, 0.f, 0.f, 0.f};
        cur = nxt; cA = nA; cB = nB; ++ui;
        if constexpr (ALIGN_EPI) { if (wr == 1) PG8_BAR; }
    }
    PG8_WAIT_V(0);
    if constexpr (!ALIGN_EPI) { if (wr == 0) PG8_BAR; }
    PG8_BAR;
#undef PG8_SA
#undef PG8_SB
#undef PG8_STAGE
#undef PG8_LDA
#undef PG8_LDB
#undef PG8_MMA
#undef PG8_WAIT_V
#undef PG8_WAIT_L
#undef PG8_BAR
#undef PG8_SCHED
}
}

namespace att {
constexpr int D = 128, NW = 8, QBLK = 32, KVBLK = 64;
constexpr float SCALE = 0.088388347648318440f;
constexpr float THR = 8.f;
constexpr size_t SHM_V = KVBLK * D * 2, SHM_K = KVBLK * D * 2, SHM_ATTN = 2 * SHM_V + 2 * SHM_K + NW * 64 * 4;
#define KSWZ(row, colB) ((row) * 256 + ((colB) ^ (((row) & 7) << 4)))
#define SBAR() __builtin_amdgcn_sched_barrier(0)
__device__ __forceinline__ int crow(int r, int hi) { return (r & 3) + 8 * (r >> 2) + 4 * hi; }
template <bool MASKED> __device__ __forceinline__ void mask_apply(f32x16& p, unsigned w) {
    if constexpr (MASKED) {
#pragma unroll
        for (int r = 0; r < 16; ++r) { const unsigned m = (unsigned)__builtin_amdgcn_sbfe((int)w, (unsigned)((r & 3) + 8 * (r >> 2)), 1u); p[r] = __uint_as_float((__float_as_uint(p[r]) & m) | (0xFF800000u & ~m)); }
    }
}
template <bool MASKED> __device__ __forceinline__ void partialSM(f32x16& p0, f32x16& p1, float& m_reg, float& mn, float& alpha, unsigned long long mk, int sh4) {
    constexpr float C = SCALE * 1.4426950408889634f;
    float pmax = p0[0];
#pragma unroll
    for (int r = 1; r < 16; ++r) pmax = fmaxf(pmax, p0[r]);
#pragma unroll
    for (int r = 0; r < 16; ++r) pmax = fmaxf(pmax, p1[r]);
    { auto rr = __builtin_amdgcn_permlane32_swap(__float_as_uint(pmax), __float_as_uint(pmax), false, false);
      pmax = fmaxf(__uint_as_float(rr[0]), __uint_as_float(rr[1])); }
    if (__builtin_expect(__all(pmax - m_reg <= THR / SCALE), 1)) { mn = m_reg; alpha = 1.f; }
    else { mn = fmaxf(m_reg, pmax); alpha = __builtin_amdgcn_exp2f((m_reg - mn) * C); m_reg = mn; }
    const float mnC = -mn * C;
#pragma unroll
    for (int r = 0; r < 16; ++r) p0[r] = fmaf(p0[r], C, mnC);
#pragma unroll
    for (int r = 0; r < 16; ++r) p1[r] = fmaf(p1[r], C, mnC);
#pragma unroll
    for (int r = 0; r < 16; ++r) p0[r] = __builtin_amdgcn_exp2f(p0[r]);
}
template <bool MASKED> __device__ __forceinline__ void finishSM(f32x16& p0, f32x16& p1, float alpha, float& l_reg, bf16x8& pa0, bf16x8& pa1, bf16x8& pa2, bf16x8& pa3, unsigned long long mk, int sh4) {
#pragma unroll
    for (int r = 0; r < 16; ++r) p1[r] = __builtin_amdgcn_exp2f(p1[r]);
    float ps = 0;
#pragma unroll
    for (int r = 0; r < 16; ++r) ps += p0[r];
#pragma unroll
    for (int r = 0; r < 16; ++r) ps += p1[r];
    { auto rr = __builtin_amdgcn_permlane32_swap(__float_as_uint(ps), __float_as_uint(ps), false, false);
      ps = __uint_as_float(rr[0]) + __uint_as_float(rr[1]); }
    l_reg = l_reg * alpha + ps;
#define PK4(P, BASE, OUT) do { unsigned a0 = cvtpk(P[BASE + 0], P[BASE + 1]), a1 = cvtpk(P[BASE + 2], P[BASE + 3]);   \
    unsigned b0 = cvtpk(P[BASE + 4], P[BASE + 5]), b1 = cvtpk(P[BASE + 6], P[BASE + 7]);                              \
    auto r0 = __builtin_amdgcn_permlane32_swap(a0, b0, false, false); auto r1 = __builtin_amdgcn_permlane32_swap(a1, b1, false, false); \
    u32x4 w = {r0[0], r1[0], r0[1], r1[1]}; OUT = *reinterpret_cast<bf16x8*>(&w); } while (0)
    PK4(p0, 0, pa0); PK4(p0, 8, pa1); PK4(p1, 0, pa2); PK4(p1, 8, pa3);
#undef PK4
}
template <bool MASKED> __device__ __forceinline__ void qkt(f32x16& p0, f32x16& p1, const bf16_t* Ks, const bf16x8* qs, int r32, int hi, unsigned long long mk, int sh4, const char* lut) {
    if constexpr (MASKED) {
        const unsigned wl = (unsigned)mk >> sh4, wh = (unsigned)(mk >> 32) >> sh4;
#pragma unroll
        for (int g = 0; g < 4; ++g) { const f32x4 b0 = *(const f32x4*)(lut + ((wl >> (8 * g)) & 15u) * 16), b1 = *(const f32x4*)(lut + ((wh >> (8 * g)) & 15u) * 16);
            p0[4 * g] = b0.x; p0[4 * g + 1] = b0.y; p0[4 * g + 2] = b0.z; p0[4 * g + 3] = b0.w; p1[4 * g] = b1.x; p1[4 * g + 1] = b1.y; p1[4 * g + 2] = b1.z; p1[4 * g + 3] = b1.w; }
    } else { p0 = f32x16{}; p1 = f32x16{}; }
#pragma unroll
    for (int d0 = 0; d0 < 8; ++d0) { int cb = (d0 * 16 + hi * 8) * 2;
        bf16x8 b0 = *reinterpret_cast<const bf16x8*>((const char*)Ks + KSWZ(r32, cb));
        bf16x8 b1 = *reinterpret_cast<const bf16x8*>((const char*)Ks + KSWZ(32 + r32, cb));
        const bf16x8 qf = qs[d0 * 64];
        p0 = __builtin_amdgcn_mfma_f32_32x32x16_bf16(b0, qf, p0, 0, 0, 0);
        p1 = __builtin_amdgcn_mfma_f32_32x32x16_bf16(b1, qf, p1, 0, 0, 0); }
}
__device__ __forceinline__ int v_st(int k, int c) { const int kk = (k & ~0xC) | ((k & 4) << 1) | ((k & 8) >> 1); return ((kk >> 3) * 4 + (c >> 5)) * 512 + ((kk & 7) * 32 + (c & 31)) * 2; }
__device__ __forceinline__ int v_rd_base(int lane) { return ((lane & 3) << 3) | (((lane >> 2) & 3) << 6) | (((lane >> 4) & 1) << 5) | (((lane >> 5) & 1) << 8); }
constexpr int v_rd_off(int d0, int ks, int half) { return d0 * 512 + ks * 4096 + half * 2048; }
template <int OFF> __device__ __forceinline__ s16x4 tr_read(int vb) {
    s16x4 r; asm volatile("ds_read_b64_tr_b16 %0, %1 offset:%2" : "=&v"(r) : "v"(vb), "i"(OFF) : "memory"); return r;
}
template <int D0> __device__ __forceinline__ void pv_one(f32x16& od, int vb, bf16x8 pa0, bf16x8 pa1, bf16x8 pa2, bf16x8 pa3) {
    const s16x4 l0 = tr_read<v_rd_off(D0, 0, 0)>(vb), h0 = tr_read<v_rd_off(D0, 0, 1)>(vb), l1 = tr_read<v_rd_off(D0, 1, 0)>(vb), h1 = tr_read<v_rd_off(D0, 1, 1)>(vb);
    const s16x4 l2 = tr_read<v_rd_off(D0, 2, 0)>(vb), h2 = tr_read<v_rd_off(D0, 2, 1)>(vb), l3 = tr_read<v_rd_off(D0, 3, 0)>(vb), h3 = tr_read<v_rd_off(D0, 3, 1)>(vb);
    asm volatile("s_waitcnt lgkmcnt(0)" ::: "memory"); SBAR();
#define PK(L, H) (bf16x8){L[0], L[1], L[2], L[3], H[0], H[1], H[2], H[3]}
    od = __builtin_amdgcn_mfma_f32_32x32x16_bf16(pa0, PK(l0, h0), od, 0, 0, 0);
    od = __builtin_amdgcn_mfma_f32_32x32x16_bf16(pa1, PK(l1, h1), od, 0, 0, 0);
    od = __builtin_amdgcn_mfma_f32_32x32x16_bf16(pa2, PK(l2, h2), od, 0, 0, 0);
    od = __builtin_amdgcn_mfma_f32_32x32x16_bf16(pa3, PK(l3, h3), od, 0, 0, 0);
#undef PK
}
__device__ __forceinline__ void pv_d0(f32x16* o, int vb, bf16x8 pa0, bf16x8 pa1, bf16x8 pa2, bf16x8 pa3) {
    pv_one<0>(o[0], vb, pa0, pa1, pa2, pa3); pv_one<1>(o[1], vb, pa0, pa1, pa2, pa3); pv_one<2>(o[2], vb, pa0, pa1, pa2, pa3); pv_one<3>(o[3], vb, pa0, pa1, pa2, pa3);
}
template <bool MASKED, int SDEPTH, int ldq, int ldk, int ldo>
__device__ __forceinline__ void attn_body(const bf16_t* __restrict__ Qb, const bf16_t* __restrict__ Kh, const bf16_t* __restrict__ Vh,
                                          bf16_t* __restrict__ Ob, int seq, const unsigned long long* __restrict__ mrow, char* lds) {
    int tid = (int)threadIdx.x; asm volatile("" : "+v"(tid));
    const int wid = tid >> 6, lane = tid & 63, r32 = lane & 31, hi = lane >> 5, sh4 = 4 * hi;
    bf16_t* V_lds = (bf16_t*)lds; bf16_t* K_lds = (bf16_t*)(lds + 2 * SHM_V);
    float* ws = (float*)(lds + 2 * SHM_V + 2 * SHM_K) + wid * 64; float* li_l = ws; float* al_l = ws + 32;
    float m_reg = -1e30f, l_reg = 0; f32x16 o[4] = {};
    const bf16_t* Qw = Qb + (long)(wid * QBLK + r32) * ldq + hi * 8;
    bf16x8* qr = (bf16x8*)(lds + SHM_ATTN) + wid * 512 + lane;
#pragma unroll
    for (int d0 = 0; d0 < 8; ++d0) qr[d0 * 64] = *reinterpret_cast<const bf16x8*>(Qw + d0 * 16);
    const char* lut = lds + SHM_ATTN + 65536;
    if (MASKED && tid < 64) ((float*)(lds + SHM_ATTN + 65536))[tid] = ((tid >> 2) >> (tid & 3)) & 1 ? 0.f : -INFINITY;
    const int sr = tid >> 4, sc = (tid & 15) * 8, vst0 = v_st(sr, sc), vst1 = v_st(32 + sr, sc);
    const int vb0 = (int)(uintptr_t)V_lds + v_rd_base(lane);
    struct { bf16x8 vs0, vs1, ks0, ks1; } sr_[SDEPTH];
#define SLOAD(i, k0) do { sr_[i].vs0 = *reinterpret_cast<const bf16x8*>(&Vh[(long)((k0) + sr) * ldk + sc]); sr_[i].vs1 = *reinterpret_cast<const bf16x8*>(&Vh[(long)((k0) + 32 + sr) * ldk + sc]); \
    sr_[i].ks0 = *reinterpret_cast<const bf16x8*>(&Kh[(long)((k0) + sr) * ldk + sc]); sr_[i].ks1 = *reinterpret_cast<const bf16x8*>(&Kh[(long)((k0) + 32 + sr) * ldk + sc]); } while (0)
#define SWRITE(b, i) do { *(bf16x8*)((char*)V_lds + (b) * SHM_V + vst0) = sr_[i].vs0;          \
    *(bf16x8*)((char*)V_lds + (b) * SHM_V + vst1) = sr_[i].vs1; int kc = sc * 2;               \
    *(bf16x8*)((char*)K_lds + (b) * SHM_K + KSWZ(sr, kc)) = sr_[i].ks0;                       \
    *(bf16x8*)((char*)K_lds + (b) * SHM_K + KSWZ(32 + sr, kc)) = sr_[i].ks1; } while (0)
#define SWAIT() do { if constexpr (SDEPTH == 2) asm volatile("s_waitcnt vmcnt(4)" ::: "memory"); else asm volatile("s_waitcnt vmcnt(0)" ::: "memory"); } while (0)
#define RESC(a) do { if (__any((a) < 1.f)) { if (hi == 0) al_l[r32] = (a); asm volatile("s_waitcnt lgkmcnt(0)" ::: "memory"); \
    _Pragma("unroll") for (int d = 0; d < 4; ++d) _Pragma("unroll") for (int r = 0; r < 16; ++r) o[d][r] *= al_l[crow(r, hi)]; } } while (0)
    f32x16 pA0, pA1, pB0, pB1; float mnA, mnB, alA, alB; bf16x8 pa0, pa1, pa2, pa3; const int NT = seq / KVBLK;
    unsigned long long mkA = 0, mkB = 0;
    constexpr int SE = 0, SO = SDEPTH - 1;
    if constexpr (MASKED) mkA = mrow[0];
    SLOAD(SE, 0); asm volatile("s_waitcnt vmcnt(0)" ::: "memory"); SWRITE(0, SE); __syncthreads();
    qkt<MASKED>(pA0, pA1, K_lds, qr, r32, hi, mkA, sh4, lut); partialSM<MASKED>(pA0, pA1, m_reg, mnA, alA, mkA, sh4);
    if constexpr (MASKED) mkB = mrow[1];
    SLOAD(SO, KVBLK); if constexpr (SDEPTH == 2) { if (2 < NT) SLOAD(SE, 2 * KVBLK); }
    SWAIT(); SWRITE(1, SO); __syncthreads();
    for (int j = 1; j + 1 < NT; j += 2) {
        SBAR(); qkt<MASKED>(pB0, pB1, (bf16_t*)((char*)K_lds + SHM_K), qr, r32, hi, mkB, sh4, lut);
        finishSM<MASKED>(pA0, pA1, alA, l_reg, pa0, pa1, pa2, pa3, mkA, sh4); SBAR();
        if constexpr (MASKED) mkA = mrow[j + 1];
        SLOAD(SO, (j + SDEPTH) * KVBLK); SBAR();
        pv_d0(o, vb0, pa0, pa1, pa2, pa3); partialSM<MASKED>(pB0, pB1, m_reg, mnB, alB, mkB, sh4);
        __syncthreads(); SWAIT(); SWRITE(0, SE);
        RESC(alB); __syncthreads();
        SBAR(); qkt<MASKED>(pA0, pA1, K_lds, qr, r32, hi, mkA, sh4, lut);
        finishSM<MASKED>(pB0, pB1, alB, l_reg, pa0, pa1, pa2, pa3, mkB, sh4); SBAR();
        if constexpr (MASKED) { if (j + 2 < NT) mkB = mrow[j + 2]; }
        if (SDEPTH == 1 || j + 3 < NT) SLOAD(SE, (j + 1 + SDEPTH) * KVBLK); SBAR();
        pv_d0(o, vb0 + (int)SHM_V, pa0, pa1, pa2, pa3); partialSM<MASKED>(pA0, pA1, m_reg, mnA, alA, mkA, sh4);
        __syncthreads(); SWAIT(); SWRITE(1, SO);
        RESC(alA); __syncthreads();
    }
    SBAR(); qkt<MASKED>(pB0, pB1, (bf16_t*)((char*)K_lds + SHM_K), qr, r32, hi, mkB, sh4, lut);
    finishSM<MASKED>(pA0, pA1, alA, l_reg, pa0, pa1, pa2, pa3, mkA, sh4); SBAR();
    pv_d0(o, vb0, pa0, pa1, pa2, pa3); partialSM<MASKED>(pB0, pB1, m_reg, mnB, alB, mkB, sh4);
    __syncthreads(); RESC(alB);
    finishSM<MASKED>(pB0, pB1, alB, l_reg, pa0, pa1, pa2, pa3, mkB, sh4); SBAR();
    pv_d0(o, vb0 + (int)SHM_V, pa0, pa1, pa2, pa3);
    if (hi == 0) li_l[r32] = l_reg; asm volatile("s_waitcnt lgkmcnt(0)" ::: "memory");
    float rli[16];
#pragma unroll
    for (int r = 0; r < 16; ++r) rli[r] = __builtin_amdgcn_rcpf(li_l[crow(r, hi)]);
    bf16_t* Ow = Ob + (long)(wid * QBLK) * ldo;
#pragma unroll
    for (int r = 0; r < 16; ++r) { const int orow = crow(r, hi);
#pragma unroll
        for (int d0 = 0; d0 < 4; ++d0) Ow[(long)orow * ldo + d0 * 32 + r32] = (bf16_t)(cvtpk(o[d0][r] * rli[r], 0.f) & 0xffffu); }
    __syncthreads();
#undef SLOAD
#undef SWRITE
#undef SWAIT
#undef RESC
}
#undef KSWZ
#undef SBAR
}

#define XB_TMO      128
#define XB_XCNT(j)  (256  + 64 * (j))
#define XB_XSUB(j)  (1280 + 64 * (j))
#define XB_XGEN(j)  (2304 + 64 * (j))
#define XB_TOP      3328
#define XB_TOPGEN   3392
#define XCD_BAR_WORDS 3456
#define XB_SPIN_CAP (1u << 22)
__device__ __forceinline__ unsigned xb_ld(unsigned* p)              { return __hip_atomic_load(p, __ATOMIC_RELAXED, __HIP_MEMORY_SCOPE_AGENT); }
__device__ __forceinline__ unsigned xb_add(unsigned* p, unsigned v) { return __hip_atomic_fetch_add(p, v, __ATOMIC_RELAXED, __HIP_MEMORY_SCOPE_AGENT); }
__device__ __forceinline__ unsigned xb_xcc_id() { return (unsigned)__builtin_amdgcn_s_getreg((3 << 11) | 20) & 0xFu; }
#define XB_SPIN(cond, bar) do { unsigned _sp = 0; while (cond) { __builtin_amdgcn_s_sleep(1); \
    if ((++_sp & 255u) == 0u) { if (xb_ld(&(bar)[XB_TMO])) break; if (_sp > XB_SPIN_CAP) { atomicAdd(&(bar)[XB_TMO], 1u); break; } } } } while (0)
struct XcdBarrier { unsigned* bar; unsigned x; volatile LAS unsigned* st; };
__device__ __forceinline__ XcdBarrier xcd_barrier_post(unsigned* bar, volatile LAS unsigned* st) {
    XcdBarrier b; b.bar = bar; b.x = xb_xcc_id(); b.st = st;
    if (threadIdx.x == 0) (void)xb_add(&bar[XB_XCNT(b.x)], 1u);
    return b;
}
__device__ __forceinline__ void xcd_barrier_complete(unsigned* bar, unsigned x, unsigned& nloc, unsigned& nx) {
    const unsigned G = gridDim.x * gridDim.y * gridDim.z;
    unsigned sum, cnt, mine, sp = 0u;
    for (;;) {
        sum = 0u; cnt = 0u; mine = 0u;
#pragma unroll
        for (unsigned j = 0; j < 16; ++j) { const unsigned c = xb_ld(&bar[XB_XCNT(j)]); sum += c; cnt += (c > 0u) ? 1u : 0u; mine = (j == x) ? c : mine; }
        if (sum == G) break;
        __builtin_amdgcn_s_sleep(1);
        if ((++sp & 255u) == 0u) { if (xb_ld(&bar[XB_TMO])) break; if (sp > XB_SPIN_CAP) { atomicAdd(&bar[XB_TMO], 1u); break; } }
    }
    nloc = mine > 0u ? mine : 1u; nx = cnt > 0u ? cnt : 1u;
}
__device__ __forceinline__ void xcd_barrier(const XcdBarrier& b) {
    asm volatile("s_waitcnt vmcnt(0)" ::: "memory");
    __syncthreads();
    if (threadIdx.x == 0) {
        unsigned* bar = b.bar;
        __builtin_amdgcn_s_waitcnt(0);
        unsigned nloc = b.st[0], nx = b.st[1];
        if (nloc == 0u) { xcd_barrier_complete(bar, b.x, nloc, nx); b.st[0] = nloc; b.st[1] = nx; }
        const unsigned old = xb_add(&bar[XB_XSUB(b.x)], 1u);
        const unsigned gen = old / nloc;
        if (old + 1u == (gen + 1u) * nloc) {
            __builtin_amdgcn_fence(__ATOMIC_RELEASE, "agent");
            asm volatile("s_waitcnt vmcnt(0)" ::: "memory");
            const unsigned og = xb_add(&bar[XB_TOP], 1u);
            const unsigned tg = og / nx;
            if (og + 1u == (tg + 1u) * nx) xb_add(&bar[XB_TOPGEN], 1u);
            else XB_SPIN(xb_ld(&bar[XB_TOPGEN]) == tg, bar);
            __builtin_amdgcn_fence(__ATOMIC_ACQUIRE, "agent");
            xb_add(&bar[XB_XGEN(b.x)], 1u);
            asm volatile("s_waitcnt vmcnt(0)" ::: "memory");
        } else {
            XB_SPIN(xb_ld(&bar[XB_XGEN(b.x)]) == gen, bar);
            __builtin_amdgcn_fence(__ATOMIC_ACQUIRE, "agent");
            asm volatile("s_waitcnt vmcnt(0)" ::: "memory");
        }
    }
    __syncthreads();
}

constexpr int NWAVES = 8;
constexpr int RING_BYTES = 151 * 1024;
constexpr int LDSCTL_OFF = RING_BYTES, MISC_OFF = LDSCTL_OFF + 320;
constexpr int LDS_BYTES = 152 * 1024;
static_assert(MISC_OFF + 128 <= LDS_BYTES, "LDS map");
constexpr int N_PHASES = 12;

struct Args {
    const float* x; const float* mem; const float* attn_g; const float* w_in; const float* q_g; const float* k_g; const float* pool_w; const float* pool_s;
    const float* mem_g; const float* w_kv; const float* mq_g; const float* mk_g; const float* w_out; const float* ffn_g; const float* w_q; const float* sk1; const float* sk2;
    const float* pu; const float* pv; float* out; unsigned char* ws; int ph_lo, ph_hi;
};
struct Frame {
    LAS unsigned char* lds; char* ldsg;
    int tid, lane, wave, vcu, G;
};

__device__ __forceinline__ int in_colmap(int n) {
    if (n < 4096) return n;
    if (n < 4608) return 4176 + (n - 4096);
    if (n < 5120) return 4688 + (n - 4608);
    if (n < 5184) return 4096 + (n - 5120);
    if (n < 5200) return 4160 + (n - 5184);
    return -1;
}
template <int MAP> __device__ __forceinline__ void p0_transpose_item(const float* W, int K, int N, bf16_t* WT, LAS float* scr, int kb, int nb, int lane) {
    const int k0 = 64 * kb, n0 = 32 * nb;
    int nsrc = n0 + (lane & 31); if (MAP == 1) nsrc = in_colmap(nsrc);
#pragma unroll 8
    for (int i = 0; i < 32; ++i) { const int kk = 2 * i + (lane >> 5); scr[kk * 33 + (lane & 31)] = nsrc >= 0 ? W[(size_t)(k0 + kk) * N + nsrc] : 0.f; }
    LDS_WAIT();
    const int c = lane & 7;
#pragma unroll
    for (int j = 0; j < 4; ++j) { const int n = (lane >> 3) + 8 * j; const LAS float* s = scr + (8 * c) * 33 + n;
        u32x4 o; o.x = cvtpk(s[0 * 33], s[1 * 33]); o.y = cvtpk(s[2 * 33], s[3 * 33]); o.z = cvtpk(s[4 * 33], s[5 * 33]); o.w = cvtpk(s[6 * 33], s[7 * 33]);
        *(u32x4*)(WT + (size_t)(n0 + n) * K + k0 + 8 * c) = o; }
    LDS_WAIT();
}
__device__ __forceinline__ void rms_row_to_bf16(const float* xrow, const float* gain, bf16_t* orow, int lane) {
    const f32x4* xr = (const f32x4*)xrow + lane;
    f32x4 v[8]; float s = 0.f;
#pragma unroll
    for (int j = 0; j < 8; ++j) { v[j] = xr[64 * j]; s += (v[j].x * v[j].x + v[j].y * v[j].y) + (v[j].z * v[j].z + v[j].w * v[j].w); }
    const float rstd = 1.f / sqrtf(wave_sum(s) * (1.f / DM) + EPS);
    unsigned long long* o8 = (unsigned long long*)orow + lane;
#pragma unroll
    for (int j = 0; j < 8; ++j) { const f32x4 g = ((const f32x4*)gain)[lane + 64 * j]; const f32x4 y = v[j] * rstd * g;
        o8[64 * j] = (unsigned long long)cvtpk(y.x, y.y) | ((unsigned long long)cvtpk(y.z, y.w) << 32); }
}
struct RowF32 { f32x4 v[8]; };
__device__ __forceinline__ void row_load(RowF32& R, const float* xrow, int lane) {
    const f32x4* xr = (const f32x4*)xrow + lane;
#pragma unroll
    for (int j = 0; j < 8; ++j) R.v[j] = xr[64 * j];
}
__device__ __forceinline__ void row_to_fp8(const RowF32& R, unsigned char* orow, float* inv, int lane) {
    unsigned* o4 = (unsigned*)orow + lane; float am = 0.f;
#pragma unroll
    for (int j = 0; j < 8; ++j) am = fmaxf(am, fmaxf(fmaxf(fabsf(R.v[j].x), fabsf(R.v[j].y)), fmaxf(fabsf(R.v[j].z), fabsf(R.v[j].w))));
#pragma unroll
    for (int o = 1; o < 64; o <<= 1) am = fmaxf(am, __shfl_xor(am, o));
    const float sc = (am > 0.f && am < 3.0e38f) ? exp2f(floorf(log2f(224.f / am))) : 1.f;
#pragma unroll
    for (int j = 0; j < 8; ++j) { int w = __builtin_amdgcn_cvt_pk_fp8_f32(R.v[j].x * sc, R.v[j].y * sc, 0, false); w = __builtin_amdgcn_cvt_pk_fp8_f32(R.v[j].z * sc, R.v[j].w * sc, w, true); o4[64 * j] = (unsigned)w; }
    if (lane == 0) *inv = 1.f / sc;
}
__device__ __forceinline__ void p0_prologue(const Frame& F, const Args& a) {
    unsigned char* ws = a.ws;
    LAS float* scr = (LAS float*)(F.lds + F.wave * 16384);
    const int gw = F.vcu * NWAVES + F.wave, NGW = F.G * NWAVES, lane = F.lane;
    bf16_t* BtIn = (bf16_t*)(ws + WS_BT_IN); bf16_t* BtOut = (bf16_t*)(ws + WS_BT_OUT); bf16_t* BtQ = (bf16_t*)(ws + WS_BT_Q); bf16_t* BtKV = (bf16_t*)(ws + WS_BT_KV);
    constexpr int I_IN = 32 * 168, I_OUT = 32 * 64, I_Q = 32 * 64, I_KV = 32 * 32;
    constexpr int NIT = I_IN + I_OUT + I_Q + I_KV;
    for (int it = gw; it < NIT; it += NGW) {
        int r = it;
        if (r < I_IN) { p0_transpose_item<1>(a.w_in, DM, IN_W, BtIn, scr, r / 168, r % 168, lane); continue; } r -= I_IN;
        if (r < I_OUT) { const int kb = r / 64; p0_transpose_item<0>(a.w_out, DM, DM, BtOut, scr, kb, r % 64, lane); continue; } r -= I_OUT;
        if (r < I_Q) { p0_transpose_item<0>(a.w_q, DM, DM, BtQ, scr, r / 64, r % 64, lane); continue; } r -= I_Q;
        p0_transpose_item<0>(a.w_kv, DM, 1024, BtKV, scr, r / 32, r % 32, lane);
    }
    { bf16_t* PWt = (bf16_t*)(ws + WS_PWT);
      for (int it = gw; it < 4 * 128; it += NGW) { const int g = it >> 7, e = it & 127; const float* pw = a.pool_w + (size_t)g * 16384 + e;
          const float v0 = pw[(size_t)(2 * lane) * 128], v1 = pw[(size_t)(2 * lane + 1) * 128]; ((unsigned*)(PWt + (size_t)it * 128))[lane] = cvtpk(v0, v1); } }
    bf16_t* XN = (bf16_t*)(ws + WS_XN); bf16_t* MN = (bf16_t*)(ws + WS_MN);
    for (int m = gw; m < NTOK; m += NGW) rms_row_to_bf16(a.x + (size_t)m * DM, a.attn_g, XN + (size_t)m * DM, lane);
    for (int m = gw; m < BATCH * MEMLEN; m += NGW) rms_row_to_bf16(a.mem + (size_t)m * DM, a.mem_g, MN + (size_t)m * DM, lane);
    unsigned char* UB = ws + WS_UB; unsigned char* VB = ws + WS_VB; float* RSU = (float*)(ws + WS_RSU); float* RSV = (float*)(ws + WS_RSV);
    (void)UB; (void)VB; (void)RSU; (void)RSV;
    bf16_t* PK = (bf16_t*)(ws + WS_PK);
    for (int m = gw; m < 256; m += NGW) { const float* src = (m < 128 ? a.sk1 + (size_t)m * 128 : a.sk2 + (size_t)(m - 128) * 128);
        const f32x2 v = ((const f32x2*)src)[lane]; ((unsigned*)(PK + (size_t)m * 128))[lane] = cvtpk(v.x, v.y); }
    float* RT = (float*)(ws + WS_ROPE);
    for (int p = gw; p < SEQ; p += NGW) {
        { const float invf = powf(10000.f, -(float)lane / 64.f); const float ang = (float)p * invf;
          RT[(size_t)p * 192 + lane] = (float)cos((double)ang); RT[(size_t)p * 192 + 64 + lane] = (float)sin((double)ang); }
        if (lane < 32) { const float invf = powf(10000.f, -(float)lane / 32.f); const float ang = (float)p * invf;
          RT[(size_t)p * 192 + 128 + lane] = (float)cos((double)ang); RT[(size_t)p * 192 + 160 + lane] = (float)sin((double)ang); }
    }
}

__device__ __forceinline__ void unpack8(const u32x4 w, float* x) { x[0] = bflo(w.x); x[1] = bfhi(w.x); x[2] = bflo(w.y); x[3] = bfhi(w.y); x[4] = bflo(w.z); x[5] = bfhi(w.z); x[6] = bflo(w.w); x[7] = bfhi(w.w); }
__device__ __forceinline__ u32x4 pack8(const float* x) { u32x4 w; w.x = cvtpk(x[0], x[1]); w.y = cvtpk(x[2], x[3]); w.z = cvtpk(x[4], x[5]); w.w = cvtpk(x[6], x[7]); return w; }
struct F8 { float v[8]; };
__device__ __forceinline__ F8 ld8f(const float* p) { const f32x4 a = *(const f32x4*)p, b = *(const f32x4*)(p + 4); F8 r; r.v[0] = a.x; r.v[1] = a.y; r.v[2] = a.z; r.v[3] = a.w; r.v[4] = b.x; r.v[5] = b.y; r.v[6] = b.z; r.v[7] = b.w; return r; }
template <bool NORM, bool ROPE> __device__ __forceinline__ void head128_fin(bf16_t* base, const u32x4 wa, const u32x4 wb, int g, const F8& g1, const F8& g2, const F8& cc, const F8& sn) {
    float x1[8], x2[8];
    unpack8(wa, x1); unpack8(wb, x2);
    if (NORM) {
        float ss = 0.f;
#pragma unroll
        for (int j = 0; j < 8; ++j) ss += x1[j] * x1[j] + x2[j] * x2[j];
        ss += __shfl_xor(ss, 1); ss += __shfl_xor(ss, 2); ss += __shfl_xor(ss, 4);
        const float rstd = 1.f / sqrtf(ss * (1.f / 128.f) + EPS);
#pragma unroll
        for (int j = 0; j < 8; ++j) { x1[j] = x1[j] * rstd * g1.v[j]; x2[j] = x2[j] * rstd * g2.v[j]; }
    }
    if (ROPE) {
#pragma unroll
        for (int j = 0; j < 8; ++j) { const float c = cc.v[j], sv = sn.v[j]; const float p = x1[j], q = x2[j]; x1[j] = p * c - q * sv; x2[j] = q * c + p * sv; }
    }
    *(u32x4*)(base + 8 * g) = pack8(x1); *(u32x4*)(base + 64 + 8 * g) = pack8(x2);
}
__device__ __forceinline__ void head64_fin(bf16_t* base, const u32x4 wa, const u32x4 wb, int g, const F8& cc, const F8& sn) {
    float x1[8], x2[8];
    unpack8(wa, x1); unpack8(wb, x2);
#pragma unroll
    for (int j = 0; j < 8; ++j) { const float c = cc.v[j], sv = sn.v[j]; const float p = x1[j], q = x2[j]; x1[j] = p * c - q * sv; x2[j] = q * c + p * sv; }
    *(u32x4*)(base + 8 * g) = pack8(x1); *(u32x4*)(base + 32 + 8 * g) = pack8(x2);
}
__device__ __forceinline__ void p2_post(const Frame& F, const Args& a) {
    unsigned char* ws = a.ws; const int lane = F.lane;
    const int gw = F.vcu * NWAVES + F.wave, NGW = F.G * NWAVES;
    bf16_t* Z = (bf16_t*)(ws + WS_Z); bf16_t* MIX = (bf16_t*)(ws + WS_XN); bf16_t* KVM = (bf16_t*)(ws + WS_KVM);
    const float* RT = (const float*)(ws + WS_ROPE);
    const int g8 = lane & 7, h8 = lane >> 3, g4 = lane & 3, h4 = lane >> 2;
    const F8 qg1 = ld8f(a.q_g + 8 * g8), qg2 = ld8f(a.q_g + 64 + 8 * g8), kg1 = ld8f(a.k_g + 8 * g8), kg2 = ld8f(a.k_g + 64 + 8 * g8), mg1 = ld8f(a.mq_g + 8 * g8), mg2 = ld8f(a.mq_g + 64 + 8 * g8);
    for (int t = gw; t < NTOK; t += NGW) {
        const int pos = t & (SEQ - 1);
        bf16_t* zr = Z + (size_t)t * ZLD; const float* rp = RT + (size_t)pos * 192;
        const int w = 2 << (lane >> 4); const int cnt = (pos + 1 < w) ? pos + 1 : w;
        u32x4 pl[16];
#pragma unroll
        for (int j = 0; j < 16; ++j) { const int jj = j < cnt ? j : 0; pl[j] = *(const u32x4*)(zr - (size_t)jj * ZLD + ZC_PU + 8 * lane); }
        bf16_t* bq = zr + ZC_Q + h8 * 128; bf16_t* bk = zr + ZC_K + h8 * 128; bf16_t* bi = zr + ZC_QI + h4 * 64; bf16_t* bki = zr + ZC_KI; bf16_t* bm = zr + ZC_QM + (h8 & 3) * 128;
        const u32x4 q1 = *(const u32x4*)(bq + 8 * g8), q2 = *(const u32x4*)(bq + 64 + 8 * g8), k1 = *(const u32x4*)(bk + 8 * g8), k2 = *(const u32x4*)(bk + 64 + 8 * g8);
        const u32x4 i1 = *(const u32x4*)(bi + 8 * g4), i2 = *(const u32x4*)(bi + 32 + 8 * g4), x1 = *(const u32x4*)(bki + 8 * g4), x2 = *(const u32x4*)(bki + 32 + 8 * g4);
        const u32x4 m1 = *(const u32x4*)(bm + 8 * g8), m2 = *(const u32x4*)(bm + 64 + 8 * g8);
        const F8 c128 = ld8f(rp + 8 * g8), s128 = ld8f(rp + 64 + 8 * g8), c64 = ld8f(rp + 128 + 8 * g4), s64 = ld8f(rp + 160 + 8 * g4);
        head128_fin<true, true>(bq, q1, q2, g8, qg1, qg2, c128, s128);
        head128_fin<true, true>(bk, k1, k2, g8, kg1, kg2, c128, s128);
        head64_fin(bi, i1, i2, g4, c64, s64);
        if (lane < 4) head64_fin(bki, x1, x2, g4, c64, s64);
        if (lane < 32) head128_fin<true, false>(bm, m1, m2, g8, mg1, mg2, c128, s128);
        { float sum[8] = {0.f, 0.f, 0.f, 0.f, 0.f, 0.f, 0.f, 0.f}, ut[8];
          unpack8(pl[0], ut);
#pragma unroll
          for (int j = 0; j < 16; ++j) { float v[8]; unpack8(pl[j], v); const float on = j < cnt ? 1.f : 0.f;
#pragma unroll
              for (int e = 0; e < 8; ++e) sum[e] = fmaf(on, v[e], sum[e]); }
          const float inv = 1.f / (float)cnt; float d[8];
#pragma unroll
          for (int e = 0; e < 8; ++e) d[e] = sum[e] * inv - ut[e];
          *(u32x4*)(MIX + (size_t)t * DM + 1024 + 8 * lane) = pack8(d); }
    }
    const F8 kmg1 = ld8f(a.mk_g + 8 * g8), kmg2 = ld8f(a.mk_g + 64 + 8 * g8);
    for (int r = gw; r < BATCH * MEMLEN; r += NGW) { if (lane < 32) { bf16_t* bm = KVM + (size_t)r * 1024 + (lane >> 3) * 128; const u32x4 m1 = *(const u32x4*)(bm + 8 * g8), m2 = *(const u32x4*)(bm + 64 + 8 * g8); head128_fin<true, false>(bm, m1, m2, g8, kmg1, kmg2, kmg1, kmg2); } }
}

namespace ix {
constexpr int KP = 144, KBUF = 64 * KP;
constexpr int OFF_KI = 0, OFF_HIST = 2 * KBUF, OFF_ST = OFF_HIST + 65536, OFF_W = OFF_ST + 8192;
constexpr int CAPB = 1024;
constexpr int CAPF = 512;
enum { S_ULO = 0, S_UHI = 64, S_SH = 128, S_NEED = 192, S_FLO = 256, S_FHI = 320, S_CCNT = 384, S_ACT = 448, S_ABOVE = 512, S_COL = 576, S_FAIL = 640,
       S_PB1 = 704, S_PB2 = 768, S_PAB = 832, S_VMIN = 896, S_VMAX = 960, S_VCNT = 1024, S_ANY = 1088, S_R1 = 1089, S_R2 = 1090 };
constexpr float WSCALE = 0.25f * 0.125f;
__device__ __forceinline__ float relu_i(float x) { const int i = __float_as_int(x); return __int_as_float(i > 0 ? i : 0); }
__device__ __forceinline__ unsigned sh_for(unsigned range) { const int bits = 32 - __clz((int)range); return range == 0u ? 0u : (bits > 9 ? (unsigned)(bits - 9) : 0u); }

template <int MODE>
__device__ __forceinline__ void sweep(const Frame& F, const bf16x8 (&A)[4][4], const bf16_t* Z, unsigned* MASK, unsigned long long* CAND, size_t qrow0, size_t krow0, int NT, int t0, int stride, int vmode) {
    const int tid = F.tid, lane = F.lane, wave = F.wave, r = lane & 31, hi = lane >> 5;
    LAS unsigned char* lds = F.lds;
    volatile LAS unsigned* st = (volatile LAS unsigned*)(lds + OFF_ST);
    LAS unsigned* hist32 = (LAS unsigned*)(lds + OFF_HIST);
    unsigned qact = 0u;
    {
#pragma unroll
        for (int qp = 0; qp < 4; ++qp) { const int q0 = 8 * wave + 2 * qp; const unsigned a2 = (MODE == 0) ? (st[S_ACT + q0] | st[S_ACT + q0 + 1]) : (vmode ? 1u : (st[S_COL + q0] | st[S_COL + q0 + 1]));
            qact |= ((unsigned)__builtin_amdgcn_readfirstlane((int)a2) != 0u ? 1u : 0u) << qp; }
    }
    unsigned ccnt_[4] = {0u, 0u, 0u, 0u}, abv_[4] = {0u, 0u, 0u, 0u};
    if (MODE == 1) {
#pragma unroll
        for (int qp = 0; qp < 4; ++qp) { ccnt_[qp] = st[S_CCNT + 8 * wave + 2 * qp + hi]; abv_[qp] = st[S_ABOVE + 8 * wave + 2 * qp + hi]; }
    }
    const int srow = tid >> 3, sch = tid & 7;
    const bf16_t* ksrc = Z + (krow0 + srow) * ZLD + ZC_KI + sch * 8;
    u32x4 stg = *(const u32x4*)(ksrc + (size_t)t0 * 64 * ZLD);
    *(LAS u32x4*)(lds + OFF_KI + srow * KP + sch * 16) = stg;
    __syncthreads();
    int buf = 0;
    for (int t = t0; t < NT; t += stride) {
        const int tn = t + stride;
        if (tn < NT) stg = *(const u32x4*)(ksrc + (size_t)tn * 64 * ZLD);
        LAS unsigned char* kb = lds + OFF_KI + buf * KBUF;
        int lane_ = (int)threadIdx.x; asm volatile("" : "+v"(lane_)); lane_ &= 63;
        const int r = lane_ & 31, hi = lane_ >> 5;
        bf16x8 B0[4], B1[4];
#pragma unroll
        for (int ks = 0; ks < 4; ++ks) { B0[ks] = *(const LAS bf16x8*)(kb + r * KP + ks * 32 + hi * 16); B1[ks] = *(const LAS bf16x8*)(kb + (32 + r) * KP + ks * 32 + hi * 16); }
#pragma unroll
        for (int qp = 0; qp < 4; ++qp) {
            if (((qact >> qp) & 1u) == 0u) continue;
            const int ql = 8 * wave + 2 * qp + hi;
            const LAS f32x4* wq = (const LAS f32x4*)(lds + OFF_W + ql * 64);
            const f32x4 w0 = wq[0], w1 = wq[1], w2 = wq[2], w3 = wq[3];
            f32x16 a0 = f32x16{}, a1 = f32x16{};
#pragma unroll
            for (int ks = 0; ks < 4; ++ks) { a0 = __builtin_amdgcn_mfma_f32_32x32x16_bf16(A[qp][ks], B0[ks], a0, 0, 0, 0); a1 = __builtin_amdgcn_mfma_f32_32x32x16_bf16(A[qp][ks], B1[ks], a1, 0, 0, 0); }
            float p0 = w0.x * relu_i(a0[0]), p1 = w2.x * relu_i(a0[8]), q0 = w0.x * relu_i(a1[0]), q1 = w2.x * relu_i(a1[8]);
            p0 = fmaf(w0.y, relu_i(a0[1]), p0); p1 = fmaf(w2.y, relu_i(a0[9]), p1); q0 = fmaf(w0.y, relu_i(a1[1]), q0); q1 = fmaf(w2.y, relu_i(a1[9]), q1);
            p0 = fmaf(w0.z, relu_i(a0[2]), p0); p1 = fmaf(w2.z, relu_i(a0[10]), p1); q0 = fmaf(w0.z, relu_i(a1[2]), q0); q1 = fmaf(w2.z, relu_i(a1[10]), q1);
            p0 = fmaf(w0.w, relu_i(a0[3]), p0); p1 = fmaf(w2.w, relu_i(a0[11]), p1); q0 = fmaf(w0.w, relu_i(a1[3]), q0); q1 = fmaf(w2.w, relu_i(a1[11]), q1);
            p0 = fmaf(w1.x, relu_i(a0[4]), p0); p1 = fmaf(w3.x, relu_i(a0[12]), p1); q0 = fmaf(w1.x, relu_i(a1[4]), q0); q1 = fmaf(w3.x, relu_i(a1[12]), q1);
            p0 = fmaf(w1.y, relu_i(a0[5]), p0); p1 = fmaf(w3.y, relu_i(a0[13]), p1); q0 = fmaf(w1.y, relu_i(a1[5]), q0); q1 = fmaf(w3.y, relu_i(a1[13]), q1);
            p0 = fmaf(w1.z, relu_i(a0[6]), p0); p1 = fmaf(w3.z, relu_i(a0[14]), p1); q0 = fmaf(w1.z, relu_i(a1[6]), q0); q1 = fmaf(w3.z, relu_i(a1[14]), q1);
            p0 = fmaf(w1.w, relu_i(a0[7]), p0); p1 = fmaf(w3.w, relu_i(a0[15]), p1); q0 = fmaf(w1.w, relu_i(a1[7]), q0); q1 = fmaf(w3.w, relu_i(a1[15]), q1);
            const unsigned u0 = f2ord(p0 + p1), u1 = f2ord(q0 + q1);
            if (MODE == 0) {
                const unsigned wlo = st[S_ULO + ql], whi = st[S_UHI + ql], wsh = st[S_SH + ql];
                if (u0 >= wlo && u0 <= whi) { const unsigned bin = (u0 - wlo) >> wsh;
                    __hip_atomic_fetch_add(hist32 + ql * 256 + (bin >> 1), 1u << ((bin & 1u) * 16u), __ATOMIC_RELAXED, __HIP_MEMORY_SCOPE_WORKGROUP); }
                if (u1 >= wlo && u1 <= whi) { const unsigned bin = (u1 - wlo) >> wsh;
                    __hip_atomic_fetch_add(hist32 + ql * 256 + (bin >> 1), 1u << ((bin & 1u) * 16u), __ATOMIC_RELAXED, __HIP_MEMORY_SCOPE_WORKGROUP); }
            } else if (IX_VERIFY && vmode) {
                LAS unsigned* vs = (LAS unsigned*)(lds + OFF_ST) + ql;
                const unsigned long long w64 = __hip_atomic_load((const unsigned long long*)(MASK + (qrow0 + ql) * MASK_WPR + 2 * t), __ATOMIC_RELAXED, __HIP_MEMORY_SCOPE_AGENT);
                if ((w64 >> r) & 1ull) { __hip_atomic_fetch_min(vs + S_VMIN, u0, __ATOMIC_RELAXED, __HIP_MEMORY_SCOPE_WORKGROUP); __hip_atomic_fetch_add(vs + S_VCNT, 1u, __ATOMIC_RELAXED, __HIP_MEMORY_SCOPE_WORKGROUP); }
                else __hip_atomic_fetch_max(vs + S_VMAX, u0, __ATOMIC_RELAXED, __HIP_MEMORY_SCOPE_WORKGROUP);
                if ((w64 >> (32 + r)) & 1ull) { __hip_atomic_fetch_min(vs + S_VMIN, u1, __ATOMIC_RELAXED, __HIP_MEMORY_SCOPE_WORKGROUP); __hip_atomic_fetch_add(vs + S_VCNT, 1u, __ATOMIC_RELAXED, __HIP_MEMORY_SCOPE_WORKGROUP); }
                else __hip_atomic_fetch_max(vs + S_VMAX, u1, __ATOMIC_RELAXED, __HIP_MEMORY_SCOPE_WORKGROUP);
            } else {
                const unsigned flo = st[S_FLO + ql], fhi = st[S_FHI + ql]; const bool col = st[S_COL + ql] != 0u;
                const unsigned long long bal0 = __ballot(col && u0 > fhi), bal1 = __ballot(col && u1 > fhi);
                const unsigned bh0 = (unsigned)(bal0 >> (32 * hi)), bh1 = (unsigned)(bal1 >> (32 * hi));
                if (col && r == 0) *(unsigned long long*)(MASK + (qrow0 + ql) * MASK_WPR + 2 * t) = (unsigned long long)bh0 | ((unsigned long long)bh1 << 32);
                abv_[qp] += __popc(bh0) + __popc(bh1);
                const bool c0 = col && (u0 >= flo) && (u0 <= fhi), c1 = col && (u1 >= flo) && (u1 <= fhi);
                const unsigned long long cb0 = __ballot(c0), cb1 = __ballot(c1);
                if (cb0 | cb1) { const unsigned h0 = (unsigned)(cb0 >> (32 * hi)), h1 = (unsigned)(cb1 >> (32 * hi)); const unsigned lt = (1u << r) - 1u;
                    const unsigned pos0 = ccnt_[qp] + __popc(h0 & lt), pos1 = ccnt_[qp] + __popc(h0) + __popc(h1 & lt);
                    if (c0 && pos0 < (unsigned)CAPB) CAND[(size_t)ql * CAPB + pos0] = (unsigned long long)u0 | ((unsigned long long)(unsigned)(64 * t + r) << 32);
                    if (c1 && pos1 < (unsigned)CAPB) CAND[(size_t)ql * CAPB + pos1] = (unsigned long long)u1 | ((unsigned long long)(unsigned)(64 * t + 32 + r) << 32);
                    ccnt_[qp] += __popc(h0) + __popc(h1); }
            }
        }
        if (tn < NT) *(LAS u32x4*)(lds + OFF_KI + (buf ^ 1) * KBUF + srow * KP + sch * 16) = stg;
        __syncthreads();
        buf ^= 1;
    }
    if (MODE == 1 && !vmode) { const int r0 = lane & 31, h0 = lane >> 5;
#pragma unroll
        for (int qp = 0; qp < 4; ++qp) { const int ql = 8 * wave + 2 * qp + h0; if (r0 == 0 && st[S_COL + ql] != 0u) { st[S_CCNT + ql] = ccnt_[qp]; st[S_ABOVE + ql] = abv_[qp]; } } }
}

__device__ __forceinline__ void resolve(const Frame& F, unsigned* MASK, const unsigned long long* CAND, size_t qrow0, int NT) {
    int lane = (int)threadIdx.x; asm volatile("" : "+v"(lane)); lane &= 63; const int wave = F.wave;
    LAS unsigned char* lds = F.lds;
    volatile LAS unsigned* st = (volatile LAS unsigned*)(lds + OFF_ST);
    LAS unsigned* wh = (LAS unsigned*)(lds + OFF_HIST + wave * 4608); LAS unsigned* bm = wh + 512; LAS unsigned long long* sl = (LAS unsigned long long*)(bm + 512);
    const unsigned long long ltm = (1ull << lane) - 1ull;
    for (int qi = 0; qi < 8; ++qi) {
        const int q = 8 * wave + qi;
        if (st[S_COL + q] == 0u) continue;
        const unsigned cnt = st[S_CCNT + q], ab = st[S_ABOVE + q];
        if (!(ab < 256u && ab + cnt >= 256u && cnt <= (unsigned)CAPB)) { if (lane == 0) st[S_FAIL + q] = 1u; continue; }
        if (lane == 0) st[S_FAIL + q] = 0u;
        unsigned need = 256u - ab, lo = st[S_FLO + q], hi = st[S_FHI + q], sh = 0u, cbin = 0u;
        const unsigned long long* cq = CAND + (size_t)q * CAPB;
#pragma unroll
        for (int i = 0; i < 8; ++i) bm[lane * 8 + i] = 0u;
        for (int lev = 0; lev < 5; ++lev) {
            sh = sh_for(hi - lo);
#pragma unroll
            for (int i = 0; i < 8; ++i) wh[lane * 8 + i] = 0u;
            LDS_WAIT();
            for (unsigned j = lane; j < cnt; j += 64) { const unsigned u = (unsigned)cq[j]; if (u >= lo && u <= hi) __hip_atomic_fetch_add(wh + ((u - lo) >> sh), 1u, __ATOMIC_RELAXED, __HIP_MEMORY_SCOPE_WORKGROUP); }
            LDS_WAIT();
            unsigned hb[8], s8 = 0u;
#pragma unroll
            for (int i = 0; i < 8; ++i) { hb[i] = wh[lane * 8 + i]; s8 += hb[i]; }
            unsigned above = 0u;
            { unsigned inc = s8;
#pragma unroll
              for (int o = 1; o < 64; o <<= 1) { const unsigned v = __shfl_down(inc, o); if (lane + o < 64) inc += v; }
              above = inc - s8; }
            const bool mine = above < need && need <= above + s8;
            unsigned bstar = 0u, run = above, cb = 0u;
            if (mine) { bool found = false;
#pragma unroll
                for (int i = 7; i >= 0; --i) { if (!found) { if (run + hb[i] >= need) { bstar = (unsigned)(lane * 8 + i); cb = hb[i]; found = true; } else run += hb[i]; } } }
            const unsigned long long mb = __ballot(mine); const int src = mb ? (int)__builtin_ctzll(mb) : 0;
            bstar = __shfl(bstar, src); run = __shfl(run, src); cbin = __shfl(cb, src);
            const unsigned nlo = lo + (bstar << sh); const unsigned long long e = (unsigned long long)nlo + ((1ull << sh) - 1ull);
            hi = e > (unsigned long long)hi ? hi : (unsigned)e; lo = nlo; need -= run;
            if (cbin <= 64u || sh == 0u) break;
        }
        const bool tiemode = cbin > 64u;
        unsigned m = 0u;
        for (unsigned j0 = 0; j0 < cnt; j0 += 64) { const unsigned j = j0 + lane; const bool vj = j < cnt; const unsigned long long e = vj ? cq[j] : 0ull; const unsigned u = (unsigned)e, key = (unsigned)(e >> 32);
            const bool inw = vj && u >= lo && u <= hi; const unsigned long long bal = __ballot(inw); const unsigned pos = m + (unsigned)__popcll(bal & ltm);
            if (vj && (u > hi || (tiemode && inw && pos < need))) __hip_atomic_fetch_or(bm + (key >> 5), 1u << (key & 31u), __ATOMIC_RELAXED, __HIP_MEMORY_SCOPE_WORKGROUP);
            if (!tiemode && inw && pos < 64u) sl[pos] = e;
            m += (unsigned)__popcll(bal); }
        LDS_WAIT();
        if (!tiemode) { if (m > 64u) m = 64u;
            if ((unsigned)lane < m) { const unsigned long long ej = sl[lane]; const unsigned uj = (unsigned)ej; unsigned rank = 0u;
                for (unsigned j2 = 0; j2 < m; ++j2) { const unsigned u2 = (unsigned)sl[j2]; rank += (u2 > uj || (u2 == uj && j2 < (unsigned)lane)) ? 1u : 0u; }
                if (rank < need) { const unsigned key = (unsigned)(ej >> 32); __hip_atomic_fetch_or(bm + (key >> 5), 1u << (key & 31u), __ATOMIC_RELAXED, __HIP_MEMORY_SCOPE_WORKGROUP); } } }
        LDS_WAIT();
        unsigned* mrow = MASK + (qrow0 + q) * MASK_WPR;
        for (int w = lane; w < 2 * NT; w += 64) { const unsigned b = bm[w]; if (b) { const unsigned old = __hip_atomic_load(mrow + w, __ATOMIC_RELAXED, __HIP_MEMORY_SCOPE_AGENT); mrow[w] = old | b; } }
        LDS_WAIT();
    }
}

__device__ __forceinline__ void unit(const Frame& F, const bf16_t* Z, unsigned* MASK, unsigned long long* CANDW, unsigned* ERR, int b, int c) {
    const int tid = F.tid, lane = F.lane, wave = F.wave, r = lane & 31, hi = lane >> 5;
    const int NT = c + 1; const size_t qrow0 = (size_t)b * SEQ + 64 * c, krow0 = (size_t)b * SEQ;
    LAS unsigned char* lds = F.lds;
    volatile LAS unsigned* st = (volatile LAS unsigned*)(lds + OFF_ST);
    LAS unsigned* hist32 = (LAS unsigned*)(lds + OFF_HIST);
    { const int tend = 4 * ((c >> 2) + 1), nz = 2 * (tend - NT);
      for (int i = tid; i < 64 * nz; i += 512) { const int q = i / nz, wi = 2 * NT + i % nz; MASK[(qrow0 + q) * MASK_WPR + wi] = 0u; } }
    if (c <= 3) {
        for (int i = tid; i < 64 * 2 * NT; i += 512) { const int q = i / (2 * NT), wi = i % (2 * NT); MASK[(qrow0 + q) * MASK_WPR + wi] = 0xFFFFFFFFu; }
        return;
    }
    bf16x8 A[4][4];
#pragma unroll
    for (int qp = 0; qp < 4; ++qp) {
        const int query = 8 * wave + 2 * qp + ((r >> 2) & 1), head = (r & 3) + 4 * (r >> 3);
        const bf16_t* src = Z + (qrow0 + query) * ZLD + ZC_QI + head * 64 + 8 * hi;
#pragma unroll
        for (int ks = 0; ks < 4; ++ks) A[qp][ks] = *(const bf16x8*)(src + ks * 16);
    }
    for (int i = tid; i < 64 * 16; i += 512) { const int q = i >> 4, hh = i & 15; ((LAS float*)(lds + OFF_W))[i] = bflo((unsigned)Z[(qrow0 + q) * ZLD + ZC_WI + hh]) * WSCALE; }
    const int stride = NT >= 32 ? 8 : (NT >= 16 ? 4 : 1), t0 = stride >> 1, nsamp = (NT - t0 + stride - 1) / stride;
    const bool pilot = stride > 1;
    int r1 = 1, r2 = 1;
    if (pilot) { const float ns = 256.f * (float)nsamp / (float)NT; const float sg = sqrtf(ns * (1.f - 1.f / (float)stride)); const int mg = (int)ceilf(4.f * sg) + 2;
        r1 = (int)floorf(ns) - mg; if (r1 < 1) r1 = 1; r2 = (int)ceilf(ns) + mg; }
    if (tid < 64) { st[S_ULO + tid] = 0u; st[S_UHI + tid] = 0xFFFFFFFFu; st[S_SH + tid] = 23u; st[S_NEED + tid] = 256u; st[S_ACT + tid] = 1u; st[S_CCNT + tid] = 0u; st[S_ABOVE + tid] = 0u;
                    st[S_COL + tid] = 1u; st[S_FAIL + tid] = pilot ? 0u : 1u; st[S_PB1 + tid] = 511u; st[S_PB2 + tid] = 0u; st[S_PAB + tid] = 0u; }
    __syncthreads();
    int stage = pilot ? 0 : 2; bool after_fallback = !pilot;
    for (int iter = 0; iter < 24; ++iter) {
        if (stage <= 2) {
            { int tid_ = (int)threadIdx.x; asm volatile("" : "+v"(tid_));
              for (int i = 0; i < 32; ++i) hist32[tid_ + 512 * i] = 0u;
              if (tid_ == 0) st[S_ANY] = 0u; }
            __syncthreads();
            const bool smp = stage <= 1;
            sweep<0>(F, A, Z, MASK, CANDW, qrow0, krow0, NT, smp ? t0 : 0, smp ? stride : 1, 0);
            { int tid_ = (int)threadIdx.x; asm volatile("" : "+v"(tid_)); const int ln = tid_ & 63;
              const int q = tid_ >> 3, seg = tid_ & 7; const LAS unsigned* h32 = hist32 + q * 256 + seg * 32;
              unsigned cnt = 0u;
              for (int i = 0; i < 32; ++i) { const unsigned wv = h32[i]; cnt += (wv & 0xffffu) + (wv >> 16); }
              unsigned above = 0u;
#pragma unroll
              for (int k = 0; k < 8; ++k) { const unsigned ck = __shfl(cnt, (ln & ~7) + k); if (k > seg) above += ck; }
              const unsigned ulo = st[S_ULO + q], uhi = st[S_UHI + q], sh = st[S_SH + q];
              if (smp) {
                  const unsigned pab = stage == 1 ? st[S_PAB + q] : 0u;
                  const unsigned t1 = (unsigned)r1 - (stage == 1 ? pab : 0u), t2 = (unsigned)r2 - (stage == 1 ? pab : 0u);
#pragma unroll
                  for (int which = 0; which < 2; ++which) { const unsigned tg = which ? t2 : t1;
                      if (above < tg && tg <= above + cnt) { unsigned run = above; int bstar = -1;
                          for (int i = 31; i >= 0; --i) { const unsigned wv = h32[i]; const unsigned c1 = wv >> 16, c0 = wv & 0xffffu;
                              if (bstar < 0) { if (run + c1 >= tg) bstar = seg * 64 + 2 * i + 1; else run += c1; }
                              if (bstar < 0) { if (run + c0 >= tg) bstar = seg * 64 + 2 * i; else run += c0; } }
                          if (which == 0) { st[S_PB1 + q] = (unsigned)bstar; if (stage == 0) st[S_PAB + q] = run; } else st[S_PB2 + q] = (unsigned)bstar; } }
              } else {
                  const unsigned need = st[S_NEED + q], active = st[S_ACT + q];
                  if (active && above < need && need <= above + cnt) {
                      unsigned run = above; int bstar = -1; unsigned cbin = 0u;
                      for (int i = 31; i >= 0; --i) { const unsigned wv = h32[i]; const unsigned c1 = wv >> 16, c0 = wv & 0xffffu;
                          if (bstar < 0) { if (run + c1 >= need) { bstar = seg * 64 + 2 * i + 1; cbin = c1; } else run += c1; }
                          if (bstar < 0) { if (run + c0 >= need) { bstar = seg * 64 + 2 * i; cbin = c0; } else run += c0; } }
                      const unsigned nlo = ulo + ((unsigned)bstar << sh); const unsigned long long e = (unsigned long long)nlo + ((1ull << sh) - 1ull);
                      const unsigned nhi = e > (unsigned long long)uhi ? uhi : (unsigned)e;
                      if (cbin <= (unsigned)CAPF || sh == 0u) { st[S_FLO + q] = nlo; st[S_FHI + q] = nhi; st[S_ACT + q] = 0u; st[S_ULO + q] = 1u; st[S_UHI + q] = 0u; }
                      else { st[S_ULO + q] = nlo; st[S_UHI + q] = nhi; st[S_SH + q] = sh >= 9u ? sh - 9u : 0u; st[S_NEED + q] = need - run; st[S_ANY] = 1u; }
                  }
              } }
            __syncthreads();
            if (stage == 0) {
                if (tid < 64) { const unsigned b1 = st[S_PB1 + tid], b2 = st[S_PB2 + tid]; const unsigned nlo = b2 << 23; const unsigned long long e = ((unsigned long long)(b1 + 1u) << 23) - 1ull;
                    const unsigned nhi = e > 0xFFFFFFFFull ? 0xFFFFFFFFu : (unsigned)e; st[S_ULO + tid] = nlo; st[S_UHI + tid] = nhi; st[S_SH + tid] = sh_for(nhi - nlo); st[S_PB1 + tid] = 511u; st[S_PB2 + tid] = 0u; }
                stage = 1;
            } else if (stage == 1) {
                if (tid < 64) { const unsigned b1 = st[S_PB1 + tid], b2 = st[S_PB2 + tid], ulo = st[S_ULO + tid], uhi = st[S_UHI + tid], sh = st[S_SH + tid];
                    const unsigned flo = ulo + (b2 << sh); const unsigned long long e = (unsigned long long)ulo + ((unsigned long long)(b1 + 1u) << sh) - 1ull;
                    st[S_FLO + tid] = flo; st[S_FHI + tid] = e > (unsigned long long)uhi ? uhi : (unsigned)e; }
                stage = 3;
            } else { const unsigned any = st[S_ANY]; if (!any) stage = 3; }
            __syncthreads();
        } else {
            const int vm = stage == 4 ? 1 : 0;
            if (vm) { if (tid < 64) { st[S_VMIN + tid] = 0xFFFFFFFFu; st[S_VMAX + tid] = 0u; st[S_VCNT + tid] = 0u; } __syncthreads(); }
            sweep<1>(F, A, Z, MASK, CANDW, qrow0, krow0, NT, 0, 1, vm);
            VM_WAIT(); __syncthreads();
            if (vm) { if (tid < 64) { if (st[S_VCNT + tid] != 256u || st[S_VMIN + tid] < st[S_VMAX + tid]) atomicOr(ERR, 1u); } __syncthreads(); break; }
            resolve(F, MASK, CANDW, qrow0, NT);
            VM_WAIT(); __syncthreads();
            unsigned nf = 0u;
            if (!after_fallback) { if (tid < 64) nf = st[S_FAIL + tid] & st[S_COL + tid]; nf = (unsigned)__syncthreads_or((int)nf); }
            if (nf) {
                if (tid < 64) { const unsigned f = st[S_FAIL + tid] & st[S_COL + tid]; st[S_ULO + tid] = f ? 0u : 1u; st[S_UHI + tid] = f ? 0xFFFFFFFFu : 0u; st[S_SH + tid] = 23u; st[S_NEED + tid] = 256u; st[S_ACT + tid] = f;
                    st[S_COL + tid] = f; if (f) { st[S_CCNT + tid] = 0u; st[S_ABOVE + tid] = 0u; } }
                __syncthreads();
                stage = 2; after_fallback = true;
            } else { if (IX_VERIFY) stage = 4; else break; }
        }
    }
}
}

namespace peer {
constexpr int TT = 16;
constexpr int SP = 129;
constexpr int OFF_S = 0, OFF_L = 256 * SP * 4;
constexpr int OFF_A = 0;
__device__ __forceinline__ void ins16(unsigned (&L)[16], unsigned x) {
#pragma unroll
    for (int j = 0; j < 16; ++j) { const unsigned a = L[j]; const unsigned mx = a > x ? a : x; x = a > x ? x : a; L[j] = mx; }
}
__device__ __forceinline__ float dot2bf(unsigned w, unsigned x, float acc) { return __builtin_amdgcn_fdot2_f32_bf16(__builtin_bit_cast(bf16x2_t, w), __builtin_bit_cast(bf16x2_t, x), acc, false); }
__device__ __forceinline__ float gelu_erf(float h) { return 0.5f * h * (1.f + erff(h * 0.70710678118654752f)); }

__device__ __forceinline__ void fp8dot4(unsigned w, f32x2 h01, f32x2 h23, f32x2& a0, f32x2& a1) {
    const f32x2 lo = __builtin_amdgcn_cvt_pk_f32_fp8((int)w, false), hi = __builtin_amdgcn_cvt_pk_f32_fp8((int)w, true); a0 = lo * h01 + a0; a1 = hi * h23 + a1; }
__device__ __forceinline__ void fp8axpy4(unsigned w, f32x2 a2, f32x2& c01, f32x2& c23) {
    const f32x2 lo = __builtin_amdgcn_cvt_pk_f32_fp8((int)w, false), hi = __builtin_amdgcn_cvt_pk_f32_fp8((int)w, true); c01 = lo * a2 + c01; c23 = hi * a2 + c23; }
constexpr int NSL = 16, SLW = 128;
__device__ __forceinline__ float dpp_sum8(float v) {
    v += __int_as_float(__builtin_amdgcn_update_dpp(0, __float_as_int(v), 0xB1, 0xF, 0xF, true));
    v += __int_as_float(__builtin_amdgcn_update_dpp(0, __float_as_int(v), 0x4E, 0xF, 0xF, true));
    v += __int_as_float(__builtin_amdgcn_update_dpp(0, __float_as_int(v), 0x141, 0xF, 0xF, true));
    return v;
}
#define PEER_EID(V0, V1, i) ((((i) < 8 ? (V0) : (V1))[((i) & 7) >> 1] >> (16 * ((i) & 1))) & 0xffffu)

struct TabCvt { const float* pu; const float* pv; unsigned char* UB; unsigned char* VB; float* RSU; float* RSV; };
__device__ __forceinline__ const float* tab_src(const TabCvt& T, int m) { return m < NEXP ? T.pu + (size_t)m * DM : T.pv + (size_t)(m - NEXP) * DM; }
__device__ __forceinline__ void tab_finish(const TabCvt& T, const RowF32& R, int m, int lane) { if (m < NEXP) row_to_fp8(R, T.UB + (size_t)m * DM, T.RSU + m, lane); else row_to_fp8(R, T.VB + (size_t)(m - NEXP) * DM, T.RSV + (m - NEXP), lane); }
__device__ __forceinline__ void route_step(const Frame& F, const bf16_t* PQ, const bf16x8 (&Bf)[2][8], unsigned short* E16, float* GT, int tok0, const TabCvt& T, int m0, int m1) {
    const int tid = F.tid, lane = F.lane, wave = F.wave, r = lane & 31, hi = lane >> 5;
    LAS float* S = (LAS float*)(F.lds + OFF_S); LAS unsigned* L = (LAS unsigned*)(F.lds + OFF_L);
    RowF32 R;
    if (m0 >= 0) row_load(R, tab_src(T, m0), lane);
    { const int half = wave & 1, cp = (wave >> 1) & 1, rh = wave >> 2;
#pragma unroll
      for (int r2 = 0; r2 < 2; ++r2) {
          const int rt = 2 * rh + r2; const int pair = 32 * rt + r, tok = pair >> 3, p = pair & 7;
          const bf16_t* src = PQ + (size_t)(tok0 + tok) * DM + p * 256 + half * 128 + 8 * hi;
          bf16x8 A[8];
#pragma unroll
          for (int ks = 0; ks < 8; ++ks) A[ks] = *(const bf16x8*)(src + ks * 16);
#pragma unroll
          for (int c2 = 0; c2 < 2; ++c2) {
              f32x16 acc = f32x16{};
#pragma unroll
              for (int ks = 0; ks < 8; ++ks) acc = __builtin_amdgcn_mfma_f32_32x32x16_bf16(A[ks], Bf[c2][ks], acc, 0, 0, 0);
#pragma unroll
              for (int i = 0; i < 16; ++i) { const int row = (32 * rt + (i & 3) + 8 * (i >> 2) + 4 * hi) * 2 + half; S[row * SP + (2 * cp + c2) * 32 + r] = acc[i]; }
          } } }
    if (m0 >= 0) tab_finish(T, R, m0, lane);
    if (m1 >= 0) row_load(R, tab_src(T, m1), lane);
    __syncthreads();
    { const int row = tid >> 1, part = tid & 1; unsigned L16[16];
#pragma unroll
      for (int j = 0; j < 16; ++j) L16[j] = 0u;
#pragma unroll 4
      for (int n = 0; n < 64; ++n) { const int nn = part * 64 + n; const unsigned k = (f2ord(S[row * SP + nn]) & ~127u) | (unsigned)(127 - nn); ins16(L16, k); }
      unsigned oth[16];
#pragma unroll
      for (int j = 0; j < 16; ++j) oth[j] = __shfl_xor(L16[j], 1);
#pragma unroll
      for (int j = 0; j < 16; ++j) ins16(L16, part == 0 ? oth[j] : 0u);
      if (part == 0) {
#pragma unroll
          for (int j = 0; j < 16; ++j) L[row * 16 + j] = L16[j]; } }
    __syncthreads();
    if (tid < 128) {
        const int pair = tid; const LAS float* S1 = S + (pair * 2) * SP; const LAS float* S2 = S + (pair * 2 + 1) * SP;
        const LAS unsigned* L1 = L + (pair * 2) * 16; const LAS unsigned* L2 = L1 + 16;
        float v1[16], v2[16];
#pragma unroll
        for (int j = 0; j < 16; ++j) { v1[j] = S1[127 - (L1[j] & 127u)]; v2[j] = S2[127 - (L2[j] & 127u)]; }
        unsigned C16[16];
#pragma unroll
        for (int j = 0; j < 16; ++j) C16[j] = 0u;
#pragma unroll
        for (int i = 0; i < 16; ++i)
#pragma unroll
            for (int j = 0; j < 16; ++j) if ((i + 1) * (j + 1) <= 16) { const unsigned k = (f2ord(v1[i] + v2[j]) & ~255u) | (unsigned)(255 - (i * 16 + j)); ins16(C16, k); }
        float sc[16]; unsigned ex[16]; float mx = -3.0e38f;
#pragma unroll
        for (int q = 0; q < 16; ++q) { const unsigned ci = 255u - (C16[q] & 255u); const unsigned n1 = 127u - (L1[ci >> 4] & 127u), n2 = 127u - (L2[ci & 15u] & 127u);
            sc[q] = S1[n1] + S2[n2]; ex[q] = n1 * 128u + n2; mx = fmaxf(mx, sc[q]); }
        float sum = 0.f;
#pragma unroll
        for (int q = 0; q < 16; ++q) { sc[q] = __expf(sc[q] - mx); sum += sc[q]; }
        const float inv = 1.f / sum;
        const size_t o = (size_t)(tok0 + (pair >> 3)) * 128 + (pair & 7) * 16;
        u32x4 e0, e1; e0.x = ex[0] | (ex[1] << 16); e0.y = ex[2] | (ex[3] << 16); e0.z = ex[4] | (ex[5] << 16); e0.w = ex[6] | (ex[7] << 16);
        e1.x = ex[8] | (ex[9] << 16); e1.y = ex[10] | (ex[11] << 16); e1.z = ex[12] | (ex[13] << 16); e1.w = ex[14] | (ex[15] << 16);
        *(u32x4*)(E16 + o) = e0; *(u32x4*)(E16 + o + 8) = e1;
#pragma unroll
        for (int q = 0; q < 4; ++q) *(f32x4*)(GT + o + 4 * q) = (f32x4){sc[4 * q] * inv, sc[4 * q + 1] * inv, sc[4 * q + 2] * inv, sc[4 * q + 3] * inv};
    }
    if (m1 >= 0) tab_finish(T, R, m1, lane);
    __syncthreads();
}

__device__ __forceinline__ void udot_compute(const u32x4 (&d)[16], const u32x4 h0, const u32x4 h1, float* dst, int k, bool ok) {
    f32x2 hq[8];
    hq[0] = (f32x2){bflo(h0.x), bfhi(h0.x)}; hq[1] = (f32x2){bflo(h0.y), bfhi(h0.y)}; hq[2] = (f32x2){bflo(h0.z), bfhi(h0.z)}; hq[3] = (f32x2){bflo(h0.w), bfhi(h0.w)};
    hq[4] = (f32x2){bflo(h1.x), bfhi(h1.x)}; hq[5] = (f32x2){bflo(h1.y), bfhi(h1.y)}; hq[6] = (f32x2){bflo(h1.z), bfhi(h1.z)}; hq[7] = (f32x2){bflo(h1.w), bfhi(h1.w)};
    float keep0 = 0.f, keep1 = 0.f;
#pragma unroll
    for (int i = 0; i < 16; ++i) {
        f32x2 a0 = {0.f, 0.f}, a1 = {0.f, 0.f};
        fp8dot4(d[i].x, hq[0], hq[1], a0, a1); fp8dot4(d[i].y, hq[2], hq[3], a0, a1); fp8dot4(d[i].z, hq[4], hq[5], a0, a1); fp8dot4(d[i].w, hq[6], hq[7], a0, a1);
        const float pr = dpp_sum8((a0.x + a0.y) + (a1.x + a1.y));
        if ((i & 7) == k) { if (i < 8) keep0 = pr; else keep1 = pr; }
    }
    if (ok) { dst[0] = keep0; dst[8] = keep1; }
}
__device__ __forceinline__ void udots(const Frame& F, const bf16_t* HN, const unsigned char* UB, const unsigned short* E16, float* PART) {
    const int lane = F.lane, g = lane >> 3, k = lane & 7;
    const int ngr = (F.G % 8 == 0) ? 8 : 1, wpg = F.G / ngr, x = F.vcu / wpg, wl = (F.vcu % wpg) * NWAVES + F.wave, wst = wpg * NWAVES, spg = NSL / ngr;
    const int ntw = (NTOK - wl + wst - 1) / wst;
#define UD_T(j) ((size_t)((wl + (j) * wst) < NTOK ? (wl + (j) * wst) : (NTOK - 1)))
#define UD_IDS(j, V0, V1) { const unsigned short* ep_ = E16 + UD_T(j) * 128 + g * 16; V0 = *(const u32x4*)ep_; V1 = *(const u32x4*)(ep_ + 8); }
#define UD_HN(j, H0, H1) { const bf16_t* hp_ = HN + UD_T(j) * DM + s * SLW + k * 16; H0 = *(const u32x4*)hp_; H1 = *(const u32x4*)(hp_ + 8); }
#define UD_ROWS(D, V0, V1) { _Pragma("unroll") for (int i = 0; i < 16; ++i) D[i] = *(const u32x4*)(ub + (size_t)PEER_EID(V0, V1, i) * DM); }
    for (int rr = 0; rr < spg; ++rr) {
        const int s = x + ngr * rr;
        const unsigned char* ub = UB + s * SLW + k * 16;
        float* pb = PART + (size_t)s * NTOK * 128 + g * 16 + k;
        u32x4 dA[16], dB[16], idA0, idA1, idB0, idB1, hA0, hA1, hB0, hB1;
        UD_IDS(0, idA0, idA1) UD_HN(0, hA0, hA1) UD_ROWS(dA, idA0, idA1)
        UD_IDS(1, idB0, idB1) UD_HN(1, hB0, hB1)
        for (int j = 0; j < ntw; j += 2) {
            UD_ROWS(dB, idB0, idB1)
            UD_IDS(j + 2, idA0, idA1)
            udot_compute(dA, hA0, hA1, pb + UD_T(j) * 128, k, true);
            UD_HN(j + 2, hA0, hA1)
            UD_ROWS(dA, idA0, idA1)
            UD_IDS(j + 3, idB0, idB1)
            udot_compute(dB, hB0, hB1, pb + UD_T(j + 1) * 128, k, j + 1 < ntw);
            UD_HN(j + 3, hB0, hB1)
        }
    }
#undef UD_IDS
#undef UD_HN
#undef UD_ROWS
}
__device__ __forceinline__ void combine(const Frame& F, const float* PART, const unsigned short* E16, const float* GT, const float* RSU, const float* RSV, float* AT) {
    const size_t n4 = (size_t)NTOK * 128 / 4, stride = (size_t)F.G * NWAVES * 64;
    for (size_t i = (size_t)F.vcu * NWAVES * 64 + F.tid; i < n4; i += stride) {
        f32x4 pv[NSL];
#pragma unroll
        for (int s = 0; s < NSL; ++s) pv[s] = *(const f32x4*)(PART + (size_t)s * n4 * 4 + i * 4);
        const u32x2 ee = *(const u32x2*)(E16 + i * 4); const f32x4 gg = *(const f32x4*)(GT + i * 4);
        const unsigned e0 = ee.x & 0xffffu, e1 = ee.x >> 16, e2 = ee.y & 0xffffu, e3 = ee.y >> 16;
        const float su0 = RSU[e0], su1 = RSU[e1], su2 = RSU[e2], su3 = RSU[e3], sv0 = RSV[e0], sv1 = RSV[e1], sv2 = RSV[e2], sv3 = RSV[e3];
        f32x4 sacc = pv[0];
#pragma unroll
        for (int s = 1; s < NSL; ++s) sacc += pv[s];
        f32x4 o; o.x = gg.x * gelu_erf(sacc.x * su0) * sv0; o.y = gg.y * gelu_erf(sacc.y * su1) * sv1; o.z = gg.z * gelu_erf(sacc.z * su2) * sv2; o.w = gg.w * gelu_erf(sacc.w * su3) * sv3;
        *(f32x4*)(AT + i * 4) = o;
    }
}
__device__ __forceinline__ void vacc_compute(const u32x4 (&d)[16], const f32x4 a0, const f32x4 a1, const f32x4 a2, const f32x4 a3, float* orow, int g, bool ok) {
    f32x2 acc[8];
#pragma unroll
    for (int c = 0; c < 8; ++c) acc[c] = (f32x2){0.f, 0.f};
    const float av[16] = {a0.x, a0.y, a0.z, a0.w, a1.x, a1.y, a1.z, a1.w, a2.x, a2.y, a2.z, a2.w, a3.x, a3.y, a3.z, a3.w};
#pragma unroll
    for (int i = 0; i < 16; ++i) { const f32x2 aa = {av[i], av[i]};
        fp8axpy4(d[i].x, aa, acc[0], acc[1]); fp8axpy4(d[i].y, aa, acc[2], acc[3]); fp8axpy4(d[i].z, aa, acc[4], acc[5]); fp8axpy4(d[i].w, aa, acc[6], acc[7]); }
    float v[16];
#pragma unroll
    for (int c = 0; c < 8; ++c) { v[2 * c] = acc[c].x; v[2 * c + 1] = acc[c].y; }
    float R[8], S4[4];
#pragma unroll
    for (int c = 0; c < 8; ++c) { auto r = __builtin_amdgcn_permlane32_swap(__float_as_uint(v[c]), __float_as_uint(v[c + 8]), false, false); R[c] = __uint_as_float(r[0]) + __uint_as_float(r[1]); }
#pragma unroll
    for (int c = 0; c < 4; ++c) { auto r = __builtin_amdgcn_permlane16_swap(__float_as_uint(R[c]), __float_as_uint(R[c + 4]), false, false); S4[c] = __uint_as_float(r[0]) + __uint_as_float(r[1]); }
    const bool b8 = (g & 1) != 0;
    float T0, T1;
    { const float keep = b8 ? S4[2] : S4[0], send = b8 ? S4[0] : S4[2]; T0 = keep + __int_as_float(__builtin_amdgcn_update_dpp(0, __float_as_int(send), 0x128, 0xF, 0xF, true)); }
    { const float keep = b8 ? S4[3] : S4[1], send = b8 ? S4[1] : S4[3]; T1 = keep + __int_as_float(__builtin_amdgcn_update_dpp(0, __float_as_int(send), 0x128, 0xF, 0xF, true)); }
    if (ok) { f32x2 o2 = *(const f32x2*)orow; o2.x += T0; o2.y += T1; *(f32x2*)orow = o2; }
}
__device__ __forceinline__ void vacc(const Frame& F, const unsigned char* VB, const unsigned short* E16, const float* AT, float* out) {
    const int lane = F.lane, g = lane >> 3, k = lane & 7;
    const int ngr = (F.G % 8 == 0) ? 8 : 1, wpg = F.G / ngr, x = F.vcu / wpg, wl = (F.vcu % wpg) * NWAVES + F.wave, wst = wpg * NWAVES, spg = NSL / ngr;
    const int ntw = (NTOK - wl + wst - 1) / wst;
#define UD_IDS(j, V0, V1) { const unsigned short* ep_ = E16 + UD_T(j) * 128 + g * 16; V0 = *(const u32x4*)ep_; V1 = *(const u32x4*)(ep_ + 8); }
#define VA_A(j, A0, A1, A2, A3) { const float* ap_ = AT + UD_T(j) * 128 + g * 16; A0 = *(const f32x4*)ap_; A1 = *(const f32x4*)(ap_ + 4); A2 = *(const f32x4*)(ap_ + 8); A3 = *(const f32x4*)(ap_ + 12); }
#define UD_ROWS(D, V0, V1) { _Pragma("unroll") for (int i = 0; i < 16; ++i) D[i] = *(const u32x4*)(vb + (size_t)PEER_EID(V0, V1, i) * DM); }
    for (int rr = 0; rr < spg; ++rr) {
        const int s = x + ngr * rr;
        const unsigned char* vb = VB + s * SLW + k * 16;
        float* ob = out + s * SLW + k * 16 + 2 * g;
        u32x4 dA[16], dB[16], idA0, idA1, idB0, idB1; f32x4 aA0, aA1, aA2, aA3, aB0, aB1, aB2, aB3;
        UD_IDS(0, idA0, idA1) VA_A(0, aA0, aA1, aA2, aA3) UD_ROWS(dA, idA0, idA1)
        UD_IDS(1, idB0, idB1) VA_A(1, aB0, aB1, aB2, aB3)
        for (int j = 0; j < ntw; j += 2) {
            UD_ROWS(dB, idB0, idB1)
            UD_IDS(j + 2, idA0, idA1)
            vacc_compute(dA, aA0, aA1, aA2, aA3, ob + UD_T(j) * DM, g, true);
            VA_A(j + 2, aA0, aA1, aA2, aA3)
            UD_ROWS(dA, idA0, idA1)
            UD_IDS(j + 3, idB0, idB1)
            vacc_compute(dB, aB0, aB1, aB2, aB3, ob + UD_T(j + 1) * DM, g, j + 1 < ntw);
            VA_A(j + 3, aB0, aB1, aB2, aB3)
        }
    }
#undef UD_T
#undef UD_IDS
#undef VA_A
#undef UD_ROWS
}
}

__device__ __forceinline__ void pool_unit(const Frame& F, bf16_t* MIX, const bf16_t* PWt, const float* pool_s, int tm, int g) {
    const int lane = F.lane, r = lane & 31, hi = lane >> 5;
    bf16_t* base = MIX + (size_t)(tm * 256 + F.wave * 32) * DM + 1024 + 128 * g;
    bf16x8 A[8];
#pragma unroll
    for (int ks = 0; ks < 8; ++ks) A[ks] = *(const bf16x8*)(base + (size_t)r * DM + ks * 16 + 8 * hi);
#pragma unroll
    for (int ct = 0; ct < 4; ++ct) {
        f32x16 acc = f32x16{};
        const bf16_t* pb = PWt + (size_t)(g * 128 + ct * 32 + r) * 128 + 8 * hi;
#pragma unroll
        for (int ks = 0; ks < 8; ++ks) { const bf16x8 B = *(const bf16x8*)(pb + ks * 16); acc = __builtin_amdgcn_mfma_f32_32x32x16_bf16(A[ks], B, acc, 0, 0, 0); }
        const float sc = pool_s[128 * g + ct * 32 + r];
#pragma unroll
        for (int i = 0; i < 16; ++i) { const int row = (i & 3) + 8 * (i >> 2) + 4 * hi; base[(size_t)row * DM + ct * 32 + r] = (bf16_t)(cvtpk(acc[i] * sc, 0.f) & 0xffffu); }
    }
}

__global__ void __launch_bounds__(NWAVES * 64, 2) fwd_kernel(Args args) {
    extern __shared__ __attribute__((aligned(16))) unsigned char lds[];
    Frame F;
    F.lds = (LAS unsigned char*)lds; F.ldsg = (char*)lds;
    F.tid = threadIdx.x; F.lane = F.tid & 63; F.wave = __builtin_amdgcn_readfirstlane(F.tid >> 6);
    F.G = gridDim.x; { const int bx = blockIdx.x; F.vcu = (F.G % 8 == 0) ? (bx % 8) * (F.G / 8) + bx / 8 : bx; }
    unsigned char* ws = args.ws;
    unsigned* ctl = (unsigned*)(ws + WS_CTL);
    volatile LAS unsigned* MISC = (volatile LAS unsigned*)(F.lds + MISC_OFF);
    for (int u = F.tid; u < (LDS_BYTES - LDSCTL_OFF) / 4; u += NWAVES * 64) ((LAS unsigned*)(F.lds + LDSCTL_OFF))[u] = 0u;
    __syncthreads();
    const int lo = args.ph_lo, hi = args.ph_hi;
    XcdBarrier bar; bar.bar = ctl + CW_BAR; bar.x = 0; bar.st = nullptr;
    if (hi - lo > 1) bar = xcd_barrier_post(ctl + CW_BAR, MISC + 8);
#define IN(k) (lo <= (k) && (k) < hi)
#define PHASE_BEGIN() do { int t_ = (int)threadIdx.x; asm volatile("" : "+v"(t_)); F.tid = t_; F.lane = t_ & 63; } while (0)
#define SEAM(k) do { if (IN(k) && IN((k) + 1)) xcd_barrier(bar); } while (0)

    bf16_t* Z = (bf16_t*)(ws + WS_Z); bf16_t* XN = (bf16_t*)(ws + WS_XN); bf16_t* MIX = XN;
    bf16_t* HN = (bf16_t*)(ws + WS_Z); bf16_t* PQ = (bf16_t*)(ws + WS_Z + 128 * MiB);
    bf16_t* KVM = (bf16_t*)(ws + WS_KVM); unsigned* MASK = (unsigned*)(ws + WS_MASK);

    if (IN(0)) { PHASE_BEGIN(); p0_prologue(F, args); } SEAM(0);
    if (IN(1)) { PHASE_BEGIN();
        { pg8::Gemm g{XN, (const bf16_t*)(ws + WS_BT_IN), NTOK, ZLD, DM}; pg8::StaticOrder S; S.init(NTOK, ZLD, F.G, (int)blockIdx.x);
          pg8::EpiBf16 E{Z, ZLD}; pg8::gemm_phase<pg8::EpiBf16, pg8::StaticOrder, true, true>(F.lds, g, S, E); }
        { pg8::Gemm g{(const bf16_t*)(ws + WS_MN), (const bf16_t*)(ws + WS_BT_KV), BATCH * MEMLEN, 1024, DM}; pg8::StaticOrder S; S.init(BATCH * MEMLEN, 1024, F.G, (int)((blockIdx.x + 128) % F.G));
          pg8::EpiBf16 E{KVM, 1024}; pg8::gemm_phase<pg8::EpiBf16, pg8::StaticOrder, true, true>(F.lds, g, S, E); }
    } SEAM(1);
    if (IN(2)) { PHASE_BEGIN(); p2_post(F, args); } SEAM(2);
    if (IN(3)) { PHASE_BEGIN();
        for (int i = 0; ; ++i) {
            int b, c;
            if (F.G == 256) { if (i >= 2) break; b = F.vcu >> 7; c = (i == 0) ? 255 - (F.vcu & 127) : (F.vcu & 127); }
            else { const int u = (int)blockIdx.x + i * F.G; if (u >= 512) break; b = u >> 8; c = u & 255; }
            ix::unit(F, Z, MASK, (unsigned long long*)(ws + WS_CAND) + (size_t)blockIdx.x * 64 * ix::CAPB, ctl + 2048, b, c);
            __syncthreads();
        }
    } SEAM(3);
    if (IN(4)) { PHASE_BEGIN();
        for (int u = F.vcu; u < (NTOK / 256) * 4; u += F.G) pool_unit(F, MIX, (const bf16_t*)(ws + WS_PWT), args.pool_s, u >> 2, u & 3);
        const int r32 = F.lane & 31;
        for (int i = 0; ; ++i) {
            int b, h, qb;
            if (F.G == 256) { if (i >= 4) break; const int bh = F.vcu >> 4, s = F.vcu & 15; b = bh >> 3; h = bh & 7; qb = (i == 0) ? 63 - s : (i == 1) ? 32 + s : (i == 2) ? 31 - s : s; }
            else { const int u = (int)blockIdx.x + i * F.G; if (u >= 1024) break; b = u >> 9; h = (u >> 6) & 7; qb = u & 63; }
            const size_t row0 = (size_t)b * SEQ + 256 * qb;
            const unsigned long long* mrow = (const unsigned long long*)MASK + (row0 + F.wave * 32 + r32) * (MASK_WPR / 2);
            att::attn_body<true, 2, ZLD, ZLD, DM>(Z + row0 * ZLD + ZC_Q + h * 128, Z + (size_t)b * SEQ * ZLD + ZC_K + h * 128, Z + (size_t)b * SEQ * ZLD + ZC_V + h * 128,
                                                  MIX + row0 * DM + h * 128, 256 * (qb + 1), mrow, F.ldsg);
        }
        for (int id = F.vcu; id < 512; id += F.G) {
            const int b2 = id >> 8, hm = (id >> 6) & 3, qb = id & 63; const size_t row0 = (size_t)b2 * SEQ + 256 * qb;
            att::attn_body<false, 1, ZLD, 1024, DM>(Z + row0 * ZLD + ZC_QM + hm * 128, KVM + (size_t)b2 * MEMLEN * 1024 + hm * 128, KVM + (size_t)b2 * MEMLEN * 1024 + 512 + hm * 128,
                                                    MIX + row0 * DM + 1536 + hm * 128, MEMLEN, nullptr, F.ldsg);
        }
    } SEAM(4);
    if (IN(5)) { PHASE_BEGIN();
#if ATT_VERIFY
        {
            const int t = (int)blockIdx.x * 128 + 77, hh = F.wave, ln = F.lane; const int bb = t / SEQ, pos = t % SEQ, N = 64 * (pos / 64 + 1);
            const bf16_t* zq = Z + (size_t)t * ZLD + ZC_Q + hh * 128 + 2 * ln; const float q0 = bflo((unsigned)zq[0]), q1 = bflo((unsigned)zq[1]);
            float m = -3.0e38f, l = 0.f, o0 = 0.f, o1 = 0.f; int nsel = 0;
            for (int w = 0; w < N / 32; ++w) { unsigned bits = __hip_atomic_load(MASK + (size_t)t * MASK_WPR + w, __ATOMIC_RELAXED, __HIP_MEMORY_SCOPE_AGENT);
                while (bits) { const int bpos = __builtin_ctz(bits); bits &= bits - 1u; const int sidx = 32 * w + bpos; ++nsel;
                    const bf16_t* zk = Z + ((size_t)bb * SEQ + sidx) * ZLD + ZC_K + hh * 128 + 2 * ln; const bf16_t* zv = Z + ((size_t)bb * SEQ + sidx) * ZLD + ZC_V + hh * 128 + 2 * ln;
                    const float lg = wave_sum(q0 * bflo((unsigned)zk[0]) + q1 * bflo((unsigned)zk[1])) * 0.088388347648318440f;
                    const float mn = fmaxf(m, lg), al = __expf(m - mn), pe = __expf(lg - mn); l = l * al + pe; o0 = o0 * al + pe * bflo((unsigned)zv[0]); o1 = o1 * al + pe * bflo((unsigned)zv[1]); m = mn; } }
            const bf16_t* mx = MIX + (size_t)t * DM + hh * 128 + 2 * ln; const float r0 = o0 / l, r1 = o1 / l;
            float er = fmaxf(fabsf(r0 - bflo((unsigned)mx[0])), fabsf(r1 - bflo((unsigned)mx[1]))), sc = fmaxf(fabsf(r0), fabsf(r1));
#pragma unroll
            for (int o = 1; o < 64; o <<= 1) { er = fmaxf(er, __shfl_xor(er, o)); sc = fmaxf(sc, __shfl_xor(sc, o)); }
            if (!(er <= 0.03f * sc + 1e-3f) || nsel != (N < 256 ? N : 256)) { if (ln == 0) atomicOr(ctl + 2048, 2u); }
        }
        __syncthreads();
#endif
        pg8::Gemm g{MIX, (const bf16_t*)(ws + WS_BT_OUT), NTOK, DM, DM}; pg8::StaticOrder S; S.init(NTOK, DM, F.G, (int)blockIdx.x);
        pg8::EpiF32Res E{args.x, args.out, DM}; pg8::gemm_phase<pg8::EpiF32Res, pg8::StaticOrder, true, true>(F.lds, g, S, E);
    } SEAM(5);
    if (IN(6)) { PHASE_BEGIN(); const int gw = F.vcu * NWAVES + F.wave, NGW = F.G * NWAVES;
        for (int m = gw; m < NTOK; m += NGW) rms_row_to_bf16(args.out + (size_t)m * DM, args.ffn_g, HN + (size_t)m * DM, F.lane);
    } SEAM(6);
    if (IN(7)) { PHASE_BEGIN();
        pg8::Gemm g{HN, (const bf16_t*)(ws + WS_BT_Q), NTOK, DM, DM}; pg8::StaticOrder S; S.init(NTOK, DM, F.G, (int)blockIdx.x);
        pg8::EpiBf16 E{PQ, DM}; pg8::gemm_phase<pg8::EpiBf16, pg8::StaticOrder, true, true>(F.lds, g, S, E);
    } SEAM(7);
    unsigned short* E16 = (unsigned short*)(ws + WS_XN); float* GT = (float*)(ws + WS_XN + 8 * MiB); float* AT = (float*)(ws + WS_XN + 24 * MiB);
    float* PART = (float*)(ws + WS_Z + 128 * MiB);
    if (IN(8)) { PHASE_BEGIN();
        const bf16_t* PKb = (const bf16_t*)(ws + WS_PK);
        bf16x8 Bf[2][8];
        { const int half = F.wave & 1, cp = (F.wave >> 1) & 1, r = F.lane & 31, hi = F.lane >> 5;
#pragma unroll
          for (int c2 = 0; c2 < 2; ++c2)
#pragma unroll
              for (int ks = 0; ks < 8; ++ks) Bf[c2][ks] = *(const bf16x8*)(PKb + (size_t)(half * 128 + (2 * cp + c2) * 32 + r) * 128 + 8 * hi + ks * 16); }
        const peer::TabCvt T{args.pu, args.pv, ws + WS_UB, ws + WS_VB, (float*)(ws + WS_RSU), (float*)(ws + WS_RSV)};
        const int gw = F.vcu * NWAVES + F.wave, NGW = F.G * NWAVES; int mrow = gw, nstep = 0;
        for (int it = F.vcu; it < NTOK / peer::TT; it += F.G, ++nstep) {
            const int m0 = mrow < 2 * NEXP ? mrow : -1; mrow += NGW; const int m1 = mrow < 2 * NEXP ? mrow : -1; mrow += NGW;
            peer::route_step(F, PQ, Bf, E16, GT, it * peer::TT, T, m0, m1);
        }
        for (; mrow < 2 * NEXP; mrow += NGW) { RowF32 R; row_load(R, peer::tab_src(T, mrow), F.lane); peer::tab_finish(T, R, mrow, F.lane); }
    } SEAM(8);
    if (IN(9)) { PHASE_BEGIN(); peer::udots(F, HN, ws + WS_UB, E16, PART); } SEAM(9);
    if (IN(10)) { PHASE_BEGIN(); peer::combine(F, PART, E16, GT, (const float*)(ws + WS_RSU), (const float*)(ws + WS_RSV), AT); } SEAM(10);
    if (IN(11)) { PHASE_BEGIN(); peer::vacc(F, ws + WS_VB, E16, AT, args.out); }
#if IX_VERIFY || ATT_VERIFY
    if (IN(11)) { __syncthreads(); if (__hip_atomic_load(ctl + 2048, __ATOMIC_RELAXED, __HIP_MEMORY_SCOPE_AGENT) != 0u) { args.out[(size_t)blockIdx.x * 512 + threadIdx.x] = __builtin_nanf(""); } }
#endif
#undef IN
#undef SEAM
}

extern "C" void kernel_launch(void* const* d_in, const int* in_sizes, int n_in, void* d_out, int out_size, void* d_ws, size_t ws_size, hipStream_t stream) {
    static int grid = 0;
    if (grid == 0) {
        if (n_in != 19 || out_size != NTOK * DM || ws_size < WS_END) { fprintf(stderr, "kernel_launch: unexpected shapes (n_in %d out %d ws %zu)\n", n_in, out_size, ws_size); grid = -1; return; }
        int dev = 0, cus = 0;
        if (hipGetDevice(&dev) != hipSuccess || hipDeviceGetAttribute(&cus, hipDeviceAttributeMultiprocessorCount, dev) != hipSuccess) { grid = -1; return; }
        if (hipFuncSetAttribute((const void*)fwd_kernel, hipFuncAttributeMaxDynamicSharedMemorySize, LDS_BYTES) != hipSuccess) { fprintf(stderr, "kernel_launch: hipFuncSetAttribute failed\n"); grid = -1; return; }
        (void)hipGetLastError();
        grid = cus;
    }
    if (grid < 0) return;
    (void)hipMemsetAsync((char*)d_ws + WS_CTL, 0, CTL_ZERO_BYTES, stream);
    Args a{};
    a.x = (const float*)d_in[0]; a.mem = (const float*)d_in[1]; a.attn_g = (const float*)d_in[2]; a.w_in = (const float*)d_in[3]; a.q_g = (const float*)d_in[4]; a.k_g = (const float*)d_in[5];
    a.pool_w = (const float*)d_in[6]; a.pool_s = (const float*)d_in[7]; a.mem_g = (const float*)d_in[8]; a.w_kv = (const float*)d_in[9]; a.mq_g = (const float*)d_in[10]; a.mk_g = (const float*)d_in[11];
    a.w_out = (const float*)d_in[12]; a.ffn_g = (const float*)d_in[13]; a.w_q = (const float*)d_in[14]; a.sk1 = (const float*)d_in[15]; a.sk2 = (const float*)d_in[16];
    a.pu = (const float*)d_in[17]; a.pv = (const float*)d_in[18]; a.out = (float*)d_out; a.ws = (unsigned char*)d_ws;
#if MK_ONE_LAUNCH
    a.ph_lo = 0; a.ph_hi = N_PHASES;
    hipLaunchKernelGGL(fwd_kernel, dim3(grid), dim3(NWAVES * 64), LDS_BYTES, stream, a);
#else
    for (int p = 0; p < N_PHASES; ++p) { a.ph_lo = p; a.ph_hi = p + 1; hipLaunchKernelGGL(fwd_kernel, dim3(grid), dim3(NWAVES * 64), LDS_BYTES, stream, a); }
#endif
}
```

```cpp
#include <hip/hip_runtime.h>
#include <hip/hip_bf16.h>
#include <cstdio>
#include <cstdint>

#ifndef IX_VERIFY
#define IX_VERIFY 0
#endif
#ifndef ATT_VERIFY
#define ATT_VERIFY 0
#endif
#ifndef MK_ONE_LAUNCH
#define MK_ONE_LAUNCH 1
#endif

#define GAS __attribute__((address_space(1)))
#define LAS __attribute__((address_space(3)))
typedef unsigned short bf16_t;
typedef short bf16x8 __attribute__((ext_vector_type(8)));
typedef short s16x4 __attribute__((ext_vector_type(4)));
typedef float f32x4 __attribute__((ext_vector_type(4)));
typedef float f32x2 __attribute__((ext_vector_type(2)));
typedef float f32x16 __attribute__((ext_vector_type(16)));
typedef unsigned u32x4 __attribute__((ext_vector_type(4)));
typedef unsigned u32x2 __attribute__((ext_vector_type(2)));
typedef __bf16 bf16x2_t __attribute__((ext_vector_type(2)));

constexpr int BATCH = 2, SEQ = 16384, DM = 2048, NTOK = BATCH * SEQ, MEMLEN = 256;
constexpr int IN_W = 5200, ZLD = 5376;
constexpr int ZC_Q = 0, ZC_K = 1024, ZC_V = 2048, ZC_QI = 3072, ZC_PU = 4096, ZC_QM = 4608, ZC_KI = 5120, ZC_WI = 5184;
constexpr int NEXP = 16384;
constexpr float EPS = 1e-6f;
constexpr int MASK_WPR = 512;

constexpr size_t MiB = 1u << 20;
constexpr size_t WS_CTL = 0, CTL_ZERO_BYTES = 1 * MiB;
constexpr size_t WS_BT_IN = 2 * MiB;
constexpr size_t WS_BT_OUT = 24 * MiB;
constexpr size_t WS_BT_Q = 32 * MiB;
constexpr size_t WS_BT_KV = 40 * MiB;
constexpr size_t WS_MN = 44 * MiB;
constexpr size_t WS_KVM = 46 * MiB;
constexpr size_t WS_PK = 47 * MiB;
constexpr size_t WS_PWT = 47 * MiB + 512 * 1024;
constexpr size_t WS_XN = 48 * MiB;
constexpr size_t WS_Z = 176 * MiB;
constexpr size_t WS_MASK = 512 * MiB;
constexpr size_t WS_UB = 576 * MiB;
constexpr size_t WS_VB = 640 * MiB;
constexpr size_t WS_RSU = 47 * MiB + 128 * 1024, WS_RSV = 47 * MiB + 256 * 1024;
constexpr size_t WS_ROPE = 704 * MiB;
constexpr size_t WS_CAND = 720 * MiB;
constexpr size_t WS_END = 848 * MiB;
constexpr int CW_BAR = 4096;

#define LDS_WAIT() asm volatile("s_waitcnt lgkmcnt(0)" ::: "memory")
#define VM_WAIT() asm volatile("s_waitcnt vmcnt(0)" ::: "memory")
__device__ __forceinline__ unsigned cvtpk(float lo, float hi) { f32x2 v = {lo, hi}; bf16x2_t b = __builtin_convertvector(v, bf16x2_t); return __builtin_bit_cast(unsigned, b); }
__device__ __forceinline__ float bflo(unsigned w) { return __uint_as_float(w << 16); }
__device__ __forceinline__ float bfhi(unsigned w) { return __uint_as_float(w & 0xffff0000u); }
__device__ __forceinline__ float wave_sum(float v) {
#pragma unroll
    for (int o = 1; o < 64; o <<= 1) v += __shfl_xor(v, o);
    return v;
}
__device__ __forceinline__ unsigned f2ord(float s) { unsigned u = __float_as_uint(s); return u ^ (((unsigned)((int)u >> 31)) | 0x80000000u); }

namespace pg8 {
#define PG8_LAS __attribute__((address_space(3)))
constexpr int BM = 256, BK = 64, HALF = 128, HTB = HALF * BK * 2, STAGE_BYTES = 8 * HTB, NXCD = 8, WGM = 8;
__host__ __device__ __forceinline__ int lds_byte(int r, int c) { const int st = (r >> 4) * 2 + (c >> 5), rr = r & 15, cc = c & 31, ob = rr * 64 + cc * 2; return st * 1024 + (ob ^ (((ob >> 9) & 1) << 5)); }
__host__ __device__ __forceinline__ void stage_rc(int b, int& R, int& C) { const int st = b / 1024, sb = b % 1024, swz = sb ^ (((sb >> 9) & 1) << 5); R = (st >> 1) * 16 + swz / 64; C = (st & 1) * 32 + (swz % 64) / 2; }
__host__ __device__ __forceinline__ int perm32(int rho) { const int n = rho >> 4, i = rho & 15; return 8 * (i >> 2) + 4 * n + (i & 3); }
struct Unit { int pm, pn; };
struct Gemm { const bf16_t* A; const bf16_t* Bt; int M, N, K; };
struct StaticOrder {
    int nM, nN, nwg, G, c;
    __host__ __device__ void init(int M, int N, int G_, int c_) { nM = M / BM; nN = N / BM; nwg = nM * nN; G = G_; c = c_; }
    __host__ __device__ bool next(int i, Unit& u) const {
        const long L = (long)i * G + c; if (L >= nwg) return false;
        int wgid = (int)L; { const int q = nwg / NXCD, r = nwg % NXCD, xcd = wgid % NXCD, off = wgid / NXCD; wgid = (xcd < r ? xcd * (q + 1) : r * (q + 1) + (xcd - r) * q) + off; }
        const int nig = WGM * nN, gid = wgid / nig, fm = gid * WGM, gsz = (nM - fm) < WGM ? (nM - fm) : WGM;
        u.pm = fm + ((wgid % nig) % gsz); u.pn = (wgid % nig) / gsz; return true;
    }
    __device__ __forceinline__ void a_ready(const Unit&) const {}
    __device__ __forceinline__ void done(const Unit&) const {}
};
struct EpiBf16 {
    static constexpr bool PERM = true, AFTER_DRAIN = false;
    bf16_t* O; int ldc;
    __device__ __forceinline__ void operator()(const f32x4 (&acc)[2][2][4][2], const Unit& u, int wr, int wc, int fr, int fq) const {
        const int row0 = u.pm * BM + wr * 64 + fr; const int col0 = u.pn * BM + wc * 32 + 8 * fq;
#pragma unroll
        for (int ai = 0; ai < 2; ++ai)
#pragma unroll
            for (int m = 0; m < 4; ++m) { bf16_t* rowp = O + (size_t)(row0 + ai * HALF + m * 16) * ldc + col0;
#pragma unroll
                for (int bj = 0; bj < 2; ++bj) { const f32x4 v0 = acc[ai][bj][m][0], v1 = acc[ai][bj][m][1];
                    u32x4 w; w.x = cvtpk(v0[0], v0[1]); w.y = cvtpk(v0[2], v0[3]); w.z = cvtpk(v1[0], v1[1]); w.w = cvtpk(v1[2], v1[3]);
                    *(u32x4*)(rowp + bj * HALF) = w; } }
    }
};
struct EpiF32Res {
    static constexpr bool PERM = false, AFTER_DRAIN = false;
    const float* R; float* C; int ldc;
    __device__ __forceinline__ void operator()(const f32x4 (&acc)[2][2][4][2], const Unit& u, int wr, int wc, int fr, int fq) const {
        const int row0 = u.pm * BM + wr * 64 + fr, col0 = u.pn * BM + wc * 32 + 4 * fq;
#pragma unroll
        for (int ai = 0; ai < 2; ++ai)
#pragma unroll
            for (int m = 0; m < 4; ++m) { const size_t off = (size_t)(row0 + ai * HALF + m * 16) * ldc + col0;
#pragma unroll
                for (int bj = 0; bj < 2; ++bj)
#pragma unroll
                    for (int n = 0; n < 2; ++n) *(f32x4*)(C + off + bj * HALF + n * 16) = acc[ai][bj][m][n] + *(const f32x4*)(R + off + bj * HALF + n * 16); }
    }
};

template <class Epi, class Sched, bool ALIGN_EPI = false, bool SP2 = false>
__device__ __forceinline__ void gemm_phase(PG8_LAS unsigned char* lds, const Gemm g, const Sched& S, const Epi& E) {
    const int tid = threadIdx.x, wid = __builtin_amdgcn_readfirstlane(tid >> 6), lane = tid & 63, wr = wid >> 2, wc = wid & 3, fr = lane & 15, fq = lane >> 4;
    const int K = g.K, nt = K / BK;
    unsigned voffA[2], voffB[2];
#pragma unroll
    for (int i = 0; i < 2; ++i) { int R, C; stage_rc(tid * 16 + i * 8192, R, C); const int Rb = Epi::PERM ? ((R & ~31) + perm32(R & 31)) : R;
        voffA[i] = (unsigned)(R * K + C) * 2u; voffB[i] = (unsigned)(Rb * K + C) * 2u; }
    const size_t kstep = (size_t)(BK * 2);
    const size_t hstep = (size_t)HALF * K * 2;
    const size_t tstep = 2 * hstep;
    const unsigned ldsw = (unsigned)wid * 1024u;
    const int aoff = lds_byte(wr * 64 + fr, fq * 8), boff = lds_byte(wc * 32 + fr, fq * 8);
#define PG8_SA(b, h) (((b) * 2 + (h)) * HTB)
#define PG8_SB(b, h) ((4 + (b) * 2 + (h)) * HTB)
#define PG8_STAGE(bufoff, gbase, voff) do { _Pragma("unroll") for (int _i = 0; _i < 2; ++_i) \
        __builtin_amdgcn_global_load_lds((const unsigned*)((const char*)(gbase) + (voff)[_i]), (PG8_LAS unsigned*)(lds + (bufoff) + ldsw + _i * 8192), 16, 0, 0); } while (0)
#define PG8_LDA(dst, b, h) do { _Pragma("unroll") for (int m = 0; m < 4; ++m) _Pragma("unroll") for (int k = 0; k < 2; ++k) dst[m][k] = *(const PG8_LAS bf16x8*)(lds + PG8_SA(b, h) + aoff + m * 2048 + k * 1024); } while (0)
#define PG8_LDB(dst, b, h) do { _Pragma("unroll") for (int n = 0; n < 2; ++n) _Pragma("unroll") for (int k = 0; k < 2; ++k) dst[n][k] = *(const PG8_LAS bf16x8*)(lds + PG8_SB(b, h) + boff + n * 2048 + k * 1024); } while (0)
#define PG8_MMA(ai, bj, At, Bt) do { __builtin_amdgcn_s_setprio(1); _Pragma("unroll") for (int m = 0; m < 4; ++m) _Pragma("unroll") for (int n = 0; n < 2; ++n) _Pragma("unroll") for (int k = 0; k < 2; ++k) \
        acc[ai][bj][m][n] = __builtin_amdgcn_mfma_f32_16x16x32_bf16(Bt[n][k], At[m][k], acc[ai][bj][m][n], 0, 0, 0); __builtin_amdgcn_s_setprio(0); } while (0)
#define PG8_WAIT_V(n) asm volatile("s_waitcnt vmcnt(" #n ")" ::: "memory")
#define PG8_WAIT_L(n) asm volatile("s_waitcnt lgkmcnt(" #n ")" ::: "memory")
#define PG8_BAR __builtin_amdgcn_s_barrier()
#define PG8_SCHED __builtin_amdgcn_sched_barrier(0)
    Unit cur, nxt; int ui = 0;
    if (!S.next(0, cur)) return;
    f32x4 acc[2][2][4][2];
#pragma unroll
    for (int a = 0; a < 2; ++a)
#pragma unroll
        for (int b = 0; b < 2; ++b)
#pragma unroll
            for (int m = 0; m < 4; ++m)
#pragma unroll
                for (int n = 0; n < 2; ++n) acc[a][b][m][n] = (f32x4){0.f, 0.f, 0.f, 0.f};
    bf16x8 At[4][2], B0[2][2], B1[2][2];
    const char* cA = (const char*)g.A + (size_t)cur.pm * tstep; const char* cB = (const char*)g.Bt + (size_t)cur.pn * tstep;
    S.a_ready(cur);
    if constexpr (SP2) {
        PG8_STAGE(PG8_SB(0, 0), cB, voffB); PG8_STAGE(PG8_SB(0, 1), cB + hstep, voffB); PG8_STAGE(PG8_SA(0, 0), cA, voffA); PG8_STAGE(PG8_SA(0, 1), cA + hstep, voffA);
        if (wr == 1) PG8_BAR;
        PG8_WAIT_V(2); PG8_BAR;
        PG8_STAGE(PG8_SB(1, 0), cB + kstep, voffB); PG8_STAGE(PG8_SA(1, 0), cA + kstep, voffA); PG8_STAGE(PG8_SB(1, 1), cB + hstep + kstep, voffB);
        PG8_WAIT_V(6); PG8_BAR;
    } else {
        PG8_STAGE(PG8_SB(0, 0), cB, voffB); PG8_STAGE(PG8_SA(0, 0), cA, voffA); PG8_STAGE(PG8_SB(0, 1), cB + hstep, voffB); PG8_STAGE(PG8_SA(0, 1), cA + hstep, voffA);
        if (wr == 1) PG8_BAR;
        PG8_WAIT_V(4); PG8_BAR;
        PG8_STAGE(PG8_SB(1, 0), cB + kstep, voffB); PG8_STAGE(PG8_SA(1, 0), cA + kstep, voffA); PG8_STAGE(PG8_SB(1, 1), cB + hstep + kstep, voffB);
        PG8_WAIT_V(6); PG8_BAR;
    }
    for (;;) {
        const bool has_next = S.next(ui + 1, nxt);
        const char* nA = has_next ? (const char*)g.A + (size_t)nxt.pm * tstep : cA; const char* nB = has_next ? (const char*)g.Bt + (size_t)nxt.pn * tstep : cB;
        for (int t = 0; t < nt; t += 2) {
            const bool last = (t == nt - 2);
            const char* a1 = cA + (size_t)(t + 1) * kstep;
            const char* a2 = last ? nA : cA + (size_t)(t + 2) * kstep; const char* b2 = last ? nB : cB + (size_t)(t + 2) * kstep;
            const char* a3 = a2 + kstep; const char* b3 = b2 + kstep;
            if (last && has_next) S.a_ready(nxt);
            if constexpr (SP2) {
            PG8_LDB(B0, 0, 0); PG8_LDB(B1, 0, 1); PG8_SCHED; PG8_LDA(At, 0, 0); PG8_STAGE(PG8_SA(1, 1), a1 + hstep, voffA);
            PG8_WAIT_V(8); PG8_WAIT_L(0); PG8_BAR; PG8_MMA(0, 0, At, B0); PG8_MMA(0, 1, At, B1); PG8_BAR; PG8_SCHED;
            PG8_LDA(At, 0, 1); PG8_STAGE(PG8_SB(0, 0), b2, voffB); PG8_STAGE(PG8_SB(0, 1), b2 + hstep, voffB); PG8_STAGE(PG8_SA(0, 0), a2, voffA);
            PG8_WAIT_V(8); PG8_WAIT_L(0); PG8_BAR; PG8_MMA(1, 0, At, B0); PG8_MMA(1, 1, At, B1); PG8_BAR; PG8_SCHED;
            PG8_LDB(B0, 1, 0); PG8_LDB(B1, 1, 1); PG8_SCHED; PG8_LDA(At, 1, 0); PG8_STAGE(PG8_SA(0, 1), a2 + hstep, voffA);
            PG8_WAIT_V(8); PG8_WAIT_L(0); PG8_BAR; PG8_MMA(0, 0, At, B0); PG8_MMA(0, 1, At, B1); PG8_BAR; PG8_SCHED;
            PG8_LDA(At, 1, 1); PG8_STAGE(PG8_SB(1, 0), b3, voffB); PG8_STAGE(PG8_SB(1, 1), b3 + hstep, voffB); PG8_STAGE(PG8_SA(1, 0), a3, voffA);
            PG8_WAIT_V(8); PG8_WAIT_L(0); PG8_BAR; PG8_MMA(1, 0, At, B0); PG8_MMA(1, 1, At, B1); PG8_BAR; PG8_SCHED;
            } else {
            PG8_LDB(B0, 0, 0); PG8_SCHED; PG8_LDA(At, 0, 0); PG8_STAGE(PG8_SA(1, 1), a1 + hstep, voffA);
            PG8_WAIT_L(8); PG8_BAR; PG8_WAIT_L(0); PG8_MMA(0, 0, At, B0); PG8_BAR; PG8_SCHED;
            PG8_LDB(B1, 0, 1); PG8_STAGE(PG8_SB(0, 0), b2, voffB);
            PG8_BAR; PG8_WAIT_L(0); PG8_MMA(0, 1, At, B1); PG8_BAR;
            PG8_LDA(At, 0, 1); PG8_STAGE(PG8_SA(0, 0), a2, voffA);
            PG8_BAR; PG8_WAIT_L(0); PG8_MMA(1, 0, At, B0); PG8_BAR; PG8_SCHED;
            PG8_STAGE(PG8_SB(0, 1), b2 + hstep, voffB);
            PG8_WAIT_V(6); PG8_BAR; PG8_MMA(1, 1, At, B1); PG8_BAR;
            PG8_LDB(B0, 1, 0); PG8_SCHED; PG8_LDA(At, 1, 0); PG8_STAGE(PG8_SA(0, 1), a2 + hstep, voffA);
            PG8_WAIT_L(8); PG8_BAR; PG8_WAIT_L(0); PG8_MMA(0, 0, At, B0); PG8_BAR; PG8_SCHED;
            PG8_LDB(B1, 1, 1); PG8_STAGE(PG8_SB(1, 0), b3, voffB);
            PG8_BAR; PG8_WAIT_L(0); PG8_MMA(0, 1, At, B1); PG8_BAR;
            PG8_LDA(At, 1, 1); PG8_STAGE(PG8_SA(1, 0), a3, voffA);
            PG8_BAR; PG8_WAIT_L(0); PG8_MMA(1, 0, At, B0); PG8_BAR; PG8_SCHED;
            PG8_STAGE(PG8_SB(1, 1), b3 + hstep, voffB);
            PG8_WAIT_V(6); PG8_BAR; PG8_MMA(1, 1, At, B1); PG8_BAR;
            }
        }
        if constexpr (ALIGN_EPI) { if (wr == 0) PG8_BAR; }
        if constexpr (!Epi::AFTER_DRAIN) { E(acc, cur, wr, wc, fr, fq); S.done(cur); }
        if (!has_next) break;
#pragma unroll
        for (int a = 0; a < 2; ++a)
#pragma unroll
            for (int b = 0; b < 2; ++b)
#pragma unroll
                for (int m = 0; m < 4; ++m)
#pragma unroll
                    for (int n = 0; n < 2; ++n) acc[a][b][m][n] = (f32x4){0.f, 0.f, 0.f, 0.f};
        cur = nxt; cA = nA; cB = nB; ++ui;
        if constexpr (ALIGN_EPI) { if (wr == 1) PG8_BAR; }
    }
    PG8_WAIT_V(0);
    if constexpr (!ALIGN_EPI) { if (wr == 0) PG8_BAR; }
    PG8_BAR;
#undef PG8_SA
#undef PG8_SB
#undef PG8_STAGE
#undef PG8_LDA
#undef PG8_LDB
#undef PG8_MMA
#undef PG8_WAIT_V
#undef PG8_WAIT_L
#undef PG8_BAR
#undef PG8_SCHED
}
}

namespace att {
constexpr int D = 128, NW = 8, QBLK = 32, KVBLK = 64;
constexpr float SCALE = 0.088388347648318440f;
constexpr float THR = 8.f;
constexpr size_t SHM_V = KVBLK * D * 2, SHM_K = KVBLK * D * 2, SHM_ATTN = 2 * SHM_V + 2 * SHM_K + NW * 64 * 4;
#define KSWZ(row, colB) ((row) * 256 + ((colB) ^ (((row) & 7) << 4)))
#define SBAR() __builtin_amdgcn_sched_barrier(0)
__device__ __forceinline__ int crow(int r, int hi) { return (r & 3) + 8 * (r >> 2) + 4 * hi; }
template <bool MASKED> __device__ __forceinline__ void mask_apply(f32x16& p, unsigned w) {
    if constexpr (MASKED) {
#pragma unroll
        for (int r = 0; r < 16; ++r) { const unsigned m = (unsigned)__builtin_amdgcn_sbfe((int)w, (unsigned)((r & 3) + 8 * (r >> 2)), 1u); p[r] = __uint_as_float((__float_as_uint(p[r]) & m) | (0xFF800000u & ~m)); }
    }
}
template <bool MASKED> __device__ __forceinline__ void partialSM(f32x16& p0, f32x16& p1, float& m_reg, float& mn, float& alpha, unsigned long long mk, int sh4) {
    constexpr float C = SCALE * 1.4426950408889634f;
    float pmax = p0[0];
#pragma unroll
    for (int r = 1; r < 16; ++r) pmax = fmaxf(pmax, p0[r]);
#pragma unroll
    for (int r = 0; r < 16; ++r) pmax = fmaxf(pmax, p1[r]);
    { auto rr = __builtin_amdgcn_permlane32_swap(__float_as_uint(pmax), __float_as_uint(pmax), false, false);
      pmax = fmaxf(__uint_as_float(rr[0]), __uint_as_float(rr[1])); }
    if (__builtin_expect(__all(pmax - m_reg <= THR / SCALE), 1)) { mn = m_reg; alpha = 1.f; }
    else { mn = fmaxf(m_reg, pmax); alpha = __builtin_amdgcn_exp2f((m_reg - mn) * C); m_reg = mn; }
    const float mnC = -mn * C;
#pragma unroll
    for (int r = 0; r < 16; ++r) p0[r] = fmaf(p0[r], C, mnC);
#pragma unroll
    for (int r = 0; r < 16; ++r) p1[r] = fmaf(p1[r], C, mnC);
#pragma unroll
    for (int r = 0; r < 16; ++r) p0[r] = __builtin_amdgcn_exp2f(p0[r]);
}
template <bool MASKED> __device__ __forceinline__ void finishSM(f32x16& p0, f32x16& p1, float alpha, float& l_reg, bf16x8& pa0, bf16x8& pa1, bf16x8& pa2, bf16x8& pa3, unsigned long long mk, int sh4) {
#pragma unroll
    for (int r = 0; r < 16; ++r) p1[r] = __builtin_amdgcn_exp2f(p1[r]);
    float ps = 0;
#pragma unroll
    for (int r = 0; r < 16; ++r) ps += p0[r];
#pragma unroll
    for (int r = 0; r < 16; ++r) ps += p1[r];
    { auto rr = __builtin_amdgcn_permlane32_swap(__float_as_uint(ps), __float_as_uint(ps), false, false);
      ps = __uint_as_float(rr[0]) + __uint_as_float(rr[1]); }
    l_reg = l_reg * alpha + ps;
#define PK4(P, BASE, OUT) do { unsigned a0 = cvtpk(P[BASE + 0], P[BASE + 1]), a1 = cvtpk(P[BASE + 2], P[BASE + 3]);   \
    unsigned b0 = cvtpk(P[BASE + 4], P[BASE + 5]), b1 = cvtpk(P[BASE + 6], P[BASE + 7]);                              \
    auto r0 = __builtin_amdgcn_permlane32_swap(a0, b0, false, false); auto r1 = __builtin_amdgcn_permlane32_swap(a1, b1, false, false); \
    u32x4 w = {r0[0], r1[0], r0[1], r1[1]}; OUT = *reinterpret_cast<bf16x8*>(&w); } while (0)
    PK4(p0, 0, pa0); PK4(p0, 8, pa1); PK4(p1, 0, pa2); PK4(p1, 8, pa3);
#undef PK4
}
template <bool MASKED> __device__ __forceinline__ void qkt(f32x16& p0, f32x16& p1, const bf16_t* Ks, const bf16x8* qs, int r32, int hi, unsigned long long mk, int sh4, const char* lut) {
    if constexpr (MASKED) {
        const unsigned wl = (unsigned)mk >> sh4, wh = (unsigned)(mk >> 32) >> sh4;
#pragma unroll
        for (int g = 0; g < 4; ++g) { const f32x4 b0 = *(const f32x4*)(lut + ((wl >> (8 * g)) & 15u) * 16), b1 = *(const f32x4*)(lut + ((wh >> (8 * g)) & 15u) * 16);
            p0[4 * g] = b0.x; p0[4 * g + 1] = b0.y; p0[4 * g + 2] = b0.z; p0[4 * g + 3] = b0.w; p1[4 * g] = b1.x; p1[4 * g + 1] = b1.y; p1[4 * g + 2] = b1.z; p1[4 * g + 3] = b1.w; }
    } else { p0 = f32x16{}; p1 = f32x16{}; }
#pragma unroll
    for (int d0 = 0; d0 < 8; ++d0) { int cb = (d0 * 16 + hi * 8) * 2;
        bf16x8 b0 = *reinterpret_cast<const bf16x8*>((const char*)Ks + KSWZ(r32, cb));
        bf16x8 b1 = *reinterpret_cast<const bf16x8*>((const char*)Ks + KSWZ(32 + r32, cb));
        const bf16x8 qf = qs[d0 * 64];
        p0 = __builtin_amdgcn_mfma_f32_32x32x16_bf16(b0, qf, p0, 0, 0, 0);
        p1 = __builtin_amdgcn_mfma_f32_32x32x16_bf16(b1, qf, p1, 0, 0, 0); }
}
__device__ __forceinline__ int v_st(int k, int c) { const int kk = (k & ~0xC) | ((k & 4) << 1) | ((k & 8) >> 1); return ((kk >> 3) * 4 + (c >> 5)) * 512 + ((kk & 7) * 32 + (c & 31)) * 2; }
__device__ __forceinline__ int v_rd_base(int lane) { return ((lane & 3) << 3) | (((lane >> 2) & 3) << 6) | (((lane >> 4) & 1) << 5) | (((lane >> 5) & 1) << 8); }
constexpr int v_rd_off(int d0, int ks, int half) { return d0 * 512 + ks * 4096 + half * 2048; }
template <int OFF> __device__ __forceinline__ s16x4 tr_read(int vb) {
    s16x4 r; asm volatile("ds_read_b64_tr_b16 %0, %1 offset:%2" : "=&v"(r) : "v"(vb), "i"(OFF) : "memory"); return r;
}
template <int D0> __device__ __forceinline__ void pv_one(f32x16& od, int vb, bf16x8 pa0, bf16x8 pa1, bf16x8 pa2, bf16x8 pa3) {
    const s16x4 l0 = tr_read<v_rd_off(D0, 0, 0)>(vb), h0 = tr_read<v_rd_off(D0, 0, 1)>(vb), l1 = tr_read<v_rd_off(D0, 1, 0)>(vb), h1 = tr_read<v_rd_off(D0, 1, 1)>(vb);
    const s16x4 l2 = tr_read<v_rd_off(D0, 2, 0)>(vb), h2 = tr_read<v_rd_off(D0, 2, 1)>(vb), l3 = tr_read<v_rd_off(D0, 3, 0)>(vb), h3 = tr_read<v_rd_off(D0, 3, 1)>(vb);
    asm volatile("s_waitcnt lgkmcnt(0)" ::: "memory"); SBAR();
#define PK(L, H) (bf16x8){L[0], L[1], L[2], L[3], H[0], H[1], H[2], H[3]}
    od = __builtin_amdgcn_mfma_f32_32x32x16_bf16(pa0, PK(l0, h0), od, 0, 0, 0);
    od = __builtin_amdgcn_mfma_f32_32x32x16_bf16(pa1, PK(l1, h1), od, 0, 0, 0);
    od = __builtin_amdgcn_mfma_f32_32x32x16_bf16(pa2, PK(l2, h2), od, 0, 0, 0);
    od = __builtin_amdgcn_mfma_f32_32x32x16_bf16(pa3, PK(l3, h3), od, 0, 0, 0);
#undef PK
}
__device__ __forceinline__ void pv_d0(f32x16* o, int vb, bf16x8 pa0, bf16x8 pa1, bf16x8 pa2, bf16x8 pa3) {
    pv_one<0>(o[0], vb, pa0, pa1, pa2, pa3); pv_one<1>(o[1], vb, pa0, pa1, pa2, pa3); pv_one<2>(o[2], vb, pa0, pa1, pa2, pa3); pv_one<3>(o[3], vb, pa0, pa1, pa2, pa3);
}
template <bool MASKED, int SDEPTH, int ldq, int ldk, int ldo>
__device__ __forceinline__ void attn_body(const bf16_t* __restrict__ Qb, const bf16_t* __restrict__ Kh, const bf16_t* __restrict__ Vh,
                                          bf16_t* __restrict__ Ob, int seq, const unsigned long long* __restrict__ mrow, char* lds) {
    int tid = (int)threadIdx.x; asm volatile("" : "+v"(tid));
    const int wid = tid >> 6, lane = tid & 63, r32 = lane & 31, hi = lane >> 5, sh4 = 4 * hi;
    bf16_t* V_lds = (bf16_t*)lds; bf16_t* K_lds = (bf16_t*)(lds + 2 * SHM_V);
    float* ws = (float*)(lds + 2 * SHM_V + 2 * SHM_K) + wid * 64; float* li_l = ws; float* al_l = ws + 32;
    float m_reg = -1e30f, l_reg = 0; f32x16 o[4] = {};
    const bf16_t* Qw = Qb + (long)(wid * QBLK + r32) * ldq + hi * 8;
    bf16x8* qr = (bf16x8*)(lds + SHM_ATTN) + wid * 512 + lane;
#pragma unroll
    for (int d0 = 0; d0 < 8; ++d0) qr[d0 * 64] = *reinterpret_cast<const bf16x8*>(Qw + d0 * 16);
    const char* lut = lds + SHM_ATTN + 65536;
    if (MASKED && tid < 64) ((float*)(lds + SHM_ATTN + 65536))[tid] = ((tid >> 2) >> (tid & 3)) & 1 ? 0.f : -INFINITY;
    const int sr = tid >> 4, sc = (tid & 15) * 8, vst0 = v_st(sr, sc), vst1 = v_st(32 + sr, sc);
    const int vb0 = (int)(uintptr_t)V_lds + v_rd_base(lane);
    struct { bf16x8 vs0, vs1, ks0, ks1; } sr_[SDEPTH];
#define SLOAD(i, k0) do { sr_[i].vs0 = *reinterpret_cast<const bf16x8*>(&Vh[(long)((k0) + sr) * ldk + sc]); sr_[i].vs1 = *reinterpret_cast<const bf16x8*>(&Vh[(long)((k0) + 32 + sr) * ldk + sc]); \
    sr_[i].ks0 = *reinterpret_cast<const bf16x8*>(&Kh[(long)((k0) + sr) * ldk + sc]); sr_[i].ks1 = *reinterpret_cast<const bf16x8*>(&Kh[(long)((k0) + 32 + sr) * ldk + sc]); } while (0)
#define SWRITE(b, i) do { *(bf16x8*)((char*)V_lds + (b) * SHM_V + vst0) = sr_[i].vs0;          \
    *(bf16x8*)((char*)V_lds + (b) * SHM_V + vst1) = sr_[i].vs1; int kc = sc * 2;               \
    *(bf16x8*)((char*)K_lds + (b) * SHM_K + KSWZ(sr, kc)) = sr_[i].ks0;                       \
    *(bf16x8*)((char*)K_lds + (b) * SHM_K + KSWZ(32 + sr, kc)) = sr_[i].ks1; } while (0)
#define SWAIT() do { if constexpr (SDEPTH == 2) asm volatile("s_waitcnt vmcnt(4)" ::: "memory"); else asm volatile("s_waitcnt vmcnt(0)" ::: "memory"); } while (0)
#define RESC(a) do { if (__any((a) < 1.f)) { if (hi == 0) al_l[r32] = (a); asm volatile("s_waitcnt lgkmcnt(0)" ::: "memory"); \
    _Pragma("unroll") for (int d = 0; d < 4; ++d) _Pragma("unroll") for (int r = 0; r < 16; ++r) o[d][r] *= al_l[crow(r, hi)]; } } while (0)
    f32x16 pA0, pA1, pB0, pB1; float mnA, mnB, alA, alB; bf16x8 pa0, pa1, pa2, pa3; const int NT = seq / KVBLK;
    unsigned long long mkA = 0, mkB = 0;
    constexpr int SE = 0, SO = SDEPTH - 1;
    if constexpr (MASKED) mkA = mrow[0];
    SLOAD(SE, 0); asm volatile("s_waitcnt vmcnt(0)" ::: "memory"); SWRITE(0, SE); __syncthreads();
    qkt<MASKED>(pA0, pA1, K_lds, qr, r32, hi, mkA, sh4, lut); partialSM<MASKED>(pA0, pA1, m_reg, mnA, alA, mkA, sh4);
    if constexpr (MASKED) mkB = mrow[1];
    SLOAD(SO, KVBLK); if constexpr (SDEPTH == 2) { if (2 < NT) SLOAD(SE, 2 * KVBLK); }
    SWAIT(); SWRITE(1, SO); __syncthreads();
    for (int j = 1; j + 1 < NT; j += 2) {
        SBAR(); qkt<MASKED>(pB0, pB1, (bf16_t*)((char*)K_lds + SHM_K), qr, r32, hi, mkB, sh4, lut);
        finishSM<MASKED>(pA0, pA1, alA, l_reg, pa0, pa1, pa2, pa3, mkA, sh4); SBAR();
        if constexpr (MASKED) mkA = mrow[j + 1];
        SLOAD(SO, (j + SDEPTH) * KVBLK); SBAR();
        pv_d0(o, vb0, pa0, pa1, pa2, pa3); partialSM<MASKED>(pB0, pB1, m_reg, mnB, alB, mkB, sh4);
        __syncthreads(); SWAIT(); SWRITE(0, SE);
        RESC(alB); __syncthreads();
        SBAR(); qkt<MASKED>(pA0, pA1, K_lds, qr, r32, hi, mkA, sh4, lut);
        finishSM<MASKED>(pB0, pB1, alB, l_reg, pa0, pa1, pa2, pa3, mkB, sh4); SBAR();
        if constexpr (MASKED) { if (j + 2 < NT) mkB = mrow[j + 2]; }
        if (SDEPTH == 1 || j + 3 < NT) SLOAD(SE, (j + 1 + SDEPTH) * KVBLK); SBAR();
        pv_d0(o, vb0 + (int)SHM_V, pa0, pa1, pa2, pa3); partialSM<MASKED>(pA0, pA1, m_reg, mnA, alA, mkA, sh4);
        __syncthreads(); SWAIT(); SWRITE(1, SO);
        RESC(alA); __syncthreads();
    }
    SBAR(); qkt<MASKED>(pB0, pB1, (bf16_t*)((char*)K_lds + SHM_K), qr, r32, hi, mkB, sh4, lut);
    finishSM<MASKED>(pA0, pA1, alA, l_reg, pa0, pa1, pa2, pa3, mkA, sh4); SBAR();
    pv_d0(o, vb0, pa0, pa1, pa2, pa3); partialSM<MASKED>(pB0, pB1, m_reg, mnB, alB, mkB, sh4);
    __syncthreads(); RESC(alB);
    finishSM<MASKED>(pB0, pB1, alB, l_reg, pa0, pa1, pa2, pa3, mkB, sh4); SBAR();
    pv_d0(o, vb0 + (int)SHM_V, pa0, pa1, pa2, pa3);
    if (hi == 0) li_l[r32] = l_reg; asm volatile("s_waitcnt lgkmcnt(0)" ::: "memory");
    float rli[16];
#pragma unroll
    for (int r = 0; r < 16; ++r) rli[r] = __builtin_amdgcn_rcpf(li_l[crow(r, hi)]);
    bf16_t* Ow = Ob + (long)(wid * QBLK) * ldo;
#pragma unroll
    for (int r = 0; r < 16; ++r) { const int orow = crow(r, hi);
#pragma unroll
        for (int d0 = 0; d0 < 4; ++d0) Ow[(long)orow * ldo + d0 * 32 + r32] = (bf16_t)(cvtpk(o[d0][r] * rli[r], 0.f) & 0xffffu); }
    __syncthreads();
#undef SLOAD
#undef SWRITE
#undef SWAIT
#undef RESC
}
#undef KSWZ
#undef SBAR
}

#define XB_TMO      128
#define XB_XCNT(j)  (256  + 64 * (j))
#define XB_XSUB(j)  (1280 + 64 * (j))
#define XB_XGEN(j)  (2304 + 64 * (j))
#define XB_TOP      3328
#define XB_TOPGEN   3392
#define XCD_BAR_WORDS 3456
#define XB_SPIN_CAP (1u << 22)
__device__ __forceinline__ unsigned xb_ld(unsigned* p)              { return __hip_atomic_load(p, __ATOMIC_RELAXED, __HIP_MEMORY_SCOPE_AGENT); }
__device__ __forceinline__ unsigned xb_add(unsigned* p, unsigned v) { return __hip_atomic_fetch_add(p, v, __ATOMIC_RELAXED, __HIP_MEMORY_SCOPE_AGENT); }
__device__ __forceinline__ unsigned xb_xcc_id() { return (unsigned)__builtin_amdgcn_s_getreg((3 << 11) | 20) & 0xFu; }
#define XB_SPIN(cond, bar) do { unsigned _sp = 0; while (cond) { __builtin_amdgcn_s_sleep(1); \
    if ((++_sp & 255u) == 0u) { if (xb_ld(&(bar)[XB_TMO])) break; if (_sp > XB_SPIN_CAP) { atomicAdd(&(bar)[XB_TMO], 1u); break; } } } } while (0)
struct XcdBarrier { unsigned* bar; unsigned x; volatile LAS unsigned* st; };
__device__ __forceinline__ XcdBarrier xcd_barrier_post(unsigned* bar, volatile LAS unsigned* st) {
    XcdBarrier b; b.bar = bar; b.x = xb_xcc_id(); b.st = st;
    if (threadIdx.x == 0) (void)xb_add(&bar[XB_XCNT(b.x)], 1u);
    return b;
}
__device__ __forceinline__ void xcd_barrier_complete(unsigned* bar, unsigned x, unsigned& nloc, unsigned& nx) {
    const unsigned G = gridDim.x * gridDim.y * gridDim.z;
    unsigned sum, cnt, mine, sp = 0u;
    for (;;) {
        sum = 0u; cnt = 0u; mine = 0u;
#pragma unroll
        for (unsigned j = 0; j < 16; ++j) { const unsigned c = xb_ld(&bar[XB_XCNT(j)]); sum += c; cnt += (c > 0u) ? 1u : 0u; mine = (j == x) ? c : mine; }
        if (sum == G) break;
        __builtin_amdgcn_s_sleep(1);
        if ((++sp & 255u) == 0u) { if (xb_ld(&bar[XB_TMO])) break; if (sp > XB_SPIN_CAP) { atomicAdd(&bar[XB_TMO], 1u); break; } }
    }
    nloc = mine > 0u ? mine : 1u; nx = cnt > 0u ? cnt : 1u;
}
__device__ __forceinline__ void xcd_barrier(const XcdBarrier& b) {
    asm volatile("s_waitcnt vmcnt(0)" ::: "memory");
    __syncthreads();
    if (threadIdx.x == 0) {
        unsigned* bar = b.bar;
        __builtin_amdgcn_s_waitcnt(0);
        unsigned nloc = b.st[0], nx = b.st[1];
        if (nloc == 0u) { xcd_barrier_complete(bar, b.x, nloc, nx); b.st[0] = nloc; b.st[1] = nx; }
        const unsigned old = xb_add(&bar[XB_XSUB(b.x)], 1u);
        const unsigned gen = old / nloc;
        if (old + 1u == (gen + 1u) * nloc) {
            __builtin_amdgcn_fence(__ATOMIC_RELEASE, "agent");
            asm volatile("s_waitcnt vmcnt(0)" ::: "memory");
            const unsigned og = xb_add(&bar[XB_TOP], 1u);
            const unsigned tg = og / nx;
            if (og + 1u == (tg + 1u) * nx) xb_add(&bar[XB_TOPGEN], 1u);
            else XB_SPIN(xb_ld(&bar[XB_TOPGEN]) == tg, bar);
            __builtin_amdgcn_fence(__ATOMIC_ACQUIRE, "agent");
            xb_add(&bar[XB_XGEN(b.x)], 1u);
            asm volatile("s_waitcnt vmcnt(0)" ::: "memory");
        } else {
            XB_SPIN(xb_ld(&bar[XB_XGEN(b.x)]) == gen, bar);
            __builtin_amdgcn_fence(__ATOMIC_ACQUIRE, "agent");
            asm volatile("s_waitcnt vmcnt(0)" ::: "memory");
        }
    }
    __syncthreads();
}

constexpr int NWAVES = 8;
constexpr int RING_BYTES = 151 * 1024;
constexpr int LDSCTL_OFF = RING_BYTES, MISC_OFF = LDSCTL_OFF + 320;
constexpr int LDS_BYTES = 152 * 1024;
static_assert(MISC_OFF + 128 <= LDS_BYTES, "LDS map");
constexpr int N_PHASES = 12;

struct Args {
    const float* x; const float* mem; const float* attn_g; const float* w_in; const float* q_g; const float* k_g; const float* pool_w; const float* pool_s;
    const float* mem_g; const float* w_kv; const float* mq_g; const float* mk_g; const float* w_out; const float* ffn_g; const float* w_q; const float* sk1; const float* sk2;
    const float* pu; const float* pv; float* out; unsigned char* ws; int ph_lo, ph_hi;
};
struct Frame {
    LAS unsigned char* lds; char* ldsg;
    int tid, lane, wave, vcu, G;
};

__device__ __forceinline__ int in_colmap(int n) {
    if (n < 4096) return n;
    if (n < 4608) return 4176 + (n - 4096);
    if (n < 5120) return 4688 + (n - 4608);
    if (n < 5184) return 4096 + (n - 5120);
    if (n < 5200) return 4160 + (n - 5184);
    return -1;
}
template <int MAP> __device__ __forceinline__ void p0_transpose_item(const float* W, int K, int N, bf16_t* WT, LAS float* scr, int kb, int nb, int lane) {
    const int k0 = 64 * kb, n0 = 32 * nb;
    int nsrc = n0 + (lane & 31); if (MAP == 1) nsrc = in_colmap(nsrc);
#pragma unroll 8
    for (int i = 0; i < 32; ++i) { const int kk = 2 * i + (lane >> 5); scr[kk * 33 + (lane & 31)] = nsrc >= 0 ? W[(size_t)(k0 + kk) * N + nsrc] : 0.f; }
    LDS_WAIT();
    const int c = lane & 7;
#pragma unroll
    for (int j = 0; j < 4; ++j) { const int n = (lane >> 3) + 8 * j; const LAS float* s = scr + (8 * c) * 33 + n;
        u32x4 o; o.x = cvtpk(s[0 * 33], s[1 * 33]); o.y = cvtpk(s[2 * 33], s[3 * 33]); o.z = cvtpk(s[4 * 33], s[5 * 33]); o.w = cvtpk(s[6 * 33], s[7 * 33]);
        *(u32x4*)(WT + (size_t)(n0 + n) * K + k0 + 8 * c) = o; }
    LDS_WAIT();
}
__device__ __forceinline__ void rms_row_to_bf16(const float* xrow, const float* gain, bf16_t* orow, int lane) {
    const f32x4* xr = (const f32x4*)xrow + lane;
    f32x4 v[8]; float s = 0.f;
#pragma unroll
    for (int j = 0; j < 8; ++j) { v[j] = xr[64 * j]; s += (v[j].x * v[j].x + v[j].y * v[j].y) + (v[j].z * v[j].z + v[j].w * v[j].w); }
    const float rstd = 1.f / sqrtf(wave_sum(s) * (1.f / DM) + EPS);
    unsigned long long* o8 = (unsigned long long*)orow + lane;
#pragma unroll
    for (int j = 0; j < 8; ++j) { const f32x4 g = ((const f32x4*)gain)[lane + 64 * j]; const f32x4 y = v[j] * rstd * g;
        o8[64 * j] = (unsigned long long)cvtpk(y.x, y.y) | ((unsigned long long)cvtpk(y.z, y.w) << 32); }
}
struct RowF32 { f32x4 v[8]; };
__device__ __forceinline__ void row_load(RowF32& R, const float* xrow, int lane) {
    const f32x4* xr = (const f32x4*)xrow + lane;
#pragma unroll
    for (int j = 0; j < 8; ++j) R.v[j] = xr[64 * j];
}
__device__ __forceinline__ void row_to_fp8(const RowF32& R, unsigned char* orow, float* inv, int lane) {
    unsigned* o4 = (unsigned*)orow + lane; float am = 0.f;
#pragma unroll
    for (int j = 0; j < 8; ++j) am = fmaxf(am, fmaxf(fmaxf(fabsf(R.v[j].x), fabsf(R.v[j].y)), fmaxf(fabsf(R.v[j].z), fabsf(R.v[j].w))));
#pragma unroll
    for (int o = 1; o < 64; o <<= 1) am = fmaxf(am, __shfl_xor(am, o));
    const float sc = (am > 0.f && am < 3.0e38f) ? exp2f(floorf(log2f(224.f / am))) : 1.f;
#pragma unroll
    for (int j = 0; j < 8; ++j) { int w = __builtin_amdgcn_cvt_pk_fp8_f32(R.v[j].x * sc, R.v[j].y * sc, 0, false); w = __builtin_amdgcn_cvt_pk_fp8_f32(R.v[j].z * sc, R.v[j].w * sc, w, true); o4[64 * j] = (unsigned)w; }
    if (lane == 0) *inv = 1.f / sc;
}
__device__ __forceinline__ void p0_prologue(const Frame& F, const Args& a) {
    unsigned char* ws = a.ws;
    LAS float* scr = (LAS float*)(F.lds + F.wave * 16384);
    const int gw = F.vcu * NWAVES + F.wave, NGW = F.G * NWAVES, lane = F.lane;
    bf16_t* BtIn = (bf16_t*)(ws + WS_BT_IN); bf16_t* BtOut = (bf16_t*)(ws + WS_BT_OUT); bf16_t* BtQ = (bf16_t*)(ws + WS_BT_Q); bf16_t* BtKV = (bf16_t*)(ws + WS_BT_KV);
    constexpr int I_IN = 32 * 168, I_OUT = 32 * 64, I_Q = 32 * 64, I_KV = 32 * 32;
    constexpr int NIT = I_IN + I_OUT + I_Q + I_KV;
    for (int it = gw; it < NIT; it += NGW) {
        int r = it;
        if (r < I_IN) { p0_transpose_item<1>(a.w_in, DM, IN_W, BtIn, scr, r / 168, r % 168, lane); continue; } r -= I_IN;
        if (r < I_OUT) { const int kb = r / 64; p0_transpose_item<0>(a.w_out, DM, DM, BtOut, scr, kb, r % 64, lane); continue; } r -= I_OUT;
        if (r < I_Q) { p0_transpose_item<0>(a.w_q, DM, DM, BtQ, scr, r / 64, r % 64, lane); continue; } r -= I_Q;
        p0_transpose_item<0>(a.w_kv, DM, 1024, BtKV, scr, r / 32, r % 32, lane);
    }
    { bf16_t* PWt = (bf16_t*)(ws + WS_PWT);
      for (int it = gw; it < 4 * 128; it += NGW) { const int g = it >> 7, e = it & 127; const float* pw = a.pool_w + (size_t)g * 16384 + e;
          const float v0 = pw[(size_t)(2 * lane) * 128], v1 = pw[(size_t)(2 * lane + 1) * 128]; ((unsigned*)(PWt + (size_t)it * 128))[lane] = cvtpk(v0, v1); } }
    bf16_t* XN = (bf16_t*)(ws + WS_XN); bf16_t* MN = (bf16_t*)(ws + WS_MN);
    for (int m = gw; m < NTOK; m += NGW) rms_row_to_bf16(a.x + (size_t)m * DM, a.attn_g, XN + (size_t)m * DM, lane);
    for (int m = gw; m < BATCH * MEMLEN; m += NGW) rms_row_to_bf16(a.mem + (size_t)m * DM, a.mem_g, MN + (size_t)m * DM, lane);
    unsigned char* UB = ws + WS_UB; unsigned char* VB = ws + WS_VB; float* RSU = (float*)(ws + WS_RSU); float* RSV = (float*)(ws + WS_RSV);
    (void)UB; (void)VB; (void)RSU; (void)RSV;
    bf16_t* PK = (bf16_t*)(ws + WS_PK);
    for (int m = gw; m < 256; m += NGW) { const float* src = (m < 128 ? a.sk1 + (size_t)m * 128 : a.sk2 + (size_t)(m - 128) * 128);
        const f32x2 v = ((const f32x2*)src)[lane]; ((unsigned*)(PK + (size_t)m * 128))[lane] = cvtpk(v.x, v.y); }
    float* RT = (float*)(ws + WS_ROPE);
    for (int p = gw; p < SEQ; p += NGW) {
        { const float invf = powf(10000.f, -(float)lane / 64.f); const float ang = (float)p * invf;
          RT[(size_t)p * 192 + lane] = (float)cos((double)ang); RT[(size_t)p * 192 + 64 + lane] = (float)sin((double)ang); }
        if (lane < 32) { const float invf = powf(10000.f, -(float)lane / 32.f); const float ang = (float)p * invf;
          RT[(size_t)p * 192 + 128 + lane] = (float)cos((double)ang); RT[(size_t)p * 192 + 160 + lane] = (float)sin((double)ang); }
    }
}

__device__ __forceinline__ void unpack8(const u32x4 w, float* x) { x[0] = bflo(w.x); x[1] = bfhi(w.x); x[2] = bflo(w.y); x[3] = bfhi(w.y); x[4] = bflo(w.z); x[5] = bfhi(w.z); x[6] = bflo(w.w); x[7] = bfhi(w.w); }
__device__ __forceinline__ u32x4 pack8(const float* x) { u32x4 w; w.x = cvtpk(x[0], x[1]); w.y = cvtpk(x[2], x[3]); w.z = cvtpk(x[4], x[5]); w.w = cvtpk(x[6], x[7]); return w; }
struct F8 { float v[8]; };
__device__ __forceinline__ F8 ld8f(const float* p) { const f32x4 a = *(const f32x4*)p, b = *(const f32x4*)(p + 4); F8 r; r.v[0] = a.x; r.v[1] = a.y; r.v[2] = a.z; r.v[3] = a.w; r.v[4] = b.x; r.v[5] = b.y; r.v[6] = b.z; r.v[7] = b.w; return r; }
template <bool NORM, bool ROPE> __device__ __forceinline__ void head128_fin(bf16_t* base, const u32x4 wa, const u32x4 wb, int g, const F8& g1, const F8& g2, const F8& cc, const F8& sn) {
    float x1[8], x2[8];
    unpack8(wa, x1); unpack8(wb, x2);
    if (NORM) {
        float ss = 0.f;
#pragma unroll
        for (int j = 0; j < 8; ++j) ss += x1[j] * x1[j] + x2[j] * x2[j];
        ss += __shfl_xor(ss, 1); ss += __shfl_xor(ss, 2); ss += __shfl_xor(ss, 4);
        const float rstd = 1.f / sqrtf(ss * (1.f / 128.f) + EPS);
#pragma unroll
        for (int j = 0; j < 8; ++j) { x1[j] = x1[j] * rstd * g1.v[j]; x2[j] = x2[j] * rstd * g2.v[j]; }
    }
    if (ROPE) {
#pragma unroll
        for (int j = 0; j < 8; ++j) { const float c = cc.v[j], sv = sn.v[j]; const float p = x1[j], q = x2[j]; x1[j] = p * c - q * sv; x2[j] = q * c + p * sv; }
    }
    *(u32x4*)(base + 8 * g) = pack8(x1); *(u32x4*)(base + 64 + 8 * g) = pack8(x2);
}
__device__ __forceinline__ void head64_fin(bf16_t* base, const u32x4 wa, const u32x4 wb, int g, const F8& cc, const F8& sn) {
    float x1[8], x2[8];
    unpack8(wa, x1); unpack8(wb, x2);
#pragma unroll
    for (int j = 0; j < 8; ++j) { const float c = cc.v[j], sv = sn.v[j]; const float p = x1[j], q = x2[j]; x1[j] = p * c - q * sv; x2[j] = q * c + p * sv; }
    *(u32x4*)(base + 8 * g) = pack8(x1); *(u32x4*)(base + 32 + 8 * g) = pack8(x2);
}
__device__ __forceinline__ void p2_post(const Frame& F, const Args& a) {
    unsigned char* ws = a.ws; const int lane = F.lane;
    const int gw = F.vcu * NWAVES + F.wave, NGW = F.G * NWAVES;
    bf16_t* Z = (bf16_t*)(ws + WS_Z); bf16_t* MIX = (bf16_t*)(ws + WS_XN); bf16_t* KVM = (bf16_t*)(ws + WS_KVM);
    const float* RT = (const float*)(ws + WS_ROPE);
    const int g8 = lane & 7, h8 = lane >> 3, g4 = lane & 3, h4 = lane >> 2;
    const F8 qg1 = ld8f(a.q_g + 8 * g8), qg2 = ld8f(a.q_g + 64 + 8 * g8), kg1 = ld8f(a.k_g + 8 * g8), kg2 = ld8f(a.k_g + 64 + 8 * g8), mg1 = ld8f(a.mq_g + 8 * g8), mg2 = ld8f(a.mq_g + 64 + 8 * g8);
    for (int t = gw; t < NTOK; t += NGW) {
        const int pos = t & (SEQ - 1);
        bf16_t* zr = Z + (size_t)t * ZLD; const float* rp = RT + (size_t)pos * 192;
        const int w = 2 << (lane >> 4); const int cnt = (pos + 1 < w) ? pos + 1 : w;
        u32x4 pl[16];
#pragma unroll
        for (int j = 0; j < 16; ++j) { const int jj = j < cnt ? j : 0; pl[j] = *(const u32x4*)(zr - (size_t)jj * ZLD + ZC_PU + 8 * lane); }
        bf16_t* bq = zr + ZC_Q + h8 * 128; bf16_t* bk = zr + ZC_K + h8 * 128; bf16_t* bi = zr + ZC_QI + h4 * 64; bf16_t* bki = zr + ZC_KI; bf16_t* bm = zr + ZC_QM + (h8 & 3) * 128;
        const u32x4 q1 = *(const u32x4*)(bq + 8 * g8), q2 = *(const u32x4*)(bq + 64 + 8 * g8), k1 = *(const u32x4*)(bk + 8 * g8), k2 = *(const u32x4*)(bk + 64 + 8 * g8);
        const u32x4 i1 = *(const u32x4*)(bi + 8 * g4), i2 = *(const u32x4*)(bi + 32 + 8 * g4), x1 = *(const u32x4*)(bki + 8 * g4), x2 = *(const u32x4*)(bki + 32 + 8 * g4);
        const u32x4 m1 = *(const u32x4*)(bm + 8 * g8), m2 = *(const u32x4*)(bm + 64 + 8 * g8);
        const F8 c128 = ld8f(rp + 8 * g8), s128 = ld8f(rp + 64 + 8 * g8), c64 = ld8f(rp + 128 + 8 * g4), s64 = ld8f(rp + 160 + 8 * g4);
        head128_fin<true, true>(bq, q1, q2, g8, qg1, qg2, c128, s128);
        head128_fin<true, true>(bk, k1, k2, g8, kg1, kg2, c128, s128);
        head64_fin(bi, i1, i2, g4, c64, s64);
        if (lane < 4) head64_fin(bki, x1, x2, g4, c64, s64);
        if (lane < 32) head128_fin<true, false>(bm, m1, m2, g8, mg1, mg2, c128, s128);
        { float sum[8] = {0.f, 0.f, 0.f, 0.f, 0.f, 0.f, 0.f, 0.f}, ut[8];
          unpack8(pl[0], ut);
#pragma unroll
          for (int j = 0; j < 16; ++j) { float v[8]; unpack8(pl[j], v); const float on = j < cnt ? 1.f : 0.f;
#pragma unroll
              for (int e = 0; e < 8; ++e) sum[e] = fmaf(on, v[e], sum[e]); }
          const float inv = 1.f / (float)cnt; float d[8];
#pragma unroll
          for (int e = 0; e < 8; ++e) d[e] = sum[e] * inv - ut[e];
          *(u32x4*)(MIX + (size_t)t * DM + 1024 + 8 * lane) = pack8(d); }
    }
    const F8 kmg1 = ld8f(a.mk_g + 8 * g8), kmg2 = ld8f(a.mk_g + 64 + 8 * g8);
    for (int r = gw; r < BATCH * MEMLEN; r += NGW) { if (lane < 32) { bf16_t* bm = KVM + (size_t)r * 1024 + (lane >> 3) * 128; const u32x4 m1 = *(const u32x4*)(bm + 8 * g8), m2 = *(const u32x4*)(bm + 64 + 8 * g8); head128_fin<true, false>(bm, m1, m2, g8, kmg1, kmg2, kmg1, kmg2); } }
}

namespace ix {
constexpr int KP = 144, KBUF = 64 * KP;
constexpr int OFF_KI = 0, OFF_HIST = 2 * KBUF, OFF_ST = OFF_HIST + 65536, OFF_W = OFF_ST + 8192;
constexpr int CAPB = 1024;
constexpr int CAPF = 512;
enum { S_ULO = 0, S_UHI = 64, S_SH = 128, S_NEED = 192, S_FLO = 256, S_FHI = 320, S_CCNT = 384, S_ACT = 448, S_ABOVE = 512, S_COL = 576, S_FAIL = 640,
       S_PB1 = 704, S_PB2 = 768, S_PAB = 832, S_VMIN = 896, S_VMAX = 960, S_VCNT = 1024, S_ANY = 1088, S_R1 = 1089, S_R2 = 1090 };
constexpr float WSCALE = 0.25f * 0.125f;
__device__ __forceinline__ float relu_i(float x) { const int i = __float_as_int(x); return __int_as_float(i > 0 ? i : 0); }
__device__ __forceinline__ unsigned sh_for(unsigned range) { const int bits = 32 - __clz((int)range); return range == 0u ? 0u : (bits > 9 ? (unsigned)(bits - 9) : 0u); }

template <int MODE>
__device__ __forceinline__ void sweep(const Frame& F, const bf16x8 (&A)[4][4], const bf16_t* Z, unsigned* MASK, unsigned long long* CAND, size_t qrow0, size_t krow0, int NT, int t0, int stride, int vmode) {
    const int tid = F.tid, lane = F.lane, wave = F.wave, r = lane & 31, hi = lane >> 5;
    LAS unsigned char* lds = F.lds;
    volatile LAS unsigned* st = (volatile LAS unsigned*)(lds + OFF_ST);
    LAS unsigned* hist32 = (LAS unsigned*)(lds + OFF_HIST);
    unsigned qact = 0u;
    {
#pragma unroll
        for (int qp = 0; qp < 4; ++qp) { const int q0 = 8 * wave + 2 * qp; const unsigned a2 = (MODE == 0) ? (st[S_ACT + q0] | st[S_ACT + q0 + 1]) : (vmode ? 1u : (st[S_COL + q0] | st[S_COL + q0 + 1]));
            qact |= ((unsigned)__builtin_amdgcn_readfirstlane((int)a2) != 0u ? 1u : 0u) << qp; }
    }
    unsigned ccnt_[4] = {0u, 0u, 0u, 0u}, abv_[4] = {0u, 0u, 0u, 0u};
    if (MODE == 1) {
#pragma unroll
        for (int qp = 0; qp < 4; ++qp) { ccnt_[qp] = st[S_CCNT + 8 * wave + 2 * qp + hi]; abv_[qp] = st[S_ABOVE + 8 * wave + 2 * qp + hi]; }
    }
    const int srow = tid >> 3, sch = tid & 7;
    const bf16_t* ksrc = Z + (krow0 + srow) * ZLD + ZC_KI + sch * 8;
    u32x4 stg = *(const u32x4*)(ksrc + (size_t)t0 * 64 * ZLD);
    *(LAS u32x4*)(lds + OFF_KI + srow * KP + sch * 16) = stg;
    __syncthreads();
    int buf = 0;
    for (int t = t0; t < NT; t += stride) {
        const int tn = t + stride;
        if (tn < NT) stg = *(const u32x4*)(ksrc + (size_t)tn * 64 * ZLD);
        LAS unsigned char* kb = lds + OFF_KI + buf * KBUF;
        int lane_ = (int)threadIdx.x; asm volatile("" : "+v"(lane_)); lane_ &= 63;
        const int r = lane_ & 31, hi = lane_ >> 5;
        bf16x8 B0[4], B1[4];
#pragma unroll
        for (int ks = 0; ks < 4; ++ks) { B0[ks] = *(const LAS bf16x8*)(kb + r * KP + ks * 32 + hi * 16); B1[ks] = *(const LAS bf16x8*)(kb + (32 + r) * KP + ks * 32 + hi * 16); }
#pragma unroll
        for (int qp = 0; qp < 4; ++qp) {
            if (((qact >> qp) & 1u) == 0u) continue;
            const int ql = 8 * wave + 2 * qp + hi;
            const LAS f32x4* wq = (const LAS f32x4*)(lds + OFF_W + ql * 64);
            const f32x4 w0 = wq[0], w1 = wq[1], w2 = wq[2], w3 = wq[3];
            f32x16 a0 = f32x16{}, a1 = f32x16{};
#pragma unroll
            for (int ks = 0; ks < 4; ++ks) { a0 = __builtin_amdgcn_mfma_f32_32x32x16_bf16(A[qp][ks], B0[ks], a0, 0, 0, 0); a1 = __builtin_amdgcn_mfma_f32_32x32x16_bf16(A[qp][ks], B1[ks], a1, 0, 0, 0); }
            float p0 = w0.x * relu_i(a0[0]), p1 = w2.x * relu_i(a0[8]), q0 = w0.x * relu_i(a1[0]), q1 = w2.x * relu_i(a1[8]);
            p0 = fmaf(w0.y, relu_i(a0[1]), p0); p1 = fmaf(w2.y, relu_i(a0[9]), p1); q0 = fmaf(w0.y, relu_i(a1[1]), q0); q1 = fmaf(w2.y, relu_i(a1[9]), q1);
            p0 = fmaf(w0.z, relu_i(a0[2]), p0); p1 = fmaf(w2.z, relu_i(a0[10]), p1); q0 = fmaf(w0.z, relu_i(a1[2]), q0); q1 = fmaf(w2.z, relu_i(a1[10]), q1);
            p0 = fmaf(w0.w, relu_i(a0[3]), p0); p1 = fmaf(w2.w, relu_i(a0[11]), p1); q0 = fmaf(w0.w, relu_i(a1[3]), q0); q1 = fmaf(w2.w, relu_i(a1[11]), q1);
            p0 = fmaf(w1.x, relu_i(a0[4]), p0); p1 = fmaf(w3.x, relu_i(a0[12]), p1); q0 = fmaf(w1.x, relu_i(a1[4]), q0); q1 = fmaf(w3.x, relu_i(a1[12]), q1);
            p0 = fmaf(w1.y, relu_i(a0[5]), p0); p1 = fmaf(w3.y, relu_i(a0[13]), p1); q0 = fmaf(w1.y, relu_i(a1[5]), q0); q1 = fmaf(w3.y, relu_i(a1[13]), q1);
            p0 = fmaf(w1.z, relu_i(a0[6]), p0); p1 = fmaf(w3.z, relu_i(a0[14]), p1); q0 = fmaf(w1.z, relu_i(a1[6]), q0); q1 = fmaf(w3.z, relu_i(a1[14]), q1);
            p0 = fmaf(w1.w, relu_i(a0[7]), p0); p1 = fmaf(w3.w, relu_i(a0[15]), p1); q0 = fmaf(w1.w, relu_i(a1[7]), q0); q1 = fmaf(w3.w, relu_i(a1[15]), q1);
            const unsigned u0 = f2ord(p0 + p1), u1 = f2ord(q0 + q1);
            if (MODE == 0) {
                const unsigned wlo = st[S_ULO + ql], whi = st[S_UHI + ql], wsh = st[S_SH + ql];
                if (u0 >= wlo && u0 <= whi) { const unsigned bin = (u0 - wlo) >> wsh;
                    __hip_atomic_fetch_add(hist32 + ql * 256 + (bin >> 1), 1u << ((bin & 1u) * 16u), __ATOMIC_RELAXED, __HIP_MEMORY_SCOPE_WORKGROUP); }
                if (u1 >= wlo && u1 <= whi) { const unsigned bin = (u1 - wlo) >> wsh;
                    __hip_atomic_fetch_add(hist32 + ql * 256 + (bin >> 1), 1u << ((bin & 1u) * 16u), __ATOMIC_RELAXED, __HIP_MEMORY_SCOPE_WORKGROUP); }
            } else if (IX_VERIFY && vmode) {
                LAS unsigned* vs = (LAS unsigned*)(lds + OFF_ST) + ql;
                const unsigned long long w64 = __hip_atomic_load((const unsigned long long*)(MASK + (qrow0 + ql) * MASK_WPR + 2 * t), __ATOMIC_RELAXED, __HIP_MEMORY_SCOPE_AGENT);
                if ((w64 >> r) & 1ull) { __hip_atomic_fetch_min(vs + S_VMIN, u0, __ATOMIC_RELAXED, __HIP_MEMORY_SCOPE_WORKGROUP); __hip_atomic_fetch_add(vs + S_VCNT, 1u, __ATOMIC_RELAXED, __HIP_MEMORY_SCOPE_WORKGROUP); }
                else __hip_atomic_fetch_max(vs + S_VMAX, u0, __ATOMIC_RELAXED, __HIP_MEMORY_SCOPE_WORKGROUP);
                if ((w64 >> (32 + r)) & 1ull) { __hip_atomic_fetch_min(vs + S_VMIN, u1, __ATOMIC_RELAXED, __HIP_MEMORY_SCOPE_WORKGROUP); __hip_atomic_fetch_add(vs + S_VCNT, 1u, __ATOMIC_RELAXED, __HIP_MEMORY_SCOPE_WORKGROUP); }
                else __hip_atomic_fetch_max(vs + S_VMAX, u1, __ATOMIC_RELAXED, __HIP_MEMORY_SCOPE_WORKGROUP);
            } else {
                const unsigned flo = st[S_FLO + ql], fhi = st[S_FHI + ql]; const bool col = st[S_COL + ql] != 0u;
                const unsigned long long bal0 = __ballot(col && u0 > fhi), bal1 = __ballot(col && u1 > fhi);
                const unsigned bh0 = (unsigned)(bal0 >> (32 * hi)), bh1 = (unsigned)(bal1 >> (32 * hi));
                if (col && r == 0) *(unsigned long long*)(MASK + (qrow0 + ql) * MASK_WPR + 2 * t) = (unsigned long long)bh0 | ((unsigned long long)bh1 << 32);
                abv_[qp] += __popc(bh0) + __popc(bh1);
                const bool c0 = col && (u0 >= flo) && (u0 <= fhi), c1 = col && (u1 >= flo) && (u1 <= fhi);
                const unsigned long long cb0 = __ballot(c0), cb1 = __ballot(c1);
                if (cb0 | cb1) { const unsigned h0 = (unsigned)(cb0 >> (32 * hi)), h1 = (unsigned)(cb1 >> (32 * hi)); const unsigned lt = (1u << r) - 1u;
                    const unsigned pos0 = ccnt_[qp] + __popc(h0 & lt), pos1 = ccnt_[qp] + __popc(h0) + __popc(h1 & lt);
                    if (c0 && pos0 < (unsigned)CAPB) CAND[(size_t)ql * CAPB + pos0] = (unsigned long long)u0 | ((unsigned long long)(unsigned)(64 * t + r) << 32);
                    if (c1 && pos1 < (unsigned)CAPB) CAND[(size_t)ql * CAPB + pos1] = (unsigned long long)u1 | ((unsigned long long)(unsigned)(64 * t + 32 + r) << 32);
                    ccnt_[qp] += __popc(h0) + __popc(h1); }
            }
        }
        if (tn < NT) *(LAS u32x4*)(lds + OFF_KI + (buf ^ 1) * KBUF + srow * KP + sch * 16) = stg;
        __syncthreads();
        buf ^= 1;
    }
    if (MODE == 1 && !vmode) { const int r0 = lane & 31, h0 = lane >> 5;
#pragma unroll
        for (int qp = 0; qp < 4; ++qp) { const int ql = 8 * wave + 2 * qp + h0; if (r0 == 0 && st[S_COL + ql] != 0u) { st[S_CCNT + ql] = ccnt_[qp]; st[S_ABOVE + ql] = abv_[qp]; } } }
}

__device__ __forceinline__ void resolve(const Frame& F, unsigned* MASK, const unsigned long long* CAND, size_t qrow0, int NT) {
    int lane = (int)threadIdx.x; asm volatile("" : "+v"(lane)); lane &= 63; const int wave = F.wave;
    LAS unsigned char* lds = F.lds;
    volatile LAS unsigned* st = (volatile LAS unsigned*)(lds + OFF_ST);
    LAS unsigned* wh = (LAS unsigned*)(lds + OFF_HIST + wave * 4608); LAS unsigned* bm = wh + 512; LAS unsigned long long* sl = (LAS unsigned long long*)(bm + 512);
    const unsigned long long ltm = (1ull << lane) - 1ull;
    for (int qi = 0; qi < 8; ++qi) {
        const int q = 8 * wave + qi;
        if (st[S_COL + q] == 0u) continue;
        const unsigned cnt = st[S_CCNT + q], ab = st[S_ABOVE + q];
        if (!(ab < 256u && ab + cnt >= 256u && cnt <= (unsigned)CAPB)) { if (lane == 0) st[S_FAIL + q] = 1u; continue; }
        if (lane == 0) st[S_FAIL + q] = 0u;
        unsigned need = 256u - ab, lo = st[S_FLO + q], hi = st[S_FHI + q], sh = 0u, cbin = 0u;
        const unsigned long long* cq = CAND + (size_t)q * CAPB;
#pragma unroll
        for (int i = 0; i < 8; ++i) bm[lane * 8 + i] = 0u;
        for (int lev = 0; lev < 5; ++lev) {
            sh = sh_for(hi - lo);
#pragma unroll
            for (int i = 0; i < 8; ++i) wh[lane * 8 + i] = 0u;
            LDS_WAIT();
            for (unsigned j = lane; j < cnt; j += 64) { const unsigned u = (unsigned)cq[j]; if (u >= lo && u <= hi) __hip_atomic_fetch_add(wh + ((u - lo) >> sh), 1u, __ATOMIC_RELAXED, __HIP_MEMORY_SCOPE_WORKGROUP); }
            LDS_WAIT();
            unsigned hb[8], s8 = 0u;
#pragma unroll
            for (int i = 0; i < 8; ++i) { hb[i] = wh[lane * 8 + i]; s8 += hb[i]; }
            unsigned above = 0u;
            { unsigned inc = s8;
#pragma unroll
              for (int o = 1; o < 64; o <<= 1) { const unsigned v = __shfl_down(inc, o); if (lane + o < 64) inc += v; }
              above = inc - s8; }
            const bool mine = above < need && need <= above + s8;
            unsigned bstar = 0u, run = above, cb = 0u;
            if (mine) { bool found = false;
#pragma unroll
                for (int i = 7; i >= 0; --i) { if (!found) { if (run + hb[i] >= need) { bstar = (unsigned)(lane * 8 + i); cb = hb[i]; found = true; } else run += hb[i]; } } }
            const unsigned long long mb = __ballot(mine); const int src = mb ? (int)__builtin_ctzll(mb) : 0;
            bstar = __shfl(bstar, src); run = __shfl(run, src); cbin = __shfl(cb, src);
            const unsigned nlo = lo + (bstar << sh); const unsigned long long e = (unsigned long long)nlo + ((1ull << sh) - 1ull);
            hi = e > (unsigned long long)hi ? hi : (unsigned)e; lo = nlo; need -= run;
            if (cbin <= 64u || sh == 0u) break;
        }
        const bool tiemode = cbin > 64u;
        unsigned m = 0u;
        for (unsigned j0 = 0; j0 < cnt; j0 += 64) { const unsigned j = j0 + lane; const bool vj = j < cnt; const unsigned long long e = vj ? cq[j] : 0ull; const unsigned u = (unsigned)e, key = (unsigned)(e >> 32);
            const bool inw = vj && u >= lo && u <= hi; const unsigned long long bal = __ballot(inw); const unsigned pos = m + (unsigned)__popcll(bal & ltm);
            if (vj && (u > hi || (tiemode && inw && pos < need))) __hip_atomic_fetch_or(bm + (key >> 5), 1u << (key & 31u), __ATOMIC_RELAXED, __HIP_MEMORY_SCOPE_WORKGROUP);
            if (!tiemode && inw && pos < 64u) sl[pos] = e;
            m += (unsigned)__popcll(bal); }
        LDS_WAIT();
        if (!tiemode) { if (m > 64u) m = 64u;
            if ((unsigned)lane < m) { const unsigned long long ej = sl[lane]; const unsigned uj = (unsigned)ej; unsigned rank = 0u;
                for (unsigned j2 = 0; j2 < m; ++j2) { const unsigned u2 = (unsigned)sl[j2]; rank += (u2 > uj || (u2 == uj && j2 < (unsigned)lane)) ? 1u : 0u; }
                if (rank < need) { const unsigned key = (unsigned)(ej >> 32); __hip_atomic_fetch_or(bm + (key >> 5), 1u << (key & 31u), __ATOMIC_RELAXED, __HIP_MEMORY_SCOPE_WORKGROUP); } } }
        LDS_WAIT();
        unsigned* mrow = MASK + (qrow0 + q) * MASK_WPR;
        for (int w = lane; w < 2 * NT; w += 64) { const unsigned b = bm[w]; if (b) { const unsigned old = __hip_atomic_load(mrow + w, __ATOMIC_RELAXED, __HIP_MEMORY_SCOPE_AGENT); mrow[w] = old | b; } }
        LDS_WAIT();
    }
}

__device__ __forceinline__ void unit(const Frame& F, const bf16_t* Z, unsigned* MASK, unsigned long long* CANDW, unsigned* ERR, int b, int c) {
    const int tid = F.tid, lane = F.lane, wave = F.wave, r = lane & 31, hi = lane >> 5;
    const int NT = c + 1; const size_t qrow0 = (size_t)b * SEQ + 64 * c, krow0 = (size_t)b * SEQ;
    LAS unsigned char* lds = F.lds;
    volatile LAS unsigned* st = (volatile LAS unsigned*)(lds + OFF_ST);
    LAS unsigned* hist32 = (LAS unsigned*)(lds + OFF_HIST);
    { const int tend = 4 * ((c >> 2) + 1), nz = 2 * (tend - NT);
      for (int i = tid; i < 64 * nz; i += 512) { const int q = i / nz, wi = 2 * NT + i % nz; MASK[(qrow0 + q) * MASK_WPR + wi] = 0u; } }
    if (c <= 3) {
        for (int i = tid; i < 64 * 2 * NT; i += 512) { const int q = i / (2 * NT), wi = i % (2 * NT); MASK[(qrow0 + q) * MASK_WPR + wi] = 0xFFFFFFFFu; }
        return;
    }
    bf16x8 A[4][4];
#pragma unroll
    for (int qp = 0; qp < 4; ++qp) {
        const int query = 8 * wave + 2 * qp + ((r >> 2) & 1), head = (r & 3) + 4 * (r >> 3);
        const bf16_t* src = Z + (qrow0 + query) * ZLD + ZC_QI + head * 64 + 8 * hi;
#pragma unroll
        for (int ks = 0; ks < 4; ++ks) A[qp][ks] = *(const bf16x8*)(src + ks * 16);
    }
    for (int i = tid; i < 64 * 16; i += 512) { const int q = i >> 4, hh = i & 15; ((LAS float*)(lds + OFF_W))[i] = bflo((unsigned)Z[(qrow0 + q) * ZLD + ZC_WI + hh]) * WSCALE; }
    const int stride = NT >= 32 ? 8 : (NT >= 16 ? 4 : 1), t0 = stride >> 1, nsamp = (NT - t0 + stride - 1) / stride;
    const bool pilot = stride > 1;
    int r1 = 1, r2 = 1;
    if (pilot) { const float ns = 256.f * (float)nsamp / (float)NT; const float sg = sqrtf(ns * (1.f - 1.f / (float)stride)); const int mg = (int)ceilf(4.f * sg) + 2;
        r1 = (int)floorf(ns) - mg; if (r1 < 1) r1 = 1; r2 = (int)ceilf(ns) + mg; }
    if (tid < 64) { st[S_ULO + tid] = 0u; st[S_UHI + tid] = 0xFFFFFFFFu; st[S_SH + tid] = 23u; st[S_NEED + tid] = 256u; st[S_ACT + tid] = 1u; st[S_CCNT + tid] = 0u; st[S_ABOVE + tid] = 0u;
                    st[S_COL + tid] = 1u; st[S_FAIL + tid] = pilot ? 0u : 1u; st[S_PB1 + tid] = 511u; st[S_PB2 + tid] = 0u; st[S_PAB + tid] = 0u; }
    __syncthreads();
    int stage = pilot ? 0 : 2; bool after_fallback = !pilot;
    for (int iter = 0; iter < 24; ++iter) {
        if (stage <= 2) {
            { int tid_ = (int)threadIdx.x; asm volatile("" : "+v"(tid_));
              for (int i = 0; i < 32; ++i) hist32[tid_ + 512 * i] = 0u;
              if (tid_ == 0) st[S_ANY] = 0u; }
            __syncthreads();
            const bool smp = stage <= 1;
            sweep<0>(F, A, Z, MASK, CANDW, qrow0, krow0, NT, smp ? t0 : 0, smp ? stride : 1, 0);
            { int tid_ = (int)threadIdx.x; asm volatile("" : "+v"(tid_)); const int ln = tid_ & 63;
              const int q = tid_ >> 3, seg = tid_ & 7; const LAS unsigned* h32 = hist32 + q * 256 + seg * 32;
              unsigned cnt = 0u;
              for (int i = 0; i < 32; ++i) { const unsigned wv = h32[i]; cnt += (wv & 0xffffu) + (wv >> 16); }
              unsigned above = 0u;
#pragma unroll
              for (int k = 0; k < 8; ++k) { const unsigned ck = __shfl(cnt, (ln & ~7) + k); if (k > seg) above += ck; }
              const unsigned ulo = st[S_ULO + q], uhi = st[S_UHI + q], sh = st[S_SH + q];
              if (smp) {
                  const unsigned pab = stage == 1 ? st[S_PAB + q] : 0u;
                  const unsigned t1 = (unsigned)r1 - (stage == 1 ? pab : 0u), t2 = (unsigned)r2 - (stage == 1 ? pab : 0u);
#pragma unroll
                  for (int which = 0; which < 2; ++which) { const unsigned tg = which ? t2 : t1;
                      if (above < tg && tg <= above + cnt) { unsigned run = above; int bstar = -1;
                          for (int i = 31; i >= 0; --i) { const unsigned wv = h32[i]; const unsigned c1 = wv >> 16, c0 = wv & 0xffffu;
                              if (bstar < 0) { if (run + c1 >= tg) bstar = seg * 64 + 2 * i + 1; else run += c1; }
                              if (bstar < 0) { if (run + c0 >= tg) bstar = seg * 64 + 2 * i; else run += c0; } }
                          if (which == 0) { st[S_PB1 + q] = (unsigned)bstar; if (stage == 0) st[S_PAB + q] = run; } else st[S_PB2 + q] = (unsigned)bstar; } }
              } else {
                  const unsigned need = st[S_NEED + q], active = st[S_ACT + q];
                  if (active && above < need && need <= above + cnt) {
                      unsigned run = above; int bstar = -1; unsigned cbin = 0u;
                      for (int i = 31; i >= 0; --i) { const unsigned wv = h32[i]; const unsigned c1 = wv >> 16, c0 = wv & 0xffffu;
                          if (bstar < 0) { if (run + c1 >= need) { bstar = seg * 64 + 2 * i + 1; cbin = c1; } else run += c1; }
                          if (bstar < 0) { if (run + c0 >= need) { bstar = seg * 64 + 2 * i; cbin = c0; } else run += c0; } }
                      const unsigned nlo = ulo + ((unsigned)bstar << sh); const unsigned long long e = (unsigned long long)nlo + ((1ull << sh) - 1ull);
                      const unsigned nhi = e > (unsigned long long)uhi ? uhi : (unsigned)e;
                      if (cbin <= (unsigned)CAPF || sh == 0u) { st[S_FLO + q] = nlo; st[S_FHI + q] = nhi; st[S_ACT + q] = 0u; st[S_ULO + q] = 1u; st[S_UHI + q] = 0u; }
                      else { st[S_ULO + q] = nlo; st[S_UHI + q] = nhi; st[S_SH + q] = sh >= 9u ? sh - 9u : 0u; st[S_NEED + q] = need - run; st[S_ANY] = 1u; }
                  }
              } }
            __syncthreads();
            if (stage == 0) {
                if (tid < 64) { const unsigned b1 = st[S_PB1 + tid], b2 = st[S_PB2 + tid]; const unsigned nlo = b2 << 23; const unsigned long long e = ((unsigned long long)(b1 + 1u) << 23) - 1ull;
                    const unsigned nhi = e > 0xFFFFFFFFull ? 0xFFFFFFFFu : (unsigned)e; st[S_ULO + tid] = nlo; st[S_UHI + tid] = nhi; st[S_SH + tid] = sh_for(nhi - nlo); st[S_PB1 + tid] = 511u; st[S_PB2 + tid] = 0u; }
                stage = 1;
            } else if (stage == 1) {
                if (tid < 64) { const unsigned b1 = st[S_PB1 + tid], b2 = st[S_PB2 + tid], ulo = st[S_ULO + tid], uhi = st[S_UHI + tid], sh = st[S_SH + tid];
                    const unsigned flo = ulo + (b2 << sh); const unsigned long long e = (unsigned long long)ulo + ((unsigned long long)(b1 + 1u) << sh) - 1ull;
                    st[S_FLO + tid] = flo; st[S_FHI + tid] = e > (unsigned long long)uhi ? uhi : (unsigned)e; }
                stage = 3;
            } else { const unsigned any = st[S_ANY]; if (!any) stage = 3; }
            __syncthreads();
        } else {
            const int vm = stage == 4 ? 1 : 0;
            if (vm) { if (tid < 64) { st[S_VMIN + tid] = 0xFFFFFFFFu; st[S_VMAX + tid] = 0u; st[S_VCNT + tid] = 0u; } __syncthreads(); }
            sweep<1>(F, A, Z, MASK, CANDW, qrow0, krow0, NT, 0, 1, vm);
            VM_WAIT(); __syncthreads();
            if (vm) { if (tid < 64) { if (st[S_VCNT + tid] != 256u || st[S_VMIN + tid] < st[S_VMAX + tid]) atomicOr(ERR, 1u); } __syncthreads(); break; }
            resolve(F, MASK, CANDW, qrow0, NT);
            VM_WAIT(); __syncthreads();
            unsigned nf = 0u;
            if (!after_fallback) { if (tid < 64) nf = st[S_FAIL + tid] & st[S_COL + tid]; nf = (unsigned)__syncthreads_or((int)nf); }
            if (nf) {
                if (tid < 64) { const unsigned f = st[S_FAIL + tid] & st[S_COL + tid]; st[S_ULO + tid] = f ? 0u : 1u; st[S_UHI + tid] = f ? 0xFFFFFFFFu : 0u; st[S_SH + tid] = 23u; st[S_NEED + tid] = 256u; st[S_ACT + tid] = f;
                    st[S_COL + tid] = f; if (f) { st[S_CCNT + tid] = 0u; st[S_ABOVE + tid] = 0u; } }
                __syncthreads();
                stage = 2; after_fallback = true;
            } else { if (IX_VERIFY) stage = 4; else break; }
        }
    }
}
}

namespace peer {
constexpr int TT = 16;
constexpr int SP = 129;
constexpr int OFF_S = 0, OFF_L = 256 * SP * 4;
constexpr int OFF_A = 0;
__device__ __forceinline__ void ins16(unsigned (&L)[16], unsigned x) {
#pragma unroll
    for (int j = 0; j < 16; ++j) { const unsigned a = L[j]; const unsigned mx = a > x ? a : x; x = a > x ? x : a; L[j] = mx; }
}
__device__ __forceinline__ float dot2bf(unsigned w, unsigned x, float acc) { return __builtin_amdgcn_fdot2_f32_bf16(__builtin_bit_cast(bf16x2_t, w), __builtin_bit_cast(bf16x2_t, x), acc, false); }
__device__ __forceinline__ float gelu_erf(float h) { return 0.5f * h * (1.f + erff(h * 0.70710678118654752f)); }

__device__ __forceinline__ void fp8dot4(unsigned w, f32x2 h01, f32x2 h23, f32x2& a0, f32x2& a1) {
    const f32x2 lo = __builtin_amdgcn_cvt_pk_f32_fp8((int)w, false), hi = __builtin_amdgcn_cvt_pk_f32_fp8((int)w, true); a0 = lo * h01 + a0; a1 = hi * h23 + a1; }
__device__ __forceinline__ void fp8axpy4(unsigned w, f32x2 a2, f32x2& c01, f32x2& c23) {
    const f32x2 lo = __builtin_amdgcn_cvt_pk_f32_fp8((int)w, false), hi = __builtin_amdgcn_cvt_pk_f32_fp8((int)w, true); c01 = lo * a2 + c01; c23 = hi * a2 + c23; }
constexpr int NSL = 16, SLW = 128;
__device__ __forceinline__ float dpp_sum8(float v) {
    v += __int_as_float(__builtin_amdgcn_update_dpp(0, __float_as_int(v), 0xB1, 0xF, 0xF, true));
    v += __int_as_float(__builtin_amdgcn_update_dpp(0, __float_as_int(v), 0x4E, 0xF, 0xF, true));
    v += __int_as_float(__builtin_amdgcn_update_dpp(0, __float_as_int(v), 0x141, 0xF, 0xF, true));
    return v;
}
#define PEER_EID(V0, V1, i) ((((i) < 8 ? (V0) : (V1))[((i) & 7) >> 1] >> (16 * ((i) & 1))) & 0xffffu)

struct TabCvt { const float* pu; const float* pv; unsigned char* UB; unsigned char* VB; float* RSU; float* RSV; };
__device__ __forceinline__ const float* tab_src(const TabCvt& T, int m) { return m < NEXP ? T.pu + (size_t)m * DM : T.pv + (size_t)(m - NEXP) * DM; }
__device__ __forceinline__ void tab_finish(const TabCvt& T, const RowF32& R, int m, int lane) { if (m < NEXP) row_to_fp8(R, T.UB + (size_t)m * DM, T.RSU + m, lane); else row_to_fp8(R, T.VB + (size_t)(m - NEXP) * DM, T.RSV + (m - NEXP), lane); }
__device__ __forceinline__ void route_step(const Frame& F, const bf16_t* PQ, const bf16x8 (&Bf)[2][8], unsigned short* E16, float* GT, int tok0, const TabCvt& T, int m0, int m1) {
    const int tid = F.tid, lane = F.lane, wave = F.wave, r = lane & 31, hi = lane >> 5;
    LAS float* S = (LAS float*)(F.lds + OFF_S); LAS unsigned* L = (LAS unsigned*)(F.lds + OFF_L);
    RowF32 R;
    if (m0 >= 0) row_load(R, tab_src(T, m0), lane);
    { const int half = wave & 1, cp = (wave >> 1) & 1, rh = wave >> 2;
#pragma unroll
      for (int r2 = 0; r2 < 2; ++r2) {
          const int rt = 2 * rh + r2; const int pair = 32 * rt + r, tok = pair >> 3, p = pair & 7;
          const bf16_t* src = PQ + (size_t)(tok0 + tok) * DM + p * 256 + half * 128 + 8 * hi;
          bf16x8 A[8];
#pragma unroll
          for (int ks = 0; ks < 8; ++ks) A[ks] = *(const bf16x8*)(src + ks * 16);
#pragma unroll
          for (int c2 = 0; c2 < 2; ++c2) {
              f32x16 acc = f32x16{};
#pragma unroll
              for (int ks = 0; ks < 8; ++ks) acc = __builtin_amdgcn_mfma_f32_32x32x16_bf16(A[ks], Bf[c2][ks], acc, 0, 0, 0);
#pragma unroll
              for (int i = 0; i < 16; ++i) { const int row = (32 * rt + (i & 3) + 8 * (i >> 2) + 4 * hi) * 2 + half; S[row * SP + (2 * cp + c2) * 32 + r] = acc[i]; }
          } } }
    if (m0 >= 0) tab_finish(T, R, m0, lane);
    if (m1 >= 0) row_load(R, tab_src(T, m1), lane);
    __syncthreads();
    { const int row = tid >> 1, part = tid & 1; unsigned L16[16];
#pragma unroll
      for (int j = 0; j < 16; ++j) L16[j] = 0u;
#pragma unroll 4
      for (int n = 0; n < 64; ++n) { const int nn = part * 64 + n; const unsigned k = (f2ord(S[row * SP + nn]) & ~127u) | (unsigned)(127 - nn); ins16(L16, k); }
      unsigned oth[16];
#pragma unroll
      for (int j = 0; j < 16; ++j) oth[j] = __shfl_xor(L16[j], 1);
#pragma unroll
      for (int j = 0; j < 16; ++j) ins16(L16, part == 0 ? oth[j] : 0u);
      if (part == 0) {
#pragma unroll
          for (int j = 0; j < 16; ++j) L[row * 16 + j] = L16[j]; } }
    __syncthreads();
    if (tid < 128) {
        const int pair = tid; const LAS float* S1 = S + (pair * 2) * SP; const LAS float* S2 = S + (pair * 2 + 1) * SP;
        const LAS unsigned* L1 = L + (pair * 2) * 16; const LAS unsigned* L2 = L1 + 16;
        float v1[16], v2[16];
#pragma unroll
        for (int j = 0; j < 16; ++j) { v1[j] = S1[127 - (L1[j] & 127u)]; v2[j] = S2[127 - (L2[j] & 127u)]; }
        unsigned C16[16];
#pragma unroll
        for (int j = 0; j < 16; ++j) C16[j] = 0u;
#pragma unroll
        for (int i = 0; i < 16; ++i)
#pragma unroll
            for (int j = 0; j < 16; ++j) if ((i + 1) * (j + 1) <= 16) { const unsigned k = (f2ord(v1[i] + v2[j]) & ~255u) | (unsigned)(255 - (i * 16 + j)); ins16(C16, k); }
        float sc[16]; unsigned ex[16]; float mx = -3.0e38f;
#pragma unroll
        for (int q = 0; q < 16; ++q) { const unsigned ci = 255u - (C16[q] & 255u); const unsigned n1 = 127u - (L1[ci >> 4] & 127u), n2 = 127u - (L2[ci & 15u] & 127u);
            sc[q] = S1[n1] + S2[n2]; ex[q] = n1 * 128u + n2; mx = fmaxf(mx, sc[q]); }
        float sum = 0.f;
#pragma unroll
        for (int q = 0; q < 16; ++q) { sc[q] = __expf(sc[q] - mx); sum += sc[q]; }
        const float inv = 1.f / sum;
        const size_t o = (size_t)(tok0 + (pair >> 3)) * 128 + (pair & 7) * 16;
        u32x4 e0, e1; e0.x = ex[0] | (ex[1] << 16); e0.y = ex[2] | (ex[3] << 16); e0.z = ex[4] | (ex[5] << 16); e0.w = ex[6] | (ex[7] << 16);
        e1.x = ex[8] | (ex[9] << 16); e1.y = ex[10] | (ex[11] << 16); e1.z = ex[12] | (ex[13] << 16); e1.w = ex[14] | (ex[15] << 16);
        *(u32x4*)(E16 + o) = e0; *(u32x4*)(E16 + o + 8) = e1;
#pragma unroll
        for (int q = 0; q < 4; ++q) *(f32x4*)(GT + o + 4 * q) = (f32x4){sc[4 * q] * inv, sc[4 * q + 1] * inv, sc[4 * q + 2] * inv, sc[4 * q + 3] * inv};
    }
    if (m1 >= 0) tab_finish(T, R, m1, lane);
    __syncthreads();
}

__device__ __forceinline__ void udot_compute(const u32x4 (&d)[16], const u32x4 h0, const u32x4 h1, float* dst, int k, bool ok) {
    f32x2 hq[8];
    hq[0] = (f32x2){bflo(h0.x), bfhi(h0.x)}; hq[1] = (f32x2){bflo(h0.y), bfhi(h0.y)}; hq[2] = (f32x2){bflo(h0.z), bfhi(h0.z)}; hq[3] = (f32x2){bflo(h0.w), bfhi(h0.w)};
    hq[4] = (f32x2){bflo(h1.x), bfhi(h1.x)}; hq[5] = (f32x2){bflo(h1.y), bfhi(h1.y)}; hq[6] = (f32x2){bflo(h1.z), bfhi(h1.z)}; hq[7] = (f32x2){bflo(h1.w), bfhi(h1.w)};
    float keep0 = 0.f, keep1 = 0.f;
#pragma unroll
    for (int i = 0; i < 16; ++i) {
        f32x2 a0 = {0.f, 0.f}, a1 = {0.f, 0.f};
        fp8dot4(d[i].x, hq[0], hq[1], a0, a1); fp8dot4(d[i].y, hq[2], hq[3], a0, a1); fp8dot4(d[i].z, hq[4], hq[5], a0, a1); fp8dot4(d[i].w, hq[6], hq[7], a0, a1);
        const float pr = dpp_sum8((a0.x + a0.y) + (a1.x + a1.y));
        if ((i & 7) == k) { if (i < 8) keep0 = pr; else keep1 = pr; }
    }
    if (ok) { dst[0] = keep0; dst[8] = keep1; }
}
__device__ __forceinline__ void udots(const Frame& F, const bf16_t* HN, const unsigned char* UB, const unsigned short* E16, float* PART) {
    const int lane = F.lane, g = lane >> 3, k = lane & 7;
    const int ngr = (F.G % 8 == 0) ? 8 : 1, wpg = F.G / ngr, x = F.vcu / wpg, wl = (F.vcu % wpg) * NWAVES + F.wave, wst = wpg * NWAVES, spg = NSL / ngr;
    const int ntw = (NTOK - wl + wst - 1) / wst;
#define UD_T(j) ((size_t)((wl + (j) * wst) < NTOK ? (wl + (j) * wst) : (NTOK - 1)))
#define UD_IDS(j, V0, V1) { const unsigned short* ep_ = E16 + UD_T(j) * 128 + g * 16; V0 = *(const u32x4*)ep_; V1 = *(const u32x4*)(ep_ + 8); }
#define UD_HN(j, H0, H1) { const bf16_t* hp_ = HN + UD_T(j) * DM + s * SLW + k * 16; H0 = *(const u32x4*)hp_; H1 = *(const u32x4*)(hp_ + 8); }
#define UD_ROWS(D, V0, V1) { _Pragma("unroll") for (int i = 0; i < 16; ++i) D[i] = *(const u32x4*)(ub + (size_t)PEER_EID(V0, V1, i) * DM); }
    for (int rr = 0; rr < spg; ++rr) {
        const int s = x + ngr * rr;
        const unsigned char* ub = UB + s * SLW + k * 16;
        float* pb = PART + (size_t)s * NTOK * 128 + g * 16 + k;
        u32x4 dA[16], dB[16], idA0, idA1, idB0, idB1, hA0, hA1, hB0, hB1;
        UD_IDS(0, idA0, idA1) UD_HN(0, hA0, hA1) UD_ROWS(dA, idA0, idA1)
        UD_IDS(1, idB0, idB1) UD_HN(1, hB0, hB1)
        for (int j = 0; j < ntw; j += 2) {
            UD_ROWS(dB, idB0, idB1)
            UD_IDS(j + 2, idA0, idA1)
            udot_compute(dA, hA0, hA1, pb + UD_T(j) * 128, k, true);
            UD_HN(j + 2, hA0, hA1)
            UD_ROWS(dA, idA0, idA1)
            UD_IDS(j + 3, idB0, idB1)
            udot_compute(dB, hB0, hB1, pb + UD_T(j + 1) * 128, k, j + 1 < ntw);
            UD_HN(j + 3, hB0, hB1)
        }
    }
#undef UD_IDS
#undef UD_HN
#undef UD_ROWS
}
__device__ __forceinline__ void combine(const Frame& F, const float* PART, const unsigned short* E16, const float* GT, const float* RSU, const float* RSV, float* AT) {
    const size_t n4 = (size_t)NTOK * 128 / 4, stride = (size_t)F.G * NWAVES * 64;
    for (size_t i = (size_t)F.vcu * NWAVES * 64 + F.tid; i < n4; i += stride) {
        f32x4 pv[NSL];
#pragma unroll
        for (int s = 0; s < NSL; ++s) pv[s] = *(const f32x4*)(PART + (size_t)s * n4 * 4 + i * 4);
        const u32x2 ee = *(const u32x2*)(E16 + i * 4); const f32x4 gg = *(const f32x4*)(GT + i * 4);
        const unsigned e0 = ee.x & 0xffffu, e1 = ee.x >> 16, e2 = ee.y & 0xffffu, e3 = ee.y >> 16;
        const float su0 = RSU[e0], su1 = RSU[e1], su2 = RSU[e2], su3 = RSU[e3], sv0 = RSV[e0], sv1 = RSV[e1], sv2 = RSV[e2], sv3 = RSV[e3];
        f32x4 sacc = pv[0];
#pragma unroll
        for (int s = 1; s < NSL; ++s) sacc += pv[s];
        f32x4 o; o.x = gg.x * gelu_erf(sacc.x * su0) * sv0; o.y = gg.y * gelu_erf(sacc.y * su1) * sv1; o.z = gg.z * gelu_erf(sacc.z * su2) * sv2; o.w = gg.w * gelu_erf(sacc.w * su3) * sv3;
        *(f32x4*)(AT + i * 4) = o;
    }
}
__device__ __forceinline__ void vacc_compute(const u32x4 (&d)[16], const f32x4 a0, const f32x4 a1, const f32x4 a2, const f32x4 a3, float* orow, int g, bool ok) {
    f32x2 acc[8];
#pragma unroll
    for (int c = 0; c < 8; ++c) acc[c] = (f32x2){0.f, 0.f};
    const float av[16] = {a0.x, a0.y, a0.z, a0.w, a1.x, a1.y, a1.z, a1.w, a2.x, a2.y, a2.z, a2.w, a3.x, a3.y, a3.z, a3.w};
#pragma unroll
    for (int i = 0; i < 16; ++i) { const f32x2 aa = {av[i], av[i]};
        fp8axpy4(d[i].x, aa, acc[0], acc[1]); fp8axpy4(d[i].y, aa, acc[2], acc[3]); fp8axpy4(d[i].z, aa, acc[4], acc[5]); fp8axpy4(d[i].w, aa, acc[6], acc[7]); }
    float v[16];
#pragma unroll
    for (int c = 0; c < 8; ++c) { v[2 * c] = acc[c].x; v[2 * c + 1] = acc[c].y; }
    float R[8], S4[4];
#pragma unroll
    for (int c = 0; c < 8; ++c) { auto r = __builtin_amdgcn_permlane32_swap(__float_as_uint(v[c]), __float_as_uint(v[c + 8]), false, false); R[c] = __uint_as_float(r[0]) + __uint_as_float(r[1]); }
#pragma unroll
    for (int c = 0; c < 4; ++c) { auto r = __builtin_amdgcn_permlane16_swap(__float_as_uint(R[c]), __float_as_uint(R[c + 4]), false, false); S4[c] = __uint_as_float(r[0]) + __uint_as_float(r[1]); }
    const bool b8 = (g & 1) != 0;
    float T0, T1;
    { const float keep = b8 ? S4[2] : S4[0], send = b8 ? S4[0] : S4[2]; T0 = keep + __int_as_float(__builtin_amdgcn_update_dpp(0, __float_as_int(send), 0x128, 0xF, 0xF, true)); }
    { const float keep = b8 ? S4[3] : S4[1], send = b8 ? S4[1] : S4[3]; T1 = keep + __int_as_float(__builtin_amdgcn_update_dpp(0, __float_as_int(send), 0x128, 0xF, 0xF, true)); }
    if (ok) { f32x2 o2 = *(const f32x2*)orow; o2.x += T0; o2.y += T1; *(f32x2*)orow = o2; }
}
__device__ __forceinline__ void vacc(const Frame& F, const unsigned char* VB, const unsigned short* E16, const float* AT, float* out) {
    const int lane = F.lane, g = lane >> 3, k = lane & 7;
    const int ngr = (F.G % 8 == 0) ? 8 : 1, wpg = F.G / ngr, x = F.vcu / wpg, wl = (F.vcu % wpg) * NWAVES + F.wave, wst = wpg * NWAVES, spg = NSL / ngr;
    const int ntw = (NTOK - wl + wst - 1) / wst;
#define UD_IDS(j, V0, V1) { const unsigned short* ep_ = E16 + UD_T(j) * 128 + g * 16; V0 = *(const u32x4*)ep_; V1 = *(const u32x4*)(ep_ + 8); }
#define VA_A(j, A0, A1, A2, A3) { const float* ap_ = AT + UD_T(j) * 128 + g * 16; A0 = *(const f32x4*)ap_; A1 = *(const f32x4*)(ap_ + 4); A2 = *(const f32x4*)(ap_ + 8); A3 = *(const f32x4*)(ap_ + 12); }
#define UD_ROWS(D, V0, V1) { _Pragma("unroll") for (int i = 0; i < 16; ++i) D[i] = *(const u32x4*)(vb + (size_t)PEER_EID(V0, V1, i) * DM); }
    for (int rr = 0; rr < spg; ++rr) {
        const int s = x + ngr * rr;
        const unsigned char* vb = VB + s * SLW + k * 16;
        float* ob = out + s * SLW + k * 16 + 2 * g;
        u32x4 dA[16], dB[16], idA0, idA1, idB0, idB1; f32x4 aA0, aA1, aA2, aA3, aB0, aB1, aB2, aB3;
        UD_IDS(0, idA0, idA1) VA_A(0, aA0, aA1, aA2, aA3) UD_ROWS(dA, idA0, idA1)
        UD_IDS(1, idB0, idB1) VA_A(1, aB0, aB1, aB2, aB3)
        for (int j = 0; j < ntw; j += 2) {
            UD_ROWS(dB, idB0, idB1)
            UD_IDS(j + 2, idA0, idA1)
            vacc_compute(dA, aA0, aA1, aA2, aA3, ob + UD_T(j) * DM, g, true);
            VA_A(j + 2, aA0, aA1, aA2, aA3)
            UD_ROWS(dA, idA0, idA1)
            UD_IDS(j + 3, idB0, idB1)
            vacc_compute(dB, aB0, aB1, aB2, aB3, ob + UD_T(j + 1) * DM, g, j + 1 < ntw);
            VA_A(j + 3, aB0, aB1, aB2, aB3)
        }
    }
#undef UD_T
#undef UD_IDS
#undef VA_A
#undef UD_ROWS
}
}

__device__ __forceinline__ void pool_unit(const Frame& F, bf16_t* MIX, const bf16_t* PWt, const float* pool_s, int tm, int g) {
    const int lane = F.lane, r = lane & 31, hi = lane >> 5;
    bf16_t* base = MIX + (size_t)(tm * 256 + F.wave * 32) * DM + 1024 + 128 * g;
    bf16x8 A[8];
#pragma unroll
    for (int ks = 0; ks < 8; ++ks) A[ks] = *(const bf16x8*)(base + (size_t)r * DM + ks * 16 + 8 * hi);
#pragma unroll
    for (int ct = 0; ct < 4; ++ct) {
        f32x16 acc = f32x16{};
        const bf16_t* pb = PWt + (size_t)(g * 128 + ct * 32 + r) * 128 + 8 * hi;
#pragma unroll
        for (int ks = 0; ks < 8; ++ks) { const bf16x8 B = *(const bf16x8*)(pb + ks * 16); acc = __builtin_amdgcn_mfma_f32_32x32x16_bf16(A[ks], B, acc, 0, 0, 0); }
        const float sc = pool_s[128 * g + ct * 32 + r];
#pragma unroll
        for (int i = 0; i < 16; ++i) { const int row = (i & 3) + 8 * (i >> 2) + 4 * hi; base[(size_t)row * DM + ct * 32 + r] = (bf16_t)(cvtpk(acc[i] * sc, 0.f) & 0xffffu); }
    }
}

__global__ void __launch_bounds__(NWAVES * 64, 2) fwd_kernel(Args args) {
    extern __shared__ __attribute__((aligned(16))) unsigned char lds[];
    Frame F;
    F.lds = (LAS unsigned char*)lds; F.ldsg = (char*)lds;
    F.tid = threadIdx.x; F.lane = F.tid & 63; F.wave = __builtin_amdgcn_readfirstlane(F.tid >> 6);
    F.G = gridDim.x; { const int bx = blockIdx.x; F.vcu = (F.G % 8 == 0) ? (bx % 8) * (F.G / 8) + bx / 8 : bx; }
    unsigned char* ws = args.ws;
    unsigned* ctl = (unsigned*)(ws + WS_CTL);
    volatile LAS unsigned* MISC = (volatile LAS unsigned*)(F.lds + MISC_OFF);
    for (int u = F.tid; u < (LDS_BYTES - LDSCTL_OFF) / 4; u += NWAVES * 64) ((LAS unsigned*)(F.lds + LDSCTL_OFF))[u] = 0u;
    __syncthreads();
    const int lo = args.ph_lo, hi = args.ph_hi;
    XcdBarrier bar; bar.bar = ctl + CW_BAR; bar.x = 0; bar.st = nullptr;
    if (hi - lo > 1) bar = xcd_barrier_post(ctl + CW_BAR, MISC + 8);
#define IN(k) (lo <= (k) && (k) < hi)
#define PHASE_BEGIN() do { int t_ = (int)threadIdx.x; asm volatile("" : "+v"(t_)); F.tid = t_; F.lane = t_ & 63; } while (0)
#define SEAM(k) do { if (IN(k) && IN((k) + 1)) xcd_barrier(bar); } while (0)

    bf16_t* Z = (bf16_t*)(ws + WS_Z); bf16_t* XN = (bf16_t*)(ws + WS_XN); bf16_t* MIX = XN;
    bf16_t* HN = (bf16_t*)(ws + WS_Z); bf16_t* PQ = (bf16_t*)(ws + WS_Z + 128 * MiB);
    bf16_t* KVM = (bf16_t*)(ws + WS_KVM); unsigned* MASK = (unsigned*)(ws + WS_MASK);

    if (IN(0)) { PHASE_BEGIN(); p0_prologue(F, args); } SEAM(0);
    if (IN(1)) { PHASE_BEGIN();
        { pg8::Gemm g{XN, (const bf16_t*)(ws + WS_BT_IN), NTOK, ZLD, DM}; pg8::StaticOrder S; S.init(NTOK, ZLD, F.G, (int)blockIdx.x);
          pg8::EpiBf16 E{Z, ZLD}; pg8::gemm_phase<pg8::EpiBf16, pg8::StaticOrder, true, true>(F.lds, g, S, E); }
        { pg8::Gemm g{(const bf16_t*)(ws + WS_MN), (const bf16_t*)(ws + WS_BT_KV), BATCH * MEMLEN, 1024, DM}; pg8::StaticOrder S; S.init(BATCH * MEMLEN, 1024, F.G, (int)((blockIdx.x + 128) % F.G));
          pg8::EpiBf16 E{KVM, 1024}; pg8::gemm_phase<pg8::EpiBf16, pg8::StaticOrder, true, true>(F.lds, g, S, E); }
    } SEAM(1);
    if (IN(2)) { PHASE_BEGIN(); p2_post(F, args); } SEAM(2);
    if (IN(3)) { PHASE_BEGIN();
        for (int i = 0; ; ++i) {
            int b, c;
            if (F.G == 256) { if (i >= 2) break; b = F.vcu >> 7; c = (i == 0) ? 255 - (F.vcu & 127) : (F.vcu & 127); }
            else { const int u = (int)blockIdx.x + i * F.G; if (u >= 512) break; b = u >> 8; c = u & 255; }
            ix::unit(F, Z, MASK, (unsigned long long*)(ws + WS_CAND) + (size_t)blockIdx.x * 64 * ix::CAPB, ctl + 2048, b, c);
            __syncthreads();
        }
    } SEAM(3);
    if (IN(4)) { PHASE_BEGIN();
        for (int u = F.vcu; u < (NTOK / 256) * 4; u += F.G) pool_unit(F, MIX, (const bf16_t*)(ws + WS_PWT), args.pool_s, u >> 2, u & 3);
        const int r32 = F.lane & 31;
        for (int i = 0; ; ++i) {
            int b, h, qb;
            if (F.G == 256) { if (i >= 4) break; const int bh = F.vcu >> 4, s = F.vcu & 15; b = bh >> 3; h = bh & 7; qb = (i == 0) ? 63 - s : (i == 1) ? 32 + s : (i == 2) ? 31 - s : s; }
            else { const int u = (int)blockIdx.x + i * F.G; if (u >= 1024) break; b = u >> 9; h = (u >> 6) & 7; qb = u & 63; }
            const size_t row0 = (size_t)b * SEQ + 256 * qb;
            const unsigned long long* mrow = (const unsigned long long*)MASK + (row0 + F.wave * 32 + r32) * (MASK_WPR / 2);
            att::attn_body<true, 2, ZLD, ZLD, DM>(Z + row0 * ZLD + ZC_Q + h * 128, Z + (size_t)b * SEQ * ZLD + ZC_K + h * 128, Z + (size_t)b * SEQ * ZLD + ZC_V + h * 128,
                                                  MIX + row0 * DM + h * 128, 256 * (qb + 1), mrow, F.ldsg);
        }
        for (int id = F.vcu; id < 512; id += F.G) {
            const int b2 = id >> 8, hm = (id >> 6) & 3, qb = id & 63; const size_t row0 = (size_t)b2 * SEQ + 256 * qb;
            att::attn_body<false, 1, ZLD, 1024, DM>(Z + row0 * ZLD + ZC_QM + hm * 128, KVM + (size_t)b2 * MEMLEN * 1024 + hm * 128, KVM + (size_t)b2 * MEMLEN * 1024 + 512 + hm * 128,
                                                    MIX + row0 * DM + 1536 + hm * 128, MEMLEN, nullptr, F.ldsg);
        }
    } SEAM(4);
    if (IN(5)) { PHASE_BEGIN();
#if ATT_VERIFY
        {
            const int t = (int)blockIdx.x * 128 + 77, hh = F.wave, ln = F.lane; const int bb = t / SEQ, pos = t % SEQ, N = 64 * (pos / 64 + 1);
            const bf16_t* zq = Z + (size_t)t * ZLD + ZC_Q + hh * 128 + 2 * ln; const float q0 = bflo((unsigned)zq[0]), q1 = bflo((unsigned)zq[1]);
            float m = -3.0e38f, l = 0.f, o0 = 0.f, o1 = 0.f; int nsel = 0;
            for (int w = 0; w < N / 32; ++w) { unsigned bits = __hip_atomic_load(MASK + (size_t)t * MASK_WPR + w, __ATOMIC_RELAXED, __HIP_MEMORY_SCOPE_AGENT);
                while (bits) { const int bpos = __builtin_ctz(bits); bits &= bits - 1u; const int sidx = 32 * w + bpos; ++nsel;
                    const bf16_t* zk = Z + ((size_t)bb * SEQ + sidx) * ZLD + ZC_K + hh * 128 + 2 * ln; const bf16_t* zv = Z + ((size_t)bb * SEQ + sidx) * ZLD + ZC_V + hh * 128 + 2 * ln;
                    const float lg = wave_sum(q0 * bflo((unsigned)zk[0]) + q1 * bflo((unsigned)zk[1])) * 0.088388347648318440f;
                    const float mn = fmaxf(m, lg), al = __expf(m - mn), pe = __expf(lg - mn); l = l * al + pe; o0 = o0 * al + pe * bflo((unsigned)zv[0]); o1 = o1 * al + pe * bflo((unsigned)zv[1]); m = mn; } }
            const bf16_t* mx = MIX + (size_t)t * DM + hh * 128 + 2 * ln; const float r0 = o0 / l, r1 = o1 / l;
            float er = fmaxf(fabsf(r0 - bflo((unsigned)mx[0])), fabsf(r1 - bflo((unsigned)mx[1]))), sc = fmaxf(fabsf(r0), fabsf(r1));
#pragma unroll
            for (int o = 1; o < 64; o <<= 1) { er = fmaxf(er, __shfl_xor(er, o)); sc = fmaxf(sc, __shfl_xor(sc, o)); }
            if (!(er <= 0.03f * sc + 1e-3f) || nsel != (N < 256 ? N : 256)) { if (ln == 0) atomicOr(ctl + 2048, 2u); }
        }
        __syncthreads();
#endif
        pg8::Gemm g{MIX, (const bf16_t*)(ws + WS_BT_OUT), NTOK, DM, DM}; pg8::StaticOrder S; S.init(NTOK, DM, F.G, (int)blockIdx.x);
        pg8::EpiF32Res E{args.x, args.out, DM}; pg8::gemm_phase<pg8::EpiF32Res, pg8::StaticOrder, true, true>(F.lds, g, S, E);
    } SEAM(5);
    if (IN(6)) { PHASE_BEGIN(); const int gw = F.vcu * NWAVES + F.wave, NGW = F.G * NWAVES;
        for (int m = gw; m < NTOK; m += NGW) rms_row_to_bf16(args.out + (size_t)m * DM, args.ffn_g, HN + (size_t)m * DM, F.lane);
    } SEAM(6);
    if (IN(7)) { PHASE_BEGIN();
        pg8::Gemm g{HN, (const bf16_t*)(ws + WS_BT_Q), NTOK, DM, DM}; pg8::StaticOrder S; S.init(NTOK, DM, F.G, (int)blockIdx.x);
        pg8::EpiBf16 E{PQ, DM}; pg8::gemm_phase<pg8::EpiBf16, pg8::StaticOrder, true, true>(F.lds, g, S, E);
    } SEAM(7);
    unsigned short* E16 = (unsigned short*)(ws + WS_XN); float* GT = (float*)(ws + WS_XN + 8 * MiB); float* AT = (float*)(ws + WS_XN + 24 * MiB);
    float* PART = (float*)(ws + WS_Z + 128 * MiB);
    if (IN(8)) { PHASE_BEGIN();
        const bf16_t* PKb = (const bf16_t*)(ws + WS_PK);
        bf16x8 Bf[2][8];
        { const int half = F.wave & 1, cp = (F.wave >> 1) & 1, r = F.lane & 31, hi = F.lane >> 5;
#pragma unroll
          for (int c2 = 0; c2 < 2; ++c2)
#pragma unroll
              for (int ks = 0; ks < 8; ++ks) Bf[c2][ks] = *(const bf16x8*)(PKb + (size_t)(half * 128 + (2 * cp + c2) * 32 + r) * 128 + 8 * hi + ks * 16); }
        const peer::TabCvt T{args.pu, args.pv, ws + WS_UB, ws + WS_VB, (float*)(ws + WS_RSU), (float*)(ws + WS_RSV)};
        const int gw = F.vcu * NWAVES + F.wave, NGW = F.G * NWAVES; int mrow = gw, nstep = 0;
        for (int it = F.vcu; it < NTOK / peer::TT; it += F.G, ++nstep) {
            const int m0 = mrow < 2 * NEXP ? mrow : -1; mrow += NGW; const int m1 = mrow < 2 * NEXP ? mrow : -1; mrow += NGW;
            peer::route_step(F, PQ, Bf, E16, GT, it * peer::TT, T, m0, m1);
        }
        for (; mrow < 2 * NEXP; mrow += NGW) { RowF32 R; row_load(R, peer::tab_src(T, mrow), F.lane); peer::tab_finish(T, R, mrow, F.lane); }
    } SEAM(8);
    if (IN(9)) { PHASE_BEGIN(); peer::udots(F, HN, ws + WS_UB, E16, PART); } SEAM(9);
    if (IN(10)) { PHASE_BEGIN(); peer::combine(F, PART, E16, GT, (const float*)(ws + WS_RSU), (const float*)(ws + WS_RSV), AT); } SEAM(10);
    if (IN(11)) { PHASE_BEGIN(); peer::vacc(F, ws + WS_VB, E16, AT, args.out); }
#if IX_VERIFY || ATT_VERIFY
    if (IN(11)) { __syncthreads(); if (__hip_atomic_load(ctl + 2048, __ATOMIC_RELAXED, __HIP_MEMORY_SCOPE_AGENT) != 0u) { args.out[(size_t)blockIdx.x * 512 + threadIdx.x] = __builtin_nanf(""); } }
#endif
#undef IN
#undef SEAM
}

extern "C" void kernel_launch(void* const* d_in, const int* in_sizes, int n_in, void* d_out, int out_size, void* d_ws, size_t ws_size, hipStream_t stream) {
    static int grid = 0;
    if (grid == 0) {
        if (n_in != 19 || out_size != NTOK * DM || ws_size < WS_END) { fprintf(stderr, "kernel_launch: unexpected shapes (n_in %d out %d ws %zu)\n", n_in, out_size, ws_size); grid = -1; return; }
        int dev = 0, cus = 0;
        if (hipGetDevice(&dev) != hipSuccess || hipDeviceGetAttribute(&cus, hipDeviceAttributeMultiprocessorCount, dev) != hipSuccess) { grid = -1; return; }
        if (hipFuncSetAttribute((const void*)fwd_kernel, hipFuncAttributeMaxDynamicSharedMemorySize, LDS_BYTES) != hipSuccess) { fprintf(stderr, "kernel_launch: hipFuncSetAttribute failed\n"); grid = -1; return; }
        int per_cu = 0;
        if (hipOccupancyMaxActiveBlocksPerMultiprocessor(&per_cu, (const void*)fwd_kernel, NWAVES * 64, LDS_BYTES) != hipSuccess || per_cu < 1) { fprintf(stderr, "kernel_launch: occupancy query reports %d workgroups per CU for %d threads / %d B LDS; nothing launched\n", per_cu, NWAVES * 64, LDS_BYTES); grid = -1; return; }
        (void)hipGetLastError();
        grid = cus;
    }
    if (grid < 0) return;
    (void)hipMemsetAsync((char*)d_ws + WS_CTL, 0, CTL_ZERO_BYTES, stream);
    Args a{};
    a.x = (const float*)d_in[0]; a.mem = (const float*)d_in[1]; a.attn_g = (const float*)d_in[2]; a.w_in = (const float*)d_in[3]; a.q_g = (const float*)d_in[4]; a.k_g = (const float*)d_in[5];
    a.pool_w = (const float*)d_in[6]; a.pool_s = (const float*)d_in[7]; a.mem_g = (const float*)d_in[8]; a.w_kv = (const float*)d_in[9]; a.mq_g = (const float*)d_in[10]; a.mk_g = (const float*)d_in[11];
    a.w_out = (const float*)d_in[12]; a.ffn_g = (const float*)d_in[13]; a.w_q = (const float*)d_in[14]; a.sk1 = (const float*)d_in[15]; a.sk2 = (const float*)d_in[16];
    a.pu = (const float*)d_in[17]; a.pv = (const float*)d_in[18]; a.out = (float*)d_out; a.ws = (unsigned char*)d_ws;
#if MK_ONE_LAUNCH
    a.ph_lo = 0; a.ph_hi = N_PHASES;
    hipLaunchKernelGGL(fwd_kernel, dim3(grid), dim3(NWAVES * 64), LDS_BYTES, stream, a);
#else
    for (int p = 0; p < N_PHASES; ++p) { a.ph_lo = p; a.ph_hi = p + 1; hipLaunchKernelGGL(fwd_kernel, dim3(grid), dim3(NWAVES * 64), LDS_BYTES, stream, a); }
#endif
}
```

```cpp
#include <hip/hip_runtime.h>
#include <hip/hip_bf16.h>
#include <cstdio>
#include <cstdint>

#ifndef IX_VERIFY
#define IX_VERIFY 0
#endif
#ifndef ATT_VERIFY
#define ATT_VERIFY 0
#endif
#ifndef MK_ONE_LAUNCH
#define MK_ONE_LAUNCH 1
#endif
#ifndef P1_FP8
#define P1_FP8 1
#endif
#ifndef P7_FP8
#define P7_FP8 0
#endif

#define GAS __attribute__((address_space(1)))
#define LAS __attribute__((address_space(3)))
typedef unsigned short bf16_t;
typedef short bf16x8 __attribute__((ext_vector_type(8)));
typedef short s16x4 __attribute__((ext_vector_type(4)));
typedef float f32x4 __attribute__((ext_vector_type(4)));
typedef float f32x2 __attribute__((ext_vector_type(2)));
typedef float f32x16 __attribute__((ext_vector_type(16)));
typedef unsigned u32x4 __attribute__((ext_vector_type(4)));
typedef unsigned u32x2 __attribute__((ext_vector_type(2)));
typedef __bf16 bf16x2_t __attribute__((ext_vector_type(2)));
typedef int i32x8 __attribute__((ext_vector_type(8)));
typedef int i32x4 __attribute__((ext_vector_type(4)));

constexpr int BATCH = 2, SEQ = 16384, DM = 2048, NTOK = BATCH * SEQ, MEMLEN = 256;
constexpr int IN_W = 5200, ZLD = 5376;
constexpr int ZC_Q = 0, ZC_K = 1024, ZC_V = 2048, ZC_QI = 3072, ZC_PU = 4096, ZC_QM = 4608, ZC_KI = 5120, ZC_WI = 5184;
constexpr int NEXP = 16384;
constexpr float EPS = 1e-6f;
constexpr int MASK_WPR = 512;

constexpr size_t MiB = 1u << 20;
constexpr size_t WS_CTL = 0, CTL_ZERO_BYTES = 1 * MiB;
constexpr size_t WS_BT_IN = 2 * MiB;
constexpr size_t WS_BT_OUT = 24 * MiB;
constexpr size_t WS_BT_Q = 32 * MiB;
constexpr size_t WS_BT_KV = 40 * MiB;
constexpr size_t WS_MN = 44 * MiB;
constexpr size_t WS_KVM = 46 * MiB;
constexpr size_t WS_PK = 47 * MiB;
constexpr size_t WS_PWT = 47 * MiB + 512 * 1024;
constexpr size_t WS_XN = 48 * MiB;
constexpr size_t WS_Z = 176 * MiB;
constexpr size_t WS_MASK = 512 * MiB;
constexpr size_t WS_UB = 576 * MiB;
constexpr size_t WS_VB = 640 * MiB;
constexpr size_t WS_RSU = 47 * MiB + 128 * 1024, WS_RSV = 47 * MiB + 256 * 1024;
constexpr size_t WS_ROPE = 704 * MiB;
constexpr size_t WS_CAND = 720 * MiB;
constexpr size_t WS_XN8 = WS_CAND, WS_BTIN8 = WS_CAND + 72 * MiB, WS_CSI = WS_CAND + 84 * MiB;
constexpr size_t WS_HN8 = WS_CAND, WS_BTQ8 = WS_CAND + 64 * MiB, WS_CSQ = WS_CAND + 68 * MiB;
constexpr size_t WS_END = 848 * MiB;
constexpr int CW_BAR = 4096;

#define LDS_WAIT() asm volatile("s_waitcnt lgkmcnt(0)" ::: "memory")
#define VM_WAIT() asm volatile("s_waitcnt vmcnt(0)" ::: "memory")
__device__ __forceinline__ unsigned cvtpk(float lo, float hi) { f32x2 v = {lo, hi}; bf16x2_t b = __builtin_convertvector(v, bf16x2_t); return __builtin_bit_cast(unsigned, b); }
__device__ __forceinline__ float bflo(unsigned w) { return __uint_as_float(w << 16); }
__device__ __forceinline__ float bfhi(unsigned w) { return __uint_as_float(w & 0xffff0000u); }
__device__ __forceinline__ float wave_sum(float v) {
#pragma unroll
    for (int o = 1; o < 64; o <<= 1) v += __shfl_xor(v, o);
    return v;
}
__device__ __forceinline__ unsigned f2ord(float s) { unsigned u = __float_as_uint(s); return u ^ (((unsigned)((int)u >> 31)) | 0x80000000u); }

namespace pg8 {
#define PG8_LAS __attribute__((address_space(3)))
constexpr int BM = 256, BK = 64, HALF = 128, HTB = HALF * BK * 2, STAGE_BYTES = 8 * HTB, NXCD = 8, WGM = 8;
__host__ __device__ __forceinline__ int lds_byte(int r, int c) { const int st = (r >> 4) * 2 + (c >> 5), rr = r & 15, cc = c & 31, ob = rr * 64 + cc * 2; return st * 1024 + (ob ^ (((ob >> 9) & 1) << 5)); }
__host__ __device__ __forceinline__ void stage_rc(int b, int& R, int& C) { const int st = b / 1024, sb = b % 1024, swz = sb ^ (((sb >> 9) & 1) << 5); R = (st >> 1) * 16 + swz / 64; C = (st & 1) * 32 + (swz % 64) / 2; }
__host__ __device__ __forceinline__ int perm32(int rho) { const int n = rho >> 4, i = rho & 15; return 8 * (i >> 2) + 4 * n + (i & 3); }
struct Unit { int pm, pn; };
struct Gemm { const bf16_t* A; const bf16_t* Bt; int M, N, K; };
struct StaticOrder {
    int nM, nN, nwg, G, c;
    __host__ __device__ void init(int M, int N, int G_, int c_) { nM = M / BM; nN = N / BM; nwg = nM * nN; G = G_; c = c_; }
    __host__ __device__ bool next(int i, Unit& u) const {
        const long L = (long)i * G + c; if (L >= nwg) return false;
        int wgid = (int)L; { const int q = nwg / NXCD, r = nwg % NXCD, xcd = wgid % NXCD, off = wgid / NXCD; wgid = (xcd < r ? xcd * (q + 1) : r * (q + 1) + (xcd - r) * q) + off; }
        const int nig = WGM * nN, gid = wgid / nig, fm = gid * WGM, gsz = (nM - fm) < WGM ? (nM - fm) : WGM;
        u.pm = fm + ((wgid % nig) % gsz); u.pn = (wgid % nig) / gsz; return true;
    }
    __device__ __forceinline__ void a_ready(const Unit&) const {}
    __device__ __forceinline__ void done(const Unit&) const {}
};
struct InBf16Order {
    StaticOrder S;
    __host__ __device__ void init(int M, int G_, int c_) { S.init(M, 5 * BM, G_, c_); }
    __host__ __device__ bool next(int i, Unit& u) const { if (!S.next(i, u)) return false; u.pn = u.pn < 4 ? 12 + u.pn : 20; return true; }
    __device__ __forceinline__ void a_ready(const Unit&) const {}
    __device__ __forceinline__ void done(const Unit&) const {}
};
struct InFp8Order {
    StaticOrder S; int G, c;
    __host__ __device__ void init(int M, int G_, int c_) { S.init(M, 16 * BM, 1, 0); G = G_; c = c_; }
    __host__ __device__ bool next(int i, Unit& u) const {
        long L;
        if (G == 256 && S.nwg == 2048) {
            if (i < 7) L = (long)i * 256 + c;
            else if (c < 128) return false;
            else { const int j = i - 7; int base, cnt;
                if (c < 136) { base = (c - 128) * 1; cnt = 1; } else if (c < 144) { base = 8 + (c - 136) * 3; cnt = 3; } else { base = 32 + (c - 144) * 2; cnt = 2; }
                if (j >= cnt) return false; L = 1792 + base + j; }
        } else { L = (long)i * G + c; if (L >= S.nwg) return false; }
        if (!S.next((int)L, u)) return false;
        u.pn = u.pn < 12 ? u.pn : u.pn + 4; return true;
    }
    __device__ __forceinline__ void a_ready(const Unit&) const {}
    __device__ __forceinline__ void done(const Unit&) const {}
};
struct EpiBf16 {
    static constexpr bool PERM = true, AFTER_DRAIN = false;
    bf16_t* O; int ldc;
    __device__ __forceinline__ void operator()(const f32x4 (&acc)[2][2][4][2], const Unit& u, int wr, int wc, int fr, int fq) const {
        const int row0 = u.pm * BM + wr * 64 + fr; const int col0 = u.pn * BM + wc * 32 + 8 * fq;
#pragma unroll
        for (int ai = 0; ai < 2; ++ai)
#pragma unroll
            for (int m = 0; m < 4; ++m) { bf16_t* rowp = O + (size_t)(row0 + ai * HALF + m * 16) * ldc + col0;
#pragma unroll
                for (int bj = 0; bj < 2; ++bj) { const f32x4 v0 = acc[ai][bj][m][0], v1 = acc[ai][bj][m][1];
                    u32x4 w; w.x = cvtpk(v0[0], v0[1]); w.y = cvtpk(v0[2], v0[3]); w.z = cvtpk(v1[0], v1[1]); w.w = cvtpk(v1[2], v1[3]);
                    *(u32x4*)(rowp + bj * HALF) = w; } }
    }
};
struct EpiBf16S {
    static constexpr bool PERM = true, AFTER_DRAIN = false;
    bf16_t* O; int ldc; const float* cs;
    __device__ __forceinline__ void operator()(const f32x4 (&acc)[2][2][4][2], const Unit& u, int wr, int wc, int fr, int fq) const {
        const int row0 = u.pm * BM + wr * 64 + fr; const int col0 = u.pn * BM + wc * 32 + 8 * fq;
        f32x4 s[2][2];
#pragma unroll
        for (int bj = 0; bj < 2; ++bj) { s[bj][0] = *(const f32x4*)(cs + col0 + bj * HALF); s[bj][1] = *(const f32x4*)(cs + col0 + bj * HALF + 4); }
#pragma unroll
        for (int ai = 0; ai < 2; ++ai)
#pragma unroll
            for (int m = 0; m < 4; ++m) { bf16_t* rowp = O + (size_t)(row0 + ai * HALF + m * 16) * ldc + col0;
#pragma unroll
                for (int bj = 0; bj < 2; ++bj) { const f32x4 v0 = acc[ai][bj][m][0] * s[bj][0], v1 = acc[ai][bj][m][1] * s[bj][1];
                    u32x4 w; w.x = cvtpk(v0[0], v0[1]); w.y = cvtpk(v0[2], v0[3]); w.z = cvtpk(v1[0], v1[1]); w.w = cvtpk(v1[2], v1[3]);
                    *(u32x4*)(rowp + bj * HALF) = w; } }
    }
};
struct EpiF32Res {
    static constexpr bool PERM = false, AFTER_DRAIN = false;
    const float* R; float* C; int ldc;
    __device__ __forceinline__ void operator()(const f32x4 (&acc)[2][2][4][2], const Unit& u, int wr, int wc, int fr, int fq) const {
        const int row0 = u.pm * BM + wr * 64 + fr, col0 = u.pn * BM + wc * 32 + 4 * fq;
#pragma unroll
        for (int ai = 0; ai < 2; ++ai)
#pragma unroll
            for (int m = 0; m < 4; ++m) { const size_t off = (size_t)(row0 + ai * HALF + m * 16) * ldc + col0;
#pragma unroll
                for (int bj = 0; bj < 2; ++bj)
#pragma unroll
                    for (int n = 0; n < 2; ++n) *(f32x4*)(C + off + bj * HALF + n * 16) = acc[ai][bj][m][n] + *(const f32x4*)(R + off + bj * HALF + n * 16); }
    }
};

__device__ __forceinline__ i32x8 cat8(bf16x8 a, bf16x8 b) { const i32x4 x = __builtin_bit_cast(i32x4, a), y = __builtin_bit_cast(i32x4, b); return __builtin_shufflevector(x, y, 0, 1, 2, 3, 4, 5, 6, 7); }
template <class Epi, class Sched, bool ALIGN_EPI = false, bool SP2 = false, bool F8 = false>
__device__ __forceinline__ void gemm_phase(PG8_LAS unsigned char* lds, const Gemm g, const Sched& S, const Epi& E) {
    const int tid = threadIdx.x, wid = __builtin_amdgcn_readfirstlane(tid >> 6), lane = tid & 63, wr = wid >> 2, wc = wid & 3, fr = lane & 15, fq = lane >> 4;
    const int K = g.K, nt = K / BK;
    unsigned voffA[2], voffB[2];
#pragma unroll
    for (int i = 0; i < 2; ++i) { int R, C; stage_rc(tid * 16 + i * 8192, R, C); const int Rb = Epi::PERM ? ((R & ~31) + perm32(R & 31)) : R;
        voffA[i] = (unsigned)(R * K + C) * 2u; voffB[i] = (unsigned)(Rb * K + C) * 2u; }
    const size_t kstep = (size_t)(BK * 2);
    const size_t hstep = (size_t)HALF * K * 2;
    const size_t tstep = 2 * hstep;
    const unsigned ldsw = (unsigned)wid * 1024u;
    const int aoff_ = lds_byte(wr * 64 + fr, fq * 8), boff_ = lds_byte(wc * 32 + fr, fq * 8);
#define PG8_SA(b, h) (((b) * 2 + (h)) * HTB)
#define PG8_SB(b, h) ((4 + (b) * 2 + (h)) * HTB)
#define PG8_STAGE(bufoff, gbase, voff) do { _Pragma("unroll") for (int _i = 0; _i < 2; ++_i) \
        __builtin_amdgcn_global_load_lds((const unsigned*)((const char*)(gbase) + (voff)[_i]), (PG8_LAS unsigned*)(lds + (bufoff) + ldsw + _i * 8192), 16, 0, 0); } while (0)
#define PG8_LD1(off) (*(const PG8_LAS bf16x8*)(lds + (off)))
#define PG8_LDA(dst, b, h) do { _Pragma("unroll") for (int m = 0; m < 4; ++m) { if constexpr (F8) dst##8[m] = cat8(PG8_LD1(PG8_SA(b, h) + aoff + m * 2048), PG8_LD1(PG8_SA(b, h) + aoff + m * 2048 + 1024)); \
        else { _Pragma("unroll") for (int k = 0; k < 2; ++k) dst[m][k] = PG8_LD1(PG8_SA(b, h) + aoff + m * 2048 + k * 1024); } } } while (0)
#define PG8_LDB(dst, b, h) do { _Pragma("unroll") for (int n = 0; n < 2; ++n) { if constexpr (F8) dst##8[n] = cat8(PG8_LD1(PG8_SB(b, h) + boff + n * 2048), PG8_LD1(PG8_SB(b, h) + boff + n * 2048 + 1024)); \
        else { _Pragma("unroll") for (int k = 0; k < 2; ++k) dst[n][k] = PG8_LD1(PG8_SB(b, h) + boff + n * 2048 + k * 1024); } } } while (0)
#define PG8_MMA(ai, bj, At, Bt) do { __builtin_amdgcn_s_setprio(1); _Pragma("unroll") for (int m = 0; m < 4; ++m) _Pragma("unroll") for (int n = 0; n < 2; ++n) { \
        if constexpr (F8) asm volatile("v_mfma_f32_16x16x128_f8f6f4 %0, %1, %2, %0" : "+v"(acc[ai][bj][m][n]) : "v"(Bt##8[n]), "v"(At##8[m])); \
        else { _Pragma("unroll") for (int k = 0; k < 2; ++k) acc[ai][bj][m][n] = __builtin_amdgcn_mfma_f32_16x16x32_bf16(Bt[n][k], At[m][k], acc[ai][bj][m][n], 0, 0, 0); } } __builtin_amdgcn_s_setprio(0); } while (0)
#define PG8_WAIT_V(n) asm volatile("s_waitcnt vmcnt(" #n ")" ::: "memory")
#define PG8_WAIT_L(n) asm volatile("s_waitcnt lgkmcnt(" #n ")" ::: "memory")
#define PG8_BAR __builtin_amdgcn_s_barrier()
#define PG8_SCHED __builtin_amdgcn_sched_barrier(0)
    Unit cur, nxt; int ui = 0;
    if (!S.next(0, cur)) return;
    f32x4 acc[2][2][4][2];
#pragma unroll
    for (int a = 0; a < 2; ++a)
#pragma unroll
        for (int b = 0; b < 2; ++b)
#pragma unroll
            for (int m = 0; m < 4; ++m)
#pragma unroll
                for (int n = 0; n < 2; ++n) acc[a][b][m][n] = (f32x4){0.f, 0.f, 0.f, 0.f};
    bf16x8 At[4][2], B0[2][2], B1[2][2]; i32x8 At8[4], B08[2], B18[2];
    const char* cA = (const char*)g.A + (size_t)cur.pm * tstep; const char* cB = (const char*)g.Bt + (size_t)cur.pn * tstep;
    S.a_ready(cur);
    if constexpr (SP2) {
        PG8_STAGE(PG8_SB(0, 0), cB, voffB); PG8_STAGE(PG8_SB(0, 1), cB + hstep, voffB); PG8_STAGE(PG8_SA(0, 0), cA, voffA); PG8_STAGE(PG8_SA(0, 1), cA + hstep, voffA);
        if (wr == 1) PG8_BAR;
        PG8_WAIT_V(2); PG8_BAR;
        PG8_STAGE(PG8_SB(1, 0), cB + kstep, voffB); PG8_STAGE(PG8_SA(1, 0), cA + kstep, voffA); PG8_STAGE(PG8_SB(1, 1), cB + hstep + kstep, voffB);
        PG8_WAIT_V(6); PG8_BAR;
    } else {
        PG8_STAGE(PG8_SB(0, 0), cB, voffB); PG8_STAGE(PG8_SA(0, 0), cA, voffA); PG8_STAGE(PG8_SB(0, 1), cB + hstep, voffB); PG8_STAGE(PG8_SA(0, 1), cA + hstep, voffA);
        if (wr == 1) PG8_BAR;
        PG8_WAIT_V(4); PG8_BAR;
        PG8_STAGE(PG8_SB(1, 0), cB + kstep, voffB); PG8_STAGE(PG8_SA(1, 0), cA + kstep, voffA); PG8_STAGE(PG8_SB(1, 1), cB + hstep + kstep, voffB);
        PG8_WAIT_V(6); PG8_BAR;
    }
    for (;;) {
        const bool has_next = S.next(ui + 1, nxt);
        const char* nA = has_next ? (const char*)g.A + (size_t)nxt.pm * tstep : cA; const char* nB = has_next ? (const char*)g.Bt + (size_t)nxt.pn * tstep : cB;
        for (int t = 0; t < nt; t += 2) {
            const bool last = (t == nt - 2);
            int aoff = aoff_, boff = boff_; if constexpr (F8) asm volatile("" : "+v"(aoff), "+v"(boff));
            const char* a1 = cA + (size_t)(t + 1) * kstep;
            const char* a2 = last ? nA : cA + (size_t)(t + 2) * kstep; const char* b2 = last ? nB : cB + (size_t)(t + 2) * kstep;
            const char* a3 = a2 + kstep; const char* b3 = b2 + kstep;
            if (last && has_next) S.a_ready(nxt);
            if constexpr (SP2) {
            PG8_LDB(B0, 0, 0); PG8_LDB(B1, 0, 1); PG8_SCHED; PG8_LDA(At, 0, 0); PG8_STAGE(PG8_SA(1, 1), a1 + hstep, voffA);
            PG8_WAIT_V(8); PG8_WAIT_L(0); PG8_BAR; PG8_MMA(0, 0, At, B0); PG8_MMA(0, 1, At, B1); PG8_BAR; PG8_SCHED;
            PG8_LDA(At, 0, 1); PG8_STAGE(PG8_SB(0, 0), b2, voffB); PG8_STAGE(PG8_SB(0, 1), b2 + hstep, voffB); PG8_STAGE(PG8_SA(0, 0), a2, voffA);
            PG8_WAIT_V(8); PG8_WAIT_L(0); PG8_BAR; PG8_MMA(1, 0, At, B0); PG8_MMA(1, 1, At, B1); PG8_BAR; PG8_SCHED;
            PG8_LDB(B0, 1, 0); PG8_LDB(B1, 1, 1); PG8_SCHED; PG8_LDA(At, 1, 0); PG8_STAGE(PG8_SA(0, 1), a2 + hstep, voffA);
            PG8_WAIT_V(8); PG8_WAIT_L(0); PG8_BAR; PG8_MMA(0, 0, At, B0); PG8_MMA(0, 1, At, B1); PG8_BAR; PG8_SCHED;
            PG8_LDA(At, 1, 1); PG8_STAGE(PG8_SB(1, 0), b3, voffB); PG8_STAGE(PG8_SB(1, 1), b3 + hstep, voffB); PG8_STAGE(PG8_SA(1, 0), a3, voffA);
            PG8_WAIT_V(8); PG8_WAIT_L(0); PG8_BAR; PG8_MMA(1, 0, At, B0); PG8_MMA(1, 1, At, B1); PG8_BAR; PG8_SCHED;
            } else {
            PG8_LDB(B0, 0, 0); PG8_SCHED; PG8_LDA(At, 0, 0); PG8_STAGE(PG8_SA(1, 1), a1 + hstep, voffA);
            PG8_WAIT_L(8); PG8_BAR; PG8_WAIT_L(0); PG8_MMA(0, 0, At, B0); PG8_BAR; PG8_SCHED;
            PG8_LDB(B1, 0, 1); PG8_STAGE(PG8_SB(0, 0), b2, voffB);
            PG8_BAR; PG8_WAIT_L(0); PG8_MMA(0, 1, At, B1); PG8_BAR;
            PG8_LDA(At, 0, 1); PG8_STAGE(PG8_SA(0, 0), a2, voffA);
            PG8_BAR; PG8_WAIT_L(0); PG8_MMA(1, 0, At, B0); PG8_BAR; PG8_SCHED;
            PG8_STAGE(PG8_SB(0, 1), b2 + hstep, voffB);
            PG8_WAIT_V(6); PG8_BAR; PG8_MMA(1, 1, At, B1); PG8_BAR;
            PG8_LDB(B0, 1, 0); PG8_SCHED; PG8_LDA(At, 1, 0); PG8_STAGE(PG8_SA(0, 1), a2 + hstep, voffA);
            PG8_WAIT_L(8); PG8_BAR; PG8_WAIT_L(0); PG8_MMA(0, 0, At, B0); PG8_BAR; PG8_SCHED;
            PG8_LDB(B1, 1, 1); PG8_STAGE(PG8_SB(1, 0), b3, voffB);
            PG8_BAR; PG8_WAIT_L(0); PG8_MMA(0, 1, At, B1); PG8_BAR;
            PG8_LDA(At, 1, 1); PG8_STAGE(PG8_SA(1, 0), a3, voffA);
            PG8_BAR; PG8_WAIT_L(0); PG8_MMA(1, 0, At, B0); PG8_BAR; PG8_SCHED;
            PG8_STAGE(PG8_SB(1, 1), b3 + hstep, voffB);
            PG8_WAIT_V(6); PG8_BAR; PG8_MMA(1, 1, At, B1); PG8_BAR;
            }
        }
        if constexpr (ALIGN_EPI) { if (wr == 0) PG8_BAR; }
        if constexpr (F8) asm volatile("s_nop 15\n\ts_nop 15" ::: "memory");
        if constexpr (!Epi::AFTER_DRAIN) { E(acc, cur, wr, wc, fr, fq); S.done(cur); }
        if (!has_next) break;
#pragma unroll
        for (int a = 0; a < 2; ++a)
#pragma unroll
            for (int b = 0; b < 2; ++b)
#pragma unroll
                for (int m = 0; m < 4; ++m)
#pragma unroll
                    for (int n = 0; n < 2; ++n) acc[a][b][m][n] = (f32x4){0.f, 0.f, 0.f, 0.f};
        cur = nxt; cA = nA; cB = nB; ++ui;
        if constexpr (ALIGN_EPI) { if (wr == 1) PG8_BAR; }
    }
    PG8_WAIT_V(0);
    if constexpr (!ALIGN_EPI) { if (wr == 0) PG8_BAR; }
    PG8_BAR;
#undef PG8_SA
#undef PG8_SB
#undef PG8_STAGE
#undef PG8_LDA
#undef PG8_LD1
#undef PG8_LDB
#undef PG8_MMA
#undef PG8_WAIT_V
#undef PG8_WAIT_L
#undef PG8_BAR
#undef PG8_SCHED
}
}

namespace att {
constexpr int D = 128, NW = 8, QBLK = 32, KVBLK = 64;
constexpr float SCALE = 0.088388347648318440f;
constexpr float THR = 8.f;
constexpr size_t SHM_V = KVBLK * D * 2, SHM_K = KVBLK * D * 2, SHM_ATTN = 2 * SHM_V + 2 * SHM_K + NW * 64 * 4;
#define KSWZ(row, colB) ((row) * 256 + ((colB) ^ (((row) & 7) << 4)))
#define SBAR() __builtin_amdgcn_sched_barrier(0)
__device__ __forceinline__ int crow(int r, int hi) { return (r & 3) + 8 * (r >> 2) + 4 * hi; }
template <bool MASKED> __device__ __forceinline__ void mask_apply(f32x16& p, unsigned w) {
    if constexpr (MASKED) {
#pragma unroll
        for (int r = 0; r < 16; ++r) { const unsigned m = (unsigned)__builtin_amdgcn_sbfe((int)w, (unsigned)((r & 3) + 8 * (r >> 2)), 1u); p[r] = __uint_as_float((__float_as_uint(p[r]) & m) | (0xFF800000u & ~m)); }
    }
}
template <bool MASKED> __device__ __forceinline__ void partialSM(f32x16& p0, f32x16& p1, float& m_reg, float& mn, float& alpha, unsigned long long mk, int sh4) {
    constexpr float C = SCALE * 1.4426950408889634f;
    float pmax = p0[0];
#pragma unroll
    for (int r = 1; r < 16; ++r) pmax = fmaxf(pmax, p0[r]);
#pragma unroll
    for (int r = 0; r < 16; ++r) pmax = fmaxf(pmax, p1[r]);
    { auto rr = __builtin_amdgcn_permlane32_swap(__float_as_uint(pmax), __float_as_uint(pmax), false, false);
      pmax = fmaxf(__uint_as_float(rr[0]), __uint_as_float(rr[1])); }
    if (__builtin_expect(__all(pmax - m_reg <= THR / SCALE), 1)) { mn = m_reg; alpha = 1.f; }
    else { mn = fmaxf(m_reg, pmax); alpha = __builtin_amdgcn_exp2f((m_reg - mn) * C); m_reg = mn; }
    const float mnC = -mn * C;
#pragma unroll
    for (int r = 0; r < 16; ++r) p0[r] = fmaf(p0[r], C, mnC);
#pragma unroll
    for (int r = 0; r < 16; ++r) p1[r] = fmaf(p1[r], C, mnC);
#pragma unroll
    for (int r = 0; r < 16; ++r) p0[r] = __builtin_amdgcn_exp2f(p0[r]);
}
template <bool MASKED> __device__ __forceinline__ void finishSM(f32x16& p0, f32x16& p1, float alpha, float& l_reg, bf16x8& pa0, bf16x8& pa1, bf16x8& pa2, bf16x8& pa3, unsigned long long mk, int sh4) {
#pragma unroll
    for (int r = 0; r < 16; ++r) p1[r] = __builtin_amdgcn_exp2f(p1[r]);
    float ps = 0;
#pragma unroll
    for (int r = 0; r < 16; ++r) ps += p0[r];
#pragma unroll
    for (int r = 0; r < 16; ++r) ps += p1[r];
    { auto rr = __builtin_amdgcn_permlane32_swap(__float_as_uint(ps), __float_as_uint(ps), false, false);
      ps = __uint_as_float(rr[0]) + __uint_as_float(rr[1]); }
    l_reg = l_reg * alpha + ps;
#define PK4(P, BASE, OUT) do { unsigned a0 = cvtpk(P[BASE + 0], P[BASE + 1]), a1 = cvtpk(P[BASE + 2], P[BASE + 3]);   \
    unsigned b0 = cvtpk(P[BASE + 4], P[BASE + 5]), b1 = cvtpk(P[BASE + 6], P[BASE + 7]);                              \
    auto r0 = __builtin_amdgcn_permlane32_swap(a0, b0, false, false); auto r1 = __builtin_amdgcn_permlane32_swap(a1, b1, false, false); \
    u32x4 w = {r0[0], r1[0], r0[1], r1[1]}; OUT = *reinterpret_cast<bf16x8*>(&w); } while (0)
    PK4(p0, 0, pa0); PK4(p0, 8, pa1); PK4(p1, 0, pa2); PK4(p1, 8, pa3);
#undef PK4
}
template <bool MASKED> __device__ __forceinline__ void qkt(f32x16& p0, f32x16& p1, const bf16_t* Ks, const bf16x8* qs, int r32, int hi, unsigned long long mk, int sh4, const char* lut) {
    if constexpr (MASKED) {
        const unsigned wl = (unsigned)mk >> sh4, wh = (unsigned)(mk >> 32) >> sh4;
#pragma unroll
        for (int g = 0; g < 4; ++g) { const f32x4 b0 = *(const f32x4*)(lut + ((wl >> (8 * g)) & 15u) * 16), b1 = *(const f32x4*)(lut + ((wh >> (8 * g)) & 15u) * 16);
            p0[4 * g] = b0.x; p0[4 * g + 1] = b0.y; p0[4 * g + 2] = b0.z; p0[4 * g + 3] = b0.w; p1[4 * g] = b1.x; p1[4 * g + 1] = b1.y; p1[4 * g + 2] = b1.z; p1[4 * g + 3] = b1.w; }
    } else { p0 = f32x16{}; p1 = f32x16{}; }
#pragma unroll
    for (int d0 = 0; d0 < 8; ++d0) { int cb = (d0 * 16 + hi * 8) * 2;
        bf16x8 b0 = *reinterpret_cast<const bf16x8*>((const char*)Ks + KSWZ(r32, cb));
        bf16x8 b1 = *reinterpret_cast<const bf16x8*>((const char*)Ks + KSWZ(32 + r32, cb));
        const bf16x8 qf = qs[d0 * 64];
        p0 = __builtin_amdgcn_mfma_f32_32x32x16_bf16(b0, qf, p0, 0, 0, 0);
        p1 = __builtin_amdgcn_mfma_f32_32x32x16_bf16(b1, qf, p1, 0, 0, 0); }
}
__device__ __forceinline__ int v_st(int k, int c) { const int kk = (k & ~0xC) | ((k & 4) << 1) | ((k & 8) >> 1); return ((kk >> 3) * 4 + (c >> 5)) * 512 + ((kk & 7) * 32 + (c & 31)) * 2; }
__device__ __forceinline__ int v_rd_base(int lane) { return ((lane & 3) << 3) | (((lane >> 2) & 3) << 6) | (((lane >> 4) & 1) << 5) | (((lane >> 5) & 1) << 8); }
constexpr int v_rd_off(int d0, int ks, int half) { return d0 * 512 + ks * 4096 + half * 2048; }
template <int OFF> __device__ __forceinline__ s16x4 tr_read(int vb) {
    s16x4 r; asm volatile("ds_read_b64_tr_b16 %0, %1 offset:%2" : "=&v"(r) : "v"(vb), "i"(OFF) : "memory"); return r;
}
template <int D0> __device__ __forceinline__ void pv_one(f32x16& od, int vb, bf16x8 pa0, bf16x8 pa1, bf16x8 pa2, bf16x8 pa3) {
    const s16x4 l0 = tr_read<v_rd_off(D0, 0, 0)>(vb), h0 = tr_read<v_rd_off(D0, 0, 1)>(vb), l1 = tr_read<v_rd_off(D0, 1, 0)>(vb), h1 = tr_read<v_rd_off(D0, 1, 1)>(vb);
    const s16x4 l2 = tr_read<v_rd_off(D0, 2, 0)>(vb), h2 = tr_read<v_rd_off(D0, 2, 1)>(vb), l3 = tr_read<v_rd_off(D0, 3, 0)>(vb), h3 = tr_read<v_rd_off(D0, 3, 1)>(vb);
    asm volatile("s_waitcnt lgkmcnt(0)" ::: "memory"); SBAR();
#define PK(L, H) (bf16x8){L[0], L[1], L[2], L[3], H[0], H[1], H[2], H[3]}
    od = __builtin_amdgcn_mfma_f32_32x32x16_bf16(pa0, PK(l0, h0), od, 0, 0, 0);
    od = __builtin_amdgcn_mfma_f32_32x32x16_bf16(pa1, PK(l1, h1), od, 0, 0, 0);
    od = __builtin_amdgcn_mfma_f32_32x32x16_bf16(pa2, PK(l2, h2), od, 0, 0, 0);
    od = __builtin_amdgcn_mfma_f32_32x32x16_bf16(pa3, PK(l3, h3), od, 0, 0, 0);
#undef PK
}
__device__ __forceinline__ void pv_d0(f32x16* o, int vb, bf16x8 pa0, bf16x8 pa1, bf16x8 pa2, bf16x8 pa3) {
    pv_one<0>(o[0], vb, pa0, pa1, pa2, pa3); pv_one<1>(o[1], vb, pa0, pa1, pa2, pa3); pv_one<2>(o[2], vb, pa0, pa1, pa2, pa3); pv_one<3>(o[3], vb, pa0, pa1, pa2, pa3);
}
template <bool MASKED, int SDEPTH, int ldq, int ldk, int ldo>
__device__ __forceinline__ void attn_body(const bf16_t* __restrict__ Qb, const bf16_t* __restrict__ Kh, const bf16_t* __restrict__ Vh,
                                          bf16_t* __restrict__ Ob, int seq, const unsigned long long* __restrict__ mrow, char* lds) {
    int tid = (int)threadIdx.x; asm volatile("" : "+v"(tid));
    const int wid = tid >> 6, lane = tid & 63, r32 = lane & 31, hi = lane >> 5, sh4 = 4 * hi;
    bf16_t* V_lds = (bf16_t*)lds; bf16_t* K_lds = (bf16_t*)(lds + 2 * SHM_V);
    float* ws = (float*)(lds + 2 * SHM_V + 2 * SHM_K) + wid * 64; float* li_l = ws; float* al_l = ws + 32;
    float m_reg = -1e30f, l_reg = 0; f32x16 o[4] = {};
    const bf16_t* Qw = Qb + (long)(wid * QBLK + r32) * ldq + hi * 8;
    bf16x8* qr = (bf16x8*)(lds + SHM_ATTN) + wid * 512 + lane;
#pragma unroll
    for (int d0 = 0; d0 < 8; ++d0) qr[d0 * 64] = *reinterpret_cast<const bf16x8*>(Qw + d0 * 16);
    const char* lut = lds + SHM_ATTN + 65536;
    if (MASKED && tid < 64) ((float*)(lds + SHM_ATTN + 65536))[tid] = ((tid >> 2) >> (tid & 3)) & 1 ? 0.f : -INFINITY;
    const int sr = tid >> 4, sc = (tid & 15) * 8, vst0 = v_st(sr, sc), vst1 = v_st(32 + sr, sc);
    const int vb0 = (int)(uintptr_t)V_lds + v_rd_base(lane);
    struct { bf16x8 vs0, vs1, ks0, ks1; } sr_[SDEPTH];
#define SLOAD(i, k0) do { sr_[i].vs0 = *reinterpret_cast<const bf16x8*>(&Vh[(long)((k0) + sr) * ldk + sc]); sr_[i].vs1 = *reinterpret_cast<const bf16x8*>(&Vh[(long)((k0) + 32 + sr) * ldk + sc]); \
    sr_[i].ks0 = *reinterpret_cast<const bf16x8*>(&Kh[(long)((k0) + sr) * ldk + sc]); sr_[i].ks1 = *reinterpret_cast<const bf16x8*>(&Kh[(long)((k0) + 32 + sr) * ldk + sc]); } while (0)
#define SWRITE(b, i) do { *(bf16x8*)((char*)V_lds + (b) * SHM_V + vst0) = sr_[i].vs0;          \
    *(bf16x8*)((char*)V_lds + (b) * SHM_V + vst1) = sr_[i].vs1; int kc = sc * 2;               \
    *(bf16x8*)((char*)K_lds + (b) * SHM_K + KSWZ(sr, kc)) = sr_[i].ks0;                       \
    *(bf16x8*)((char*)K_lds + (b) * SHM_K + KSWZ(32 + sr, kc)) = sr_[i].ks1; } while (0)
#define SWAIT() do { if constexpr (SDEPTH == 2) asm volatile("s_waitcnt vmcnt(4)" ::: "memory"); else asm volatile("s_waitcnt vmcnt(0)" ::: "memory"); } while (0)
#define RESC(a) do { if (__any((a) < 1.f)) { if (hi == 0) al_l[r32] = (a); asm volatile("s_waitcnt lgkmcnt(0)" ::: "memory"); \
    _Pragma("unroll") for (int d = 0; d < 4; ++d) _Pragma("unroll") for (int r = 0; r < 16; ++r) o[d][r] *= al_l[crow(r, hi)]; } } while (0)
    f32x16 pA0, pA1, pB0, pB1; float mnA, mnB, alA, alB; bf16x8 pa0, pa1, pa2, pa3; const int NT = seq / KVBLK;
    unsigned long long mkA = 0, mkB = 0;
    constexpr int SE = 0, SO = SDEPTH - 1;
    if constexpr (MASKED) mkA = mrow[0];
    SLOAD(SE, 0); asm volatile("s_waitcnt vmcnt(0)" ::: "memory"); SWRITE(0, SE); __syncthreads();
    qkt<MASKED>(pA0, pA1, K_lds, qr, r32, hi, mkA, sh4, lut); partialSM<MASKED>(pA0, pA1, m_reg, mnA, alA, mkA, sh4);
    if constexpr (MASKED) mkB = mrow[1];
    SLOAD(SO, KVBLK); if constexpr (SDEPTH == 2) { if (2 < NT) SLOAD(SE, 2 * KVBLK); }
    SWAIT(); SWRITE(1, SO); __syncthreads();
    for (int j = 1; j + 1 < NT; j += 2) {
        SBAR(); qkt<MASKED>(pB0, pB1, (bf16_t*)((char*)K_lds + SHM_K), qr, r32, hi, mkB, sh4, lut);
        finishSM<MASKED>(pA0, pA1, alA, l_reg, pa0, pa1, pa2, pa3, mkA, sh4); SBAR();
        if constexpr (MASKED) mkA = mrow[j + 1];
        SLOAD(SO, (j + SDEPTH) * KVBLK); SBAR();
        pv_d0(o, vb0, pa0, pa1, pa2, pa3); partialSM<MASKED>(pB0, pB1, m_reg, mnB, alB, mkB, sh4);
        __syncthreads(); SWAIT(); SWRITE(0, SE);
        RESC(alB); __syncthreads();
        SBAR(); qkt<MASKED>(pA0, pA1, K_lds, qr, r32, hi, mkA, sh4, lut);
        finishSM<MASKED>(pB0, pB1, alB, l_reg, pa0, pa1, pa2, pa3, mkB, sh4); SBAR();
        if constexpr (MASKED) { if (j + 2 < NT) mkB = mrow[j + 2]; }
        if (SDEPTH == 1 || j + 3 < NT) SLOAD(SE, (j + 1 + SDEPTH) * KVBLK); SBAR();
        pv_d0(o, vb0 + (int)SHM_V, pa0, pa1, pa2, pa3); partialSM<MASKED>(pA0, pA1, m_reg, mnA, alA, mkA, sh4);
        __syncthreads(); SWAIT(); SWRITE(1, SO);
        RESC(alA); __syncthreads();
    }
    SBAR(); qkt<MASKED>(pB0, pB1, (bf16_t*)((char*)K_lds + SHM_K), qr, r32, hi, mkB, sh4, lut);
    finishSM<MASKED>(pA0, pA1, alA, l_reg, pa0, pa1, pa2, pa3, mkA, sh4); SBAR();
    pv_d0(o, vb0, pa0, pa1, pa2, pa3); partialSM<MASKED>(pB0, pB1, m_reg, mnB, alB, mkB, sh4);
    __syncthreads(); RESC(alB);
    finishSM<MASKED>(pB0, pB1, alB, l_reg, pa0, pa1, pa2, pa3, mkB, sh4); SBAR();
    pv_d0(o, vb0 + (int)SHM_V, pa0, pa1, pa2, pa3);
    if (hi == 0) li_l[r32] = l_reg; asm volatile("s_waitcnt lgkmcnt(0)" ::: "memory");
    float rli[16];
#pragma unroll
    for (int r = 0; r < 16; ++r) rli[r] = __builtin_amdgcn_rcpf(li_l[crow(r, hi)]);
    bf16_t* Ow = Ob + (long)(wid * QBLK) * ldo;
#pragma unroll
    for (int r = 0; r < 16; ++r) { const int orow = crow(r, hi);
#pragma unroll
        for (int d0 = 0; d0 < 4; ++d0) Ow[(long)orow * ldo + d0 * 32 + r32] = (bf16_t)(cvtpk(o[d0][r] * rli[r], 0.f) & 0xffffu); }
    __syncthreads();
#undef SLOAD
#undef SWRITE
#undef SWAIT
#undef RESC
}
#undef KSWZ
#undef SBAR
}

#define XB_TMO      128
#define XB_XCNT(j)  (256  + 64 * (j))
#define XB_XSUB(j)  (1280 + 64 * (j))
#define XB_XGEN(j)  (2304 + 64 * (j))
#define XB_TOP      3328
#define XB_TOPGEN   3392
#define XCD_BAR_WORDS 3456
#define XB_SPIN_CAP (1u << 22)
__device__ __forceinline__ unsigned xb_ld(unsigned* p)              { return __hip_atomic_load(p, __ATOMIC_RELAXED, __HIP_MEMORY_SCOPE_AGENT); }
__device__ __forceinline__ unsigned xb_add(unsigned* p, unsigned v) { return __hip_atomic_fetch_add(p, v, __ATOMIC_RELAXED, __HIP_MEMORY_SCOPE_AGENT); }
__device__ __forceinline__ unsigned xb_xcc_id() { return (unsigned)__builtin_amdgcn_s_getreg((3 << 11) | 20) & 0xFu; }
#define XB_SPIN(cond, bar) do { unsigned _sp = 0; while (cond) { __builtin_amdgcn_s_sleep(1); \
    if ((++_sp & 255u) == 0u) { if (xb_ld(&(bar)[XB_TMO])) break; if (_sp > XB_SPIN_CAP) { atomicAdd(&(bar)[XB_TMO], 1u); break; } } } } while (0)
struct XcdBarrier { unsigned* bar; unsigned x; volatile LAS unsigned* st; };
__device__ __forceinline__ XcdBarrier xcd_barrier_post(unsigned* bar, volatile LAS unsigned* st) {
    XcdBarrier b; b.bar = bar; b.x = xb_xcc_id(); b.st = st;
    if (threadIdx.x == 0) (void)xb_add(&bar[XB_XCNT(b.x)], 1u);
    return b;
}
__device__ __forceinline__ void xcd_barrier_complete(unsigned* bar, unsigned x, unsigned& nloc, unsigned& nx) {
    const unsigned G = gridDim.x * gridDim.y * gridDim.z;
    unsigned sum, cnt, mine, sp = 0u;
    for (;;) {
        sum = 0u; cnt = 0u; mine = 0u;
#pragma unroll
        for (unsigned j = 0; j < 16; ++j) { const unsigned c = xb_ld(&bar[XB_XCNT(j)]); sum += c; cnt += (c > 0u) ? 1u : 0u; mine = (j == x) ? c : mine; }
        if (sum == G) break;
        __builtin_amdgcn_s_sleep(1);
        if ((++sp & 255u) == 0u) { if (xb_ld(&bar[XB_TMO])) break; if (sp > XB_SPIN_CAP) { atomicAdd(&bar[XB_TMO], 1u); break; } }
    }
    nloc = mine > 0u ? mine : 1u; nx = cnt > 0u ? cnt : 1u;
}
__device__ __forceinline__ void xcd_barrier(const XcdBarrier& b) {
    asm volatile("s_waitcnt vmcnt(0)" ::: "memory");
    __syncthreads();
    if (threadIdx.x == 0) {
        unsigned* bar = b.bar;
        __builtin_amdgcn_s_waitcnt(0);
        unsigned nloc = b.st[0], nx = b.st[1];
        if (nloc == 0u) { xcd_barrier_complete(bar, b.x, nloc, nx); b.st[0] = nloc; b.st[1] = nx; }
        const unsigned old = xb_add(&bar[XB_XSUB(b.x)], 1u);
        const unsigned gen = old / nloc;
        if (old + 1u == (gen + 1u) * nloc) {
            __builtin_amdgcn_fence(__ATOMIC_RELEASE, "agent");
            asm volatile("s_waitcnt vmcnt(0)" ::: "memory");
            const unsigned og = xb_add(&bar[XB_TOP], 1u);
            const unsigned tg = og / nx;
            if (og + 1u == (tg + 1u) * nx) xb_add(&bar[XB_TOPGEN], 1u);
            else XB_SPIN(xb_ld(&bar[XB_TOPGEN]) == tg, bar);
            __builtin_amdgcn_fence(__ATOMIC_ACQUIRE, "agent");
            xb_add(&bar[XB_XGEN(b.x)], 1u);
            asm volatile("s_waitcnt vmcnt(0)" ::: "memory");
        } else {
            XB_SPIN(xb_ld(&bar[XB_XGEN(b.x)]) == gen, bar);
            __builtin_amdgcn_fence(__ATOMIC_ACQUIRE, "agent");
            asm volatile("s_waitcnt vmcnt(0)" ::: "memory");
        }
    }
    __syncthreads();
}

constexpr int NWAVES = 8;
constexpr int RING_BYTES = 151 * 1024;
constexpr int LDSCTL_OFF = RING_BYTES, MISC_OFF = LDSCTL_OFF + 320;
constexpr int LDS_BYTES = 152 * 1024;
static_assert(MISC_OFF + 128 <= LDS_BYTES, "LDS map");
constexpr int N_PHASES = 13;

struct Args {
    const float* x; const float* mem; const float* attn_g; const float* w_in; const float* q_g; const float* k_g; const float* pool_w; const float* pool_s;
    const float* mem_g; const float* w_kv; const float* mq_g; const float* mk_g; const float* w_out; const float* ffn_g; const float* w_q; const float* sk1; const float* sk2;
    const float* pu; const float* pv; float* out; unsigned char* ws; int ph_lo, ph_hi;
};
struct Frame {
    LAS unsigned char* lds; char* ldsg;
    int tid, lane, wave, vcu, G;
};

__device__ __forceinline__ int in_colmap(int n) {
    if (n < 4096) return n;
    if (n < 4608) return 4176 + (n - 4096);
    if (n < 5120) return 4688 + (n - 4608);
    if (n < 5184) return 4096 + (n - 5120);
    if (n < 5200) return 4160 + (n - 5184);
    return -1;
}
template <int MAP> __device__ __forceinline__ void p0_transpose_item(const float* W, int K, int N, bf16_t* WT, LAS float* scr, int kb, int nb, int lane) {
    const int k0 = 64 * kb, n0 = 32 * nb;
    int nsrc = n0 + (lane & 31); if (MAP == 1) nsrc = in_colmap(nsrc);
#pragma unroll 8
    for (int i = 0; i < 32; ++i) { const int kk = 2 * i + (lane >> 5); scr[kk * 33 + (lane & 31)] = nsrc >= 0 ? W[(size_t)(k0 + kk) * N + nsrc] : 0.f; }
    LDS_WAIT();
    const int c = lane & 7;
#pragma unroll
    for (int j = 0; j < 4; ++j) { const int n = (lane >> 3) + 8 * j; const LAS float* s = scr + (8 * c) * 33 + n;
        u32x4 o; o.x = cvtpk(s[0 * 33], s[1 * 33]); o.y = cvtpk(s[2 * 33], s[3 * 33]); o.z = cvtpk(s[4 * 33], s[5 * 33]); o.w = cvtpk(s[6 * 33], s[7 * 33]);
        *(u32x4*)(WT + (size_t)(n0 + n) * K + k0 + 8 * c) = o; }
    LDS_WAIT();
}
__device__ __forceinline__ void rms_row_to_bf16(const float* xrow, const float* gain, bf16_t* orow, int lane) {
    const f32x4* xr = (const f32x4*)xrow + lane;
    f32x4 v[8]; float s = 0.f;
#pragma unroll
    for (int j = 0; j < 8; ++j) { v[j] = xr[64 * j]; s += (v[j].x * v[j].x + v[j].y * v[j].y) + (v[j].z * v[j].z + v[j].w * v[j].w); }
    const float rstd = 1.f / sqrtf(wave_sum(s) * (1.f / DM) + EPS);
    unsigned long long* o8 = (unsigned long long*)orow + lane;
#pragma unroll
    for (int j = 0; j < 8; ++j) { const f32x4 g = ((const f32x4*)gain)[lane + 64 * j]; const f32x4 y = v[j] * rstd * g;
        o8[64 * j] = (unsigned long long)cvtpk(y.x, y.y) | ((unsigned long long)cvtpk(y.z, y.w) << 32); }
}
__device__ __forceinline__ void rms_row_to_bf16_fp8(const float* xrow, const float* gain, bf16_t* orow, unsigned char* o8row, int lane) {
    const f32x4* xr = (const f32x4*)xrow + lane;
    f32x4 v[8]; float s = 0.f;
#pragma unroll
    for (int j = 0; j < 8; ++j) { v[j] = xr[64 * j]; s += (v[j].x * v[j].x + v[j].y * v[j].y) + (v[j].z * v[j].z + v[j].w * v[j].w); }
    const float rstd = 1.f / sqrtf(wave_sum(s) * (1.f / DM) + EPS);
    unsigned long long* o8 = (unsigned long long*)orow + lane; unsigned* q4 = (unsigned*)o8row + lane;
#pragma unroll
    for (int j = 0; j < 8; ++j) { const f32x4 g = ((const f32x4*)gain)[lane + 64 * j]; const f32x4 y = v[j] * rstd * g;
        o8[64 * j] = (unsigned long long)cvtpk(y.x, y.y) | ((unsigned long long)cvtpk(y.z, y.w) << 32);
        int w = __builtin_amdgcn_cvt_pk_fp8_f32(__builtin_amdgcn_fmed3f(y.x, -448.f, 448.f), __builtin_amdgcn_fmed3f(y.y, -448.f, 448.f), 0, false);
        w = __builtin_amdgcn_cvt_pk_fp8_f32(__builtin_amdgcn_fmed3f(y.z, -448.f, 448.f), __builtin_amdgcn_fmed3f(y.w, -448.f, 448.f), w, true); q4[64 * j] = (unsigned)w; }
}
struct RowF32 { f32x4 v[8]; };
__device__ __forceinline__ void row_load(RowF32& R, const float* xrow, int lane) {
    const f32x4* xr = (const f32x4*)xrow + lane;
#pragma unroll
    for (int j = 0; j < 8; ++j) R.v[j] = xr[64 * j];
}
__device__ __forceinline__ void row_load_bf16(RowF32& R, const bf16_t* brow, int lane) {
    const u32x2* br = (const u32x2*)brow + lane;
#pragma unroll
    for (int j = 0; j < 8; ++j) { const u32x2 w = br[64 * j]; R.v[j] = (f32x4){bflo(w.x), bfhi(w.x), bflo(w.y), bfhi(w.y)}; }
}
__device__ __forceinline__ void row_to_fp8(const RowF32& R, unsigned char* orow, float* inv, int lane) {
    unsigned* o4 = (unsigned*)orow + lane; float am = 0.f;
#pragma unroll
    for (int j = 0; j < 8; ++j) am = fmaxf(am, fmaxf(fmaxf(fabsf(R.v[j].x), fabsf(R.v[j].y)), fmaxf(fabsf(R.v[j].z), fabsf(R.v[j].w))));
#pragma unroll
    for (int o = 1; o < 64; o <<= 1) am = fmaxf(am, __shfl_xor(am, o));
    const float sc = (am > 0.f && am < 3.0e38f) ? exp2f(floorf(log2f(224.f / am))) : 1.f;
#pragma unroll
    for (int j = 0; j < 8; ++j) { int w = __builtin_amdgcn_cvt_pk_fp8_f32(R.v[j].x * sc, R.v[j].y * sc, 0, false); w = __builtin_amdgcn_cvt_pk_fp8_f32(R.v[j].z * sc, R.v[j].w * sc, w, true); o4[64 * j] = (unsigned)w; }
    if (lane == 0) *inv = 1.f / sc;
}
__device__ __forceinline__ void p0_prologue(const Frame& F, const Args& a) {
    unsigned char* ws = a.ws;
    LAS float* scr = (LAS float*)(F.lds + F.wave * 16384);
    const int gw = F.vcu * NWAVES + F.wave, NGW = F.G * NWAVES, lane = F.lane;
    bf16_t* BtIn = (bf16_t*)(ws + WS_BT_IN); bf16_t* BtOut = (bf16_t*)(ws + WS_BT_OUT); bf16_t* BtQ = (bf16_t*)(ws + WS_BT_Q); bf16_t* BtKV = (bf16_t*)(ws + WS_BT_KV);
    constexpr int I_IN = 32 * 168, I_OUT = 32 * 64, I_Q = 32 * 64, I_KV = 32 * 32;
    constexpr int NIT = I_IN + I_OUT + I_Q + I_KV;
    for (int it = gw; it < NIT; it += NGW) {
        int r = it;
        if (r < I_IN) { p0_transpose_item<1>(a.w_in, DM, IN_W, BtIn, scr, r / 168, r % 168, lane); continue; } r -= I_IN;
        if (r < I_OUT) { const int kb = r / 64; p0_transpose_item<0>(a.w_out, DM, DM, BtOut, scr, kb, r % 64, lane); continue; } r -= I_OUT;
        if (r < I_Q) { p0_transpose_item<0>(a.w_q, DM, DM, BtQ, scr, r / 64, r % 64, lane); continue; } r -= I_Q;
        p0_transpose_item<0>(a.w_kv, DM, 1024, BtKV, scr, r / 32, r % 32, lane);
    }
    { bf16_t* PWt = (bf16_t*)(ws + WS_PWT);
      for (int it = gw; it < 4 * 128; it += NGW) { const int g = it >> 7, e = it & 127; const float* pw = a.pool_w + (size_t)g * 16384 + e;
          const float v0 = pw[(size_t)(2 * lane) * 128], v1 = pw[(size_t)(2 * lane + 1) * 128]; ((unsigned*)(PWt + (size_t)it * 128))[lane] = cvtpk(v0, v1); } }
    bf16_t* XN = (bf16_t*)(ws + WS_XN); bf16_t* MN = (bf16_t*)(ws + WS_MN);
#if P1_FP8
    for (int m = gw; m < NTOK; m += NGW) rms_row_to_bf16_fp8(a.x + (size_t)m * DM, a.attn_g, XN + (size_t)m * DM, ws + WS_XN8 + (size_t)m * DM, lane);
#else
    for (int m = gw; m < NTOK; m += NGW) rms_row_to_bf16(a.x + (size_t)m * DM, a.attn_g, XN + (size_t)m * DM, lane);
#endif
    for (int m = gw; m < BATCH * MEMLEN; m += NGW) rms_row_to_bf16(a.mem + (size_t)m * DM, a.mem_g, MN + (size_t)m * DM, lane);
    unsigned char* UB = ws + WS_UB; unsigned char* VB = ws + WS_VB; float* RSU = (float*)(ws + WS_RSU); float* RSV = (float*)(ws + WS_RSV);
    (void)UB; (void)VB; (void)RSU; (void)RSV;
    bf16_t* PK = (bf16_t*)(ws + WS_PK);
    for (int m = gw; m < 256; m += NGW) { const float* src = (m < 128 ? a.sk1 + (size_t)m * 128 : a.sk2 + (size_t)(m - 128) * 128);
        const f32x2 v = ((const f32x2*)src)[lane]; ((unsigned*)(PK + (size_t)m * 128))[lane] = cvtpk(v.x, v.y); }
    float* RT = (float*)(ws + WS_ROPE);
    for (int p = gw; p < SEQ; p += NGW) {
        { const float invf = powf(10000.f, -(float)lane / 64.f); const float ang = (float)p * invf;
          RT[(size_t)p * 192 + lane] = (float)cos((double)ang); RT[(size_t)p * 192 + 64 + lane] = (float)sin((double)ang); }
        if (lane < 32) { const float invf = powf(10000.f, -(float)lane / 32.f); const float ang = (float)p * invf;
          RT[(size_t)p * 192 + 128 + lane] = (float)cos((double)ang); RT[(size_t)p * 192 + 160 + lane] = (float)sin((double)ang); }
    }
}

__device__ __forceinline__ void unpack8(const u32x4 w, float* x) { x[0] = bflo(w.x); x[1] = bfhi(w.x); x[2] = bflo(w.y); x[3] = bfhi(w.y); x[4] = bflo(w.z); x[5] = bfhi(w.z); x[6] = bflo(w.w); x[7] = bfhi(w.w); }
__device__ __forceinline__ u32x4 pack8(const float* x) { u32x4 w; w.x = cvtpk(x[0], x[1]); w.y = cvtpk(x[2], x[3]); w.z = cvtpk(x[4], x[5]); w.w = cvtpk(x[6], x[7]); return w; }
struct F8 { float v[8]; };
__device__ __forceinline__ F8 ld8f(const float* p) { const f32x4 a = *(const f32x4*)p, b = *(const f32x4*)(p + 4); F8 r; r.v[0] = a.x; r.v[1] = a.y; r.v[2] = a.z; r.v[3] = a.w; r.v[4] = b.x; r.v[5] = b.y; r.v[6] = b.z; r.v[7] = b.w; return r; }
template <bool NORM, bool ROPE> __device__ __forceinline__ void head128_fin(bf16_t* base, const u32x4 wa, const u32x4 wb, int g, const F8& g1, const F8& g2, const F8& cc, const F8& sn) {
    float x1[8], x2[8];
    unpack8(wa, x1); unpack8(wb, x2);
    if (NORM) {
        float ss = 0.f;
#pragma unroll
        for (int j = 0; j < 8; ++j) ss += x1[j] * x1[j] + x2[j] * x2[j];
        ss += __shfl_xor(ss, 1); ss += __shfl_xor(ss, 2); ss += __shfl_xor(ss, 4);
        const float rstd = 1.f / sqrtf(ss * (1.f / 128.f) + EPS);
#pragma unroll
        for (int j = 0; j < 8; ++j) { x1[j] = x1[j] * rstd * g1.v[j]; x2[j] = x2[j] * rstd * g2.v[j]; }
    }
    if (ROPE) {
#pragma unroll
        for (int j = 0; j < 8; ++j) { const float c = cc.v[j], sv = sn.v[j]; const float p = x1[j], q = x2[j]; x1[j] = p * c - q * sv; x2[j] = q * c + p * sv; }
    }
    *(u32x4*)(base + 8 * g) = pack8(x1); *(u32x4*)(base + 64 + 8 * g) = pack8(x2);
}
__device__ __forceinline__ void head64_fin(bf16_t* base, const u32x4 wa, const u32x4 wb, int g, const F8& cc, const F8& sn) {
    float x1[8], x2[8];
    unpack8(wa, x1); unpack8(wb, x2);
#pragma unroll
    for (int j = 0; j < 8; ++j) { const float c = cc.v[j], sv = sn.v[j]; const float p = x1[j], q = x2[j]; x1[j] = p * c - q * sv; x2[j] = q * c + p * sv; }
    *(u32x4*)(base + 8 * g) = pack8(x1); *(u32x4*)(base + 32 + 8 * g) = pack8(x2);
}
__device__ __forceinline__ void p2_post(const Frame& F, const Args& a) {
    unsigned char* ws = a.ws; const int lane = F.lane;
    const int gw = F.vcu * NWAVES + F.wave, NGW = F.G * NWAVES;
    bf16_t* Z = (bf16_t*)(ws + WS_Z); bf16_t* MIX = (bf16_t*)(ws + WS_XN); bf16_t* KVM = (bf16_t*)(ws + WS_KVM);
    const float* RT = (const float*)(ws + WS_ROPE);
    const int g8 = lane & 7, h8 = lane >> 3, g4 = lane & 3, h4 = lane >> 2;
    const F8 qg1 = ld8f(a.q_g + 8 * g8), qg2 = ld8f(a.q_g + 64 + 8 * g8), kg1 = ld8f(a.k_g + 8 * g8), kg2 = ld8f(a.k_g + 64 + 8 * g8), mg1 = ld8f(a.mq_g + 8 * g8), mg2 = ld8f(a.mq_g + 64 + 8 * g8);
    for (int t = gw; t < NTOK; t += NGW) {
        const int pos = t & (SEQ - 1);
        bf16_t* zr = Z + (size_t)t * ZLD; const float* rp = RT + (size_t)pos * 192;
        const int w = 2 << (lane >> 4); const int cnt = (pos + 1 < w) ? pos + 1 : w;
        u32x4 pl[16];
#pragma unroll
        for (int j = 0; j < 16; ++j) { const int jj = j < cnt ? j : 0; pl[j] = *(const u32x4*)(zr - (size_t)jj * ZLD + ZC_PU + 8 * lane); }
        bf16_t* bq = zr + ZC_Q + h8 * 128; bf16_t* bk = zr + ZC_K + h8 * 128; bf16_t* bi = zr + ZC_QI + h4 * 64; bf16_t* bki = zr + ZC_KI; bf16_t* bm = zr + ZC_QM + (h8 & 3) * 128;
        const u32x4 q1 = *(const u32x4*)(bq + 8 * g8), q2 = *(const u32x4*)(bq + 64 + 8 * g8), k1 = *(const u32x4*)(bk + 8 * g8), k2 = *(const u32x4*)(bk + 64 + 8 * g8);
        const u32x4 i1 = *(const u32x4*)(bi + 8 * g4), i2 = *(const u32x4*)(bi + 32 + 8 * g4), x1 = *(const u32x4*)(bki + 8 * g4), x2 = *(const u32x4*)(bki + 32 + 8 * g4);
        const u32x4 m1 = *(const u32x4*)(bm + 8 * g8), m2 = *(const u32x4*)(bm + 64 + 8 * g8);
        const F8 c128 = ld8f(rp + 8 * g8), s128 = ld8f(rp + 64 + 8 * g8), c64 = ld8f(rp + 128 + 8 * g4), s64 = ld8f(rp + 160 + 8 * g4);
        head128_fin<true, true>(bq, q1, q2, g8, qg1, qg2, c128, s128);
        head128_fin<true, true>(bk, k1, k2, g8, kg1, kg2, c128, s128);
        head64_fin(bi, i1, i2, g4, c64, s64);
        if (lane < 4) head64_fin(bki, x1, x2, g4, c64, s64);
        if (lane < 32) head128_fin<true, false>(bm, m1, m2, g8, mg1, mg2, c128, s128);
        { float sum[8] = {0.f, 0.f, 0.f, 0.f, 0.f, 0.f, 0.f, 0.f}, ut[8];
          unpack8(pl[0], ut);
#pragma unroll
          for (int j = 0; j < 16; ++j) { float v[8]; unpack8(pl[j], v); const float on = j < cnt ? 1.f : 0.f;
#pragma unroll
              for (int e = 0; e < 8; ++e) sum[e] = fmaf(on, v[e], sum[e]); }
          const float inv = 1.f / (float)cnt; float d[8];
#pragma unroll
          for (int e = 0; e < 8; ++e) d[e] = sum[e] * inv - ut[e];
          *(u32x4*)(MIX + (size_t)t * DM + 1024 + 8 * lane) = pack8(d); }
    }
    const F8 kmg1 = ld8f(a.mk_g + 8 * g8), kmg2 = ld8f(a.mk_g + 64 + 8 * g8);
    for (int r = gw; r < BATCH * MEMLEN; r += NGW) { if (lane < 32) { bf16_t* bm = KVM + (size_t)r * 1024 + (lane >> 3) * 128; const u32x4 m1 = *(const u32x4*)(bm + 8 * g8), m2 = *(const u32x4*)(bm + 64 + 8 * g8); head128_fin<true, false>(bm, m1, m2, g8, kmg1, kmg2, kmg1, kmg2); } }
}

namespace ix {
constexpr int KP = 144, KBUF = 64 * KP;
constexpr int OFF_KI = 0, OFF_HIST = 2 * KBUF, OFF_ST = OFF_HIST + 65536, OFF_W = OFF_ST + 8192;
constexpr int CAPB = 1024;
constexpr int CAPF = 512;
enum { S_ULO = 0, S_UHI = 64, S_SH = 128, S_NEED = 192, S_FLO = 256, S_FHI = 320, S_CCNT = 384, S_ACT = 448, S_ABOVE = 512, S_COL = 576, S_FAIL = 640,
       S_PB1 = 704, S_PB2 = 768, S_PAB = 832, S_VMIN = 896, S_VMAX = 960, S_VCNT = 1024, S_ANY = 1088, S_R1 = 1089, S_R2 = 1090 };
constexpr float WSCALE = 0.25f * 0.125f;
__device__ __forceinline__ float relu_i(float x) { const int i = __float_as_int(x); return __int_as_float(i > 0 ? i : 0); }
__device__ __forceinline__ unsigned sh_for(unsigned range) { const int bits = 32 - __clz((int)range); return range == 0u ? 0u : (bits > 9 ? (unsigned)(bits - 9) : 0u); }

template <int MODE>
__device__ __forceinline__ void sweep(const Frame& F, const bf16x8 (&A)[4][4], const bf16_t* Z, unsigned* MASK, unsigned long long* CAND, size_t qrow0, size_t krow0, int NT, int t0, int stride, int vmode) {
    const int tid = F.tid, lane = F.lane, wave = F.wave, r = lane & 31, hi = lane >> 5;
    LAS unsigned char* lds = F.lds;
    volatile LAS unsigned* st = (volatile LAS unsigned*)(lds + OFF_ST);
    LAS unsigned* hist32 = (LAS unsigned*)(lds + OFF_HIST);
    unsigned qact = 0u;
    {
#pragma unroll
        for (int qp = 0; qp < 4; ++qp) { const int q0 = 8 * wave + 2 * qp; const unsigned a2 = (MODE == 0) ? (st[S_ACT + q0] | st[S_ACT + q0 + 1]) : (vmode ? 1u : (st[S_COL + q0] | st[S_COL + q0 + 1]));
            qact |= ((unsigned)__builtin_amdgcn_readfirstlane((int)a2) != 0u ? 1u : 0u) << qp; }
    }
    unsigned ccnt_[4] = {0u, 0u, 0u, 0u}, abv_[4] = {0u, 0u, 0u, 0u};
    if (MODE == 1) {
#pragma unroll
        for (int qp = 0; qp < 4; ++qp) { ccnt_[qp] = st[S_CCNT + 8 * wave + 2 * qp + hi]; abv_[qp] = st[S_ABOVE + 8 * wave + 2 * qp + hi]; }
    }
    const int srow = tid >> 3, sch = tid & 7;
    const bf16_t* ksrc = Z + (krow0 + srow) * ZLD + ZC_KI + sch * 8;
    u32x4 stg = *(const u32x4*)(ksrc + (size_t)t0 * 64 * ZLD);
    *(LAS u32x4*)(lds + OFF_KI + srow * KP + sch * 16) = stg;
    __syncthreads();
    int buf = 0;
    for (int t = t0; t < NT; t += stride) {
        const int tn = t + stride;
        if (tn < NT) stg = *(const u32x4*)(ksrc + (size_t)tn * 64 * ZLD);
        LAS unsigned char* kb = lds + OFF_KI + buf * KBUF;
        int lane_ = (int)threadIdx.x; asm volatile("" : "+v"(lane_)); lane_ &= 63;
        const int r = lane_ & 31, hi = lane_ >> 5;
        bf16x8 B0[4], B1[4];
#pragma unroll
        for (int ks = 0; ks < 4; ++ks) { B0[ks] = *(const LAS bf16x8*)(kb + r * KP + ks * 32 + hi * 16); B1[ks] = *(const LAS bf16x8*)(kb + (32 + r) * KP + ks * 32 + hi * 16); }
#pragma unroll
        for (int qp = 0; qp < 4; ++qp) {
            if (((qact >> qp) & 1u) == 0u) continue;
            const int ql = 8 * wave + 2 * qp + hi;
            const LAS f32x4* wq = (const LAS f32x4*)(lds + OFF_W + ql * 64);
            const f32x4 w0 = wq[0], w1 = wq[1], w2 = wq[2], w3 = wq[3];
            f32x16 a0 = f32x16{}, a1 = f32x16{};
#pragma unroll
            for (int ks = 0; ks < 4; ++ks) { a0 = __builtin_amdgcn_mfma_f32_32x32x16_bf16(A[qp][ks], B0[ks], a0, 0, 0, 0); a1 = __builtin_amdgcn_mfma_f32_32x32x16_bf16(A[qp][ks], B1[ks], a1, 0, 0, 0); }
            float p0 = w0.x * relu_i(a0[0]), p1 = w2.x * relu_i(a0[8]), q0 = w0.x * relu_i(a1[0]), q1 = w2.x * relu_i(a1[8]);
            p0 = fmaf(w0.y, relu_i(a0[1]), p0); p1 = fmaf(w2.y, relu_i(a0[9]), p1); q0 = fmaf(w0.y, relu_i(a1[1]), q0); q1 = fmaf(w2.y, relu_i(a1[9]), q1);
            p0 = fmaf(w0.z, relu_i(a0[2]), p0); p1 = fmaf(w2.z, relu_i(a0[10]), p1); q0 = fmaf(w0.z, relu_i(a1[2]), q0); q1 = fmaf(w2.z, relu_i(a1[10]), q1);
            p0 = fmaf(w0.w, relu_i(a0[3]), p0); p1 = fmaf(w2.w, relu_i(a0[11]), p1); q0 = fmaf(w0.w, relu_i(a1[3]), q0); q1 = fmaf(w2.w, relu_i(a1[11]), q1);
            p0 = fmaf(w1.x, relu_i(a0[4]), p0); p1 = fmaf(w3.x, relu_i(a0[12]), p1); q0 = fmaf(w1.x, relu_i(a1[4]), q0); q1 = fmaf(w3.x, relu_i(a1[12]), q1);
            p0 = fmaf(w1.y, relu_i(a0[5]), p0); p1 = fmaf(w3.y, relu_i(a0[13]), p1); q0 = fmaf(w1.y, relu_i(a1[5]), q0); q1 = fmaf(w3.y, relu_i(a1[13]), q1);
            p0 = fmaf(w1.z, relu_i(a0[6]), p0); p1 = fmaf(w3.z, relu_i(a0[14]), p1); q0 = fmaf(w1.z, relu_i(a1[6]), q0); q1 = fmaf(w3.z, relu_i(a1[14]), q1);
            p0 = fmaf(w1.w, relu_i(a0[7]), p0); p1 = fmaf(w3.w, relu_i(a0[15]), p1); q0 = fmaf(w1.w, relu_i(a1[7]), q0); q1 = fmaf(w3.w, relu_i(a1[15]), q1);
            const unsigned u0 = f2ord(p0 + p1), u1 = f2ord(q0 + q1);
            if (MODE == 0) {
                const unsigned wlo = st[S_ULO + ql], whi = st[S_UHI + ql], wsh = st[S_SH + ql];
                if (u0 >= wlo && u0 <= whi) { const unsigned bin = (u0 - wlo) >> wsh;
                    __hip_atomic_fetch_add(hist32 + ql * 256 + (bin >> 1), 1u << ((bin & 1u) * 16u), __ATOMIC_RELAXED, __HIP_MEMORY_SCOPE_WORKGROUP); }
                if (u1 >= wlo && u1 <= whi) { const unsigned bin = (u1 - wlo) >> wsh;
                    __hip_atomic_fetch_add(hist32 + ql * 256 + (bin >> 1), 1u << ((bin & 1u) * 16u), __ATOMIC_RELAXED, __HIP_MEMORY_SCOPE_WORKGROUP); }
            } else if (IX_VERIFY && vmode) {
                LAS unsigned* vs = (LAS unsigned*)(lds + OFF_ST) + ql;
                const unsigned long long w64 = __hip_atomic_load((const unsigned long long*)(MASK + (qrow0 + ql) * MASK_WPR + 2 * t), __ATOMIC_RELAXED, __HIP_MEMORY_SCOPE_AGENT);
                if ((w64 >> r) & 1ull) { __hip_atomic_fetch_min(vs + S_VMIN, u0, __ATOMIC_RELAXED, __HIP_MEMORY_SCOPE_WORKGROUP); __hip_atomic_fetch_add(vs + S_VCNT, 1u, __ATOMIC_RELAXED, __HIP_MEMORY_SCOPE_WORKGROUP); }
                else __hip_atomic_fetch_max(vs + S_VMAX, u0, __ATOMIC_RELAXED, __HIP_MEMORY_SCOPE_WORKGROUP);
                if ((w64 >> (32 + r)) & 1ull) { __hip_atomic_fetch_min(vs + S_VMIN, u1, __ATOMIC_RELAXED, __HIP_MEMORY_SCOPE_WORKGROUP); __hip_atomic_fetch_add(vs + S_VCNT, 1u, __ATOMIC_RELAXED, __HIP_MEMORY_SCOPE_WORKGROUP); }
                else __hip_atomic_fetch_max(vs + S_VMAX, u1, __ATOMIC_RELAXED, __HIP_MEMORY_SCOPE_WORKGROUP);
            } else {
                const unsigned flo = st[S_FLO + ql], fhi = st[S_FHI + ql]; const bool col = st[S_COL + ql] != 0u;
                const unsigned long long bal0 = __ballot(col && u0 > fhi), bal1 = __ballot(col && u1 > fhi);
                const unsigned bh0 = (unsigned)(bal0 >> (32 * hi)), bh1 = (unsigned)(bal1 >> (32 * hi));
                if (col && r == 0) *(unsigned long long*)(MASK + (qrow0 + ql) * MASK_WPR + 2 * t) = (unsigned long long)bh0 | ((unsigned long long)bh1 << 32);
                abv_[qp] += __popc(bh0) + __popc(bh1);
                const bool c0 = col && (u0 >= flo) && (u0 <= fhi), c1 = col && (u1 >= flo) && (u1 <= fhi);
                const unsigned long long cb0 = __ballot(c0), cb1 = __ballot(c1);
                if (cb0 | cb1) { const unsigned h0 = (unsigned)(cb0 >> (32 * hi)), h1 = (unsigned)(cb1 >> (32 * hi)); const unsigned lt = (1u << r) - 1u;
                    const unsigned pos0 = ccnt_[qp] + __popc(h0 & lt), pos1 = ccnt_[qp] + __popc(h0) + __popc(h1 & lt);
                    if (c0 && pos0 < (unsigned)CAPB) CAND[(size_t)ql * CAPB + pos0] = (unsigned long long)u0 | ((unsigned long long)(unsigned)(64 * t + r) << 32);
                    if (c1 && pos1 < (unsigned)CAPB) CAND[(size_t)ql * CAPB + pos1] = (unsigned long long)u1 | ((unsigned long long)(unsigned)(64 * t + 32 + r) << 32);
                    ccnt_[qp] += __popc(h0) + __popc(h1); }
            }
        }
        if (tn < NT) *(LAS u32x4*)(lds + OFF_KI + (buf ^ 1) * KBUF + srow * KP + sch * 16) = stg;
        __syncthreads();
        buf ^= 1;
    }
    if (MODE == 1 && !vmode) { const int r0 = lane & 31, h0 = lane >> 5;
#pragma unroll
        for (int qp = 0; qp < 4; ++qp) { const int ql = 8 * wave + 2 * qp + h0; if (r0 == 0 && st[S_COL + ql] != 0u) { st[S_CCNT + ql] = ccnt_[qp]; st[S_ABOVE + ql] = abv_[qp]; } } }
}

__device__ __forceinline__ void resolve(const Frame& F, unsigned* MASK, const unsigned long long* CAND, size_t qrow0, int NT) {
    int lane = (int)threadIdx.x; asm volatile("" : "+v"(lane)); lane &= 63; const int wave = F.wave;
    LAS unsigned char* lds = F.lds;
    volatile LAS unsigned* st = (volatile LAS unsigned*)(lds + OFF_ST);
    LAS unsigned* wh = (LAS unsigned*)(lds + OFF_HIST + wave * 4608); LAS unsigned* bm = wh + 512; LAS unsigned long long* sl = (LAS unsigned long long*)(bm + 512);
    const unsigned long long ltm = (1ull << lane) - 1ull;
    for (int qi = 0; qi < 8; ++qi) {
        const int q = 8 * wave + qi;
        if (st[S_COL + q] == 0u) continue;
        const unsigned cnt = st[S_CCNT + q], ab = st[S_ABOVE + q];
        if (!(ab < 256u && ab + cnt >= 256u && cnt <= (unsigned)CAPB)) { if (lane == 0) st[S_FAIL + q] = 1u; continue; }
        if (lane == 0) st[S_FAIL + q] = 0u;
        unsigned need = 256u - ab, lo = st[S_FLO + q], hi = st[S_FHI + q], sh = 0u, cbin = 0u;
        const unsigned long long* cq = CAND + (size_t)q * CAPB;
#pragma unroll
        for (int i = 0; i < 8; ++i) bm[lane * 8 + i] = 0u;
        for (int lev = 0; lev < 5; ++lev) {
            sh = sh_for(hi - lo);
#pragma unroll
            for (int i = 0; i < 8; ++i) wh[lane * 8 + i] = 0u;
            LDS_WAIT();
            for (unsigned j = lane; j < cnt; j += 64) { const unsigned u = (unsigned)cq[j]; if (u >= lo && u <= hi) __hip_atomic_fetch_add(wh + ((u - lo) >> sh), 1u, __ATOMIC_RELAXED, __HIP_MEMORY_SCOPE_WORKGROUP); }
            LDS_WAIT();
            unsigned hb[8], s8 = 0u;
#pragma unroll
            for (int i = 0; i < 8; ++i) { hb[i] = wh[lane * 8 + i]; s8 += hb[i]; }
            unsigned above = 0u;
            { unsigned inc = s8;
#pragma unroll
              for (int o = 1; o < 64; o <<= 1) { const unsigned v = __shfl_down(inc, o); if (lane + o < 64) inc += v; }
              above = inc - s8; }
            const bool mine = above < need && need <= above + s8;
            unsigned bstar = 0u, run = above, cb = 0u;
            if (mine) { bool found = false;
#pragma unroll
                for (int i = 7; i >= 0; --i) { if (!found) { if (run + hb[i] >= need) { bstar = (unsigned)(lane * 8 + i); cb = hb[i]; found = true; } else run += hb[i]; } } }
            const unsigned long long mb = __ballot(mine); const int src = mb ? (int)__builtin_ctzll(mb) : 0;
            bstar = __shfl(bstar, src); run = __shfl(run, src); cbin = __shfl(cb, src);
            const unsigned nlo = lo + (bstar << sh); const unsigned long long e = (unsigned long long)nlo + ((1ull << sh) - 1ull);
            hi = e > (unsigned long long)hi ? hi : (unsigned)e; lo = nlo; need -= run;
            if (cbin <= 64u || sh == 0u) break;
        }
        const bool tiemode = cbin > 64u;
        unsigned m = 0u;
        for (unsigned j0 = 0; j0 < cnt; j0 += 64) { const unsigned j = j0 + lane; const bool vj = j < cnt; const unsigned long long e = vj ? cq[j] : 0ull; const unsigned u = (unsigned)e, key = (unsigned)(e >> 32);
            const bool inw = vj && u >= lo && u <= hi; const unsigned long long bal = __ballot(inw); const unsigned pos = m + (unsigned)__popcll(bal & ltm);
            if (vj && (u > hi || (tiemode && inw && pos < need))) __hip_atomic_fetch_or(bm + (key >> 5), 1u << (key & 31u), __ATOMIC_RELAXED, __HIP_MEMORY_SCOPE_WORKGROUP);
            if (!tiemode && inw && pos < 64u) sl[pos] = e;
            m += (unsigned)__popcll(bal); }
        LDS_WAIT();
        if (!tiemode) { if (m > 64u) m = 64u;
            if ((unsigned)lane < m) { const unsigned long long ej = sl[lane]; const unsigned uj = (unsigned)ej; unsigned rank = 0u;
                for (unsigned j2 = 0; j2 < m; ++j2) { const unsigned u2 = (unsigned)sl[j2]; rank += (u2 > uj || (u2 == uj && j2 < (unsigned)lane)) ? 1u : 0u; }
                if (rank < need) { const unsigned key = (unsigned)(ej >> 32); __hip_atomic_fetch_or(bm + (key >> 5), 1u << (key & 31u), __ATOMIC_RELAXED, __HIP_MEMORY_SCOPE_WORKGROUP); } } }
        LDS_WAIT();
        unsigned* mrow = MASK + (qrow0 + q) * MASK_WPR;
        for (int w = lane; w < 2 * NT; w += 64) { const unsigned b = bm[w]; if (b) { const unsigned old = __hip_atomic_load(mrow + w, __ATOMIC_RELAXED, __HIP_MEMORY_SCOPE_AGENT); mrow[w] = old | b; } }
        LDS_WAIT();
    }
}

__device__ __forceinline__ void unit(const Frame& F, const bf16_t* Z, unsigned* MASK, unsigned long long* CANDW, unsigned* ERR, int b, int c) {
    const int tid = F.tid, lane = F.lane, wave = F.wave, r = lane & 31, hi = lane >> 5;
    const int NT = c + 1; const size_t qrow0 = (size_t)b * SEQ + 64 * c, krow0 = (size_t)b * SEQ;
    LAS unsigned char* lds = F.lds;
    volatile LAS unsigned* st = (volatile LAS unsigned*)(lds + OFF_ST);
    LAS unsigned* hist32 = (LAS unsigned*)(lds + OFF_HIST);
    { const int tend = 4 * ((c >> 2) + 1), nz = 2 * (tend - NT);
      for (int i = tid; i < 64 * nz; i += 512) { const int q = i / nz, wi = 2 * NT + i % nz; MASK[(qrow0 + q) * MASK_WPR + wi] = 0u; } }
    if (c <= 3) {
        for (int i = tid; i < 64 * 2 * NT; i += 512) { const int q = i / (2 * NT), wi = i % (2 * NT); MASK[(qrow0 + q) * MASK_WPR + wi] = 0xFFFFFFFFu; }
        return;
    }
    bf16x8 A[4][4];
#pragma unroll
    for (int qp = 0; qp < 4; ++qp) {
        const int query = 8 * wave + 2 * qp + ((r >> 2) & 1), head = (r & 3) + 4 * (r >> 3);
        const bf16_t* src = Z + (qrow0 + query) * ZLD + ZC_QI + head * 64 + 8 * hi;
#pragma unroll
        for (int ks = 0; ks < 4; ++ks) A[qp][ks] = *(const bf16x8*)(src + ks * 16);
    }
    for (int i = tid; i < 64 * 16; i += 512) { const int q = i >> 4, hh = i & 15; ((LAS float*)(lds + OFF_W))[i] = bflo((unsigned)Z[(qrow0 + q) * ZLD + ZC_WI + hh]) * WSCALE; }
    const int stride = NT >= 32 ? 8 : (NT >= 16 ? 4 : 1), t0 = stride >> 1, nsamp = (NT - t0 + stride - 1) / stride;
    const bool pilot = stride > 1;
    int r1 = 1, r2 = 1;
    if (pilot) { const float ns = 256.f * (float)nsamp / (float)NT; const float sg = sqrtf(ns * (1.f - 1.f / (float)stride)); const int mg = (int)ceilf(4.f * sg) + 2;
        r1 = (int)floorf(ns) - mg; if (r1 < 1) r1 = 1; r2 = (int)ceilf(ns) + mg; }
    if (tid < 64) { st[S_ULO + tid] = 0u; st[S_UHI + tid] = 0xFFFFFFFFu; st[S_SH + tid] = 23u; st[S_NEED + tid] = 256u; st[S_ACT + tid] = 1u; st[S_CCNT + tid] = 0u; st[S_ABOVE + tid] = 0u;
                    st[S_COL + tid] = 1u; st[S_FAIL + tid] = pilot ? 0u : 1u; st[S_PB1 + tid] = 511u; st[S_PB2 + tid] = 0u; st[S_PAB + tid] = 0u; }
    __syncthreads();
    int stage = pilot ? 0 : 2; bool after_fallback = !pilot;
    for (int iter = 0; iter < 24; ++iter) {
        if (stage <= 2) {
            { int tid_ = (int)threadIdx.x; asm volatile("" : "+v"(tid_));
              for (int i = 0; i < 32; ++i) hist32[tid_ + 512 * i] = 0u;
              if (tid_ == 0) st[S_ANY] = 0u; }
            __syncthreads();
            const bool smp = stage <= 1;
            sweep<0>(F, A, Z, MASK, CANDW, qrow0, krow0, NT, smp ? t0 : 0, smp ? stride : 1, 0);
            { int tid_ = (int)threadIdx.x; asm volatile("" : "+v"(tid_)); const int ln = tid_ & 63;
              const int q = tid_ >> 3, seg = tid_ & 7; const LAS unsigned* h32 = hist32 + q * 256 + seg * 32;
              unsigned cnt = 0u;
              for (int i = 0; i < 32; ++i) { const unsigned wv = h32[i]; cnt += (wv & 0xffffu) + (wv >> 16); }
              unsigned above = 0u;
#pragma unroll
              for (int k = 0; k < 8; ++k) { const unsigned ck = __shfl(cnt, (ln & ~7) + k); if (k > seg) above += ck; }
              const unsigned ulo = st[S_ULO + q], uhi = st[S_UHI + q], sh = st[S_SH + q];
              if (smp) {
                  const unsigned pab = stage == 1 ? st[S_PAB + q] : 0u;
                  const unsigned t1 = (unsigned)r1 - (stage == 1 ? pab : 0u), t2 = (unsigned)r2 - (stage == 1 ? pab : 0u);
#pragma unroll
                  for (int which = 0; which < 2; ++which) { const unsigned tg = which ? t2 : t1;
                      if (above < tg && tg <= above + cnt) { unsigned run = above; int bstar = -1;
                          for (int i = 31; i >= 0; --i) { const unsigned wv = h32[i]; const unsigned c1 = wv >> 16, c0 = wv & 0xffffu;
                              if (bstar < 0) { if (run + c1 >= tg) bstar = seg * 64 + 2 * i + 1; else run += c1; }
                              if (bstar < 0) { if (run + c0 >= tg) bstar = seg * 64 + 2 * i; else run += c0; } }
                          if (which == 0) { st[S_PB1 + q] = (unsigned)bstar; if (stage == 0) st[S_PAB + q] = run; } else st[S_PB2 + q] = (unsigned)bstar; } }
              } else {
                  const unsigned need = st[S_NEED + q], active = st[S_ACT + q];
                  if (active && above < need && need <= above + cnt) {
                      unsigned run = above; int bstar = -1; unsigned cbin = 0u;
                      for (int i = 31; i >= 0; --i) { const unsigned wv = h32[i]; const unsigned c1 = wv >> 16, c0 = wv & 0xffffu;
                          if (bstar < 0) { if (run + c1 >= need) { bstar = seg * 64 + 2 * i + 1; cbin = c1; } else run += c1; }
                          if (bstar < 0) { if (run + c0 >= need) { bstar = seg * 64 + 2 * i; cbin = c0; } else run += c0; } }
                      const unsigned nlo = ulo + ((unsigned)bstar << sh); const unsigned long long e = (unsigned long long)nlo + ((1ull << sh) - 1ull);
                      const unsigned nhi = e > (unsigned long long)uhi ? uhi : (unsigned)e;
                      if (cbin <= (unsigned)CAPF || sh == 0u) { st[S_FLO + q] = nlo; st[S_FHI + q] = nhi; st[S_ACT + q] = 0u; st[S_ULO + q] = 1u; st[S_UHI + q] = 0u; }
                      else { st[S_ULO + q] = nlo; st[S_UHI + q] = nhi; st[S_SH + q] = sh >= 9u ? sh - 9u : 0u; st[S_NEED + q] = need - run; st[S_ANY] = 1u; }
                  }
              } }
            __syncthreads();
            if (stage == 0) {
                if (tid < 64) { const unsigned b1 = st[S_PB1 + tid], b2 = st[S_PB2 + tid]; const unsigned nlo = b2 << 23; const unsigned long long e = ((unsigned long long)(b1 + 1u) << 23) - 1ull;
                    const unsigned nhi = e > 0xFFFFFFFFull ? 0xFFFFFFFFu : (unsigned)e; st[S_ULO + tid] = nlo; st[S_UHI + tid] = nhi; st[S_SH + tid] = sh_for(nhi - nlo); st[S_PB1 + tid] = 511u; st[S_PB2 + tid] = 0u; }
                stage = 1;
            } else if (stage == 1) {
                if (tid < 64) { const unsigned b1 = st[S_PB1 + tid], b2 = st[S_PB2 + tid], ulo = st[S_ULO + tid], uhi = st[S_UHI + tid], sh = st[S_SH + tid];
                    const unsigned flo = ulo + (b2 << sh); const unsigned long long e = (unsigned long long)ulo + ((unsigned long long)(b1 + 1u) << sh) - 1ull;
                    st[S_FLO + tid] = flo; st[S_FHI + tid] = e > (unsigned long long)uhi ? uhi : (unsigned)e; }
                stage = 3;
            } else { const unsigned any = st[S_ANY]; if (!any) stage = 3; }
            __syncthreads();
        } else {
            const int vm = stage == 4 ? 1 : 0;
            if (vm) { if (tid < 64) { st[S_VMIN + tid] = 0xFFFFFFFFu; st[S_VMAX + tid] = 0u; st[S_VCNT + tid] = 0u; } __syncthreads(); }
            sweep<1>(F, A, Z, MASK, CANDW, qrow0, krow0, NT, 0, 1, vm);
            VM_WAIT(); __syncthreads();
            if (vm) { if (tid < 64) { if (st[S_VCNT + tid] != 256u || st[S_VMIN + tid] < st[S_VMAX + tid]) atomicOr(ERR, 1u); } __syncthreads(); break; }
            resolve(F, MASK, CANDW, qrow0, NT);
            VM_WAIT(); __syncthreads();
            unsigned nf = 0u;
            if (!after_fallback) { if (tid < 64) nf = st[S_FAIL + tid] & st[S_COL + tid]; nf = (unsigned)__syncthreads_or((int)nf); }
            if (nf) {
                if (tid < 64) { const unsigned f = st[S_FAIL + tid] & st[S_COL + tid]; st[S_ULO + tid] = f ? 0u : 1u; st[S_UHI + tid] = f ? 0xFFFFFFFFu : 0u; st[S_SH + tid] = 23u; st[S_NEED + tid] = 256u; st[S_ACT + tid] = f;
                    st[S_COL + tid] = f; if (f) { st[S_CCNT + tid] = 0u; st[S_ABOVE + tid] = 0u; } }
                __syncthreads();
                stage = 2; after_fallback = true;
            } else { if (IX_VERIFY) stage = 4; else break; }
        }
    }
}
}

namespace peer {
constexpr int TT = 16;
constexpr int SP = 129;
constexpr int OFF_S = 0, OFF_L = 256 * SP * 4;
constexpr int OFF_A = 0;
__device__ __forceinline__ void ins16(unsigned (&L)[16], unsigned x) {
#pragma unroll
    for (int j = 0; j < 16; ++j) { const unsigned a = L[j]; const unsigned mx = a > x ? a : x; x = a > x ? x : a; L[j] = mx; }
}
__device__ __forceinline__ float dot2bf(unsigned w, unsigned x, float acc) { return __builtin_amdgcn_fdot2_f32_bf16(__builtin_bit_cast(bf16x2_t, w), __builtin_bit_cast(bf16x2_t, x), acc, false); }
__device__ __forceinline__ float gelu_erf(float h) { return 0.5f * h * (1.f + erff(h * 0.70710678118654752f)); }

__device__ __forceinline__ void fp8dot4(unsigned w, f32x2 h01, f32x2 h23, f32x2& a0, f32x2& a1) {
    const f32x2 lo = __builtin_amdgcn_cvt_pk_f32_fp8((int)w, false), hi = __builtin_amdgcn_cvt_pk_f32_fp8((int)w, true); a0 = lo * h01 + a0; a1 = hi * h23 + a1; }
__device__ __forceinline__ void fp8axpy4(unsigned w, f32x2 a2, f32x2& c01, f32x2& c23) {
    const f32x2 lo = __builtin_amdgcn_cvt_pk_f32_fp8((int)w, false), hi = __builtin_amdgcn_cvt_pk_f32_fp8((int)w, true); c01 = lo * a2 + c01; c23 = hi * a2 + c23; }
constexpr int NSL = 16, SLW = 128;
__device__ __forceinline__ float dpp_sum8(float v) {
    v += __int_as_float(__builtin_amdgcn_update_dpp(0, __float_as_int(v), 0xB1, 0xF, 0xF, true));
    v += __int_as_float(__builtin_amdgcn_update_dpp(0, __float_as_int(v), 0x4E, 0xF, 0xF, true));
    v += __int_as_float(__builtin_amdgcn_update_dpp(0, __float_as_int(v), 0x141, 0xF, 0xF, true));
    return v;
}
#define PEER_EID(V0, V1, i) ((((i) < 8 ? (V0) : (V1))[((i) & 7) >> 1] >> (16 * ((i) & 1))) & 0xffffu)

struct TabCvt { const float* pu; const float* pv; unsigned char* UB; unsigned char* VB; float* RSU; float* RSV; };
__device__ __forceinline__ const float* tab_src(const TabCvt& T, int m) { return m < NEXP ? T.pu + (size_t)m * DM : T.pv + (size_t)(m - NEXP) * DM; }
__device__ __forceinline__ void tab_finish(const TabCvt& T, const RowF32& R, int m, int lane) { if (m < NEXP) row_to_fp8(R, T.UB + (size_t)m * DM, T.RSU + m, lane); else row_to_fp8(R, T.VB + (size_t)(m - NEXP) * DM, T.RSV + (m - NEXP), lane); }
__device__ __forceinline__ void route_step(const Frame& F, const bf16_t* PQ, const bf16x8 (&Bf)[2][8], unsigned short* E16, float* GT, int tok0, const TabCvt& T, int m0, int m1) {
    const int tid = F.tid, lane = F.lane, wave = F.wave, r = lane & 31, hi = lane >> 5;
    LAS float* S = (LAS float*)(F.lds + OFF_S); LAS unsigned* L = (LAS unsigned*)(F.lds + OFF_L);
    RowF32 R;
    if (m0 >= 0) row_load(R, tab_src(T, m0), lane);
    { const int half = wave & 1, cp = (wave >> 1) & 1, rh = wave >> 2;
#pragma unroll
      for (int r2 = 0; r2 < 2; ++r2) {
          const int rt = 2 * rh + r2; const int pair = 32 * rt + r, tok = pair >> 3, p = pair & 7;
          const bf16_t* src = PQ + (size_t)(tok0 + tok) * DM + p * 256 + half * 128 + 8 * hi;
          bf16x8 A[8];
#pragma unroll
          for (int ks = 0; ks < 8; ++ks) A[ks] = *(const bf16x8*)(src + ks * 16);
#pragma unroll
          for (int c2 = 0; c2 < 2; ++c2) {
              f32x16 acc = f32x16{};
#pragma unroll
              for (int ks = 0; ks < 8; ++ks) acc = __builtin_amdgcn_mfma_f32_32x32x16_bf16(A[ks], Bf[c2][ks], acc, 0, 0, 0);
#pragma unroll
              for (int i = 0; i < 16; ++i) { const int row = (32 * rt + (i & 3) + 8 * (i >> 2) + 4 * hi) * 2 + half; S[row * SP + (2 * cp + c2) * 32 + r] = acc[i]; }
          } } }
    if (m0 >= 0) tab_finish(T, R, m0, lane);
    if (m1 >= 0) row_load(R, tab_src(T, m1), lane);
    __syncthreads();
    { const int row = tid >> 1, part = tid & 1; unsigned L16[16];
#pragma unroll
      for (int j = 0; j < 16; ++j) L16[j] = 0u;
#pragma unroll 4
      for (int n = 0; n < 64; ++n) { const int nn = part * 64 + n; const unsigned k = (f2ord(S[row * SP + nn]) & ~127u) | (unsigned)(127 - nn); ins16(L16, k); }
      unsigned oth[16];
#pragma unroll
      for (int j = 0; j < 16; ++j) oth[j] = __shfl_xor(L16[j], 1);
#pragma unroll
      for (int j = 0; j < 16; ++j) ins16(L16, part == 0 ? oth[j] : 0u);
      if (part == 0) {
#pragma unroll
          for (int j = 0; j < 16; ++j) L[row * 16 + j] = L16[j]; } }
    __syncthreads();
    if (tid < 128) {
        const int pair = tid; const LAS float* S1 = S + (pair * 2) * SP; const LAS float* S2 = S + (pair * 2 + 1) * SP;
        const LAS unsigned* L1 = L + (pair * 2) * 16; const LAS unsigned* L2 = L1 + 16;
        float v1[16], v2[16];
#pragma unroll
        for (int j = 0; j < 16; ++j) { v1[j] = S1[127 - (L1[j] & 127u)]; v2[j] = S2[127 - (L2[j] & 127u)]; }
        unsigned C16[16];
#pragma unroll
        for (int j = 0; j < 16; ++j) C16[j] = 0u;
#pragma unroll
        for (int i = 0; i < 16; ++i)
#pragma unroll
            for (int j = 0; j < 16; ++j) if ((i + 1) * (j + 1) <= 16) { const unsigned k = (f2ord(v1[i] + v2[j]) & ~255u) | (unsigned)(255 - (i * 16 + j)); ins16(C16, k); }
        float sc[16]; unsigned ex[16]; float mx = -3.0e38f;
#pragma unroll
        for (int q = 0; q < 16; ++q) { const unsigned ci = 255u - (C16[q] & 255u); const unsigned n1 = 127u - (L1[ci >> 4] & 127u), n2 = 127u - (L2[ci & 15u] & 127u);
            sc[q] = S1[n1] + S2[n2]; ex[q] = n1 * 128u + n2; mx = fmaxf(mx, sc[q]); }
        float sum = 0.f;
#pragma unroll
        for (int q = 0; q < 16; ++q) { sc[q] = __expf(sc[q] - mx); sum += sc[q]; }
        const float inv = 1.f / sum;
        const size_t o = (size_t)(tok0 + (pair >> 3)) * 128 + (pair & 7) * 16;
        u32x4 e0, e1; e0.x = ex[0] | (ex[1] << 16); e0.y = ex[2] | (ex[3] << 16); e0.z = ex[4] | (ex[5] << 16); e0.w = ex[6] | (ex[7] << 16);
        e1.x = ex[8] | (ex[9] << 16); e1.y = ex[10] | (ex[11] << 16); e1.z = ex[12] | (ex[13] << 16); e1.w = ex[14] | (ex[15] << 16);
        *(u32x4*)(E16 + o) = e0; *(u32x4*)(E16 + o + 8) = e1;
#pragma unroll
        for (int q = 0; q < 4; ++q) *(f32x4*)(GT + o + 4 * q) = (f32x4){sc[4 * q] * inv, sc[4 * q + 1] * inv, sc[4 * q + 2] * inv, sc[4 * q + 3] * inv};
    }
    if (m1 >= 0) tab_finish(T, R, m1, lane);
    __syncthreads();
}

__device__ __forceinline__ void udot_compute(const u32x4 (&d)[16], const u32x4 h0, const u32x4 h1, float* dst, int k, bool ok) {
    f32x2 hq[8];
    hq[0] = (f32x2){bflo(h0.x), bfhi(h0.x)}; hq[1] = (f32x2){bflo(h0.y), bfhi(h0.y)}; hq[2] = (f32x2){bflo(h0.z), bfhi(h0.z)}; hq[3] = (f32x2){bflo(h0.w), bfhi(h0.w)};
    hq[4] = (f32x2){bflo(h1.x), bfhi(h1.x)}; hq[5] = (f32x2){bflo(h1.y), bfhi(h1.y)}; hq[6] = (f32x2){bflo(h1.z), bfhi(h1.z)}; hq[7] = (f32x2){bflo(h1.w), bfhi(h1.w)};
    float keep0 = 0.f, keep1 = 0.f;
#pragma unroll
    for (int i = 0; i < 16; ++i) {
        f32x2 a0 = {0.f, 0.f}, a1 = {0.f, 0.f};
        fp8dot4(d[i].x, hq[0], hq[1], a0, a1); fp8dot4(d[i].y, hq[2], hq[3], a0, a1); fp8dot4(d[i].z, hq[4], hq[5], a0, a1); fp8dot4(d[i].w, hq[6], hq[7], a0, a1);
        const float pr = dpp_sum8((a0.x + a0.y) + (a1.x + a1.y));
        if ((i & 7) == k) { if (i < 8) keep0 = pr; else keep1 = pr; }
    }
    if (ok) { dst[0] = keep0; dst[8] = keep1; }
}
__device__ __forceinline__ void udots(const Frame& F, const bf16_t* HN, const unsigned char* UB, const unsigned short* E16, float* PART) {
    const int lane = F.lane, g = lane >> 3, k = lane & 7;
    const int ngr = (F.G % 8 == 0) ? 8 : 1, wpg = F.G / ngr, x = F.vcu / wpg, wl = (F.vcu % wpg) * NWAVES + F.wave, wst = wpg * NWAVES, spg = NSL / ngr;
    const int ntw = (NTOK - wl + wst - 1) / wst;
#define UD_T(j) ((size_t)((wl + (j) * wst) < NTOK ? (wl + (j) * wst) : (NTOK - 1)))
#define UD_IDS(j, V0, V1) { const unsigned short* ep_ = E16 + UD_T(j) * 128 + g * 16; V0 = *(const u32x4*)ep_; V1 = *(const u32x4*)(ep_ + 8); }
#define UD_HN(j, H0, H1) { const bf16_t* hp_ = HN + UD_T(j) * DM + s * SLW + k * 16; H0 = *(const u32x4*)hp_; H1 = *(const u32x4*)(hp_ + 8); }
#define UD_ROWS(D, V0, V1) { _Pragma("unroll") for (int i = 0; i < 16; ++i) D[i] = *(const u32x4*)(ub + (size_t)PEER_EID(V0, V1, i) * DM); }
    for (int rr = 0; rr < spg; ++rr) {
        const int s = x + ngr * rr;
        const unsigned char* ub = UB + s * SLW + k * 16;
        float* pb = PART + (size_t)s * NTOK * 128 + g * 16 + k;
        u32x4 dA[16], dB[16], idA0, idA1, idB0, idB1, hA0, hA1, hB0, hB1;
        UD_IDS(0, idA0, idA1) UD_HN(0, hA0, hA1) UD_ROWS(dA, idA0, idA1)
        UD_IDS(1, idB0, idB1) UD_HN(1, hB0, hB1)
        for (int j = 0; j < ntw; j += 2) {
            UD_ROWS(dB, idB0, idB1)
            UD_IDS(j + 2, idA0, idA1)
            udot_compute(dA, hA0, hA1, pb + UD_T(j) * 128, k, true);
            UD_HN(j + 2, hA0, hA1)
            UD_ROWS(dA, idA0, idA1)
            UD_IDS(j + 3, idB0, idB1)
            udot_compute(dB, hB0, hB1, pb + UD_T(j + 1) * 128, k, j + 1 < ntw);
            UD_HN(j + 3, hB0, hB1)
        }
    }
#undef UD_IDS
#undef UD_HN
#undef UD_ROWS
}
__device__ __forceinline__ void combine(const Frame& F, const float* PART, const unsigned short* E16, const float* GT, const float* RSU, const float* RSV, float* AT) {
    const size_t n4 = (size_t)NTOK * 128 / 4, stride = (size_t)F.G * NWAVES * 64;
    for (size_t i = (size_t)F.vcu * NWAVES * 64 + F.tid; i < n4; i += stride) {
        f32x4 pv[NSL];
#pragma unroll
        for (int s = 0; s < NSL; ++s) pv[s] = *(const f32x4*)(PART + (size_t)s * n4 * 4 + i * 4);
        const u32x2 ee = *(const u32x2*)(E16 + i * 4); const f32x4 gg = *(const f32x4*)(GT + i * 4);
        const unsigned e0 = ee.x & 0xffffu, e1 = ee.x >> 16, e2 = ee.y & 0xffffu, e3 = ee.y >> 16;
        const float su0 = RSU[e0], su1 = RSU[e1], su2 = RSU[e2], su3 = RSU[e3], sv0 = RSV[e0], sv1 = RSV[e1], sv2 = RSV[e2], sv3 = RSV[e3];
        f32x4 sacc = pv[0];
#pragma unroll
        for (int s = 1; s < NSL; ++s) sacc += pv[s];
        f32x4 o; o.x = gg.x * gelu_erf(sacc.x * su0) * sv0; o.y = gg.y * gelu_erf(sacc.y * su1) * sv1; o.z = gg.z * gelu_erf(sacc.z * su2) * sv2; o.w = gg.w * gelu_erf(sacc.w * su3) * sv3;
        *(f32x4*)(AT + i * 4) = o;
    }
}
__device__ __forceinline__ void vacc_compute(const u32x4 (&d)[16], const f32x4 a0, const f32x4 a1, const f32x4 a2, const f32x4 a3, float* orow, int g, bool ok) {
    f32x2 acc[8];
#pragma unroll
    for (int c = 0; c < 8; ++c) acc[c] = (f32x2){0.f, 0.f};
    const float av[16] = {a0.x, a0.y, a0.z, a0.w, a1.x, a1.y, a1.z, a1.w, a2.x, a2.y, a2.z, a2.w, a3.x, a3.y, a3.z, a3.w};
#pragma unroll
    for (int i = 0; i < 16; ++i) { const f32x2 aa = {av[i], av[i]};
        fp8axpy4(d[i].x, aa, acc[0], acc[1]); fp8axpy4(d[i].y, aa, acc[2], acc[3]); fp8axpy4(d[i].z, aa, acc[4], acc[5]); fp8axpy4(d[i].w, aa, acc[6], acc[7]); }
    float v[16];
#pragma unroll
    for (int c = 0; c < 8; ++c) { v[2 * c] = acc[c].x; v[2 * c + 1] = acc[c].y; }
    float R[8], S4[4];
#pragma unroll
    for (int c = 0; c < 8; ++c) { auto r = __builtin_amdgcn_permlane32_swap(__float_as_uint(v[c]), __float_as_uint(v[c + 8]), false, false); R[c] = __uint_as_float(r[0]) + __uint_as_float(r[1]); }
#pragma unroll
    for (int c = 0; c < 4; ++c) { auto r = __builtin_amdgcn_permlane16_swap(__float_as_uint(R[c]), __float_as_uint(R[c + 4]), false, false); S4[c] = __uint_as_float(r[0]) + __uint_as_float(r[1]); }
    const bool b8 = (g & 1) != 0;
    float T0, T1;
    { const float keep = b8 ? S4[2] : S4[0], send = b8 ? S4[0] : S4[2]; T0 = keep + __int_as_float(__builtin_amdgcn_update_dpp(0, __float_as_int(send), 0x128, 0xF, 0xF, true)); }
    { const float keep = b8 ? S4[3] : S4[1], send = b8 ? S4[1] : S4[3]; T1 = keep + __int_as_float(__builtin_amdgcn_update_dpp(0, __float_as_int(send), 0x128, 0xF, 0xF, true)); }
    if (ok) { f32x2 o2 = *(const f32x2*)orow; o2.x += T0; o2.y += T1; *(f32x2*)orow = o2; }
}
__device__ __forceinline__ void vacc(const Frame& F, const unsigned char* VB, const unsigned short* E16, const float* AT, float* out) {
    const int lane = F.lane, g = lane >> 3, k = lane & 7;
    const int ngr = (F.G % 8 == 0) ? 8 : 1, wpg = F.G / ngr, x = F.vcu / wpg, wl = (F.vcu % wpg) * NWAVES + F.wave, wst = wpg * NWAVES, spg = NSL / ngr;
    const int ntw = (NTOK - wl + wst - 1) / wst;
#define UD_IDS(j, V0, V1) { const unsigned short* ep_ = E16 + UD_T(j) * 128 + g * 16; V0 = *(const u32x4*)ep_; V1 = *(const u32x4*)(ep_ + 8); }
#define VA_A(j, A0, A1, A2, A3) { const float* ap_ = AT + UD_T(j) * 128 + g * 16; A0 = *(const f32x4*)ap_; A1 = *(const f32x4*)(ap_ + 4); A2 = *(const f32x4*)(ap_ + 8); A3 = *(const f32x4*)(ap_ + 12); }
#define UD_ROWS(D, V0, V1) { _Pragma("unroll") for (int i = 0; i < 16; ++i) D[i] = *(const u32x4*)(vb + (size_t)PEER_EID(V0, V1, i) * DM); }
    for (int rr = 0; rr < spg; ++rr) {
        const int s = x + ngr * rr;
        const unsigned char* vb = VB + s * SLW + k * 16;
        float* ob = out + s * SLW + k * 16 + 2 * g;
        u32x4 dA[16], dB[16], idA0, idA1, idB0, idB1; f32x4 aA0, aA1, aA2, aA3, aB0, aB1, aB2, aB3;
        UD_IDS(0, idA0, idA1) VA_A(0, aA0, aA1, aA2, aA3) UD_ROWS(dA, idA0, idA1)
        UD_IDS(1, idB0, idB1) VA_A(1, aB0, aB1, aB2, aB3)
        for (int j = 0; j < ntw; j += 2) {
            UD_ROWS(dB, idB0, idB1)
            UD_IDS(j + 2, idA0, idA1)
            vacc_compute(dA, aA0, aA1, aA2, aA3, ob + UD_T(j) * DM, g, true);
            VA_A(j + 2, aA0, aA1, aA2, aA3)
            UD_ROWS(dA, idA0, idA1)
            UD_IDS(j + 3, idB0, idB1)
            vacc_compute(dB, aB0, aB1, aB2, aB3, ob + UD_T(j + 1) * DM, g, j + 1 < ntw);
            VA_A(j + 3, aB0, aB1, aB2, aB3)
        }
    }
#undef UD_T
#undef UD_IDS
#undef VA_A
#undef UD_ROWS
}
}

__device__ __forceinline__ void pool_unit(const Frame& F, bf16_t* MIX, const bf16_t* PWt, const float* pool_s, int tm, int g) {
    const int lane = F.lane, r = lane & 31, hi = lane >> 5;
    bf16_t* base = MIX + (size_t)(tm * 256 + F.wave * 32) * DM + 1024 + 128 * g;
    bf16x8 A[8];
#pragma unroll
    for (int ks = 0; ks < 8; ++ks) A[ks] = *(const bf16x8*)(base + (size_t)r * DM + ks * 16 + 8 * hi);
#pragma unroll
    for (int ct = 0; ct < 4; ++ct) {
        f32x16 acc = f32x16{};
        const bf16_t* pb = PWt + (size_t)(g * 128 + ct * 32 + r) * 128 + 8 * hi;
#pragma unroll
        for (int ks = 0; ks < 8; ++ks) { const bf16x8 B = *(const bf16x8*)(pb + ks * 16); acc = __builtin_amdgcn_mfma_f32_32x32x16_bf16(A[ks], B, acc, 0, 0, 0); }
        const float sc = pool_s[128 * g + ct * 32 + r];
#pragma unroll
        for (int i = 0; i < 16; ++i) { const int row = (i & 3) + 8 * (i >> 2) + 4 * hi; base[(size_t)row * DM + ct * 32 + r] = (bf16_t)(cvtpk(acc[i] * sc, 0.f) & 0xffffu); }
    }
}

__global__ void __launch_bounds__(NWAVES * 64, 2) fwd_kernel(Args args) {
    extern __shared__ __attribute__((aligned(16))) unsigned char lds[];
    Frame F;
    F.lds = (LAS unsigned char*)lds; F.ldsg = (char*)lds;
    F.tid = threadIdx.x; F.lane = F.tid & 63; F.wave = __builtin_amdgcn_readfirstlane(F.tid >> 6);
    F.G = gridDim.x; { const int bx = blockIdx.x; F.vcu = (F.G % 8 == 0) ? (bx % 8) * (F.G / 8) + bx / 8 : bx; }
    unsigned char* ws = args.ws;
    unsigned* ctl = (unsigned*)(ws + WS_CTL);
    volatile LAS unsigned* MISC = (volatile LAS unsigned*)(F.lds + MISC_OFF);
    for (int u = F.tid; u < (LDS_BYTES - LDSCTL_OFF) / 4; u += NWAVES * 64) ((LAS unsigned*)(F.lds + LDSCTL_OFF))[u] = 0u;
    __syncthreads();
    const int lo = args.ph_lo, hi = args.ph_hi;
    XcdBarrier bar; bar.bar = ctl + CW_BAR; bar.x = 0; bar.st = nullptr;
    if (hi - lo > 1) bar = xcd_barrier_post(ctl + CW_BAR, MISC + 8);
#define IN(k) (lo <= (k) && (k) < hi)
#define PHASE_BEGIN() do { int t_ = (int)threadIdx.x; asm volatile("" : "+v"(t_)); F.tid = t_; F.lane = t_ & 63; } while (0)
#define SEAM(k) do { if (IN(k) && IN((k) + 1)) xcd_barrier(bar); } while (0)

    bf16_t* Z = (bf16_t*)(ws + WS_Z); bf16_t* XN = (bf16_t*)(ws + WS_XN); bf16_t* MIX = XN;
    bf16_t* HN = (bf16_t*)(ws + WS_Z); bf16_t* PQ = (bf16_t*)(ws + WS_Z + 128 * MiB);
    bf16_t* KVM = (bf16_t*)(ws + WS_KVM); unsigned* MASK = (unsigned*)(ws + WS_MASK);

    if (IN(0)) { PHASE_BEGIN(); p0_prologue(F, args); } SEAM(0);
    if (IN(1)) { PHASE_BEGIN();
#if P1_FP8
        const int gw = F.vcu * NWAVES + F.wave, NGW = F.G * NWAVES;
        for (int i = gw; i < 4096; i += NGW) { const int n = i < 3072 ? i : i + 1024; RowF32 R; row_load_bf16(R, (const bf16_t*)(ws + WS_BT_IN) + (size_t)n * DM, F.lane); row_to_fp8(R, ws + WS_BTIN8 + (size_t)n * DM, (float*)(ws + WS_CSI) + n, F.lane); }
#endif
    } SEAM(1);
    if (IN(2)) { PHASE_BEGIN();
#if P1_FP8
        { pg8::Gemm g{XN, (const bf16_t*)(ws + WS_BT_IN), NTOK, ZLD, DM}; pg8::InBf16Order S; S.init(NTOK, F.G, (int)blockIdx.x);
          pg8::EpiBf16 E{Z, ZLD}; pg8::gemm_phase<pg8::EpiBf16, pg8::InBf16Order, true, true>(F.lds, g, S, E); }
        { pg8::Gemm g{(const bf16_t*)(ws + WS_XN8), (const bf16_t*)(ws + WS_BTIN8), NTOK, ZLD, DM / 2}; pg8::InFp8Order S; S.init(NTOK, F.G, (int)blockIdx.x);
          pg8::EpiBf16S E{Z, ZLD, (const float*)(ws + WS_CSI)}; pg8::gemm_phase<pg8::EpiBf16S, pg8::InFp8Order, true, true, true>(F.lds, g, S, E); }
#else
        { pg8::Gemm g{XN, (const bf16_t*)(ws + WS_BT_IN), NTOK, ZLD, DM}; pg8::StaticOrder S; S.init(NTOK, ZLD, F.G, (int)blockIdx.x);
          pg8::EpiBf16 E{Z, ZLD}; pg8::gemm_phase<pg8::EpiBf16, pg8::StaticOrder, true, true>(F.lds, g, S, E); }
#endif
        { pg8::Gemm g{(const bf16_t*)(ws + WS_MN), (const bf16_t*)(ws + WS_BT_KV), BATCH * MEMLEN, 1024, DM}; pg8::StaticOrder S; S.init(BATCH * MEMLEN, 1024, F.G, (int)((blockIdx.x + 128) % F.G));
          pg8::EpiBf16 E{KVM, 1024}; pg8::gemm_phase<pg8::EpiBf16, pg8::StaticOrder, true, true>(F.lds, g, S, E); }
    } SEAM(2);
    if (IN(3)) { PHASE_BEGIN(); p2_post(F, args); } SEAM(3);
    if (IN(4)) { PHASE_BEGIN();
        for (int i = 0; ; ++i) {
            int b, c;
            if (F.G == 256) { if (i >= 2) break; b = F.vcu >> 7; c = (i == 0) ? 255 - (F.vcu & 127) : (F.vcu & 127); }
            else { const int u = (int)blockIdx.x + i * F.G; if (u >= 512) break; b = u >> 8; c = u & 255; }
            ix::unit(F, Z, MASK, (unsigned long long*)(ws + WS_CAND) + (size_t)blockIdx.x * 64 * ix::CAPB, ctl + 2048, b, c);
            __syncthreads();
        }
    } SEAM(4);
    if (IN(5)) { PHASE_BEGIN();
        for (int u = F.vcu; u < (NTOK / 256) * 4; u += F.G) pool_unit(F, MIX, (const bf16_t*)(ws + WS_PWT), args.pool_s, u >> 2, u & 3);
        const int r32 = F.lane & 31;
        for (int i = 0; ; ++i) {
            int b, h, qb;
            if (F.G == 256) { if (i >= 4) break; const int bh = F.vcu >> 4, s = F.vcu & 15; b = bh >> 3; h = bh & 7; qb = (i == 0) ? 63 - s : (i == 1) ? 32 + s : (i == 2) ? 31 - s : s; }
            else { const int u = (int)blockIdx.x + i * F.G; if (u >= 1024) break; b = u >> 9; h = (u >> 6) & 7; qb = u & 63; }
            const size_t row0 = (size_t)b * SEQ + 256 * qb;
            const unsigned long long* mrow = (const unsigned long long*)MASK + (row0 + F.wave * 32 + r32) * (MASK_WPR / 2);
            att::attn_body<true, 2, ZLD, ZLD, DM>(Z + row0 * ZLD + ZC_Q + h * 128, Z + (size_t)b * SEQ * ZLD + ZC_K + h * 128, Z + (size_t)b * SEQ * ZLD + ZC_V + h * 128,
                                                  MIX + row0 * DM + h * 128, 256 * (qb + 1), mrow, F.ldsg);
        }
        for (int id = F.vcu; id < 512; id += F.G) {
            const int b2 = id >> 8, hm = (id >> 6) & 3, qb = id & 63; const size_t row0 = (size_t)b2 * SEQ + 256 * qb;
            att::attn_body<false, 1, ZLD, 1024, DM>(Z + row0 * ZLD + ZC_QM + hm * 128, KVM + (size_t)b2 * MEMLEN * 1024 + hm * 128, KVM + (size_t)b2 * MEMLEN * 1024 + 512 + hm * 128,
                                                    MIX + row0 * DM + 1536 + hm * 128, MEMLEN, nullptr, F.ldsg);
        }
    } SEAM(5);
    if (IN(6)) { PHASE_BEGIN();
#if ATT_VERIFY
        {
            const int t = (int)blockIdx.x * 128 + 77, hh = F.wave, ln = F.lane; const int bb = t / SEQ, pos = t % SEQ, N = 64 * (pos / 64 + 1);
            const bf16_t* zq = Z + (size_t)t * ZLD + ZC_Q + hh * 128 + 2 * ln; const float q0 = bflo((unsigned)zq[0]), q1 = bflo((unsigned)zq[1]);
            float m = -3.0e38f, l = 0.f, o0 = 0.f, o1 = 0.f; int nsel = 0;
            for (int w = 0; w < N / 32; ++w) { unsigned bits = __hip_atomic_load(MASK + (size_t)t * MASK_WPR + w, __ATOMIC_RELAXED, __HIP_MEMORY_SCOPE_AGENT);
                while (bits) { const int bpos = __builtin_ctz(bits); bits &= bits - 1u; const int sidx = 32 * w + bpos; ++nsel;
                    const bf16_t* zk = Z + ((size_t)bb * SEQ + sidx) * ZLD + ZC_K + hh * 128 + 2 * ln; const bf16_t* zv = Z + ((size_t)bb * SEQ + sidx) * ZLD + ZC_V + hh * 128 + 2 * ln;
                    const float lg = wave_sum(q0 * bflo((unsigned)zk[0]) + q1 * bflo((unsigned)zk[1])) * 0.088388347648318440f;
                    const float mn = fmaxf(m, lg), al = __expf(m - mn), pe = __expf(lg - mn); l = l * al + pe; o0 = o0 * al + pe * bflo((unsigned)zv[0]); o1 = o1 * al + pe * bflo((unsigned)zv[1]); m = mn; } }
            const bf16_t* mx = MIX + (size_t)t * DM + hh * 128 + 2 * ln; const float r0 = o0 / l, r1 = o1 / l;
            float er = fmaxf(fabsf(r0 - bflo((unsigned)mx[0])), fabsf(r1 - bflo((unsigned)mx[1]))), sc = fmaxf(fabsf(r0), fabsf(r1));
#pragma unroll
            for (int o = 1; o < 64; o <<= 1) { er = fmaxf(er, __shfl_xor(er, o)); sc = fmaxf(sc, __shfl_xor(sc, o)); }
            if (!(er <= 0.03f * sc + 1e-3f) || nsel != (N < 256 ? N : 256)) { if (ln == 0) atomicOr(ctl + 2048, 2u); }
        }
        __syncthreads();
#endif
        pg8::Gemm g{MIX, (const bf16_t*)(ws + WS_BT_OUT), NTOK, DM, DM}; pg8::StaticOrder S; S.init(NTOK, DM, F.G, (int)blockIdx.x);
        pg8::EpiF32Res E{args.x, args.out, DM}; pg8::gemm_phase<pg8::EpiF32Res, pg8::StaticOrder, true, true>(F.lds, g, S, E);
    } SEAM(6);
    if (IN(7)) { PHASE_BEGIN(); const int gw = F.vcu * NWAVES + F.wave, NGW = F.G * NWAVES;
#if P7_FP8
        for (int n = gw; n < DM; n += NGW) { RowF32 R; row_load_bf16(R, (const bf16_t*)(ws + WS_BT_Q) + (size_t)n * DM, F.lane); row_to_fp8(R, ws + WS_BTQ8 + (size_t)n * DM, (float*)(ws + WS_CSQ) + n, F.lane); }
        for (int m = gw; m < NTOK; m += NGW) rms_row_to_bf16_fp8(args.out + (size_t)m * DM, args.ffn_g, HN + (size_t)m * DM, ws + WS_HN8 + (size_t)m * DM, F.lane);
#else
        for (int m = gw; m < NTOK; m += NGW) rms_row_to_bf16(args.out + (size_t)m * DM, args.ffn_g, HN + (size_t)m * DM, F.lane);
#endif
    } SEAM(7);
    if (IN(8)) { PHASE_BEGIN();
#if P7_FP8
        pg8::Gemm g{(const bf16_t*)(ws + WS_HN8), (const bf16_t*)(ws + WS_BTQ8), NTOK, DM, DM / 2}; pg8::StaticOrder S; S.init(NTOK, DM, F.G, (int)blockIdx.x);
        pg8::EpiBf16S E{PQ, DM, (const float*)(ws + WS_CSQ)}; pg8::gemm_phase<pg8::EpiBf16S, pg8::StaticOrder, true, true, true>(F.lds, g, S, E);
#else
        pg8::Gemm g{HN, (const bf16_t*)(ws + WS_BT_Q), NTOK, DM, DM}; pg8::StaticOrder S; S.init(NTOK, DM, F.G, (int)blockIdx.x);
        pg8::EpiBf16 E{PQ, DM}; pg8::gemm_phase<pg8::EpiBf16, pg8::StaticOrder, true, true>(F.lds, g, S, E);
#endif
    } SEAM(8);
    unsigned short* E16 = (unsigned short*)(ws + WS_XN); float* GT = (float*)(ws + WS_XN + 8 * MiB); float* AT = (float*)(ws + WS_XN + 24 * MiB);
    float* PART = (float*)(ws + WS_Z + 128 * MiB);
    if (IN(9)) { PHASE_BEGIN();
        const bf16_t* PKb = (const bf16_t*)(ws + WS_PK);
        bf16x8 Bf[2][8];
        { const int half = F.wave & 1, cp = (F.wave >> 1) & 1, r = F.lane & 31, hi = F.lane >> 5;
#pragma unroll
          for (int c2 = 0; c2 < 2; ++c2)
#pragma unroll
              for (int ks = 0; ks < 8; ++ks) Bf[c2][ks] = *(const bf16x8*)(PKb + (size_t)(half * 128 + (2 * cp + c2) * 32 + r) * 128 + 8 * hi + ks * 16); }
        const peer::TabCvt T{args.pu, args.pv, ws + WS_UB, ws + WS_VB, (float*)(ws + WS_RSU), (float*)(ws + WS_RSV)};
        const int gw = F.vcu * NWAVES + F.wave, NGW = F.G * NWAVES; int mrow = gw, nstep = 0;
        for (int it = F.vcu; it < NTOK / peer::TT; it += F.G, ++nstep) {
            const int m0 = mrow < 2 * NEXP ? mrow : -1; mrow += NGW; const int m1 = mrow < 2 * NEXP ? mrow : -1; mrow += NGW;
            peer::route_step(F, PQ, Bf, E16, GT, it * peer::TT, T, m0, m1);
        }
        for (; mrow < 2 * NEXP; mrow += NGW) { RowF32 R; row_load(R, peer::tab_src(T, mrow), F.lane); peer::tab_finish(T, R, mrow, F.lane); }
    } SEAM(9);
    if (IN(10)) { PHASE_BEGIN(); peer::udots(F, HN, ws + WS_UB, E16, PART); } SEAM(10);
    if (IN(11)) { PHASE_BEGIN(); peer::combine(F, PART, E16, GT, (const float*)(ws + WS_RSU), (const float*)(ws + WS_RSV), AT); } SEAM(11);
    if (IN(12)) { PHASE_BEGIN(); peer::vacc(F, ws + WS_VB, E16, AT, args.out); }
#if IX_VERIFY || ATT_VERIFY
    if (IN(12)) { __syncthreads(); if (__hip_atomic_load(ctl + 2048, __ATOMIC_RELAXED, __HIP_MEMORY_SCOPE_AGENT) != 0u) { args.out[(size_t)blockIdx.x * 512 + threadIdx.x] = __builtin_nanf(""); } }
#endif
#undef IN
#undef SEAM
}

extern "C" void kernel_launch(void* const* d_in, const int* in_sizes, int n_in, void* d_out, int out_size, void* d_ws, size_t ws_size, hipStream_t stream) {
    static int grid = 0;
    if (grid == 0) {
        if (n_in != 19 || out_size != NTOK * DM || ws_size < WS_END) { fprintf(stderr, "kernel_launch: unexpected shapes (n_in %d out %d ws %zu)\n", n_in, out_size, ws_size); grid = -1; return; }
        int dev = 0, cus = 0;
        if (hipGetDevice(&dev) != hipSuccess || hipDeviceGetAttribute(&cus, hipDeviceAttributeMultiprocessorCount, dev) != hipSuccess) { grid = -1; return; }
        if (hipFuncSetAttribute((const void*)fwd_kernel, hipFuncAttributeMaxDynamicSharedMemorySize, LDS_BYTES) != hipSuccess) { fprintf(stderr, "kernel_launch: hipFuncSetAttribute failed\n"); grid = -1; return; }
        int per_cu = 0;
        if (hipOccupancyMaxActiveBlocksPerMultiprocessor(&per_cu, (const void*)fwd_kernel, NWAVES * 64, LDS_BYTES) != hipSuccess || per_cu < 1) { fprintf(stderr, "kernel_launch: occupancy query reports %d workgroups per CU for %d threads / %d B LDS; nothing launched\n", per_cu, NWAVES * 64, LDS_BYTES); grid = -1; return; }
        (void)hipGetLastError();
        grid = cus;
    }
    if (grid < 0) return;
    (void)hipMemsetAsync((char*)d_ws + WS_CTL, 0, CTL_ZERO_BYTES, stream);
    Args a{};
    a.x = (const float*)d_in[0]; a.mem = (const float*)d_in[1]; a.attn_g = (const float*)d_in[2]; a.w_in = (const float*)d_in[3]; a.q_g = (const float*)d_in[4]; a.k_g = (const float*)d_in[5];
    a.pool_w = (const float*)d_in[6]; a.pool_s = (const float*)d_in[7]; a.mem_g = (const float*)d_in[8]; a.w_kv = (const float*)d_in[9]; a.mq_g = (const float*)d_in[10]; a.mk_g = (const float*)d_in[11];
    a.w_out = (const float*)d_in[12]; a.ffn_g = (const float*)d_in[13]; a.w_q = (const float*)d_in[14]; a.sk1 = (const float*)d_in[15]; a.sk2 = (const float*)d_in[16];
    a.pu = (const float*)d_in[17]; a.pv = (const float*)d_in[18]; a.out = (float*)d_out; a.ws = (unsigned char*)d_ws;
#if MK_ONE_LAUNCH
    a.ph_lo = 0; a.ph_hi = N_PHASES;
    hipLaunchKernelGGL(fwd_kernel, dim3(grid), dim3(NWAVES * 64), LDS_BYTES, stream, a);
#else
    for (int p = 0; p < N_PHASES; ++p) { a.ph_lo = p; a.ph_hi = p + 1; hipLaunchKernelGGL(fwd_kernel, dim3(grid), dim3(NWAVES * 64), LDS_BYTES, stream, a); }
#endif
}
```

```cpp
#include <hip/hip_runtime.h>
#include <hip/hip_bf16.h>
#include <cstdio>
#include <cstdint>

#ifndef IX_VERIFY
#define IX_VERIFY 0
#endif
#ifndef ATT_VERIFY
#define ATT_VERIFY 0
#endif
#ifndef MK_ONE_LAUNCH
#define MK_ONE_LAUNCH 1
#endif
#ifndef P1_FP8
#define P1_FP8 1
#endif
#ifndef QK_FP8
#define QK_FP8 1
#endif
#ifndef P7_FP8
#define P7_FP8 0
#endif

#define GAS __attribute__((address_space(1)))
#define LAS __attribute__((address_space(3)))
typedef unsigned short bf16_t;
typedef short bf16x8 __attribute__((ext_vector_type(8)));
typedef short s16x4 __attribute__((ext_vector_type(4)));
typedef float f32x4 __attribute__((ext_vector_type(4)));
typedef float f32x2 __attribute__((ext_vector_type(2)));
typedef float f32x16 __attribute__((ext_vector_type(16)));
typedef unsigned u32x4 __attribute__((ext_vector_type(4)));
typedef unsigned u32x2 __attribute__((ext_vector_type(2)));
typedef __bf16 bf16x2_t __attribute__((ext_vector_type(2)));
typedef int i32x8 __attribute__((ext_vector_type(8)));
typedef int i32x4 __attribute__((ext_vector_type(4)));

constexpr int BATCH = 2, SEQ = 16384, DM = 2048, NTOK = BATCH * SEQ, MEMLEN = 256;
constexpr int IN_W = 5200, ZLD = 5376;
constexpr int ZC_Q = 0, ZC_K = 1024, ZC_V = 2048, ZC_QI = 3072, ZC_PU = 4096, ZC_QM = 4608, ZC_KI = 5120, ZC_WI = 5184;
constexpr int NEXP = 16384;
constexpr float EPS = 1e-6f;
constexpr int MASK_WPR = 512;

constexpr size_t MiB = 1u << 20;
constexpr size_t WS_CTL = 0, CTL_ZERO_BYTES = 1 * MiB;
constexpr size_t WS_BT_IN = 2 * MiB;
constexpr size_t WS_BT_OUT = 24 * MiB;
constexpr size_t WS_BT_Q = 32 * MiB;
constexpr size_t WS_BT_KV = 40 * MiB;
constexpr size_t WS_MN = 44 * MiB;
constexpr size_t WS_KVM = 46 * MiB;
constexpr size_t WS_PK = 47 * MiB;
constexpr size_t WS_PWT = 47 * MiB + 512 * 1024;
constexpr size_t WS_XN = 48 * MiB;
constexpr size_t WS_Z = 176 * MiB;
constexpr size_t WS_MASK = 512 * MiB;
constexpr size_t WS_UB = 576 * MiB;
constexpr size_t WS_VB = 640 * MiB;
constexpr size_t WS_RSU = 47 * MiB + 128 * 1024, WS_RSV = 47 * MiB + 256 * 1024;
constexpr size_t WS_ROPE = 704 * MiB;
constexpr size_t WS_CAND = 720 * MiB;
constexpr size_t WS_Q8 = WS_UB, WS_K8 = WS_UB + 32 * MiB;
constexpr size_t WS_XN8 = WS_CAND, WS_BTIN8 = WS_CAND + 72 * MiB, WS_CSI = WS_CAND + 84 * MiB;
constexpr size_t WS_HN8 = WS_CAND, WS_BTQ8 = WS_CAND + 64 * MiB, WS_CSQ = WS_CAND + 68 * MiB;
constexpr size_t WS_END = 848 * MiB;
constexpr int CW_BAR = 4096;

#define LDS_WAIT() asm volatile("s_waitcnt lgkmcnt(0)" ::: "memory")
#define VM_WAIT() asm volatile("s_waitcnt vmcnt(0)" ::: "memory")
__device__ __forceinline__ unsigned cvtpk(float lo, float hi) { f32x2 v = {lo, hi}; bf16x2_t b = __builtin_convertvector(v, bf16x2_t); return __builtin_bit_cast(unsigned, b); }
__device__ __forceinline__ float bflo(unsigned w) { return __uint_as_float(w << 16); }
__device__ __forceinline__ float bfhi(unsigned w) { return __uint_as_float(w & 0xffff0000u); }
__device__ __forceinline__ float wave_sum(float v) {
#pragma unroll
    for (int o = 1; o < 64; o <<= 1) v += __shfl_xor(v, o);
    return v;
}
__device__ __forceinline__ unsigned f2ord(float s) { unsigned u = __float_as_uint(s); return u ^ (((unsigned)((int)u >> 31)) | 0x80000000u); }

namespace pg8 {
#define PG8_LAS __attribute__((address_space(3)))
constexpr int BM = 256, BK = 64, HALF = 128, HTB = HALF * BK * 2, STAGE_BYTES = 8 * HTB, NXCD = 8, WGM = 8;
__host__ __device__ __forceinline__ int lds_byte(int r, int c) { const int st = (r >> 4) * 2 + (c >> 5), rr = r & 15, cc = c & 31, ob = rr * 64 + cc * 2; return st * 1024 + (ob ^ (((ob >> 9) & 1) << 5)); }
__host__ __device__ __forceinline__ void stage_rc(int b, int& R, int& C) { const int st = b / 1024, sb = b % 1024, swz = sb ^ (((sb >> 9) & 1) << 5); R = (st >> 1) * 16 + swz / 64; C = (st & 1) * 32 + (swz % 64) / 2; }
__host__ __device__ __forceinline__ int perm32(int rho) { const int n = rho >> 4, i = rho & 15; return 8 * (i >> 2) + 4 * n + (i & 3); }
struct Unit { int pm, pn; };
struct Gemm { const bf16_t* A; const bf16_t* Bt; int M, N, K; };
struct StaticOrder {
    int nM, nN, nwg, G, c;
    __host__ __device__ void init(int M, int N, int G_, int c_) { nM = M / BM; nN = N / BM; nwg = nM * nN; G = G_; c = c_; }
    __host__ __device__ bool next(int i, Unit& u) const {
        const long L = (long)i * G + c; if (L >= nwg) return false;
        int wgid = (int)L; { const int q = nwg / NXCD, r = nwg % NXCD, xcd = wgid % NXCD, off = wgid / NXCD; wgid = (xcd < r ? xcd * (q + 1) : r * (q + 1) + (xcd - r) * q) + off; }
        const int nig = WGM * nN, gid = wgid / nig, fm = gid * WGM, gsz = (nM - fm) < WGM ? (nM - fm) : WGM;
        u.pm = fm + ((wgid % nig) % gsz); u.pn = (wgid % nig) / gsz; return true;
    }
    __device__ __forceinline__ void a_ready(const Unit&) const {}
    __device__ __forceinline__ void done(const Unit&) const {}
};
struct InBf16Order {
    StaticOrder S;
    __host__ __device__ void init(int M, int G_, int c_) { S.init(M, 5 * BM, G_, c_); }
    __host__ __device__ bool next(int i, Unit& u) const { if (!S.next(i, u)) return false; u.pn = u.pn < 4 ? 12 + u.pn : 20; return true; }
    __device__ __forceinline__ void a_ready(const Unit&) const {}
    __device__ __forceinline__ void done(const Unit&) const {}
};
struct InFp8Order {
    StaticOrder S; int G, c;
    __host__ __device__ void init(int M, int G_, int c_) { S.init(M, 16 * BM, 1, 0); G = G_; c = c_; }
    __host__ __device__ bool next(int i, Unit& u) const {
        long L;
        if (G == 256 && S.nwg == 2048) {
            if (i < 7) L = (long)i * 256 + c;
            else if (c < 128) return false;
            else { const int j = i - 7; int base, cnt;
                if (c < 136) { base = (c - 128) * 1; cnt = 1; } else if (c < 144) { base = 8 + (c - 136) * 3; cnt = 3; } else { base = 32 + (c - 144) * 2; cnt = 2; }
                if (j >= cnt) return false; L = 1792 + base + j; }
        } else { L = (long)i * G + c; if (L >= S.nwg) return false; }
        if (!S.next((int)L, u)) return false;
        u.pn = u.pn < 12 ? u.pn : u.pn + 4; return true;
    }
    __device__ __forceinline__ void a_ready(const Unit&) const {}
    __device__ __forceinline__ void done(const Unit&) const {}
};
struct EpiBf16 {
    static constexpr bool PERM = true, AFTER_DRAIN = false;
    bf16_t* O; int ldc;
    __device__ __forceinline__ void operator()(const f32x4 (&acc)[2][2][4][2], const Unit& u, int wr, int wc, int fr, int fq) const {
        const int row0 = u.pm * BM + wr * 64 + fr; const int col0 = u.pn * BM + wc * 32 + 8 * fq;
#pragma unroll
        for (int ai = 0; ai < 2; ++ai)
#pragma unroll
            for (int m = 0; m < 4; ++m) { bf16_t* rowp = O + (size_t)(row0 + ai * HALF + m * 16) * ldc + col0;
#pragma unroll
                for (int bj = 0; bj < 2; ++bj) { const f32x4 v0 = acc[ai][bj][m][0], v1 = acc[ai][bj][m][1];
                    u32x4 w; w.x = cvtpk(v0[0], v0[1]); w.y = cvtpk(v0[2], v0[3]); w.z = cvtpk(v1[0], v1[1]); w.w = cvtpk(v1[2], v1[3]);
                    *(u32x4*)(rowp + bj * HALF) = w; } }
    }
};
struct EpiBf16S {
    static constexpr bool PERM = true, AFTER_DRAIN = false;
    bf16_t* O; int ldc; const float* cs;
    __device__ __forceinline__ void operator()(const f32x4 (&acc)[2][2][4][2], const Unit& u, int wr, int wc, int fr, int fq) const {
        const int row0 = u.pm * BM + wr * 64 + fr; const int col0 = u.pn * BM + wc * 32 + 8 * fq;
        f32x4 s[2][2];
#pragma unroll
        for (int bj = 0; bj < 2; ++bj) { s[bj][0] = *(const f32x4*)(cs + col0 + bj * HALF); s[bj][1] = *(const f32x4*)(cs + col0 + bj * HALF + 4); }
#pragma unroll
        for (int ai = 0; ai < 2; ++ai)
#pragma unroll
            for (int m = 0; m < 4; ++m) { bf16_t* rowp = O + (size_t)(row0 + ai * HALF + m * 16) * ldc + col0;
#pragma unroll
                for (int bj = 0; bj < 2; ++bj) { const f32x4 v0 = acc[ai][bj][m][0] * s[bj][0], v1 = acc[ai][bj][m][1] * s[bj][1];
                    u32x4 w; w.x = cvtpk(v0[0], v0[1]); w.y = cvtpk(v0[2], v0[3]); w.z = cvtpk(v1[0], v1[1]); w.w = cvtpk(v1[2], v1[3]);
                    *(u32x4*)(rowp + bj * HALF) = w; } }
    }
};
struct EpiF32Res {
    static constexpr bool PERM = false, AFTER_DRAIN = false;
    const float* R; float* C; int ldc;
    __device__ __forceinline__ void operator()(const f32x4 (&acc)[2][2][4][2], const Unit& u, int wr, int wc, int fr, int fq) const {
        const int row0 = u.pm * BM + wr * 64 + fr, col0 = u.pn * BM + wc * 32 + 4 * fq;
#pragma unroll
        for (int ai = 0; ai < 2; ++ai)
#pragma unroll
            for (int m = 0; m < 4; ++m) { const size_t off = (size_t)(row0 + ai * HALF + m * 16) * ldc + col0;
#pragma unroll
                for (int bj = 0; bj < 2; ++bj)
#pragma unroll
                    for (int n = 0; n < 2; ++n) *(f32x4*)(C + off + bj * HALF + n * 16) = acc[ai][bj][m][n] + *(const f32x4*)(R + off + bj * HALF + n * 16); }
    }
};

__device__ __forceinline__ i32x8 cat8(bf16x8 a, bf16x8 b) { const i32x4 x = __builtin_bit_cast(i32x4, a), y = __builtin_bit_cast(i32x4, b); return __builtin_shufflevector(x, y, 0, 1, 2, 3, 4, 5, 6, 7); }
template <class Epi, class Sched, bool ALIGN_EPI = false, bool SP2 = false, bool F8 = false>
__device__ __forceinline__ void gemm_phase(PG8_LAS unsigned char* lds, const Gemm g, const Sched& S, const Epi& E) {
    const int tid = threadIdx.x, wid = __builtin_amdgcn_readfirstlane(tid >> 6), lane = tid & 63, wr = wid >> 2, wc = wid & 3, fr = lane & 15, fq = lane >> 4;
    const int K = g.K, nt = K / BK;
    unsigned voffA[2], voffB[2];
#pragma unroll
    for (int i = 0; i < 2; ++i) { int R, C; stage_rc(tid * 16 + i * 8192, R, C); const int Rb = Epi::PERM ? ((R & ~31) + perm32(R & 31)) : R;
        voffA[i] = (unsigned)(R * K + C) * 2u; voffB[i] = (unsigned)(Rb * K + C) * 2u; }
    const size_t kstep = (size_t)(BK * 2);
    const size_t hstep = (size_t)HALF * K * 2;
    const size_t tstep = 2 * hstep;
    const unsigned ldsw = (unsigned)wid * 1024u;
    const int aoff_ = lds_byte(wr * 64 + fr, fq * 8), boff_ = lds_byte(wc * 32 + fr, fq * 8);
#define PG8_SA(b, h) (((b) * 2 + (h)) * HTB)
#define PG8_SB(b, h) ((4 + (b) * 2 + (h)) * HTB)
#define PG8_STAGE(bufoff, gbase, voff) do { _Pragma("unroll") for (int _i = 0; _i < 2; ++_i) \
        __builtin_amdgcn_global_load_lds((const unsigned*)((const char*)(gbase) + (voff)[_i]), (PG8_LAS unsigned*)(lds + (bufoff) + ldsw + _i * 8192), 16, 0, 0); } while (0)
#define PG8_LD1(off) (*(const PG8_LAS bf16x8*)(lds + (off)))
#define PG8_LDA(dst, b, h) do { _Pragma("unroll") for (int m = 0; m < 4; ++m) { if constexpr (F8) dst##8[m] = cat8(PG8_LD1(PG8_SA(b, h) + aoff + m * 2048), PG8_LD1(PG8_SA(b, h) + aoff + m * 2048 + 1024)); \
        else { _Pragma("unroll") for (int k = 0; k < 2; ++k) dst[m][k] = PG8_LD1(PG8_SA(b, h) + aoff + m * 2048 + k * 1024); } } } while (0)
#define PG8_LDB(dst, b, h) do { _Pragma("unroll") for (int n = 0; n < 2; ++n) { if constexpr (F8) dst##8[n] = cat8(PG8_LD1(PG8_SB(b, h) + boff + n * 2048), PG8_LD1(PG8_SB(b, h) + boff + n * 2048 + 1024)); \
        else { _Pragma("unroll") for (int k = 0; k < 2; ++k) dst[n][k] = PG8_LD1(PG8_SB(b, h) + boff + n * 2048 + k * 1024); } } } while (0)
#define PG8_MMA(ai, bj, At, Bt) do { __builtin_amdgcn_s_setprio(1); _Pragma("unroll") for (int m = 0; m < 4; ++m) _Pragma("unroll") for (int n = 0; n < 2; ++n) { \
        if constexpr (F8) asm volatile("v_mfma_f32_16x16x128_f8f6f4 %0, %1, %2, %0" : "+v"(acc[ai][bj][m][n]) : "v"(Bt##8[n]), "v"(At##8[m])); \
        else { _Pragma("unroll") for (int k = 0; k < 2; ++k) acc[ai][bj][m][n] = __builtin_amdgcn_mfma_f32_16x16x32_bf16(Bt[n][k], At[m][k], acc[ai][bj][m][n], 0, 0, 0); } } __builtin_amdgcn_s_setprio(0); } while (0)
#define PG8_WAIT_V(n) asm volatile("s_waitcnt vmcnt(" #n ")" ::: "memory")
#define PG8_WAIT_L(n) asm volatile("s_waitcnt lgkmcnt(" #n ")" ::: "memory")
#define PG8_BAR __builtin_amdgcn_s_barrier()
#define PG8_SCHED __builtin_amdgcn_sched_barrier(0)
    Unit cur, nxt; int ui = 0;
    if (!S.next(0, cur)) return;
    f32x4 acc[2][2][4][2];
#pragma unroll
    for (int a = 0; a < 2; ++a)
#pragma unroll
        for (int b = 0; b < 2; ++b)
#pragma unroll
            for (int m = 0; m < 4; ++m)
#pragma unroll
                for (int n = 0; n < 2; ++n) acc[a][b][m][n] = (f32x4){0.f, 0.f, 0.f, 0.f};
    bf16x8 At[4][2], B0[2][2], B1[2][2]; i32x8 At8[4], B08[2], B18[2];
    const char* cA = (const char*)g.A + (size_t)cur.pm * tstep; const char* cB = (const char*)g.Bt + (size_t)cur.pn * tstep;
    S.a_ready(cur);
    if constexpr (SP2) {
        PG8_STAGE(PG8_SB(0, 0), cB, voffB); PG8_STAGE(PG8_SB(0, 1), cB + hstep, voffB); PG8_STAGE(PG8_SA(0, 0), cA, voffA); PG8_STAGE(PG8_SA(0, 1), cA + hstep, voffA);
        if (wr == 1) PG8_BAR;
        PG8_WAIT_V(2); PG8_BAR;
        PG8_STAGE(PG8_SB(1, 0), cB + kstep, voffB); PG8_STAGE(PG8_SA(1, 0), cA + kstep, voffA); PG8_STAGE(PG8_SB(1, 1), cB + hstep + kstep, voffB);
        PG8_WAIT_V(6); PG8_BAR;
    } else {
        PG8_STAGE(PG8_SB(0, 0), cB, voffB); PG8_STAGE(PG8_SA(0, 0), cA, voffA); PG8_STAGE(PG8_SB(0, 1), cB + hstep, voffB); PG8_STAGE(PG8_SA(0, 1), cA + hstep, voffA);
        if (wr == 1) PG8_BAR;
        PG8_WAIT_V(4); PG8_BAR;
        PG8_STAGE(PG8_SB(1, 0), cB + kstep, voffB); PG8_STAGE(PG8_SA(1, 0), cA + kstep, voffA); PG8_STAGE(PG8_SB(1, 1), cB + hstep + kstep, voffB);
        PG8_WAIT_V(6); PG8_BAR;
    }
    for (;;) {
        const bool has_next = S.next(ui + 1, nxt);
        const char* nA = has_next ? (const char*)g.A + (size_t)nxt.pm * tstep : cA; const char* nB = has_next ? (const char*)g.Bt + (size_t)nxt.pn * tstep : cB;
        for (int t = 0; t < nt; t += 2) {
            const bool last = (t == nt - 2);
            int aoff = aoff_, boff = boff_; if constexpr (F8) asm volatile("" : "+v"(aoff), "+v"(boff));
            const char* a1 = cA + (size_t)(t + 1) * kstep;
            const char* a2 = last ? nA : cA + (size_t)(t + 2) * kstep; const char* b2 = last ? nB : cB + (size_t)(t + 2) * kstep;
            const char* a3 = a2 + kstep; const char* b3 = b2 + kstep;
            if (last && has_next) S.a_ready(nxt);
            if constexpr (SP2) {
            PG8_LDB(B0, 0, 0); PG8_LDB(B1, 0, 1); PG8_SCHED; PG8_LDA(At, 0, 0); PG8_STAGE(PG8_SA(1, 1), a1 + hstep, voffA);
            PG8_WAIT_V(8); PG8_WAIT_L(0); PG8_BAR; PG8_MMA(0, 0, At, B0); PG8_MMA(0, 1, At, B1); PG8_BAR; PG8_SCHED;
            PG8_LDA(At, 0, 1); PG8_STAGE(PG8_SB(0, 0), b2, voffB); PG8_STAGE(PG8_SB(0, 1), b2 + hstep, voffB); PG8_STAGE(PG8_SA(0, 0), a2, voffA);
            PG8_WAIT_V(8); PG8_WAIT_L(0); PG8_BAR; PG8_MMA(1, 0, At, B0); PG8_MMA(1, 1, At, B1); PG8_BAR; PG8_SCHED;
            PG8_LDB(B0, 1, 0); PG8_LDB(B1, 1, 1); PG8_SCHED; PG8_LDA(At, 1, 0); PG8_STAGE(PG8_SA(0, 1), a2 + hstep, voffA);
            PG8_WAIT_V(8); PG8_WAIT_L(0); PG8_BAR; PG8_MMA(0, 0, At, B0); PG8_MMA(0, 1, At, B1); PG8_BAR; PG8_SCHED;
            PG8_LDA(At, 1, 1); PG8_STAGE(PG8_SB(1, 0), b3, voffB); PG8_STAGE(PG8_SB(1, 1), b3 + hstep, voffB); PG8_STAGE(PG8_SA(1, 0), a3, voffA);
            PG8_WAIT_V(8); PG8_WAIT_L(0); PG8_BAR; PG8_MMA(1, 0, At, B0); PG8_MMA(1, 1, At, B1); PG8_BAR; PG8_SCHED;
            } else {
            PG8_LDB(B0, 0, 0); PG8_SCHED; PG8_LDA(At, 0, 0); PG8_STAGE(PG8_SA(1, 1), a1 + hstep, voffA);
            PG8_WAIT_L(8); PG8_BAR; PG8_WAIT_L(0); PG8_MMA(0, 0, At, B0); PG8_BAR; PG8_SCHED;
            PG8_LDB(B1, 0, 1); PG8_STAGE(PG8_SB(0, 0), b2, voffB);
            PG8_BAR; PG8_WAIT_L(0); PG8_MMA(0, 1, At, B1); PG8_BAR;
            PG8_LDA(At, 0, 1); PG8_STAGE(PG8_SA(0, 0), a2, voffA);
            PG8_BAR; PG8_WAIT_L(0); PG8_MMA(1, 0, At, B0); PG8_BAR; PG8_SCHED;
            PG8_STAGE(PG8_SB(0, 1), b2 + hstep, voffB);
            PG8_WAIT_V(6); PG8_BAR; PG8_MMA(1, 1, At, B1); PG8_BAR;
            PG8_LDB(B0, 1, 0); PG8_SCHED; PG8_LDA(At, 1, 0); PG8_STAGE(PG8_SA(0, 1), a2 + hstep, voffA);
            PG8_WAIT_L(8); PG8_BAR; PG8_WAIT_L(0); PG8_MMA(0, 0, At, B0); PG8_BAR; PG8_SCHED;
            PG8_LDB(B1, 1, 1); PG8_STAGE(PG8_SB(1, 0), b3, voffB);
            PG8_BAR; PG8_WAIT_L(0); PG8_MMA(0, 1, At, B1); PG8_BAR;
            PG8_LDA(At, 1, 1); PG8_STAGE(PG8_SA(1, 0), a3, voffA);
            PG8_BAR; PG8_WAIT_L(0); PG8_MMA(1, 0, At, B0); PG8_BAR; PG8_SCHED;
            PG8_STAGE(PG8_SB(1, 1), b3 + hstep, voffB);
            PG8_WAIT_V(6); PG8_BAR; PG8_MMA(1, 1, At, B1); PG8_BAR;
            }
        }
        if constexpr (ALIGN_EPI) { if (wr == 0) PG8_BAR; }
        if constexpr (F8) asm volatile("s_nop 15\n\ts_nop 15" ::: "memory");
        if constexpr (!Epi::AFTER_DRAIN) { E(acc, cur, wr, wc, fr, fq); S.done(cur); }
        if (!has_next) break;
#pragma unroll
        for (int a = 0; a < 2; ++a)
#pragma unroll
            for (int b = 0; b < 2; ++b)
#pragma unroll
                for (int m = 0; m < 4; ++m)
#pragma unroll
                    for (int n = 0; n < 2; ++n) acc[a][b][m][n] = (f32x4){0.f, 0.f, 0.f, 0.f};
        cur = nxt; cA = nA; cB = nB; ++ui;
        if constexpr (ALIGN_EPI) { if (wr == 1) PG8_BAR; }
    }
    PG8_WAIT_V(0);
    if constexpr (!ALIGN_EPI) { if (wr == 0) PG8_BAR; }
    PG8_BAR;
#undef PG8_SA
#undef PG8_SB
#undef PG8_STAGE
#undef PG8_LDA
#undef PG8_LD1
#undef PG8_LDB
#undef PG8_MMA
#undef PG8_WAIT_V
#undef PG8_WAIT_L
#undef PG8_BAR
#undef PG8_SCHED
}
}

namespace att {
constexpr int D = 128, NW = 8, QBLK = 32, KVBLK = 64;
constexpr float SCALE = 0.088388347648318440f;
constexpr float THR = 8.f;
constexpr size_t SHM_V = KVBLK * D * 2, SHM_K = KVBLK * D * 2, SHM_ATTN = 2 * SHM_V + 2 * SHM_K + NW * 64 * 4;
#define KSWZ(row, colB) ((row) * 256 + ((colB) ^ (((row) & 7) << 4)))
#define KSWZ8(row, colB) ((row) * 128 + ((colB) ^ ((((row) >> 1) & 7) << 4)))
#define SBAR() __builtin_amdgcn_sched_barrier(0)
__device__ __forceinline__ int crow(int r, int hi) { return (r & 3) + 8 * (r >> 2) + 4 * hi; }
template <bool MASKED> __device__ __forceinline__ void mask_apply(f32x16& p, unsigned w) {
    if constexpr (MASKED) {
#pragma unroll
        for (int r = 0; r < 16; ++r) { const unsigned m = (unsigned)__builtin_amdgcn_sbfe((int)w, (unsigned)((r & 3) + 8 * (r >> 2)), 1u); p[r] = __uint_as_float((__float_as_uint(p[r]) & m) | (0xFF800000u & ~m)); }
    }
}
template <bool MASKED> __device__ __forceinline__ void partialSM(f32x16& p0, f32x16& p1, float& m_reg, float& mn, float& alpha, unsigned long long mk, int sh4) {
    constexpr float C = SCALE * 1.4426950408889634f;
    float pmax = p0[0];
#pragma unroll
    for (int r = 1; r < 16; ++r) pmax = fmaxf(pmax, p0[r]);
#pragma unroll
    for (int r = 0; r < 16; ++r) pmax = fmaxf(pmax, p1[r]);
    { auto rr = __builtin_amdgcn_permlane32_swap(__float_as_uint(pmax), __float_as_uint(pmax), false, false);
      pmax = fmaxf(__uint_as_float(rr[0]), __uint_as_float(rr[1])); }
    if (__builtin_expect(__all(pmax - m_reg <= THR / SCALE), 1)) { mn = m_reg; alpha = 1.f; }
    else { mn = fmaxf(m_reg, pmax); alpha = __builtin_amdgcn_exp2f((m_reg - mn) * C); m_reg = mn; }
    const float mnC = -mn * C;
#pragma unroll
    for (int r = 0; r < 16; ++r) p0[r] = fmaf(p0[r], C, mnC);
#pragma unroll
    for (int r = 0; r < 16; ++r) p1[r] = fmaf(p1[r], C, mnC);
#pragma unroll
    for (int r = 0; r < 16; ++r) p0[r] = __builtin_amdgcn_exp2f(p0[r]);
}
template <bool MASKED> __device__ __forceinline__ void finishSM(f32x16& p0, f32x16& p1, float alpha, float& l_reg, bf16x8& pa0, bf16x8& pa1, bf16x8& pa2, bf16x8& pa3, unsigned long long mk, int sh4) {
#pragma unroll
    for (int r = 0; r < 16; ++r) p1[r] = __builtin_amdgcn_exp2f(p1[r]);
    float ps = 0;
#pragma unroll
    for (int r = 0; r < 16; ++r) ps += p0[r];
#pragma unroll
    for (int r = 0; r < 16; ++r) ps += p1[r];
    { auto rr = __builtin_amdgcn_permlane32_swap(__float_as_uint(ps), __float_as_uint(ps), false, false);
      ps = __uint_as_float(rr[0]) + __uint_as_float(rr[1]); }
    l_reg = l_reg * alpha + ps;
#define PK4(P, BASE, OUT) do { unsigned a0 = cvtpk(P[BASE + 0], P[BASE + 1]), a1 = cvtpk(P[BASE + 2], P[BASE + 3]);   \
    unsigned b0 = cvtpk(P[BASE + 4], P[BASE + 5]), b1 = cvtpk(P[BASE + 6], P[BASE + 7]);                              \
    auto r0 = __builtin_amdgcn_permlane32_swap(a0, b0, false, false); auto r1 = __builtin_amdgcn_permlane32_swap(a1, b1, false, false); \
    u32x4 w = {r0[0], r1[0], r0[1], r1[1]}; OUT = *reinterpret_cast<bf16x8*>(&w); } while (0)
    PK4(p0, 0, pa0); PK4(p0, 8, pa1); PK4(p1, 0, pa2); PK4(p1, 8, pa3);
#undef PK4
}
template <bool MASKED> __device__ __forceinline__ void qkt(f32x16& p0, f32x16& p1, const bf16_t* Ks, const bf16x8* qs, int r32, int hi, unsigned long long mk, int sh4, const char* lut) {
    if constexpr (MASKED) {
        const unsigned wl = (unsigned)mk >> sh4, wh = (unsigned)(mk >> 32) >> sh4;
#pragma unroll
        for (int g = 0; g < 4; ++g) { const f32x4 b0 = *(const f32x4*)(lut + ((wl >> (8 * g)) & 15u) * 16), b1 = *(const f32x4*)(lut + ((wh >> (8 * g)) & 15u) * 16);
            p0[4 * g] = b0.x; p0[4 * g + 1] = b0.y; p0[4 * g + 2] = b0.z; p0[4 * g + 3] = b0.w; p1[4 * g] = b1.x; p1[4 * g + 1] = b1.y; p1[4 * g + 2] = b1.z; p1[4 * g + 3] = b1.w; }
    } else { p0 = f32x16{}; p1 = f32x16{}; }
#pragma unroll
    for (int d0 = 0; d0 < 8; ++d0) { int cb = (d0 * 16 + hi * 8) * 2;
        bf16x8 b0 = *reinterpret_cast<const bf16x8*>((const char*)Ks + KSWZ(r32, cb));
        bf16x8 b1 = *reinterpret_cast<const bf16x8*>((const char*)Ks + KSWZ(32 + r32, cb));
        const bf16x8 qf = qs[d0 * 64];
        p0 = __builtin_amdgcn_mfma_f32_32x32x16_bf16(b0, qf, p0, 0, 0, 0);
        p1 = __builtin_amdgcn_mfma_f32_32x32x16_bf16(b1, qf, p1, 0, 0, 0); }
}
template <bool MASKED> __device__ __forceinline__ void qkt8(f32x16& p0, f32x16& p1, const char* Ks, const bf16x8* qs, int r32, int hi, unsigned long long mk, int sh4, const char* lut) {
    if constexpr (MASKED) {
        const unsigned wl = (unsigned)mk >> sh4, wh = (unsigned)(mk >> 32) >> sh4;
#pragma unroll
        for (int g = 0; g < 4; ++g) { const f32x4 b0 = *(const f32x4*)(lut + ((wl >> (8 * g)) & 15u) * 16), b1 = *(const f32x4*)(lut + ((wh >> (8 * g)) & 15u) * 16);
            p0[4 * g] = b0.x; p0[4 * g + 1] = b0.y; p0[4 * g + 2] = b0.z; p0[4 * g + 3] = b0.w; p1[4 * g] = b1.x; p1[4 * g + 1] = b1.y; p1[4 * g + 2] = b1.z; p1[4 * g + 3] = b1.w; }
    } else { p0 = f32x16{}; p1 = f32x16{}; }
#pragma unroll
    for (int s2 = 0; s2 < 2; ++s2) { const int cb = (s2 * 4 + hi * 2) * 16;
        const i32x8 a0 = pg8::cat8(*reinterpret_cast<const bf16x8*>(Ks + KSWZ8(r32, cb)), *reinterpret_cast<const bf16x8*>(Ks + KSWZ8(r32, cb + 16)));
        const i32x8 a1 = pg8::cat8(*reinterpret_cast<const bf16x8*>(Ks + KSWZ8(32 + r32, cb)), *reinterpret_cast<const bf16x8*>(Ks + KSWZ8(32 + r32, cb + 16)));
        const i32x8 qf = pg8::cat8(qs[(2 * s2) * 64], qs[(2 * s2 + 1) * 64]);
        p0 = __builtin_amdgcn_mfma_scale_f32_32x32x64_f8f6f4(a0, qf, p0, 0, 0, 0, 0, 0, 0);
        p1 = __builtin_amdgcn_mfma_scale_f32_32x32x64_f8f6f4(a1, qf, p1, 0, 0, 0, 0, 0, 0); }
}
__device__ __forceinline__ int v_st(int k, int c) { const int kk = (k & ~0xC) | ((k & 4) << 1) | ((k & 8) >> 1); return ((kk >> 3) * 4 + (c >> 5)) * 512 + ((kk & 7) * 32 + (c & 31)) * 2; }
__device__ __forceinline__ int v_rd_base(int lane) { return ((lane & 3) << 3) | (((lane >> 2) & 3) << 6) | (((lane >> 4) & 1) << 5) | (((lane >> 5) & 1) << 8); }
constexpr int v_rd_off(int d0, int ks, int half) { return d0 * 512 + ks * 4096 + half * 2048; }
template <int OFF> __device__ __forceinline__ s16x4 tr_read(int vb) {
    s16x4 r; asm volatile("ds_read_b64_tr_b16 %0, %1 offset:%2" : "=&v"(r) : "v"(vb), "i"(OFF) : "memory"); return r;
}
template <int D0> __device__ __forceinline__ void pv_one(f32x16& od, int vb, bf16x8 pa0, bf16x8 pa1, bf16x8 pa2, bf16x8 pa3) {
    const s16x4 l0 = tr_read<v_rd_off(D0, 0, 0)>(vb), h0 = tr_read<v_rd_off(D0, 0, 1)>(vb), l1 = tr_read<v_rd_off(D0, 1, 0)>(vb), h1 = tr_read<v_rd_off(D0, 1, 1)>(vb);
    const s16x4 l2 = tr_read<v_rd_off(D0, 2, 0)>(vb), h2 = tr_read<v_rd_off(D0, 2, 1)>(vb), l3 = tr_read<v_rd_off(D0, 3, 0)>(vb), h3 = tr_read<v_rd_off(D0, 3, 1)>(vb);
    asm volatile("s_waitcnt lgkmcnt(0)" ::: "memory"); SBAR();
#define PK(L, H) (bf16x8){L[0], L[1], L[2], L[3], H[0], H[1], H[2], H[3]}
    od = __builtin_amdgcn_mfma_f32_32x32x16_bf16(pa0, PK(l0, h0), od, 0, 0, 0);
    od = __builtin_amdgcn_mfma_f32_32x32x16_bf16(pa1, PK(l1, h1), od, 0, 0, 0);
    od = __builtin_amdgcn_mfma_f32_32x32x16_bf16(pa2, PK(l2, h2), od, 0, 0, 0);
    od = __builtin_amdgcn_mfma_f32_32x32x16_bf16(pa3, PK(l3, h3), od, 0, 0, 0);
#undef PK
}
__device__ __forceinline__ void pv_d0(f32x16* o, int vb, bf16x8 pa0, bf16x8 pa1, bf16x8 pa2, bf16x8 pa3) {
    pv_one<0>(o[0], vb, pa0, pa1, pa2, pa3); pv_one<1>(o[1], vb, pa0, pa1, pa2, pa3); pv_one<2>(o[2], vb, pa0, pa1, pa2, pa3); pv_one<3>(o[3], vb, pa0, pa1, pa2, pa3);
}
template <bool MASKED, int SDEPTH, int ldq, int ldk, int ldo, bool QK8 = false>
__device__ __forceinline__ void attn_body(const bf16_t* __restrict__ Qb, const bf16_t* __restrict__ Kh, const bf16_t* __restrict__ Vh,
                                          bf16_t* __restrict__ Ob, int seq, const unsigned long long* __restrict__ mrow, char* lds,
                                          const unsigned char* __restrict__ Q8b = nullptr, const unsigned char* __restrict__ K8h = nullptr) {
    int tid = (int)threadIdx.x; asm volatile("" : "+v"(tid));
    const int wid = tid >> 6, lane = tid & 63, r32 = lane & 31, hi = lane >> 5, sh4 = 4 * hi;
    bf16_t* V_lds = (bf16_t*)lds; bf16_t* K_lds = (bf16_t*)(lds + 2 * SHM_V);
    float* ws = (float*)(lds + 2 * SHM_V + 2 * SHM_K) + wid * 64; float* li_l = ws; float* al_l = ws + 32;
    float m_reg = -1e30f, l_reg = 0; f32x16 o[4] = {};
    const bf16_t* Qw = Qb + (long)(wid * QBLK + r32) * ldq + hi * 8;
    bf16x8* qr = (bf16x8*)(lds + SHM_ATTN) + wid * 512 + lane;
    if constexpr (QK8) { const unsigned char* Q8w = Q8b + (long)(wid * QBLK + r32) * 1024 + hi * 32;
#pragma unroll
        for (int j = 0; j < 4; ++j) qr[j * 64] = *reinterpret_cast<const bf16x8*>(Q8w + (j >> 1) * 64 + (j & 1) * 16);
    } else {
#pragma unroll
        for (int d0 = 0; d0 < 8; ++d0) qr[d0 * 64] = *reinterpret_cast<const bf16x8*>(Qw + d0 * 16); }
    const char* lut = lds + SHM_ATTN + 65536;
    if (MASKED && tid < 64) ((float*)(lds + SHM_ATTN + 65536))[tid] = ((tid >> 2) >> (tid & 3)) & 1 ? 0.f : -INFINITY;
    const int sr = tid >> 4, sc = (tid & 15) * 8, vst0 = v_st(sr, sc), vst1 = v_st(32 + sr, sc);
    const int vb0 = (int)(uintptr_t)V_lds + v_rd_base(lane);
    struct { bf16x8 vs0, vs1, ks0, ks1; } sr_[SDEPTH];
    const int kr8 = tid >> 3, kc8 = (tid & 7) * 16;
#define SLOAD(i, k0) do { sr_[i].vs0 = *reinterpret_cast<const bf16x8*>(&Vh[(long)((k0) + sr) * ldk + sc]); sr_[i].vs1 = *reinterpret_cast<const bf16x8*>(&Vh[(long)((k0) + 32 + sr) * ldk + sc]); \
    if constexpr (QK8) sr_[i].ks0 = *reinterpret_cast<const bf16x8*>(K8h + (long)((k0) + kr8) * 1024 + kc8); \
    else { sr_[i].ks0 = *reinterpret_cast<const bf16x8*>(&Kh[(long)((k0) + sr) * ldk + sc]); sr_[i].ks1 = *reinterpret_cast<const bf16x8*>(&Kh[(long)((k0) + 32 + sr) * ldk + sc]); } } while (0)
#define SWRITE(b, i) do { *(bf16x8*)((char*)V_lds + (b) * SHM_V + vst0) = sr_[i].vs0;          \
    *(bf16x8*)((char*)V_lds + (b) * SHM_V + vst1) = sr_[i].vs1; int kc = sc * 2;               \
    if constexpr (QK8) *(bf16x8*)((char*)K_lds + (b) * SHM_K + KSWZ8(kr8, kc8)) = sr_[i].ks0;  \
    else { *(bf16x8*)((char*)K_lds + (b) * SHM_K + KSWZ(sr, kc)) = sr_[i].ks0;                  \
    *(bf16x8*)((char*)K_lds + (b) * SHM_K + KSWZ(32 + sr, kc)) = sr_[i].ks1; } } while (0)
#define SWAIT() do { if constexpr (SDEPTH == 2) { if constexpr (QK8) asm volatile("s_waitcnt vmcnt(3)" ::: "memory"); else asm volatile("s_waitcnt vmcnt(4)" ::: "memory"); } else asm volatile("s_waitcnt vmcnt(0)" ::: "memory"); } while (0)
#define QKT(P0, P1, KB, MK) do { if constexpr (QK8) qkt8<MASKED>(P0, P1, (const char*)(KB), qr, r32, hi, MK, sh4, lut); else qkt<MASKED>(P0, P1, (const bf16_t*)(KB), qr, r32, hi, MK, sh4, lut); } while (0)
#define RESC(a) do { if (__any((a) < 1.f)) { if (hi == 0) al_l[r32] = (a); asm volatile("s_waitcnt lgkmcnt(0)" ::: "memory"); \
    _Pragma("unroll") for (int d = 0; d < 4; ++d) _Pragma("unroll") for (int r = 0; r < 16; ++r) o[d][r] *= al_l[crow(r, hi)]; } } while (0)
    f32x16 pA0, pA1, pB0, pB1; float mnA, mnB, alA, alB; bf16x8 pa0, pa1, pa2, pa3; const int NT = seq / KVBLK;
    unsigned long long mkA = 0, mkB = 0;
    constexpr int SE = 0, SO = SDEPTH - 1;
    if constexpr (MASKED) mkA = mrow[0];
    SLOAD(SE, 0); asm volatile("s_waitcnt vmcnt(0)" ::: "memory"); SWRITE(0, SE); __syncthreads();
    QKT(pA0, pA1, K_lds, mkA); partialSM<MASKED>(pA0, pA1, m_reg, mnA, alA, mkA, sh4);
    if constexpr (MASKED) mkB = mrow[1];
    SLOAD(SO, KVBLK); if constexpr (SDEPTH == 2) { if (2 < NT) SLOAD(SE, 2 * KVBLK); }
    SWAIT(); SWRITE(1, SO); __syncthreads();
    for (int j = 1; j + 1 < NT; j += 2) {
        SBAR(); QKT(pB0, pB1, (char*)K_lds + SHM_K, mkB);
        finishSM<MASKED>(pA0, pA1, alA, l_reg, pa0, pa1, pa2, pa3, mkA, sh4); SBAR();
        if constexpr (MASKED) mkA = mrow[j + 1];
        SLOAD(SO, (j + SDEPTH) * KVBLK); SBAR();
        pv_d0(o, vb0, pa0, pa1, pa2, pa3); partialSM<MASKED>(pB0, pB1, m_reg, mnB, alB, mkB, sh4);
        __syncthreads(); SWAIT(); SWRITE(0, SE);
        RESC(alB); __syncthreads();
        SBAR(); QKT(pA0, pA1, K_lds, mkA);
        finishSM<MASKED>(pB0, pB1, alB, l_reg, pa0, pa1, pa2, pa3, mkB, sh4); SBAR();
        if constexpr (MASKED) { if (j + 2 < NT) mkB = mrow[j + 2]; }
        if (SDEPTH == 1 || j + 3 < NT) SLOAD(SE, (j + 1 + SDEPTH) * KVBLK); SBAR();
        pv_d0(o, vb0 + (int)SHM_V, pa0, pa1, pa2, pa3); partialSM<MASKED>(pA0, pA1, m_reg, mnA, alA, mkA, sh4);
        __syncthreads(); SWAIT(); SWRITE(1, SO);
        RESC(alA); __syncthreads();
    }
    SBAR(); QKT(pB0, pB1, (char*)K_lds + SHM_K, mkB);
    finishSM<MASKED>(pA0, pA1, alA, l_reg, pa0, pa1, pa2, pa3, mkA, sh4); SBAR();
    pv_d0(o, vb0, pa0, pa1, pa2, pa3); partialSM<MASKED>(pB0, pB1, m_reg, mnB, alB, mkB, sh4);
    __syncthreads(); RESC(alB);
    finishSM<MASKED>(pB0, pB1, alB, l_reg, pa0, pa1, pa2, pa3, mkB, sh4); SBAR();
    pv_d0(o, vb0 + (int)SHM_V, pa0, pa1, pa2, pa3);
    if (hi == 0) li_l[r32] = l_reg; asm volatile("s_waitcnt lgkmcnt(0)" ::: "memory");
    float rli[16];
#pragma unroll
    for (int r = 0; r < 16; ++r) rli[r] = __builtin_amdgcn_rcpf(li_l[crow(r, hi)]);
    bf16_t* Ow = Ob + (long)(wid * QBLK) * ldo;
#pragma unroll
    for (int r = 0; r < 16; ++r) { const int orow = crow(r, hi);
#pragma unroll
        for (int d0 = 0; d0 < 4; ++d0) Ow[(long)orow * ldo + d0 * 32 + r32] = (bf16_t)(cvtpk(o[d0][r] * rli[r], 0.f) & 0xffffu); }
    __syncthreads();
#undef SLOAD
#undef SWRITE
#undef SWAIT
#undef QKT
#undef RESC
}
#undef KSWZ
#undef KSWZ8
#undef SBAR
}

#define XB_TMO      128
#define XB_XCNT(j)  (256  + 64 * (j))
#define XB_XSUB(j)  (1280 + 64 * (j))
#define XB_XGEN(j)  (2304 + 64 * (j))
#define XB_TOP      3328
#define XB_TOPGEN   3392
#define XCD_BAR_WORDS 3456
#define XB_SPIN_CAP (1u << 22)
__device__ __forceinline__ unsigned xb_ld(unsigned* p)              { return __hip_atomic_load(p, __ATOMIC_RELAXED, __HIP_MEMORY_SCOPE_AGENT); }
__device__ __forceinline__ unsigned xb_add(unsigned* p, unsigned v) { return __hip_atomic_fetch_add(p, v, __ATOMIC_RELAXED, __HIP_MEMORY_SCOPE_AGENT); }
__device__ __forceinline__ unsigned xb_xcc_id() { return (unsigned)__builtin_amdgcn_s_getreg((3 << 11) | 20) & 0xFu; }
#define XB_SPIN(cond, bar) do { unsigned _sp = 0; while (cond) { __builtin_amdgcn_s_sleep(1); \
    if ((++_sp & 255u) == 0u) { if (xb_ld(&(bar)[XB_TMO])) break; if (_sp > XB_SPIN_CAP) { atomicAdd(&(bar)[XB_TMO], 1u); break; } } } } while (0)
struct XcdBarrier { unsigned* bar; unsigned x; volatile LAS unsigned* st; };
__device__ __forceinline__ XcdBarrier xcd_barrier_post(unsigned* bar, volatile LAS unsigned* st) {
    XcdBarrier b; b.bar = bar; b.x = xb_xcc_id(); b.st = st;
    if (threadIdx.x == 0) (void)xb_add(&bar[XB_XCNT(b.x)], 1u);
    return b;
}
__device__ __forceinline__ void xcd_barrier_complete(unsigned* bar, unsigned x, unsigned& nloc, unsigned& nx) {
    const unsigned G = gridDim.x * gridDim.y * gridDim.z;
    unsigned sum, cnt, mine, sp = 0u;
    for (;;) {
        sum = 0u; cnt = 0u; mine = 0u;
#pragma unroll
        for (unsigned j = 0; j < 16; ++j) { const unsigned c = xb_ld(&bar[XB_XCNT(j)]); sum += c; cnt += (c > 0u) ? 1u : 0u; mine = (j == x) ? c : mine; }
        if (sum == G) break;
        __builtin_amdgcn_s_sleep(1);
        if ((++sp & 255u) == 0u) { if (xb_ld(&bar[XB_TMO])) break; if (sp > XB_SPIN_CAP) { atomicAdd(&bar[XB_TMO], 1u); break; } }
    }
    nloc = mine > 0u ? mine : 1u; nx = cnt > 0u ? cnt : 1u;
}
__device__ __forceinline__ void xcd_barrier(const XcdBarrier& b) {
    asm volatile("s_waitcnt vmcnt(0)" ::: "memory");
    __syncthreads();
    if (threadIdx.x == 0) {
        unsigned* bar = b.bar;
        __builtin_amdgcn_s_waitcnt(0);
        unsigned nloc = b.st[0], nx = b.st[1];
        if (nloc == 0u) { xcd_barrier_complete(bar, b.x, nloc, nx); b.st[0] = nloc; b.st[1] = nx; }
        const unsigned old = xb_add(&bar[XB_XSUB(b.x)], 1u);
        const unsigned gen = old / nloc;
        if (old + 1u == (gen + 1u) * nloc) {
            __builtin_amdgcn_fence(__ATOMIC_RELEASE, "agent");
            asm volatile("s_waitcnt vmcnt(0)" ::: "memory");
            const unsigned og = xb_add(&bar[XB_TOP], 1u);
            const unsigned tg = og / nx;
            if (og + 1u == (tg + 1u) * nx) xb_add(&bar[XB_TOPGEN], 1u);
            else XB_SPIN(xb_ld(&bar[XB_TOPGEN]) == tg, bar);
            __builtin_amdgcn_fence(__ATOMIC_ACQUIRE, "agent");
            xb_add(&bar[XB_XGEN(b.x)], 1u);
            asm volatile("s_waitcnt vmcnt(0)" ::: "memory");
        } else {
            XB_SPIN(xb_ld(&bar[XB_XGEN(b.x)]) == gen, bar);
            __builtin_amdgcn_fence(__ATOMIC_ACQUIRE, "agent");
            asm volatile("s_waitcnt vmcnt(0)" ::: "memory");
        }
    }
    __syncthreads();
}

constexpr int NWAVES = 8;
constexpr int RING_BYTES = 151 * 1024;
constexpr int LDSCTL_OFF = RING_BYTES, MISC_OFF = LDSCTL_OFF + 320;
constexpr int LDS_BYTES = 152 * 1024;
static_assert(MISC_OFF + 128 <= LDS_BYTES, "LDS map");
constexpr int N_PHASES = 13;

struct Args {
    const float* x; const float* mem; const float* attn_g; const float* w_in; const float* q_g; const float* k_g; const float* pool_w; const float* pool_s;
    const float* mem_g; const float* w_kv; const float* mq_g; const float* mk_g; const float* w_out; const float* ffn_g; const float* w_q; const float* sk1; const float* sk2;
    const float* pu; const float* pv; float* out; unsigned char* ws; int ph_lo, ph_hi;
};
struct Frame {
    LAS unsigned char* lds; char* ldsg;
    int tid, lane, wave, vcu, G;
};

__device__ __forceinline__ int in_colmap(int n) {
    if (n < 4096) return n;
    if (n < 4608) return 4176 + (n - 4096);
    if (n < 5120) return 4688 + (n - 4608);
    if (n < 5184) return 4096 + (n - 5120);
    if (n < 5200) return 4160 + (n - 5184);
    return -1;
}
template <int MAP> __device__ __forceinline__ void p0_transpose_item(const float* W, int K, int N, bf16_t* WT, LAS float* scr, int kb, int nb, int lane) {
    const int k0 = 64 * kb, n0 = 32 * nb;
    int nsrc = n0 + (lane & 31); if (MAP == 1) nsrc = in_colmap(nsrc);
#pragma unroll 8
    for (int i = 0; i < 32; ++i) { const int kk = 2 * i + (lane >> 5); scr[kk * 33 + (lane & 31)] = nsrc >= 0 ? W[(size_t)(k0 + kk) * N + nsrc] : 0.f; }
    LDS_WAIT();
    const int c = lane & 7;
#pragma unroll
    for (int j = 0; j < 4; ++j) { const int n = (lane >> 3) + 8 * j; const LAS float* s = scr + (8 * c) * 33 + n;
        u32x4 o; o.x = cvtpk(s[0 * 33], s[1 * 33]); o.y = cvtpk(s[2 * 33], s[3 * 33]); o.z = cvtpk(s[4 * 33], s[5 * 33]); o.w = cvtpk(s[6 * 33], s[7 * 33]);
        *(u32x4*)(WT + (size_t)(n0 + n) * K + k0 + 8 * c) = o; }
    LDS_WAIT();
}
__device__ __forceinline__ void rms_row_to_bf16(const float* xrow, const float* gain, bf16_t* orow, int lane) {
    const f32x4* xr = (const f32x4*)xrow + lane;
    f32x4 v[8]; float s = 0.f;
#pragma unroll
    for (int j = 0; j < 8; ++j) { v[j] = xr[64 * j]; s += (v[j].x * v[j].x + v[j].y * v[j].y) + (v[j].z * v[j].z + v[j].w * v[j].w); }
    const float rstd = 1.f / sqrtf(wave_sum(s) * (1.f / DM) + EPS);
    unsigned long long* o8 = (unsigned long long*)orow + lane;
#pragma unroll
    for (int j = 0; j < 8; ++j) { const f32x4 g = ((const f32x4*)gain)[lane + 64 * j]; const f32x4 y = v[j] * rstd * g;
        o8[64 * j] = (unsigned long long)cvtpk(y.x, y.y) | ((unsigned long long)cvtpk(y.z, y.w) << 32); }
}
__device__ __forceinline__ void rms_row_to_bf16_fp8(const float* xrow, const float* gain, bf16_t* orow, unsigned char* o8row, int lane) {
    const f32x4* xr = (const f32x4*)xrow + lane;
    f32x4 v[8]; float s = 0.f;
#pragma unroll
    for (int j = 0; j < 8; ++j) { v[j] = xr[64 * j]; s += (v[j].x * v[j].x + v[j].y * v[j].y) + (v[j].z * v[j].z + v[j].w * v[j].w); }
    const float rstd = 1.f / sqrtf(wave_sum(s) * (1.f / DM) + EPS);
    unsigned long long* o8 = (unsigned long long*)orow + lane; unsigned* q4 = (unsigned*)o8row + lane;
#pragma unroll
    for (int j = 0; j < 8; ++j) { const f32x4 g = ((const f32x4*)gain)[lane + 64 * j]; const f32x4 y = v[j] * rstd * g;
        o8[64 * j] = (unsigned long long)cvtpk(y.x, y.y) | ((unsigned long long)cvtpk(y.z, y.w) << 32);
        int w = __builtin_amdgcn_cvt_pk_fp8_f32(__builtin_amdgcn_fmed3f(y.x, -448.f, 448.f), __builtin_amdgcn_fmed3f(y.y, -448.f, 448.f), 0, false);
        w = __builtin_amdgcn_cvt_pk_fp8_f32(__builtin_amdgcn_fmed3f(y.z, -448.f, 448.f), __builtin_amdgcn_fmed3f(y.w, -448.f, 448.f), w, true); q4[64 * j] = (unsigned)w; }
}
struct RowF32 { f32x4 v[8]; };
__device__ __forceinline__ void row_load(RowF32& R, const float* xrow, int lane) {
    const f32x4* xr = (const f32x4*)xrow + lane;
#pragma unroll
    for (int j = 0; j < 8; ++j) R.v[j] = xr[64 * j];
}
__device__ __forceinline__ void row_load_bf16(RowF32& R, const bf16_t* brow, int lane) {
    const u32x2* br = (const u32x2*)brow + lane;
#pragma unroll
    for (int j = 0; j < 8; ++j) { const u32x2 w = br[64 * j]; R.v[j] = (f32x4){bflo(w.x), bfhi(w.x), bflo(w.y), bfhi(w.y)}; }
}
__device__ __forceinline__ void row_to_fp8(const RowF32& R, unsigned char* orow, float* inv, int lane) {
    unsigned* o4 = (unsigned*)orow + lane; float am = 0.f;
#pragma unroll
    for (int j = 0; j < 8; ++j) am = fmaxf(am, fmaxf(fmaxf(fabsf(R.v[j].x), fabsf(R.v[j].y)), fmaxf(fabsf(R.v[j].z), fabsf(R.v[j].w))));
#pragma unroll
    for (int o = 1; o < 64; o <<= 1) am = fmaxf(am, __shfl_xor(am, o));
    const float sc = (am > 0.f && am < 3.0e38f) ? exp2f(floorf(log2f(224.f / am))) : 1.f;
#pragma unroll
    for (int j = 0; j < 8; ++j) { int w = __builtin_amdgcn_cvt_pk_fp8_f32(R.v[j].x * sc, R.v[j].y * sc, 0, false); w = __builtin_amdgcn_cvt_pk_fp8_f32(R.v[j].z * sc, R.v[j].w * sc, w, true); o4[64 * j] = (unsigned)w; }
    if (lane == 0) *inv = 1.f / sc;
}
__device__ __forceinline__ void p0_prologue(const Frame& F, const Args& a) {
    unsigned char* ws = a.ws;
    LAS float* scr = (LAS float*)(F.lds + F.wave * 16384);
    const int gw = F.vcu * NWAVES + F.wave, NGW = F.G * NWAVES, lane = F.lane;
    bf16_t* BtIn = (bf16_t*)(ws + WS_BT_IN); bf16_t* BtOut = (bf16_t*)(ws + WS_BT_OUT); bf16_t* BtQ = (bf16_t*)(ws + WS_BT_Q); bf16_t* BtKV = (bf16_t*)(ws + WS_BT_KV);
    constexpr int I_IN = 32 * 168, I_OUT = 32 * 64, I_Q = 32 * 64, I_KV = 32 * 32;
    constexpr int NIT = I_IN + I_OUT + I_Q + I_KV;
    for (int it = gw; it < NIT; it += NGW) {
        int r = it;
        if (r < I_IN) { p0_transpose_item<1>(a.w_in, DM, IN_W, BtIn, scr, r / 168, r % 168, lane); continue; } r -= I_IN;
        if (r < I_OUT) { const int kb = r / 64; p0_transpose_item<0>(a.w_out, DM, DM, BtOut, scr, kb, r % 64, lane); continue; } r -= I_OUT;
        if (r < I_Q) { p0_transpose_item<0>(a.w_q, DM, DM, BtQ, scr, r / 64, r % 64, lane); continue; } r -= I_Q;
        p0_transpose_item<0>(a.w_kv, DM, 1024, BtKV, scr, r / 32, r % 32, lane);
    }
    { bf16_t* PWt = (bf16_t*)(ws + WS_PWT);
      for (int it = gw; it < 4 * 128; it += NGW) { const int g = it >> 7, e = it & 127; const float* pw = a.pool_w + (size_t)g * 16384 + e;
          const float v0 = pw[(size_t)(2 * lane) * 128], v1 = pw[(size_t)(2 * lane + 1) * 128]; ((unsigned*)(PWt + (size_t)it * 128))[lane] = cvtpk(v0, v1); } }
    bf16_t* XN = (bf16_t*)(ws + WS_XN); bf16_t* MN = (bf16_t*)(ws + WS_MN);
#if P1_FP8
    for (int m = gw; m < NTOK; m += NGW) rms_row_to_bf16_fp8(a.x + (size_t)m * DM, a.attn_g, XN + (size_t)m * DM, ws + WS_XN8 + (size_t)m * DM, lane);
#else
    for (int m = gw; m < NTOK; m += NGW) rms_row_to_bf16(a.x + (size_t)m * DM, a.attn_g, XN + (size_t)m * DM, lane);
#endif
    for (int m = gw; m < BATCH * MEMLEN; m += NGW) rms_row_to_bf16(a.mem + (size_t)m * DM, a.mem_g, MN + (size_t)m * DM, lane);
    unsigned char* UB = ws + WS_UB; unsigned char* VB = ws + WS_VB; float* RSU = (float*)(ws + WS_RSU); float* RSV = (float*)(ws + WS_RSV);
    (void)UB; (void)VB; (void)RSU; (void)RSV;
    bf16_t* PK = (bf16_t*)(ws + WS_PK);
    for (int m = gw; m < 256; m += NGW) { const float* src = (m < 128 ? a.sk1 + (size_t)m * 128 : a.sk2 + (size_t)(m - 128) * 128);
        const f32x2 v = ((const f32x2*)src)[lane]; ((unsigned*)(PK + (size_t)m * 128))[lane] = cvtpk(v.x, v.y); }
    float* RT = (float*)(ws + WS_ROPE);
    for (int p = gw; p < SEQ; p += NGW) {
        { const float invf = powf(10000.f, -(float)lane / 64.f); const float ang = (float)p * invf;
          RT[(size_t)p * 192 + lane] = (float)cos((double)ang); RT[(size_t)p * 192 + 64 + lane] = (float)sin((double)ang); }
        if (lane < 32) { const float invf = powf(10000.f, -(float)lane / 32.f); const float ang = (float)p * invf;
          RT[(size_t)p * 192 + 128 + lane] = (float)cos((double)ang); RT[(size_t)p * 192 + 160 + lane] = (float)sin((double)ang); }
    }
}

__device__ __forceinline__ void unpack8(const u32x4 w, float* x) { x[0] = bflo(w.x); x[1] = bfhi(w.x); x[2] = bflo(w.y); x[3] = bfhi(w.y); x[4] = bflo(w.z); x[5] = bfhi(w.z); x[6] = bflo(w.w); x[7] = bfhi(w.w); }
__device__ __forceinline__ u32x4 pack8(const float* x) { u32x4 w; w.x = cvtpk(x[0], x[1]); w.y = cvtpk(x[2], x[3]); w.z = cvtpk(x[4], x[5]); w.w = cvtpk(x[6], x[7]); return w; }
struct F8 { float v[8]; };
__device__ __forceinline__ F8 ld8f(const float* p) { const f32x4 a = *(const f32x4*)p, b = *(const f32x4*)(p + 4); F8 r; r.v[0] = a.x; r.v[1] = a.y; r.v[2] = a.z; r.v[3] = a.w; r.v[4] = b.x; r.v[5] = b.y; r.v[6] = b.z; r.v[7] = b.w; return r; }
__device__ __forceinline__ u32x2 pack8_fp8(const float* x) { int a = __builtin_amdgcn_cvt_pk_fp8_f32(x[0], x[1], 0, false); a = __builtin_amdgcn_cvt_pk_fp8_f32(x[2], x[3], a, true); int b = __builtin_amdgcn_cvt_pk_fp8_f32(x[4], x[5], 0, false); b = __builtin_amdgcn_cvt_pk_fp8_f32(x[6], x[7], b, true); return (u32x2){(unsigned)a, (unsigned)b}; }
template <bool NORM, bool ROPE, bool WB16 = true> __device__ __forceinline__ void head128_fin(bf16_t* base, const u32x4 wa, const u32x4 wb, int g, const F8& g1, const F8& g2, const F8& cc, const F8& sn, unsigned char* f8base = nullptr) {
    float x1[8], x2[8];
    unpack8(wa, x1); unpack8(wb, x2);
    if (NORM) {
        float ss = 0.f;
#pragma unroll
        for (int j = 0; j < 8; ++j) ss += x1[j] * x1[j] + x2[j] * x2[j];
        ss += __shfl_xor(ss, 1); ss += __shfl_xor(ss, 2); ss += __shfl_xor(ss, 4);
        const float rstd = 1.f / sqrtf(ss * (1.f / 128.f) + EPS);
#pragma unroll
        for (int j = 0; j < 8; ++j) { x1[j] = x1[j] * rstd * g1.v[j]; x2[j] = x2[j] * rstd * g2.v[j]; }
    }
    if (ROPE) {
#pragma unroll
        for (int j = 0; j < 8; ++j) { const float c = cc.v[j], sv = sn.v[j]; const float p = x1[j], q = x2[j]; x1[j] = p * c - q * sv; x2[j] = q * c + p * sv; }
    }
    if (WB16) { *(u32x4*)(base + 8 * g) = pack8(x1); *(u32x4*)(base + 64 + 8 * g) = pack8(x2); }
    if (f8base) { *(u32x2*)(f8base + 8 * g) = pack8_fp8(x1); *(u32x2*)(f8base + 64 + 8 * g) = pack8_fp8(x2); }
}
__device__ __forceinline__ void head64_fin(bf16_t* base, const u32x4 wa, const u32x4 wb, int g, const F8& cc, const F8& sn) {
    float x1[8], x2[8];
    unpack8(wa, x1); unpack8(wb, x2);
#pragma unroll
    for (int j = 0; j < 8; ++j) { const float c = cc.v[j], sv = sn.v[j]; const float p = x1[j], q = x2[j]; x1[j] = p * c - q * sv; x2[j] = q * c + p * sv; }
    *(u32x4*)(base + 8 * g) = pack8(x1); *(u32x4*)(base + 32 + 8 * g) = pack8(x2);
}
__device__ __forceinline__ void p2_post(const Frame& F, const Args& a) {
    unsigned char* ws = a.ws; const int lane = F.lane;
    const int gw = F.vcu * NWAVES + F.wave, NGW = F.G * NWAVES;
    bf16_t* Z = (bf16_t*)(ws + WS_Z); bf16_t* MIX = (bf16_t*)(ws + WS_XN); bf16_t* KVM = (bf16_t*)(ws + WS_KVM);
    const float* RT = (const float*)(ws + WS_ROPE);
    const int g8 = lane & 7, h8 = lane >> 3, g4 = lane & 3, h4 = lane >> 2;
    const F8 qg1 = ld8f(a.q_g + 8 * g8), qg2 = ld8f(a.q_g + 64 + 8 * g8), kg1 = ld8f(a.k_g + 8 * g8), kg2 = ld8f(a.k_g + 64 + 8 * g8), mg1 = ld8f(a.mq_g + 8 * g8), mg2 = ld8f(a.mq_g + 64 + 8 * g8);
    for (int t = gw; t < NTOK; t += NGW) {
        const int pos = t & (SEQ - 1);
        bf16_t* zr = Z + (size_t)t * ZLD; const float* rp = RT + (size_t)pos * 192;
        const int w = 2 << (lane >> 4); const int cnt = (pos + 1 < w) ? pos + 1 : w;
        u32x4 pl[16];
#pragma unroll
        for (int j = 0; j < 16; ++j) { const int jj = j < cnt ? j : 0; pl[j] = *(const u32x4*)(zr - (size_t)jj * ZLD + ZC_PU + 8 * lane); }
        bf16_t* bq = zr + ZC_Q + h8 * 128; bf16_t* bk = zr + ZC_K + h8 * 128; bf16_t* bi = zr + ZC_QI + h4 * 64; bf16_t* bki = zr + ZC_KI; bf16_t* bm = zr + ZC_QM + (h8 & 3) * 128;
        const u32x4 q1 = *(const u32x4*)(bq + 8 * g8), q2 = *(const u32x4*)(bq + 64 + 8 * g8), k1 = *(const u32x4*)(bk + 8 * g8), k2 = *(const u32x4*)(bk + 64 + 8 * g8);
        const u32x4 i1 = *(const u32x4*)(bi + 8 * g4), i2 = *(const u32x4*)(bi + 32 + 8 * g4), x1 = *(const u32x4*)(bki + 8 * g4), x2 = *(const u32x4*)(bki + 32 + 8 * g4);
        const u32x4 m1 = *(const u32x4*)(bm + 8 * g8), m2 = *(const u32x4*)(bm + 64 + 8 * g8);
        const F8 c128 = ld8f(rp + 8 * g8), s128 = ld8f(rp + 64 + 8 * g8), c64 = ld8f(rp + 128 + 8 * g4), s64 = ld8f(rp + 160 + 8 * g4);
#if QK_FP8
        head128_fin<true, true, ATT_VERIFY != 0>(bq, q1, q2, g8, qg1, qg2, c128, s128, ws + WS_Q8 + (size_t)t * 1024 + h8 * 128);
        head128_fin<true, true, ATT_VERIFY != 0>(bk, k1, k2, g8, kg1, kg2, c128, s128, ws + WS_K8 + (size_t)t * 1024 + h8 * 128);
#else
        head128_fin<true, true>(bq, q1, q2, g8, qg1, qg2, c128, s128);
        head128_fin<true, true>(bk, k1, k2, g8, kg1, kg2, c128, s128);
#endif
        head64_fin(bi, i1, i2, g4, c64, s64);
        if (lane < 4) head64_fin(bki, x1, x2, g4, c64, s64);
        if (lane < 32) head128_fin<true, false>(bm, m1, m2, g8, mg1, mg2, c128, s128);
        { float sum[8] = {0.f, 0.f, 0.f, 0.f, 0.f, 0.f, 0.f, 0.f}, ut[8];
          unpack8(pl[0], ut);
#pragma unroll
          for (int j = 0; j < 16; ++j) { float v[8]; unpack8(pl[j], v); const float on = j < cnt ? 1.f : 0.f;
#pragma unroll
              for (int e = 0; e < 8; ++e) sum[e] = fmaf(on, v[e], sum[e]); }
          const float inv = 1.f / (float)cnt; float d[8];
#pragma unroll
          for (int e = 0; e < 8; ++e) d[e] = sum[e] * inv - ut[e];
          *(u32x4*)(MIX + (size_t)t * DM + 1024 + 8 * lane) = pack8(d); }
    }
    const F8 kmg1 = ld8f(a.mk_g + 8 * g8), kmg2 = ld8f(a.mk_g + 64 + 8 * g8);
    for (int r = gw; r < BATCH * MEMLEN; r += NGW) { if (lane < 32) { bf16_t* bm = KVM + (size_t)r * 1024 + (lane >> 3) * 128; const u32x4 m1 = *(const u32x4*)(bm + 8 * g8), m2 = *(const u32x4*)(bm + 64 + 8 * g8); head128_fin<true, false>(bm, m1, m2, g8, kmg1, kmg2, kmg1, kmg2); } }
}

namespace ix {
constexpr int KP = 144, KBUF = 64 * KP;
constexpr int OFF_KI = 0, OFF_HIST = 2 * KBUF, OFF_ST = OFF_HIST + 65536, OFF_W = OFF_ST + 8192;
constexpr int CAPB = 1024;
constexpr int CAPF = 512;
enum { S_ULO = 0, S_UHI = 64, S_SH = 128, S_NEED = 192, S_FLO = 256, S_FHI = 320, S_CCNT = 384, S_ACT = 448, S_ABOVE = 512, S_COL = 576, S_FAIL = 640,
       S_PB1 = 704, S_PB2 = 768, S_PAB = 832, S_VMIN = 896, S_VMAX = 960, S_VCNT = 1024, S_ANY = 1088, S_R1 = 1089, S_R2 = 1090 };
constexpr float WSCALE = 0.25f * 0.125f;
__device__ __forceinline__ float relu_i(float x) { const int i = __float_as_int(x); return __int_as_float(i > 0 ? i : 0); }
__device__ __forceinline__ unsigned sh_for(unsigned range) { const int bits = 32 - __clz((int)range); return range == 0u ? 0u : (bits > 9 ? (unsigned)(bits - 9) : 0u); }

template <int MODE>
__device__ __forceinline__ void sweep(const Frame& F, const bf16x8 (&A)[4][4], const bf16_t* Z, unsigned* MASK, unsigned long long* CAND, size_t qrow0, size_t krow0, int NT, int t0, int stride, int vmode) {
    const int tid = F.tid, lane = F.lane, wave = F.wave, r = lane & 31, hi = lane >> 5;
    LAS unsigned char* lds = F.lds;
    volatile LAS unsigned* st = (volatile LAS unsigned*)(lds + OFF_ST);
    LAS unsigned* hist32 = (LAS unsigned*)(lds + OFF_HIST);
    unsigned qact = 0u;
    {
#pragma unroll
        for (int qp = 0; qp < 4; ++qp) { const int q0 = 8 * wave + 2 * qp; const unsigned a2 = (MODE == 0) ? (st[S_ACT + q0] | st[S_ACT + q0 + 1]) : (vmode ? 1u : (st[S_COL + q0] | st[S_COL + q0 + 1]));
            qact |= ((unsigned)__builtin_amdgcn_readfirstlane((int)a2) != 0u ? 1u : 0u) << qp; }
    }
    unsigned ccnt_[4] = {0u, 0u, 0u, 0u}, abv_[4] = {0u, 0u, 0u, 0u};
    if (MODE == 1) {
#pragma unroll
        for (int qp = 0; qp < 4; ++qp) { ccnt_[qp] = st[S_CCNT + 8 * wave + 2 * qp + hi]; abv_[qp] = st[S_ABOVE + 8 * wave + 2 * qp + hi]; }
    }
    const int srow = tid >> 3, sch = tid & 7;
    const bf16_t* ksrc = Z + (krow0 + srow) * ZLD + ZC_KI + sch * 8;
    u32x4 stg = *(const u32x4*)(ksrc + (size_t)t0 * 64 * ZLD);
    *(LAS u32x4*)(lds + OFF_KI + srow * KP + sch * 16) = stg;
    __syncthreads();
    int buf = 0;
    for (int t = t0; t < NT; t += stride) {
        const int tn = t + stride;
        if (tn < NT) stg = *(const u32x4*)(ksrc + (size_t)tn * 64 * ZLD);
        LAS unsigned char* kb = lds + OFF_KI + buf * KBUF;
        int lane_ = (int)threadIdx.x; asm volatile("" : "+v"(lane_)); lane_ &= 63;
        const int r = lane_ & 31, hi = lane_ >> 5;
        bf16x8 B0[4], B1[4];
#pragma unroll
        for (int ks = 0; ks < 4; ++ks) { B0[ks] = *(const LAS bf16x8*)(kb + r * KP + ks * 32 + hi * 16); B1[ks] = *(const LAS bf16x8*)(kb + (32 + r) * KP + ks * 32 + hi * 16); }
#pragma unroll
        for (int qp = 0; qp < 4; ++qp) {
            if (((qact >> qp) & 1u) == 0u) continue;
            const int ql = 8 * wave + 2 * qp + hi;
            const LAS f32x4* wq = (const LAS f32x4*)(lds + OFF_W + ql * 64);
            const f32x4 w0 = wq[0], w1 = wq[1], w2 = wq[2], w3 = wq[3];
            f32x16 a0 = f32x16{}, a1 = f32x16{};
#pragma unroll
            for (int ks = 0; ks < 4; ++ks) { a0 = __builtin_amdgcn_mfma_f32_32x32x16_bf16(A[qp][ks], B0[ks], a0, 0, 0, 0); a1 = __builtin_amdgcn_mfma_f32_32x32x16_bf16(A[qp][ks], B1[ks], a1, 0, 0, 0); }
            float p0 = w0.x * relu_i(a0[0]), p1 = w2.x * relu_i(a0[8]), q0 = w0.x * relu_i(a1[0]), q1 = w2.x * relu_i(a1[8]);
            p0 = fmaf(w0.y, relu_i(a0[1]), p0); p1 = fmaf(w2.y, relu_i(a0[9]), p1); q0 = fmaf(w0.y, relu_i(a1[1]), q0); q1 = fmaf(w2.y, relu_i(a1[9]), q1);
            p0 = fmaf(w0.z, relu_i(a0[2]), p0); p1 = fmaf(w2.z, relu_i(a0[10]), p1); q0 = fmaf(w0.z, relu_i(a1[2]), q0); q1 = fmaf(w2.z, relu_i(a1[10]), q1);
            p0 = fmaf(w0.w, relu_i(a0[3]), p0); p1 = fmaf(w2.w, relu_i(a0[11]), p1); q0 = fmaf(w0.w, relu_i(a1[3]), q0); q1 = fmaf(w2.w, relu_i(a1[11]), q1);
            p0 = fmaf(w1.x, relu_i(a0[4]), p0); p1 = fmaf(w3.x, relu_i(a0[12]), p1); q0 = fmaf(w1.x, relu_i(a1[4]), q0); q1 = fmaf(w3.x, relu_i(a1[12]), q1);
            p0 = fmaf(w1.y, relu_i(a0[5]), p0); p1 = fmaf(w3.y, relu_i(a0[13]), p1); q0 = fmaf(w1.y, relu_i(a1[5]), q0); q1 = fmaf(w3.y, relu_i(a1[13]), q1);
            p0 = fmaf(w1.z, relu_i(a0[6]), p0); p1 = fmaf(w3.z, relu_i(a0[14]), p1); q0 = fmaf(w1.z, relu_i(a1[6]), q0); q1 = fmaf(w3.z, relu_i(a1[14]), q1);
            p0 = fmaf(w1.w, relu_i(a0[7]), p0); p1 = fmaf(w3.w, relu_i(a0[15]), p1); q0 = fmaf(w1.w, relu_i(a1[7]), q0); q1 = fmaf(w3.w, relu_i(a1[15]), q1);
            const unsigned u0 = f2ord(p0 + p1), u1 = f2ord(q0 + q1);
            if (MODE == 0) {
                const unsigned wlo = st[S_ULO + ql], whi = st[S_UHI + ql], wsh = st[S_SH + ql];
                if (u0 >= wlo && u0 <= whi) { const unsigned bin = (u0 - wlo) >> wsh;
                    __hip_atomic_fetch_add(hist32 + ql * 256 + (bin >> 1), 1u << ((bin & 1u) * 16u), __ATOMIC_RELAXED, __HIP_MEMORY_SCOPE_WORKGROUP); }
                if (u1 >= wlo && u1 <= whi) { const unsigned bin = (u1 - wlo) >> wsh;
                    __hip_atomic_fetch_add(hist32 + ql * 256 + (bin >> 1), 1u << ((bin & 1u) * 16u), __ATOMIC_RELAXED, __HIP_MEMORY_SCOPE_WORKGROUP); }
            } else if (IX_VERIFY && vmode) {
                LAS unsigned* vs = (LAS unsigned*)(lds + OFF_ST) + ql;
                const unsigned long long w64 = __hip_atomic_load((const unsigned long long*)(MASK + (qrow0 + ql) * MASK_WPR + 2 * t), __ATOMIC_RELAXED, __HIP_MEMORY_SCOPE_AGENT);
                if ((w64 >> r) & 1ull) { __hip_atomic_fetch_min(vs + S_VMIN, u0, __ATOMIC_RELAXED, __HIP_MEMORY_SCOPE_WORKGROUP); __hip_atomic_fetch_add(vs + S_VCNT, 1u, __ATOMIC_RELAXED, __HIP_MEMORY_SCOPE_WORKGROUP); }
                else __hip_atomic_fetch_max(vs + S_VMAX, u0, __ATOMIC_RELAXED, __HIP_MEMORY_SCOPE_WORKGROUP);
                if ((w64 >> (32 + r)) & 1ull) { __hip_atomic_fetch_min(vs + S_VMIN, u1, __ATOMIC_RELAXED, __HIP_MEMORY_SCOPE_WORKGROUP); __hip_atomic_fetch_add(vs + S_VCNT, 1u, __ATOMIC_RELAXED, __HIP_MEMORY_SCOPE_WORKGROUP); }
                else __hip_atomic_fetch_max(vs + S_VMAX, u1, __ATOMIC_RELAXED, __HIP_MEMORY_SCOPE_WORKGROUP);
            } else {
                const unsigned flo = st[S_FLO + ql], fhi = st[S_FHI + ql]; const bool col = st[S_COL + ql] != 0u;
                const unsigned long long bal0 = __ballot(col && u0 > fhi), bal1 = __ballot(col && u1 > fhi);
                const unsigned bh0 = (unsigned)(bal0 >> (32 * hi)), bh1 = (unsigned)(bal1 >> (32 * hi));
                if (col && r == 0) *(unsigned long long*)(MASK + (qrow0 + ql) * MASK_WPR + 2 * t) = (unsigned long long)bh0 | ((unsigned long long)bh1 << 32);
                abv_[qp] += __popc(bh0) + __popc(bh1);
                const bool c0 = col && (u0 >= flo) && (u0 <= fhi), c1 = col && (u1 >= flo) && (u1 <= fhi);
                const unsigned long long cb0 = __ballot(c0), cb1 = __ballot(c1);
                if (cb0 | cb1) { const unsigned h0 = (unsigned)(cb0 >> (32 * hi)), h1 = (unsigned)(cb1 >> (32 * hi)); const unsigned lt = (1u << r) - 1u;
                    const unsigned pos0 = ccnt_[qp] + __popc(h0 & lt), pos1 = ccnt_[qp] + __popc(h0) + __popc(h1 & lt);
                    if (c0 && pos0 < (unsigned)CAPB) CAND[(size_t)ql * CAPB + pos0] = (unsigned long long)u0 | ((unsigned long long)(unsigned)(64 * t + r) << 32);
                    if (c1 && pos1 < (unsigned)CAPB) CAND[(size_t)ql * CAPB + pos1] = (unsigned long long)u1 | ((unsigned long long)(unsigned)(64 * t + 32 + r) << 32);
                    ccnt_[qp] += __popc(h0) + __popc(h1); }
            }
        }
        if (tn < NT) *(LAS u32x4*)(lds + OFF_KI + (buf ^ 1) * KBUF + srow * KP + sch * 16) = stg;
        __syncthreads();
        buf ^= 1;
    }
    if (MODE == 1 && !vmode) { const int r0 = lane & 31, h0 = lane >> 5;
#pragma unroll
        for (int qp = 0; qp < 4; ++qp) { const int ql = 8 * wave + 2 * qp + h0; if (r0 == 0 && st[S_COL + ql] != 0u) { st[S_CCNT + ql] = ccnt_[qp]; st[S_ABOVE + ql] = abv_[qp]; } } }
}

__device__ __forceinline__ void resolve(const Frame& F, unsigned* MASK, const unsigned long long* CAND, size_t qrow0, int NT) {
    int lane = (int)threadIdx.x; asm volatile("" : "+v"(lane)); lane &= 63; const int wave = F.wave;
    LAS unsigned char* lds = F.lds;
    volatile LAS unsigned* st = (volatile LAS unsigned*)(lds + OFF_ST);
    LAS unsigned* wh = (LAS unsigned*)(lds + OFF_HIST + wave * 4608); LAS unsigned* bm = wh + 512; LAS unsigned long long* sl = (LAS unsigned long long*)(bm + 512);
    const unsigned long long ltm = (1ull << lane) - 1ull;
    for (int qi = 0; qi < 8; ++qi) {
        const int q = 8 * wave + qi;
        if (st[S_COL + q] == 0u) continue;
        const unsigned cnt = st[S_CCNT + q], ab = st[S_ABOVE + q];
        if (!(ab < 256u && ab + cnt >= 256u && cnt <= (unsigned)CAPB)) { if (lane == 0) st[S_FAIL + q] = 1u; continue; }
        if (lane == 0) st[S_FAIL + q] = 0u;
        unsigned need = 256u - ab, lo = st[S_FLO + q], hi = st[S_FHI + q], sh = 0u, cbin = 0u;
        const unsigned long long* cq = CAND + (size_t)q * CAPB;
#pragma unroll
        for (int i = 0; i < 8; ++i) bm[lane * 8 + i] = 0u;
        for (int lev = 0; lev < 5; ++lev) {
            sh = sh_for(hi - lo);
#pragma unroll
            for (int i = 0; i < 8; ++i) wh[lane * 8 + i] = 0u;
            LDS_WAIT();
            for (unsigned j = lane; j < cnt; j += 64) { const unsigned u = (unsigned)cq[j]; if (u >= lo && u <= hi) __hip_atomic_fetch_add(wh + ((u - lo) >> sh), 1u, __ATOMIC_RELAXED, __HIP_MEMORY_SCOPE_WORKGROUP); }
            LDS_WAIT();
            unsigned hb[8], s8 = 0u;
#pragma unroll
            for (int i = 0; i < 8; ++i) { hb[i] = wh[lane * 8 + i]; s8 += hb[i]; }
            unsigned above = 0u;
            { unsigned inc = s8;
#pragma unroll
              for (int o = 1; o < 64; o <<= 1) { const unsigned v = __shfl_down(inc, o); if (lane + o < 64) inc += v; }
              above = inc - s8; }
            const bool mine = above < need && need <= above + s8;
            unsigned bstar = 0u, run = above, cb = 0u;
            if (mine) { bool found = false;
#pragma unroll
                for (int i = 7; i >= 0; --i) { if (!found) { if (run + hb[i] >= need) { bstar = (unsigned)(lane * 8 + i); cb = hb[i]; found = true; } else run += hb[i]; } } }
            const unsigned long long mb = __ballot(mine); const int src = mb ? (int)__builtin_ctzll(mb) : 0;
            bstar = __shfl(bstar, src); run = __shfl(run, src); cbin = __shfl(cb, src);
            const unsigned nlo = lo + (bstar << sh); const unsigned long long e = (unsigned long long)nlo + ((1ull << sh) - 1ull);
            hi = e > (unsigned long long)hi ? hi : (unsigned)e; lo = nlo; need -= run;
            if (cbin <= 64u || sh == 0u) break;
        }
        const bool tiemode = cbin > 64u;
        unsigned m = 0u;
        for (unsigned j0 = 0; j0 < cnt; j0 += 64) { const unsigned j = j0 + lane; const bool vj = j < cnt; const unsigned long long e = vj ? cq[j] : 0ull; const unsigned u = (unsigned)e, key = (unsigned)(e >> 32);
            const bool inw = vj && u >= lo && u <= hi; const unsigned long long bal = __ballot(inw); const unsigned pos = m + (unsigned)__popcll(bal & ltm);
            if (vj && (u > hi || (tiemode && inw && pos < need))) __hip_atomic_fetch_or(bm + (key >> 5), 1u << (key & 31u), __ATOMIC_RELAXED, __HIP_MEMORY_SCOPE_WORKGROUP);
            if (!tiemode && inw && pos < 64u) sl[pos] = e;
            m += (unsigned)__popcll(bal); }
        LDS_WAIT();
        if (!tiemode) { if (m > 64u) m = 64u;
            if ((unsigned)lane < m) { const unsigned long long ej = sl[lane]; const unsigned uj = (unsigned)ej; unsigned rank = 0u;
                for (unsigned j2 = 0; j2 < m; ++j2) { const unsigned u2 = (unsigned)sl[j2]; rank += (u2 > uj || (u2 == uj && j2 < (unsigned)lane)) ? 1u : 0u; }
                if (rank < need) { const unsigned key = (unsigned)(ej >> 32); __hip_atomic_fetch_or(bm + (key >> 5), 1u << (key & 31u), __ATOMIC_RELAXED, __HIP_MEMORY_SCOPE_WORKGROUP); } } }
        LDS_WAIT();
        unsigned* mrow = MASK + (qrow0 + q) * MASK_WPR;
        for (int w = lane; w < 2 * NT; w += 64) { const unsigned b = bm[w]; if (b) { const unsigned old = __hip_atomic_load(mrow + w, __ATOMIC_RELAXED, __HIP_MEMORY_SCOPE_AGENT); mrow[w] = old | b; } }
        LDS_WAIT();
    }
}

__device__ __forceinline__ void unit(const Frame& F, const bf16_t* Z, unsigned* MASK, unsigned long long* CANDW, unsigned* ERR, int b, int c) {
    const int tid = F.tid, lane = F.lane, wave = F.wave, r = lane & 31, hi = lane >> 5;
    const int NT = c + 1; const size_t qrow0 = (size_t)b * SEQ + 64 * c, krow0 = (size_t)b * SEQ;
    LAS unsigned char* lds = F.lds;
    volatile LAS unsigned* st = (volatile LAS unsigned*)(lds + OFF_ST);
    LAS unsigned* hist32 = (LAS unsigned*)(lds + OFF_HIST);
    { const int tend = 4 * ((c >> 2) + 1), nz = 2 * (tend - NT);
      for (int i = tid; i < 64 * nz; i += 512) { const int q = i / nz, wi = 2 * NT + i % nz; MASK[(qrow0 + q) * MASK_WPR + wi] = 0u; } }
    if (c <= 3) {
        for (int i = tid; i < 64 * 2 * NT; i += 512) { const int q = i / (2 * NT), wi = i % (2 * NT); MASK[(qrow0 + q) * MASK_WPR + wi] = 0xFFFFFFFFu; }
        return;
    }
    bf16x8 A[4][4];
#pragma unroll
    for (int qp = 0; qp < 4; ++qp) {
        const int query = 8 * wave + 2 * qp + ((r >> 2) & 1), head = (r & 3) + 4 * (r >> 3);
        const bf16_t* src = Z + (qrow0 + query) * ZLD + ZC_QI + head * 64 + 8 * hi;
#pragma unroll
        for (int ks = 0; ks < 4; ++ks) A[qp][ks] = *(const bf16x8*)(src + ks * 16);
    }
    for (int i = tid; i < 64 * 16; i += 512) { const int q = i >> 4, hh = i & 15; ((LAS float*)(lds + OFF_W))[i] = bflo((unsigned)Z[(qrow0 + q) * ZLD + ZC_WI + hh]) * WSCALE; }
    const int stride = NT >= 32 ? 8 : (NT >= 16 ? 4 : 1), t0 = stride >> 1, nsamp = (NT - t0 + stride - 1) / stride;
    const bool pilot = stride > 1;
    int r1 = 1, r2 = 1;
    if (pilot) { const float ns = 256.f * (float)nsamp / (float)NT; const float sg = sqrtf(ns * (1.f - 1.f / (float)stride)); const int mg = (int)ceilf(4.f * sg) + 2;
        r1 = (int)floorf(ns) - mg; if (r1 < 1) r1 = 1; r2 = (int)ceilf(ns) + mg; }
    if (tid < 64) { st[S_ULO + tid] = 0u; st[S_UHI + tid] = 0xFFFFFFFFu; st[S_SH + tid] = 23u; st[S_NEED + tid] = 256u; st[S_ACT + tid] = 1u; st[S_CCNT + tid] = 0u; st[S_ABOVE + tid] = 0u;
                    st[S_COL + tid] = 1u; st[S_FAIL + tid] = pilot ? 0u : 1u; st[S_PB1 + tid] = 511u; st[S_PB2 + tid] = 0u; st[S_PAB + tid] = 0u; }
    __syncthreads();
    int stage = pilot ? 0 : 2; bool after_fallback = !pilot;
    for (int iter = 0; iter < 24; ++iter) {
        if (stage <= 2) {
            { int tid_ = (int)threadIdx.x; asm volatile("" : "+v"(tid_));
              for (int i = 0; i < 32; ++i) hist32[tid_ + 512 * i] = 0u;
              if (tid_ == 0) st[S_ANY] = 0u; }
            __syncthreads();
            const bool smp = stage <= 1;
            sweep<0>(F, A, Z, MASK, CANDW, qrow0, krow0, NT, smp ? t0 : 0, smp ? stride : 1, 0);
            { int tid_ = (int)threadIdx.x; asm volatile("" : "+v"(tid_)); const int ln = tid_ & 63;
              const int q = tid_ >> 3, seg = tid_ & 7; const LAS unsigned* h32 = hist32 + q * 256 + seg * 32;
              unsigned cnt = 0u;
              for (int i = 0; i < 32; ++i) { const unsigned wv = h32[i]; cnt += (wv & 0xffffu) + (wv >> 16); }
              unsigned above = 0u;
#pragma unroll
              for (int k = 0; k < 8; ++k) { const unsigned ck = __shfl(cnt, (ln & ~7) + k); if (k > seg) above += ck; }
              const unsigned ulo = st[S_ULO + q], uhi = st[S_UHI + q], sh = st[S_SH + q];
              if (smp) {
                  const unsigned pab = stage == 1 ? st[S_PAB + q] : 0u;
                  const unsigned t1 = (unsigned)r1 - (stage == 1 ? pab : 0u), t2 = (unsigned)r2 - (stage == 1 ? pab : 0u);
#pragma unroll
                  for (int which = 0; which < 2; ++which) { const unsigned tg = which ? t2 : t1;
                      if (above < tg && tg <= above + cnt) { unsigned run = above; int bstar = -1;
                          for (int i = 31; i >= 0; --i) { const unsigned wv = h32[i]; const unsigned c1 = wv >> 16, c0 = wv & 0xffffu;
                              if (bstar < 0) { if (run + c1 >= tg) bstar = seg * 64 + 2 * i + 1; else run += c1; }
                              if (bstar < 0) { if (run + c0 >= tg) bstar = seg * 64 + 2 * i; else run += c0; } }
                          if (which == 0) { st[S_PB1 + q] = (unsigned)bstar; if (stage == 0) st[S_PAB + q] = run; } else st[S_PB2 + q] = (unsigned)bstar; } }
              } else {
                  const unsigned need = st[S_NEED + q], active = st[S_ACT + q];
                  if (active && above < need && need <= above + cnt) {
                      unsigned run = above; int bstar = -1; unsigned cbin = 0u;
                      for (int i = 31; i >= 0; --i) { const unsigned wv = h32[i]; const unsigned c1 = wv >> 16, c0 = wv & 0xffffu;
                          if (bstar < 0) { if (run + c1 >= need) { bstar = seg * 64 + 2 * i + 1; cbin = c1; } else run += c1; }
                          if (bstar < 0) { if (run + c0 >= need) { bstar = seg * 64 + 2 * i; cbin = c0; } else run += c0; } }
                      const unsigned nlo = ulo + ((unsigned)bstar << sh); const unsigned long long e = (unsigned long long)nlo + ((1ull << sh) - 1ull);
                      const unsigned nhi = e > (unsigned long long)uhi ? uhi : (unsigned)e;
                      if (cbin <= (unsigned)CAPF || sh == 0u) { st[S_FLO + q] = nlo; st[S_FHI + q] = nhi; st[S_ACT + q] = 0u; st[S_ULO + q] = 1u; st[S_UHI + q] = 0u; }
                      else { st[S_ULO + q] = nlo; st[S_UHI + q] = nhi; st[S_SH + q] = sh >= 9u ? sh - 9u : 0u; st[S_NEED + q] = need - run; st[S_ANY] = 1u; }
                  }
              } }
            __syncthreads();
            if (stage == 0) {
                if (tid < 64) { const unsigned b1 = st[S_PB1 + tid], b2 = st[S_PB2 + tid]; const unsigned nlo = b2 << 23; const unsigned long long e = ((unsigned long long)(b1 + 1u) << 23) - 1ull;
                    const unsigned nhi = e > 0xFFFFFFFFull ? 0xFFFFFFFFu : (unsigned)e; st[S_ULO + tid] = nlo; st[S_UHI + tid] = nhi; st[S_SH + tid] = sh_for(nhi - nlo); st[S_PB1 + tid] = 511u; st[S_PB2 + tid] = 0u; }
                stage = 1;
            } else if (stage == 1) {
                if (tid < 64) { const unsigned b1 = st[S_PB1 + tid], b2 = st[S_PB2 + tid], ulo = st[S_ULO + tid], uhi = st[S_UHI + tid], sh = st[S_SH + tid];
                    const unsigned flo = ulo + (b2 << sh); const unsigned long long e = (unsigned long long)ulo + ((unsigned long long)(b1 + 1u) << sh) - 1ull;
                    st[S_FLO + tid] = flo; st[S_FHI + tid] = e > (unsigned long long)uhi ? uhi : (unsigned)e; }
                stage = 3;
            } else { const unsigned any = st[S_ANY]; if (!any) stage = 3; }
            __syncthreads();
        } else {
            const int vm = stage == 4 ? 1 : 0;
            if (vm) { if (tid < 64) { st[S_VMIN + tid] = 0xFFFFFFFFu; st[S_VMAX + tid] = 0u; st[S_VCNT + tid] = 0u; } __syncthreads(); }
            sweep<1>(F, A, Z, MASK, CANDW, qrow0, krow0, NT, 0, 1, vm);
            VM_WAIT(); __syncthreads();
            if (vm) { if (tid < 64) { if (st[S_VCNT + tid] != 256u || st[S_VMIN + tid] < st[S_VMAX + tid]) atomicOr(ERR, 1u); } __syncthreads(); break; }
            resolve(F, MASK, CANDW, qrow0, NT);
            VM_WAIT(); __syncthreads();
            unsigned nf = 0u;
            if (!after_fallback) { if (tid < 64) nf = st[S_FAIL + tid] & st[S_COL + tid]; nf = (unsigned)__syncthreads_or((int)nf); }
            if (nf) {
                if (tid < 64) { const unsigned f = st[S_FAIL + tid] & st[S_COL + tid]; st[S_ULO + tid] = f ? 0u : 1u; st[S_UHI + tid] = f ? 0xFFFFFFFFu : 0u; st[S_SH + tid] = 23u; st[S_NEED + tid] = 256u; st[S_ACT + tid] = f;
                    st[S_COL + tid] = f; if (f) { st[S_CCNT + tid] = 0u; st[S_ABOVE + tid] = 0u; } }
                __syncthreads();
                stage = 2; after_fallback = true;
            } else { if (IX_VERIFY) stage = 4; else break; }
        }
    }
}
}

namespace peer {
constexpr int TT = 16;
constexpr int SP = 129;
constexpr int OFF_S = 0, OFF_L = 256 * SP * 4;
constexpr int OFF_A = 0;
__device__ __forceinline__ void ins16(unsigned (&L)[16], unsigned x) {
#pragma unroll
    for (int j = 0; j < 16; ++j) { const unsigned a = L[j]; const unsigned mx = a > x ? a : x; x = a > x ? x : a; L[j] = mx; }
}
__device__ __forceinline__ float dot2bf(unsigned w, unsigned x, float acc) { return __builtin_amdgcn_fdot2_f32_bf16(__builtin_bit_cast(bf16x2_t, w), __builtin_bit_cast(bf16x2_t, x), acc, false); }
__device__ __forceinline__ float gelu_erf(float h) { return 0.5f * h * (1.f + erff(h * 0.70710678118654752f)); }

__device__ __forceinline__ void fp8dot4(unsigned w, f32x2 h01, f32x2 h23, f32x2& a0, f32x2& a1) {
    const f32x2 lo = __builtin_amdgcn_cvt_pk_f32_fp8((int)w, false), hi = __builtin_amdgcn_cvt_pk_f32_fp8((int)w, true); a0 = lo * h01 + a0; a1 = hi * h23 + a1; }
__device__ __forceinline__ void fp8axpy4(unsigned w, f32x2 a2, f32x2& c01, f32x2& c23) {
    const f32x2 lo = __builtin_amdgcn_cvt_pk_f32_fp8((int)w, false), hi = __builtin_amdgcn_cvt_pk_f32_fp8((int)w, true); c01 = lo * a2 + c01; c23 = hi * a2 + c23; }
constexpr int NSL = 16, SLW = 128;
__device__ __forceinline__ float dpp_sum8(float v) {
    v += __int_as_float(__builtin_amdgcn_update_dpp(0, __float_as_int(v), 0xB1, 0xF, 0xF, true));
    v += __int_as_float(__builtin_amdgcn_update_dpp(0, __float_as_int(v), 0x4E, 0xF, 0xF, true));
    v += __int_as_float(__builtin_amdgcn_update_dpp(0, __float_as_int(v), 0x141, 0xF, 0xF, true));
    return v;
}
#define PEER_EID(V0, V1, i) ((((i) < 8 ? (V0) : (V1))[((i) & 7) >> 1] >> (16 * ((i) & 1))) & 0xffffu)

struct TabCvt { const float* pu; const float* pv; unsigned char* UB; unsigned char* VB; float* RSU; float* RSV; };
__device__ __forceinline__ const float* tab_src(const TabCvt& T, int m) { return m < NEXP ? T.pu + (size_t)m * DM : T.pv + (size_t)(m - NEXP) * DM; }
__device__ __forceinline__ void tab_finish(const TabCvt& T, const RowF32& R, int m, int lane) { if (m < NEXP) row_to_fp8(R, T.UB + (size_t)m * DM, T.RSU + m, lane); else row_to_fp8(R, T.VB + (size_t)(m - NEXP) * DM, T.RSV + (m - NEXP), lane); }
__device__ __forceinline__ void route_step(const Frame& F, const bf16_t* PQ, const bf16x8 (&Bf)[2][8], unsigned short* E16, float* GT, int tok0, const TabCvt& T, int m0, int m1) {
    const int tid = F.tid, lane = F.lane, wave = F.wave, r = lane & 31, hi = lane >> 5;
    LAS float* S = (LAS float*)(F.lds + OFF_S); LAS unsigned* L = (LAS unsigned*)(F.lds + OFF_L);
    RowF32 R;
    if (m0 >= 0) row_load(R, tab_src(T, m0), lane);
    { const int half = wave & 1, cp = (wave >> 1) & 1, rh = wave >> 2;
#pragma unroll
      for (int r2 = 0; r2 < 2; ++r2) {
          const int rt = 2 * rh + r2; const int pair = 32 * rt + r, tok = pair >> 3, p = pair & 7;
          const bf16_t* src = PQ + (size_t)(tok0 + tok) * DM + p * 256 + half * 128 + 8 * hi;
          bf16x8 A[8];
#pragma unroll
          for (int ks = 0; ks < 8; ++ks) A[ks] = *(const bf16x8*)(src + ks * 16);
#pragma unroll
          for (int c2 = 0; c2 < 2; ++c2) {
              f32x16 acc = f32x16{};
#pragma unroll
              for (int ks = 0; ks < 8; ++ks) acc = __builtin_amdgcn_mfma_f32_32x32x16_bf16(A[ks], Bf[c2][ks], acc, 0, 0, 0);
#pragma unroll
              for (int i = 0; i < 16; ++i) { const int row = (32 * rt + (i & 3) + 8 * (i >> 2) + 4 * hi) * 2 + half; S[row * SP + (2 * cp + c2) * 32 + r] = acc[i]; }
          } } }
    if (m0 >= 0) tab_finish(T, R, m0, lane);
    if (m1 >= 0) row_load(R, tab_src(T, m1), lane);
    __syncthreads();
    { const int row = tid >> 1, part = tid & 1; unsigned L16[16];
#pragma unroll
      for (int j = 0; j < 16; ++j) L16[j] = 0u;
#pragma unroll 4
      for (int n = 0; n < 64; ++n) { const int nn = part * 64 + n; const unsigned k = (f2ord(S[row * SP + nn]) & ~127u) | (unsigned)(127 - nn); ins16(L16, k); }
      unsigned oth[16];
#pragma unroll
      for (int j = 0; j < 16; ++j) oth[j] = __shfl_xor(L16[j], 1);
#pragma unroll
      for (int j = 0; j < 16; ++j) ins16(L16, part == 0 ? oth[j] : 0u);
      if (part == 0) {
#pragma unroll
          for (int j = 0; j < 16; ++j) L[row * 16 + j] = L16[j]; } }
    __syncthreads();
    if (tid < 128) {
        const int pair = tid; const LAS float* S1 = S + (pair * 2) * SP; const LAS float* S2 = S + (pair * 2 + 1) * SP;
        const LAS unsigned* L1 = L + (pair * 2) * 16; const LAS unsigned* L2 = L1 + 16;
        float v1[16], v2[16];
#pragma unroll
        for (int j = 0; j < 16; ++j) { v1[j] = S1[127 - (L1[j] & 127u)]; v2[j] = S2[127 - (L2[j] & 127u)]; }
        unsigned C16[16];
#pragma unroll
        for (int j = 0; j < 16; ++j) C16[j] = 0u;
#pragma unroll
        for (int i = 0; i < 16; ++i)
#pragma unroll
            for (int j = 0; j < 16; ++j) if ((i + 1) * (j + 1) <= 16) { const unsigned k = (f2ord(v1[i] + v2[j]) & ~255u) | (unsigned)(255 - (i * 16 + j)); ins16(C16, k); }
        float sc[16]; unsigned ex[16]; float mx = -3.0e38f;
#pragma unroll
        for (int q = 0; q < 16; ++q) { const unsigned ci = 255u - (C16[q] & 255u); const unsigned n1 = 127u - (L1[ci >> 4] & 127u), n2 = 127u - (L2[ci & 15u] & 127u);
            sc[q] = S1[n1] + S2[n2]; ex[q] = n1 * 128u + n2; mx = fmaxf(mx, sc[q]); }
        float sum = 0.f;
#pragma unroll
        for (int q = 0; q < 16; ++q) { sc[q] = __expf(sc[q] - mx); sum += sc[q]; }
        const float inv = 1.f / sum;
        const size_t o = (size_t)(tok0 + (pair >> 3)) * 128 + (pair & 7) * 16;
        u32x4 e0, e1; e0.x = ex[0] | (ex[1] << 16); e0.y = ex[2] | (ex[3] << 16); e0.z = ex[4] | (ex[5] << 16); e0.w = ex[6] | (ex[7] << 16);
        e1.x = ex[8] | (ex[9] << 16); e1.y = ex[10] | (ex[11] << 16); e1.z = ex[12] | (ex[13] << 16); e1.w = ex[14] | (ex[15] << 16);
        *(u32x4*)(E16 + o) = e0; *(u32x4*)(E16 + o + 8) = e1;
#pragma unroll
        for (int q = 0; q < 4; ++q) *(f32x4*)(GT + o + 4 * q) = (f32x4){sc[4 * q] * inv, sc[4 * q + 1] * inv, sc[4 * q + 2] * inv, sc[4 * q + 3] * inv};
    }
    if (m1 >= 0) tab_finish(T, R, m1, lane);
    __syncthreads();
}

__device__ __forceinline__ void udot_compute(const u32x4 (&d)[16], const u32x4 h0, const u32x4 h1, float* dst, int k, bool ok) {
    f32x2 hq[8];
    hq[0] = (f32x2){bflo(h0.x), bfhi(h0.x)}; hq[1] = (f32x2){bflo(h0.y), bfhi(h0.y)}; hq[2] = (f32x2){bflo(h0.z), bfhi(h0.z)}; hq[3] = (f32x2){bflo(h0.w), bfhi(h0.w)};
    hq[4] = (f32x2){bflo(h1.x), bfhi(h1.x)}; hq[5] = (f32x2){bflo(h1.y), bfhi(h1.y)}; hq[6] = (f32x2){bflo(h1.z), bfhi(h1.z)}; hq[7] = (f32x2){bflo(h1.w), bfhi(h1.w)};
    float keep0 = 0.f, keep1 = 0.f;
#pragma unroll
    for (int i = 0; i < 16; ++i) {
        f32x2 a0 = {0.f, 0.f}, a1 = {0.f, 0.f};
        fp8dot4(d[i].x, hq[0], hq[1], a0, a1); fp8dot4(d[i].y, hq[2], hq[3], a0, a1); fp8dot4(d[i].z, hq[4], hq[5], a0, a1); fp8dot4(d[i].w, hq[6], hq[7], a0, a1);
        const float pr = dpp_sum8((a0.x + a0.y) + (a1.x + a1.y));
        if ((i & 7) == k) { if (i < 8) keep0 = pr; else keep1 = pr; }
    }
    if (ok) { dst[0] = keep0; dst[8] = keep1; }
}
__device__ __forceinline__ void udots(const Frame& F, const bf16_t* HN, const unsigned char* UB, const unsigned short* E16, float* PART) {
    const int lane = F.lane, g = lane >> 3, k = lane & 7;
    const int ngr = (F.G % 8 == 0) ? 8 : 1, wpg = F.G / ngr, x = F.vcu / wpg, wl = (F.vcu % wpg) * NWAVES + F.wave, wst = wpg * NWAVES, spg = NSL / ngr;
    const int ntw = (NTOK - wl + wst - 1) / wst;
#define UD_T(j) ((size_t)((wl + (j) * wst) < NTOK ? (wl + (j) * wst) : (NTOK - 1)))
#define UD_IDS(j, V0, V1) { const unsigned short* ep_ = E16 + UD_T(j) * 128 + g * 16; V0 = *(const u32x4*)ep_; V1 = *(const u32x4*)(ep_ + 8); }
#define UD_HN(j, H0, H1) { const bf16_t* hp_ = HN + UD_T(j) * DM + s * SLW + k * 16; H0 = *(const u32x4*)hp_; H1 = *(const u32x4*)(hp_ + 8); }
#define UD_ROWS(D, V0, V1) { _Pragma("unroll") for (int i = 0; i < 16; ++i) D[i] = *(const u32x4*)(ub + (size_t)PEER_EID(V0, V1, i) * DM); }
    for (int rr = 0; rr < spg; ++rr) {
        const int s = x + ngr * rr;
        const unsigned char* ub = UB + s * SLW + k * 16;
        float* pb = PART + (size_t)s * NTOK * 128 + g * 16 + k;
        u32x4 dA[16], dB[16], idA0, idA1, idB0, idB1, hA0, hA1, hB0, hB1;
        UD_IDS(0, idA0, idA1) UD_HN(0, hA0, hA1) UD_ROWS(dA, idA0, idA1)
        UD_IDS(1, idB0, idB1) UD_HN(1, hB0, hB1)
        for (int j = 0; j < ntw; j += 2) {
            UD_ROWS(dB, idB0, idB1)
            UD_IDS(j + 2, idA0, idA1)
            udot_compute(dA, hA0, hA1, pb + UD_T(j) * 128, k, true);
            UD_HN(j + 2, hA0, hA1)
            UD_ROWS(dA, idA0, idA1)
            UD_IDS(j + 3, idB0, idB1)
            udot_compute(dB, hB0, hB1, pb + UD_T(j + 1) * 128, k, j + 1 < ntw);
            UD_HN(j + 3, hB0, hB1)
        }
    }
#undef UD_IDS
#undef UD_HN
#undef UD_ROWS
}
__device__ __forceinline__ void combine(const Frame& F, const float* PART, const unsigned short* E16, const float* GT, const float* RSU, const float* RSV, float* AT) {
    const size_t n4 = (size_t)NTOK * 128 / 4, stride = (size_t)F.G * NWAVES * 64;
    for (size_t i = (size_t)F.vcu * NWAVES * 64 + F.tid; i < n4; i += stride) {
        f32x4 pv[NSL];
#pragma unroll
        for (int s = 0; s < NSL; ++s) pv[s] = *(const f32x4*)(PART + (size_t)s * n4 * 4 + i * 4);
        const u32x2 ee = *(const u32x2*)(E16 + i * 4); const f32x4 gg = *(const f32x4*)(GT + i * 4);
        const unsigned e0 = ee.x & 0xffffu, e1 = ee.x >> 16, e2 = ee.y & 0xffffu, e3 = ee.y >> 16;
        const float su0 = RSU[e0], su1 = RSU[e1], su2 = RSU[e2], su3 = RSU[e3], sv0 = RSV[e0], sv1 = RSV[e1], sv2 = RSV[e2], sv3 = RSV[e3];
        f32x4 sacc = pv[0];
#pragma unroll
        for (int s = 1; s < NSL; ++s) sacc += pv[s];
        f32x4 o; o.x = gg.x * gelu_erf(sacc.x * su0) * sv0; o.y = gg.y * gelu_erf(sacc.y * su1) * sv1; o.z = gg.z * gelu_erf(sacc.z * su2) * sv2; o.w = gg.w * gelu_erf(sacc.w * su3) * sv3;
        *(f32x4*)(AT + i * 4) = o;
    }
}
__device__ __forceinline__ void vacc_compute(const u32x4 (&d)[16], const f32x4 a0, const f32x4 a1, const f32x4 a2, const f32x4 a3, float* orow, int g, bool ok) {
    f32x2 acc[8];
#pragma unroll
    for (int c = 0; c < 8; ++c) acc[c] = (f32x2){0.f, 0.f};
    const float av[16] = {a0.x, a0.y, a0.z, a0.w, a1.x, a1.y, a1.z, a1.w, a2.x, a2.y, a2.z, a2.w, a3.x, a3.y, a3.z, a3.w};
#pragma unroll
    for (int i = 0; i < 16; ++i) { const f32x2 aa = {av[i], av[i]};
        fp8axpy4(d[i].x, aa, acc[0], acc[1]); fp8axpy4(d[i].y, aa, acc[2], acc[3]); fp8axpy4(d[i].z, aa, acc[4], acc[5]); fp8axpy4(d[i].w, aa, acc[6], acc[7]); }
    float v[16];
#pragma unroll
    for (int c = 0; c < 8; ++c) { v[2 * c] = acc[c].x; v[2 * c + 1] = acc[c].y; }
    float R[8], S4[4];
#pragma unroll
    for (int c = 0; c < 8; ++c) { auto r = __builtin_amdgcn_permlane32_swap(__float_as_uint(v[c]), __float_as_uint(v[c + 8]), false, false); R[c] = __uint_as_float(r[0]) + __uint_as_float(r[1]); }
#pragma unroll
    for (int c = 0; c < 4; ++c) { auto r = __builtin_amdgcn_permlane16_swap(__float_as_uint(R[c]), __float_as_uint(R[c + 4]), false, false); S4[c] = __uint_as_float(r[0]) + __uint_as_float(r[1]); }
    const bool b8 = (g & 1) != 0;
    float T0, T1;
    { const float keep = b8 ? S4[2] : S4[0], send = b8 ? S4[0] : S4[2]; T0 = keep + __int_as_float(__builtin_amdgcn_update_dpp(0, __float_as_int(send), 0x128, 0xF, 0xF, true)); }
    { const float keep = b8 ? S4[3] : S4[1], send = b8 ? S4[1] : S4[3]; T1 = keep + __int_as_float(__builtin_amdgcn_update_dpp(0, __float_as_int(send), 0x128, 0xF, 0xF, true)); }
    if (ok) { f32x2 o2 = *(const f32x2*)orow; o2.x += T0; o2.y += T1; *(f32x2*)orow = o2; }
}
__device__ __forceinline__ void vacc(const Frame& F, const unsigned char* VB, const unsigned short* E16, const float* AT, float* out) {
    const int lane = F.lane, g = lane >> 3, k = lane & 7;
    const int ngr = (F.G % 8 == 0) ? 8 : 1, wpg = F.G / ngr, x = F.vcu / wpg, wl = (F.vcu % wpg) * NWAVES + F.wave, wst = wpg * NWAVES, spg = NSL / ngr;
    const int ntw = (NTOK - wl + wst - 1) / wst;
#define UD_IDS(j, V0, V1) { const unsigned short* ep_ = E16 + UD_T(j) * 128 + g * 16; V0 = *(const u32x4*)ep_; V1 = *(const u32x4*)(ep_ + 8); }
#define VA_A(j, A0, A1, A2, A3) { const float* ap_ = AT + UD_T(j) * 128 + g * 16; A0 = *(const f32x4*)ap_; A1 = *(const f32x4*)(ap_ + 4); A2 = *(const f32x4*)(ap_ + 8); A3 = *(const f32x4*)(ap_ + 12); }
#define UD_ROWS(D, V0, V1) { _Pragma("unroll") for (int i = 0; i < 16; ++i) D[i] = *(const u32x4*)(vb + (size_t)PEER_EID(V0, V1, i) * DM); }
    for (int rr = 0; rr < spg; ++rr) {
        const int s = x + ngr * rr;
        const unsigned char* vb = VB + s * SLW + k * 16;
        float* ob = out + s * SLW + k * 16 + 2 * g;
        u32x4 dA[16], dB[16], idA0, idA1, idB0, idB1; f32x4 aA0, aA1, aA2, aA3, aB0, aB1, aB2, aB3;
        UD_IDS(0, idA0, idA1) VA_A(0, aA0, aA1, aA2, aA3) UD_ROWS(dA, idA0, idA1)
        UD_IDS(1, idB0, idB1) VA_A(1, aB0, aB1, aB2, aB3)
        for (int j = 0; j < ntw; j += 2) {
            UD_ROWS(dB, idB0, idB1)
            UD_IDS(j + 2, idA0, idA1)
            vacc_compute(dA, aA0, aA1, aA2, aA3, ob + UD_T(j) * DM, g, true);
            VA_A(j + 2, aA0, aA1, aA2, aA3)
            UD_ROWS(dA, idA0, idA1)
            UD_IDS(j + 3, idB0, idB1)
            vacc_compute(dB, aB0, aB1, aB2, aB3, ob + UD_T(j + 1) * DM, g, j + 1 < ntw);
            VA_A(j + 3, aB0, aB1, aB2, aB3)
        }
    }
#undef UD_T
#undef UD_IDS
#undef VA_A
#undef UD_ROWS
}
}

__device__ __forceinline__ void pool_unit(const Frame& F, bf16_t* MIX, const bf16_t* PWt, const float* pool_s, int tm, int g) {
    const int lane = F.lane, r = lane & 31, hi = lane >> 5;
    bf16_t* base = MIX + (size_t)(tm * 256 + F.wave * 32) * DM + 1024 + 128 * g;
    bf16x8 A[8];
#pragma unroll
    for (int ks = 0; ks < 8; ++ks) A[ks] = *(const bf16x8*)(base + (size_t)r * DM + ks * 16 + 8 * hi);
#pragma unroll
    for (int ct = 0; ct < 4; ++ct) {
        f32x16 acc = f32x16{};
        const bf16_t* pb = PWt + (size_t)(g * 128 + ct * 32 + r) * 128 + 8 * hi;
#pragma unroll
        for (int ks = 0; ks < 8; ++ks) { const bf16x8 B = *(const bf16x8*)(pb + ks * 16); acc = __builtin_amdgcn_mfma_f32_32x32x16_bf16(A[ks], B, acc, 0, 0, 0); }
        const float sc = pool_s[128 * g + ct * 32 + r];
#pragma unroll
        for (int i = 0; i < 16; ++i) { const int row = (i & 3) + 8 * (i >> 2) + 4 * hi; base[(size_t)row * DM + ct * 32 + r] = (bf16_t)(cvtpk(acc[i] * sc, 0.f) & 0xffffu); }
    }
}

__global__ void __launch_bounds__(NWAVES * 64, 2) fwd_kernel(Args args) {
    extern __shared__ __attribute__((aligned(16))) unsigned char lds[];
    Frame F;
    F.lds = (LAS unsigned char*)lds; F.ldsg = (char*)lds;
    F.tid = threadIdx.x; F.lane = F.tid & 63; F.wave = __builtin_amdgcn_readfirstlane(F.tid >> 6);
    F.G = gridDim.x; { const int bx = blockIdx.x; F.vcu = (F.G % 8 == 0) ? (bx % 8) * (F.G / 8) + bx / 8 : bx; }
    unsigned char* ws = args.ws;
    unsigned* ctl = (unsigned*)(ws + WS_CTL);
    volatile LAS unsigned* MISC = (volatile LAS unsigned*)(F.lds + MISC_OFF);
    for (int u = F.tid; u < (LDS_BYTES - LDSCTL_OFF) / 4; u += NWAVES * 64) ((LAS unsigned*)(F.lds + LDSCTL_OFF))[u] = 0u;
    __syncthreads();
    const int lo = args.ph_lo, hi = args.ph_hi;
    XcdBarrier bar; bar.bar = ctl + CW_BAR; bar.x = 0; bar.st = nullptr;
    if (hi - lo > 1) bar = xcd_barrier_post(ctl + CW_BAR, MISC + 8);
#define IN(k) (lo <= (k) && (k) < hi)
#define PHASE_BEGIN() do { int t_ = (int)threadIdx.x; asm volatile("" : "+v"(t_)); F.tid = t_; F.lane = t_ & 63; } while (0)
#define SEAM(k) do { if (IN(k) && IN((k) + 1)) xcd_barrier(bar); } while (0)

    bf16_t* Z = (bf16_t*)(ws + WS_Z); bf16_t* XN = (bf16_t*)(ws + WS_XN); bf16_t* MIX = XN;
    bf16_t* HN = (bf16_t*)(ws + WS_Z); bf16_t* PQ = (bf16_t*)(ws + WS_Z + 128 * MiB);
    bf16_t* KVM = (bf16_t*)(ws + WS_KVM); unsigned* MASK = (unsigned*)(ws + WS_MASK);

    if (IN(0)) { PHASE_BEGIN(); p0_prologue(F, args); } SEAM(0);
    if (IN(1)) { PHASE_BEGIN();
#if P1_FP8
        const int gw = F.vcu * NWAVES + F.wave, NGW = F.G * NWAVES;
        for (int i = gw; i < 4096; i += NGW) { const int n = i < 3072 ? i : i + 1024; RowF32 R; row_load_bf16(R, (const bf16_t*)(ws + WS_BT_IN) + (size_t)n * DM, F.lane); row_to_fp8(R, ws + WS_BTIN8 + (size_t)n * DM, (float*)(ws + WS_CSI) + n, F.lane); }
#endif
    } SEAM(1);
    if (IN(2)) { PHASE_BEGIN();
#if P1_FP8
        { pg8::Gemm g{XN, (const bf16_t*)(ws + WS_BT_IN), NTOK, ZLD, DM}; pg8::InBf16Order S; S.init(NTOK, F.G, (int)blockIdx.x);
          pg8::EpiBf16 E{Z, ZLD}; pg8::gemm_phase<pg8::EpiBf16, pg8::InBf16Order, true, true>(F.lds, g, S, E); }
        { pg8::Gemm g{(const bf16_t*)(ws + WS_XN8), (const bf16_t*)(ws + WS_BTIN8), NTOK, ZLD, DM / 2}; pg8::InFp8Order S; S.init(NTOK, F.G, (int)blockIdx.x);
          pg8::EpiBf16S E{Z, ZLD, (const float*)(ws + WS_CSI)}; pg8::gemm_phase<pg8::EpiBf16S, pg8::InFp8Order, true, true, true>(F.lds, g, S, E); }
#else
        { pg8::Gemm g{XN, (const bf16_t*)(ws + WS_BT_IN), NTOK, ZLD, DM}; pg8::StaticOrder S; S.init(NTOK, ZLD, F.G, (int)blockIdx.x);
          pg8::EpiBf16 E{Z, ZLD}; pg8::gemm_phase<pg8::EpiBf16, pg8::StaticOrder, true, true>(F.lds, g, S, E); }
#endif
        { pg8::Gemm g{(const bf16_t*)(ws + WS_MN), (const bf16_t*)(ws + WS_BT_KV), BATCH * MEMLEN, 1024, DM}; pg8::StaticOrder S; S.init(BATCH * MEMLEN, 1024, F.G, (int)((blockIdx.x + 128) % F.G));
          pg8::EpiBf16 E{KVM, 1024}; pg8::gemm_phase<pg8::EpiBf16, pg8::StaticOrder, true, true>(F.lds, g, S, E); }
    } SEAM(2);
    if (IN(3)) { PHASE_BEGIN(); p2_post(F, args); } SEAM(3);
    if (IN(4)) { PHASE_BEGIN();
        for (int i = 0; ; ++i) {
            int b, c;
            if (F.G == 256) { if (i >= 2) break; b = F.vcu >> 7; c = (i == 0) ? 255 - (F.vcu & 127) : (F.vcu & 127); }
            else { const int u = (int)blockIdx.x + i * F.G; if (u >= 512) break; b = u >> 8; c = u & 255; }
            ix::unit(F, Z, MASK, (unsigned long long*)(ws + WS_CAND) + (size_t)blockIdx.x * 64 * ix::CAPB, ctl + 2048, b, c);
            __syncthreads();
        }
    } SEAM(4);
    if (IN(5)) { PHASE_BEGIN();
        for (int u = F.vcu; u < (NTOK / 256) * 4; u += F.G) pool_unit(F, MIX, (const bf16_t*)(ws + WS_PWT), args.pool_s, u >> 2, u & 3);
        const int r32 = F.lane & 31;
        for (int i = 0; ; ++i) {
            int b, h, qb;
            if (F.G == 256) { if (i >= 4) break; const int bh = F.vcu >> 4, s = F.vcu & 15; b = bh >> 3; h = bh & 7; qb = (i == 0) ? 63 - s : (i == 1) ? 32 + s : (i == 2) ? 31 - s : s; }
            else { const int u = (int)blockIdx.x + i * F.G; if (u >= 1024) break; b = u >> 9; h = (u >> 6) & 7; qb = u & 63; }
            const size_t row0 = (size_t)b * SEQ + 256 * qb;
            const unsigned long long* mrow = (const unsigned long long*)MASK + (row0 + F.wave * 32 + r32) * (MASK_WPR / 2);
#if QK_FP8
            att::attn_body<true, 2, ZLD, ZLD, DM, true>(Z + row0 * ZLD + ZC_Q + h * 128, Z + (size_t)b * SEQ * ZLD + ZC_K + h * 128, Z + (size_t)b * SEQ * ZLD + ZC_V + h * 128,
                                                        MIX + row0 * DM + h * 128, 256 * (qb + 1), mrow, F.ldsg, ws + WS_Q8 + row0 * 1024 + h * 128, ws + WS_K8 + (size_t)b * SEQ * 1024 + h * 128);
#else
            att::attn_body<true, 2, ZLD, ZLD, DM>(Z + row0 * ZLD + ZC_Q + h * 128, Z + (size_t)b * SEQ * ZLD + ZC_K + h * 128, Z + (size_t)b * SEQ * ZLD + ZC_V + h * 128,
                                                  MIX + row0 * DM + h * 128, 256 * (qb + 1), mrow, F.ldsg);
#endif
        }
        for (int id = F.vcu; id < 512; id += F.G) {
            const int b2 = id >> 8, hm = (id >> 6) & 3, qb = id & 63; const size_t row0 = (size_t)b2 * SEQ + 256 * qb;
            att::attn_body<false, 1, ZLD, 1024, DM>(Z + row0 * ZLD + ZC_QM + hm * 128, KVM + (size_t)b2 * MEMLEN * 1024 + hm * 128, KVM + (size_t)b2 * MEMLEN * 1024 + 512 + hm * 128,
                                                    MIX + row0 * DM + 1536 + hm * 128, MEMLEN, nullptr, F.ldsg);
        }
    } SEAM(5);
    if (IN(6)) { PHASE_BEGIN();
#if ATT_VERIFY
        {
            const int t = (int)blockIdx.x * 128 + 77, hh = F.wave, ln = F.lane; const int bb = t / SEQ, pos = t % SEQ, N = 64 * (pos / 64 + 1);
            const bf16_t* zq = Z + (size_t)t * ZLD + ZC_Q + hh * 128 + 2 * ln; const float q0 = bflo((unsigned)zq[0]), q1 = bflo((unsigned)zq[1]);
            float m = -3.0e38f, l = 0.f, o0 = 0.f, o1 = 0.f; int nsel = 0;
            for (int w = 0; w < N / 32; ++w) { unsigned bits = __hip_atomic_load(MASK + (size_t)t * MASK_WPR + w, __ATOMIC_RELAXED, __HIP_MEMORY_SCOPE_AGENT);
                while (bits) { const int bpos = __builtin_ctz(bits); bits &= bits - 1u; const int sidx = 32 * w + bpos; ++nsel;
                    const bf16_t* zk = Z + ((size_t)bb * SEQ + sidx) * ZLD + ZC_K + hh * 128 + 2 * ln; const bf16_t* zv = Z + ((size_t)bb * SEQ + sidx) * ZLD + ZC_V + hh * 128 + 2 * ln;
                    const float lg = wave_sum(q0 * bflo((unsigned)zk[0]) + q1 * bflo((unsigned)zk[1])) * 0.088388347648318440f;
                    const float mn = fmaxf(m, lg), al = __expf(m - mn), pe = __expf(lg - mn); l = l * al + pe; o0 = o0 * al + pe * bflo((unsigned)zv[0]); o1 = o1 * al + pe * bflo((unsigned)zv[1]); m = mn; } }
            const bf16_t* mx = MIX + (size_t)t * DM + hh * 128 + 2 * ln; const float r0 = o0 / l, r1 = o1 / l;
            float er = fmaxf(fabsf(r0 - bflo((unsigned)mx[0])), fabsf(r1 - bflo((unsigned)mx[1]))), sc = fmaxf(fabsf(r0), fabsf(r1));
#pragma unroll
            for (int o = 1; o < 64; o <<= 1) { er = fmaxf(er, __shfl_xor(er, o)); sc = fmaxf(sc, __shfl_xor(sc, o)); }
            if (!(er <= (QK_FP8 ? 0.12f : 0.03f) * sc + (QK_FP8 ? 4e-3f : 1e-3f)) || nsel != (N < 256 ? N : 256)) { if (ln == 0) atomicOr(ctl + 2048, 2u); }
        }
        __syncthreads();
#endif
        pg8::Gemm g{MIX, (const bf16_t*)(ws + WS_BT_OUT), NTOK, DM, DM}; pg8::StaticOrder S; S.init(NTOK, DM, F.G, (int)blockIdx.x);
        pg8::EpiF32Res E{args.x, args.out, DM}; pg8::gemm_phase<pg8::EpiF32Res, pg8::StaticOrder, true, true>(F.lds, g, S, E);
    } SEAM(6);
    if (IN(7)) { PHASE_BEGIN(); const int gw = F.vcu * NWAVES + F.wave, NGW = F.G * NWAVES;
#if P7_FP8
        for (int n = gw; n < DM; n += NGW) { RowF32 R; row_load_bf16(R, (const bf16_t*)(ws + WS_BT_Q) + (size_t)n * DM, F.lane); row_to_fp8(R, ws + WS_BTQ8 + (size_t)n * DM, (float*)(ws + WS_CSQ) + n, F.lane); }
        for (int m = gw; m < NTOK; m += NGW) rms_row_to_bf16_fp8(args.out + (size_t)m * DM, args.ffn_g, HN + (size_t)m * DM, ws + WS_HN8 + (size_t)m * DM, F.lane);
#else
        for (int m = gw; m < NTOK; m += NGW) rms_row_to_bf16(args.out + (size_t)m * DM, args.ffn_g, HN + (size_t)m * DM, F.lane);
#endif
    } SEAM(7);
    if (IN(8)) { PHASE_BEGIN();
#if P7_FP8
        pg8::Gemm g{(const bf16_t*)(ws + WS_HN8), (const bf16_t*)(ws + WS_BTQ8), NTOK, DM, DM / 2}; pg8::StaticOrder S; S.init(NTOK, DM, F.G, (int)blockIdx.x);
        pg8::EpiBf16S E{PQ, DM, (const float*)(ws + WS_CSQ)}; pg8::gemm_phase<pg8::EpiBf16S, pg8::StaticOrder, true, true, true>(F.lds, g, S, E);
#else
        pg8::Gemm g{HN, (const bf16_t*)(ws + WS_BT_Q), NTOK, DM, DM}; pg8::StaticOrder S; S.init(NTOK, DM, F.G, (int)blockIdx.x);
        pg8::EpiBf16 E{PQ, DM}; pg8::gemm_phase<pg8::EpiBf16, pg8::StaticOrder, true, true>(F.lds, g, S, E);
#endif
    } SEAM(8);
    unsigned short* E16 = (unsigned short*)(ws + WS_XN); float* GT = (float*)(ws + WS_XN + 8 * MiB); float* AT = (float*)(ws + WS_XN + 24 * MiB);
    float* PART = (float*)(ws + WS_Z + 128 * MiB);
    if (IN(9)) { PHASE_BEGIN();
        const bf16_t* PKb = (const bf16_t*)(ws + WS_PK);
        bf16x8 Bf[2][8];
        { const int half = F.wave & 1, cp = (F.wave >> 1) & 1, r = F.lane & 31, hi = F.lane >> 5;
#pragma unroll
          for (int c2 = 0; c2 < 2; ++c2)
#pragma unroll
              for (int ks = 0; ks < 8; ++ks) Bf[c2][ks] = *(const bf16x8*)(PKb + (size_t)(half * 128 + (2 * cp + c2) * 32 + r) * 128 + 8 * hi + ks * 16); }
        const peer::TabCvt T{args.pu, args.pv, ws + WS_UB, ws + WS_VB, (float*)(ws + WS_RSU), (float*)(ws + WS_RSV)};
        const int gw = F.vcu * NWAVES + F.wave, NGW = F.G * NWAVES; int mrow = gw, nstep = 0;
        for (int it = F.vcu; it < NTOK / peer::TT; it += F.G, ++nstep) {
            const int m0 = mrow < 2 * NEXP ? mrow : -1; mrow += NGW; const int m1 = mrow < 2 * NEXP ? mrow : -1; mrow += NGW;
            peer::route_step(F, PQ, Bf, E16, GT, it * peer::TT, T, m0, m1);
        }
        for (; mrow < 2 * NEXP; mrow += NGW) { RowF32 R; row_load(R, peer::tab_src(T, mrow), F.lane); peer::tab_finish(T, R, mrow, F.lane); }
    } SEAM(9);
    if (IN(10)) { PHASE_BEGIN(); peer::udots(F, HN, ws + WS_UB, E16, PART); } SEAM(10);
    if (IN(11)) { PHASE_BEGIN(); peer::combine(F, PART, E16, GT, (const float*)(ws + WS_RSU), (const float*)(ws + WS_RSV), AT); } SEAM(11);
    if (IN(12)) { PHASE_BEGIN(); peer::vacc(F, ws + WS_VB, E16, AT, args.out); }
#if IX_VERIFY || ATT_VERIFY
    if (IN(12)) { __syncthreads(); if (__hip_atomic_load(ctl + 2048, __ATOMIC_RELAXED, __HIP_MEMORY_SCOPE_AGENT) != 0u) { args.out[(size_t)blockIdx.x * 512 + threadIdx.x] = __builtin_nanf(""); } }
#endif
#undef IN
#undef SEAM
}

extern "C" void kernel_launch(void* const* d_in, const int* in_sizes, int n_in, void* d_out, int out_size, void* d_ws, size_t ws_size, hipStream_t stream) {
    static int grid = 0;
    if (grid == 0) {
        if (n_in != 19 || out_size != NTOK * DM || ws_size < WS_END) { fprintf(stderr, "kernel_launch: unexpected shapes (n_in %d out %d ws %zu)\n", n_in, out_size, ws_size); grid = -1; return; }
        int dev = 0, cus = 0;
        if (hipGetDevice(&dev) != hipSuccess || hipDeviceGetAttribute(&cus, hipDeviceAttributeMultiprocessorCount, dev) != hipSuccess) { grid = -1; return; }
        if (hipFuncSetAttribute((const void*)fwd_kernel, hipFuncAttributeMaxDynamicSharedMemorySize, LDS_BYTES) != hipSuccess) { fprintf(stderr, "kernel_launch: hipFuncSetAttribute failed\n"); grid = -1; return; }
        int per_cu = 0;
        if (hipOccupancyMaxActiveBlocksPerMultiprocessor(&per_cu, (const void*)fwd_kernel, NWAVES * 64, LDS_BYTES) != hipSuccess || per_cu < 1) { fprintf(stderr, "kernel_launch: occupancy query reports %d workgroups per CU for %d threads / %d B LDS; nothing launched\n", per_cu, NWAVES * 64, LDS_BYTES); grid = -1; return; }
        (void)hipGetLastError();
        grid = cus;
    }
    if (grid < 0) return;
    (void)hipMemsetAsync((char*)d_ws + WS_CTL, 0, CTL_ZERO_BYTES, stream);
    Args a{};
    a.x = (const float*)d_in[0]; a.mem = (const float*)d_in[1]; a.attn_g = (const float*)d_in[2]; a.w_in = (const float*)d_in[3]; a.q_g = (const float*)d_in[4]; a.k_g = (const float*)d_in[5];
    a.pool_w = (const float*)d_in[6]; a.pool_s = (const float*)d_in[7]; a.mem_g = (const float*)d_in[8]; a.w_kv = (const float*)d_in[9]; a.mq_g = (const float*)d_in[10]; a.mk_g = (const float*)d_in[11];
    a.w_out = (const float*)d_in[12]; a.ffn_g = (const float*)d_in[13]; a.w_q = (const float*)d_in[14]; a.sk1 = (const float*)d_in[15]; a.sk2 = (const float*)d_in[16];
    a.pu = (const float*)d_in[17]; a.pv = (const float*)d_in[18]; a.out = (float*)d_out; a.ws = (unsigned char*)d_ws;
#if MK_ONE_LAUNCH
    a.ph_lo = 0; a.ph_hi = N_PHASES;
    hipLaunchKernelGGL(fwd_kernel, dim3(grid), dim3(NWAVES * 64), LDS_BYTES, stream, a);
#else
    for (int p = 0; p < N_PHASES; ++p) { a.ph_lo = p; a.ph_hi = p + 1; hipLaunchKernelGGL(fwd_kernel, dim3(grid), dim3(NWAVES * 64), LDS_BYTES, stream, a); }
#endif
}
```

```cpp
#include <hip/hip_runtime.h>
#include <hip/hip_bf16.h>
#include <cstdio>
#include <cstdint>

#ifndef IX_VERIFY
#define IX_VERIFY 0
#endif
#ifndef ATT_VERIFY
#define ATT_VERIFY 0
#endif
#ifndef MK_ONE_LAUNCH
#define MK_ONE_LAUNCH 1
#endif
#ifndef P1_FP8
#define P1_FP8 1
#endif
#ifndef QK_FP8
#define QK_FP8 1
#endif
#ifndef PV_FP8
#define PV_FP8 1
#endif
#ifndef P7_FP8
#define P7_FP8 0
#endif

#define GAS __attribute__((address_space(1)))
#define LAS __attribute__((address_space(3)))
typedef unsigned short bf16_t;
typedef short bf16x8 __attribute__((ext_vector_type(8)));
typedef short s16x4 __attribute__((ext_vector_type(4)));
typedef float f32x4 __attribute__((ext_vector_type(4)));
typedef float f32x2 __attribute__((ext_vector_type(2)));
typedef float f32x16 __attribute__((ext_vector_type(16)));
typedef unsigned u32x4 __attribute__((ext_vector_type(4)));
typedef unsigned u32x2 __attribute__((ext_vector_type(2)));
typedef __bf16 bf16x2_t __attribute__((ext_vector_type(2)));
typedef int i32x8 __attribute__((ext_vector_type(8)));
typedef int i32x4 __attribute__((ext_vector_type(4)));

constexpr int BATCH = 2, SEQ = 16384, DM = 2048, NTOK = BATCH * SEQ, MEMLEN = 256;
constexpr int IN_W = 5200, ZLD = 5376;
constexpr int ZC_Q = 0, ZC_K = 1024, ZC_V = 2048, ZC_QI = 3072, ZC_PU = 4096, ZC_QM = 4608, ZC_KI = 5120, ZC_WI = 5184;
constexpr int NEXP = 16384;
constexpr float EPS = 1e-6f;
constexpr int MASK_WPR = 512;

constexpr size_t MiB = 1u << 20;
constexpr size_t WS_CTL = 0, CTL_ZERO_BYTES = 1 * MiB;
constexpr size_t WS_BT_IN = 2 * MiB;
constexpr size_t WS_BT_OUT = 24 * MiB;
constexpr size_t WS_BT_Q = 32 * MiB;
constexpr size_t WS_BT_KV = 40 * MiB;
constexpr size_t WS_MN = 44 * MiB;
constexpr size_t WS_KVM = 46 * MiB;
constexpr size_t WS_PK = 47 * MiB;
constexpr size_t WS_PWT = 47 * MiB + 512 * 1024;
constexpr size_t WS_XN = 48 * MiB;
constexpr size_t WS_Z = 176 * MiB;
constexpr size_t WS_MASK = 512 * MiB;
constexpr size_t WS_UB = 576 * MiB;
constexpr size_t WS_VB = 640 * MiB;
constexpr size_t WS_RSU = 47 * MiB + 128 * 1024, WS_RSV = 47 * MiB + 256 * 1024;
constexpr size_t WS_ROPE = 704 * MiB;
constexpr size_t WS_CAND = 720 * MiB;
constexpr size_t WS_Q8 = WS_UB, WS_K8 = WS_UB + 32 * MiB;
constexpr size_t WS_V8T = WS_VB;
constexpr size_t WS_XN8 = WS_CAND, WS_BTIN8 = WS_CAND + 72 * MiB, WS_CSI = WS_CAND + 84 * MiB;
constexpr size_t WS_HN8 = WS_CAND, WS_BTQ8 = WS_CAND + 64 * MiB, WS_CSQ = WS_CAND + 68 * MiB;
constexpr size_t WS_END = 848 * MiB;
constexpr int CW_BAR = 4096;

#define LDS_WAIT() asm volatile("s_waitcnt lgkmcnt(0)" ::: "memory")
#define VM_WAIT() asm volatile("s_waitcnt vmcnt(0)" ::: "memory")
__device__ __forceinline__ unsigned cvtpk(float lo, float hi) { f32x2 v = {lo, hi}; bf16x2_t b = __builtin_convertvector(v, bf16x2_t); return __builtin_bit_cast(unsigned, b); }
__device__ __forceinline__ float bflo(unsigned w) { return __uint_as_float(w << 16); }
__device__ __forceinline__ float bfhi(unsigned w) { return __uint_as_float(w & 0xffff0000u); }
__device__ __forceinline__ float wave_sum(float v) {
#pragma unroll
    for (int o = 1; o < 64; o <<= 1) v += __shfl_xor(v, o);
    return v;
}
__device__ __forceinline__ unsigned f2ord(float s) { unsigned u = __float_as_uint(s); return u ^ (((unsigned)((int)u >> 31)) | 0x80000000u); }

namespace pg8 {
#define PG8_LAS __attribute__((address_space(3)))
constexpr int BM = 256, BK = 64, HALF = 128, HTB = HALF * BK * 2, STAGE_BYTES = 8 * HTB, NXCD = 8, WGM = 8;
__host__ __device__ __forceinline__ int lds_byte(int r, int c) { const int st = (r >> 4) * 2 + (c >> 5), rr = r & 15, cc = c & 31, ob = rr * 64 + cc * 2; return st * 1024 + (ob ^ (((ob >> 9) & 1) << 5)); }
__host__ __device__ __forceinline__ void stage_rc(int b, int& R, int& C) { const int st = b / 1024, sb = b % 1024, swz = sb ^ (((sb >> 9) & 1) << 5); R = (st >> 1) * 16 + swz / 64; C = (st & 1) * 32 + (swz % 64) / 2; }
__host__ __device__ __forceinline__ int perm32(int rho) { const int n = rho >> 4, i = rho & 15; return 8 * (i >> 2) + 4 * n + (i & 3); }
struct Unit { int pm, pn; };
struct Gemm { const bf16_t* A; const bf16_t* Bt; int M, N, K; };
struct StaticOrder {
    int nM, nN, nwg, G, c;
    __host__ __device__ void init(int M, int N, int G_, int c_) { nM = M / BM; nN = N / BM; nwg = nM * nN; G = G_; c = c_; }
    __host__ __device__ bool next(int i, Unit& u) const {
        const long L = (long)i * G + c; if (L >= nwg) return false;
        int wgid = (int)L; { const int q = nwg / NXCD, r = nwg % NXCD, xcd = wgid % NXCD, off = wgid / NXCD; wgid = (xcd < r ? xcd * (q + 1) : r * (q + 1) + (xcd - r) * q) + off; }
        const int nig = WGM * nN, gid = wgid / nig, fm = gid * WGM, gsz = (nM - fm) < WGM ? (nM - fm) : WGM;
        u.pm = fm + ((wgid % nig) % gsz); u.pn = (wgid % nig) / gsz; return true;
    }
    __device__ __forceinline__ void a_ready(const Unit&) const {}
    __device__ __forceinline__ void done(const Unit&) const {}
};
struct InBf16Order {
    StaticOrder S;
    __host__ __device__ void init(int M, int G_, int c_) { S.init(M, 5 * BM, G_, c_); }
    __host__ __device__ bool next(int i, Unit& u) const { if (!S.next(i, u)) return false; u.pn = u.pn < 4 ? 12 + u.pn : 20; return true; }
    __device__ __forceinline__ void a_ready(const Unit&) const {}
    __device__ __forceinline__ void done(const Unit&) const {}
};
struct InFp8Order {
    StaticOrder S; int G, c;
    __host__ __device__ void init(int M, int G_, int c_) { S.init(M, 16 * BM, 1, 0); G = G_; c = c_; }
    __host__ __device__ bool next(int i, Unit& u) const {
        long L;
        if (G == 256 && S.nwg == 2048) {
            if (i < 7) L = (long)i * 256 + c;
            else if (c < 128) return false;
            else { const int j = i - 7; int base, cnt;
                if (c < 136) { base = (c - 128) * 1; cnt = 1; } else if (c < 144) { base = 8 + (c - 136) * 3; cnt = 3; } else { base = 32 + (c - 144) * 2; cnt = 2; }
                if (j >= cnt) return false; L = 1792 + base + j; }
        } else { L = (long)i * G + c; if (L >= S.nwg) return false; }
        if (!S.next((int)L, u)) return false;
        u.pn = u.pn < 12 ? u.pn : u.pn + 4; return true;
    }
    __device__ __forceinline__ void a_ready(const Unit&) const {}
    __device__ __forceinline__ void done(const Unit&) const {}
};
struct EpiBf16 {
    static constexpr bool PERM = true, AFTER_DRAIN = false;
    bf16_t* O; int ldc;
    __device__ __forceinline__ void operator()(const f32x4 (&acc)[2][2][4][2], const Unit& u, int wr, int wc, int fr, int fq) const {
        const int row0 = u.pm * BM + wr * 64 + fr; const int col0 = u.pn * BM + wc * 32 + 8 * fq;
#pragma unroll
        for (int ai = 0; ai < 2; ++ai)
#pragma unroll
            for (int m = 0; m < 4; ++m) { bf16_t* rowp = O + (size_t)(row0 + ai * HALF + m * 16) * ldc + col0;
#pragma unroll
                for (int bj = 0; bj < 2; ++bj) { const f32x4 v0 = acc[ai][bj][m][0], v1 = acc[ai][bj][m][1];
                    u32x4 w; w.x = cvtpk(v0[0], v0[1]); w.y = cvtpk(v0[2], v0[3]); w.z = cvtpk(v1[0], v1[1]); w.w = cvtpk(v1[2], v1[3]);
                    *(u32x4*)(rowp + bj * HALF) = w; } }
    }
};
struct EpiBf16S {
    static constexpr bool PERM = true, AFTER_DRAIN = false;
    bf16_t* O; int ldc; const float* cs;
    __device__ __forceinline__ void operator()(const f32x4 (&acc)[2][2][4][2], const Unit& u, int wr, int wc, int fr, int fq) const {
        const int row0 = u.pm * BM + wr * 64 + fr; const int col0 = u.pn * BM + wc * 32 + 8 * fq;
        f32x4 s[2][2];
#pragma unroll
        for (int bj = 0; bj < 2; ++bj) { s[bj][0] = *(const f32x4*)(cs + col0 + bj * HALF); s[bj][1] = *(const f32x4*)(cs + col0 + bj * HALF + 4); }
#pragma unroll
        for (int ai = 0; ai < 2; ++ai)
#pragma unroll
            for (int m = 0; m < 4; ++m) { bf16_t* rowp = O + (size_t)(row0 + ai * HALF + m * 16) * ldc + col0;
#pragma unroll
                for (int bj = 0; bj < 2; ++bj) { const f32x4 v0 = acc[ai][bj][m][0] * s[bj][0], v1 = acc[ai][bj][m][1] * s[bj][1];
                    u32x4 w; w.x = cvtpk(v0[0], v0[1]); w.y = cvtpk(v0[2], v0[3]); w.z = cvtpk(v1[0], v1[1]); w.w = cvtpk(v1[2], v1[3]);
                    *(u32x4*)(rowp + bj * HALF) = w; } }
    }
};
struct EpiF32Res {
    static constexpr bool PERM = false, AFTER_DRAIN = false;
    const float* R; float* C; int ldc;
    __device__ __forceinline__ void operator()(const f32x4 (&acc)[2][2][4][2], const Unit& u, int wr, int wc, int fr, int fq) const {
        const int row0 = u.pm * BM + wr * 64 + fr, col0 = u.pn * BM + wc * 32 + 4 * fq;
#pragma unroll
        for (int ai = 0; ai < 2; ++ai)
#pragma unroll
            for (int m = 0; m < 4; ++m) { const size_t off = (size_t)(row0 + ai * HALF + m * 16) * ldc + col0;
#pragma unroll
                for (int bj = 0; bj < 2; ++bj)
#pragma unroll
                    for (int n = 0; n < 2; ++n) *(f32x4*)(C + off + bj * HALF + n * 16) = acc[ai][bj][m][n] + *(const f32x4*)(R + off + bj * HALF + n * 16); }
    }
};

__device__ __forceinline__ i32x8 cat8(bf16x8 a, bf16x8 b) { const i32x4 x = __builtin_bit_cast(i32x4, a), y = __builtin_bit_cast(i32x4, b); return __builtin_shufflevector(x, y, 0, 1, 2, 3, 4, 5, 6, 7); }
template <class Epi, class Sched, bool ALIGN_EPI = false, bool SP2 = false, bool F8 = false>
__device__ __forceinline__ void gemm_phase(PG8_LAS unsigned char* lds, const Gemm g, const Sched& S, const Epi& E) {
    const int tid = threadIdx.x, wid = __builtin_amdgcn_readfirstlane(tid >> 6), lane = tid & 63, wr = wid >> 2, wc = wid & 3, fr = lane & 15, fq = lane >> 4;
    const int K = g.K, nt = K / BK;
    unsigned voffA[2], voffB[2];
#pragma unroll
    for (int i = 0; i < 2; ++i) { int R, C; stage_rc(tid * 16 + i * 8192, R, C); const int Rb = Epi::PERM ? ((R & ~31) + perm32(R & 31)) : R;
        voffA[i] = (unsigned)(R * K + C) * 2u; voffB[i] = (unsigned)(Rb * K + C) * 2u; }
    const size_t kstep = (size_t)(BK * 2);
    const size_t hstep = (size_t)HALF * K * 2;
    const size_t tstep = 2 * hstep;
    const unsigned ldsw = (unsigned)wid * 1024u;
    const int aoff_ = lds_byte(wr * 64 + fr, fq * 8), boff_ = lds_byte(wc * 32 + fr, fq * 8);
#define PG8_SA(b, h) (((b) * 2 + (h)) * HTB)
#define PG8_SB(b, h) ((4 + (b) * 2 + (h)) * HTB)
#define PG8_STAGE(bufoff, gbase, voff) do { _Pragma("unroll") for (int _i = 0; _i < 2; ++_i) \
        __builtin_amdgcn_global_load_lds((const unsigned*)((const char*)(gbase) + (voff)[_i]), (PG8_LAS unsigned*)(lds + (bufoff) + ldsw + _i * 8192), 16, 0, 0); } while (0)
#define PG8_LD1(off) (*(const PG8_LAS bf16x8*)(lds + (off)))
#define PG8_LDA(dst, b, h) do { _Pragma("unroll") for (int m = 0; m < 4; ++m) { if constexpr (F8) dst##8[m] = cat8(PG8_LD1(PG8_SA(b, h) + aoff + m * 2048), PG8_LD1(PG8_SA(b, h) + aoff + m * 2048 + 1024)); \
        else { _Pragma("unroll") for (int k = 0; k < 2; ++k) dst[m][k] = PG8_LD1(PG8_SA(b, h) + aoff + m * 2048 + k * 1024); } } } while (0)
#define PG8_LDB(dst, b, h) do { _Pragma("unroll") for (int n = 0; n < 2; ++n) { if constexpr (F8) dst##8[n] = cat8(PG8_LD1(PG8_SB(b, h) + boff + n * 2048), PG8_LD1(PG8_SB(b, h) + boff + n * 2048 + 1024)); \
        else { _Pragma("unroll") for (int k = 0; k < 2; ++k) dst[n][k] = PG8_LD1(PG8_SB(b, h) + boff + n * 2048 + k * 1024); } } } while (0)
#define PG8_MMA(ai, bj, At, Bt) do { __builtin_amdgcn_s_setprio(1); _Pragma("unroll") for (int m = 0; m < 4; ++m) _Pragma("unroll") for (int n = 0; n < 2; ++n) { \
        if constexpr (F8) asm volatile("v_mfma_f32_16x16x128_f8f6f4 %0, %1, %2, %0" : "+v"(acc[ai][bj][m][n]) : "v"(Bt##8[n]), "v"(At##8[m])); \
        else { _Pragma("unroll") for (int k = 0; k < 2; ++k) acc[ai][bj][m][n] = __builtin_amdgcn_mfma_f32_16x16x32_bf16(Bt[n][k], At[m][k], acc[ai][bj][m][n], 0, 0, 0); } } __builtin_amdgcn_s_setprio(0); } while (0)
#define PG8_WAIT_V(n) asm volatile("s_waitcnt vmcnt(" #n ")" ::: "memory")
#define PG8_WAIT_L(n) asm volatile("s_waitcnt lgkmcnt(" #n ")" ::: "memory")
#define PG8_BAR __builtin_amdgcn_s_barrier()
#define PG8_SCHED __builtin_amdgcn_sched_barrier(0)
    Unit cur, nxt; int ui = 0;
    if (!S.next(0, cur)) return;
    f32x4 acc[2][2][4][2];
#pragma unroll
    for (int a = 0; a < 2; ++a)
#pragma unroll
        for (int b = 0; b < 2; ++b)
#pragma unroll
            for (int m = 0; m < 4; ++m)
#pragma unroll
                for (int n = 0; n < 2; ++n) acc[a][b][m][n] = (f32x4){0.f, 0.f, 0.f, 0.f};
    bf16x8 At[4][2], B0[2][2], B1[2][2]; i32x8 At8[4], B08[2], B18[2];
    const char* cA = (const char*)g.A + (size_t)cur.pm * tstep; const char* cB = (const char*)g.Bt + (size_t)cur.pn * tstep;
    S.a_ready(cur);
    if constexpr (SP2) {
        PG8_STAGE(PG8_SB(0, 0), cB, voffB); PG8_STAGE(PG8_SB(0, 1), cB + hstep, voffB); PG8_STAGE(PG8_SA(0, 0), cA, voffA); PG8_STAGE(PG8_SA(0, 1), cA + hstep, voffA);
        if (wr == 1) PG8_BAR;
        PG8_WAIT_V(2); PG8_BAR;
        PG8_STAGE(PG8_SB(1, 0), cB + kstep, voffB); PG8_STAGE(PG8_SA(1, 0), cA + kstep, voffA); PG8_STAGE(PG8_SB(1, 1), cB + hstep + kstep, voffB);
        PG8_WAIT_V(6); PG8_BAR;
    } else {
        PG8_STAGE(PG8_SB(0, 0), cB, voffB); PG8_STAGE(PG8_SA(0, 0), cA, voffA); PG8_STAGE(PG8_SB(0, 1), cB + hstep, voffB); PG8_STAGE(PG8_SA(0, 1), cA + hstep, voffA);
        if (wr == 1) PG8_BAR;
        PG8_WAIT_V(4); PG8_BAR;
        PG8_STAGE(PG8_SB(1, 0), cB + kstep, voffB); PG8_STAGE(PG8_SA(1, 0), cA + kstep, voffA); PG8_STAGE(PG8_SB(1, 1), cB + hstep + kstep, voffB);
        PG8_WAIT_V(6); PG8_BAR;
    }
    for (;;) {
        const bool has_next = S.next(ui + 1, nxt);
        const char* nA = has_next ? (const char*)g.A + (size_t)nxt.pm * tstep : cA; const char* nB = has_next ? (const char*)g.Bt + (size_t)nxt.pn * tstep : cB;
        for (int t = 0; t < nt; t += 2) {
            const bool last = (t == nt - 2);
            int aoff = aoff_, boff = boff_; if constexpr (F8) asm volatile("" : "+v"(aoff), "+v"(boff));
            const char* a1 = cA + (size_t)(t + 1) * kstep;
            const char* a2 = last ? nA : cA + (size_t)(t + 2) * kstep; const char* b2 = last ? nB : cB + (size_t)(t + 2) * kstep;
            const char* a3 = a2 + kstep; const char* b3 = b2 + kstep;
            if (last && has_next) S.a_ready(nxt);
            if constexpr (SP2) {
            PG8_LDB(B0, 0, 0); PG8_LDB(B1, 0, 1); PG8_SCHED; PG8_LDA(At, 0, 0); PG8_STAGE(PG8_SA(1, 1), a1 + hstep, voffA);
            PG8_WAIT_V(8); PG8_WAIT_L(0); PG8_BAR; PG8_MMA(0, 0, At, B0); PG8_MMA(0, 1, At, B1); PG8_BAR; PG8_SCHED;
            PG8_LDA(At, 0, 1); PG8_STAGE(PG8_SB(0, 0), b2, voffB); PG8_STAGE(PG8_SB(0, 1), b2 + hstep, voffB); PG8_STAGE(PG8_SA(0, 0), a2, voffA);
            PG8_WAIT_V(8); PG8_WAIT_L(0); PG8_BAR; PG8_MMA(1, 0, At, B0); PG8_MMA(1, 1, At, B1); PG8_BAR; PG8_SCHED;
            PG8_LDB(B0, 1, 0); PG8_LDB(B1, 1, 1); PG8_SCHED; PG8_LDA(At, 1, 0); PG8_STAGE(PG8_SA(0, 1), a2 + hstep, voffA);
            PG8_WAIT_V(8); PG8_WAIT_L(0); PG8_BAR; PG8_MMA(0, 0, At, B0); PG8_MMA(0, 1, At, B1); PG8_BAR; PG8_SCHED;
            PG8_LDA(At, 1, 1); PG8_STAGE(PG8_SB(1, 0), b3, voffB); PG8_STAGE(PG8_SB(1, 1), b3 + hstep, voffB); PG8_STAGE(PG8_SA(1, 0), a3, voffA);
            PG8_WAIT_V(8); PG8_WAIT_L(0); PG8_BAR; PG8_MMA(1, 0, At, B0); PG8_MMA(1, 1, At, B1); PG8_BAR; PG8_SCHED;
            } else {
            PG8_LDB(B0, 0, 0); PG8_SCHED; PG8_LDA(At, 0, 0); PG8_STAGE(PG8_SA(1, 1), a1 + hstep, voffA);
            PG8_WAIT_L(8); PG8_BAR; PG8_WAIT_L(0); PG8_MMA(0, 0, At, B0); PG8_BAR; PG8_SCHED;
            PG8_LDB(B1, 0, 1); PG8_STAGE(PG8_SB(0, 0), b2, voffB);
            PG8_BAR; PG8_WAIT_L(0); PG8_MMA(0, 1, At, B1); PG8_BAR;
            PG8_LDA(At, 0, 1); PG8_STAGE(PG8_SA(0, 0), a2, voffA);
            PG8_BAR; PG8_WAIT_L(0); PG8_MMA(1, 0, At, B0); PG8_BAR; PG8_SCHED;
            PG8_STAGE(PG8_SB(0, 1), b2 + hstep, voffB);
            PG8_WAIT_V(6); PG8_BAR; PG8_MMA(1, 1, At, B1); PG8_BAR;
            PG8_LDB(B0, 1, 0); PG8_SCHED; PG8_LDA(At, 1, 0); PG8_STAGE(PG8_SA(0, 1), a2 + hstep, voffA);
            PG8_WAIT_L(8); PG8_BAR; PG8_WAIT_L(0); PG8_MMA(0, 0, At, B0); PG8_BAR; PG8_SCHED;
            PG8_LDB(B1, 1, 1); PG8_STAGE(PG8_SB(1, 0), b3, voffB);
            PG8_BAR; PG8_WAIT_L(0); PG8_MMA(0, 1, At, B1); PG8_BAR;
            PG8_LDA(At, 1, 1); PG8_STAGE(PG8_SA(1, 0), a3, voffA);
            PG8_BAR; PG8_WAIT_L(0); PG8_MMA(1, 0, At, B0); PG8_BAR; PG8_SCHED;
            PG8_STAGE(PG8_SB(1, 1), b3 + hstep, voffB);
            PG8_WAIT_V(6); PG8_BAR; PG8_MMA(1, 1, At, B1); PG8_BAR;
            }
        }
        if constexpr (ALIGN_EPI) { if (wr == 0) PG8_BAR; }
        if constexpr (F8) asm volatile("s_nop 15\n\ts_nop 15" ::: "memory");
        if constexpr (!Epi::AFTER_DRAIN) { E(acc, cur, wr, wc, fr, fq); S.done(cur); }
        if (!has_next) break;
#pragma unroll
        for (int a = 0; a < 2; ++a)
#pragma unroll
            for (int b = 0; b < 2; ++b)
#pragma unroll
                for (int m = 0; m < 4; ++m)
#pragma unroll
                    for (int n = 0; n < 2; ++n) acc[a][b][m][n] = (f32x4){0.f, 0.f, 0.f, 0.f};
        cur = nxt; cA = nA; cB = nB; ++ui;
        if constexpr (ALIGN_EPI) { if (wr == 1) PG8_BAR; }
    }
    PG8_WAIT_V(0);
    if constexpr (!ALIGN_EPI) { if (wr == 0) PG8_BAR; }
    PG8_BAR;
#undef PG8_SA
#undef PG8_SB
#undef PG8_STAGE
#undef PG8_LDA
#undef PG8_LD1
#undef PG8_LDB
#undef PG8_MMA
#undef PG8_WAIT_V
#undef PG8_WAIT_L
#undef PG8_BAR
#undef PG8_SCHED
}
}

namespace att {
constexpr int D = 128, NW = 8, QBLK = 32, KVBLK = 64;
constexpr float SCALE = 0.088388347648318440f;
constexpr size_t SHM_V = KVBLK * D * 2, SHM_K = KVBLK * D * 2, SHM_ATTN = 2 * SHM_V + 2 * SHM_K + NW * 64 * 4;
#define KSWZ(row, colB) ((row) * 256 + ((colB) ^ (((row) & 7) << 4)))
#define KSWZ8(row, colB) ((row) * 128 + ((colB) ^ ((((row) >> 1) & 7) << 4)))
#define SBAR() __builtin_amdgcn_sched_barrier(0)
__device__ __forceinline__ int crow(int r, int hi) { return (r & 3) + 8 * (r >> 2) + 4 * hi; }
template <bool MASKED> __device__ __forceinline__ void mask_apply(f32x16& p, unsigned w) {
    if constexpr (MASKED) {
#pragma unroll
        for (int r = 0; r < 16; ++r) { const unsigned m = (unsigned)__builtin_amdgcn_sbfe((int)w, (unsigned)((r & 3) + 8 * (r >> 2)), 1u); p[r] = __uint_as_float((__float_as_uint(p[r]) & m) | (0xFF800000u & ~m)); }
    }
}
template <bool MASKED, bool P8 = false> __device__ __forceinline__ void partialSM(f32x16& p0, f32x16& p1, float& m_reg, float& mn, float& alpha, unsigned long long mk, int sh4) {
    constexpr float C = SCALE * 1.4426950408889634f; constexpr float THR = P8 ? 5.f : 8.f;
    float pmax = p0[0];
#pragma unroll
    for (int r = 1; r < 16; ++r) pmax = fmaxf(pmax, p0[r]);
#pragma unroll
    for (int r = 0; r < 16; ++r) pmax = fmaxf(pmax, p1[r]);
    { auto rr = __builtin_amdgcn_permlane32_swap(__float_as_uint(pmax), __float_as_uint(pmax), false, false);
      pmax = fmaxf(__uint_as_float(rr[0]), __uint_as_float(rr[1])); }
    if (__builtin_expect(__all(pmax - m_reg <= THR / SCALE), 1)) { mn = m_reg; alpha = 1.f; }
    else { mn = fmaxf(m_reg, pmax); alpha = __builtin_amdgcn_exp2f((m_reg - mn) * C); m_reg = mn; }
    const float mnC = -mn * C;
#pragma unroll
    for (int r = 0; r < 16; ++r) p0[r] = fmaf(p0[r], C, mnC);
#pragma unroll
    for (int r = 0; r < 16; ++r) p1[r] = fmaf(p1[r], C, mnC);
#pragma unroll
    for (int r = 0; r < 16; ++r) p0[r] = __builtin_amdgcn_exp2f(p0[r]);
}
template <bool MASKED> __device__ __forceinline__ void finishSM(f32x16& p0, f32x16& p1, float alpha, float& l_reg, bf16x8& pa0, bf16x8& pa1, bf16x8& pa2, bf16x8& pa3, unsigned long long mk, int sh4) {
#pragma unroll
    for (int r = 0; r < 16; ++r) p1[r] = __builtin_amdgcn_exp2f(p1[r]);
    float ps = 0;
#pragma unroll
    for (int r = 0; r < 16; ++r) ps += p0[r];
#pragma unroll
    for (int r = 0; r < 16; ++r) ps += p1[r];
    { auto rr = __builtin_amdgcn_permlane32_swap(__float_as_uint(ps), __float_as_uint(ps), false, false);
      ps = __uint_as_float(rr[0]) + __uint_as_float(rr[1]); }
    l_reg = l_reg * alpha + ps;
#define PK4(P, BASE, OUT) do { unsigned a0 = cvtpk(P[BASE + 0], P[BASE + 1]), a1 = cvtpk(P[BASE + 2], P[BASE + 3]);   \
    unsigned b0 = cvtpk(P[BASE + 4], P[BASE + 5]), b1 = cvtpk(P[BASE + 6], P[BASE + 7]);                              \
    auto r0 = __builtin_amdgcn_permlane32_swap(a0, b0, false, false); auto r1 = __builtin_amdgcn_permlane32_swap(a1, b1, false, false); \
    u32x4 w = {r0[0], r1[0], r0[1], r1[1]}; OUT = *reinterpret_cast<bf16x8*>(&w); } while (0)
    PK4(p0, 0, pa0); PK4(p0, 8, pa1); PK4(p1, 0, pa2); PK4(p1, 8, pa3);
#undef PK4
}
__device__ __forceinline__ void finishSM8(f32x16& p0, f32x16& p1, float alpha, float& l_reg, i32x8& pa) {
#pragma unroll
    for (int r = 0; r < 16; ++r) p1[r] = __builtin_amdgcn_exp2f(p1[r]);
    float ps = 0;
#pragma unroll
    for (int r = 0; r < 16; ++r) ps += p0[r];
#pragma unroll
    for (int r = 0; r < 16; ++r) ps += p1[r];
    { auto rr = __builtin_amdgcn_permlane32_swap(__float_as_uint(ps), __float_as_uint(ps), false, false);
      ps = __uint_as_float(rr[0]) + __uint_as_float(rr[1]); }
    l_reg = l_reg * alpha + ps;
#pragma unroll
    for (int q = 0; q < 4; ++q) { int w = __builtin_amdgcn_cvt_pk_fp8_f32(p0[4 * q], p0[4 * q + 1], 0, false); pa[q] = __builtin_amdgcn_cvt_pk_fp8_f32(p0[4 * q + 2], p0[4 * q + 3], w, true);
        int v = __builtin_amdgcn_cvt_pk_fp8_f32(p1[4 * q], p1[4 * q + 1], 0, false); pa[4 + q] = __builtin_amdgcn_cvt_pk_fp8_f32(p1[4 * q + 2], p1[4 * q + 3], v, true); }
}
#define VSWZ8(d, c) ((d) * 64 + ((((c) ^ (((d) >> 2) & 3))) << 4))
__device__ __forceinline__ void pv8(f32x16* o, const char* Vt, const i32x8 pa, int r32, int hi) {
#pragma unroll
    for (int d0 = 0; d0 < 4; ++d0) { const int d = d0 * 32 + r32;
        const i32x8 vb = pg8::cat8(*reinterpret_cast<const bf16x8*>(Vt + VSWZ8(d, 2 * hi)), *reinterpret_cast<const bf16x8*>(Vt + VSWZ8(d, 2 * hi + 1)));
        o[d0] = __builtin_amdgcn_mfma_scale_f32_32x32x64_f8f6f4(pa, vb, o[d0], 0, 0, 0, 0, 0, 0); }
}
template <bool MASKED> __device__ __forceinline__ void qkt(f32x16& p0, f32x16& p1, const bf16_t* Ks, const bf16x8* qs, int r32, int hi, unsigned long long mk, int sh4, const char* lut) {
    if constexpr (MASKED) {
        const unsigned wl = (unsigned)mk >> sh4, wh = (unsigned)(mk >> 32) >> sh4;
#pragma unroll
        for (int g = 0; g < 4; ++g) { const f32x4 b0 = *(const f32x4*)(lut + ((wl >> (8 * g)) & 15u) * 16), b1 = *(const f32x4*)(lut + ((wh >> (8 * g)) & 15u) * 16);
            p0[4 * g] = b0.x; p0[4 * g + 1] = b0.y; p0[4 * g + 2] = b0.z; p0[4 * g + 3] = b0.w; p1[4 * g] = b1.x; p1[4 * g + 1] = b1.y; p1[4 * g + 2] = b1.z; p1[4 * g + 3] = b1.w; }
    } else { p0 = f32x16{}; p1 = f32x16{}; }
#pragma unroll
    for (int d0 = 0; d0 < 8; ++d0) { int cb = (d0 * 16 + hi * 8) * 2;
        bf16x8 b0 = *reinterpret_cast<const bf16x8*>((const char*)Ks + KSWZ(r32, cb));
        bf16x8 b1 = *reinterpret_cast<const bf16x8*>((const char*)Ks + KSWZ(32 + r32, cb));
        const bf16x8 qf = qs[d0 * 64];
        p0 = __builtin_amdgcn_mfma_f32_32x32x16_bf16(b0, qf, p0, 0, 0, 0);
        p1 = __builtin_amdgcn_mfma_f32_32x32x16_bf16(b1, qf, p1, 0, 0, 0); }
}
template <bool MASKED> __device__ __forceinline__ void qkt8(f32x16& p0, f32x16& p1, const char* Ks, const bf16x8* qs, int r32, int hi, unsigned long long mk, int sh4, const char* lut) {
    if constexpr (MASKED) {
        const unsigned wl = (unsigned)mk >> sh4, wh = (unsigned)(mk >> 32) >> sh4;
#pragma unroll
        for (int g = 0; g < 4; ++g) { const f32x4 b0 = *(const f32x4*)(lut + ((wl >> (8 * g)) & 15u) * 16), b1 = *(const f32x4*)(lut + ((wh >> (8 * g)) & 15u) * 16);
            p0[4 * g] = b0.x; p0[4 * g + 1] = b0.y; p0[4 * g + 2] = b0.z; p0[4 * g + 3] = b0.w; p1[4 * g] = b1.x; p1[4 * g + 1] = b1.y; p1[4 * g + 2] = b1.z; p1[4 * g + 3] = b1.w; }
    } else { p0 = f32x16{}; p1 = f32x16{}; }
#pragma unroll
    for (int s2 = 0; s2 < 2; ++s2) { const int cb = (s2 * 4 + hi * 2) * 16;
        const i32x8 a0 = pg8::cat8(*reinterpret_cast<const bf16x8*>(Ks + KSWZ8(r32, cb)), *reinterpret_cast<const bf16x8*>(Ks + KSWZ8(r32, cb + 16)));
        const i32x8 a1 = pg8::cat8(*reinterpret_cast<const bf16x8*>(Ks + KSWZ8(32 + r32, cb)), *reinterpret_cast<const bf16x8*>(Ks + KSWZ8(32 + r32, cb + 16)));
        const i32x8 qf = pg8::cat8(qs[(2 * s2) * 64], qs[(2 * s2 + 1) * 64]);
        p0 = __builtin_amdgcn_mfma_scale_f32_32x32x64_f8f6f4(a0, qf, p0, 0, 0, 0, 0, 0, 0);
        p1 = __builtin_amdgcn_mfma_scale_f32_32x32x64_f8f6f4(a1, qf, p1, 0, 0, 0, 0, 0, 0); }
}
__device__ __forceinline__ int v_st(int k, int c) { const int kk = (k & ~0xC) | ((k & 4) << 1) | ((k & 8) >> 1); return ((kk >> 3) * 4 + (c >> 5)) * 512 + ((kk & 7) * 32 + (c & 31)) * 2; }
__device__ __forceinline__ int v_rd_base(int lane) { return ((lane & 3) << 3) | (((lane >> 2) & 3) << 6) | (((lane >> 4) & 1) << 5) | (((lane >> 5) & 1) << 8); }
constexpr int v_rd_off(int d0, int ks, int half) { return d0 * 512 + ks * 4096 + half * 2048; }
template <int OFF> __device__ __forceinline__ s16x4 tr_read(int vb) {
    s16x4 r; asm volatile("ds_read_b64_tr_b16 %0, %1 offset:%2" : "=&v"(r) : "v"(vb), "i"(OFF) : "memory"); return r;
}
template <int D0> __device__ __forceinline__ void pv_one(f32x16& od, int vb, bf16x8 pa0, bf16x8 pa1, bf16x8 pa2, bf16x8 pa3) {
    const s16x4 l0 = tr_read<v_rd_off(D0, 0, 0)>(vb), h0 = tr_read<v_rd_off(D0, 0, 1)>(vb), l1 = tr_read<v_rd_off(D0, 1, 0)>(vb), h1 = tr_read<v_rd_off(D0, 1, 1)>(vb);
    const s16x4 l2 = tr_read<v_rd_off(D0, 2, 0)>(vb), h2 = tr_read<v_rd_off(D0, 2, 1)>(vb), l3 = tr_read<v_rd_off(D0, 3, 0)>(vb), h3 = tr_read<v_rd_off(D0, 3, 1)>(vb);
    asm volatile("s_waitcnt lgkmcnt(0)" ::: "memory"); SBAR();
#define PK(L, H) (bf16x8){L[0], L[1], L[2], L[3], H[0], H[1], H[2], H[3]}
    od = __builtin_amdgcn_mfma_f32_32x32x16_bf16(pa0, PK(l0, h0), od, 0, 0, 0);
    od = __builtin_amdgcn_mfma_f32_32x32x16_bf16(pa1, PK(l1, h1), od, 0, 0, 0);
    od = __builtin_amdgcn_mfma_f32_32x32x16_bf16(pa2, PK(l2, h2), od, 0, 0, 0);
    od = __builtin_amdgcn_mfma_f32_32x32x16_bf16(pa3, PK(l3, h3), od, 0, 0, 0);
#undef PK
}
__device__ __forceinline__ void pv_d0(f32x16* o, int vb, bf16x8 pa0, bf16x8 pa1, bf16x8 pa2, bf16x8 pa3) {
    pv_one<0>(o[0], vb, pa0, pa1, pa2, pa3); pv_one<1>(o[1], vb, pa0, pa1, pa2, pa3); pv_one<2>(o[2], vb, pa0, pa1, pa2, pa3); pv_one<3>(o[3], vb, pa0, pa1, pa2, pa3);
}
template <bool MASKED, int SDEPTH, int ldq, int ldk, int ldo, bool QK8 = false, bool PV8 = false>
__device__ __forceinline__ void attn_body(const bf16_t* __restrict__ Qb, const bf16_t* __restrict__ Kh, const bf16_t* __restrict__ Vh,
                                          bf16_t* __restrict__ Ob, int seq, const unsigned long long* __restrict__ mrow, char* lds,
                                          const unsigned char* __restrict__ Q8b = nullptr, const unsigned char* __restrict__ K8h = nullptr, const unsigned char* __restrict__ V8h = nullptr) {
    int tid = (int)threadIdx.x; asm volatile("" : "+v"(tid));
    const int wid = tid >> 6, lane = tid & 63, r32 = lane & 31, hi = lane >> 5, sh4 = 4 * hi;
    bf16_t* V_lds = (bf16_t*)lds; bf16_t* K_lds = (bf16_t*)(lds + 2 * SHM_V);
    float* ws = (float*)(lds + 2 * SHM_V + 2 * SHM_K) + wid * 64; float* li_l = ws; float* al_l = ws + 32;
    float m_reg = -1e30f, l_reg = 0; f32x16 o[4] = {};
    const bf16_t* Qw = Qb + (long)(wid * QBLK + r32) * ldq + hi * 8;
    bf16x8* qr = (bf16x8*)(lds + SHM_ATTN) + wid * 512 + lane;
    if constexpr (QK8) { const unsigned char* Q8w = Q8b + (long)(wid * QBLK + r32) * 1024 + hi * 32;
#pragma unroll
        for (int j = 0; j < 4; ++j) qr[j * 64] = *reinterpret_cast<const bf16x8*>(Q8w + (j >> 1) * 64 + (j & 1) * 16);
    } else {
#pragma unroll
        for (int d0 = 0; d0 < 8; ++d0) qr[d0 * 64] = *reinterpret_cast<const bf16x8*>(Qw + d0 * 16); }
    const char* lut = lds + SHM_ATTN + 65536;
    if (MASKED && tid < 64) ((float*)(lds + SHM_ATTN + 65536))[tid] = ((tid >> 2) >> (tid & 3)) & 1 ? 0.f : -INFINITY;
    const int sr = tid >> 4, sc = (tid & 15) * 8, vst0 = v_st(sr, sc), vst1 = v_st(32 + sr, sc);
    const int vb0 = (int)(uintptr_t)V_lds + v_rd_base(lane);
    struct { bf16x8 vs0, vs1, ks0, ks1; } sr_[SDEPTH];
    const int kr8 = tid >> 3, kc8 = (tid & 7) * 16;
#define SLOAD(i, k0) do { if constexpr (PV8) sr_[i].vs0 = *reinterpret_cast<const bf16x8*>(V8h + (long)(k0) * 128 + tid * 16); \
    else { sr_[i].vs0 = *reinterpret_cast<const bf16x8*>(&Vh[(long)((k0) + sr) * ldk + sc]); sr_[i].vs1 = *reinterpret_cast<const bf16x8*>(&Vh[(long)((k0) + 32 + sr) * ldk + sc]); } \
    if constexpr (QK8) sr_[i].ks0 = *reinterpret_cast<const bf16x8*>(K8h + (long)((k0) + kr8) * 1024 + kc8); \
    else { sr_[i].ks0 = *reinterpret_cast<const bf16x8*>(&Kh[(long)((k0) + sr) * ldk + sc]); sr_[i].ks1 = *reinterpret_cast<const bf16x8*>(&Kh[(long)((k0) + 32 + sr) * ldk + sc]); } } while (0)
#define SWRITE(b, i) do { if constexpr (PV8) *(bf16x8*)((char*)V_lds + (b) * SHM_V + VSWZ8(tid >> 2, tid & 3)) = sr_[i].vs0; \
    else { *(bf16x8*)((char*)V_lds + (b) * SHM_V + vst0) = sr_[i].vs0;          \
    *(bf16x8*)((char*)V_lds + (b) * SHM_V + vst1) = sr_[i].vs1; } int kc = sc * 2;               \
    if constexpr (QK8) *(bf16x8*)((char*)K_lds + (b) * SHM_K + KSWZ8(kr8, kc8)) = sr_[i].ks0;  \
    else { *(bf16x8*)((char*)K_lds + (b) * SHM_K + KSWZ(sr, kc)) = sr_[i].ks0;                  \
    *(bf16x8*)((char*)K_lds + (b) * SHM_K + KSWZ(32 + sr, kc)) = sr_[i].ks1; } } while (0)
#define SWAIT() do { if constexpr (SDEPTH == 2) { if constexpr (QK8 && PV8) asm volatile("s_waitcnt vmcnt(2)" ::: "memory"); else if constexpr (QK8) asm volatile("s_waitcnt vmcnt(3)" ::: "memory"); else asm volatile("s_waitcnt vmcnt(4)" ::: "memory"); } else asm volatile("s_waitcnt vmcnt(0)" ::: "memory"); } while (0)
#define FIN(P0, P1, AL, MK) do { if constexpr (PV8) finishSM8(P0, P1, AL, l_reg, pa8); else finishSM<MASKED>(P0, P1, AL, l_reg, pa0, pa1, pa2, pa3, MK, sh4); } while (0)
#define PVD(VOFF) do { if constexpr (PV8) pv8(o, (const char*)V_lds + (VOFF), pa8, r32, hi); else pv_d0(o, vb0 + (int)(VOFF), pa0, pa1, pa2, pa3); } while (0)
#define QKT(P0, P1, KB, MK) do { if constexpr (QK8) qkt8<MASKED>(P0, P1, (const char*)(KB), qr, r32, hi, MK, sh4, lut); else qkt<MASKED>(P0, P1, (const bf16_t*)(KB), qr, r32, hi, MK, sh4, lut); } while (0)
#define RESC(a) do { if (__any((a) < 1.f)) { if (hi == 0) al_l[r32] = (a); asm volatile("s_waitcnt lgkmcnt(0)" ::: "memory"); \
    _Pragma("unroll") for (int d = 0; d < 4; ++d) _Pragma("unroll") for (int r = 0; r < 16; ++r) o[d][r] *= al_l[crow(r, hi)]; } } while (0)
    f32x16 pA0, pA1, pB0, pB1; float mnA, mnB, alA, alB; bf16x8 pa0, pa1, pa2, pa3; i32x8 pa8; const int NT = seq / KVBLK;
    unsigned long long mkA = 0, mkB = 0;
    constexpr int SE = 0, SO = SDEPTH - 1;
    if constexpr (MASKED) mkA = mrow[0];
    SLOAD(SE, 0); asm volatile("s_waitcnt vmcnt(0)" ::: "memory"); SWRITE(0, SE); __syncthreads();
    QKT(pA0, pA1, K_lds, mkA); partialSM<MASKED, PV8>(pA0, pA1, m_reg, mnA, alA, mkA, sh4);
    if constexpr (MASKED) mkB = mrow[1];
    SLOAD(SO, KVBLK); if constexpr (SDEPTH == 2) { if (2 < NT) SLOAD(SE, 2 * KVBLK); }
    SWAIT(); SWRITE(1, SO); __syncthreads();
    for (int j = 1; j + 1 < NT; j += 2) {
        SBAR(); QKT(pB0, pB1, (char*)K_lds + SHM_K, mkB);
        FIN(pA0, pA1, alA, mkA); SBAR();
        if constexpr (MASKED) mkA = mrow[j + 1];
        SLOAD(SO, (j + SDEPTH) * KVBLK); SBAR();
        PVD(0); partialSM<MASKED, PV8>(pB0, pB1, m_reg, mnB, alB, mkB, sh4);
        __syncthreads(); SWAIT(); SWRITE(0, SE);
        RESC(alB); __syncthreads();
        SBAR(); QKT(pA0, pA1, K_lds, mkA);
        FIN(pB0, pB1, alB, mkB); SBAR();
        if constexpr (MASKED) { if (j + 2 < NT) mkB = mrow[j + 2]; }
        if (SDEPTH == 1 || j + 3 < NT) SLOAD(SE, (j + 1 + SDEPTH) * KVBLK); SBAR();
        PVD(SHM_V); partialSM<MASKED, PV8>(pA0, pA1, m_reg, mnA, alA, mkA, sh4);
        __syncthreads(); SWAIT(); SWRITE(1, SO);
        RESC(alA); __syncthreads();
    }
    SBAR(); QKT(pB0, pB1, (char*)K_lds + SHM_K, mkB);
    FIN(pA0, pA1, alA, mkA); SBAR();
    PVD(0); partialSM<MASKED, PV8>(pB0, pB1, m_reg, mnB, alB, mkB, sh4);
    __syncthreads(); RESC(alB);
    FIN(pB0, pB1, alB, mkB); SBAR();
    PVD(SHM_V);
    if (hi == 0) li_l[r32] = l_reg; asm volatile("s_waitcnt lgkmcnt(0)" ::: "memory");
    float rli[16];
#pragma unroll
    for (int r = 0; r < 16; ++r) rli[r] = __builtin_amdgcn_rcpf(li_l[crow(r, hi)]);
    bf16_t* Ow = Ob + (long)(wid * QBLK) * ldo;
#pragma unroll
    for (int r = 0; r < 16; ++r) { const int orow = crow(r, hi);
#pragma unroll
        for (int d0 = 0; d0 < 4; ++d0) Ow[(long)orow * ldo + d0 * 32 + r32] = (bf16_t)(cvtpk(o[d0][r] * rli[r], 0.f) & 0xffffu); }
    __syncthreads();
#undef SLOAD
#undef SWRITE
#undef SWAIT
#undef QKT
#undef FIN
#undef PVD
#undef RESC
}
#undef KSWZ
#undef KSWZ8
#undef VSWZ8
#undef SBAR
}

#define XB_TMO      128
#define XB_XCNT(j)  (256  + 64 * (j))
#define XB_XSUB(j)  (1280 + 64 * (j))
#define XB_XGEN(j)  (2304 + 64 * (j))
#define XB_TOP      3328
#define XB_TOPGEN   3392
#define XCD_BAR_WORDS 3456
#define XB_SPIN_CAP (1u << 22)
__device__ __forceinline__ unsigned xb_ld(unsigned* p)              { return __hip_atomic_load(p, __ATOMIC_RELAXED, __HIP_MEMORY_SCOPE_AGENT); }
__device__ __forceinline__ unsigned xb_add(unsigned* p, unsigned v) { return __hip_atomic_fetch_add(p, v, __ATOMIC_RELAXED, __HIP_MEMORY_SCOPE_AGENT); }
__device__ __forceinline__ unsigned xb_xcc_id() { return (unsigned)__builtin_amdgcn_s_getreg((3 << 11) | 20) & 0xFu; }
#define XB_SPIN(cond, bar) do { unsigned _sp = 0; while (cond) { __builtin_amdgcn_s_sleep(1); \
    if ((++_sp & 255u) == 0u) { if (xb_ld(&(bar)[XB_TMO])) break; if (_sp > XB_SPIN_CAP) { atomicAdd(&(bar)[XB_TMO], 1u); break; } } } } while (0)
struct XcdBarrier { unsigned* bar; unsigned x; volatile LAS unsigned* st; };
__device__ __forceinline__ XcdBarrier xcd_barrier_post(unsigned* bar, volatile LAS unsigned* st) {
    XcdBarrier b; b.bar = bar; b.x = xb_xcc_id(); b.st = st;
    if (threadIdx.x == 0) (void)xb_add(&bar[XB_XCNT(b.x)], 1u);
    return b;
}
__device__ __forceinline__ void xcd_barrier_complete(unsigned* bar, unsigned x, unsigned& nloc, unsigned& nx) {
    const unsigned G = gridDim.x * gridDim.y * gridDim.z;
    unsigned sum, cnt, mine, sp = 0u;
    for (;;) {
        sum = 0u; cnt = 0u; mine = 0u;
#pragma unroll
        for (unsigned j = 0; j < 16; ++j) { const unsigned c = xb_ld(&bar[XB_XCNT(j)]); sum += c; cnt += (c > 0u) ? 1u : 0u; mine = (j == x) ? c : mine; }
        if (sum == G) break;
        __builtin_amdgcn_s_sleep(1);
        if ((++sp & 255u) == 0u) { if (xb_ld(&bar[XB_TMO])) break; if (sp > XB_SPIN_CAP) { atomicAdd(&bar[XB_TMO], 1u); break; } }
    }
    nloc = mine > 0u ? mine : 1u; nx = cnt > 0u ? cnt : 1u;
}
__device__ __forceinline__ void xcd_barrier(const XcdBarrier& b) {
    asm volatile("s_waitcnt vmcnt(0)" ::: "memory");
    __syncthreads();
    if (threadIdx.x == 0) {
        unsigned* bar = b.bar;
        __builtin_amdgcn_s_waitcnt(0);
        unsigned nloc = b.st[0], nx = b.st[1];
        if (nloc == 0u) { xcd_barrier_complete(bar, b.x, nloc, nx); b.st[0] = nloc; b.st[1] = nx; }
        const unsigned old = xb_add(&bar[XB_XSUB(b.x)], 1u);
        const unsigned gen = old / nloc;
        if (old + 1u == (gen + 1u) * nloc) {
            __builtin_amdgcn_fence(__ATOMIC_RELEASE, "agent");
            asm volatile("s_waitcnt vmcnt(0)" ::: "memory");
            const unsigned og = xb_add(&bar[XB_TOP], 1u);
            const unsigned tg = og / nx;
            if (og + 1u == (tg + 1u) * nx) xb_add(&bar[XB_TOPGEN], 1u);
            else XB_SPIN(xb_ld(&bar[XB_TOPGEN]) == tg, bar);
            __builtin_amdgcn_fence(__ATOMIC_ACQUIRE, "agent");
            xb_add(&bar[XB_XGEN(b.x)], 1u);
            asm volatile("s_waitcnt vmcnt(0)" ::: "memory");
        } else {
            XB_SPIN(xb_ld(&bar[XB_XGEN(b.x)]) == gen, bar);
            __builtin_amdgcn_fence(__ATOMIC_ACQUIRE, "agent");
            asm volatile("s_waitcnt vmcnt(0)" ::: "memory");
        }
    }
    __syncthreads();
}

constexpr int NWAVES = 8;
constexpr int RING_BYTES = 151 * 1024;
constexpr int LDSCTL_OFF = RING_BYTES, MISC_OFF = LDSCTL_OFF + 320;
constexpr int LDS_BYTES = 152 * 1024;
static_assert(MISC_OFF + 128 <= LDS_BYTES, "LDS map");
constexpr int N_PHASES = 13;

struct Args {
    const float* x; const float* mem; const float* attn_g; const float* w_in; const float* q_g; const float* k_g; const float* pool_w; const float* pool_s;
    const float* mem_g; const float* w_kv; const float* mq_g; const float* mk_g; const float* w_out; const float* ffn_g; const float* w_q; const float* sk1; const float* sk2;
    const float* pu; const float* pv; float* out; unsigned char* ws; int ph_lo, ph_hi;
};
struct Frame {
    LAS unsigned char* lds; char* ldsg;
    int tid, lane, wave, vcu, G;
};

__device__ __forceinline__ int in_colmap(int n) {
    if (n < 4096) return n;
    if (n < 4608) return 4176 + (n - 4096);
    if (n < 5120) return 4688 + (n - 4608);
    if (n < 5184) return 4096 + (n - 5120);
    if (n < 5200) return 4160 + (n - 5184);
    return -1;
}
template <int MAP> __device__ __forceinline__ void p0_transpose_item(const float* W, int K, int N, bf16_t* WT, LAS float* scr, int kb, int nb, int lane) {
    const int k0 = 64 * kb, n0 = 32 * nb;
    int nsrc = n0 + (lane & 31); if (MAP == 1) nsrc = in_colmap(nsrc);
#pragma unroll 8
    for (int i = 0; i < 32; ++i) { const int kk = 2 * i + (lane >> 5); scr[kk * 33 + (lane & 31)] = nsrc >= 0 ? W[(size_t)(k0 + kk) * N + nsrc] : 0.f; }
    LDS_WAIT();
    const int c = lane & 7;
#pragma unroll
    for (int j = 0; j < 4; ++j) { const int n = (lane >> 3) + 8 * j; const LAS float* s = scr + (8 * c) * 33 + n;
        u32x4 o; o.x = cvtpk(s[0 * 33], s[1 * 33]); o.y = cvtpk(s[2 * 33], s[3 * 33]); o.z = cvtpk(s[4 * 33], s[5 * 33]); o.w = cvtpk(s[6 * 33], s[7 * 33]);
        *(u32x4*)(WT + (size_t)(n0 + n) * K + k0 + 8 * c) = o; }
    LDS_WAIT();
}
__device__ __forceinline__ void rms_row_to_bf16(const float* xrow, const float* gain, bf16_t* orow, int lane) {
    const f32x4* xr = (const f32x4*)xrow + lane;
    f32x4 v[8]; float s = 0.f;
#pragma unroll
    for (int j = 0; j < 8; ++j) { v[j] = xr[64 * j]; s += (v[j].x * v[j].x + v[j].y * v[j].y) + (v[j].z * v[j].z + v[j].w * v[j].w); }
    const float rstd = 1.f / sqrtf(wave_sum(s) * (1.f / DM) + EPS);
    unsigned long long* o8 = (unsigned long long*)orow + lane;
#pragma unroll
    for (int j = 0; j < 8; ++j) { const f32x4 g = ((const f32x4*)gain)[lane + 64 * j]; const f32x4 y = v[j] * rstd * g;
        o8[64 * j] = (unsigned long long)cvtpk(y.x, y.y) | ((unsigned long long)cvtpk(y.z, y.w) << 32); }
}
__device__ __forceinline__ void rms_row_to_bf16_fp8(const float* xrow, const float* gain, bf16_t* orow, unsigned char* o8row, int lane) {
    const f32x4* xr = (const f32x4*)xrow + lane;
    f32x4 v[8]; float s = 0.f;
#pragma unroll
    for (int j = 0; j < 8; ++j) { v[j] = xr[64 * j]; s += (v[j].x * v[j].x + v[j].y * v[j].y) + (v[j].z * v[j].z + v[j].w * v[j].w); }
    const float rstd = 1.f / sqrtf(wave_sum(s) * (1.f / DM) + EPS);
    unsigned long long* o8 = (unsigned long long*)orow + lane; unsigned* q4 = (unsigned*)o8row + lane;
#pragma unroll
    for (int j = 0; j < 8; ++j) { const f32x4 g = ((const f32x4*)gain)[lane + 64 * j]; const f32x4 y = v[j] * rstd * g;
        o8[64 * j] = (unsigned long long)cvtpk(y.x, y.y) | ((unsigned long long)cvtpk(y.z, y.w) << 32);
        int w = __builtin_amdgcn_cvt_pk_fp8_f32(__builtin_amdgcn_fmed3f(y.x, -448.f, 448.f), __builtin_amdgcn_fmed3f(y.y, -448.f, 448.f), 0, false);
        w = __builtin_amdgcn_cvt_pk_fp8_f32(__builtin_amdgcn_fmed3f(y.z, -448.f, 448.f), __builtin_amdgcn_fmed3f(y.w, -448.f, 448.f), w, true); q4[64 * j] = (unsigned)w; }
}
struct RowF32 { f32x4 v[8]; };
__device__ __forceinline__ void row_load(RowF32& R, const float* xrow, int lane) {
    const f32x4* xr = (const f32x4*)xrow + lane;
#pragma unroll
    for (int j = 0; j < 8; ++j) R.v[j] = xr[64 * j];
}
__device__ __forceinline__ void row_load_bf16(RowF32& R, const bf16_t* brow, int lane) {
    const u32x2* br = (const u32x2*)brow + lane;
#pragma unroll
    for (int j = 0; j < 8; ++j) { const u32x2 w = br[64 * j]; R.v[j] = (f32x4){bflo(w.x), bfhi(w.x), bflo(w.y), bfhi(w.y)}; }
}
__device__ __forceinline__ void row_to_fp8(const RowF32& R, unsigned char* orow, float* inv, int lane) {
    unsigned* o4 = (unsigned*)orow + lane; float am = 0.f;
#pragma unroll
    for (int j = 0; j < 8; ++j) am = fmaxf(am, fmaxf(fmaxf(fabsf(R.v[j].x), fabsf(R.v[j].y)), fmaxf(fabsf(R.v[j].z), fabsf(R.v[j].w))));
#pragma unroll
    for (int o = 1; o < 64; o <<= 1) am = fmaxf(am, __shfl_xor(am, o));
    const float sc = (am > 0.f && am < 3.0e38f) ? exp2f(floorf(log2f(224.f / am))) : 1.f;
#pragma unroll
    for (int j = 0; j < 8; ++j) { int w = __builtin_amdgcn_cvt_pk_fp8_f32(R.v[j].x * sc, R.v[j].y * sc, 0, false); w = __builtin_amdgcn_cvt_pk_fp8_f32(R.v[j].z * sc, R.v[j].w * sc, w, true); o4[64 * j] = (unsigned)w; }
    if (lane == 0) *inv = 1.f / sc;
}
__device__ __forceinline__ void p0_prologue(const Frame& F, const Args& a) {
    unsigned char* ws = a.ws;
    LAS float* scr = (LAS float*)(F.lds + F.wave * 16384);
    const int gw = F.vcu * NWAVES + F.wave, NGW = F.G * NWAVES, lane = F.lane;
    bf16_t* BtIn = (bf16_t*)(ws + WS_BT_IN); bf16_t* BtOut = (bf16_t*)(ws + WS_BT_OUT); bf16_t* BtQ = (bf16_t*)(ws + WS_BT_Q); bf16_t* BtKV = (bf16_t*)(ws + WS_BT_KV);
    constexpr int I_IN = 32 * 168, I_OUT = 32 * 64, I_Q = 32 * 64, I_KV = 32 * 32;
    constexpr int NIT = I_IN + I_OUT + I_Q + I_KV;
    for (int it = gw; it < NIT; it += NGW) {
        int r = it;
        if (r < I_IN) { p0_transpose_item<1>(a.w_in, DM, IN_W, BtIn, scr, r / 168, r % 168, lane); continue; } r -= I_IN;
        if (r < I_OUT) { const int kb = r / 64; p0_transpose_item<0>(a.w_out, DM, DM, BtOut, scr, kb, r % 64, lane); continue; } r -= I_OUT;
        if (r < I_Q) { p0_transpose_item<0>(a.w_q, DM, DM, BtQ, scr, r / 64, r % 64, lane); continue; } r -= I_Q;
        p0_transpose_item<0>(a.w_kv, DM, 1024, BtKV, scr, r / 32, r % 32, lane);
    }
    { bf16_t* PWt = (bf16_t*)(ws + WS_PWT);
      for (int it = gw; it < 4 * 128; it += NGW) { const int g = it >> 7, e = it & 127; const float* pw = a.pool_w + (size_t)g * 16384 + e;
          const float v0 = pw[(size_t)(2 * lane) * 128], v1 = pw[(size_t)(2 * lane + 1) * 128]; ((unsigned*)(PWt + (size_t)it * 128))[lane] = cvtpk(v0, v1); } }
    bf16_t* XN = (bf16_t*)(ws + WS_XN); bf16_t* MN = (bf16_t*)(ws + WS_MN);
#if P1_FP8
    for (int m = gw; m < NTOK; m += NGW) rms_row_to_bf16_fp8(a.x + (size_t)m * DM, a.attn_g, XN + (size_t)m * DM, ws + WS_XN8 + (size_t)m * DM, lane);
#else
    for (int m = gw; m < NTOK; m += NGW) rms_row_to_bf16(a.x + (size_t)m * DM, a.attn_g, XN + (size_t)m * DM, lane);
#endif
    for (int m = gw; m < BATCH * MEMLEN; m += NGW) rms_row_to_bf16(a.mem + (size_t)m * DM, a.mem_g, MN + (size_t)m * DM, lane);
    unsigned char* UB = ws + WS_UB; unsigned char* VB = ws + WS_VB; float* RSU = (float*)(ws + WS_RSU); float* RSV = (float*)(ws + WS_RSV);
    (void)UB; (void)VB; (void)RSU; (void)RSV;
    bf16_t* PK = (bf16_t*)(ws + WS_PK);
    for (int m = gw; m < 256; m += NGW) { const float* src = (m < 128 ? a.sk1 + (size_t)m * 128 : a.sk2 + (size_t)(m - 128) * 128);
        const f32x2 v = ((const f32x2*)src)[lane]; ((unsigned*)(PK + (size_t)m * 128))[lane] = cvtpk(v.x, v.y); }
    float* RT = (float*)(ws + WS_ROPE);
    for (int p = gw; p < SEQ; p += NGW) {
        { const float invf = powf(10000.f, -(float)lane / 64.f); const float ang = (float)p * invf;
          RT[(size_t)p * 192 + lane] = (float)cos((double)ang); RT[(size_t)p * 192 + 64 + lane] = (float)sin((double)ang); }
        if (lane < 32) { const float invf = powf(10000.f, -(float)lane / 32.f); const float ang = (float)p * invf;
          RT[(size_t)p * 192 + 128 + lane] = (float)cos((double)ang); RT[(size_t)p * 192 + 160 + lane] = (float)sin((double)ang); }
    }
}

__device__ __forceinline__ void unpack8(const u32x4 w, float* x) { x[0] = bflo(w.x); x[1] = bfhi(w.x); x[2] = bflo(w.y); x[3] = bfhi(w.y); x[4] = bflo(w.z); x[5] = bfhi(w.z); x[6] = bflo(w.w); x[7] = bfhi(w.w); }
__device__ __forceinline__ u32x4 pack8(const float* x) { u32x4 w; w.x = cvtpk(x[0], x[1]); w.y = cvtpk(x[2], x[3]); w.z = cvtpk(x[4], x[5]); w.w = cvtpk(x[6], x[7]); return w; }
struct F8 { float v[8]; };
__device__ __forceinline__ F8 ld8f(const float* p) { const f32x4 a = *(const f32x4*)p, b = *(const f32x4*)(p + 4); F8 r; r.v[0] = a.x; r.v[1] = a.y; r.v[2] = a.z; r.v[3] = a.w; r.v[4] = b.x; r.v[5] = b.y; r.v[6] = b.z; r.v[7] = b.w; return r; }
__device__ __forceinline__ u32x2 pack8_fp8(const float* x) { int a = __builtin_amdgcn_cvt_pk_fp8_f32(x[0], x[1], 0, false); a = __builtin_amdgcn_cvt_pk_fp8_f32(x[2], x[3], a, true); int b = __builtin_amdgcn_cvt_pk_fp8_f32(x[4], x[5], 0, false); b = __builtin_amdgcn_cvt_pk_fp8_f32(x[6], x[7], b, true); return (u32x2){(unsigned)a, (unsigned)b}; }
template <bool NORM, bool ROPE, bool WB16 = true> __device__ __forceinline__ void head128_fin(bf16_t* base, const u32x4 wa, const u32x4 wb, int g, const F8& g1, const F8& g2, const F8& cc, const F8& sn, unsigned char* f8base = nullptr) {
    float x1[8], x2[8];
    unpack8(wa, x1); unpack8(wb, x2);
    if (NORM) {
        float ss = 0.f;
#pragma unroll
        for (int j = 0; j < 8; ++j) ss += x1[j] * x1[j] + x2[j] * x2[j];
        ss += __shfl_xor(ss, 1); ss += __shfl_xor(ss, 2); ss += __shfl_xor(ss, 4);
        const float rstd = 1.f / sqrtf(ss * (1.f / 128.f) + EPS);
#pragma unroll
        for (int j = 0; j < 8; ++j) { x1[j] = x1[j] * rstd * g1.v[j]; x2[j] = x2[j] * rstd * g2.v[j]; }
    }
    if (ROPE) {
#pragma unroll
        for (int j = 0; j < 8; ++j) { const float c = cc.v[j], sv = sn.v[j]; const float p = x1[j], q = x2[j]; x1[j] = p * c - q * sv; x2[j] = q * c + p * sv; }
    }
    if (WB16) { *(u32x4*)(base + 8 * g) = pack8(x1); *(u32x4*)(base + 64 + 8 * g) = pack8(x2); }
    if (f8base) { *(u32x2*)(f8base + 8 * g) = pack8_fp8(x1); *(u32x2*)(f8base + 64 + 8 * g) = pack8_fp8(x2); }
}
__device__ __forceinline__ void head64_fin(bf16_t* base, const u32x4 wa, const u32x4 wb, int g, const F8& cc, const F8& sn) {
    float x1[8], x2[8];
    unpack8(wa, x1); unpack8(wb, x2);
#pragma unroll
    for (int j = 0; j < 8; ++j) { const float c = cc.v[j], sv = sn.v[j]; const float p = x1[j], q = x2[j]; x1[j] = p * c - q * sv; x2[j] = q * c + p * sv; }
    *(u32x4*)(base + 8 * g) = pack8(x1); *(u32x4*)(base + 32 + 8 * g) = pack8(x2);
}
__device__ __forceinline__ void p2_post(const Frame& F, const Args& a) {
    unsigned char* ws = a.ws; const int lane = F.lane;
    const int gw = F.vcu * NWAVES + F.wave, NGW = F.G * NWAVES;
    bf16_t* Z = (bf16_t*)(ws + WS_Z); bf16_t* MIX = (bf16_t*)(ws + WS_XN); bf16_t* KVM = (bf16_t*)(ws + WS_KVM);
    const float* RT = (const float*)(ws + WS_ROPE);
    const int g8 = lane & 7, h8 = lane >> 3, g4 = lane & 3, h4 = lane >> 2;
    const F8 qg1 = ld8f(a.q_g + 8 * g8), qg2 = ld8f(a.q_g + 64 + 8 * g8), kg1 = ld8f(a.k_g + 8 * g8), kg2 = ld8f(a.k_g + 64 + 8 * g8), mg1 = ld8f(a.mq_g + 8 * g8), mg2 = ld8f(a.mq_g + 64 + 8 * g8);
    for (int t = gw; t < NTOK; t += NGW) {
        const int pos = t & (SEQ - 1);
        bf16_t* zr = Z + (size_t)t * ZLD; const float* rp = RT + (size_t)pos * 192;
        const int w = 2 << (lane >> 4); const int cnt = (pos + 1 < w) ? pos + 1 : w;
        u32x4 pl[16];
#pragma unroll
        for (int j = 0; j < 16; ++j) { const int jj = j < cnt ? j : 0; pl[j] = *(const u32x4*)(zr - (size_t)jj * ZLD + ZC_PU + 8 * lane); }
        bf16_t* bq = zr + ZC_Q + h8 * 128; bf16_t* bk = zr + ZC_K + h8 * 128; bf16_t* bi = zr + ZC_QI + h4 * 64; bf16_t* bki = zr + ZC_KI; bf16_t* bm = zr + ZC_QM + (h8 & 3) * 128;
        const u32x4 q1 = *(const u32x4*)(bq + 8 * g8), q2 = *(const u32x4*)(bq + 64 + 8 * g8), k1 = *(const u32x4*)(bk + 8 * g8), k2 = *(const u32x4*)(bk + 64 + 8 * g8);
        const u32x4 i1 = *(const u32x4*)(bi + 8 * g4), i2 = *(const u32x4*)(bi + 32 + 8 * g4), x1 = *(const u32x4*)(bki + 8 * g4), x2 = *(const u32x4*)(bki + 32 + 8 * g4);
        const u32x4 m1 = *(const u32x4*)(bm + 8 * g8), m2 = *(const u32x4*)(bm + 64 + 8 * g8);
        const F8 c128 = ld8f(rp + 8 * g8), s128 = ld8f(rp + 64 + 8 * g8), c64 = ld8f(rp + 128 + 8 * g4), s64 = ld8f(rp + 160 + 8 * g4);
#if QK_FP8
        head128_fin<true, true, ATT_VERIFY != 0>(bq, q1, q2, g8, qg1, qg2, c128, s128, ws + WS_Q8 + (size_t)t * 1024 + h8 * 128);
        head128_fin<true, true, ATT_VERIFY != 0>(bk, k1, k2, g8, kg1, kg2, c128, s128, ws + WS_K8 + (size_t)t * 1024 + h8 * 128);
#else
        head128_fin<true, true>(bq, q1, q2, g8, qg1, qg2, c128, s128);
        head128_fin<true, true>(bk, k1, k2, g8, kg1, kg2, c128, s128);
#endif
        head64_fin(bi, i1, i2, g4, c64, s64);
        if (lane < 4) head64_fin(bki, x1, x2, g4, c64, s64);
        if (lane < 32) head128_fin<true, false>(bm, m1, m2, g8, mg1, mg2, c128, s128);
        { float sum[8] = {0.f, 0.f, 0.f, 0.f, 0.f, 0.f, 0.f, 0.f}, ut[8];
          unpack8(pl[0], ut);
#pragma unroll
          for (int j = 0; j < 16; ++j) { float v[8]; unpack8(pl[j], v); const float on = j < cnt ? 1.f : 0.f;
#pragma unroll
              for (int e = 0; e < 8; ++e) sum[e] = fmaf(on, v[e], sum[e]); }
          const float inv = 1.f / (float)cnt; float d[8];
#pragma unroll
          for (int e = 0; e < 8; ++e) d[e] = sum[e] * inv - ut[e];
          *(u32x4*)(MIX + (size_t)t * DM + 1024 + 8 * lane) = pack8(d); }
    }
    const F8 kmg1 = ld8f(a.mk_g + 8 * g8), kmg2 = ld8f(a.mk_g + 64 + 8 * g8);
    for (int r = gw; r < BATCH * MEMLEN; r += NGW) { if (lane < 32) { bf16_t* bm = KVM + (size_t)r * 1024 + (lane >> 3) * 128; const u32x4 m1 = *(const u32x4*)(bm + 8 * g8), m2 = *(const u32x4*)(bm + 64 + 8 * g8); head128_fin<true, false>(bm, m1, m2, g8, kmg1, kmg2, kmg1, kmg2); } }
}

#if PV_FP8
__device__ __forceinline__ void p2_vt(const Frame& F, const Args& a) {
    unsigned char* ws = a.ws; const int lane = F.lane;
    const int gw = F.vcu * NWAVES + F.wave, NGW = F.G * NWAVES;
    const bf16_t* Z = (const bf16_t*)(ws + WS_Z);
    {
        LAS unsigned char* tb = F.lds + F.wave * 8704; unsigned char* V8T = ws + WS_V8T;
        for (int blk = gw; blk < BATCH * 256 * 8; blk += NGW) {
            const int h = blk & 7, T = (blk >> 3) & 255, b = blk >> 11;
            const bf16_t* vrow = Z + ((size_t)b * SEQ + 64 * T + lane) * ZLD + ZC_V + h * 128;
            u32x4 w[16];
#pragma unroll
            for (int i = 0; i < 16; ++i) w[i] = *(const u32x4*)(vrow + 8 * i);
#pragma unroll
            for (int i = 0; i < 16; ++i) { float x[8]; unpack8(w[i], x);
#pragma unroll
                for (int e = 0; e < 8; ++e) x[e] = __builtin_amdgcn_fmed3f(x[e], -448.f, 448.f);
                *(LAS u32x2*)(tb + lane * 136 + 8 * i) = pack8_fp8(x); }
            LDS_WAIT();
            unsigned char* dst = V8T + ((size_t)((b * 8 + h) * 256 + T)) * 8192 + (size_t)lane * 128;
#pragma unroll
            for (int c = 0; c < 2; ++c) { const int d = 2 * lane + c;
#pragma unroll
                for (int q4 = 0; q4 < 4; ++q4) { unsigned o[4];
#pragma unroll
                    for (int qq = 0; qq < 4; ++qq) { const int pq = 4 * (4 * q4 + qq); const int key0 = 32 * ((pq >> 4) & 1) + 8 * ((pq >> 2) & 3) + 4 * (pq >> 5);
                        const unsigned b0 = tb[(key0 + 0) * 136 + d], b1 = tb[(key0 + 1) * 136 + d], b2 = tb[(key0 + 2) * 136 + d], b3 = tb[(key0 + 3) * 136 + d];
                        o[qq] = b0 | (b1 << 8) | (b2 << 16) | (b3 << 24); }
                    *(u32x4*)(dst + c * 64 + q4 * 16) = (u32x4){o[0], o[1], o[2], o[3]}; } }
            LDS_WAIT();
        }
    }
}
#endif

namespace ix {
constexpr int KP = 144, KBUF = 64 * KP;
constexpr int OFF_KI = 0, OFF_HIST = 2 * KBUF, OFF_ST = OFF_HIST + 65536, OFF_W = OFF_ST + 8192;
constexpr int CAPB = 1024;
constexpr int CAPF = 512;
enum { S_ULO = 0, S_UHI = 64, S_SH = 128, S_NEED = 192, S_FLO = 256, S_FHI = 320, S_CCNT = 384, S_ACT = 448, S_ABOVE = 512, S_COL = 576, S_FAIL = 640,
       S_PB1 = 704, S_PB2 = 768, S_PAB = 832, S_VMIN = 896, S_VMAX = 960, S_VCNT = 1024, S_ANY = 1088, S_R1 = 1089, S_R2 = 1090 };
constexpr float WSCALE = 0.25f * 0.125f;
__device__ __forceinline__ float relu_i(float x) { const int i = __float_as_int(x); return __int_as_float(i > 0 ? i : 0); }
__device__ __forceinline__ unsigned sh_for(unsigned range) { const int bits = 32 - __clz((int)range); return range == 0u ? 0u : (bits > 9 ? (unsigned)(bits - 9) : 0u); }

template <int MODE>
__device__ __forceinline__ void sweep(const Frame& F, const bf16x8 (&A)[4][4], const bf16_t* Z, unsigned* MASK, unsigned long long* CAND, size_t qrow0, size_t krow0, int NT, int t0, int stride, int vmode) {
    const int tid = F.tid, lane = F.lane, wave = F.wave, r = lane & 31, hi = lane >> 5;
    LAS unsigned char* lds = F.lds;
    volatile LAS unsigned* st = (volatile LAS unsigned*)(lds + OFF_ST);
    LAS unsigned* hist32 = (LAS unsigned*)(lds + OFF_HIST);
    unsigned qact = 0u;
    {
#pragma unroll
        for (int qp = 0; qp < 4; ++qp) { const int q0 = 8 * wave + 2 * qp; const unsigned a2 = (MODE == 0) ? (st[S_ACT + q0] | st[S_ACT + q0 + 1]) : (vmode ? 1u : (st[S_COL + q0] | st[S_COL + q0 + 1]));
            qact |= ((unsigned)__builtin_amdgcn_readfirstlane((int)a2) != 0u ? 1u : 0u) << qp; }
    }
    unsigned ccnt_[4] = {0u, 0u, 0u, 0u}, abv_[4] = {0u, 0u, 0u, 0u};
    if (MODE == 1) {
#pragma unroll
        for (int qp = 0; qp < 4; ++qp) { ccnt_[qp] = st[S_CCNT + 8 * wave + 2 * qp + hi]; abv_[qp] = st[S_ABOVE + 8 * wave + 2 * qp + hi]; }
    }
    const int srow = tid >> 3, sch = tid & 7;
    const bf16_t* ksrc = Z + (krow0 + srow) * ZLD + ZC_KI + sch * 8;
    u32x4 stg = *(const u32x4*)(ksrc + (size_t)t0 * 64 * ZLD);
    *(LAS u32x4*)(lds + OFF_KI + srow * KP + sch * 16) = stg;
    __syncthreads();
    int buf = 0;
    for (int t = t0; t < NT; t += stride) {
        const int tn = t + stride;
        if (tn < NT) stg = *(const u32x4*)(ksrc + (size_t)tn * 64 * ZLD);
        LAS unsigned char* kb = lds + OFF_KI + buf * KBUF;
        int lane_ = (int)threadIdx.x; asm volatile("" : "+v"(lane_)); lane_ &= 63;
        const int r = lane_ & 31, hi = lane_ >> 5;
        bf16x8 B0[4], B1[4];
#pragma unroll
        for (int ks = 0; ks < 4; ++ks) { B0[ks] = *(const LAS bf16x8*)(kb + r * KP + ks * 32 + hi * 16); B1[ks] = *(const LAS bf16x8*)(kb + (32 + r) * KP + ks * 32 + hi * 16); }
#pragma unroll
        for (int qp = 0; qp < 4; ++qp) {
            if (((qact >> qp) & 1u) == 0u) continue;
            const int ql = 8 * wave + 2 * qp + hi;
            const LAS f32x4* wq = (const LAS f32x4*)(lds + OFF_W + ql * 64);
            const f32x4 w0 = wq[0], w1 = wq[1], w2 = wq[2], w3 = wq[3];
            f32x16 a0 = f32x16{}, a1 = f32x16{};
#pragma unroll
            for (int ks = 0; ks < 4; ++ks) { a0 = __builtin_amdgcn_mfma_f32_32x32x16_bf16(A[qp][ks], B0[ks], a0, 0, 0, 0); a1 = __builtin_amdgcn_mfma_f32_32x32x16_bf16(A[qp][ks], B1[ks], a1, 0, 0, 0); }
            float p0 = w0.x * relu_i(a0[0]), p1 = w2.x * relu_i(a0[8]), q0 = w0.x * relu_i(a1[0]), q1 = w2.x * relu_i(a1[8]);
            p0 = fmaf(w0.y, relu_i(a0[1]), p0); p1 = fmaf(w2.y, relu_i(a0[9]), p1); q0 = fmaf(w0.y, relu_i(a1[1]), q0); q1 = fmaf(w2.y, relu_i(a1[9]), q1);
            p0 = fmaf(w0.z, relu_i(a0[2]), p0); p1 = fmaf(w2.z, relu_i(a0[10]), p1); q0 = fmaf(w0.z, relu_i(a1[2]), q0); q1 = fmaf(w2.z, relu_i(a1[10]), q1);
            p0 = fmaf(w0.w, relu_i(a0[3]), p0); p1 = fmaf(w2.w, relu_i(a0[11]), p1); q0 = fmaf(w0.w, relu_i(a1[3]), q0); q1 = fmaf(w2.w, relu_i(a1[11]), q1);
            p0 = fmaf(w1.x, relu_i(a0[4]), p0); p1 = fmaf(w3.x, relu_i(a0[12]), p1); q0 = fmaf(w1.x, relu_i(a1[4]), q0); q1 = fmaf(w3.x, relu_i(a1[12]), q1);
            p0 = fmaf(w1.y, relu_i(a0[5]), p0); p1 = fmaf(w3.y, relu_i(a0[13]), p1); q0 = fmaf(w1.y, relu_i(a1[5]), q0); q1 = fmaf(w3.y, relu_i(a1[13]), q1);
            p0 = fmaf(w1.z, relu_i(a0[6]), p0); p1 = fmaf(w3.z, relu_i(a0[14]), p1); q0 = fmaf(w1.z, relu_i(a1[6]), q0); q1 = fmaf(w3.z, relu_i(a1[14]), q1);
            p0 = fmaf(w1.w, relu_i(a0[7]), p0); p1 = fmaf(w3.w, relu_i(a0[15]), p1); q0 = fmaf(w1.w, relu_i(a1[7]), q0); q1 = fmaf(w3.w, relu_i(a1[15]), q1);
            const unsigned u0 = f2ord(p0 + p1), u1 = f2ord(q0 + q1);
            if (MODE == 0) {
                const unsigned wlo = st[S_ULO + ql], whi = st[S_UHI + ql], wsh = st[S_SH + ql];
                if (u0 >= wlo && u0 <= whi) { const unsigned bin = (u0 - wlo) >> wsh;
                    __hip_atomic_fetch_add(hist32 + ql * 256 + (bin >> 1), 1u << ((bin & 1u) * 16u), __ATOMIC_RELAXED, __HIP_MEMORY_SCOPE_WORKGROUP); }
                if (u1 >= wlo && u1 <= whi) { const unsigned bin = (u1 - wlo) >> wsh;
                    __hip_atomic_fetch_add(hist32 + ql * 256 + (bin >> 1), 1u << ((bin & 1u) * 16u), __ATOMIC_RELAXED, __HIP_MEMORY_SCOPE_WORKGROUP); }
            } else if (IX_VERIFY && vmode) {
                LAS unsigned* vs = (LAS unsigned*)(lds + OFF_ST) + ql;
                const unsigned long long w64 = __hip_atomic_load((const unsigned long long*)(MASK + (qrow0 + ql) * MASK_WPR + 2 * t), __ATOMIC_RELAXED, __HIP_MEMORY_SCOPE_AGENT);
                if ((w64 >> r) & 1ull) { __hip_atomic_fetch_min(vs + S_VMIN, u0, __ATOMIC_RELAXED, __HIP_MEMORY_SCOPE_WORKGROUP); __hip_atomic_fetch_add(vs + S_VCNT, 1u, __ATOMIC_RELAXED, __HIP_MEMORY_SCOPE_WORKGROUP); }
                else __hip_atomic_fetch_max(vs + S_VMAX, u0, __ATOMIC_RELAXED, __HIP_MEMORY_SCOPE_WORKGROUP);
                if ((w64 >> (32 + r)) & 1ull) { __hip_atomic_fetch_min(vs + S_VMIN, u1, __ATOMIC_RELAXED, __HIP_MEMORY_SCOPE_WORKGROUP); __hip_atomic_fetch_add(vs + S_VCNT, 1u, __ATOMIC_RELAXED, __HIP_MEMORY_SCOPE_WORKGROUP); }
                else __hip_atomic_fetch_max(vs + S_VMAX, u1, __ATOMIC_RELAXED, __HIP_MEMORY_SCOPE_WORKGROUP);
            } else {
                const unsigned flo = st[S_FLO + ql], fhi = st[S_FHI + ql]; const bool col = st[S_COL + ql] != 0u;
                const unsigned long long bal0 = __ballot(col && u0 > fhi), bal1 = __ballot(col && u1 > fhi);
                const unsigned bh0 = (unsigned)(bal0 >> (32 * hi)), bh1 = (unsigned)(bal1 >> (32 * hi));
                if (col && r == 0) *(unsigned long long*)(MASK + (qrow0 + ql) * MASK_WPR + 2 * t) = (unsigned long long)bh0 | ((unsigned long long)bh1 << 32);
                abv_[qp] += __popc(bh0) + __popc(bh1);
                const bool c0 = col && (u0 >= flo) && (u0 <= fhi), c1 = col && (u1 >= flo) && (u1 <= fhi);
                const unsigned long long cb0 = __ballot(c0), cb1 = __ballot(c1);
                if (cb0 | cb1) { const unsigned h0 = (unsigned)(cb0 >> (32 * hi)), h1 = (unsigned)(cb1 >> (32 * hi)); const unsigned lt = (1u << r) - 1u;
                    const unsigned pos0 = ccnt_[qp] + __popc(h0 & lt), pos1 = ccnt_[qp] + __popc(h0) + __popc(h1 & lt);
                    if (c0 && pos0 < (unsigned)CAPB) CAND[(size_t)ql * CAPB + pos0] = (unsigned long long)u0 | ((unsigned long long)(unsigned)(64 * t + r) << 32);
                    if (c1 && pos1 < (unsigned)CAPB) CAND[(size_t)ql * CAPB + pos1] = (unsigned long long)u1 | ((unsigned long long)(unsigned)(64 * t + 32 + r) << 32);
                    ccnt_[qp] += __popc(h0) + __popc(h1); }
            }
        }
        if (tn < NT) *(LAS u32x4*)(lds + OFF_KI + (buf ^ 1) * KBUF + srow * KP + sch * 16) = stg;
        __syncthreads();
        buf ^= 1;
    }
    if (MODE == 1 && !vmode) { const int r0 = lane & 31, h0 = lane >> 5;
#pragma unroll
        for (int qp = 0; qp < 4; ++qp) { const int ql = 8 * wave + 2 * qp + h0; if (r0 == 0 && st[S_COL + ql] != 0u) { st[S_CCNT + ql] = ccnt_[qp]; st[S_ABOVE + ql] = abv_[qp]; } } }
}

__device__ __forceinline__ void resolve(const Frame& F, unsigned* MASK, const unsigned long long* CAND, size_t qrow0, int NT) {
    int lane = (int)threadIdx.x; asm volatile("" : "+v"(lane)); lane &= 63; const int wave = F.wave;
    LAS unsigned char* lds = F.lds;
    volatile LAS unsigned* st = (volatile LAS unsigned*)(lds + OFF_ST);
    LAS unsigned* wh = (LAS unsigned*)(lds + OFF_HIST + wave * 4608); LAS unsigned* bm = wh + 512; LAS unsigned long long* sl = (LAS unsigned long long*)(bm + 512);
    const unsigned long long ltm = (1ull << lane) - 1ull;
    for (int qi = 0; qi < 8; ++qi) {
        const int q = 8 * wave + qi;
        if (st[S_COL + q] == 0u) continue;
        const unsigned cnt = st[S_CCNT + q], ab = st[S_ABOVE + q];
        if (!(ab < 256u && ab + cnt >= 256u && cnt <= (unsigned)CAPB)) { if (lane == 0) st[S_FAIL + q] = 1u; continue; }
        if (lane == 0) st[S_FAIL + q] = 0u;
        unsigned need = 256u - ab, lo = st[S_FLO + q], hi = st[S_FHI + q], sh = 0u, cbin = 0u;
        const unsigned long long* cq = CAND + (size_t)q * CAPB;
#pragma unroll
        for (int i = 0; i < 8; ++i) bm[lane * 8 + i] = 0u;
        for (int lev = 0; lev < 5; ++lev) {
            sh = sh_for(hi - lo);
#pragma unroll
            for (int i = 0; i < 8; ++i) wh[lane * 8 + i] = 0u;
            LDS_WAIT();
            for (unsigned j = lane; j < cnt; j += 64) { const unsigned u = (unsigned)cq[j]; if (u >= lo && u <= hi) __hip_atomic_fetch_add(wh + ((u - lo) >> sh), 1u, __ATOMIC_RELAXED, __HIP_MEMORY_SCOPE_WORKGROUP); }
            LDS_WAIT();
            unsigned hb[8], s8 = 0u;
#pragma unroll
            for (int i = 0; i < 8; ++i) { hb[i] = wh[lane * 8 + i]; s8 += hb[i]; }
            unsigned above = 0u;
            { unsigned inc = s8;
#pragma unroll
              for (int o = 1; o < 64; o <<= 1) { const unsigned v = __shfl_down(inc, o); if (lane + o < 64) inc += v; }
              above = inc - s8; }
            const bool mine = above < need && need <= above + s8;
            unsigned bstar = 0u, run = above, cb = 0u;
            if (mine) { bool found = false;
#pragma unroll
                for (int i = 7; i >= 0; --i) { if (!found) { if (run + hb[i] >= need) { bstar = (unsigned)(lane * 8 + i); cb = hb[i]; found = true; } else run += hb[i]; } } }
            const unsigned long long mb = __ballot(mine); const int src = mb ? (int)__builtin_ctzll(mb) : 0;
            bstar = __shfl(bstar, src); run = __shfl(run, src); cbin = __shfl(cb, src);
            const unsigned nlo = lo + (bstar << sh); const unsigned long long e = (unsigned long long)nlo + ((1ull << sh) - 1ull);
            hi = e > (unsigned long long)hi ? hi : (unsigned)e; lo = nlo; need -= run;
            if (cbin <= 64u || sh == 0u) break;
        }
        const bool tiemode = cbin > 64u;
        unsigned m = 0u;
        for (unsigned j0 = 0; j0 < cnt; j0 += 64) { const unsigned j = j0 + lane; const bool vj = j < cnt; const unsigned long long e = vj ? cq[j] : 0ull; const unsigned u = (unsigned)e, key = (unsigned)(e >> 32);
            const bool inw = vj && u >= lo && u <= hi; const unsigned long long bal = __ballot(inw); const unsigned pos = m + (unsigned)__popcll(bal & ltm);
            if (vj && (u > hi || (tiemode && inw && pos < need))) __hip_atomic_fetch_or(bm + (key >> 5), 1u << (key & 31u), __ATOMIC_RELAXED, __HIP_MEMORY_SCOPE_WORKGROUP);
            if (!tiemode && inw && pos < 64u) sl[pos] = e;
            m += (unsigned)__popcll(bal); }
        LDS_WAIT();
        if (!tiemode) { if (m > 64u) m = 64u;
            if ((unsigned)lane < m) { const unsigned long long ej = sl[lane]; const unsigned uj = (unsigned)ej; unsigned rank = 0u;
                for (unsigned j2 = 0; j2 < m; ++j2) { const unsigned u2 = (unsigned)sl[j2]; rank += (u2 > uj || (u2 == uj && j2 < (unsigned)lane)) ? 1u : 0u; }
                if (rank < need) { const unsigned key = (unsigned)(ej >> 32); __hip_atomic_fetch_or(bm + (key >> 5), 1u << (key & 31u), __ATOMIC_RELAXED, __HIP_MEMORY_SCOPE_WORKGROUP); } } }
        LDS_WAIT();
        unsigned* mrow = MASK + (qrow0 + q) * MASK_WPR;
        for (int w = lane; w < 2 * NT; w += 64) { const unsigned b = bm[w]; if (b) { const unsigned old = __hip_atomic_load(mrow + w, __ATOMIC_RELAXED, __HIP_MEMORY_SCOPE_AGENT); mrow[w] = old | b; } }
        LDS_WAIT();
    }
}

__device__ __forceinline__ void unit(const Frame& F, const bf16_t* Z, unsigned* MASK, unsigned long long* CANDW, unsigned* ERR, int b, int c) {
    const int tid = F.tid, lane = F.lane, wave = F.wave, r = lane & 31, hi = lane >> 5;
    const int NT = c + 1; const size_t qrow0 = (size_t)b * SEQ + 64 * c, krow0 = (size_t)b * SEQ;
    LAS unsigned char* lds = F.lds;
    volatile LAS unsigned* st = (volatile LAS unsigned*)(lds + OFF_ST);
    LAS unsigned* hist32 = (LAS unsigned*)(lds + OFF_HIST);
    { const int tend = 4 * ((c >> 2) + 1), nz = 2 * (tend - NT);
      for (int i = tid; i < 64 * nz; i += 512) { const int q = i / nz, wi = 2 * NT + i % nz; MASK[(qrow0 + q) * MASK_WPR + wi] = 0u; } }
    if (c <= 3) {
        for (int i = tid; i < 64 * 2 * NT; i += 512) { const int q = i / (2 * NT), wi = i % (2 * NT); MASK[(qrow0 + q) * MASK_WPR + wi] = 0xFFFFFFFFu; }
        return;
    }
    bf16x8 A[4][4];
#pragma unroll
    for (int qp = 0; qp < 4; ++qp) {
        const int query = 8 * wave + 2 * qp + ((r >> 2) & 1), head = (r & 3) + 4 * (r >> 3);
        const bf16_t* src = Z + (qrow0 + query) * ZLD + ZC_QI + head * 64 + 8 * hi;
#pragma unroll
        for (int ks = 0; ks < 4; ++ks) A[qp][ks] = *(const bf16x8*)(src + ks * 16);
    }
    for (int i = tid; i < 64 * 16; i += 512) { const int q = i >> 4, hh = i & 15; ((LAS float*)(lds + OFF_W))[i] = bflo((unsigned)Z[(qrow0 + q) * ZLD + ZC_WI + hh]) * WSCALE; }
    const int stride = NT >= 32 ? 8 : (NT >= 16 ? 4 : 1), t0 = stride >> 1, nsamp = (NT - t0 + stride - 1) / stride;
    const bool pilot = stride > 1;
    int r1 = 1, r2 = 1;
    if (pilot) { const float ns = 256.f * (float)nsamp / (float)NT; const float sg = sqrtf(ns * (1.f - 1.f / (float)stride)); const int mg = (int)ceilf(4.f * sg) + 2;
        r1 = (int)floorf(ns) - mg; if (r1 < 1) r1 = 1; r2 = (int)ceilf(ns) + mg; }
    if (tid < 64) { st[S_ULO + tid] = 0u; st[S_UHI + tid] = 0xFFFFFFFFu; st[S_SH + tid] = 23u; st[S_NEED + tid] = 256u; st[S_ACT + tid] = 1u; st[S_CCNT + tid] = 0u; st[S_ABOVE + tid] = 0u;
                    st[S_COL + tid] = 1u; st[S_FAIL + tid] = pilot ? 0u : 1u; st[S_PB1 + tid] = 511u; st[S_PB2 + tid] = 0u; st[S_PAB + tid] = 0u; }
    __syncthreads();
    int stage = pilot ? 0 : 2; bool after_fallback = !pilot;
    for (int iter = 0; iter < 24; ++iter) {
        if (stage <= 2) {
            { int tid_ = (int)threadIdx.x; asm volatile("" : "+v"(tid_));
              for (int i = 0; i < 32; ++i) hist32[tid_ + 512 * i] = 0u;
              if (tid_ == 0) st[S_ANY] = 0u; }
            __syncthreads();
            const bool smp = stage <= 1;
            sweep<0>(F, A, Z, MASK, CANDW, qrow0, krow0, NT, smp ? t0 : 0, smp ? stride : 1, 0);
            { int tid_ = (int)threadIdx.x; asm volatile("" : "+v"(tid_)); const int ln = tid_ & 63;
              const int q = tid_ >> 3, seg = tid_ & 7; const LAS unsigned* h32 = hist32 + q * 256 + seg * 32;
              unsigned cnt = 0u;
              for (int i = 0; i < 32; ++i) { const unsigned wv = h32[i]; cnt += (wv & 0xffffu) + (wv >> 16); }
              unsigned above = 0u;
#pragma unroll
              for (int k = 0; k < 8; ++k) { const unsigned ck = __shfl(cnt, (ln & ~7) + k); if (k > seg) above += ck; }
              const unsigned ulo = st[S_ULO + q], uhi = st[S_UHI + q], sh = st[S_SH + q];
              if (smp) {
                  const unsigned pab = stage == 1 ? st[S_PAB + q] : 0u;
                  const unsigned t1 = (unsigned)r1 - (stage == 1 ? pab : 0u), t2 = (unsigned)r2 - (stage == 1 ? pab : 0u);
#pragma unroll
                  for (int which = 0; which < 2; ++which) { const unsigned tg = which ? t2 : t1;
                      if (above < tg && tg <= above + cnt) { unsigned run = above; int bstar = -1;
                          for (int i = 31; i >= 0; --i) { const unsigned wv = h32[i]; const unsigned c1 = wv >> 16, c0 = wv & 0xffffu;
                              if (bstar < 0) { if (run + c1 >= tg) bstar = seg * 64 + 2 * i + 1; else run += c1; }
                              if (bstar < 0) { if (run + c0 >= tg) bstar = seg * 64 + 2 * i; else run += c0; } }
                          if (which == 0) { st[S_PB1 + q] = (unsigned)bstar; if (stage == 0) st[S_PAB + q] = run; } else st[S_PB2 + q] = (unsigned)bstar; } }
              } else {
                  const unsigned need = st[S_NEED + q], active = st[S_ACT + q];
                  if (active && above < need && need <= above + cnt) {
                      unsigned run = above; int bstar = -1; unsigned cbin = 0u;
                      for (int i = 31; i >= 0; --i) { const unsigned wv = h32[i]; const unsigned c1 = wv >> 16, c0 = wv & 0xffffu;
                          if (bstar < 0) { if (run + c1 >= need) { bstar = seg * 64 + 2 * i + 1; cbin = c1; } else run += c1; }
                          if (bstar < 0) { if (run + c0 >= need) { bstar = seg * 64 + 2 * i; cbin = c0; } else run += c0; } }
                      const unsigned nlo = ulo + ((unsigned)bstar << sh); const unsigned long long e = (unsigned long long)nlo + ((1ull << sh) - 1ull);
                      const unsigned nhi = e > (unsigned long long)uhi ? uhi : (unsigned)e;
                      if (cbin <= (unsigned)CAPF || sh == 0u) { st[S_FLO + q] = nlo; st[S_FHI + q] = nhi; st[S_ACT + q] = 0u; st[S_ULO + q] = 1u; st[S_UHI + q] = 0u; }
                      else { st[S_ULO + q] = nlo; st[S_UHI + q] = nhi; st[S_SH + q] = sh >= 9u ? sh - 9u : 0u; st[S_NEED + q] = need - run; st[S_ANY] = 1u; }
                  }
              } }
            __syncthreads();
            if (stage == 0) {
                if (tid < 64) { const unsigned b1 = st[S_PB1 + tid], b2 = st[S_PB2 + tid]; const unsigned nlo = b2 << 23; const unsigned long long e = ((unsigned long long)(b1 + 1u) << 23) - 1ull;
                    const unsigned nhi = e > 0xFFFFFFFFull ? 0xFFFFFFFFu : (unsigned)e; st[S_ULO + tid] = nlo; st[S_UHI + tid] = nhi; st[S_SH + tid] = sh_for(nhi - nlo); st[S_PB1 + tid] = 511u; st[S_PB2 + tid] = 0u; }
                stage = 1;
            } else if (stage == 1) {
                if (tid < 64) { const unsigned b1 = st[S_PB1 + tid], b2 = st[S_PB2 + tid], ulo = st[S_ULO + tid], uhi = st[S_UHI + tid], sh = st[S_SH + tid];
                    const unsigned flo = ulo + (b2 << sh); const unsigned long long e = (unsigned long long)ulo + ((unsigned long long)(b1 + 1u) << sh) - 1ull;
                    st[S_FLO + tid] = flo; st[S_FHI + tid] = e > (unsigned long long)uhi ? uhi : (unsigned)e; }
                stage = 3;
            } else { const unsigned any = st[S_ANY]; if (!any) stage = 3; }
            __syncthreads();
        } else {
            const int vm = stage == 4 ? 1 : 0;
            if (vm) { if (tid < 64) { st[S_VMIN + tid] = 0xFFFFFFFFu; st[S_VMAX + tid] = 0u; st[S_VCNT + tid] = 0u; } __syncthreads(); }
            sweep<1>(F, A, Z, MASK, CANDW, qrow0, krow0, NT, 0, 1, vm);
            VM_WAIT(); __syncthreads();
            if (vm) { if (tid < 64) { if (st[S_VCNT + tid] != 256u || st[S_VMIN + tid] < st[S_VMAX + tid]) atomicOr(ERR, 1u); } __syncthreads(); break; }
            resolve(F, MASK, CANDW, qrow0, NT);
            VM_WAIT(); __syncthreads();
            unsigned nf = 0u;
            if (!after_fallback) { if (tid < 64) nf = st[S_FAIL + tid] & st[S_COL + tid]; nf = (unsigned)__syncthreads_or((int)nf); }
            if (nf) {
                if (tid < 64) { const unsigned f = st[S_FAIL + tid] & st[S_COL + tid]; st[S_ULO + tid] = f ? 0u : 1u; st[S_UHI + tid] = f ? 0xFFFFFFFFu : 0u; st[S_SH + tid] = 23u; st[S_NEED + tid] = 256u; st[S_ACT + tid] = f;
                    st[S_COL + tid] = f; if (f) { st[S_CCNT + tid] = 0u; st[S_ABOVE + tid] = 0u; } }
                __syncthreads();
                stage = 2; after_fallback = true;
            } else { if (IX_VERIFY) stage = 4; else break; }
        }
    }
}
}

namespace peer {
constexpr int TT = 16;
constexpr int SP = 129;
constexpr int OFF_S = 0, OFF_L = 256 * SP * 4;
constexpr int OFF_A = 0;
__device__ __forceinline__ void ins16(unsigned (&L)[16], unsigned x) {
#pragma unroll
    for (int j = 0; j < 16; ++j) { const unsigned a = L[j]; const unsigned mx = a > x ? a : x; x = a > x ? x : a; L[j] = mx; }
}
__device__ __forceinline__ float dot2bf(unsigned w, unsigned x, float acc) { return __builtin_amdgcn_fdot2_f32_bf16(__builtin_bit_cast(bf16x2_t, w), __builtin_bit_cast(bf16x2_t, x), acc, false); }
__device__ __forceinline__ float gelu_erf(float h) { return 0.5f * h * (1.f + erff(h * 0.70710678118654752f)); }

__device__ __forceinline__ void fp8dot4(unsigned w, f32x2 h01, f32x2 h23, f32x2& a0, f32x2& a1) {
    const f32x2 lo = __builtin_amdgcn_cvt_pk_f32_fp8((int)w, false), hi = __builtin_amdgcn_cvt_pk_f32_fp8((int)w, true); a0 = lo * h01 + a0; a1 = hi * h23 + a1; }
__device__ __forceinline__ void fp8axpy4(unsigned w, f32x2 a2, f32x2& c01, f32x2& c23) {
    const f32x2 lo = __builtin_amdgcn_cvt_pk_f32_fp8((int)w, false), hi = __builtin_amdgcn_cvt_pk_f32_fp8((int)w, true); c01 = lo * a2 + c01; c23 = hi * a2 + c23; }
constexpr int NSL = 16, SLW = 128;
__device__ __forceinline__ float dpp_sum8(float v) {
    v += __int_as_float(__builtin_amdgcn_update_dpp(0, __float_as_int(v), 0xB1, 0xF, 0xF, true));
    v += __int_as_float(__builtin_amdgcn_update_dpp(0, __float_as_int(v), 0x4E, 0xF, 0xF, true));
    v += __int_as_float(__builtin_amdgcn_update_dpp(0, __float_as_int(v), 0x141, 0xF, 0xF, true));
    return v;
}
#define PEER_EID(V0, V1, i) ((((i) < 8 ? (V0) : (V1))[((i) & 7) >> 1] >> (16 * ((i) & 1))) & 0xffffu)

struct TabCvt { const float* pu; const float* pv; unsigned char* UB; unsigned char* VB; float* RSU; float* RSV; };
__device__ __forceinline__ const float* tab_src(const TabCvt& T, int m) { return m < NEXP ? T.pu + (size_t)m * DM : T.pv + (size_t)(m - NEXP) * DM; }
__device__ __forceinline__ void tab_finish(const TabCvt& T, const RowF32& R, int m, int lane) { if (m < NEXP) row_to_fp8(R, T.UB + (size_t)m * DM, T.RSU + m, lane); else row_to_fp8(R, T.VB + (size_t)(m - NEXP) * DM, T.RSV + (m - NEXP), lane); }
__device__ __forceinline__ void route_step(const Frame& F, const bf16_t* PQ, const bf16x8 (&Bf)[2][8], unsigned short* E16, float* GT, int tok0, const TabCvt& T, int m0, int m1) {
    const int tid = F.tid, lane = F.lane, wave = F.wave, r = lane & 31, hi = lane >> 5;
    LAS float* S = (LAS float*)(F.lds + OFF_S); LAS unsigned* L = (LAS unsigned*)(F.lds + OFF_L);
    RowF32 R;
    if (m0 >= 0) row_load(R, tab_src(T, m0), lane);
    { const int half = wave & 1, cp = (wave >> 1) & 1, rh = wave >> 2;
#pragma unroll
      for (int r2 = 0; r2 < 2; ++r2) {
          const int rt = 2 * rh + r2; const int pair = 32 * rt + r, tok = pair >> 3, p = pair & 7;
          const bf16_t* src = PQ + (size_t)(tok0 + tok) * DM + p * 256 + half * 128 + 8 * hi;
          bf16x8 A[8];
#pragma unroll
          for (int ks = 0; ks < 8; ++ks) A[ks] = *(const bf16x8*)(src + ks * 16);
#pragma unroll
          for (int c2 = 0; c2 < 2; ++c2) {
              f32x16 acc = f32x16{};
#pragma unroll
              for (int ks = 0; ks < 8; ++ks) acc = __builtin_amdgcn_mfma_f32_32x32x16_bf16(A[ks], Bf[c2][ks], acc, 0, 0, 0);
#pragma unroll
              for (int i = 0; i < 16; ++i) { const int row = (32 * rt + (i & 3) + 8 * (i >> 2) + 4 * hi) * 2 + half; S[row * SP + (2 * cp + c2) * 32 + r] = acc[i]; }
          } } }
    if (m0 >= 0) tab_finish(T, R, m0, lane);
    if (m1 >= 0) row_load(R, tab_src(T, m1), lane);
    __syncthreads();
    { const int row = tid >> 1, part = tid & 1; unsigned L16[16];
#pragma unroll
      for (int j = 0; j < 16; ++j) L16[j] = 0u;
#pragma unroll 4
      for (int n = 0; n < 64; ++n) { const int nn = part * 64 + n; const unsigned k = (f2ord(S[row * SP + nn]) & ~127u) | (unsigned)(127 - nn); ins16(L16, k); }
      unsigned oth[16];
#pragma unroll
      for (int j = 0; j < 16; ++j) oth[j] = __shfl_xor(L16[j], 1);
#pragma unroll
      for (int j = 0; j < 16; ++j) ins16(L16, part == 0 ? oth[j] : 0u);
      if (part == 0) {
#pragma unroll
          for (int j = 0; j < 16; ++j) L[row * 16 + j] = L16[j]; } }
    __syncthreads();
    if (tid < 128) {
        const int pair = tid; const LAS float* S1 = S + (pair * 2) * SP; const LAS float* S2 = S + (pair * 2 + 1) * SP;
        const LAS unsigned* L1 = L + (pair * 2) * 16; const LAS unsigned* L2 = L1 + 16;
        float v1[16], v2[16];
#pragma unroll
        for (int j = 0; j < 16; ++j) { v1[j] = S1[127 - (L1[j] & 127u)]; v2[j] = S2[127 - (L2[j] & 127u)]; }
        unsigned C16[16];
#pragma unroll
        for (int j = 0; j < 16; ++j) C16[j] = 0u;
#pragma unroll
        for (int i = 0; i < 16; ++i)
#pragma unroll
            for (int j = 0; j < 16; ++j) if ((i + 1) * (j + 1) <= 16) { const unsigned k = (f2ord(v1[i] + v2[j]) & ~255u) | (unsigned)(255 - (i * 16 + j)); ins16(C16, k); }
        float sc[16]; unsigned ex[16]; float mx = -3.0e38f;
#pragma unroll
        for (int q = 0; q < 16; ++q) { const unsigned ci = 255u - (C16[q] & 255u); const unsigned n1 = 127u - (L1[ci >> 4] & 127u), n2 = 127u - (L2[ci & 15u] & 127u);
            sc[q] = S1[n1] + S2[n2]; ex[q] = n1 * 128u + n2; mx = fmaxf(mx, sc[q]); }
        float sum = 0.f;
#pragma unroll
        for (int q = 0; q < 16; ++q) { sc[q] = __expf(sc[q] - mx); sum += sc[q]; }
        const float inv = 1.f / sum;
        const size_t o = (size_t)(tok0 + (pair >> 3)) * 128 + (pair & 7) * 16;
        u32x4 e0, e1; e0.x = ex[0] | (ex[1] << 16); e0.y = ex[2] | (ex[3] << 16); e0.z = ex[4] | (ex[5] << 16); e0.w = ex[6] | (ex[7] << 16);
        e1.x = ex[8] | (ex[9] << 16); e1.y = ex[10] | (ex[11] << 16); e1.z = ex[12] | (ex[13] << 16); e1.w = ex[14] | (ex[15] << 16);
        *(u32x4*)(E16 + o) = e0; *(u32x4*)(E16 + o + 8) = e1;
#pragma unroll
        for (int q = 0; q < 4; ++q) *(f32x4*)(GT + o + 4 * q) = (f32x4){sc[4 * q] * inv, sc[4 * q + 1] * inv, sc[4 * q + 2] * inv, sc[4 * q + 3] * inv};
    }
    if (m1 >= 0) tab_finish(T, R, m1, lane);
    __syncthreads();
}

__device__ __forceinline__ void udot_compute(const u32x4 (&d)[16], const u32x4 h0, const u32x4 h1, float* dst, int k, bool ok) {
    f32x2 hq[8];
    hq[0] = (f32x2){bflo(h0.x), bfhi(h0.x)}; hq[1] = (f32x2){bflo(h0.y), bfhi(h0.y)}; hq[2] = (f32x2){bflo(h0.z), bfhi(h0.z)}; hq[3] = (f32x2){bflo(h0.w), bfhi(h0.w)};
    hq[4] = (f32x2){bflo(h1.x), bfhi(h1.x)}; hq[5] = (f32x2){bflo(h1.y), bfhi(h1.y)}; hq[6] = (f32x2){bflo(h1.z), bfhi(h1.z)}; hq[7] = (f32x2){bflo(h1.w), bfhi(h1.w)};
    float keep0 = 0.f, keep1 = 0.f;
#pragma unroll
    for (int i = 0; i < 16; ++i) {
        f32x2 a0 = {0.f, 0.f}, a1 = {0.f, 0.f};
        fp8dot4(d[i].x, hq[0], hq[1], a0, a1); fp8dot4(d[i].y, hq[2], hq[3], a0, a1); fp8dot4(d[i].z, hq[4], hq[5], a0, a1); fp8dot4(d[i].w, hq[6], hq[7], a0, a1);
        const float pr = dpp_sum8((a0.x + a0.y) + (a1.x + a1.y));
        if ((i & 7) == k) { if (i < 8) keep0 = pr; else keep1 = pr; }
    }
    if (ok) { dst[0] = keep0; dst[8] = keep1; }
}
__device__ __forceinline__ void udots(const Frame& F, const bf16_t* HN, const unsigned char* UB, const unsigned short* E16, float* PART) {
    const int lane = F.lane, g = lane >> 3, k = lane & 7;
    const int ngr = (F.G % 8 == 0) ? 8 : 1, wpg = F.G / ngr, x = F.vcu / wpg, wl = (F.vcu % wpg) * NWAVES + F.wave, wst = wpg * NWAVES, spg = NSL / ngr;
    const int ntw = (NTOK - wl + wst - 1) / wst;
#define UD_T(j) ((size_t)((wl + (j) * wst) < NTOK ? (wl + (j) * wst) : (NTOK - 1)))
#define UD_IDS(j, V0, V1) { const unsigned short* ep_ = E16 + UD_T(j) * 128 + g * 16; V0 = *(const u32x4*)ep_; V1 = *(const u32x4*)(ep_ + 8); }
#define UD_HN(j, H0, H1) { const bf16_t* hp_ = HN + UD_T(j) * DM + s * SLW + k * 16; H0 = *(const u32x4*)hp_; H1 = *(const u32x4*)(hp_ + 8); }
#define UD_ROWS(D, V0, V1) { _Pragma("unroll") for (int i = 0; i < 16; ++i) D[i] = *(const u32x4*)(ub + (size_t)PEER_EID(V0, V1, i) * DM); }
    for (int rr = 0; rr < spg; ++rr) {
        const int s = x + ngr * rr;
        const unsigned char* ub = UB + s * SLW + k * 16;
        float* pb = PART + (size_t)s * NTOK * 128 + g * 16 + k;
        u32x4 dA[16], dB[16], idA0, idA1, idB0, idB1, hA0, hA1, hB0, hB1;
        UD_IDS(0, idA0, idA1) UD_HN(0, hA0, hA1) UD_ROWS(dA, idA0, idA1)
        UD_IDS(1, idB0, idB1) UD_HN(1, hB0, hB1)
        for (int j = 0; j < ntw; j += 2) {
            UD_ROWS(dB, idB0, idB1)
            UD_IDS(j + 2, idA0, idA1)
            udot_compute(dA, hA0, hA1, pb + UD_T(j) * 128, k, true);
            UD_HN(j + 2, hA0, hA1)
            UD_ROWS(dA, idA0, idA1)
            UD_IDS(j + 3, idB0, idB1)
            udot_compute(dB, hB0, hB1, pb + UD_T(j + 1) * 128, k, j + 1 < ntw);
            UD_HN(j + 3, hB0, hB1)
        }
    }
#undef UD_IDS
#undef UD_HN
#undef UD_ROWS
}
__device__ __forceinline__ void combine(const Frame& F, const float* PART, const unsigned short* E16, const float* GT, const float* RSU, const float* RSV, float* AT) {
    const size_t n4 = (size_t)NTOK * 128 / 4, stride = (size_t)F.G * NWAVES * 64;
    for (size_t i = (size_t)F.vcu * NWAVES * 64 + F.tid; i < n4; i += stride) {
        f32x4 pv[NSL];
#pragma unroll
        for (int s = 0; s < NSL; ++s) pv[s] = *(const f32x4*)(PART + (size_t)s * n4 * 4 + i * 4);
        const u32x2 ee = *(const u32x2*)(E16 + i * 4); const f32x4 gg = *(const f32x4*)(GT + i * 4);
        const unsigned e0 = ee.x & 0xffffu, e1 = ee.x >> 16, e2 = ee.y & 0xffffu, e3 = ee.y >> 16;
        const float su0 = RSU[e0], su1 = RSU[e1], su2 = RSU[e2], su3 = RSU[e3], sv0 = RSV[e0], sv1 = RSV[e1], sv2 = RSV[e2], sv3 = RSV[e3];
        f32x4 sacc = pv[0];
#pragma unroll
        for (int s = 1; s < NSL; ++s) sacc += pv[s];
        f32x4 o; o.x = gg.x * gelu_erf(sacc.x * su0) * sv0; o.y = gg.y * gelu_erf(sacc.y * su1) * sv1; o.z = gg.z * gelu_erf(sacc.z * su2) * sv2; o.w = gg.w * gelu_erf(sacc.w * su3) * sv3;
        *(f32x4*)(AT + i * 4) = o;
    }
}
__device__ __forceinline__ void vacc_compute(const u32x4 (&d)[16], const f32x4 a0, const f32x4 a1, const f32x4 a2, const f32x4 a3, float* orow, int g, bool ok) {
    f32x2 acc[8];
#pragma unroll
    for (int c = 0; c < 8; ++c) acc[c] = (f32x2){0.f, 0.f};
    const float av[16] = {a0.x, a0.y, a0.z, a0.w, a1.x, a1.y, a1.z, a1.w, a2.x, a2.y, a2.z, a2.w, a3.x, a3.y, a3.z, a3.w};
#pragma unroll
    for (int i = 0; i < 16; ++i) { const f32x2 aa = {av[i], av[i]};
        fp8axpy4(d[i].x, aa, acc[0], acc[1]); fp8axpy4(d[i].y, aa, acc[2], acc[3]); fp8axpy4(d[i].z, aa, acc[4], acc[5]); fp8axpy4(d[i].w, aa, acc[6], acc[7]); }
    float v[16];
#pragma unroll
    for (int c = 0; c < 8; ++c) { v[2 * c] = acc[c].x; v[2 * c + 1] = acc[c].y; }
    float R[8], S4[4];
#pragma unroll
    for (int c = 0; c < 8; ++c) { auto r = __builtin_amdgcn_permlane32_swap(__float_as_uint(v[c]), __float_as_uint(v[c + 8]), false, false); R[c] = __uint_as_float(r[0]) + __uint_as_float(r[1]); }
#pragma unroll
    for (int c = 0; c < 4; ++c) { auto r = __builtin_amdgcn_permlane16_swap(__float_as_uint(R[c]), __float_as_uint(R[c + 4]), false, false); S4[c] = __uint_as_float(r[0]) + __uint_as_float(r[1]); }
    const bool b8 = (g & 1) != 0;
    float T0, T1;
    { const float keep = b8 ? S4[2] : S4[0], send = b8 ? S4[0] : S4[2]; T0 = keep + __int_as_float(__builtin_amdgcn_update_dpp(0, __float_as_int(send), 0x128, 0xF, 0xF, true)); }
    { const float keep = b8 ? S4[3] : S4[1], send = b8 ? S4[1] : S4[3]; T1 = keep + __int_as_float(__builtin_amdgcn_update_dpp(0, __float_as_int(send), 0x128, 0xF, 0xF, true)); }
    if (ok) { f32x2 o2 = *(const f32x2*)orow; o2.x += T0; o2.y += T1; *(f32x2*)orow = o2; }
}
__device__ __forceinline__ void vacc(const Frame& F, const unsigned char* VB, const unsigned short* E16, const float* AT, float* out) {
    const int lane = F.lane, g = lane >> 3, k = lane & 7;
    const int ngr = (F.G % 8 == 0) ? 8 : 1, wpg = F.G / ngr, x = F.vcu / wpg, wl = (F.vcu % wpg) * NWAVES + F.wave, wst = wpg * NWAVES, spg = NSL / ngr;
    const int ntw = (NTOK - wl + wst - 1) / wst;
#define UD_IDS(j, V0, V1) { const unsigned short* ep_ = E16 + UD_T(j) * 128 + g * 16; V0 = *(const u32x4*)ep_; V1 = *(const u32x4*)(ep_ + 8); }
#define VA_A(j, A0, A1, A2, A3) { const float* ap_ = AT + UD_T(j) * 128 + g * 16; A0 = *(const f32x4*)ap_; A1 = *(const f32x4*)(ap_ + 4); A2 = *(const f32x4*)(ap_ + 8); A3 = *(const f32x4*)(ap_ + 12); }
#define UD_ROWS(D, V0, V1) { _Pragma("unroll") for (int i = 0; i < 16; ++i) D[i] = *(const u32x4*)(vb + (size_t)PEER_EID(V0, V1, i) * DM); }
    for (int rr = 0; rr < spg; ++rr) {
        const int s = x + ngr * rr;
        const unsigned char* vb = VB + s * SLW + k * 16;
        float* ob = out + s * SLW + k * 16 + 2 * g;
        u32x4 dA[16], dB[16], idA0, idA1, idB0, idB1; f32x4 aA0, aA1, aA2, aA3, aB0, aB1, aB2, aB3;
        UD_IDS(0, idA0, idA1) VA_A(0, aA0, aA1, aA2, aA3) UD_ROWS(dA, idA0, idA1)
        UD_IDS(1, idB0, idB1) VA_A(1, aB0, aB1, aB2, aB3)
        for (int j = 0; j < ntw; j += 2) {
            UD_ROWS(dB, idB0, idB1)
            UD_IDS(j + 2, idA0, idA1)
            vacc_compute(dA, aA0, aA1, aA2, aA3, ob + UD_T(j) * DM, g, true);
            VA_A(j + 2, aA0, aA1, aA2, aA3)
            UD_ROWS(dA, idA0, idA1)
            UD_IDS(j + 3, idB0, idB1)
            vacc_compute(dB, aB0, aB1, aB2, aB3, ob + UD_T(j + 1) * DM, g, j + 1 < ntw);
            VA_A(j + 3, aB0, aB1, aB2, aB3)
        }
    }
#undef UD_T
#undef UD_IDS
#undef VA_A
#undef UD_ROWS
}
}

__device__ __forceinline__ void pool_unit(const Frame& F, bf16_t* MIX, const bf16_t* PWt, const float* pool_s, int tm, int g) {
    const int lane = F.lane, r = lane & 31, hi = lane >> 5;
    bf16_t* base = MIX + (size_t)(tm * 256 + F.wave * 32) * DM + 1024 + 128 * g;
    bf16x8 A[8];
#pragma unroll
    for (int ks = 0; ks < 8; ++ks) A[ks] = *(const bf16x8*)(base + (size_t)r * DM + ks * 16 + 8 * hi);
#pragma unroll
    for (int ct = 0; ct < 4; ++ct) {
        f32x16 acc = f32x16{};
        const bf16_t* pb = PWt + (size_t)(g * 128 + ct * 32 + r) * 128 + 8 * hi;
#pragma unroll
        for (int ks = 0; ks < 8; ++ks) { const bf16x8 B = *(const bf16x8*)(pb + ks * 16); acc = __builtin_amdgcn_mfma_f32_32x32x16_bf16(A[ks], B, acc, 0, 0, 0); }
        const float sc = pool_s[128 * g + ct * 32 + r];
#pragma unroll
        for (int i = 0; i < 16; ++i) { const int row = (i & 3) + 8 * (i >> 2) + 4 * hi; base[(size_t)row * DM + ct * 32 + r] = (bf16_t)(cvtpk(acc[i] * sc, 0.f) & 0xffffu); }
    }
}

__global__ void __launch_bounds__(NWAVES * 64, 2) fwd_kernel(Args args) {
    extern __shared__ __attribute__((aligned(16))) unsigned char lds[];
    Frame F;
    F.lds = (LAS unsigned char*)lds; F.ldsg = (char*)lds;
    F.tid = threadIdx.x; F.lane = F.tid & 63; F.wave = __builtin_amdgcn_readfirstlane(F.tid >> 6);
    F.G = gridDim.x; { const int bx = blockIdx.x; F.vcu = (F.G % 8 == 0) ? (bx % 8) * (F.G / 8) + bx / 8 : bx; }
    unsigned char* ws = args.ws;
    unsigned* ctl = (unsigned*)(ws + WS_CTL);
    volatile LAS unsigned* MISC = (volatile LAS unsigned*)(F.lds + MISC_OFF);
    for (int u = F.tid; u < (LDS_BYTES - LDSCTL_OFF) / 4; u += NWAVES * 64) ((LAS unsigned*)(F.lds + LDSCTL_OFF))[u] = 0u;
    __syncthreads();
    const int lo = args.ph_lo, hi = args.ph_hi;
    XcdBarrier bar; bar.bar = ctl + CW_BAR; bar.x = 0; bar.st = nullptr;
    if (hi - lo > 1) bar = xcd_barrier_post(ctl + CW_BAR, MISC + 8);
#define IN(k) (lo <= (k) && (k) < hi)
#define PHASE_BEGIN() do { int t_ = (int)threadIdx.x; asm volatile("" : "+v"(t_)); F.tid = t_; F.lane = t_ & 63; } while (0)
#define SEAM(k) do { if (IN(k) && IN((k) + 1)) xcd_barrier(bar); } while (0)

    bf16_t* Z = (bf16_t*)(ws + WS_Z); bf16_t* XN = (bf16_t*)(ws + WS_XN); bf16_t* MIX = XN;
    bf16_t* HN = (bf16_t*)(ws + WS_Z); bf16_t* PQ = (bf16_t*)(ws + WS_Z + 128 * MiB);
    bf16_t* KVM = (bf16_t*)(ws + WS_KVM); unsigned* MASK = (unsigned*)(ws + WS_MASK);

    if (IN(0)) { PHASE_BEGIN(); p0_prologue(F, args); } SEAM(0);
    if (IN(1)) { PHASE_BEGIN();
#if P1_FP8
        const int gw = F.vcu * NWAVES + F.wave, NGW = F.G * NWAVES;
        for (int i = gw; i < 4096; i += NGW) { const int n = i < 3072 ? i : i + 1024; RowF32 R; row_load_bf16(R, (const bf16_t*)(ws + WS_BT_IN) + (size_t)n * DM, F.lane); row_to_fp8(R, ws + WS_BTIN8 + (size_t)n * DM, (float*)(ws + WS_CSI) + n, F.lane); }
#endif
    } SEAM(1);
    if (IN(2)) { PHASE_BEGIN();
#if P1_FP8
        { pg8::Gemm g{XN, (const bf16_t*)(ws + WS_BT_IN), NTOK, ZLD, DM}; pg8::InBf16Order S; S.init(NTOK, F.G, (int)blockIdx.x);
          pg8::EpiBf16 E{Z, ZLD}; pg8::gemm_phase<pg8::EpiBf16, pg8::InBf16Order, true, true>(F.lds, g, S, E); }
        { pg8::Gemm g{(const bf16_t*)(ws + WS_XN8), (const bf16_t*)(ws + WS_BTIN8), NTOK, ZLD, DM / 2}; pg8::InFp8Order S; S.init(NTOK, F.G, (int)blockIdx.x);
          pg8::EpiBf16S E{Z, ZLD, (const float*)(ws + WS_CSI)}; pg8::gemm_phase<pg8::EpiBf16S, pg8::InFp8Order, true, true, true>(F.lds, g, S, E); }
#else
        { pg8::Gemm g{XN, (const bf16_t*)(ws + WS_BT_IN), NTOK, ZLD, DM}; pg8::StaticOrder S; S.init(NTOK, ZLD, F.G, (int)blockIdx.x);
          pg8::EpiBf16 E{Z, ZLD}; pg8::gemm_phase<pg8::EpiBf16, pg8::StaticOrder, true, true>(F.lds, g, S, E); }
#endif
        { pg8::Gemm g{(const bf16_t*)(ws + WS_MN), (const bf16_t*)(ws + WS_BT_KV), BATCH * MEMLEN, 1024, DM}; pg8::StaticOrder S; S.init(BATCH * MEMLEN, 1024, F.G, (int)((blockIdx.x + 128) % F.G));
          pg8::EpiBf16 E{KVM, 1024}; pg8::gemm_phase<pg8::EpiBf16, pg8::StaticOrder, true, true>(F.lds, g, S, E); }
    } SEAM(2);
    if (IN(3)) { PHASE_BEGIN(); p2_post(F, args);
#if PV_FP8
        PHASE_BEGIN(); p2_vt(F, args);
#endif
    } SEAM(3);
    if (IN(4)) { PHASE_BEGIN();
        for (int i = 0; ; ++i) {
            int b, c;
            if (F.G == 256) { if (i >= 2) break; b = F.vcu >> 7; c = (i == 0) ? 255 - (F.vcu & 127) : (F.vcu & 127); }
            else { const int u = (int)blockIdx.x + i * F.G; if (u >= 512) break; b = u >> 8; c = u & 255; }
            ix::unit(F, Z, MASK, (unsigned long long*)(ws + WS_CAND) + (size_t)blockIdx.x * 64 * ix::CAPB, ctl + 2048, b, c);
            __syncthreads();
        }
    } SEAM(4);
    if (IN(5)) { PHASE_BEGIN();
        for (int u = F.vcu; u < (NTOK / 256) * 4; u += F.G) pool_unit(F, MIX, (const bf16_t*)(ws + WS_PWT), args.pool_s, u >> 2, u & 3);
        const int r32 = F.lane & 31;
        for (int i = 0; ; ++i) {
            int b, h, qb;
            if (F.G == 256) { if (i >= 4) break; const int bh = F.vcu >> 4, s = F.vcu & 15; b = bh >> 3; h = bh & 7; qb = (i == 0) ? 63 - s : (i == 1) ? 32 + s : (i == 2) ? 31 - s : s; }
            else { const int u = (int)blockIdx.x + i * F.G; if (u >= 1024) break; b = u >> 9; h = (u >> 6) & 7; qb = u & 63; }
            const size_t row0 = (size_t)b * SEQ + 256 * qb;
            const unsigned long long* mrow = (const unsigned long long*)MASK + (row0 + F.wave * 32 + r32) * (MASK_WPR / 2);
#if QK_FP8
            att::attn_body<true, 2, ZLD, ZLD, DM, true, PV_FP8 != 0>(Z + row0 * ZLD + ZC_Q + h * 128, Z + (size_t)b * SEQ * ZLD + ZC_K + h * 128, Z + (size_t)b * SEQ * ZLD + ZC_V + h * 128,
                                                        MIX + row0 * DM + h * 128, 256 * (qb + 1), mrow, F.ldsg, ws + WS_Q8 + row0 * 1024 + h * 128, ws + WS_K8 + (size_t)b * SEQ * 1024 + h * 128,
                                                        ws + WS_V8T + (size_t)(b * 8 + h) * 256 * 8192);
#else
            att::attn_body<true, 2, ZLD, ZLD, DM>(Z + row0 * ZLD + ZC_Q + h * 128, Z + (size_t)b * SEQ * ZLD + ZC_K + h * 128, Z + (size_t)b * SEQ * ZLD + ZC_V + h * 128,
                                                  MIX + row0 * DM + h * 128, 256 * (qb + 1), mrow, F.ldsg);
#endif
        }
        for (int id = F.vcu; id < 512; id += F.G) {
            const int b2 = id >> 8, hm = (id >> 6) & 3, qb = id & 63; const size_t row0 = (size_t)b2 * SEQ + 256 * qb;
            att::attn_body<false, 1, ZLD, 1024, DM>(Z + row0 * ZLD + ZC_QM + hm * 128, KVM + (size_t)b2 * MEMLEN * 1024 + hm * 128, KVM + (size_t)b2 * MEMLEN * 1024 + 512 + hm * 128,
                                                    MIX + row0 * DM + 1536 + hm * 128, MEMLEN, nullptr, F.ldsg);
        }
    } SEAM(5);
    if (IN(6)) { PHASE_BEGIN();
#if ATT_VERIFY
        {
            const int t = (int)blockIdx.x * 128 + 77, hh = F.wave, ln = F.lane; const int bb = t / SEQ, pos = t % SEQ, N = 64 * (pos / 64 + 1);
            const bf16_t* zq = Z + (size_t)t * ZLD + ZC_Q + hh * 128 + 2 * ln; const float q0 = bflo((unsigned)zq[0]), q1 = bflo((unsigned)zq[1]);
            float m = -3.0e38f, l = 0.f, o0 = 0.f, o1 = 0.f; int nsel = 0;
            for (int w = 0; w < N / 32; ++w) { unsigned bits = __hip_atomic_load(MASK + (size_t)t * MASK_WPR + w, __ATOMIC_RELAXED, __HIP_MEMORY_SCOPE_AGENT);
                while (bits) { const int bpos = __builtin_ctz(bits); bits &= bits - 1u; const int sidx = 32 * w + bpos; ++nsel;
                    const bf16_t* zk = Z + ((size_t)bb * SEQ + sidx) * ZLD + ZC_K + hh * 128 + 2 * ln; const bf16_t* zv = Z + ((size_t)bb * SEQ + sidx) * ZLD + ZC_V + hh * 128 + 2 * ln;
                    const float lg = wave_sum(q0 * bflo((unsigned)zk[0]) + q1 * bflo((unsigned)zk[1])) * 0.088388347648318440f;
                    const float mn = fmaxf(m, lg), al = __expf(m - mn), pe = __expf(lg - mn); l = l * al + pe; o0 = o0 * al + pe * bflo((unsigned)zv[0]); o1 = o1 * al + pe * bflo((unsigned)zv[1]); m = mn; } }
            const bf16_t* mx = MIX + (size_t)t * DM + hh * 128 + 2 * ln; const float r0 = o0 / l, r1 = o1 / l;
            float er = fmaxf(fabsf(r0 - bflo((unsigned)mx[0])), fabsf(r1 - bflo((unsigned)mx[1]))), sc = fmaxf(fabsf(r0), fabsf(r1));
#pragma unroll
            for (int o = 1; o < 64; o <<= 1) { er = fmaxf(er, __shfl_xor(er, o)); sc = fmaxf(sc, __shfl_xor(sc, o)); }
            if (!(er <= (QK_FP8 ? 0.12f : 0.03f) * sc + (QK_FP8 ? 4e-3f : 1e-3f)) || nsel != (N < 256 ? N : 256)) { if (ln == 0) atomicOr(ctl + 2048, 2u); }
        }
        __syncthreads();
#endif
        pg8::Gemm g{MIX, (const bf16_t*)(ws + WS_BT_OUT), NTOK, DM, DM}; pg8::StaticOrder S; S.init(NTOK, DM, F.G, (int)blockIdx.x);
        pg8::EpiF32Res E{args.x, args.out, DM}; pg8::gemm_phase<pg8::EpiF32Res, pg8::StaticOrder, true, true>(F.lds, g, S, E);
    } SEAM(6);
    if (IN(7)) { PHASE_BEGIN(); const int gw = F.vcu * NWAVES + F.wave, NGW = F.G * NWAVES;
#if P7_FP8
        for (int n = gw; n < DM; n += NGW) { RowF32 R; row_load_bf16(R, (const bf16_t*)(ws + WS_BT_Q) + (size_t)n * DM, F.lane); row_to_fp8(R, ws + WS_BTQ8 + (size_t)n * DM, (float*)(ws + WS_CSQ) + n, F.lane); }
        for (int m = gw; m < NTOK; m += NGW) rms_row_to_bf16_fp8(args.out + (size_t)m * DM, args.ffn_g, HN + (size_t)m * DM, ws + WS_HN8 + (size_t)m * DM, F.lane);
#else
        for (int m = gw; m < NTOK; m += NGW) rms_row_to_bf16(args.out + (size_t)m * DM, args.ffn_g, HN + (size_t)m * DM, F.lane);
#endif
    } SEAM(7);
    if (IN(8)) { PHASE_BEGIN();
#if P7_FP8
        pg8::Gemm g{(const bf16_t*)(ws + WS_HN8), (const bf16_t*)(ws + WS_BTQ8), NTOK, DM, DM / 2}; pg8::StaticOrder S; S.init(NTOK, DM, F.G, (int)blockIdx.x);
        pg8::EpiBf16S E{PQ, DM, (const float*)(ws + WS_CSQ)}; pg8::gemm_phase<pg8::EpiBf16S, pg8::StaticOrder, true, true, true>(F.lds, g, S, E);
#else
        pg8::Gemm g{HN, (const bf16_t*)(ws + WS_BT_Q), NTOK, DM, DM}; pg8::StaticOrder S; S.init(NTOK, DM, F.G, (int)blockIdx.x);
        pg8::EpiBf16 E{PQ, DM}; pg8::gemm_phase<pg8::EpiBf16, pg8::StaticOrder, true, true>(F.lds, g, S, E);
#endif
    } SEAM(8);
    unsigned short* E16 = (unsigned short*)(ws + WS_XN); float* GT = (float*)(ws + WS_XN + 8 * MiB); float* AT = (float*)(ws + WS_XN + 24 * MiB);
    float* PART = (float*)(ws + WS_Z + 128 * MiB);
    if (IN(9)) { PHASE_BEGIN();
        const bf16_t* PKb = (const bf16_t*)(ws + WS_PK);
        bf16x8 Bf[2][8];
        { const int half = F.wave & 1, cp = (F.wave >> 1) & 1, r = F.lane & 31, hi = F.lane >> 5;
#pragma unroll
          for (int c2 = 0; c2 < 2; ++c2)
#pragma unroll
              for (int ks = 0; ks < 8; ++ks) Bf[c2][ks] = *(const bf16x8*)(PKb + (size_t)(half * 128 + (2 * cp + c2) * 32 + r) * 128 + 8 * hi + ks * 16); }
        const peer::TabCvt T{args.pu, args.pv, ws + WS_UB, ws + WS_VB, (float*)(ws + WS_RSU), (float*)(ws + WS_RSV)};
        const int gw = F.vcu * NWAVES + F.wave, NGW = F.G * NWAVES; int mrow = gw, nstep = 0;
        for (int it = F.vcu; it < NTOK / peer::TT; it += F.G, ++nstep) {
            const int m0 = mrow < 2 * NEXP ? mrow : -1; mrow += NGW; const int m1 = mrow < 2 * NEXP ? mrow : -1; mrow += NGW;
            peer::route_step(F, PQ, Bf, E16, GT, it * peer::TT, T, m0, m1);
        }
        for (; mrow < 2 * NEXP; mrow += NGW) { RowF32 R; row_load(R, peer::tab_src(T, mrow), F.lane); peer::tab_finish(T, R, mrow, F.lane); }
    } SEAM(9);
    if (IN(10)) { PHASE_BEGIN(); peer::udots(F, HN, ws + WS_UB, E16, PART); } SEAM(10);
    if (IN(11)) { PHASE_BEGIN(); peer::combine(F, PART, E16, GT, (const float*)(ws + WS_RSU), (const float*)(ws + WS_RSV), AT); } SEAM(11);
    if (IN(12)) { PHASE_BEGIN(); peer::vacc(F, ws + WS_VB, E16, AT, args.out); }
#if IX_VERIFY || ATT_VERIFY
    if (IN(12)) { __syncthreads(); if (__hip_atomic_load(ctl + 2048, __ATOMIC_RELAXED, __HIP_MEMORY_SCOPE_AGENT) != 0u) { args.out[(size_t)blockIdx.x * 512 + threadIdx.x] = __builtin_nanf(""); } }
#endif
#undef IN
#undef SEAM
}

extern "C" void kernel_launch(void* const* d_in, const int* in_sizes, int n_in, void* d_out, int out_size, void* d_ws, size_t ws_size, hipStream_t stream) {
    static int grid = 0;
    if (grid == 0) {
        if (n_in != 19 || out_size != NTOK * DM || ws_size < WS_END) { fprintf(stderr, "kernel_launch: unexpected shapes (n_in %d out %d ws %zu)\n", n_in, out_size, ws_size); grid = -1; return; }
        int dev = 0, cus = 0;
        if (hipGetDevice(&dev) != hipSuccess || hipDeviceGetAttribute(&cus, hipDeviceAttributeMultiprocessorCount, dev) != hipSuccess) { grid = -1; return; }
        if (hipFuncSetAttribute((const void*)fwd_kernel, hipFuncAttributeMaxDynamicSharedMemorySize, LDS_BYTES) != hipSuccess) { fprintf(stderr, "kernel_launch: hipFuncSetAttribute failed\n"); grid = -1; return; }
        int per_cu = 0;
        if (hipOccupancyMaxActiveBlocksPerMultiprocessor(&per_cu, (const void*)fwd_kernel, NWAVES * 64, LDS_BYTES) != hipSuccess || per_cu < 1) { fprintf(stderr, "kernel_launch: occupancy query reports %d workgroups per CU for %d threads / %d B LDS; nothing launched\n", per_cu, NWAVES * 64, LDS_BYTES); grid = -1; return; }
        (void)hipGetLastError();
        grid = cus;
    }
    if (grid < 0) return;
    (void)hipMemsetAsync((char*)d_ws + WS_CTL, 0, CTL_ZERO_BYTES, stream);
    Args a{};
    a.x = (const float*)d_in[0]; a.mem = (const float*)d_in[1]; a.attn_g = (const float*)d_in[2]; a.w_in = (const float*)d_in[3]; a.q_g = (const float*)d_in[4]; a.k_g = (const float*)d_in[5];
    a.pool_w = (const float*)d_in[6]; a.pool_s = (const float*)d_in[7]; a.mem_g = (const float*)d_in[8]; a.w_kv = (const float*)d_in[9]; a.mq_g = (const float*)d_in[10]; a.mk_g = (const float*)d_in[11];
    a.w_out = (const float*)d_in[12]; a.ffn_g = (const float*)d_in[13]; a.w_q = (const float*)d_in[14]; a.sk1 = (const float*)d_in[15]; a.sk2 = (const float*)d_in[16];
    a.pu = (const float*)d_in[17]; a.pv = (const float*)d_in[18]; a.out = (float*)d_out; a.ws = (unsigned char*)d_ws;
#if MK_ONE_LAUNCH
    a.ph_lo = 0; a.ph_hi = N_PHASES;
    hipLaunchKernelGGL(fwd_kernel, dim3(grid), dim3(NWAVES * 64), LDS_BYTES, stream, a);
#else
    for (int p = 0; p < N_PHASES; ++p) { a.ph_lo = p; a.ph_hi = p + 1; hipLaunchKernelGGL(fwd_kernel, dim3(grid), dim3(NWAVES * 64), LDS_BYTES, stream, a); }
#endif
}
```

```cpp
#include <hip/hip_runtime.h>
#include <hip/hip_bf16.h>
#include <cstdio>
#include <cstdint>

#ifndef IX_VERIFY
#define IX_VERIFY 0
#endif
#ifndef ATT_VERIFY
#define ATT_VERIFY 0
#endif
#ifndef MK_ONE_LAUNCH
#define MK_ONE_LAUNCH 1
#endif
#ifndef P1_FP8
#define P1_FP8 1
#endif
#ifndef QK_FP8
#define QK_FP8 1
#endif
#ifndef PV_FP8
#define PV_FP8 1
#endif
#ifndef P7_FP8
#define P7_FP8 0
#endif

#define GAS __attribute__((address_space(1)))
#define LAS __attribute__((address_space(3)))
typedef unsigned short bf16_t;
typedef short bf16x8 __attribute__((ext_vector_type(8)));
typedef short s16x4 __attribute__((ext_vector_type(4)));
typedef float f32x4 __attribute__((ext_vector_type(4)));
typedef float f32x2 __attribute__((ext_vector_type(2)));
typedef float f32x16 __attribute__((ext_vector_type(16)));
typedef unsigned u32x4 __attribute__((ext_vector_type(4)));
typedef unsigned u32x2 __attribute__((ext_vector_type(2)));
typedef __bf16 bf16x2_t __attribute__((ext_vector_type(2)));
typedef int i32x8 __attribute__((ext_vector_type(8)));
typedef int i32x4 __attribute__((ext_vector_type(4)));

constexpr int BATCH = 2, SEQ = 16384, DM = 2048, NTOK = BATCH * SEQ, MEMLEN = 256;
constexpr int IN_W = 5200, ZLD = 5376;
constexpr int ZC_Q = 0, ZC_K = 1024, ZC_V = 2048, ZC_QI = 3072, ZC_PU = 4096, ZC_QM = 4608, ZC_KI = 5120, ZC_WI = 5184;
constexpr int NEXP = 16384;
constexpr float EPS = 1e-6f;
constexpr int MASK_WPR = 512;

constexpr size_t MiB = 1u << 20;
constexpr size_t WS_CTL = 0, CTL_ZERO_BYTES = 1 * MiB;
constexpr size_t WS_BT_IN = 2 * MiB;
constexpr size_t WS_BT_OUT = 24 * MiB;
constexpr size_t WS_BT_Q = 32 * MiB;
constexpr size_t WS_BT_KV = 40 * MiB;
constexpr size_t WS_MN = 44 * MiB;
constexpr size_t WS_KVM = 46 * MiB;
constexpr size_t WS_PK = 47 * MiB;
constexpr size_t WS_PWT = 47 * MiB + 512 * 1024;
constexpr size_t WS_XN = 48 * MiB;
constexpr size_t WS_Z = 176 * MiB;
constexpr size_t WS_MASK = 512 * MiB;
constexpr size_t WS_UB = 576 * MiB;
constexpr size_t WS_VB = 640 * MiB;
constexpr size_t WS_RSU = 47 * MiB + 128 * 1024, WS_RSV = 47 * MiB + 256 * 1024;
constexpr size_t WS_ROPE = 704 * MiB;
constexpr size_t WS_CAND = 720 * MiB;
constexpr size_t WS_Q8 = WS_UB, WS_K8 = WS_UB + 32 * MiB;
constexpr size_t WS_V8T = WS_VB;
constexpr size_t WS_XN8 = WS_CAND, WS_BTIN8 = WS_CAND + 72 * MiB, WS_CSI = WS_CAND + 84 * MiB;
constexpr size_t WS_HN8 = WS_CAND, WS_BTQ8 = WS_CAND + 64 * MiB, WS_CSQ = WS_CAND + 68 * MiB;
constexpr size_t WS_END = 848 * MiB;
constexpr int CW_BAR = 4096;

#define LDS_WAIT() asm volatile("s_waitcnt lgkmcnt(0)" ::: "memory")
#define VM_WAIT() asm volatile("s_waitcnt vmcnt(0)" ::: "memory")
__device__ __forceinline__ unsigned cvtpk(float lo, float hi) { f32x2 v = {lo, hi}; bf16x2_t b = __builtin_convertvector(v, bf16x2_t); return __builtin_bit_cast(unsigned, b); }
__device__ __forceinline__ float bflo(unsigned w) { return __uint_as_float(w << 16); }
__device__ __forceinline__ float bfhi(unsigned w) { return __uint_as_float(w & 0xffff0000u); }
__device__ __forceinline__ float wave_sum(float v) {
#pragma unroll
    for (int o = 1; o < 64; o <<= 1) v += __shfl_xor(v, o);
    return v;
}
__device__ __forceinline__ unsigned f2ord(float s) { unsigned u = __float_as_uint(s); return u ^ (((unsigned)((int)u >> 31)) | 0x80000000u); }

namespace pg8 {
#define PG8_LAS __attribute__((address_space(3)))
constexpr int BM = 256, BK = 64, HALF = 128, HTB = HALF * BK * 2, STAGE_BYTES = 8 * HTB, NXCD = 8, WGM = 8;
__host__ __device__ __forceinline__ int lds_byte(int r, int c) { const int st = (r >> 4) * 2 + (c >> 5), rr = r & 15, cc = c & 31, ob = rr * 64 + cc * 2; return st * 1024 + (ob ^ (((ob >> 9) & 1) << 5)); }
__host__ __device__ __forceinline__ void stage_rc(int b, int& R, int& C) { const int st = b / 1024, sb = b % 1024, swz = sb ^ (((sb >> 9) & 1) << 5); R = (st >> 1) * 16 + swz / 64; C = (st & 1) * 32 + (swz % 64) / 2; }
__host__ __device__ __forceinline__ int perm32(int rho) { const int n = rho >> 4, i = rho & 15; return 8 * (i >> 2) + 4 * n + (i & 3); }
struct Unit { int pm, pn; };
struct Gemm { const bf16_t* A; const bf16_t* Bt; int M, N, K; };
struct StaticOrder {
    int nM, nN, nwg, G, c;
    __host__ __device__ void init(int M, int N, int G_, int c_) { nM = M / BM; nN = N / BM; nwg = nM * nN; G = G_; c = c_; }
    __host__ __device__ bool next(int i, Unit& u) const {
        const long L = (long)i * G + c; if (L >= nwg) return false;
        int wgid = (int)L; { const int q = nwg / NXCD, r = nwg % NXCD, xcd = wgid % NXCD, off = wgid / NXCD; wgid = (xcd < r ? xcd * (q + 1) : r * (q + 1) + (xcd - r) * q) + off; }
        const int nig = WGM * nN, gid = wgid / nig, fm = gid * WGM, gsz = (nM - fm) < WGM ? (nM - fm) : WGM;
        u.pm = fm + ((wgid % nig) % gsz); u.pn = (wgid % nig) / gsz; return true;
    }
    __device__ __forceinline__ void a_ready(const Unit&) const {}
    __device__ __forceinline__ void done(const Unit&) const {}
};
struct InBf16Order {
    StaticOrder S;
    __host__ __device__ void init(int M, int G_, int c_) { S.init(M, 5 * BM, G_, c_); }
    __host__ __device__ bool next(int i, Unit& u) const { if (!S.next(i, u)) return false; u.pn = u.pn < 4 ? 12 + u.pn : 20; return true; }
    __device__ __forceinline__ void a_ready(const Unit&) const {}
    __device__ __forceinline__ void done(const Unit&) const {}
};
struct InFp8Order {
    StaticOrder S; int G, c;
    __host__ __device__ void init(int M, int G_, int c_) { S.init(M, 16 * BM, 1, 0); G = G_; c = c_; }
    __host__ __device__ bool next(int i, Unit& u) const {
        long L;
        if (G == 256 && S.nwg == 2048) {
            if (i < 7) L = (long)i * 256 + c;
            else if (c < 128) return false;
            else { const int j = i - 7; int base, cnt;
                if (c < 136) { base = (c - 128) * 1; cnt = 1; } else if (c < 144) { base = 8 + (c - 136) * 3; cnt = 3; } else { base = 32 + (c - 144) * 2; cnt = 2; }
                if (j >= cnt) return false; L = 1792 + base + j; }
        } else { L = (long)i * G + c; if (L >= S.nwg) return false; }
        if (!S.next((int)L, u)) return false;
        u.pn = u.pn < 12 ? u.pn : u.pn + 4; return true;
    }
    __device__ __forceinline__ void a_ready(const Unit&) const {}
    __device__ __forceinline__ void done(const Unit&) const {}
};
struct EpiBf16 {
    static constexpr bool PERM = true, AFTER_DRAIN = false;
    bf16_t* O; int ldc;
    __device__ __forceinline__ void operator()(const f32x4 (&acc)[2][2][4][2], const Unit& u, int wr, int wc, int fr, int fq) const {
        const int row0 = u.pm * BM + wr * 64 + fr; const int col0 = u.pn * BM + wc * 32 + 8 * fq;
#pragma unroll
        for (int ai = 0; ai < 2; ++ai)
#pragma unroll
            for (int m = 0; m < 4; ++m) { bf16_t* rowp = O + (size_t)(row0 + ai * HALF + m * 16) * ldc + col0;
#pragma unroll
                for (int bj = 0; bj < 2; ++bj) { const f32x4 v0 = acc[ai][bj][m][0], v1 = acc[ai][bj][m][1];
                    u32x4 w; w.x = cvtpk(v0[0], v0[1]); w.y = cvtpk(v0[2], v0[3]); w.z = cvtpk(v1[0], v1[1]); w.w = cvtpk(v1[2], v1[3]);
                    *(u32x4*)(rowp + bj * HALF) = w; } }
    }
};
struct EpiBf16S {
    static constexpr bool PERM = true, AFTER_DRAIN = false;
    bf16_t* O; int ldc; const float* cs;
    __device__ __forceinline__ void operator()(const f32x4 (&acc)[2][2][4][2], const Unit& u, int wr, int wc, int fr, int fq) const {
        const int row0 = u.pm * BM + wr * 64 + fr; const int col0 = u.pn * BM + wc * 32 + 8 * fq;
        f32x4 s[2][2];
#pragma unroll
        for (int bj = 0; bj < 2; ++bj) { s[bj][0] = *(const f32x4*)(cs + col0 + bj * HALF); s[bj][1] = *(const f32x4*)(cs + col0 + bj * HALF + 4); }
#pragma unroll
        for (int ai = 0; ai < 2; ++ai)
#pragma unroll
            for (int m = 0; m < 4; ++m) { bf16_t* rowp = O + (size_t)(row0 + ai * HALF + m * 16) * ldc + col0;
#pragma unroll
                for (int bj = 0; bj < 2; ++bj) { const f32x4 v0 = acc[ai][bj][m][0] * s[bj][0], v1 = acc[ai][bj][m][1] * s[bj][1];
                    u32x4 w; w.x = cvtpk(v0[0], v0[1]); w.y = cvtpk(v0[2], v0[3]); w.z = cvtpk(v1[0], v1[1]); w.w = cvtpk(v1[2], v1[3]);
                    *(u32x4*)(rowp + bj * HALF) = w; } }
    }
};
struct EpiF32Res {
    static constexpr bool PERM = false, AFTER_DRAIN = false;
    const float* R; float* C; int ldc;
    __device__ __forceinline__ void operator()(const f32x4 (&acc)[2][2][4][2], const Unit& u, int wr, int wc, int fr, int fq) const {
        const int row0 = u.pm * BM + wr * 64 + fr, col0 = u.pn * BM + wc * 32 + 4 * fq;
#pragma unroll
        for (int ai = 0; ai < 2; ++ai)
#pragma unroll
            for (int m = 0; m < 4; ++m) { const size_t off = (size_t)(row0 + ai * HALF + m * 16) * ldc + col0;
#pragma unroll
                for (int bj = 0; bj < 2; ++bj)
#pragma unroll
                    for (int n = 0; n < 2; ++n) *(f32x4*)(C + off + bj * HALF + n * 16) = acc[ai][bj][m][n] + *(const f32x4*)(R + off + bj * HALF + n * 16); }
    }
};

__device__ __forceinline__ i32x8 cat8(bf16x8 a, bf16x8 b) { const i32x4 x = __builtin_bit_cast(i32x4, a), y = __builtin_bit_cast(i32x4, b); return __builtin_shufflevector(x, y, 0, 1, 2, 3, 4, 5, 6, 7); }
template <class Epi, class Sched, bool ALIGN_EPI = false, bool SP2 = false, bool F8 = false>
__device__ __forceinline__ void gemm_phase(PG8_LAS unsigned char* lds, const Gemm g, const Sched& S, const Epi& E) {
    const int tid = threadIdx.x, wid = __builtin_amdgcn_readfirstlane(tid >> 6), lane = tid & 63, wr = wid >> 2, wc = wid & 3, fr = lane & 15, fq = lane >> 4;
    const int K = g.K, nt = K / BK;
    unsigned voffA[2], voffB[2];
#pragma unroll
    for (int i = 0; i < 2; ++i) { int R, C; stage_rc(tid * 16 + i * 8192, R, C); const int Rb = Epi::PERM ? ((R & ~31) + perm32(R & 31)) : R;
        voffA[i] = (unsigned)(R * K + C) * 2u; voffB[i] = (unsigned)(Rb * K + C) * 2u; }
    const size_t kstep = (size_t)(BK * 2);
    const size_t hstep = (size_t)HALF * K * 2;
    const size_t tstep = 2 * hstep;
    const unsigned ldsw = (unsigned)wid * 1024u;
    const int aoff_ = lds_byte(wr * 64 + fr, fq * 8), boff_ = lds_byte(wc * 32 + fr, fq * 8);
#define PG8_SA(b, h) (((b) * 2 + (h)) * HTB)
#define PG8_SB(b, h) ((4 + (b) * 2 + (h)) * HTB)
#define PG8_STAGE(bufoff, gbase, voff) do { _Pragma("unroll") for (int _i = 0; _i < 2; ++_i) \
        __builtin_amdgcn_global_load_lds((const unsigned*)((const char*)(gbase) + (voff)[_i]), (PG8_LAS unsigned*)(lds + (bufoff) + ldsw + _i * 8192), 16, 0, 0); } while (0)
#define PG8_LD1(off) (*(const PG8_LAS bf16x8*)(lds + (off)))
#define PG8_LDA(dst, b, h) do { _Pragma("unroll") for (int m = 0; m < 4; ++m) { if constexpr (F8) dst##8[m] = cat8(PG8_LD1(PG8_SA(b, h) + aoff + m * 2048), PG8_LD1(PG8_SA(b, h) + aoff + m * 2048 + 1024)); \
        else { _Pragma("unroll") for (int k = 0; k < 2; ++k) dst[m][k] = PG8_LD1(PG8_SA(b, h) + aoff + m * 2048 + k * 1024); } } } while (0)
#define PG8_LDB(dst, b, h) do { _Pragma("unroll") for (int n = 0; n < 2; ++n) { if constexpr (F8) dst##8[n] = cat8(PG8_LD1(PG8_SB(b, h) + boff + n * 2048), PG8_LD1(PG8_SB(b, h) + boff + n * 2048 + 1024)); \
        else { _Pragma("unroll") for (int k = 0; k < 2; ++k) dst[n][k] = PG8_LD1(PG8_SB(b, h) + boff + n * 2048 + k * 1024); } } } while (0)
#define PG8_MMA(ai, bj, At, Bt) do { __builtin_amdgcn_s_setprio(1); _Pragma("unroll") for (int m = 0; m < 4; ++m) _Pragma("unroll") for (int n = 0; n < 2; ++n) { \
        if constexpr (F8) asm volatile("v_mfma_f32_16x16x128_f8f6f4 %0, %1, %2, %0" : "+v"(acc[ai][bj][m][n]) : "v"(Bt##8[n]), "v"(At##8[m])); \
        else { _Pragma("unroll") for (int k = 0; k < 2; ++k) acc[ai][bj][m][n] = __builtin_amdgcn_mfma_f32_16x16x32_bf16(Bt[n][k], At[m][k], acc[ai][bj][m][n], 0, 0, 0); } } __builtin_amdgcn_s_setprio(0); } while (0)
#define PG8_WAIT_V(n) asm volatile("s_waitcnt vmcnt(" #n ")" ::: "memory")
#define PG8_WAIT_L(n) asm volatile("s_waitcnt lgkmcnt(" #n ")" ::: "memory")
#define PG8_BAR __builtin_amdgcn_s_barrier()
#define PG8_SCHED __builtin_amdgcn_sched_barrier(0)
    Unit cur, nxt; int ui = 0;
    if (!S.next(0, cur)) return;
    f32x4 acc[2][2][4][2];
#pragma unroll
    for (int a = 0; a < 2; ++a)
#pragma unroll
        for (int b = 0; b < 2; ++b)
#pragma unroll
            for (int m = 0; m < 4; ++m)
#pragma unroll
                for (int n = 0; n < 2; ++n) acc[a][b][m][n] = (f32x4){0.f, 0.f, 0.f, 0.f};
    bf16x8 At[4][2], B0[2][2], B1[2][2]; i32x8 At8[4], B08[2], B18[2];
    const char* cA = (const char*)g.A + (size_t)cur.pm * tstep; const char* cB = (const char*)g.Bt + (size_t)cur.pn * tstep;
    S.a_ready(cur);
    if constexpr (SP2) {
        PG8_STAGE(PG8_SB(0, 0), cB, voffB); PG8_STAGE(PG8_SB(0, 1), cB + hstep, voffB); PG8_STAGE(PG8_SA(0, 0), cA, voffA); PG8_STAGE(PG8_SA(0, 1), cA + hstep, voffA);
        if (wr == 1) PG8_BAR;
        PG8_WAIT_V(2); PG8_BAR;
        PG8_STAGE(PG8_SB(1, 0), cB + kstep, voffB); PG8_STAGE(PG8_SA(1, 0), cA + kstep, voffA); PG8_STAGE(PG8_SB(1, 1), cB + hstep + kstep, voffB);
        PG8_WAIT_V(6); PG8_BAR;
    } else {
        PG8_STAGE(PG8_SB(0, 0), cB, voffB); PG8_STAGE(PG8_SA(0, 0), cA, voffA); PG8_STAGE(PG8_SB(0, 1), cB + hstep, voffB); PG8_STAGE(PG8_SA(0, 1), cA + hstep, voffA);
        if (wr == 1) PG8_BAR;
        PG8_WAIT_V(4); PG8_BAR;
        PG8_STAGE(PG8_SB(1, 0), cB + kstep, voffB); PG8_STAGE(PG8_SA(1, 0), cA + kstep, voffA); PG8_STAGE(PG8_SB(1, 1), cB + hstep + kstep, voffB);
        PG8_WAIT_V(6); PG8_BAR;
    }
    for (;;) {
        const bool has_next = S.next(ui + 1, nxt);
        const char* nA = has_next ? (const char*)g.A + (size_t)nxt.pm * tstep : cA; const char* nB = has_next ? (const char*)g.Bt + (size_t)nxt.pn * tstep : cB;
        for (int t = 0; t < nt; t += 2) {
            const bool last = (t == nt - 2);
            int aoff = aoff_, boff = boff_; if constexpr (F8) asm volatile("" : "+v"(aoff), "+v"(boff));
            const char* a1 = cA + (size_t)(t + 1) * kstep;
            const char* a2 = last ? nA : cA + (size_t)(t + 2) * kstep; const char* b2 = last ? nB : cB + (size_t)(t + 2) * kstep;
            const char* a3 = a2 + kstep; const char* b3 = b2 + kstep;
            if (last && has_next) S.a_ready(nxt);
            if constexpr (SP2) {
            PG8_LDB(B0, 0, 0); PG8_LDB(B1, 0, 1); PG8_SCHED; PG8_LDA(At, 0, 0); PG8_STAGE(PG8_SA(1, 1), a1 + hstep, voffA);
            PG8_WAIT_V(8); PG8_WAIT_L(0); PG8_BAR; PG8_MMA(0, 0, At, B0); PG8_MMA(0, 1, At, B1); PG8_BAR; PG8_SCHED;
            PG8_LDA(At, 0, 1); PG8_STAGE(PG8_SB(0, 0), b2, voffB); PG8_STAGE(PG8_SB(0, 1), b2 + hstep, voffB); PG8_STAGE(PG8_SA(0, 0), a2, voffA);
            PG8_WAIT_V(8); PG8_WAIT_L(0); PG8_BAR; PG8_MMA(1, 0, At, B0); PG8_MMA(1, 1, At, B1); PG8_BAR; PG8_SCHED;
            PG8_LDB(B0, 1, 0); PG8_LDB(B1, 1, 1); PG8_SCHED; PG8_LDA(At, 1, 0); PG8_STAGE(PG8_SA(0, 1), a2 + hstep, voffA);
            PG8_WAIT_V(8); PG8_WAIT_L(0); PG8_BAR; PG8_MMA(0, 0, At, B0); PG8_MMA(0, 1, At, B1); PG8_BAR; PG8_SCHED;
            PG8_LDA(At, 1, 1); PG8_STAGE(PG8_SB(1, 0), b3, voffB); PG8_STAGE(PG8_SB(1, 1), b3 + hstep, voffB); PG8_STAGE(PG8_SA(1, 0), a3, voffA);
            PG8_WAIT_V(8); PG8_WAIT_L(0); PG8_BAR; PG8_MMA(1, 0, At, B0); PG8_MMA(1, 1, At, B1); PG8_BAR; PG8_SCHED;
            } else {
            PG8_LDB(B0, 0, 0); PG8_SCHED; PG8_LDA(At, 0, 0); PG8_STAGE(PG8_SA(1, 1), a1 + hstep, voffA);
            PG8_WAIT_L(8); PG8_BAR; PG8_WAIT_L(0); PG8_MMA(0, 0, At, B0); PG8_BAR; PG8_SCHED;
            PG8_LDB(B1, 0, 1); PG8_STAGE(PG8_SB(0, 0), b2, voffB);
            PG8_BAR; PG8_WAIT_L(0); PG8_MMA(0, 1, At, B1); PG8_BAR;
            PG8_LDA(At, 0, 1); PG8_STAGE(PG8_SA(0, 0), a2, voffA);
            PG8_BAR; PG8_WAIT_L(0); PG8_MMA(1, 0, At, B0); PG8_BAR; PG8_SCHED;
            PG8_STAGE(PG8_SB(0, 1), b2 + hstep, voffB);
            PG8_WAIT_V(6); PG8_BAR; PG8_MMA(1, 1, At, B1); PG8_BAR;
            PG8_LDB(B0, 1, 0); PG8_SCHED; PG8_LDA(At, 1, 0); PG8_STAGE(PG8_SA(0, 1), a2 + hstep, voffA);
            PG8_WAIT_L(8); PG8_BAR; PG8_WAIT_L(0); PG8_MMA(0, 0, At, B0); PG8_BAR; PG8_SCHED;
            PG8_LDB(B1, 1, 1); PG8_STAGE(PG8_SB(1, 0), b3, voffB);
            PG8_BAR; PG8_WAIT_L(0); PG8_MMA(0, 1, At, B1); PG8_BAR;
            PG8_LDA(At, 1, 1); PG8_STAGE(PG8_SA(1, 0), a3, voffA);
            PG8_BAR; PG8_WAIT_L(0); PG8_MMA(1, 0, At, B0); PG8_BAR; PG8_SCHED;
            PG8_STAGE(PG8_SB(1, 1), b3 + hstep, voffB);
            PG8_WAIT_V(6); PG8_BAR; PG8_MMA(1, 1, At, B1); PG8_BAR;
            }
        }
        if constexpr (ALIGN_EPI) { if (wr == 0) PG8_BAR; }
        if constexpr (F8) asm volatile("s_nop 15\n\ts_nop 15" ::: "memory");
        if constexpr (!Epi::AFTER_DRAIN) { E(acc, cur, wr, wc, fr, fq); S.done(cur); }
        if (!has_next) break;
#pragma unroll
        for (int a = 0; a < 2; ++a)
#pragma unroll
            for (int b = 0; b < 2; ++b)
#pragma unroll
                for (int m = 0; m < 4; ++m)
#pragma unroll
                    for (int n = 0; n < 2; ++n) acc[a][b][m][n] = (f32x4){0.f, 0.f, 0.f, 0.f};
        cur = nxt; cA = nA; cB = nB; ++ui;
        if constexpr (ALIGN_EPI) { if (wr == 1) PG8_BAR; }
    }
    PG8_WAIT_V(0);
    if constexpr (!ALIGN_EPI) { if (wr == 0) PG8_BAR; }
    PG8_BAR;
#undef PG8_SA
#undef PG8_SB
#undef PG8_STAGE
#undef PG8_LDA
#undef PG8_LD1
#undef PG8_LDB
#undef PG8_MMA
#undef PG8_WAIT_V
#undef PG8_WAIT_L
#undef PG8_BAR
#undef PG8_SCHED
}
}

namespace att {
constexpr int D = 128, NW = 8, QBLK = 32, KVBLK = 64;
constexpr float SCALE = 0.088388347648318440f;
constexpr size_t SHM_V = KVBLK * D * 2, SHM_K = KVBLK * D * 2, SHM_ATTN = 2 * SHM_V + 2 * SHM_K + NW * 64 * 4;
#define KSWZ(row, colB) ((row) * 256 + ((colB) ^ (((row) & 7) << 4)))
#define KSWZ8(row, colB) ((row) * 128 + ((colB) ^ ((((row) >> 1) & 7) << 4)))
#define SBAR() __builtin_amdgcn_sched_barrier(0)
__device__ __forceinline__ int crow(int r, int hi) { return (r & 3) + 8 * (r >> 2) + 4 * hi; }
template <bool MASKED> __device__ __forceinline__ void mask_apply(f32x16& p, unsigned w) {
    if constexpr (MASKED) {
#pragma unroll
        for (int r = 0; r < 16; ++r) { const unsigned m = (unsigned)__builtin_amdgcn_sbfe((int)w, (unsigned)((r & 3) + 8 * (r >> 2)), 1u); p[r] = __uint_as_float((__float_as_uint(p[r]) & m) | (0xFF800000u & ~m)); }
    }
}
template <bool MASKED, bool P8 = false> __device__ __forceinline__ void partialSM(f32x16& p0, f32x16& p1, float& m_reg, float& mn, float& alpha, unsigned long long mk, int sh4) {
    constexpr float C = SCALE * 1.4426950408889634f; constexpr float THR = P8 ? 5.f : 8.f;
    float pmax = p0[0];
#pragma unroll
    for (int r = 1; r < 16; ++r) pmax = fmaxf(pmax, p0[r]);
#pragma unroll
    for (int r = 0; r < 16; ++r) pmax = fmaxf(pmax, p1[r]);
    { auto rr = __builtin_amdgcn_permlane32_swap(__float_as_uint(pmax), __float_as_uint(pmax), false, false);
      pmax = fmaxf(__uint_as_float(rr[0]), __uint_as_float(rr[1])); }
    if (__builtin_expect(__all(pmax - m_reg <= THR / SCALE), 1)) { mn = m_reg; alpha = 1.f; }
    else { mn = fmaxf(m_reg, pmax); alpha = __builtin_amdgcn_exp2f((m_reg - mn) * C); m_reg = mn; }
    const float mnC = -mn * C;
#pragma unroll
    for (int r = 0; r < 16; ++r) p0[r] = fmaf(p0[r], C, mnC);
#pragma unroll
    for (int r = 0; r < 16; ++r) p1[r] = fmaf(p1[r], C, mnC);
#pragma unroll
    for (int r = 0; r < 16; ++r) p0[r] = __builtin_amdgcn_exp2f(p0[r]);
}
template <bool MASKED> __device__ __forceinline__ void finishSM(f32x16& p0, f32x16& p1, float alpha, float& l_reg, bf16x8& pa0, bf16x8& pa1, bf16x8& pa2, bf16x8& pa3, unsigned long long mk, int sh4) {
#pragma unroll
    for (int r = 0; r < 16; ++r) p1[r] = __builtin_amdgcn_exp2f(p1[r]);
    float ps = 0;
#pragma unroll
    for (int r = 0; r < 16; ++r) ps += p0[r];
#pragma unroll
    for (int r = 0; r < 16; ++r) ps += p1[r];
    { auto rr = __builtin_amdgcn_permlane32_swap(__float_as_uint(ps), __float_as_uint(ps), false, false);
      ps = __uint_as_float(rr[0]) + __uint_as_float(rr[1]); }
    l_reg = l_reg * alpha + ps;
#define PK4(P, BASE, OUT) do { unsigned a0 = cvtpk(P[BASE + 0], P[BASE + 1]), a1 = cvtpk(P[BASE + 2], P[BASE + 3]);   \
    unsigned b0 = cvtpk(P[BASE + 4], P[BASE + 5]), b1 = cvtpk(P[BASE + 6], P[BASE + 7]);                              \
    auto r0 = __builtin_amdgcn_permlane32_swap(a0, b0, false, false); auto r1 = __builtin_amdgcn_permlane32_swap(a1, b1, false, false); \
    u32x4 w = {r0[0], r1[0], r0[1], r1[1]}; OUT = *reinterpret_cast<bf16x8*>(&w); } while (0)
    PK4(p0, 0, pa0); PK4(p0, 8, pa1); PK4(p1, 0, pa2); PK4(p1, 8, pa3);
#undef PK4
}
__device__ __forceinline__ void finishSM8(f32x16& p0, f32x16& p1, float alpha, float& l_reg, i32x8& pa) {
#pragma unroll
    for (int r = 0; r < 16; ++r) p1[r] = __builtin_amdgcn_exp2f(p1[r]);
    float ps = 0;
#pragma unroll
    for (int r = 0; r < 16; ++r) ps += p0[r];
#pragma unroll
    for (int r = 0; r < 16; ++r) ps += p1[r];
    { auto rr = __builtin_amdgcn_permlane32_swap(__float_as_uint(ps), __float_as_uint(ps), false, false);
      ps = __uint_as_float(rr[0]) + __uint_as_float(rr[1]); }
    l_reg = l_reg * alpha + ps;
#pragma unroll
    for (int q = 0; q < 4; ++q) { int w = __builtin_amdgcn_cvt_pk_fp8_f32(p0[4 * q], p0[4 * q + 1], 0, false); pa[q] = __builtin_amdgcn_cvt_pk_fp8_f32(p0[4 * q + 2], p0[4 * q + 3], w, true);
        int v = __builtin_amdgcn_cvt_pk_fp8_f32(p1[4 * q], p1[4 * q + 1], 0, false); pa[4 + q] = __builtin_amdgcn_cvt_pk_fp8_f32(p1[4 * q + 2], p1[4 * q + 3], v, true); }
}
#define VSWZ8(d, c) ((d) * 64 + ((((c) ^ (((d) >> 2) & 3))) << 4))
__device__ __forceinline__ void pv8(f32x16* o, const char* Vt, const i32x8 pa, int r32, int hi) {
#pragma unroll
    for (int d0 = 0; d0 < 4; ++d0) { const int d = d0 * 32 + r32;
        const i32x8 vb = pg8::cat8(*reinterpret_cast<const bf16x8*>(Vt + VSWZ8(d, 2 * hi)), *reinterpret_cast<const bf16x8*>(Vt + VSWZ8(d, 2 * hi + 1)));
        o[d0] = __builtin_amdgcn_mfma_scale_f32_32x32x64_f8f6f4(pa, vb, o[d0], 0, 0, 0, 0, 0, 0); }
}
template <bool MASKED> __device__ __forceinline__ void qkt(f32x16& p0, f32x16& p1, const bf16_t* Ks, const bf16x8* qs, int r32, int hi, unsigned long long mk, int sh4, const char* lut) {
    if constexpr (MASKED) {
        const unsigned wl = (unsigned)mk >> sh4, wh = (unsigned)(mk >> 32) >> sh4;
#pragma unroll
        for (int g = 0; g < 4; ++g) { const f32x4 b0 = *(const f32x4*)(lut + ((wl >> (8 * g)) & 15u) * 16), b1 = *(const f32x4*)(lut + ((wh >> (8 * g)) & 15u) * 16);
            p0[4 * g] = b0.x; p0[4 * g + 1] = b0.y; p0[4 * g + 2] = b0.z; p0[4 * g + 3] = b0.w; p1[4 * g] = b1.x; p1[4 * g + 1] = b1.y; p1[4 * g + 2] = b1.z; p1[4 * g + 3] = b1.w; }
    } else { p0 = f32x16{}; p1 = f32x16{}; }
#pragma unroll
    for (int d0 = 0; d0 < 8; ++d0) { int cb = (d0 * 16 + hi * 8) * 2;
        bf16x8 b0 = *reinterpret_cast<const bf16x8*>((const char*)Ks + KSWZ(r32, cb));
        bf16x8 b1 = *reinterpret_cast<const bf16x8*>((const char*)Ks + KSWZ(32 + r32, cb));
        const bf16x8 qf = qs[d0 * 64];
        p0 = __builtin_amdgcn_mfma_f32_32x32x16_bf16(b0, qf, p0, 0, 0, 0);
        p1 = __builtin_amdgcn_mfma_f32_32x32x16_bf16(b1, qf, p1, 0, 0, 0); }
}
template <bool MASKED> __device__ __forceinline__ void qkt8(f32x16& p0, f32x16& p1, const char* Ks, const bf16x8* qs, int r32, int hi, unsigned long long mk, int sh4, const char* lut) {
    if constexpr (MASKED) {
        const unsigned wl = (unsigned)mk >> sh4, wh = (unsigned)(mk >> 32) >> sh4;
#pragma unroll
        for (int g = 0; g < 4; ++g) { const f32x4 b0 = *(const f32x4*)(lut + ((wl >> (8 * g)) & 15u) * 16), b1 = *(const f32x4*)(lut + ((wh >> (8 * g)) & 15u) * 16);
            p0[4 * g] = b0.x; p0[4 * g + 1] = b0.y; p0[4 * g + 2] = b0.z; p0[4 * g + 3] = b0.w; p1[4 * g] = b1.x; p1[4 * g + 1] = b1.y; p1[4 * g + 2] = b1.z; p1[4 * g + 3] = b1.w; }
    } else { p0 = f32x16{}; p1 = f32x16{}; }
#pragma unroll
    for (int s2 = 0; s2 < 2; ++s2) { const int cb = (s2 * 4 + hi * 2) * 16;
        const i32x8 a0 = pg8::cat8(*reinterpret_cast<const bf16x8*>(Ks + KSWZ8(r32, cb)), *reinterpret_cast<const bf16x8*>(Ks + KSWZ8(r32, cb + 16)));
        const i32x8 a1 = pg8::cat8(*reinterpret_cast<const bf16x8*>(Ks + KSWZ8(32 + r32, cb)), *reinterpret_cast<const bf16x8*>(Ks + KSWZ8(32 + r32, cb + 16)));
        const i32x8 qf = pg8::cat8(qs[(2 * s2) * 64], qs[(2 * s2 + 1) * 64]);
        p0 = __builtin_amdgcn_mfma_scale_f32_32x32x64_f8f6f4(a0, qf, p0, 0, 0, 0, 0, 0, 0);
        p1 = __builtin_amdgcn_mfma_scale_f32_32x32x64_f8f6f4(a1, qf, p1, 0, 0, 0, 0, 0, 0); }
}
__device__ __forceinline__ int v_st(int k, int c) { const int kk = (k & ~0xC) | ((k & 4) << 1) | ((k & 8) >> 1); return ((kk >> 3) * 4 + (c >> 5)) * 512 + ((kk & 7) * 32 + (c & 31)) * 2; }
__device__ __forceinline__ int v_rd_base(int lane) { return ((lane & 3) << 3) | (((lane >> 2) & 3) << 6) | (((lane >> 4) & 1) << 5) | (((lane >> 5) & 1) << 8); }
constexpr int v_rd_off(int d0, int ks, int half) { return d0 * 512 + ks * 4096 + half * 2048; }
template <int OFF> __device__ __forceinline__ s16x4 tr_read(int vb) {
    s16x4 r; asm volatile("ds_read_b64_tr_b16 %0, %1 offset:%2" : "=&v"(r) : "v"(vb), "i"(OFF) : "memory"); return r;
}
template <int D0> __device__ __forceinline__ void pv_one(f32x16& od, int vb, bf16x8 pa0, bf16x8 pa1, bf16x8 pa2, bf16x8 pa3) {
    const s16x4 l0 = tr_read<v_rd_off(D0, 0, 0)>(vb), h0 = tr_read<v_rd_off(D0, 0, 1)>(vb), l1 = tr_read<v_rd_off(D0, 1, 0)>(vb), h1 = tr_read<v_rd_off(D0, 1, 1)>(vb);
    const s16x4 l2 = tr_read<v_rd_off(D0, 2, 0)>(vb), h2 = tr_read<v_rd_off(D0, 2, 1)>(vb), l3 = tr_read<v_rd_off(D0, 3, 0)>(vb), h3 = tr_read<v_rd_off(D0, 3, 1)>(vb);
    asm volatile("s_waitcnt lgkmcnt(0)" ::: "memory"); SBAR();
#define PK(L, H) (bf16x8){L[0], L[1], L[2], L[3], H[0], H[1], H[2], H[3]}
    od = __builtin_amdgcn_mfma_f32_32x32x16_bf16(pa0, PK(l0, h0), od, 0, 0, 0);
    od = __builtin_amdgcn_mfma_f32_32x32x16_bf16(pa1, PK(l1, h1), od, 0, 0, 0);
    od = __builtin_amdgcn_mfma_f32_32x32x16_bf16(pa2, PK(l2, h2), od, 0, 0, 0);
    od = __builtin_amdgcn_mfma_f32_32x32x16_bf16(pa3, PK(l3, h3), od, 0, 0, 0);
#undef PK
}
__device__ __forceinline__ void pv_d0(f32x16* o, int vb, bf16x8 pa0, bf16x8 pa1, bf16x8 pa2, bf16x8 pa3) {
    pv_one<0>(o[0], vb, pa0, pa1, pa2, pa3); pv_one<1>(o[1], vb, pa0, pa1, pa2, pa3); pv_one<2>(o[2], vb, pa0, pa1, pa2, pa3); pv_one<3>(o[3], vb, pa0, pa1, pa2, pa3);
}
template <bool MASKED, int SDEPTH, int ldq, int ldk, int ldo, bool QK8 = false, bool PV8 = false>
__device__ __forceinline__ void attn_body(const bf16_t* __restrict__ Qb, const bf16_t* __restrict__ Kh, const bf16_t* __restrict__ Vh,
                                          bf16_t* __restrict__ Ob, int seq, const unsigned long long* __restrict__ mrow, char* lds,
                                          const unsigned char* __restrict__ Q8b = nullptr, const unsigned char* __restrict__ K8h = nullptr, const unsigned char* __restrict__ V8h = nullptr) {
    int tid = (int)threadIdx.x; asm volatile("" : "+v"(tid));
    const int wid = tid >> 6, lane = tid & 63, r32 = lane & 31, hi = lane >> 5, sh4 = 4 * hi;
    bf16_t* V_lds = (bf16_t*)lds; bf16_t* K_lds = (bf16_t*)(lds + 2 * SHM_V);
    float* ws = (float*)(lds + 2 * SHM_V + 2 * SHM_K) + wid * 64; float* li_l = ws; float* al_l = ws + 32;
    float m_reg = -1e30f, l_reg = 0; f32x16 o[4] = {};
    const bf16_t* Qw = Qb + (long)(wid * QBLK + r32) * ldq + hi * 8;
    bf16x8* qr = (bf16x8*)(lds + SHM_ATTN) + wid * 512 + lane;
    if constexpr (QK8) { const unsigned char* Q8w = Q8b + (long)(wid * QBLK + r32) * 1024 + hi * 32;
#pragma unroll
        for (int j = 0; j < 4; ++j) qr[j * 64] = *reinterpret_cast<const bf16x8*>(Q8w + (j >> 1) * 64 + (j & 1) * 16);
    } else {
#pragma unroll
        for (int d0 = 0; d0 < 8; ++d0) qr[d0 * 64] = *reinterpret_cast<const bf16x8*>(Qw + d0 * 16); }
    const char* lut = lds + SHM_ATTN + 65536;
    if (MASKED && tid < 64) ((float*)(lds + SHM_ATTN + 65536))[tid] = ((tid >> 2) >> (tid & 3)) & 1 ? 0.f : -INFINITY;
    const int sr = tid >> 4, sc = (tid & 15) * 8, vst0 = v_st(sr, sc), vst1 = v_st(32 + sr, sc);
    const int vb0 = (int)(uintptr_t)V_lds + v_rd_base(lane);
    struct { bf16x8 vs0, vs1, ks0, ks1; } sr_[SDEPTH];
    const int kr8 = tid >> 3, kc8 = (tid & 7) * 16;
#define SLOAD(i, k0) do { if constexpr (PV8) sr_[i].vs0 = *reinterpret_cast<const bf16x8*>(V8h + (long)(k0) * 128 + tid * 16); \
    else { sr_[i].vs0 = *reinterpret_cast<const bf16x8*>(&Vh[(long)((k0) + sr) * ldk + sc]); sr_[i].vs1 = *reinterpret_cast<const bf16x8*>(&Vh[(long)((k0) + 32 + sr) * ldk + sc]); } \
    if constexpr (QK8) sr_[i].ks0 = *reinterpret_cast<const bf16x8*>(K8h + (long)((k0) + kr8) * 1024 + kc8); \
    else { sr_[i].ks0 = *reinterpret_cast<const bf16x8*>(&Kh[(long)((k0) + sr) * ldk + sc]); sr_[i].ks1 = *reinterpret_cast<const bf16x8*>(&Kh[(long)((k0) + 32 + sr) * ldk + sc]); } } while (0)
#define SWRITE(b, i) do { if constexpr (PV8) *(bf16x8*)((char*)V_lds + (b) * SHM_V + VSWZ8(tid >> 2, tid & 3)) = sr_[i].vs0; \
    else { *(bf16x8*)((char*)V_lds + (b) * SHM_V + vst0) = sr_[i].vs0;          \
    *(bf16x8*)((char*)V_lds + (b) * SHM_V + vst1) = sr_[i].vs1; } int kc = sc * 2;               \
    if constexpr (QK8) *(bf16x8*)((char*)K_lds + (b) * SHM_K + KSWZ8(kr8, kc8)) = sr_[i].ks0;  \
    else { *(bf16x8*)((char*)K_lds + (b) * SHM_K + KSWZ(sr, kc)) = sr_[i].ks0;                  \
    *(bf16x8*)((char*)K_lds + (b) * SHM_K + KSWZ(32 + sr, kc)) = sr_[i].ks1; } } while (0)
#define SWAIT() do { if constexpr (SDEPTH == 2) { if constexpr (QK8 && PV8) asm volatile("s_waitcnt vmcnt(2)" ::: "memory"); else if constexpr (QK8) asm volatile("s_waitcnt vmcnt(3)" ::: "memory"); else asm volatile("s_waitcnt vmcnt(4)" ::: "memory"); } else asm volatile("s_waitcnt vmcnt(0)" ::: "memory"); } while (0)
#define FIN(P0, P1, AL, MK) do { if constexpr (PV8) finishSM8(P0, P1, AL, l_reg, pa8); else finishSM<MASKED>(P0, P1, AL, l_reg, pa0, pa1, pa2, pa3, MK, sh4); } while (0)
#define PVD(VOFF) do { if constexpr (PV8) pv8(o, (const char*)V_lds + (VOFF), pa8, r32, hi); else pv_d0(o, vb0 + (int)(VOFF), pa0, pa1, pa2, pa3); } while (0)
#define QKT(P0, P1, KB, MK) do { if constexpr (QK8) qkt8<MASKED>(P0, P1, (const char*)(KB), qr, r32, hi, MK, sh4, lut); else qkt<MASKED>(P0, P1, (const bf16_t*)(KB), qr, r32, hi, MK, sh4, lut); } while (0)
#define RESC(a) do { if (__any((a) < 1.f)) { if (hi == 0) al_l[r32] = (a); asm volatile("s_waitcnt lgkmcnt(0)" ::: "memory"); \
    _Pragma("unroll") for (int d = 0; d < 4; ++d) _Pragma("unroll") for (int r = 0; r < 16; ++r) o[d][r] *= al_l[crow(r, hi)]; } } while (0)
    f32x16 pA0, pA1, pB0, pB1; float mnA, mnB, alA, alB; bf16x8 pa0, pa1, pa2, pa3; i32x8 pa8; const int NT = seq / KVBLK;
    unsigned long long mkA = 0, mkB = 0;
    constexpr int SE = 0, SO = SDEPTH - 1;
    if constexpr (MASKED) mkA = mrow[0];
    SLOAD(SE, 0); asm volatile("s_waitcnt vmcnt(0)" ::: "memory"); SWRITE(0, SE); __syncthreads();
    QKT(pA0, pA1, K_lds, mkA); partialSM<MASKED, PV8>(pA0, pA1, m_reg, mnA, alA, mkA, sh4);
    if constexpr (MASKED) mkB = mrow[1];
    SLOAD(SO, KVBLK); if constexpr (SDEPTH == 2) { if (2 < NT) SLOAD(SE, 2 * KVBLK); }
    SWAIT(); SWRITE(1, SO); __syncthreads();
    for (int j = 1; j + 1 < NT; j += 2) {
        SBAR(); QKT(pB0, pB1, (char*)K_lds + SHM_K, mkB);
        FIN(pA0, pA1, alA, mkA); SBAR();
        if constexpr (MASKED) mkA = mrow[j + 1];
        SLOAD(SO, (j + SDEPTH) * KVBLK); SBAR();
        PVD(0); partialSM<MASKED, PV8>(pB0, pB1, m_reg, mnB, alB, mkB, sh4);
        __syncthreads(); SWAIT(); SWRITE(0, SE);
        RESC(alB); __syncthreads();
        SBAR(); QKT(pA0, pA1, K_lds, mkA);
        FIN(pB0, pB1, alB, mkB); SBAR();
        if constexpr (MASKED) { if (j + 2 < NT) mkB = mrow[j + 2]; }
        if (SDEPTH == 1 || j + 3 < NT) SLOAD(SE, (j + 1 + SDEPTH) * KVBLK); SBAR();
        PVD(SHM_V); partialSM<MASKED, PV8>(pA0, pA1, m_reg, mnA, alA, mkA, sh4);
        __syncthreads(); SWAIT(); SWRITE(1, SO);
        RESC(alA); __syncthreads();
    }
    SBAR(); QKT(pB0, pB1, (char*)K_lds + SHM_K, mkB);
    FIN(pA0, pA1, alA, mkA); SBAR();
    PVD(0); partialSM<MASKED, PV8>(pB0, pB1, m_reg, mnB, alB, mkB, sh4);
    __syncthreads(); RESC(alB);
    FIN(pB0, pB1, alB, mkB); SBAR();
    PVD(SHM_V);
    if (hi == 0) li_l[r32] = l_reg; asm volatile("s_waitcnt lgkmcnt(0)" ::: "memory");
    float rli[16];
#pragma unroll
    for (int r = 0; r < 16; ++r) rli[r] = __builtin_amdgcn_rcpf(li_l[crow(r, hi)]);
    bf16_t* Ow = Ob + (long)(wid * QBLK) * ldo;
#pragma unroll
    for (int r = 0; r < 16; ++r) { const int orow = crow(r, hi);
#pragma unroll
        for (int d0 = 0; d0 < 4; ++d0) Ow[(long)orow * ldo + d0 * 32 + r32] = (bf16_t)(cvtpk(o[d0][r] * rli[r], 0.f) & 0xffffu); }
    __syncthreads();
#undef SLOAD
#undef SWRITE
#undef SWAIT
#undef QKT
#undef FIN
#undef PVD
#undef RESC
}
#undef KSWZ
#undef KSWZ8
#undef VSWZ8
#undef SBAR
}

#define XB_TMO      128
#define XB_XCNT(j)  (256  + 64 * (j))
#define XB_XSUB(j)  (1280 + 64 * (j))
#define XB_XGEN(j)  (2304 + 64 * (j))
#define XB_TOP      3328
#define XB_TOPGEN   3392
#define XCD_BAR_WORDS 3456
#define XB_SPIN_CAP (1u << 22)
__device__ __forceinline__ unsigned xb_ld(unsigned* p)              { return __hip_atomic_load(p, __ATOMIC_RELAXED, __HIP_MEMORY_SCOPE_AGENT); }
__device__ __forceinline__ unsigned xb_add(unsigned* p, unsigned v) { return __hip_atomic_fetch_add(p, v, __ATOMIC_RELAXED, __HIP_MEMORY_SCOPE_AGENT); }
__device__ __forceinline__ unsigned xb_xcc_id() { return (unsigned)__builtin_amdgcn_s_getreg((3 << 11) | 20) & 0xFu; }
#define XB_SPIN(cond, bar) do { unsigned _sp = 0; while (cond) { __builtin_amdgcn_s_sleep(1); \
    if ((++_sp & 255u) == 0u) { if (xb_ld(&(bar)[XB_TMO])) break; if (_sp > XB_SPIN_CAP) { atomicAdd(&(bar)[XB_TMO], 1u); break; } } } } while (0)
struct XcdBarrier { unsigned* bar; unsigned x; volatile LAS unsigned* st; };
__device__ __forceinline__ XcdBarrier xcd_barrier_post(unsigned* bar, volatile LAS unsigned* st) {
    XcdBarrier b; b.bar = bar; b.x = xb_xcc_id(); b.st = st;
    if (threadIdx.x == 0) (void)xb_add(&bar[XB_XCNT(b.x)], 1u);
    return b;
}
__device__ __forceinline__ void xcd_barrier_complete(unsigned* bar, unsigned x, unsigned& nloc, unsigned& nx) {
    const unsigned G = gridDim.x * gridDim.y * gridDim.z;
    unsigned sum, cnt, mine, sp = 0u;
    for (;;) {
        sum = 0u; cnt = 0u; mine = 0u;
#pragma unroll
        for (unsigned j = 0; j < 16; ++j) { const unsigned c = xb_ld(&bar[XB_XCNT(j)]); sum += c; cnt += (c > 0u) ? 1u : 0u; mine = (j == x) ? c : mine; }
        if (sum == G) break;
        __builtin_amdgcn_s_sleep(1);
        if ((++sp & 255u) == 0u) { if (xb_ld(&bar[XB_TMO])) break; if (sp > XB_SPIN_CAP) { atomicAdd(&bar[XB_TMO], 1u); break; } }
    }
    nloc = mine > 0u ? mine : 1u; nx = cnt > 0u ? cnt : 1u;
}
__device__ __forceinline__ void xcd_barrier(const XcdBarrier& b) {
    asm volatile("s_waitcnt vmcnt(0)" ::: "memory");
    __syncthreads();
    if (threadIdx.x == 0) {
        unsigned* bar = b.bar;
        __builtin_amdgcn_s_waitcnt(0);
        unsigned nloc = b.st[0], nx = b.st[1];
        if (nloc == 0u) { xcd_barrier_complete(bar, b.x, nloc, nx); b.st[0] = nloc; b.st[1] = nx; }
        const unsigned old = xb_add(&bar[XB_XSUB(b.x)], 1u);
        const unsigned gen = old / nloc;
        if (old + 1u == (gen + 1u) * nloc) {
            __builtin_amdgcn_fence(__ATOMIC_RELEASE, "agent");
            asm volatile("s_waitcnt vmcnt(0)" ::: "memory");
            const unsigned og = xb_add(&bar[XB_TOP], 1u);
            const unsigned tg = og / nx;
            if (og + 1u == (tg + 1u) * nx) xb_add(&bar[XB_TOPGEN], 1u);
            else XB_SPIN(xb_ld(&bar[XB_TOPGEN]) == tg, bar);
            __builtin_amdgcn_fence(__ATOMIC_ACQUIRE, "agent");
            xb_add(&bar[XB_XGEN(b.x)], 1u);
            asm volatile("s_waitcnt vmcnt(0)" ::: "memory");
        } else {
            XB_SPIN(xb_ld(&bar[XB_XGEN(b.x)]) == gen, bar);
            __builtin_amdgcn_fence(__ATOMIC_ACQUIRE, "agent");
            asm volatile("s_waitcnt vmcnt(0)" ::: "memory");
        }
    }
    __syncthreads();
}

constexpr int NWAVES = 8;
constexpr int RING_BYTES = 151 * 1024;
constexpr int LDSCTL_OFF = RING_BYTES, MISC_OFF = LDSCTL_OFF + 320;
constexpr int LDS_BYTES = 152 * 1024;
static_assert(MISC_OFF + 128 <= LDS_BYTES, "LDS map");
constexpr int N_PHASES = 13;

struct Args {
    const float* x; const float* mem; const float* attn_g; const float* w_in; const float* q_g; const float* k_g; const float* pool_w; const float* pool_s;
    const float* mem_g; const float* w_kv; const float* mq_g; const float* mk_g; const float* w_out; const float* ffn_g; const float* w_q; const float* sk1; const float* sk2;
    const float* pu; const float* pv; float* out; unsigned char* ws; int ph_lo, ph_hi;
};
struct Frame {
    LAS unsigned char* lds; char* ldsg;
    int tid, lane, wave, vcu, G;
};

__device__ __forceinline__ int in_colmap(int n) {
    if (n < 4096) return n;
    if (n < 4608) return 4176 + (n - 4096);
    if (n < 5120) return 4688 + (n - 4608);
    if (n < 5184) return 4096 + (n - 5120);
    if (n < 5200) return 4160 + (n - 5184);
    return -1;
}
template <int MAP> __device__ __forceinline__ void p0_transpose_item(const float* W, int K, int N, bf16_t* WT, LAS float* scr, int kb, int nb, int lane) {
    const int k0 = 64 * kb, n0 = 32 * nb;
    int nsrc = n0 + (lane & 31); if (MAP == 1) nsrc = in_colmap(nsrc);
#pragma unroll 8
    for (int i = 0; i < 32; ++i) { const int kk = 2 * i + (lane >> 5); scr[kk * 33 + (lane & 31)] = nsrc >= 0 ? W[(size_t)(k0 + kk) * N + nsrc] : 0.f; }
    LDS_WAIT();
    const int c = lane & 7;
#pragma unroll
    for (int j = 0; j < 4; ++j) { const int n = (lane >> 3) + 8 * j; const LAS float* s = scr + (8 * c) * 33 + n;
        u32x4 o; o.x = cvtpk(s[0 * 33], s[1 * 33]); o.y = cvtpk(s[2 * 33], s[3 * 33]); o.z = cvtpk(s[4 * 33], s[5 * 33]); o.w = cvtpk(s[6 * 33], s[7 * 33]);
        *(u32x4*)(WT + (size_t)(n0 + n) * K + k0 + 8 * c) = o; }
    LDS_WAIT();
}
__device__ __forceinline__ void rms_row_to_bf16(const float* xrow, const float* gain, bf16_t* orow, int lane) {
    const f32x4* xr = (const f32x4*)xrow + lane;
    f32x4 v[8]; float s = 0.f;
#pragma unroll
    for (int j = 0; j < 8; ++j) { v[j] = xr[64 * j]; s += (v[j].x * v[j].x + v[j].y * v[j].y) + (v[j].z * v[j].z + v[j].w * v[j].w); }
    const float rstd = 1.f / sqrtf(wave_sum(s) * (1.f / DM) + EPS);
    unsigned long long* o8 = (unsigned long long*)orow + lane;
#pragma unroll
    for (int j = 0; j < 8; ++j) { const f32x4 g = ((const f32x4*)gain)[lane + 64 * j]; const f32x4 y = v[j] * rstd * g;
        o8[64 * j] = (unsigned long long)cvtpk(y.x, y.y) | ((unsigned long long)cvtpk(y.z, y.w) << 32); }
}
__device__ __forceinline__ void rms_row_to_bf16_fp8(const float* xrow, const float* gain, bf16_t* orow, unsigned char* o8row, int lane) {
    const f32x4* xr = (const f32x4*)xrow + lane;
    f32x4 v[8]; float s = 0.f;
#pragma unroll
    for (int j = 0; j < 8; ++j) { v[j] = xr[64 * j]; s += (v[j].x * v[j].x + v[j].y * v[j].y) + (v[j].z * v[j].z + v[j].w * v[j].w); }
    const float rstd = 1.f / sqrtf(wave_sum(s) * (1.f / DM) + EPS);
    unsigned long long* o8 = (unsigned long long*)orow + lane; unsigned* q4 = (unsigned*)o8row + lane;
#pragma unroll
    for (int j = 0; j < 8; ++j) { const f32x4 g = ((const f32x4*)gain)[lane + 64 * j]; const f32x4 y = v[j] * rstd * g;
        o8[64 * j] = (unsigned long long)cvtpk(y.x, y.y) | ((unsigned long long)cvtpk(y.z, y.w) << 32);
        int w = __builtin_amdgcn_cvt_pk_fp8_f32(__builtin_amdgcn_fmed3f(y.x, -448.f, 448.f), __builtin_amdgcn_fmed3f(y.y, -448.f, 448.f), 0, false);
        w = __builtin_amdgcn_cvt_pk_fp8_f32(__builtin_amdgcn_fmed3f(y.z, -448.f, 448.f), __builtin_amdgcn_fmed3f(y.w, -448.f, 448.f), w, true); q4[64 * j] = (unsigned)w; }
}
struct RowF32 { f32x4 v[8]; };
__device__ __forceinline__ void row_load(RowF32& R, const float* xrow, int lane) {
    const f32x4* xr = (const f32x4*)xrow + lane;
#pragma unroll
    for (int j = 0; j < 8; ++j) R.v[j] = xr[64 * j];
}
__device__ __forceinline__ void row_load_bf16(RowF32& R, const bf16_t* brow, int lane) {
    const u32x2* br = (const u32x2*)brow + lane;
#pragma unroll
    for (int j = 0; j < 8; ++j) { const u32x2 w = br[64 * j]; R.v[j] = (f32x4){bflo(w.x), bfhi(w.x), bflo(w.y), bfhi(w.y)}; }
}
__device__ __forceinline__ void row_to_fp8(const RowF32& R, unsigned char* orow, float* inv, int lane) {
    unsigned* o4 = (unsigned*)orow + lane; float am = 0.f;
#pragma unroll
    for (int j = 0; j < 8; ++j) am = fmaxf(am, fmaxf(fmaxf(fabsf(R.v[j].x), fabsf(R.v[j].y)), fmaxf(fabsf(R.v[j].z), fabsf(R.v[j].w))));
#pragma unroll
    for (int o = 1; o < 64; o <<= 1) am = fmaxf(am, __shfl_xor(am, o));
    const float sc = (am > 0.f && am < 3.0e38f) ? exp2f(floorf(log2f(224.f / am))) : 1.f;
#pragma unroll
    for (int j = 0; j < 8; ++j) { int w = __builtin_amdgcn_cvt_pk_fp8_f32(R.v[j].x * sc, R.v[j].y * sc, 0, false); w = __builtin_amdgcn_cvt_pk_fp8_f32(R.v[j].z * sc, R.v[j].w * sc, w, true); o4[64 * j] = (unsigned)w; }
    if (lane == 0) *inv = 1.f / sc;
}
__device__ __forceinline__ void row_to_fp8_sliced(const RowF32& R, unsigned char* tab, int m, float* inv, int lane) {
    float am = 0.f;
#pragma unroll
    for (int j = 0; j < 8; ++j) am = fmaxf(am, fmaxf(fmaxf(fabsf(R.v[j].x), fabsf(R.v[j].y)), fmaxf(fabsf(R.v[j].z), fabsf(R.v[j].w))));
#pragma unroll
    for (int o = 1; o < 64; o <<= 1) am = fmaxf(am, __shfl_xor(am, o));
    const float sc = (am > 0.f && am < 3.0e38f) ? exp2f(floorf(log2f(224.f / am))) : 1.f;
    unsigned char* o = tab + (size_t)(lane >> 5) * ((size_t)NEXP * 128) + (size_t)m * 128 + 4 * (lane & 31);
#pragma unroll
    for (int j = 0; j < 8; ++j) { int w = __builtin_amdgcn_cvt_pk_fp8_f32(R.v[j].x * sc, R.v[j].y * sc, 0, false); w = __builtin_amdgcn_cvt_pk_fp8_f32(R.v[j].z * sc, R.v[j].w * sc, w, true); *(unsigned*)(o + (size_t)(2 * j) * ((size_t)NEXP * 128)) = (unsigned)w; }
    if (lane == 0) *inv = 1.f / sc;
}
__device__ __forceinline__ void p0_prologue(const Frame& F, const Args& a) {
    unsigned char* ws = a.ws;
    LAS float* scr = (LAS float*)(F.lds + F.wave * 16384);
    const int gw = F.vcu * NWAVES + F.wave, NGW = F.G * NWAVES, lane = F.lane;
    bf16_t* BtIn = (bf16_t*)(ws + WS_BT_IN); bf16_t* BtOut = (bf16_t*)(ws + WS_BT_OUT); bf16_t* BtQ = (bf16_t*)(ws + WS_BT_Q); bf16_t* BtKV = (bf16_t*)(ws + WS_BT_KV);
    constexpr int I_IN = 32 * 168, I_OUT = 32 * 64, I_Q = 32 * 64, I_KV = 32 * 32;
    constexpr int NIT = I_IN + I_OUT + I_Q + I_KV;
    for (int it = gw; it < NIT; it += NGW) {
        int r = it;
        if (r < I_IN) { p0_transpose_item<1>(a.w_in, DM, IN_W, BtIn, scr, r / 168, r % 168, lane); continue; } r -= I_IN;
        if (r < I_OUT) { const int kb = r / 64; p0_transpose_item<0>(a.w_out, DM, DM, BtOut, scr, kb, r % 64, lane); continue; } r -= I_OUT;
        if (r < I_Q) { p0_transpose_item<0>(a.w_q, DM, DM, BtQ, scr, r / 64, r % 64, lane); continue; } r -= I_Q;
        p0_transpose_item<0>(a.w_kv, DM, 1024, BtKV, scr, r / 32, r % 32, lane);
    }
    { bf16_t* PWt = (bf16_t*)(ws + WS_PWT);
      for (int it = gw; it < 4 * 128; it += NGW) { const int g = it >> 7, e = it & 127; const float* pw = a.pool_w + (size_t)g * 16384 + e;
          const float v0 = pw[(size_t)(2 * lane) * 128], v1 = pw[(size_t)(2 * lane + 1) * 128]; ((unsigned*)(PWt + (size_t)it * 128))[lane] = cvtpk(v0, v1); } }
    bf16_t* XN = (bf16_t*)(ws + WS_XN); bf16_t* MN = (bf16_t*)(ws + WS_MN);
#if P1_FP8
    for (int m = gw; m < NTOK; m += NGW) rms_row_to_bf16_fp8(a.x + (size_t)m * DM, a.attn_g, XN + (size_t)m * DM, ws + WS_XN8 + (size_t)m * DM, lane);
#else
    for (int m = gw; m < NTOK; m += NGW) rms_row_to_bf16(a.x + (size_t)m * DM, a.attn_g, XN + (size_t)m * DM, lane);
#endif
    for (int m = gw; m < BATCH * MEMLEN; m += NGW) rms_row_to_bf16(a.mem + (size_t)m * DM, a.mem_g, MN + (size_t)m * DM, lane);
    unsigned char* UB = ws + WS_UB; unsigned char* VB = ws + WS_VB; float* RSU = (float*)(ws + WS_RSU); float* RSV = (float*)(ws + WS_RSV);
    (void)UB; (void)VB; (void)RSU; (void)RSV;
    bf16_t* PK = (bf16_t*)(ws + WS_PK);
    for (int m = gw; m < 256; m += NGW) { const float* src = (m < 128 ? a.sk1 + (size_t)m * 128 : a.sk2 + (size_t)(m - 128) * 128);
        const f32x2 v = ((const f32x2*)src)[lane]; ((unsigned*)(PK + (size_t)m * 128))[lane] = cvtpk(v.x, v.y); }
    float* RT = (float*)(ws + WS_ROPE);
    for (int p = gw; p < SEQ; p += NGW) {
        { const float invf = powf(10000.f, -(float)lane / 64.f); const float ang = (float)p * invf;
          RT[(size_t)p * 192 + lane] = (float)cos((double)ang); RT[(size_t)p * 192 + 64 + lane] = (float)sin((double)ang); }
        if (lane < 32) { const float invf = powf(10000.f, -(float)lane / 32.f); const float ang = (float)p * invf;
          RT[(size_t)p * 192 + 128 + lane] = (float)cos((double)ang); RT[(size_t)p * 192 + 160 + lane] = (float)sin((double)ang); }
    }
}

__device__ __forceinline__ void unpack8(const u32x4 w, float* x) { x[0] = bflo(w.x); x[1] = bfhi(w.x); x[2] = bflo(w.y); x[3] = bfhi(w.y); x[4] = bflo(w.z); x[5] = bfhi(w.z); x[6] = bflo(w.w); x[7] = bfhi(w.w); }
__device__ __forceinline__ u32x4 pack8(const float* x) { u32x4 w; w.x = cvtpk(x[0], x[1]); w.y = cvtpk(x[2], x[3]); w.z = cvtpk(x[4], x[5]); w.w = cvtpk(x[6], x[7]); return w; }
struct F8 { float v[8]; };
__device__ __forceinline__ F8 ld8f(const float* p) { const f32x4 a = *(const f32x4*)p, b = *(const f32x4*)(p + 4); F8 r; r.v[0] = a.x; r.v[1] = a.y; r.v[2] = a.z; r.v[3] = a.w; r.v[4] = b.x; r.v[5] = b.y; r.v[6] = b.z; r.v[7] = b.w; return r; }
__device__ __forceinline__ u32x2 pack8_fp8(const float* x) { int a = __builtin_amdgcn_cvt_pk_fp8_f32(x[0], x[1], 0, false); a = __builtin_amdgcn_cvt_pk_fp8_f32(x[2], x[3], a, true); int b = __builtin_amdgcn_cvt_pk_fp8_f32(x[4], x[5], 0, false); b = __builtin_amdgcn_cvt_pk_fp8_f32(x[6], x[7], b, true); return (u32x2){(unsigned)a, (unsigned)b}; }
template <bool NORM, bool ROPE, bool WB16 = true> __device__ __forceinline__ void head128_fin(bf16_t* base, const u32x4 wa, const u32x4 wb, int g, const F8& g1, const F8& g2, const F8& cc, const F8& sn, unsigned char* f8base = nullptr) {
    float x1[8], x2[8];
    unpack8(wa, x1); unpack8(wb, x2);
    if (NORM) {
        float ss = 0.f;
#pragma unroll
        for (int j = 0; j < 8; ++j) ss += x1[j] * x1[j] + x2[j] * x2[j];
        ss += __shfl_xor(ss, 1); ss += __shfl_xor(ss, 2); ss += __shfl_xor(ss, 4);
        const float rstd = 1.f / sqrtf(ss * (1.f / 128.f) + EPS);
#pragma unroll
        for (int j = 0; j < 8; ++j) { x1[j] = x1[j] * rstd * g1.v[j]; x2[j] = x2[j] * rstd * g2.v[j]; }
    }
    if (ROPE) {
#pragma unroll
        for (int j = 0; j < 8; ++j) { const float c = cc.v[j], sv = sn.v[j]; const float p = x1[j], q = x2[j]; x1[j] = p * c - q * sv; x2[j] = q * c + p * sv; }
    }
    if (WB16) { *(u32x4*)(base + 8 * g) = pack8(x1); *(u32x4*)(base + 64 + 8 * g) = pack8(x2); }
    if (f8base) { *(u32x2*)(f8base + 8 * g) = pack8_fp8(x1); *(u32x2*)(f8base + 64 + 8 * g) = pack8_fp8(x2); }
}
__device__ __forceinline__ void head64_fin(bf16_t* base, const u32x4 wa, const u32x4 wb, int g, const F8& cc, const F8& sn) {
    float x1[8], x2[8];
    unpack8(wa, x1); unpack8(wb, x2);
#pragma unroll
    for (int j = 0; j < 8; ++j) { const float c = cc.v[j], sv = sn.v[j]; const float p = x1[j], q = x2[j]; x1[j] = p * c - q * sv; x2[j] = q * c + p * sv; }
    *(u32x4*)(base + 8 * g) = pack8(x1); *(u32x4*)(base + 32 + 8 * g) = pack8(x2);
}
__device__ __forceinline__ void p2_post(const Frame& F, const Args& a) {
    unsigned char* ws = a.ws; const int lane = F.lane;
    const int gw = F.vcu * NWAVES + F.wave, NGW = F.G * NWAVES;
    bf16_t* Z = (bf16_t*)(ws + WS_Z); bf16_t* MIX = (bf16_t*)(ws + WS_XN); bf16_t* KVM = (bf16_t*)(ws + WS_KVM);
    const float* RT = (const float*)(ws + WS_ROPE);
    const int g8 = lane & 7, h8 = lane >> 3, g4 = lane & 3, h4 = lane >> 2;
    const F8 qg1 = ld8f(a.q_g + 8 * g8), qg2 = ld8f(a.q_g + 64 + 8 * g8), kg1 = ld8f(a.k_g + 8 * g8), kg2 = ld8f(a.k_g + 64 + 8 * g8), mg1 = ld8f(a.mq_g + 8 * g8), mg2 = ld8f(a.mq_g + 64 + 8 * g8);
    for (int t = gw; t < NTOK; t += NGW) {
        const int pos = t & (SEQ - 1);
        bf16_t* zr = Z + (size_t)t * ZLD; const float* rp = RT + (size_t)pos * 192;
        const int w = 2 << (lane >> 4); const int cnt = (pos + 1 < w) ? pos + 1 : w;
        u32x4 pl[16];
#pragma unroll
        for (int j = 0; j < 16; ++j) { const int jj = j < cnt ? j : 0; pl[j] = *(const u32x4*)(zr - (size_t)jj * ZLD + ZC_PU + 8 * lane); }
        bf16_t* bq = zr + ZC_Q + h8 * 128; bf16_t* bk = zr + ZC_K + h8 * 128; bf16_t* bi = zr + ZC_QI + h4 * 64; bf16_t* bki = zr + ZC_KI; bf16_t* bm = zr + ZC_QM + (h8 & 3) * 128;
        const u32x4 q1 = *(const u32x4*)(bq + 8 * g8), q2 = *(const u32x4*)(bq + 64 + 8 * g8), k1 = *(const u32x4*)(bk + 8 * g8), k2 = *(const u32x4*)(bk + 64 + 8 * g8);
        const u32x4 i1 = *(const u32x4*)(bi + 8 * g4), i2 = *(const u32x4*)(bi + 32 + 8 * g4), x1 = *(const u32x4*)(bki + 8 * g4), x2 = *(const u32x4*)(bki + 32 + 8 * g4);
        const u32x4 m1 = *(const u32x4*)(bm + 8 * g8), m2 = *(const u32x4*)(bm + 64 + 8 * g8);
        const F8 c128 = ld8f(rp + 8 * g8), s128 = ld8f(rp + 64 + 8 * g8), c64 = ld8f(rp + 128 + 8 * g4), s64 = ld8f(rp + 160 + 8 * g4);
#if QK_FP8
        head128_fin<true, true, ATT_VERIFY != 0>(bq, q1, q2, g8, qg1, qg2, c128, s128, ws + WS_Q8 + (size_t)t * 1024 + h8 * 128);
        head128_fin<true, true, ATT_VERIFY != 0>(bk, k1, k2, g8, kg1, kg2, c128, s128, ws + WS_K8 + (size_t)t * 1024 + h8 * 128);
#else
        head128_fin<true, true>(bq, q1, q2, g8, qg1, qg2, c128, s128);
        head128_fin<true, true>(bk, k1, k2, g8, kg1, kg2, c128, s128);
#endif
        head64_fin(bi, i1, i2, g4, c64, s64);
        if (lane < 4) head64_fin(bki, x1, x2, g4, c64, s64);
        if (lane < 32) head128_fin<true, false>(bm, m1, m2, g8, mg1, mg2, c128, s128);
        { float sum[8] = {0.f, 0.f, 0.f, 0.f, 0.f, 0.f, 0.f, 0.f}, ut[8];
          unpack8(pl[0], ut);
#pragma unroll
          for (int j = 0; j < 16; ++j) { float v[8]; unpack8(pl[j], v); const float on = j < cnt ? 1.f : 0.f;
#pragma unroll
              for (int e = 0; e < 8; ++e) sum[e] = fmaf(on, v[e], sum[e]); }
          const float inv = 1.f / (float)cnt; float d[8];
#pragma unroll
          for (int e = 0; e < 8; ++e) d[e] = sum[e] * inv - ut[e];
          *(u32x4*)(MIX + (size_t)t * DM + 1024 + 8 * lane) = pack8(d); }
    }
    const F8 kmg1 = ld8f(a.mk_g + 8 * g8), kmg2 = ld8f(a.mk_g + 64 + 8 * g8);
    for (int r = gw; r < BATCH * MEMLEN; r += NGW) { if (lane < 32) { bf16_t* bm = KVM + (size_t)r * 1024 + (lane >> 3) * 128; const u32x4 m1 = *(const u32x4*)(bm + 8 * g8), m2 = *(const u32x4*)(bm + 64 + 8 * g8); head128_fin<true, false>(bm, m1, m2, g8, kmg1, kmg2, kmg1, kmg2); } }
}

#if PV_FP8
__device__ __forceinline__ void p2_vt(const Frame& F, const Args& a) {
    unsigned char* ws = a.ws; const int lane = F.lane;
    const int gw = F.vcu * NWAVES + F.wave, NGW = F.G * NWAVES;
    const bf16_t* Z = (const bf16_t*)(ws + WS_Z);
    {
        LAS unsigned char* tb = F.lds + F.wave * 8704; unsigned char* V8T = ws + WS_V8T;
        for (int blk = gw; blk < BATCH * 256 * 8; blk += NGW) {
            const int h = blk & 7, T = (blk >> 3) & 255, b = blk >> 11;
            const bf16_t* vrow = Z + ((size_t)b * SEQ + 64 * T + lane) * ZLD + ZC_V + h * 128;
            u32x4 w[16];
#pragma unroll
            for (int i = 0; i < 16; ++i) w[i] = *(const u32x4*)(vrow + 8 * i);
#pragma unroll
            for (int i = 0; i < 16; ++i) { float x[8]; unpack8(w[i], x);
#pragma unroll
                for (int e = 0; e < 8; ++e) x[e] = __builtin_amdgcn_fmed3f(x[e], -448.f, 448.f);
                *(LAS u32x2*)(tb + lane * 136 + 8 * i) = pack8_fp8(x); }
            LDS_WAIT();
            unsigned char* dst = V8T + ((size_t)((b * 8 + h) * 256 + T)) * 8192 + (size_t)lane * 128;
#pragma unroll
            for (int c = 0; c < 2; ++c) { const int d = 2 * lane + c;
#pragma unroll
                for (int q4 = 0; q4 < 4; ++q4) { unsigned o[4];
#pragma unroll
                    for (int qq = 0; qq < 4; ++qq) { const int pq = 4 * (4 * q4 + qq); const int key0 = 32 * ((pq >> 4) & 1) + 8 * ((pq >> 2) & 3) + 4 * (pq >> 5);
                        const unsigned b0 = tb[(key0 + 0) * 136 + d], b1 = tb[(key0 + 1) * 136 + d], b2 = tb[(key0 + 2) * 136 + d], b3 = tb[(key0 + 3) * 136 + d];
                        o[qq] = b0 | (b1 << 8) | (b2 << 16) | (b3 << 24); }
                    *(u32x4*)(dst + c * 64 + q4 * 16) = (u32x4){o[0], o[1], o[2], o[3]}; } }
            LDS_WAIT();
        }
    }
}
#endif

namespace ix {
constexpr int KP = 144, KBUF = 64 * KP;
constexpr int OFF_KI = 0, OFF_HIST = 2 * KBUF, OFF_ST = OFF_HIST + 65536, OFF_W = OFF_ST + 8192;
constexpr int CAPB = 1024;
constexpr int CAPF = 512;
enum { S_ULO = 0, S_UHI = 64, S_SH = 128, S_NEED = 192, S_FLO = 256, S_FHI = 320, S_CCNT = 384, S_ACT = 448, S_ABOVE = 512, S_COL = 576, S_FAIL = 640,
       S_PB1 = 704, S_PB2 = 768, S_PAB = 832, S_VMIN = 896, S_VMAX = 960, S_VCNT = 1024, S_ANY = 1088, S_R1 = 1089, S_R2 = 1090 };
constexpr float WSCALE = 0.25f * 0.125f;
__device__ __forceinline__ float relu_i(float x) { const int i = __float_as_int(x); return __int_as_float(i > 0 ? i : 0); }
__device__ __forceinline__ unsigned sh_for(unsigned range) { const int bits = 32 - __clz((int)range); return range == 0u ? 0u : (bits > 9 ? (unsigned)(bits - 9) : 0u); }

template <int MODE>
__device__ __forceinline__ void sweep(const Frame& F, const bf16x8 (&A)[4][4], const bf16_t* Z, unsigned* MASK, unsigned long long* CAND, size_t qrow0, size_t krow0, int NT, int t0, int stride, int vmode) {
    const int tid = F.tid, lane = F.lane, wave = F.wave, r = lane & 31, hi = lane >> 5;
    LAS unsigned char* lds = F.lds;
    volatile LAS unsigned* st = (volatile LAS unsigned*)(lds + OFF_ST);
    LAS unsigned* hist32 = (LAS unsigned*)(lds + OFF_HIST);
    unsigned qact = 0u;
    {
#pragma unroll
        for (int qp = 0; qp < 4; ++qp) { const int q0 = 8 * wave + 2 * qp; const unsigned a2 = (MODE == 0) ? (st[S_ACT + q0] | st[S_ACT + q0 + 1]) : (vmode ? 1u : (st[S_COL + q0] | st[S_COL + q0 + 1]));
            qact |= ((unsigned)__builtin_amdgcn_readfirstlane((int)a2) != 0u ? 1u : 0u) << qp; }
    }
    unsigned ccnt_[4] = {0u, 0u, 0u, 0u}, abv_[4] = {0u, 0u, 0u, 0u};
    if (MODE == 1) {
#pragma unroll
        for (int qp = 0; qp < 4; ++qp) { ccnt_[qp] = st[S_CCNT + 8 * wave + 2 * qp + hi]; abv_[qp] = st[S_ABOVE + 8 * wave + 2 * qp + hi]; }
    }
    const int srow = tid >> 3, sch = tid & 7;
    const bf16_t* ksrc = Z + (krow0 + srow) * ZLD + ZC_KI + sch * 8;
    u32x4 stg = *(const u32x4*)(ksrc + (size_t)t0 * 64 * ZLD);
    *(LAS u32x4*)(lds + OFF_KI + srow * KP + sch * 16) = stg;
    __syncthreads();
    int buf = 0;
    for (int t = t0; t < NT; t += stride) {
        const int tn = t + stride;
        if (tn < NT) stg = *(const u32x4*)(ksrc + (size_t)tn * 64 * ZLD);
        LAS unsigned char* kb = lds + OFF_KI + buf * KBUF;
        int lane_ = (int)threadIdx.x; asm volatile("" : "+v"(lane_)); lane_ &= 63;
        const int r = lane_ & 31, hi = lane_ >> 5;
        bf16x8 B0[4], B1[4];
#pragma unroll
        for (int ks = 0; ks < 4; ++ks) { B0[ks] = *(const LAS bf16x8*)(kb + r * KP + ks * 32 + hi * 16); B1[ks] = *(const LAS bf16x8*)(kb + (32 + r) * KP + ks * 32 + hi * 16); }
#pragma unroll
        for (int qp = 0; qp < 4; ++qp) {
            if (((qact >> qp) & 1u) == 0u) continue;
            const int ql = 8 * wave + 2 * qp + hi;
            const LAS f32x4* wq = (const LAS f32x4*)(lds + OFF_W + ql * 64);
            const f32x4 w0 = wq[0], w1 = wq[1], w2 = wq[2], w3 = wq[3];
            f32x16 a0 = f32x16{}, a1 = f32x16{};
#pragma unroll
            for (int ks = 0; ks < 4; ++ks) { a0 = __builtin_amdgcn_mfma_f32_32x32x16_bf16(A[qp][ks], B0[ks], a0, 0, 0, 0); a1 = __builtin_amdgcn_mfma_f32_32x32x16_bf16(A[qp][ks], B1[ks], a1, 0, 0, 0); }
            float p0 = w0.x * relu_i(a0[0]), p1 = w2.x * relu_i(a0[8]), q0 = w0.x * relu_i(a1[0]), q1 = w2.x * relu_i(a1[8]);
            p0 = fmaf(w0.y, relu_i(a0[1]), p0); p1 = fmaf(w2.y, relu_i(a0[9]), p1); q0 = fmaf(w0.y, relu_i(a1[1]), q0); q1 = fmaf(w2.y, relu_i(a1[9]), q1);
            p0 = fmaf(w0.z, relu_i(a0[2]), p0); p1 = fmaf(w2.z, relu_i(a0[10]), p1); q0 = fmaf(w0.z, relu_i(a1[2]), q0); q1 = fmaf(w2.z, relu_i(a1[10]), q1);
            p0 = fmaf(w0.w, relu_i(a0[3]), p0); p1 = fmaf(w2.w, relu_i(a0[11]), p1); q0 = fmaf(w0.w, relu_i(a1[3]), q0); q1 = fmaf(w2.w, relu_i(a1[11]), q1);
            p0 = fmaf(w1.x, relu_i(a0[4]), p0); p1 = fmaf(w3.x, relu_i(a0[12]), p1); q0 = fmaf(w1.x, relu_i(a1[4]), q0); q1 = fmaf(w3.x, relu_i(a1[12]), q1);
            p0 = fmaf(w1.y, relu_i(a0[5]), p0); p1 = fmaf(w3.y, relu_i(a0[13]), p1); q0 = fmaf(w1.y, relu_i(a1[5]), q0); q1 = fmaf(w3.y, relu_i(a1[13]), q1);
            p0 = fmaf(w1.z, relu_i(a0[6]), p0); p1 = fmaf(w3.z, relu_i(a0[14]), p1); q0 = fmaf(w1.z, relu_i(a1[6]), q0); q1 = fmaf(w3.z, relu_i(a1[14]), q1);
            p0 = fmaf(w1.w, relu_i(a0[7]), p0); p1 = fmaf(w3.w, relu_i(a0[15]), p1); q0 = fmaf(w1.w, relu_i(a1[7]), q0); q1 = fmaf(w3.w, relu_i(a1[15]), q1);
            const unsigned u0 = f2ord(p0 + p1), u1 = f2ord(q0 + q1);
            if (MODE == 0) {
                const unsigned wlo = st[S_ULO + ql], whi = st[S_UHI + ql], wsh = st[S_SH + ql];
                if (u0 >= wlo && u0 <= whi) { const unsigned bin = (u0 - wlo) >> wsh;
                    __hip_atomic_fetch_add(hist32 + ql * 256 + (bin >> 1), 1u << ((bin & 1u) * 16u), __ATOMIC_RELAXED, __HIP_MEMORY_SCOPE_WORKGROUP); }
                if (u1 >= wlo && u1 <= whi) { const unsigned bin = (u1 - wlo) >> wsh;
                    __hip_atomic_fetch_add(hist32 + ql * 256 + (bin >> 1), 1u << ((bin & 1u) * 16u), __ATOMIC_RELAXED, __HIP_MEMORY_SCOPE_WORKGROUP); }
            } else if (IX_VERIFY && vmode) {
                LAS unsigned* vs = (LAS unsigned*)(lds + OFF_ST) + ql;
                const unsigned long long w64 = __hip_atomic_load((const unsigned long long*)(MASK + (qrow0 + ql) * MASK_WPR + 2 * t), __ATOMIC_RELAXED, __HIP_MEMORY_SCOPE_AGENT);
                if ((w64 >> r) & 1ull) { __hip_atomic_fetch_min(vs + S_VMIN, u0, __ATOMIC_RELAXED, __HIP_MEMORY_SCOPE_WORKGROUP); __hip_atomic_fetch_add(vs + S_VCNT, 1u, __ATOMIC_RELAXED, __HIP_MEMORY_SCOPE_WORKGROUP); }
                else __hip_atomic_fetch_max(vs + S_VMAX, u0, __ATOMIC_RELAXED, __HIP_MEMORY_SCOPE_WORKGROUP);
                if ((w64 >> (32 + r)) & 1ull) { __hip_atomic_fetch_min(vs + S_VMIN, u1, __ATOMIC_RELAXED, __HIP_MEMORY_SCOPE_WORKGROUP); __hip_atomic_fetch_add(vs + S_VCNT, 1u, __ATOMIC_RELAXED, __HIP_MEMORY_SCOPE_WORKGROUP); }
                else __hip_atomic_fetch_max(vs + S_VMAX, u1, __ATOMIC_RELAXED, __HIP_MEMORY_SCOPE_WORKGROUP);
            } else {
                const unsigned flo = st[S_FLO + ql], fhi = st[S_FHI + ql]; const bool col = st[S_COL + ql] != 0u;
                const unsigned long long bal0 = __ballot(col && u0 > fhi), bal1 = __ballot(col && u1 > fhi);
                const unsigned bh0 = (unsigned)(bal0 >> (32 * hi)), bh1 = (unsigned)(bal1 >> (32 * hi));
                if (col && r == 0) *(unsigned long long*)(MASK + (qrow0 + ql) * MASK_WPR + 2 * t) = (unsigned long long)bh0 | ((unsigned long long)bh1 << 32);
                abv_[qp] += __popc(bh0) + __popc(bh1);
                const bool c0 = col && (u0 >= flo) && (u0 <= fhi), c1 = col && (u1 >= flo) && (u1 <= fhi);
                const unsigned long long cb0 = __ballot(c0), cb1 = __ballot(c1);
                if (cb0 | cb1) { const unsigned h0 = (unsigned)(cb0 >> (32 * hi)), h1 = (unsigned)(cb1 >> (32 * hi)); const unsigned lt = (1u << r) - 1u;
                    const unsigned pos0 = ccnt_[qp] + __popc(h0 & lt), pos1 = ccnt_[qp] + __popc(h0) + __popc(h1 & lt);
                    if (c0 && pos0 < (unsigned)CAPB) CAND[(size_t)ql * CAPB + pos0] = (unsigned long long)u0 | ((unsigned long long)(unsigned)(64 * t + r) << 32);
                    if (c1 && pos1 < (unsigned)CAPB) CAND[(size_t)ql * CAPB + pos1] = (unsigned long long)u1 | ((unsigned long long)(unsigned)(64 * t + 32 + r) << 32);
                    ccnt_[qp] += __popc(h0) + __popc(h1); }
            }
        }
        if (tn < NT) *(LAS u32x4*)(lds + OFF_KI + (buf ^ 1) * KBUF + srow * KP + sch * 16) = stg;
        __syncthreads();
        buf ^= 1;
    }
    if (MODE == 1 && !vmode) { const int r0 = lane & 31, h0 = lane >> 5;
#pragma unroll
        for (int qp = 0; qp < 4; ++qp) { const int ql = 8 * wave + 2 * qp + h0; if (r0 == 0 && st[S_COL + ql] != 0u) { st[S_CCNT + ql] = ccnt_[qp]; st[S_ABOVE + ql] = abv_[qp]; } } }
}

__device__ __forceinline__ void resolve(const Frame& F, unsigned* MASK, const unsigned long long* CAND, size_t qrow0, int NT) {
    int lane = (int)threadIdx.x; asm volatile("" : "+v"(lane)); lane &= 63; const int wave = F.wave;
    LAS unsigned char* lds = F.lds;
    volatile LAS unsigned* st = (volatile LAS unsigned*)(lds + OFF_ST);
    LAS unsigned* wh = (LAS unsigned*)(lds + OFF_HIST + wave * 4608); LAS unsigned* bm = wh + 512; LAS unsigned long long* sl = (LAS unsigned long long*)(bm + 512);
    const unsigned long long ltm = (1ull << lane) - 1ull;
    for (int qi = 0; qi < 8; ++qi) {
        const int q = 8 * wave + qi;
        if (st[S_COL + q] == 0u) continue;
        const unsigned cnt = st[S_CCNT + q], ab = st[S_ABOVE + q];
        if (!(ab < 256u && ab + cnt >= 256u && cnt <= (unsigned)CAPB)) { if (lane == 0) st[S_FAIL + q] = 1u; continue; }
        if (lane == 0) st[S_FAIL + q] = 0u;
        unsigned need = 256u - ab, lo = st[S_FLO + q], hi = st[S_FHI + q], sh = 0u, cbin = 0u;
        const unsigned long long* cq = CAND + (size_t)q * CAPB;
#pragma unroll
        for (int i = 0; i < 8; ++i) bm[lane * 8 + i] = 0u;
        for (int lev = 0; lev < 5; ++lev) {
            sh = sh_for(hi - lo);
#pragma unroll
            for (int i = 0; i < 8; ++i) wh[lane * 8 + i] = 0u;
            LDS_WAIT();
            for (unsigned j = lane; j < cnt; j += 64) { const unsigned u = (unsigned)cq[j]; if (u >= lo && u <= hi) __hip_atomic_fetch_add(wh + ((u - lo) >> sh), 1u, __ATOMIC_RELAXED, __HIP_MEMORY_SCOPE_WORKGROUP); }
            LDS_WAIT();
            unsigned hb[8], s8 = 0u;
#pragma unroll
            for (int i = 0; i < 8; ++i) { hb[i] = wh[lane * 8 + i]; s8 += hb[i]; }
            unsigned above = 0u;
            { unsigned inc = s8;
#pragma unroll
              for (int o = 1; o < 64; o <<= 1) { const unsigned v = __shfl_down(inc, o); if (lane + o < 64) inc += v; }
              above = inc - s8; }
            const bool mine = above < need && need <= above + s8;
            unsigned bstar = 0u, run = above, cb = 0u;
            if (mine) { bool found = false;
#pragma unroll
                for (int i = 7; i >= 0; --i) { if (!found) { if (run + hb[i] >= need) { bstar = (unsigned)(lane * 8 + i); cb = hb[i]; found = true; } else run += hb[i]; } } }
            const unsigned long long mb = __ballot(mine); const int src = mb ? (int)__builtin_ctzll(mb) : 0;
            bstar = __shfl(bstar, src); run = __shfl(run, src); cbin = __shfl(cb, src);
            const unsigned nlo = lo + (bstar << sh); const unsigned long long e = (unsigned long long)nlo + ((1ull << sh) - 1ull);
            hi = e > (unsigned long long)hi ? hi : (unsigned)e; lo = nlo; need -= run;
            if (cbin <= 64u || sh == 0u) break;
        }
        const bool tiemode = cbin > 64u;
        unsigned m = 0u;
        for (unsigned j0 = 0; j0 < cnt; j0 += 64) { const unsigned j = j0 + lane; const bool vj = j < cnt; const unsigned long long e = vj ? cq[j] : 0ull; const unsigned u = (unsigned)e, key = (unsigned)(e >> 32);
            const bool inw = vj && u >= lo && u <= hi; const unsigned long long bal = __ballot(inw); const unsigned pos = m + (unsigned)__popcll(bal & ltm);
            if (vj && (u > hi || (tiemode && inw && pos < need))) __hip_atomic_fetch_or(bm + (key >> 5), 1u << (key & 31u), __ATOMIC_RELAXED, __HIP_MEMORY_SCOPE_WORKGROUP);
            if (!tiemode && inw && pos < 64u) sl[pos] = e;
            m += (unsigned)__popcll(bal); }
        LDS_WAIT();
        if (!tiemode) { if (m > 64u) m = 64u;
            if ((unsigned)lane < m) { const unsigned long long ej = sl[lane]; const unsigned uj = (unsigned)ej; unsigned rank = 0u;
                for (unsigned j2 = 0; j2 < m; ++j2) { const unsigned u2 = (unsigned)sl[j2]; rank += (u2 > uj || (u2 == uj && j2 < (unsigned)lane)) ? 1u : 0u; }
                if (rank < need) { const unsigned key = (unsigned)(ej >> 32); __hip_atomic_fetch_or(bm + (key >> 5), 1u << (key & 31u), __ATOMIC_RELAXED, __HIP_MEMORY_SCOPE_WORKGROUP); } } }
        LDS_WAIT();
        unsigned* mrow = MASK + (qrow0 + q) * MASK_WPR;
        for (int w = lane; w < 2 * NT; w += 64) { const unsigned b = bm[w]; if (b) { const unsigned old = __hip_atomic_load(mrow + w, __ATOMIC_RELAXED, __HIP_MEMORY_SCOPE_AGENT); mrow[w] = old | b; } }
        LDS_WAIT();
    }
}

__device__ __forceinline__ void unit(const Frame& F, const bf16_t* Z, unsigned* MASK, unsigned long long* CANDW, unsigned* ERR, int b, int c) {
    const int tid = F.tid, lane = F.lane, wave = F.wave, r = lane & 31, hi = lane >> 5;
    const int NT = c + 1; const size_t qrow0 = (size_t)b * SEQ + 64 * c, krow0 = (size_t)b * SEQ;
    LAS unsigned char* lds = F.lds;
    volatile LAS unsigned* st = (volatile LAS unsigned*)(lds + OFF_ST);
    LAS unsigned* hist32 = (LAS unsigned*)(lds + OFF_HIST);
    { const int tend = 4 * ((c >> 2) + 1), nz = 2 * (tend - NT);
      for (int i = tid; i < 64 * nz; i += 512) { const int q = i / nz, wi = 2 * NT + i % nz; MASK[(qrow0 + q) * MASK_WPR + wi] = 0u; } }
    if (c <= 3) {
        for (int i = tid; i < 64 * 2 * NT; i += 512) { const int q = i / (2 * NT), wi = i % (2 * NT); MASK[(qrow0 + q) * MASK_WPR + wi] = 0xFFFFFFFFu; }
        return;
    }
    bf16x8 A[4][4];
#pragma unroll
    for (int qp = 0; qp < 4; ++qp) {
        const int query = 8 * wave + 2 * qp + ((r >> 2) & 1), head = (r & 3) + 4 * (r >> 3);
        const bf16_t* src = Z + (qrow0 + query) * ZLD + ZC_QI + head * 64 + 8 * hi;
#pragma unroll
        for (int ks = 0; ks < 4; ++ks) A[qp][ks] = *(const bf16x8*)(src + ks * 16);
    }
    for (int i = tid; i < 64 * 16; i += 512) { const int q = i >> 4, hh = i & 15; ((LAS float*)(lds + OFF_W))[i] = bflo((unsigned)Z[(qrow0 + q) * ZLD + ZC_WI + hh]) * WSCALE; }
    const int stride = NT >= 32 ? 8 : (NT >= 16 ? 4 : 1), t0 = stride >> 1, nsamp = (NT - t0 + stride - 1) / stride;
    const bool pilot = stride > 1;
    int r1 = 1, r2 = 1;
    if (pilot) { const float ns = 256.f * (float)nsamp / (float)NT; const float sg = sqrtf(ns * (1.f - 1.f / (float)stride)); const int mg = (int)ceilf(4.f * sg) + 2;
        r1 = (int)floorf(ns) - mg; if (r1 < 1) r1 = 1; r2 = (int)ceilf(ns) + mg; }
    if (tid < 64) { st[S_ULO + tid] = 0u; st[S_UHI + tid] = 0xFFFFFFFFu; st[S_SH + tid] = 23u; st[S_NEED + tid] = 256u; st[S_ACT + tid] = 1u; st[S_CCNT + tid] = 0u; st[S_ABOVE + tid] = 0u;
                    st[S_COL + tid] = 1u; st[S_FAIL + tid] = pilot ? 0u : 1u; st[S_PB1 + tid] = 511u; st[S_PB2 + tid] = 0u; st[S_PAB + tid] = 0u; }
    __syncthreads();
    int stage = pilot ? 0 : 2; bool after_fallback = !pilot;
    for (int iter = 0; iter < 24; ++iter) {
        if (stage <= 2) {
            { int tid_ = (int)threadIdx.x; asm volatile("" : "+v"(tid_));
              for (int i = 0; i < 32; ++i) hist32[tid_ + 512 * i] = 0u;
              if (tid_ == 0) st[S_ANY] = 0u; }
            __syncthreads();
            const bool smp = stage <= 1;
            sweep<0>(F, A, Z, MASK, CANDW, qrow0, krow0, NT, smp ? t0 : 0, smp ? stride : 1, 0);
            { int tid_ = (int)threadIdx.x; asm volatile("" : "+v"(tid_)); const int ln = tid_ & 63;
              const int q = tid_ >> 3, seg = tid_ & 7; const LAS unsigned* h32 = hist32 + q * 256 + seg * 32;
              unsigned cnt = 0u;
              for (int i = 0; i < 32; ++i) { const unsigned wv = h32[i]; cnt += (wv & 0xffffu) + (wv >> 16); }
              unsigned above = 0u;
#pragma unroll
              for (int k = 0; k < 8; ++k) { const unsigned ck = __shfl(cnt, (ln & ~7) + k); if (k > seg) above += ck; }
              const unsigned ulo = st[S_ULO + q], uhi = st[S_UHI + q], sh = st[S_SH + q];
              if (smp) {
                  const unsigned pab = stage == 1 ? st[S_PAB + q] : 0u;
                  const unsigned t1 = (unsigned)r1 - (stage == 1 ? pab : 0u), t2 = (unsigned)r2 - (stage == 1 ? pab : 0u);
#pragma unroll
                  for (int which = 0; which < 2; ++which) { const unsigned tg = which ? t2 : t1;
                      if (above < tg && tg <= above + cnt) { unsigned run = above; int bstar = -1;
                          for (int i = 31; i >= 0; --i) { const unsigned wv = h32[i]; const unsigned c1 = wv >> 16, c0 = wv & 0xffffu;
                              if (bstar < 0) { if (run + c1 >= tg) bstar = seg * 64 + 2 * i + 1; else run += c1; }
                              if (bstar < 0) { if (run + c0 >= tg) bstar = seg * 64 + 2 * i; else run += c0; } }
                          if (which == 0) { st[S_PB1 + q] = (unsigned)bstar; if (stage == 0) st[S_PAB + q] = run; } else st[S_PB2 + q] = (unsigned)bstar; } }
              } else {
                  const unsigned need = st[S_NEED + q], active = st[S_ACT + q];
                  if (active && above < need && need <= above + cnt) {
                      unsigned run = above; int bstar = -1; unsigned cbin = 0u;
                      for (int i = 31; i >= 0; --i) { const unsigned wv = h32[i]; const unsigned c1 = wv >> 16, c0 = wv & 0xffffu;
                          if (bstar < 0) { if (run + c1 >= need) { bstar = seg * 64 + 2 * i + 1; cbin = c1; } else run += c1; }
                          if (bstar < 0) { if (run + c0 >= need) { bstar = seg * 64 + 2 * i; cbin = c0; } else run += c0; } }
                      const unsigned nlo = ulo + ((unsigned)bstar << sh); const unsigned long long e = (unsigned long long)nlo + ((1ull << sh) - 1ull);
                      const unsigned nhi = e > (unsigned long long)uhi ? uhi : (unsigned)e;
                      if (cbin <= (unsigned)CAPF || sh == 0u) { st[S_FLO + q] = nlo; st[S_FHI + q] = nhi; st[S_ACT + q] = 0u; st[S_ULO + q] = 1u; st[S_UHI + q] = 0u; }
                      else { st[S_ULO + q] = nlo; st[S_UHI + q] = nhi; st[S_SH + q] = sh >= 9u ? sh - 9u : 0u; st[S_NEED + q] = need - run; st[S_ANY] = 1u; }
                  }
              } }
            __syncthreads();
            if (stage == 0) {
                if (tid < 64) { const unsigned b1 = st[S_PB1 + tid], b2 = st[S_PB2 + tid]; const unsigned nlo = b2 << 23; const unsigned long long e = ((unsigned long long)(b1 + 1u) << 23) - 1ull;
                    const unsigned nhi = e > 0xFFFFFFFFull ? 0xFFFFFFFFu : (unsigned)e; st[S_ULO + tid] = nlo; st[S_UHI + tid] = nhi; st[S_SH + tid] = sh_for(nhi - nlo); st[S_PB1 + tid] = 511u; st[S_PB2 + tid] = 0u; }
                stage = 1;
            } else if (stage == 1) {
                if (tid < 64) { const unsigned b1 = st[S_PB1 + tid], b2 = st[S_PB2 + tid], ulo = st[S_ULO + tid], uhi = st[S_UHI + tid], sh = st[S_SH + tid];
                    const unsigned flo = ulo + (b2 << sh); const unsigned long long e = (unsigned long long)ulo + ((unsigned long long)(b1 + 1u) << sh) - 1ull;
                    st[S_FLO + tid] = flo; st[S_FHI + tid] = e > (unsigned long long)uhi ? uhi : (unsigned)e; }
                stage = 3;
            } else { const unsigned any = st[S_ANY]; if (!any) stage = 3; }
            __syncthreads();
        } else {
            const int vm = stage == 4 ? 1 : 0;
            if (vm) { if (tid < 64) { st[S_VMIN + tid] = 0xFFFFFFFFu; st[S_VMAX + tid] = 0u; st[S_VCNT + tid] = 0u; } __syncthreads(); }
            sweep<1>(F, A, Z, MASK, CANDW, qrow0, krow0, NT, 0, 1, vm);
            VM_WAIT(); __syncthreads();
            if (vm) { if (tid < 64) { if (st[S_VCNT + tid] != 256u || st[S_VMIN + tid] < st[S_VMAX + tid]) atomicOr(ERR, 1u); } __syncthreads(); break; }
            resolve(F, MASK, CANDW, qrow0, NT);
            VM_WAIT(); __syncthreads();
            unsigned nf = 0u;
            if (!after_fallback) { if (tid < 64) nf = st[S_FAIL + tid] & st[S_COL + tid]; nf = (unsigned)__syncthreads_or((int)nf); }
            if (nf) {
                if (tid < 64) { const unsigned f = st[S_FAIL + tid] & st[S_COL + tid]; st[S_ULO + tid] = f ? 0u : 1u; st[S_UHI + tid] = f ? 0xFFFFFFFFu : 0u; st[S_SH + tid] = 23u; st[S_NEED + tid] = 256u; st[S_ACT + tid] = f;
                    st[S_COL + tid] = f; if (f) { st[S_CCNT + tid] = 0u; st[S_ABOVE + tid] = 0u; } }
                __syncthreads();
                stage = 2; after_fallback = true;
            } else { if (IX_VERIFY) stage = 4; else break; }
        }
    }
}
}

namespace peer {
constexpr int TT = 16;
constexpr int SP = 129;
constexpr int OFF_S = 0, OFF_L = 256 * SP * 4;
constexpr int OFF_A = 0;
__device__ __forceinline__ void ins16(unsigned (&L)[16], unsigned x) {
#pragma unroll
    for (int j = 0; j < 16; ++j) { const unsigned a = L[j]; const unsigned mx = a > x ? a : x; x = a > x ? x : a; L[j] = mx; }
}
__device__ __forceinline__ float dot2bf(unsigned w, unsigned x, float acc) { return __builtin_amdgcn_fdot2_f32_bf16(__builtin_bit_cast(bf16x2_t, w), __builtin_bit_cast(bf16x2_t, x), acc, false); }
__device__ __forceinline__ float gelu_erf(float h) { return 0.5f * h * (1.f + erff(h * 0.70710678118654752f)); }

__device__ __forceinline__ void fp8dot4(unsigned w, f32x2 h01, f32x2 h23, f32x2& a0, f32x2& a1) {
    const f32x2 lo = __builtin_amdgcn_cvt_pk_f32_fp8((int)w, false), hi = __builtin_amdgcn_cvt_pk_f32_fp8((int)w, true); a0 = lo * h01 + a0; a1 = hi * h23 + a1; }
__device__ __forceinline__ void fp8axpy4(unsigned w, f32x2 a2, f32x2& c01, f32x2& c23) {
    const f32x2 lo = __builtin_amdgcn_cvt_pk_f32_fp8((int)w, false), hi = __builtin_amdgcn_cvt_pk_f32_fp8((int)w, true); c01 = lo * a2 + c01; c23 = hi * a2 + c23; }
constexpr int NSL = 16, SLW = 128;
__device__ __forceinline__ float dpp_sum8(float v) {
    v += __int_as_float(__builtin_amdgcn_update_dpp(0, __float_as_int(v), 0xB1, 0xF, 0xF, true));
    v += __int_as_float(__builtin_amdgcn_update_dpp(0, __float_as_int(v), 0x4E, 0xF, 0xF, true));
    v += __int_as_float(__builtin_amdgcn_update_dpp(0, __float_as_int(v), 0x141, 0xF, 0xF, true));
    return v;
}
#define PEER_EID(V0, V1, i) ((((i) < 8 ? (V0) : (V1))[((i) & 7) >> 1] >> (16 * ((i) & 1))) & 0xffffu)

struct TabCvt { const float* pu; const float* pv; unsigned char* UB; unsigned char* VB; float* RSU; float* RSV; };
__device__ __forceinline__ const float* tab_src(const TabCvt& T, int m) { return m < NEXP ? T.pu + (size_t)m * DM : T.pv + (size_t)(m - NEXP) * DM; }
__device__ __forceinline__ void tab_finish(const TabCvt& T, const RowF32& R, int m, int lane) { if (m < NEXP) row_to_fp8_sliced(R, T.UB, m, T.RSU + m, lane); else row_to_fp8_sliced(R, T.VB, m - NEXP, T.RSV + (m - NEXP), lane); }
__device__ __forceinline__ void route_step(const Frame& F, const bf16_t* PQ, const bf16x8 (&Bf)[2][8], unsigned short* E16, float* GT, int tok0, const TabCvt& T, int m0, int m1) {
    const int tid = F.tid, lane = F.lane, wave = F.wave, r = lane & 31, hi = lane >> 5;
    LAS float* S = (LAS float*)(F.lds + OFF_S); LAS unsigned* L = (LAS unsigned*)(F.lds + OFF_L);
    RowF32 R;
    if (m0 >= 0) row_load(R, tab_src(T, m0), lane);
    { const int half = wave & 1, cp = (wave >> 1) & 1, rh = wave >> 2;
#pragma unroll
      for (int r2 = 0; r2 < 2; ++r2) {
          const int rt = 2 * rh + r2; const int pair = 32 * rt + r, tok = pair >> 3, p = pair & 7;
          const bf16_t* src = PQ + (size_t)(tok0 + tok) * DM + p * 256 + half * 128 + 8 * hi;
          bf16x8 A[8];
#pragma unroll
          for (int ks = 0; ks < 8; ++ks) A[ks] = *(const bf16x8*)(src + ks * 16);
#pragma unroll
          for (int c2 = 0; c2 < 2; ++c2) {
              f32x16 acc = f32x16{};
#pragma unroll
              for (int ks = 0; ks < 8; ++ks) acc = __builtin_amdgcn_mfma_f32_32x32x16_bf16(A[ks], Bf[c2][ks], acc, 0, 0, 0);
#pragma unroll
              for (int i = 0; i < 16; ++i) { const int row = (32 * rt + (i & 3) + 8 * (i >> 2) + 4 * hi) * 2 + half; S[row * SP + (2 * cp + c2) * 32 + r] = acc[i]; }
          } } }
    if (m0 >= 0) tab_finish(T, R, m0, lane);
    if (m1 >= 0) row_load(R, tab_src(T, m1), lane);
    __syncthreads();
    { const int row = tid >> 1, part = tid & 1; unsigned L16[16];
#pragma unroll
      for (int j = 0; j < 16; ++j) L16[j] = 0u;
#pragma unroll 4
      for (int n = 0; n < 64; ++n) { const int nn = part * 64 + n; const unsigned k = (f2ord(S[row * SP + nn]) & ~127u) | (unsigned)(127 - nn); ins16(L16, k); }
      unsigned oth[16];
#pragma unroll
      for (int j = 0; j < 16; ++j) oth[j] = __shfl_xor(L16[j], 1);
#pragma unroll
      for (int j = 0; j < 16; ++j) ins16(L16, part == 0 ? oth[j] : 0u);
      if (part == 0) {
#pragma unroll
          for (int j = 0; j < 16; ++j) L[row * 16 + j] = L16[j]; } }
    __syncthreads();
    if (tid < 128) {
        const int pair = tid; const LAS float* S1 = S + (pair * 2) * SP; const LAS float* S2 = S + (pair * 2 + 1) * SP;
        const LAS unsigned* L1 = L + (pair * 2) * 16; const LAS unsigned* L2 = L1 + 16;
        float v1[16], v2[16];
#pragma unroll
        for (int j = 0; j < 16; ++j) { v1[j] = S1[127 - (L1[j] & 127u)]; v2[j] = S2[127 - (L2[j] & 127u)]; }
        unsigned C16[16];
#pragma unroll
        for (int j = 0; j < 16; ++j) C16[j] = 0u;
#pragma unroll
        for (int i = 0; i < 16; ++i)
#pragma unroll
            for (int j = 0; j < 16; ++j) if ((i + 1) * (j + 1) <= 16) { const unsigned k = (f2ord(v1[i] + v2[j]) & ~255u) | (unsigned)(255 - (i * 16 + j)); ins16(C16, k); }
        float sc[16]; unsigned ex[16]; float mx = -3.0e38f;
#pragma unroll
        for (int q = 0; q < 16; ++q) { const unsigned ci = 255u - (C16[q] & 255u); const unsigned n1 = 127u - (L1[ci >> 4] & 127u), n2 = 127u - (L2[ci & 15u] & 127u);
            sc[q] = S1[n1] + S2[n2]; ex[q] = n1 * 128u + n2; mx = fmaxf(mx, sc[q]); }
        float sum = 0.f;
#pragma unroll
        for (int q = 0; q < 16; ++q) { sc[q] = __expf(sc[q] - mx); sum += sc[q]; }
        const float inv = 1.f / sum;
        const size_t o = (size_t)(tok0 + (pair >> 3)) * 128 + (pair & 7) * 16;
        u32x4 e0, e1; e0.x = ex[0] | (ex[1] << 16); e0.y = ex[2] | (ex[3] << 16); e0.z = ex[4] | (ex[5] << 16); e0.w = ex[6] | (ex[7] << 16);
        e1.x = ex[8] | (ex[9] << 16); e1.y = ex[10] | (ex[11] << 16); e1.z = ex[12] | (ex[13] << 16); e1.w = ex[14] | (ex[15] << 16);
        *(u32x4*)(E16 + o) = e0; *(u32x4*)(E16 + o + 8) = e1;
#pragma unroll
        for (int q = 0; q < 4; ++q) *(f32x4*)(GT + o + 4 * q) = (f32x4){sc[4 * q] * inv, sc[4 * q + 1] * inv, sc[4 * q + 2] * inv, sc[4 * q + 3] * inv};
    }
    if (m1 >= 0) tab_finish(T, R, m1, lane);
    __syncthreads();
}

__device__ __forceinline__ void udot_compute(const u32x4 (&d)[16], const u32x4 h0, const u32x4 h1, float* dst, int k, bool ok) {
    f32x2 hq[8];
    hq[0] = (f32x2){bflo(h0.x), bfhi(h0.x)}; hq[1] = (f32x2){bflo(h0.y), bfhi(h0.y)}; hq[2] = (f32x2){bflo(h0.z), bfhi(h0.z)}; hq[3] = (f32x2){bflo(h0.w), bfhi(h0.w)};
    hq[4] = (f32x2){bflo(h1.x), bfhi(h1.x)}; hq[5] = (f32x2){bflo(h1.y), bfhi(h1.y)}; hq[6] = (f32x2){bflo(h1.z), bfhi(h1.z)}; hq[7] = (f32x2){bflo(h1.w), bfhi(h1.w)};
    float keep0 = 0.f, keep1 = 0.f;
#pragma unroll
    for (int i = 0; i < 16; ++i) {
        f32x2 a0 = {0.f, 0.f}, a1 = {0.f, 0.f};
        fp8dot4(d[i].x, hq[0], hq[1], a0, a1); fp8dot4(d[i].y, hq[2], hq[3], a0, a1); fp8dot4(d[i].z, hq[4], hq[5], a0, a1); fp8dot4(d[i].w, hq[6], hq[7], a0, a1);
        const float pr = dpp_sum8((a0.x + a0.y) + (a1.x + a1.y));
        if ((i & 7) == k) { if (i < 8) keep0 = pr; else keep1 = pr; }
    }
    if (ok) { dst[0] = keep0; dst[8] = keep1; }
}
__device__ __forceinline__ void udots(const Frame& F, const bf16_t* HN, const unsigned char* UB, const unsigned short* E16, float* PART) {
    const int lane = F.lane, g = lane >> 3, k = lane & 7;
    const int ngr = (F.G % 8 == 0) ? 8 : 1, wpg = F.G / ngr, x = F.vcu / wpg, wl = (F.vcu % wpg) * NWAVES + F.wave, wst = wpg * NWAVES, spg = NSL / ngr;
    const int ntw = (NTOK - wl + wst - 1) / wst;
#define UD_T(j) ((size_t)((wl + (j) * wst) < NTOK ? (wl + (j) * wst) : (NTOK - 1)))
#define UD_IDS(j, V0, V1) { const unsigned short* ep_ = E16 + UD_T(j) * 128 + g * 16; V0 = *(const u32x4*)ep_; V1 = *(const u32x4*)(ep_ + 8); }
#define UD_HN(j, H0, H1) { const bf16_t* hp_ = HN + UD_T(j) * DM + s * SLW + k * 16; H0 = *(const u32x4*)hp_; H1 = *(const u32x4*)(hp_ + 8); }
#define UD_ROWS(D, V0, V1) { _Pragma("unroll") for (int i = 0; i < 16; ++i) D[i] = *(const u32x4*)(ub + (size_t)PEER_EID(V0, V1, i) * 128); }
    for (int rr = 0; rr < spg; ++rr) {
        const int s = x + ngr * rr;
        const unsigned char* ub = UB + (size_t)s * ((size_t)NEXP * 128) + k * 16;
        float* pb = PART + (size_t)s * NTOK * 128 + g * 16 + k;
        u32x4 dA[16], dB[16], idA0, idA1, idB0, idB1, hA0, hA1, hB0, hB1;
        UD_IDS(0, idA0, idA1) UD_HN(0, hA0, hA1) UD_ROWS(dA, idA0, idA1)
        UD_IDS(1, idB0, idB1) UD_HN(1, hB0, hB1)
        for (int j = 0; j < ntw; j += 2) {
            UD_ROWS(dB, idB0, idB1)
            UD_IDS(j + 2, idA0, idA1)
            udot_compute(dA, hA0, hA1, pb + UD_T(j) * 128, k, true);
            UD_HN(j + 2, hA0, hA1)
            UD_ROWS(dA, idA0, idA1)
            UD_IDS(j + 3, idB0, idB1)
            udot_compute(dB, hB0, hB1, pb + UD_T(j + 1) * 128, k, j + 1 < ntw);
            UD_HN(j + 3, hB0, hB1)
        }
    }
#undef UD_IDS
#undef UD_HN
#undef UD_ROWS
}
__device__ __forceinline__ void combine(const Frame& F, const float* PART, const unsigned short* E16, const float* GT, const float* RSU, const float* RSV, float* AT) {
    const size_t n4 = (size_t)NTOK * 128 / 4, stride = (size_t)F.G * NWAVES * 64;
    for (size_t i = (size_t)F.vcu * NWAVES * 64 + F.tid; i < n4; i += stride) {
        f32x4 pv[NSL];
#pragma unroll
        for (int s = 0; s < NSL; ++s) pv[s] = *(const f32x4*)(PART + (size_t)s * n4 * 4 + i * 4);
        const u32x2 ee = *(const u32x2*)(E16 + i * 4); const f32x4 gg = *(const f32x4*)(GT + i * 4);
        const unsigned e0 = ee.x & 0xffffu, e1 = ee.x >> 16, e2 = ee.y & 0xffffu, e3 = ee.y >> 16;
        const float su0 = RSU[e0], su1 = RSU[e1], su2 = RSU[e2], su3 = RSU[e3], sv0 = RSV[e0], sv1 = RSV[e1], sv2 = RSV[e2], sv3 = RSV[e3];
        f32x4 sacc = pv[0];
#pragma unroll
        for (int s = 1; s < NSL; ++s) sacc += pv[s];
        f32x4 o; o.x = gg.x * gelu_erf(sacc.x * su0) * sv0; o.y = gg.y * gelu_erf(sacc.y * su1) * sv1; o.z = gg.z * gelu_erf(sacc.z * su2) * sv2; o.w = gg.w * gelu_erf(sacc.w * su3) * sv3;
        *(f32x4*)(AT + i * 4) = o;
    }
}
__device__ __forceinline__ void vacc_compute(const u32x4 (&d)[16], const f32x4 a0, const f32x4 a1, const f32x4 a2, const f32x4 a3, float* orow, int g, bool ok) {
    f32x2 acc[8];
#pragma unroll
    for (int c = 0; c < 8; ++c) acc[c] = (f32x2){0.f, 0.f};
    const float av[16] = {a0.x, a0.y, a0.z, a0.w, a1.x, a1.y, a1.z, a1.w, a2.x, a2.y, a2.z, a2.w, a3.x, a3.y, a3.z, a3.w};
#pragma unroll
    for (int i = 0; i < 16; ++i) { const f32x2 aa = {av[i], av[i]};
        fp8axpy4(d[i].x, aa, acc[0], acc[1]); fp8axpy4(d[i].y, aa, acc[2], acc[3]); fp8axpy4(d[i].z, aa, acc[4], acc[5]); fp8axpy4(d[i].w, aa, acc[6], acc[7]); }
    float v[16];
#pragma unroll
    for (int c = 0; c < 8; ++c) { v[2 * c] = acc[c].x; v[2 * c + 1] = acc[c].y; }
    float R[8], S4[4];
#pragma unroll
    for (int c = 0; c < 8; ++c) { auto r = __builtin_amdgcn_permlane32_swap(__float_as_uint(v[c]), __float_as_uint(v[c + 8]), false, false); R[c] = __uint_as_float(r[0]) + __uint_as_float(r[1]); }
#pragma unroll
    for (int c = 0; c < 4; ++c) { auto r = __builtin_amdgcn_permlane16_swap(__float_as_uint(R[c]), __float_as_uint(R[c + 4]), false, false); S4[c] = __uint_as_float(r[0]) + __uint_as_float(r[1]); }
    const bool b8 = (g & 1) != 0;
    float T0, T1;
    { const float keep = b8 ? S4[2] : S4[0], send = b8 ? S4[0] : S4[2]; T0 = keep + __int_as_float(__builtin_amdgcn_update_dpp(0, __float_as_int(send), 0x128, 0xF, 0xF, true)); }
    { const float keep = b8 ? S4[3] : S4[1], send = b8 ? S4[1] : S4[3]; T1 = keep + __int_as_float(__builtin_amdgcn_update_dpp(0, __float_as_int(send), 0x128, 0xF, 0xF, true)); }
    if (ok) { f32x2 o2 = *(const f32x2*)orow; o2.x += T0; o2.y += T1; *(f32x2*)orow = o2; }
}
__device__ __forceinline__ void vacc(const Frame& F, const unsigned char* VB, const unsigned short* E16, const float* AT, float* out) {
    const int lane = F.lane, g = lane >> 3, k = lane & 7;
    const int ngr = (F.G % 8 == 0) ? 8 : 1, wpg = F.G / ngr, x = F.vcu / wpg, wl = (F.vcu % wpg) * NWAVES + F.wave, wst = wpg * NWAVES, spg = NSL / ngr;
    const int ntw = (NTOK - wl + wst - 1) / wst;
#define UD_IDS(j, V0, V1) { const unsigned short* ep_ = E16 + UD_T(j) * 128 + g * 16; V0 = *(const u32x4*)ep_; V1 = *(const u32x4*)(ep_ + 8); }
#define VA_A(j, A0, A1, A2, A3) { const float* ap_ = AT + UD_T(j) * 128 + g * 16; A0 = *(const f32x4*)ap_; A1 = *(const f32x4*)(ap_ + 4); A2 = *(const f32x4*)(ap_ + 8); A3 = *(const f32x4*)(ap_ + 12); }
#define UD_ROWS(D, V0, V1) { _Pragma("unroll") for (int i = 0; i < 16; ++i) D[i] = *(const u32x4*)(vb + (size_t)PEER_EID(V0, V1, i) * 128); }
    for (int rr = 0; rr < spg; ++rr) {
        const int s = x + ngr * rr;
        const unsigned char* vb = VB + (size_t)s * ((size_t)NEXP * 128) + k * 16;
        float* ob = out + s * SLW + k * 16 + 2 * g;
        u32x4 dA[16], dB[16], idA0, idA1, idB0, idB1; f32x4 aA0, aA1, aA2, aA3, aB0, aB1, aB2, aB3;
        UD_IDS(0, idA0, idA1) VA_A(0, aA0, aA1, aA2, aA3) UD_ROWS(dA, idA0, idA1)
        UD_IDS(1, idB0, idB1) VA_A(1, aB0, aB1, aB2, aB3)
        for (int j = 0; j < ntw; j += 2) {
            UD_ROWS(dB, idB0, idB1)
            UD_IDS(j + 2, idA0, idA1)
            vacc_compute(dA, aA0, aA1, aA2, aA3, ob + UD_T(j) * DM, g, true);
            VA_A(j + 2, aA0, aA1, aA2, aA3)
            UD_ROWS(dA, idA0, idA1)
            UD_IDS(j + 3, idB0, idB1)
            vacc_compute(dB, aB0, aB1, aB2, aB3, ob + UD_T(j + 1) * DM, g, j + 1 < ntw);
            VA_A(j + 3, aB0, aB1, aB2, aB3)
        }
    }
#undef UD_T
#undef UD_IDS
#undef VA_A
#undef UD_ROWS
}
}

__device__ __forceinline__ void pool_unit(const Frame& F, bf16_t* MIX, const bf16_t* PWt, const float* pool_s, int tm, int g) {
    const int lane = F.lane, r = lane & 31, hi = lane >> 5;
    bf16_t* base = MIX + (size_t)(tm * 256 + F.wave * 32) * DM + 1024 + 128 * g;
    bf16x8 A[8];
#pragma unroll
    for (int ks = 0; ks < 8; ++ks) A[ks] = *(const bf16x8*)(base + (size_t)r * DM + ks * 16 + 8 * hi);
#pragma unroll
    for (int ct = 0; ct < 4; ++ct) {
        f32x16 acc = f32x16{};
        const bf16_t* pb = PWt + (size_t)(g * 128 + ct * 32 + r) * 128 + 8 * hi;
#pragma unroll
        for (int ks = 0; ks < 8; ++ks) { const bf16x8 B = *(const bf16x8*)(pb + ks * 16); acc = __builtin_amdgcn_mfma_f32_32x32x16_bf16(A[ks], B, acc, 0, 0, 0); }
        const float sc = pool_s[128 * g + ct * 32 + r];
#pragma unroll
        for (int i = 0; i < 16; ++i) { const int row = (i & 3) + 8 * (i >> 2) + 4 * hi; base[(size_t)row * DM + ct * 32 + r] = (bf16_t)(cvtpk(acc[i] * sc, 0.f) & 0xffffu); }
    }
}

__global__ void __launch_bounds__(NWAVES * 64, 2) fwd_kernel(Args args) {
    extern __shared__ __attribute__((aligned(16))) unsigned char lds[];
    Frame F;
    F.lds = (LAS unsigned char*)lds; F.ldsg = (char*)lds;
    F.tid = threadIdx.x; F.lane = F.tid & 63; F.wave = __builtin_amdgcn_readfirstlane(F.tid >> 6);
    F.G = gridDim.x; { const int bx = blockIdx.x; F.vcu = (F.G % 8 == 0) ? (bx % 8) * (F.G / 8) + bx / 8 : bx; }
    unsigned char* ws = args.ws;
    unsigned* ctl = (unsigned*)(ws + WS_CTL);
    volatile LAS unsigned* MISC = (volatile LAS unsigned*)(F.lds + MISC_OFF);
    for (int u = F.tid; u < (LDS_BYTES - LDSCTL_OFF) / 4; u += NWAVES * 64) ((LAS unsigned*)(F.lds + LDSCTL_OFF))[u] = 0u;
    __syncthreads();
    const int lo = args.ph_lo, hi = args.ph_hi;
    XcdBarrier bar; bar.bar = ctl + CW_BAR; bar.x = 0; bar.st = nullptr;
    if (hi - lo > 1) bar = xcd_barrier_post(ctl + CW_BAR, MISC + 8);
#define IN(k) (lo <= (k) && (k) < hi)
#define PHASE_BEGIN() do { int t_ = (int)threadIdx.x; asm volatile("" : "+v"(t_)); F.tid = t_; F.lane = t_ & 63; } while (0)
#define SEAM(k) do { if (IN(k) && IN((k) + 1)) xcd_barrier(bar); } while (0)

    bf16_t* Z = (bf16_t*)(ws + WS_Z); bf16_t* XN = (bf16_t*)(ws + WS_XN); bf16_t* MIX = XN;
    bf16_t* HN = (bf16_t*)(ws + WS_Z); bf16_t* PQ = (bf16_t*)(ws + WS_Z + 128 * MiB);
    bf16_t* KVM = (bf16_t*)(ws + WS_KVM); unsigned* MASK = (unsigned*)(ws + WS_MASK);

    if (IN(0)) { PHASE_BEGIN(); p0_prologue(F, args); } SEAM(0);
    if (IN(1)) { PHASE_BEGIN();
#if P1_FP8
        const int gw = F.vcu * NWAVES + F.wave, NGW = F.G * NWAVES;
        for (int i = gw; i < 4096; i += NGW) { const int n = i < 3072 ? i : i + 1024; RowF32 R; row_load_bf16(R, (const bf16_t*)(ws + WS_BT_IN) + (size_t)n * DM, F.lane); row_to_fp8(R, ws + WS_BTIN8 + (size_t)n * DM, (float*)(ws + WS_CSI) + n, F.lane); }
#endif
    } SEAM(1);
    if (IN(2)) { PHASE_BEGIN();
#if P1_FP8
        { pg8::Gemm g{XN, (const bf16_t*)(ws + WS_BT_IN), NTOK, ZLD, DM}; pg8::InBf16Order S; S.init(NTOK, F.G, (int)blockIdx.x);
          pg8::EpiBf16 E{Z, ZLD}; pg8::gemm_phase<pg8::EpiBf16, pg8::InBf16Order, true, true>(F.lds, g, S, E); }
        { pg8::Gemm g{(const bf16_t*)(ws + WS_XN8), (const bf16_t*)(ws + WS_BTIN8), NTOK, ZLD, DM / 2}; pg8::InFp8Order S; S.init(NTOK, F.G, (int)blockIdx.x);
          pg8::EpiBf16S E{Z, ZLD, (const float*)(ws + WS_CSI)}; pg8::gemm_phase<pg8::EpiBf16S, pg8::InFp8Order, true, true, true>(F.lds, g, S, E); }
#else
        { pg8::Gemm g{XN, (const bf16_t*)(ws + WS_BT_IN), NTOK, ZLD, DM}; pg8::StaticOrder S; S.init(NTOK, ZLD, F.G, (int)blockIdx.x);
          pg8::EpiBf16 E{Z, ZLD}; pg8::gemm_phase<pg8::EpiBf16, pg8::StaticOrder, true, true>(F.lds, g, S, E); }
#endif
        { pg8::Gemm g{(const bf16_t*)(ws + WS_MN), (const bf16_t*)(ws + WS_BT_KV), BATCH * MEMLEN, 1024, DM}; pg8::StaticOrder S; S.init(BATCH * MEMLEN, 1024, F.G, (int)((blockIdx.x + 128) % F.G));
          pg8::EpiBf16 E{KVM, 1024}; pg8::gemm_phase<pg8::EpiBf16, pg8::StaticOrder, true, true>(F.lds, g, S, E); }
    } SEAM(2);
    if (IN(3)) { PHASE_BEGIN(); p2_post(F, args);
#if PV_FP8
        PHASE_BEGIN(); p2_vt(F, args);
#endif
    } SEAM(3);
    if (IN(4)) { PHASE_BEGIN();
        for (int i = 0; ; ++i) {
            int b, c;
            if (F.G == 256) { if (i >= 2) break; b = F.vcu >> 7; c = (i == 0) ? 255 - (F.vcu & 127) : (F.vcu & 127); }
            else { const int u = (int)blockIdx.x + i * F.G; if (u >= 512) break; b = u >> 8; c = u & 255; }
            ix::unit(F, Z, MASK, (unsigned long long*)(ws + WS_CAND) + (size_t)blockIdx.x * 64 * ix::CAPB, ctl + 2048, b, c);
            __syncthreads();
        }
    } SEAM(4);
    if (IN(5)) { PHASE_BEGIN();
        for (int u = F.vcu; u < (NTOK / 256) * 4; u += F.G) pool_unit(F, MIX, (const bf16_t*)(ws + WS_PWT), args.pool_s, u >> 2, u & 3);
        const int r32 = F.lane & 31;
        for (int i = 0; ; ++i) {
            int b, h, qb;
            if (F.G == 256) { if (i >= 4) break; const int bh = F.vcu >> 4, s = F.vcu & 15; b = bh >> 3; h = bh & 7; qb = (i == 0) ? 63 - s : (i == 1) ? 32 + s : (i == 2) ? 31 - s : s; }
            else { const int u = (int)blockIdx.x + i * F.G; if (u >= 1024) break; b = u >> 9; h = (u >> 6) & 7; qb = u & 63; }
            const size_t row0 = (size_t)b * SEQ + 256 * qb;
            const unsigned long long* mrow = (const unsigned long long*)MASK + (row0 + F.wave * 32 + r32) * (MASK_WPR / 2);
#if QK_FP8
            att::attn_body<true, 2, ZLD, ZLD, DM, true, PV_FP8 != 0>(Z + row0 * ZLD + ZC_Q + h * 128, Z + (size_t)b * SEQ * ZLD + ZC_K + h * 128, Z + (size_t)b * SEQ * ZLD + ZC_V + h * 128,
                                                        MIX + row0 * DM + h * 128, 256 * (qb + 1), mrow, F.ldsg, ws + WS_Q8 + row0 * 1024 + h * 128, ws + WS_K8 + (size_t)b * SEQ * 1024 + h * 128,
                                                        ws + WS_V8T + (size_t)(b * 8 + h) * 256 * 8192);
#else
            att::attn_body<true, 2, ZLD, ZLD, DM>(Z + row0 * ZLD + ZC_Q + h * 128, Z + (size_t)b * SEQ * ZLD + ZC_K + h * 128, Z + (size_t)b * SEQ * ZLD + ZC_V + h * 128,
                                                  MIX + row0 * DM + h * 128, 256 * (qb + 1), mrow, F.ldsg);
#endif
        }
        for (int id = F.vcu; id < 512; id += F.G) {
            const int b2 = id >> 8, hm = (id >> 6) & 3, qb = id & 63; const size_t row0 = (size_t)b2 * SEQ + 256 * qb;
            att::attn_body<false, 1, ZLD, 1024, DM>(Z + row0 * ZLD + ZC_QM + hm * 128, KVM + (size_t)b2 * MEMLEN * 1024 + hm * 128, KVM + (size_t)b2 * MEMLEN * 1024 + 512 + hm * 128,
                                                    MIX + row0 * DM + 1536 + hm * 128, MEMLEN, nullptr, F.ldsg);
        }
    } SEAM(5);
    if (IN(6)) { PHASE_BEGIN();
#if ATT_VERIFY
        {
            const int t = (int)blockIdx.x * 128 + 77, hh = F.wave, ln = F.lane; const int bb = t / SEQ, pos = t % SEQ, N = 64 * (pos / 64 + 1);
            const bf16_t* zq = Z + (size_t)t * ZLD + ZC_Q + hh * 128 + 2 * ln; const float q0 = bflo((unsigned)zq[0]), q1 = bflo((unsigned)zq[1]);
            float m = -3.0e38f, l = 0.f, o0 = 0.f, o1 = 0.f; int nsel = 0;
            for (int w = 0; w < N / 32; ++w) { unsigned bits = __hip_atomic_load(MASK + (size_t)t * MASK_WPR + w, __ATOMIC_RELAXED, __HIP_MEMORY_SCOPE_AGENT);
                while (bits) { const int bpos = __builtin_ctz(bits); bits &= bits - 1u; const int sidx = 32 * w + bpos; ++nsel;
                    const bf16_t* zk = Z + ((size_t)bb * SEQ + sidx) * ZLD + ZC_K + hh * 128 + 2 * ln; const bf16_t* zv = Z + ((size_t)bb * SEQ + sidx) * ZLD + ZC_V + hh * 128 + 2 * ln;
                    const float lg = wave_sum(q0 * bflo((unsigned)zk[0]) + q1 * bflo((unsigned)zk[1])) * 0.088388347648318440f;
                    const float mn = fmaxf(m, lg), al = __expf(m - mn), pe = __expf(lg - mn); l = l * al + pe; o0 = o0 * al + pe * bflo((unsigned)zv[0]); o1 = o1 * al + pe * bflo((unsigned)zv[1]); m = mn; } }
            const bf16_t* mx = MIX + (size_t)t * DM + hh * 128 + 2 * ln; const float r0 = o0 / l, r1 = o1 / l;
            float er = fmaxf(fabsf(r0 - bflo((unsigned)mx[0])), fabsf(r1 - bflo((unsigned)mx[1]))), sc = fmaxf(fabsf(r0), fabsf(r1));
#pragma unroll
            for (int o = 1; o < 64; o <<= 1) { er = fmaxf(er, __shfl_xor(er, o)); sc = fmaxf(sc, __shfl_xor(sc, o)); }
            if (!(er <= (QK_FP8 ? 0.12f : 0.03f) * sc + (QK_FP8 ? 4e-3f : 1e-3f)) || nsel != (N < 256 ? N : 256)) { if (ln == 0) atomicOr(ctl + 2048, 2u); }
        }
        __syncthreads();
#endif
        pg8::Gemm g{MIX, (const bf16_t*)(ws + WS_BT_OUT), NTOK, DM, DM}; pg8::StaticOrder S; S.init(NTOK, DM, F.G, (int)blockIdx.x);
        pg8::EpiF32Res E{args.x, args.out, DM}; pg8::gemm_phase<pg8::EpiF32Res, pg8::StaticOrder, true, true>(F.lds, g, S, E);
    } SEAM(6);
    if (IN(7)) { PHASE_BEGIN(); const int gw = F.vcu * NWAVES + F.wave, NGW = F.G * NWAVES;
#if P7_FP8
        for (int n = gw; n < DM; n += NGW) { RowF32 R; row_load_bf16(R, (const bf16_t*)(ws + WS_BT_Q) + (size_t)n * DM, F.lane); row_to_fp8(R, ws + WS_BTQ8 + (size_t)n * DM, (float*)(ws + WS_CSQ) + n, F.lane); }
        for (int m = gw; m < NTOK; m += NGW) rms_row_to_bf16_fp8(args.out + (size_t)m * DM, args.ffn_g, HN + (size_t)m * DM, ws + WS_HN8 + (size_t)m * DM, F.lane);
#else
        for (int m = gw; m < NTOK; m += NGW) rms_row_to_bf16(args.out + (size_t)m * DM, args.ffn_g, HN + (size_t)m * DM, F.lane);
#endif
    } SEAM(7);
    if (IN(8)) { PHASE_BEGIN();
#if P7_FP8
        pg8::Gemm g{(const bf16_t*)(ws + WS_HN8), (const bf16_t*)(ws + WS_BTQ8), NTOK, DM, DM / 2}; pg8::StaticOrder S; S.init(NTOK, DM, F.G, (int)blockIdx.x);
        pg8::EpiBf16S E{PQ, DM, (const float*)(ws + WS_CSQ)}; pg8::gemm_phase<pg8::EpiBf16S, pg8::StaticOrder, true, true, true>(F.lds, g, S, E);
#else
        pg8::Gemm g{HN, (const bf16_t*)(ws + WS_BT_Q), NTOK, DM, DM}; pg8::StaticOrder S; S.init(NTOK, DM, F.G, (int)blockIdx.x);
        pg8::EpiBf16 E{PQ, DM}; pg8::gemm_phase<pg8::EpiBf16, pg8::StaticOrder, true, true>(F.lds, g, S, E);
#endif
    } SEAM(8);
    unsigned short* E16 = (unsigned short*)(ws + WS_XN); float* GT = (float*)(ws + WS_XN + 8 * MiB); float* AT = (float*)(ws + WS_XN + 24 * MiB);
    float* PART = (float*)(ws + WS_Z + 128 * MiB);
    if (IN(9)) { PHASE_BEGIN();
        const bf16_t* PKb = (const bf16_t*)(ws + WS_PK);
        bf16x8 Bf[2][8];
        { const int half = F.wave & 1, cp = (F.wave >> 1) & 1, r = F.lane & 31, hi = F.lane >> 5;
#pragma unroll
          for (int c2 = 0; c2 < 2; ++c2)
#pragma unroll
              for (int ks = 0; ks < 8; ++ks) Bf[c2][ks] = *(const bf16x8*)(PKb + (size_t)(half * 128 + (2 * cp + c2) * 32 + r) * 128 + 8 * hi + ks * 16); }
        const peer::TabCvt T{args.pu, args.pv, ws + WS_UB, ws + WS_VB, (float*)(ws + WS_RSU), (float*)(ws + WS_RSV)};
        const int gw = F.vcu * NWAVES + F.wave, NGW = F.G * NWAVES; int mrow = gw, nstep = 0;
        for (int it = F.vcu; it < NTOK / peer::TT; it += F.G, ++nstep) {
            const int m0 = mrow < 2 * NEXP ? mrow : -1; mrow += NGW; const int m1 = mrow < 2 * NEXP ? mrow : -1; mrow += NGW;
            peer::route_step(F, PQ, Bf, E16, GT, it * peer::TT, T, m0, m1);
        }
        for (; mrow < 2 * NEXP; mrow += NGW) { RowF32 R; row_load(R, peer::tab_src(T, mrow), F.lane); peer::tab_finish(T, R, mrow, F.lane); }
    } SEAM(9);
    if (IN(10)) { PHASE_BEGIN(); peer::udots(F, HN, ws + WS_UB, E16, PART); } SEAM(10);
    if (IN(11)) { PHASE_BEGIN(); peer::combine(F, PART, E16, GT, (const float*)(ws + WS_RSU), (const float*)(ws + WS_RSV), AT); } SEAM(11);
    if (IN(12)) { PHASE_BEGIN(); peer::vacc(F, ws + WS_VB, E16, AT, args.out); }
#if IX_VERIFY || ATT_VERIFY
    if (IN(12)) { __syncthreads(); if (__hip_atomic_load(ctl + 2048, __ATOMIC_RELAXED, __HIP_MEMORY_SCOPE_AGENT) != 0u) { args.out[(size_t)blockIdx.x * 512 + threadIdx.x] = __builtin_nanf(""); } }
#endif
#undef IN
#undef SEAM
}

extern "C" void kernel_launch(void* const* d_in, const int* in_sizes, int n_in, void* d_out, int out_size, void* d_ws, size_t ws_size, hipStream_t stream) {
    static int grid = 0;
    if (grid == 0) {
        if (n_in != 19 || out_size != NTOK * DM || ws_size < WS_END) { fprintf(stderr, "kernel_launch: unexpected shapes (n_in %d out %d ws %zu)\n", n_in, out_size, ws_size); grid = -1; return; }
        int dev = 0, cus = 0;
        if (hipGetDevice(&dev) != hipSuccess || hipDeviceGetAttribute(&cus, hipDeviceAttributeMultiprocessorCount, dev) != hipSuccess) { grid = -1; return; }
        if (hipFuncSetAttribute((const void*)fwd_kernel, hipFuncAttributeMaxDynamicSharedMemorySize, LDS_BYTES) != hipSuccess) { fprintf(stderr, "kernel_launch: hipFuncSetAttribute failed\n"); grid = -1; return; }
        int per_cu = 0;
        if (hipOccupancyMaxActiveBlocksPerMultiprocessor(&per_cu, (const void*)fwd_kernel, NWAVES * 64, LDS_BYTES) != hipSuccess || per_cu < 1) { fprintf(stderr, "kernel_launch: occupancy query reports %d workgroups per CU for %d threads / %d B LDS; nothing launched\n", per_cu, NWAVES * 64, LDS_BYTES); grid = -1; return; }
        (void)hipGetLastError();
        grid = cus;
    }
    if (grid < 0) return;
    (void)hipMemsetAsync((char*)d_ws + WS_CTL, 0, CTL_ZERO_BYTES, stream);
    Args a{};
    a.x = (const float*)d_in[0]; a.mem = (const float*)d_in[1]; a.attn_g = (const float*)d_in[2]; a.w_in = (const float*)d_in[3]; a.q_g = (const float*)d_in[4]; a.k_g = (const float*)d_in[5];
    a.pool_w = (const float*)d_in[6]; a.pool_s = (const float*)d_in[7]; a.mem_g = (const float*)d_in[8]; a.w_kv = (const float*)d_in[9]; a.mq_g = (const float*)d_in[10]; a.mk_g = (const float*)d_in[11];
    a.w_out = (const float*)d_in[12]; a.ffn_g = (const float*)d_in[13]; a.w_q = (const float*)d_in[14]; a.sk1 = (const float*)d_in[15]; a.sk2 = (const float*)d_in[16];
    a.pu = (const float*)d_in[17]; a.pv = (const float*)d_in[18]; a.out = (float*)d_out; a.ws = (unsigned char*)d_ws;
#if MK_ONE_LAUNCH
    a.ph_lo = 0; a.ph_hi = N_PHASES;
    hipLaunchKernelGGL(fwd_kernel, dim3(grid), dim3(NWAVES * 64), LDS_BYTES, stream, a);
#else
    for (int p = 0; p < N_PHASES; ++p) { a.ph_lo = p; a.ph_hi = p + 1; hipLaunchKernelGGL(fwd_kernel, dim3(grid), dim3(NWAVES * 64), LDS_BYTES, stream, a); }
#endif
}
```

```cpp
#include <hip/hip_runtime.h>
#include <hip/hip_bf16.h>
#include <cstdio>
#include <cstdint>

#ifndef IX_VERIFY
#define IX_VERIFY 0
#endif
#ifndef ATT_VERIFY
#define ATT_VERIFY 0
#endif
#ifndef PROBE_DUP_MASK
#define PROBE_DUP_MASK 0
#endif
#ifndef MK_ONE_LAUNCH
#define MK_ONE_LAUNCH 1
#endif
#ifndef P1_FP8
#define P1_FP8 1
#endif
#ifndef QK_FP8
#define QK_FP8 1
#endif
#ifndef PV_FP8
#define PV_FP8 1
#endif
#ifndef P5_FP8
#define P5_FP8 1
#endif
#ifndef UDOT_MFMA
#define UDOT_MFMA 1
#endif
#ifndef VACC_MFMA
#define VACC_MFMA 1
#endif
#ifndef PART_BF16
#define PART_BF16 1
#endif
#ifndef P7_FP8
#define P7_FP8 1
#endif

#if ATT_VERIFY && P5_FP8
#error "ATT_VERIFY reads the bf16 MIX: build it with -DP5_FP8=0"
#endif
#if PART_BF16 && !UDOT_MFMA
#error "PART_BF16 is implemented for the UDOT_MFMA path only"
#endif
#if UDOT_MFMA && !P7_FP8
#error "UDOT_MFMA drops the bf16 HN: it needs P7_FP8"
#endif
#define GAS __attribute__((address_space(1)))
#define LAS __attribute__((address_space(3)))
typedef unsigned short bf16_t;
typedef short bf16x8 __attribute__((ext_vector_type(8)));
typedef short s16x4 __attribute__((ext_vector_type(4)));
typedef float f32x4 __attribute__((ext_vector_type(4)));
typedef float f32x2 __attribute__((ext_vector_type(2)));
typedef float f32x16 __attribute__((ext_vector_type(16)));
typedef unsigned u32x4 __attribute__((ext_vector_type(4)));
typedef unsigned u32x2 __attribute__((ext_vector_type(2)));
typedef __bf16 bf16x2_t __attribute__((ext_vector_type(2)));
typedef int i32x8 __attribute__((ext_vector_type(8)));
typedef int i32x4 __attribute__((ext_vector_type(4)));

constexpr int BATCH = 2, SEQ = 16384, DM = 2048, NTOK = BATCH * SEQ, MEMLEN = 256;
constexpr int IN_W = 5200, ZLD = 5376;
constexpr int ZC_Q = 0, ZC_K = 1024, ZC_V = 2048, ZC_QI = 3072, ZC_PU = 4096, ZC_QM = 4608, ZC_KI = 5120, ZC_WI = 5184;
constexpr int NEXP = 16384;
constexpr float EPS = 1e-6f;
constexpr int MASK_WPR = 512;

constexpr size_t MiB = 1u << 20;
constexpr size_t WS_CTL = 0, CTL_ZERO_BYTES = 1 * MiB;
constexpr size_t WS_BT_IN = 2 * MiB;
constexpr size_t WS_BT_OUT = 24 * MiB;
constexpr size_t WS_BT_Q = 32 * MiB;
constexpr size_t WS_BT_KV = 40 * MiB;
constexpr size_t WS_MN = 44 * MiB;
constexpr size_t WS_KVM = 46 * MiB;
constexpr size_t WS_PK = 47 * MiB;
constexpr size_t WS_PWT = 47 * MiB + 512 * 1024;
constexpr size_t WS_XN = 48 * MiB;
constexpr size_t WS_Z = 176 * MiB;
constexpr size_t WS_MASK = 512 * MiB;
constexpr size_t WS_UB = 576 * MiB;
constexpr size_t WS_VB = 640 * MiB;
constexpr size_t WS_RSU = 47 * MiB + 128 * 1024, WS_RSV = 47 * MiB + 256 * 1024;
constexpr size_t WS_ROPE = 704 * MiB;
constexpr size_t WS_CAND = 720 * MiB;
constexpr size_t WS_Q8 = WS_UB, WS_K8 = WS_UB + 32 * MiB;
constexpr size_t WS_KI = WS_VB + 32 * MiB;
constexpr size_t WS_V8T = WS_VB;
constexpr size_t WS_XN8 = WS_CAND, WS_BTIN8 = WS_CAND + 72 * MiB, WS_CSI = WS_CAND + 84 * MiB;
constexpr size_t WS_HN8LO = WS_Z;
constexpr size_t WS_HN8 = WS_CAND, WS_BTQ8 = WS_CAND + 64 * MiB, WS_CSQ = WS_CAND + 68 * MiB;
constexpr size_t WS_BTOUT8 = 848 * MiB, WS_CSO = 852 * MiB;
constexpr size_t WS_MIX8 = WS_CAND;
constexpr float MIX8_SCALE = 16.f;
constexpr size_t WS_END = 856 * MiB;
constexpr int CW_BAR = 4096;

#define LDS_WAIT() asm volatile("s_waitcnt lgkmcnt(0)" ::: "memory")
#define VM_WAIT() asm volatile("s_waitcnt vmcnt(0)" ::: "memory")
__device__ __forceinline__ unsigned cvtpk(float lo, float hi) { f32x2 v = {lo, hi}; bf16x2_t b = __builtin_convertvector(v, bf16x2_t); return __builtin_bit_cast(unsigned, b); }
__device__ __forceinline__ float bflo(unsigned w) { return __uint_as_float(w << 16); }
__device__ __forceinline__ float bfhi(unsigned w) { return __uint_as_float(w & 0xffff0000u); }
__device__ __forceinline__ float wave_sum(float v) {
#pragma unroll
    for (int o = 1; o < 64; o <<= 1) v += __shfl_xor(v, o);
    return v;
}
__device__ __forceinline__ unsigned char to_fp8(float v) { return (unsigned char)(__builtin_amdgcn_cvt_pk_fp8_f32(__builtin_amdgcn_fmed3f(v, -448.f, 448.f), 0.f, 0, false) & 0xff); }
__device__ __forceinline__ unsigned f2ord(float s) { unsigned u = __float_as_uint(s); return u ^ (((unsigned)((int)u >> 31)) | 0x80000000u); }

namespace pg8 {
#define PG8_LAS __attribute__((address_space(3)))
constexpr int BM = 256, BK = 64, HALF = 128, HTB = HALF * BK * 2, STAGE_BYTES = 8 * HTB, NXCD = 8, WGM = 8;
__host__ __device__ __forceinline__ int lds_byte(int r, int c) { const int st = (r >> 4) * 2 + (c >> 5), rr = r & 15, cc = c & 31, ob = rr * 64 + cc * 2; return st * 1024 + (ob ^ (((ob >> 9) & 1) << 5)); }
__host__ __device__ __forceinline__ void stage_rc(int b, int& R, int& C) { const int st = b / 1024, sb = b % 1024, swz = sb ^ (((sb >> 9) & 1) << 5); R = (st >> 1) * 16 + swz / 64; C = (st & 1) * 32 + (swz % 64) / 2; }
__host__ __device__ __forceinline__ int perm32(int rho) { const int n = rho >> 4, i = rho & 15; return 8 * (i >> 2) + 4 * n + (i & 3); }
struct Unit { int pm, pn; };
struct Gemm { const bf16_t* A; const bf16_t* Bt; int M, N, K; };
struct StaticOrder {
    int nM, nN, nwg, G, c;
    __host__ __device__ void init(int M, int N, int G_, int c_) { nM = M / BM; nN = N / BM; nwg = nM * nN; G = G_; c = c_; }
    __host__ __device__ bool next(int i, Unit& u) const {
        const long L = (long)i * G + c; if (L >= nwg) return false;
        int wgid = (int)L; { const int q = nwg / NXCD, r = nwg % NXCD, xcd = wgid % NXCD, off = wgid / NXCD; wgid = (xcd < r ? xcd * (q + 1) : r * (q + 1) + (xcd - r) * q) + off; }
        const int nig = WGM * nN, gid = wgid / nig, fm = gid * WGM, gsz = (nM - fm) < WGM ? (nM - fm) : WGM;
        u.pm = fm + ((wgid % nig) % gsz); u.pn = (wgid % nig) / gsz; return true;
    }
    __device__ __forceinline__ void a_ready(const Unit&) const {}
    __device__ __forceinline__ void done(const Unit&) const {}
};
struct InBf16Order {
    StaticOrder S;
    __host__ __device__ void init(int M, int G_, int c_) { S.init(M, 5 * BM, G_, c_); }
    __host__ __device__ bool next(int i, Unit& u) const { if (!S.next(i, u)) return false; u.pn = u.pn < 4 ? 12 + u.pn : 20; return true; }
    __device__ __forceinline__ void a_ready(const Unit&) const {}
    __device__ __forceinline__ void done(const Unit&) const {}
};
struct InFp8Order {
    StaticOrder S; int G, c;
    __host__ __device__ void init(int M, int G_, int c_) { S.init(M, 16 * BM, 1, 0); G = G_; c = c_; }
    __host__ __device__ bool next(int i, Unit& u) const {
        long L;
        if (G == 256 && S.nwg == 2048) {
            if (i < 7) L = (long)i * 256 + c;
            else { const int j = i - 7; int base, cnt;
                if (c < 16) { base = c; cnt = 1; } else if (c < 136) { base = 0; cnt = 0; } else { base = 16 + (c - 136) * 2; cnt = 2; }
                if (j >= cnt) return false; L = 1792 + base + j; }
        } else { L = (long)i * G + c; if (L >= S.nwg) return false; }
        if (!S.next((int)L, u)) return false;
        u.pn = u.pn < 12 ? u.pn : u.pn + 4; return true;
    }
    __device__ __forceinline__ void a_ready(const Unit&) const {}
    __device__ __forceinline__ void done(const Unit&) const {}
};
struct EpiBf16 {
    static constexpr bool PERM = true, AFTER_DRAIN = false;
    bf16_t* O; int ldc;
    __device__ __forceinline__ void operator()(const f32x4 (&acc)[2][2][4][2], const Unit& u, int wr, int wc, int fr, int fq) const {
        const int row0 = u.pm * BM + wr * 64 + fr; const int col0 = u.pn * BM + wc * 32 + 8 * fq;
#pragma unroll
        for (int ai = 0; ai < 2; ++ai)
#pragma unroll
            for (int m = 0; m < 4; ++m) { bf16_t* rowp = O + (size_t)(row0 + ai * HALF + m * 16) * ldc + col0;
#pragma unroll
                for (int bj = 0; bj < 2; ++bj) { const f32x4 v0 = acc[ai][bj][m][0], v1 = acc[ai][bj][m][1];
                    u32x4 w; w.x = cvtpk(v0[0], v0[1]); w.y = cvtpk(v0[2], v0[3]); w.z = cvtpk(v1[0], v1[1]); w.w = cvtpk(v1[2], v1[3]);
                    *(u32x4*)(rowp + bj * HALF) = w; } }
    }
};
struct EpiBf16S {
    static constexpr bool PERM = true, AFTER_DRAIN = false;
    bf16_t* O; int ldc; const float* cs;
    __device__ __forceinline__ void operator()(const f32x4 (&acc)[2][2][4][2], const Unit& u, int wr, int wc, int fr, int fq) const {
        const int row0 = u.pm * BM + wr * 64 + fr; const int col0 = u.pn * BM + wc * 32 + 8 * fq;
        f32x4 s[2][2];
#pragma unroll
        for (int bj = 0; bj < 2; ++bj) { s[bj][0] = *(const f32x4*)(cs + col0 + bj * HALF); s[bj][1] = *(const f32x4*)(cs + col0 + bj * HALF + 4); }
#pragma unroll
        for (int ai = 0; ai < 2; ++ai)
#pragma unroll
            for (int m = 0; m < 4; ++m) { bf16_t* rowp = O + (size_t)(row0 + ai * HALF + m * 16) * ldc + col0;
#pragma unroll
                for (int bj = 0; bj < 2; ++bj) { const f32x4 v0 = acc[ai][bj][m][0] * s[bj][0], v1 = acc[ai][bj][m][1] * s[bj][1];
                    u32x4 w; w.x = cvtpk(v0[0], v0[1]); w.y = cvtpk(v0[2], v0[3]); w.z = cvtpk(v1[0], v1[1]); w.w = cvtpk(v1[2], v1[3]);
                    *(u32x4*)(rowp + bj * HALF) = w; } }
    }
};
struct EpiF32Res {
    static constexpr bool PERM = false, AFTER_DRAIN = false;
    const float* R; float* C; int ldc;
    __device__ __forceinline__ void operator()(const f32x4 (&acc)[2][2][4][2], const Unit& u, int wr, int wc, int fr, int fq) const {
        const int row0 = u.pm * BM + wr * 64 + fr, col0 = u.pn * BM + wc * 32 + 4 * fq;
#pragma unroll
        for (int ai = 0; ai < 2; ++ai)
#pragma unroll
            for (int m = 0; m < 4; ++m) { const size_t off = (size_t)(row0 + ai * HALF + m * 16) * ldc + col0;
#pragma unroll
                for (int bj = 0; bj < 2; ++bj)
#pragma unroll
                    for (int n = 0; n < 2; ++n) *(f32x4*)(C + off + bj * HALF + n * 16) = acc[ai][bj][m][n] + *(const f32x4*)(R + off + bj * HALF + n * 16); }
    }
};

struct EpiF32ResS {
    static constexpr bool PERM = false, AFTER_DRAIN = false;
    const float* R; float* C; int ldc; const float* cs;
    __device__ __forceinline__ void operator()(const f32x4 (&acc)[2][2][4][2], const Unit& u, int wr, int wc, int fr, int fq) const {
        const int row0 = u.pm * BM + wr * 64 + fr, col0 = u.pn * BM + wc * 32 + 4 * fq;
        f32x4 s[2][2];
#pragma unroll
        for (int bj = 0; bj < 2; ++bj)
#pragma unroll
            for (int n = 0; n < 2; ++n) s[bj][n] = *(const f32x4*)(cs + col0 + bj * HALF + n * 16);
#pragma unroll
        for (int ai = 0; ai < 2; ++ai)
#pragma unroll
            for (int m = 0; m < 4; ++m) { const size_t off = (size_t)(row0 + ai * HALF + m * 16) * ldc + col0;
#pragma unroll
                for (int bj = 0; bj < 2; ++bj)
#pragma unroll
                    for (int n = 0; n < 2; ++n) *(f32x4*)(C + off + bj * HALF + n * 16) = acc[ai][bj][m][n] * s[bj][n] + *(const f32x4*)(R + off + bj * HALF + n * 16); }
    }
};
__device__ __forceinline__ i32x8 cat8(bf16x8 a, bf16x8 b) { const i32x4 x = __builtin_bit_cast(i32x4, a), y = __builtin_bit_cast(i32x4, b); return __builtin_shufflevector(x, y, 0, 1, 2, 3, 4, 5, 6, 7); }
template <class Epi, class Sched, bool ALIGN_EPI = false, bool SP2 = false, bool F8 = false>
__device__ __forceinline__ void gemm_phase(PG8_LAS unsigned char* lds, const Gemm g, const Sched& S, const Epi& E) {
    const int tid = threadIdx.x, wid = __builtin_amdgcn_readfirstlane(tid >> 6), lane = tid & 63, wr = wid >> 2, wc = wid & 3, fr = lane & 15, fq = lane >> 4;
    const int K = g.K, nt = K / BK;
    unsigned voffA[2], voffB[2];
#pragma unroll
    for (int i = 0; i < 2; ++i) { int R, C; stage_rc(tid * 16 + i * 8192, R, C); const int Rb = Epi::PERM ? ((R & ~31) + perm32(R & 31)) : R;
        voffA[i] = (unsigned)(R * K + C) * 2u; voffB[i] = (unsigned)(Rb * K + C) * 2u; }
    const size_t kstep = (size_t)(BK * 2);
    const size_t hstep = (size_t)HALF * K * 2;
    const size_t tstep = 2 * hstep;
    const unsigned ldsw = (unsigned)wid * 1024u;
    const int aoff_ = lds_byte(wr * 64 + fr, fq * 8), boff_ = lds_byte(wc * 32 + fr, fq * 8);
#define PG8_SA(b, h) (((b) * 2 + (h)) * HTB)
#define PG8_SB(b, h) ((4 + (b) * 2 + (h)) * HTB)
#define PG8_STAGE(bufoff, gbase, voff) do { _Pragma("unroll") for (int _i = 0; _i < 2; ++_i) \
        __builtin_amdgcn_global_load_lds((const unsigned*)((const char*)(gbase) + (voff)[_i]), (PG8_LAS unsigned*)(lds + (bufoff) + ldsw + _i * 8192), 16, 0, 0); } while (0)
#define PG8_LD1(off) (*(const PG8_LAS bf16x8*)(lds + (off)))
#define PG8_LDA(dst, b, h) do { _Pragma("unroll") for (int m = 0; m < 4; ++m) { if constexpr (F8) dst##8[m] = cat8(PG8_LD1(PG8_SA(b, h) + aoff + m * 2048), PG8_LD1(PG8_SA(b, h) + aoff + m * 2048 + 1024)); \
        else { _Pragma("unroll") for (int k = 0; k < 2; ++k) dst[m][k] = PG8_LD1(PG8_SA(b, h) + aoff + m * 2048 + k * 1024); } } } while (0)
#define PG8_LDB(dst, b, h) do { _Pragma("unroll") for (int n = 0; n < 2; ++n) { if constexpr (F8) dst##8[n] = cat8(PG8_LD1(PG8_SB(b, h) + boff + n * 2048), PG8_LD1(PG8_SB(b, h) + boff + n * 2048 + 1024)); \
        else { _Pragma("unroll") for (int k = 0; k < 2; ++k) dst[n][k] = PG8_LD1(PG8_SB(b, h) + boff + n * 2048 + k * 1024); } } } while (0)
#define PG8_MMA(ai, bj, At, Bt) do { __builtin_amdgcn_s_setprio(1); _Pragma("unroll") for (int m = 0; m < 4; ++m) _Pragma("unroll") for (int n = 0; n < 2; ++n) { \
        if constexpr (F8) asm volatile("v_mfma_f32_16x16x128_f8f6f4 %0, %1, %2, %0" : "+v"(acc[ai][bj][m][n]) : "v"(Bt##8[n]), "v"(At##8[m])); \
        else { _Pragma("unroll") for (int k = 0; k < 2; ++k) acc[ai][bj][m][n] = __builtin_amdgcn_mfma_f32_16x16x32_bf16(Bt[n][k], At[m][k], acc[ai][bj][m][n], 0, 0, 0); } } __builtin_amdgcn_s_setprio(0); } while (0)
#define PG8_WAIT_V(n) asm volatile("s_waitcnt vmcnt(" #n ")" ::: "memory")
#define PG8_WAIT_L(n) asm volatile("s_waitcnt lgkmcnt(" #n ")" ::: "memory")
#define PG8_BAR __builtin_amdgcn_s_barrier()
#define PG8_SCHED __builtin_amdgcn_sched_barrier(0)
    Unit cur, nxt; int ui = 0;
    if (!S.next(0, cur)) return;
    f32x4 acc[2][2][4][2];
#pragma unroll
    for (int a = 0; a < 2; ++a)
#pragma unroll
        for (int b = 0; b < 2; ++b)
#pragma unroll
            for (int m = 0; m < 4; ++m)
#pragma unroll
                for (int n = 0; n < 2; ++n) acc[a][b][m][n] = (f32x4){0.f, 0.f, 0.f, 0.f};
    bf16x8 At[4][2], B0[2][2], B1[2][2]; i32x8 At8[4], B08[2], B18[2];
    const char* cA = (const char*)g.A + (size_t)cur.pm * tstep; const char* cB = (const char*)g.Bt + (size_t)cur.pn * tstep;
    S.a_ready(cur);
    if constexpr (SP2) {
        PG8_STAGE(PG8_SB(0, 0), cB, voffB); PG8_STAGE(PG8_SB(0, 1), cB + hstep, voffB); PG8_STAGE(PG8_SA(0, 0), cA, voffA); PG8_STAGE(PG8_SA(0, 1), cA + hstep, voffA);
        if (wr == 1) PG8_BAR;
        PG8_WAIT_V(2); PG8_BAR;
        PG8_STAGE(PG8_SB(1, 0), cB + kstep, voffB); PG8_STAGE(PG8_SA(1, 0), cA + kstep, voffA); PG8_STAGE(PG8_SB(1, 1), cB + hstep + kstep, voffB);
        PG8_WAIT_V(6); PG8_BAR;
    } else {
        PG8_STAGE(PG8_SB(0, 0), cB, voffB); PG8_STAGE(PG8_SA(0, 0), cA, voffA); PG8_STAGE(PG8_SB(0, 1), cB + hstep, voffB); PG8_STAGE(PG8_SA(0, 1), cA + hstep, voffA);
        if (wr == 1) PG8_BAR;
        PG8_WAIT_V(4); PG8_BAR;
        PG8_STAGE(PG8_SB(1, 0), cB + kstep, voffB); PG8_STAGE(PG8_SA(1, 0), cA + kstep, voffA); PG8_STAGE(PG8_SB(1, 1), cB + hstep + kstep, voffB);
        PG8_WAIT_V(6); PG8_BAR;
    }
    for (;;) {
        const bool has_next = S.next(ui + 1, nxt);
        const char* nA = has_next ? (const char*)g.A + (size_t)nxt.pm * tstep : cA; const char* nB = has_next ? (const char*)g.Bt + (size_t)nxt.pn * tstep : cB;
        for (int t = 0; t < nt; t += 2) {
            const bool last = (t == nt - 2);
            int aoff = aoff_, boff = boff_; if constexpr (F8) asm volatile("" : "+v"(aoff), "+v"(boff));
            const char* a1 = cA + (size_t)(t + 1) * kstep;
            const char* a2 = last ? nA : cA + (size_t)(t + 2) * kstep; const char* b2 = last ? nB : cB + (size_t)(t + 2) * kstep;
            const char* a3 = a2 + kstep; const char* b3 = b2 + kstep;
            if (last && has_next) S.a_ready(nxt);
            if constexpr (SP2) {
            PG8_LDB(B0, 0, 0); PG8_LDB(B1, 0, 1); PG8_SCHED; PG8_LDA(At, 0, 0); PG8_STAGE(PG8_SA(1, 1), a1 + hstep, voffA);
            PG8_WAIT_V(8); PG8_WAIT_L(0); PG8_BAR; PG8_MMA(0, 0, At, B0); PG8_MMA(0, 1, At, B1); PG8_BAR; PG8_SCHED;
            PG8_LDA(At, 0, 1); PG8_STAGE(PG8_SB(0, 0), b2, voffB); PG8_STAGE(PG8_SB(0, 1), b2 + hstep, voffB); PG8_STAGE(PG8_SA(0, 0), a2, voffA);
            PG8_WAIT_V(8); PG8_WAIT_L(0); PG8_BAR; PG8_MMA(1, 0, At, B0); PG8_MMA(1, 1, At, B1); PG8_BAR; PG8_SCHED;
            PG8_LDB(B0, 1, 0); PG8_LDB(B1, 1, 1); PG8_SCHED; PG8_LDA(At, 1, 0); PG8_STAGE(PG8_SA(0, 1), a2 + hstep, voffA);
            PG8_WAIT_V(8); PG8_WAIT_L(0); PG8_BAR; PG8_MMA(0, 0, At, B0); PG8_MMA(0, 1, At, B1); PG8_BAR; PG8_SCHED;
            PG8_LDA(At, 1, 1); PG8_STAGE(PG8_SB(1, 0), b3, voffB); PG8_STAGE(PG8_SB(1, 1), b3 + hstep, voffB); PG8_STAGE(PG8_SA(1, 0), a3, voffA);
            PG8_WAIT_V(8); PG8_WAIT_L(0); PG8_BAR; PG8_MMA(1, 0, At, B0); PG8_MMA(1, 1, At, B1); PG8_BAR; PG8_SCHED;
            } else {
            PG8_LDB(B0, 0, 0); PG8_SCHED; PG8_LDA(At, 0, 0); PG8_STAGE(PG8_SA(1, 1), a1 + hstep, voffA);
            PG8_WAIT_L(8); PG8_BAR; PG8_WAIT_L(0); PG8_MMA(0, 0, At, B0); PG8_BAR; PG8_SCHED;
            PG8_LDB(B1, 0, 1); PG8_STAGE(PG8_SB(0, 0), b2, voffB);
            PG8_BAR; PG8_WAIT_L(0); PG8_MMA(0, 1, At, B1); PG8_BAR;
            PG8_LDA(At, 0, 1); PG8_STAGE(PG8_SA(0, 0), a2, voffA);
            PG8_BAR; PG8_WAIT_L(0); PG8_MMA(1, 0, At, B0); PG8_BAR; PG8_SCHED;
            PG8_STAGE(PG8_SB(0, 1), b2 + hstep, voffB);
            PG8_WAIT_V(6); PG8_BAR; PG8_MMA(1, 1, At, B1); PG8_BAR;
            PG8_LDB(B0, 1, 0); PG8_SCHED; PG8_LDA(At, 1, 0); PG8_STAGE(PG8_SA(0, 1), a2 + hstep, voffA);
            PG8_WAIT_L(8); PG8_BAR; PG8_WAIT_L(0); PG8_MMA(0, 0, At, B0); PG8_BAR; PG8_SCHED;
            PG8_LDB(B1, 1, 1); PG8_STAGE(PG8_SB(1, 0), b3, voffB);
            PG8_BAR; PG8_WAIT_L(0); PG8_MMA(0, 1, At, B1); PG8_BAR;
            PG8_LDA(At, 1, 1); PG8_STAGE(PG8_SA(1, 0), a3, voffA);
            PG8_BAR; PG8_WAIT_L(0); PG8_MMA(1, 0, At, B0); PG8_BAR; PG8_SCHED;
            PG8_STAGE(PG8_SB(1, 1), b3 + hstep, voffB);
            PG8_WAIT_V(6); PG8_BAR; PG8_MMA(1, 1, At, B1); PG8_BAR;
            }
        }
        if constexpr (ALIGN_EPI) { if (wr == 0) PG8_BAR; }
        if constexpr (F8) asm volatile("s_nop 15\n\ts_nop 15" ::: "memory");
        if constexpr (!Epi::AFTER_DRAIN) { E(acc, cur, wr, wc, fr, fq); S.done(cur); }
        if (!has_next) break;
#pragma unroll
        for (int a = 0; a < 2; ++a)
#pragma unroll
            for (int b = 0; b < 2; ++b)
#pragma unroll
                for (int m = 0; m < 4; ++m)
#pragma unroll
                    for (int n = 0; n < 2; ++n) acc[a][b][m][n] = (f32x4){0.f, 0.f, 0.f, 0.f};
        cur = nxt; cA = nA; cB = nB; ++ui;
        if constexpr (ALIGN_EPI) { if (wr == 1) PG8_BAR; }
    }
    PG8_WAIT_V(0);
    if constexpr (!ALIGN_EPI) { if (wr == 0) PG8_BAR; }
    PG8_BAR;
#undef PG8_SA
#undef PG8_SB
#undef PG8_STAGE
#undef PG8_LDA
#undef PG8_LD1
#undef PG8_LDB
#undef PG8_MMA
#undef PG8_WAIT_V
#undef PG8_WAIT_L
#undef PG8_BAR
#undef PG8_SCHED
}
}

namespace att {
constexpr int D = 128, NW = 8, QBLK = 32, KVBLK = 64;
constexpr float SCALE = 0.088388347648318440f;
constexpr size_t SHM_V = KVBLK * D * 2, SHM_K = KVBLK * D * 2, SHM_ATTN = 2 * SHM_V + 2 * SHM_K + NW * 64 * 4;
#define KSWZ(row, colB) ((row) * 256 + ((colB) ^ (((row) & 7) << 4)))
#define KSWZ8(row, colB) ((row) * 128 + ((colB) ^ ((((row) >> 1) & 7) << 4)))
#define SBAR() __builtin_amdgcn_sched_barrier(0)
__device__ __forceinline__ int crow(int r, int hi) { return (r & 3) + 8 * (r >> 2) + 4 * hi; }
template <bool MASKED> __device__ __forceinline__ void mask_apply(f32x16& p, unsigned w) {
    if constexpr (MASKED) {
#pragma unroll
        for (int r = 0; r < 16; ++r) { const unsigned m = (unsigned)__builtin_amdgcn_sbfe((int)w, (unsigned)((r & 3) + 8 * (r >> 2)), 1u); p[r] = __uint_as_float((__float_as_uint(p[r]) & m) | (0xFF800000u & ~m)); }
    }
}
template <bool MASKED, bool P8 = false> __device__ __forceinline__ void partialSM(f32x16& p0, f32x16& p1, float& m_reg, float& mn, float& alpha, unsigned long long mk, int sh4) {
    constexpr float C = SCALE * 1.4426950408889634f; constexpr float THR = P8 ? 5.f : 8.f;
    float pmax = p0[0];
#pragma unroll
    for (int r = 1; r < 16; ++r) pmax = fmaxf(pmax, p0[r]);
#pragma unroll
    for (int r = 0; r < 16; ++r) pmax = fmaxf(pmax, p1[r]);
    { auto rr = __builtin_amdgcn_permlane32_swap(__float_as_uint(pmax), __float_as_uint(pmax), false, false);
      pmax = fmaxf(__uint_as_float(rr[0]), __uint_as_float(rr[1])); }
    if (__builtin_expect(__all(pmax - m_reg <= THR / SCALE), 1)) { mn = m_reg; alpha = 1.f; }
    else { mn = fmaxf(m_reg, pmax); alpha = __builtin_amdgcn_exp2f((m_reg - mn) * C); m_reg = mn; }
    const float mnC = -mn * C;
#pragma unroll
    for (int r = 0; r < 16; ++r) p0[r] = fmaf(p0[r], C, mnC);
#pragma unroll
    for (int r = 0; r < 16; ++r) p1[r] = fmaf(p1[r], C, mnC);
#pragma unroll
    for (int r = 0; r < 16; ++r) p0[r] = __builtin_amdgcn_exp2f(p0[r]);
}
template <bool MASKED> __device__ __forceinline__ void finishSM(f32x16& p0, f32x16& p1, float alpha, float& l_reg, bf16x8& pa0, bf16x8& pa1, bf16x8& pa2, bf16x8& pa3, unsigned long long mk, int sh4) {
#pragma unroll
    for (int r = 0; r < 16; ++r) p1[r] = __builtin_amdgcn_exp2f(p1[r]);
    float ps = 0;
#pragma unroll
    for (int r = 0; r < 16; ++r) ps += p0[r];
#pragma unroll
    for (int r = 0; r < 16; ++r) ps += p1[r];
    { auto rr = __builtin_amdgcn_permlane32_swap(__float_as_uint(ps), __float_as_uint(ps), false, false);
      ps = __uint_as_float(rr[0]) + __uint_as_float(rr[1]); }
    l_reg = l_reg * alpha + ps;
#define PK4(P, BASE, OUT) do { unsigned a0 = cvtpk(P[BASE + 0], P[BASE + 1]), a1 = cvtpk(P[BASE + 2], P[BASE + 3]);   \
    unsigned b0 = cvtpk(P[BASE + 4], P[BASE + 5]), b1 = cvtpk(P[BASE + 6], P[BASE + 7]);                              \
    auto r0 = __builtin_amdgcn_permlane32_swap(a0, b0, false, false); auto r1 = __builtin_amdgcn_permlane32_swap(a1, b1, false, false); \
    u32x4 w = {r0[0], r1[0], r0[1], r1[1]}; OUT = *reinterpret_cast<bf16x8*>(&w); } while (0)
    PK4(p0, 0, pa0); PK4(p0, 8, pa1); PK4(p1, 0, pa2); PK4(p1, 8, pa3);
#undef PK4
}
__device__ __forceinline__ void finishSM8(f32x16& p0, f32x16& p1, i32x8& pa) {
#pragma unroll
    for (int r = 0; r < 16; ++r) p1[r] = __builtin_amdgcn_exp2f(p1[r]);
#pragma unroll
    for (int q = 0; q < 4; ++q) { int w = __builtin_amdgcn_cvt_pk_fp8_f32(p0[4 * q], p0[4 * q + 1], 0, false); pa[q] = __builtin_amdgcn_cvt_pk_fp8_f32(p0[4 * q + 2], p0[4 * q + 3], w, true);
        int v = __builtin_amdgcn_cvt_pk_fp8_f32(p1[4 * q], p1[4 * q + 1], 0, false); pa[4 + q] = __builtin_amdgcn_cvt_pk_fp8_f32(p1[4 * q + 2], p1[4 * q + 3], v, true); }
}
#define VSWZ8(d, c) ((d) * 64 + ((((c) ^ (((d) >> 2) & 3))) << 4))
__device__ __forceinline__ void pv8(f32x16* o, f32x16& lacc, const char* ones, const char* Vt, const i32x8 pa, int r32, int hi) {
    { const i32x8 ob = pg8::cat8(*reinterpret_cast<const bf16x8*>(ones), *reinterpret_cast<const bf16x8*>(ones + 16));
      lacc = __builtin_amdgcn_mfma_scale_f32_32x32x64_f8f6f4(pa, ob, lacc, 0, 0, 0, 0, 0, 0); }
#pragma unroll
    for (int d0 = 0; d0 < 4; ++d0) { const int d = d0 * 32 + r32;
        const i32x8 vb = pg8::cat8(*reinterpret_cast<const bf16x8*>(Vt + VSWZ8(d, 2 * hi)), *reinterpret_cast<const bf16x8*>(Vt + VSWZ8(d, 2 * hi + 1)));
        o[d0] = __builtin_amdgcn_mfma_scale_f32_32x32x64_f8f6f4(pa, vb, o[d0], 0, 0, 0, 0, 0, 0); }
}
template <bool MASKED> __device__ __forceinline__ void qkt(f32x16& p0, f32x16& p1, const bf16_t* Ks, const bf16x8* qs, int r32, int hi, unsigned long long mk, int sh4, const char* lut) {
    if constexpr (MASKED) {
        const unsigned wl = (unsigned)mk >> sh4, wh = (unsigned)(mk >> 32) >> sh4;
#pragma unroll
        for (int g = 0; g < 4; ++g) { const f32x4 b0 = *(const f32x4*)(lut + ((wl >> (8 * g)) & 15u) * 16), b1 = *(const f32x4*)(lut + ((wh >> (8 * g)) & 15u) * 16);
            p0[4 * g] = b0.x; p0[4 * g + 1] = b0.y; p0[4 * g + 2] = b0.z; p0[4 * g + 3] = b0.w; p1[4 * g] = b1.x; p1[4 * g + 1] = b1.y; p1[4 * g + 2] = b1.z; p1[4 * g + 3] = b1.w; }
    } else { p0 = f32x16{}; p1 = f32x16{}; }
#pragma unroll
    for (int d0 = 0; d0 < 8; ++d0) { int cb = (d0 * 16 + hi * 8) * 2;
        bf16x8 b0 = *reinterpret_cast<const bf16x8*>((const char*)Ks + KSWZ(r32, cb));
        bf16x8 b1 = *reinterpret_cast<const bf16x8*>((const char*)Ks + KSWZ(32 + r32, cb));
        const bf16x8 qf = qs[d0 * 64];
        p0 = __builtin_amdgcn_mfma_f32_32x32x16_bf16(b0, qf, p0, 0, 0, 0);
        p1 = __builtin_amdgcn_mfma_f32_32x32x16_bf16(b1, qf, p1, 0, 0, 0); }
}
template <bool MASKED> __device__ __forceinline__ void qkt8(f32x16& p0, f32x16& p1, const char* Ks, const bf16x8* qs, int r32, int hi, unsigned long long mk, int sh4, const char* lut) {
    if constexpr (MASKED) {
        const unsigned wl = (unsigned)mk >> sh4, wh = (unsigned)(mk >> 32) >> sh4;
#pragma unroll
        for (int g = 0; g < 4; ++g) { const f32x4 b0 = *(const f32x4*)(lut + ((wl >> (8 * g)) & 15u) * 16), b1 = *(const f32x4*)(lut + ((wh >> (8 * g)) & 15u) * 16);
            p0[4 * g] = b0.x; p0[4 * g + 1] = b0.y; p0[4 * g + 2] = b0.z; p0[4 * g + 3] = b0.w; p1[4 * g] = b1.x; p1[4 * g + 1] = b1.y; p1[4 * g + 2] = b1.z; p1[4 * g + 3] = b1.w; }
    } else { p0 = f32x16{}; p1 = f32x16{}; }
#pragma unroll
    for (int s2 = 0; s2 < 2; ++s2) { const int cb = (s2 * 4 + hi * 2) * 16;
        const i32x8 a0 = pg8::cat8(*reinterpret_cast<const bf16x8*>(Ks + KSWZ8(r32, cb)), *reinterpret_cast<const bf16x8*>(Ks + KSWZ8(r32, cb + 16)));
        const i32x8 a1 = pg8::cat8(*reinterpret_cast<const bf16x8*>(Ks + KSWZ8(32 + r32, cb)), *reinterpret_cast<const bf16x8*>(Ks + KSWZ8(32 + r32, cb + 16)));
        const i32x8 qf = pg8::cat8(qs[(2 * s2) * 64], qs[(2 * s2 + 1) * 64]);
        p0 = __builtin_amdgcn_mfma_scale_f32_32x32x64_f8f6f4(a0, qf, p0, 0, 0, 0, 0, 0, 0);
        p1 = __builtin_amdgcn_mfma_scale_f32_32x32x64_f8f6f4(a1, qf, p1, 0, 0, 0, 0, 0, 0); }
}
__device__ __forceinline__ int v_st(int k, int c) { const int kk = (k & ~0xC) | ((k & 4) << 1) | ((k & 8) >> 1); return ((kk >> 3) * 4 + (c >> 5)) * 512 + ((kk & 7) * 32 + (c & 31)) * 2; }
__device__ __forceinline__ int v_rd_base(int lane) { return ((lane & 3) << 3) | (((lane >> 2) & 3) << 6) | (((lane >> 4) & 1) << 5) | (((lane >> 5) & 1) << 8); }
constexpr int v_rd_off(int d0, int ks, int half) { return d0 * 512 + ks * 4096 + half * 2048; }
template <int OFF> __device__ __forceinline__ s16x4 tr_read(int vb) {
    s16x4 r; asm volatile("ds_read_b64_tr_b16 %0, %1 offset:%2" : "=&v"(r) : "v"(vb), "i"(OFF) : "memory"); return r;
}
template <int D0> __device__ __forceinline__ void pv_one(f32x16& od, int vb, bf16x8 pa0, bf16x8 pa1, bf16x8 pa2, bf16x8 pa3) {
    const s16x4 l0 = tr_read<v_rd_off(D0, 0, 0)>(vb), h0 = tr_read<v_rd_off(D0, 0, 1)>(vb), l1 = tr_read<v_rd_off(D0, 1, 0)>(vb), h1 = tr_read<v_rd_off(D0, 1, 1)>(vb);
    const s16x4 l2 = tr_read<v_rd_off(D0, 2, 0)>(vb), h2 = tr_read<v_rd_off(D0, 2, 1)>(vb), l3 = tr_read<v_rd_off(D0, 3, 0)>(vb), h3 = tr_read<v_rd_off(D0, 3, 1)>(vb);
    asm volatile("s_waitcnt lgkmcnt(0)" ::: "memory"); SBAR();
#define PK(L, H) (bf16x8){L[0], L[1], L[2], L[3], H[0], H[1], H[2], H[3]}
    od = __builtin_amdgcn_mfma_f32_32x32x16_bf16(pa0, PK(l0, h0), od, 0, 0, 0);
    od = __builtin_amdgcn_mfma_f32_32x32x16_bf16(pa1, PK(l1, h1), od, 0, 0, 0);
    od = __builtin_amdgcn_mfma_f32_32x32x16_bf16(pa2, PK(l2, h2), od, 0, 0, 0);
    od = __builtin_amdgcn_mfma_f32_32x32x16_bf16(pa3, PK(l3, h3), od, 0, 0, 0);
#undef PK
}
__device__ __forceinline__ void pv_d0(f32x16* o, int vb, bf16x8 pa0, bf16x8 pa1, bf16x8 pa2, bf16x8 pa3) {
    pv_one<0>(o[0], vb, pa0, pa1, pa2, pa3); pv_one<1>(o[1], vb, pa0, pa1, pa2, pa3); pv_one<2>(o[2], vb, pa0, pa1, pa2, pa3); pv_one<3>(o[3], vb, pa0, pa1, pa2, pa3);
}
template <bool MASKED, int SDEPTH, int ldq, int ldk, int ldo, bool QK8 = false, bool PV8 = false>
__device__ __forceinline__ void attn_body(const bf16_t* __restrict__ Qb, const bf16_t* __restrict__ Kh, const bf16_t* __restrict__ Vh,
                                          bf16_t* __restrict__ Ob, int seq, const unsigned long long* __restrict__ mrow, char* lds,
                                          const unsigned char* __restrict__ Q8b = nullptr, const unsigned char* __restrict__ K8h = nullptr, const unsigned char* __restrict__ V8h = nullptr, unsigned char* __restrict__ O8b = nullptr) {
    int tid = (int)threadIdx.x; asm volatile("" : "+v"(tid));
    const int wid = tid >> 6, lane = tid & 63, r32 = lane & 31, hi = lane >> 5, sh4 = 4 * hi;
    bf16_t* V_lds = (bf16_t*)lds; bf16_t* K_lds = (bf16_t*)(lds + 2 * SHM_V);
    float* ws = (float*)(lds + 2 * SHM_V + 2 * SHM_K) + wid * 64; float* li_l = ws; float* al_l = ws + 32;
    float m_reg = -1e30f, l_reg = 0; f32x16 o[4] = {}; f32x16 lacc = {};
    const bf16_t* Qw = Qb + (long)(wid * QBLK + r32) * ldq + hi * 8;
    bf16x8* qr = (bf16x8*)(lds + SHM_ATTN) + wid * 512 + lane;
    if constexpr (QK8) { const unsigned char* Q8w = Q8b + (long)(wid * QBLK + r32) * 1024 + hi * 32;
#pragma unroll
        for (int j = 0; j < 4; ++j) qr[j * 64] = *reinterpret_cast<const bf16x8*>(Q8w + (j >> 1) * 64 + (j & 1) * 16);
    } else {
#pragma unroll
        for (int d0 = 0; d0 < 8; ++d0) qr[d0 * 64] = *reinterpret_cast<const bf16x8*>(Qw + d0 * 16); }
    const char* lut = lds + SHM_ATTN + 65536;
    if (MASKED && tid < 64) ((float*)(lds + SHM_ATTN + 65536))[tid] = ((tid >> 2) >> (tid & 3)) & 1 ? 0.f : -INFINITY;
    const char* ones = lds + SHM_ATTN + 65536 + 256;
    if (PV8 && tid < 8) ((unsigned*)(lds + SHM_ATTN + 65536 + 256))[tid] = 0x38383838u;
    const int sr = tid >> 4, sc = (tid & 15) * 8, vst0 = v_st(sr, sc), vst1 = v_st(32 + sr, sc);
    const int vb0 = (int)(uintptr_t)V_lds + v_rd_base(lane);
    struct { bf16x8 vs0, vs1, ks0, ks1; } sr_[SDEPTH];
    const int kr8 = tid >> 3, kc8 = (tid & 7) * 16;
#define SLOAD(i, k0) do { if constexpr (PV8) sr_[i].vs0 = *reinterpret_cast<const bf16x8*>(V8h + (long)(k0) * 128 + tid * 16); \
    else { sr_[i].vs0 = *reinterpret_cast<const bf16x8*>(&Vh[(long)((k0) + sr) * ldk + sc]); sr_[i].vs1 = *reinterpret_cast<const bf16x8*>(&Vh[(long)((k0) + 32 + sr) * ldk + sc]); } \
    if constexpr (QK8) sr_[i].ks0 = *reinterpret_cast<const bf16x8*>(K8h + (long)((k0) + kr8) * 1024 + kc8); \
    else { sr_[i].ks0 = *reinterpret_cast<const bf16x8*>(&Kh[(long)((k0) + sr) * ldk + sc]); sr_[i].ks1 = *reinterpret_cast<const bf16x8*>(&Kh[(long)((k0) + 32 + sr) * ldk + sc]); } } while (0)
#define SWRITE(b, i) do { if constexpr (PV8) *(bf16x8*)((char*)V_lds + (b) * SHM_V + VSWZ8(tid >> 2, tid & 3)) = sr_[i].vs0; \
    else { *(bf16x8*)((char*)V_lds + (b) * SHM_V + vst0) = sr_[i].vs0;          \
    *(bf16x8*)((char*)V_lds + (b) * SHM_V + vst1) = sr_[i].vs1; } int kc = sc * 2;               \
    if constexpr (QK8) *(bf16x8*)((char*)K_lds + (b) * SHM_K + KSWZ8(kr8, kc8)) = sr_[i].ks0;  \
    else { *(bf16x8*)((char*)K_lds + (b) * SHM_K + KSWZ(sr, kc)) = sr_[i].ks0;                  \
    *(bf16x8*)((char*)K_lds + (b) * SHM_K + KSWZ(32 + sr, kc)) = sr_[i].ks1; } } while (0)
#define SWAIT() do { if constexpr (SDEPTH == 2) { if constexpr (QK8 && PV8) asm volatile("s_waitcnt vmcnt(2)" ::: "memory"); else if constexpr (QK8) asm volatile("s_waitcnt vmcnt(3)" ::: "memory"); else asm volatile("s_waitcnt vmcnt(4)" ::: "memory"); } else asm volatile("s_waitcnt vmcnt(0)" ::: "memory"); } while (0)
#define FIN(P0, P1, AL, MK) do { if constexpr (PV8) finishSM8(P0, P1, pa8); else finishSM<MASKED>(P0, P1, AL, l_reg, pa0, pa1, pa2, pa3, MK, sh4); } while (0)
#define PVD(VOFF) do { if constexpr (PV8) pv8(o, lacc, ones, (const char*)V_lds + (VOFF), pa8, r32, hi); else pv_d0(o, vb0 + (int)(VOFF), pa0, pa1, pa2, pa3); } while (0)
#define QKT(P0, P1, KB, MK) do { if constexpr (QK8) qkt8<MASKED>(P0, P1, (const char*)(KB), qr, r32, hi, MK, sh4, lut); else qkt<MASKED>(P0, P1, (const bf16_t*)(KB), qr, r32, hi, MK, sh4, lut); } while (0)
#define RESC(a) do { if (__any((a) < 1.f)) { if (hi == 0) al_l[r32] = (a); asm volatile("s_waitcnt lgkmcnt(0)" ::: "memory"); \
    _Pragma("unroll") for (int d = 0; d < 4; ++d) _Pragma("unroll") for (int r = 0; r < 16; ++r) o[d][r] *= al_l[crow(r, hi)]; \
    if constexpr (PV8) { _Pragma("unroll") for (int r = 0; r < 16; ++r) lacc[r] *= al_l[crow(r, hi)]; } } } while (0)
    f32x16 pA0, pA1, pB0, pB1; float mnA, mnB, alA, alB; bf16x8 pa0, pa1, pa2, pa3; i32x8 pa8; const int NT = seq / KVBLK;
    unsigned long long mkA = 0, mkB = 0;
    constexpr int SE = 0, SO = SDEPTH - 1;
    if constexpr (MASKED) mkA = mrow[0];
    SLOAD(SE, 0); asm volatile("s_waitcnt vmcnt(0)" ::: "memory"); SWRITE(0, SE); __syncthreads();
    QKT(pA0, pA1, K_lds, mkA); partialSM<MASKED, PV8>(pA0, pA1, m_reg, mnA, alA, mkA, sh4);
    if constexpr (MASKED) mkB = mrow[1];
    SLOAD(SO, KVBLK); if constexpr (SDEPTH == 2) { if (2 < NT) SLOAD(SE, 2 * KVBLK); }
    SWAIT(); SWRITE(1, SO); __syncthreads();
    for (int j = 1; j + 1 < NT; j += 2) {
        SBAR(); QKT(pB0, pB1, (char*)K_lds + SHM_K, mkB);
        FIN(pA0, pA1, alA, mkA); SBAR();
        if constexpr (MASKED) mkA = mrow[j + 1];
        SLOAD(SO, (j + SDEPTH) * KVBLK); SBAR();
        PVD(0); partialSM<MASKED, PV8>(pB0, pB1, m_reg, mnB, alB, mkB, sh4);
        __syncthreads(); SWAIT(); SWRITE(0, SE);
        RESC(alB); __syncthreads();
        SBAR(); QKT(pA0, pA1, K_lds, mkA);
        FIN(pB0, pB1, alB, mkB); SBAR();
        if constexpr (MASKED) { if (j + 2 < NT) mkB = mrow[j + 2]; }
        if (SDEPTH == 1 || j + 3 < NT) SLOAD(SE, (j + 1 + SDEPTH) * KVBLK); SBAR();
        PVD(SHM_V); partialSM<MASKED, PV8>(pA0, pA1, m_reg, mnA, alA, mkA, sh4);
        __syncthreads(); SWAIT(); SWRITE(1, SO);
        RESC(alA); __syncthreads();
    }
    SBAR(); QKT(pB0, pB1, (char*)K_lds + SHM_K, mkB);
    FIN(pA0, pA1, alA, mkA); SBAR();
    PVD(0); partialSM<MASKED, PV8>(pB0, pB1, m_reg, mnB, alB, mkB, sh4);
    __syncthreads(); RESC(alB);
    FIN(pB0, pB1, alB, mkB); SBAR();
    PVD(SHM_V);
    float rli[16];
    if constexpr (PV8) {
#pragma unroll
        for (int r = 0; r < 16; ++r) rli[r] = __builtin_amdgcn_rcpf(lacc[r]);
    } else {
        if (hi == 0) li_l[r32] = l_reg; asm volatile("s_waitcnt lgkmcnt(0)" ::: "memory");
#pragma unroll
        for (int r = 0; r < 16; ++r) rli[r] = __builtin_amdgcn_rcpf(li_l[crow(r, hi)]); }
    if (O8b) {
        unsigned char* O8w = O8b + (long)(wid * QBLK) * ldo;
#pragma unroll
        for (int r = 0; r < 16; ++r) { const int orow = crow(r, hi); const float sc8 = rli[r] * MIX8_SCALE;
#pragma unroll
            for (int d0 = 0; d0 < 4; ++d0) O8w[(long)orow * ldo + d0 * 32 + r32] = to_fp8(o[d0][r] * sc8); }
    } else {
    bf16_t* Ow = Ob + (long)(wid * QBLK) * ldo;
#pragma unroll
    for (int r = 0; r < 16; ++r) { const int orow = crow(r, hi);
#pragma unroll
        for (int d0 = 0; d0 < 4; ++d0) Ow[(long)orow * ldo + d0 * 32 + r32] = (bf16_t)(cvtpk(o[d0][r] * rli[r], 0.f) & 0xffffu); }
    }
    __syncthreads();
#undef SLOAD
#undef SWRITE
#undef SWAIT
#undef QKT
#undef FIN
#undef PVD
#undef RESC
}
#undef KSWZ
#undef KSWZ8
#undef VSWZ8
#undef SBAR
}

#define XB_TMO      128
#define XB_XCNT(j)  (256  + 64 * (j))
#define XB_XSUB(j)  (1280 + 64 * (j))
#define XB_XGEN(j)  (2304 + 64 * (j))
#define XB_TOP      3328
#define XB_TOPGEN   3392
#define XCD_BAR_WORDS 3456
#define XB_SPIN_CAP (1u << 22)
__device__ __forceinline__ unsigned xb_ld(unsigned* p)              { return __hip_atomic_load(p, __ATOMIC_RELAXED, __HIP_MEMORY_SCOPE_AGENT); }
__device__ __forceinline__ unsigned xb_add(unsigned* p, unsigned v) { return __hip_atomic_fetch_add(p, v, __ATOMIC_RELAXED, __HIP_MEMORY_SCOPE_AGENT); }
__device__ __forceinline__ unsigned xb_xcc_id() { return (unsigned)__builtin_amdgcn_s_getreg((3 << 11) | 20) & 0xFu; }
#define XB_SPIN(cond, bar) do { unsigned _sp = 0; while (cond) { __builtin_amdgcn_s_sleep(1); \
    if ((++_sp & 255u) == 0u) { if (xb_ld(&(bar)[XB_TMO])) break; if (_sp > XB_SPIN_CAP) { atomicAdd(&(bar)[XB_TMO], 1u); break; } } } } while (0)
struct XcdBarrier { unsigned* bar; unsigned x; volatile LAS unsigned* st; };
__device__ __forceinline__ XcdBarrier xcd_barrier_post(unsigned* bar, volatile LAS unsigned* st) {
    XcdBarrier b; b.bar = bar; b.x = xb_xcc_id(); b.st = st;
    if (threadIdx.x == 0) (void)xb_add(&bar[XB_XCNT(b.x)], 1u);
    return b;
}
__device__ __forceinline__ void xcd_barrier_complete(unsigned* bar, unsigned x, unsigned& nloc, unsigned& nx) {
    const unsigned G = gridDim.x * gridDim.y * gridDim.z;
    unsigned sum, cnt, mine, sp = 0u;
    for (;;) {
        sum = 0u; cnt = 0u; mine = 0u;
#pragma unroll
        for (unsigned j = 0; j < 16; ++j) { const unsigned c = xb_ld(&bar[XB_XCNT(j)]); sum += c; cnt += (c > 0u) ? 1u : 0u; mine = (j == x) ? c : mine; }
        if (sum == G) break;
        __builtin_amdgcn_s_sleep(1);
        if ((++sp & 255u) == 0u) { if (xb_ld(&bar[XB_TMO])) break; if (sp > XB_SPIN_CAP) { atomicAdd(&bar[XB_TMO], 1u); break; } }
    }
    nloc = mine > 0u ? mine : 1u; nx = cnt > 0u ? cnt : 1u;
}
__device__ __forceinline__ void xcd_barrier(const XcdBarrier& b) {
    asm volatile("s_waitcnt vmcnt(0)" ::: "memory");
    __syncthreads();
    if (threadIdx.x == 0) {
        unsigned* bar = b.bar;
        __builtin_amdgcn_s_waitcnt(0);
        unsigned nloc = b.st[0], nx = b.st[1];
        if (nloc == 0u) { xcd_barrier_complete(bar, b.x, nloc, nx); b.st[0] = nloc; b.st[1] = nx; }
        const unsigned old = xb_add(&bar[XB_XSUB(b.x)], 1u);
        const unsigned gen = old / nloc;
        if (old + 1u == (gen + 1u) * nloc) {
            __builtin_amdgcn_fence(__ATOMIC_RELEASE, "agent");
            asm volatile("s_waitcnt vmcnt(0)" ::: "memory");
            const unsigned og = xb_add(&bar[XB_TOP], 1u);
            const unsigned tg = og / nx;
            if (og + 1u == (tg + 1u) * nx) xb_add(&bar[XB_TOPGEN], 1u);
            else XB_SPIN(xb_ld(&bar[XB_TOPGEN]) == tg, bar);
            __builtin_amdgcn_fence(__ATOMIC_ACQUIRE, "agent");
            xb_add(&bar[XB_XGEN(b.x)], 1u);
            asm volatile("s_waitcnt vmcnt(0)" ::: "memory");
        } else {
            XB_SPIN(xb_ld(&bar[XB_XGEN(b.x)]) == gen, bar);
            __builtin_amdgcn_fence(__ATOMIC_ACQUIRE, "agent");
            asm volatile("s_waitcnt vmcnt(0)" ::: "memory");
        }
    }
    __syncthreads();
}

constexpr int NWAVES = 8;
constexpr int RING_BYTES = 151 * 1024;
constexpr int LDSCTL_OFF = RING_BYTES, MISC_OFF = LDSCTL_OFF + 320;
constexpr int LDS_BYTES = 152 * 1024;
static_assert(MISC_OFF + 128 <= LDS_BYTES, "LDS map");
constexpr int N_PHASES = 13;

struct Args {
    const float* x; const float* mem; const float* attn_g; const float* w_in; const float* q_g; const float* k_g; const float* pool_w; const float* pool_s;
    const float* mem_g; const float* w_kv; const float* mq_g; const float* mk_g; const float* w_out; const float* ffn_g; const float* w_q; const float* sk1; const float* sk2;
    const float* pu; const float* pv; float* out; unsigned char* ws; int ph_lo, ph_hi;
};
struct Frame {
    LAS unsigned char* lds; char* ldsg;
    int tid, lane, wave, vcu, G;
};

__device__ __forceinline__ int in_colmap(int n) {
    if (n < 4096) return n;
    if (n < 4608) return 4176 + (n - 4096);
    if (n < 5120) return 4688 + (n - 4608);
    if (n < 5184) return 4096 + (n - 5120);
    if (n < 5200) return 4160 + (n - 5184);
    return -1;
}
template <int MAP> __device__ __forceinline__ void p0_transpose_item(const float* W, int K, int N, bf16_t* WT, LAS float* scr, int kb, int nb, int lane) {
    const int k0 = 64 * kb, n0 = 32 * nb;
    const int c4 = lane & 7, rg = lane >> 3;
    int nsrc = n0 + 4 * c4; if (MAP == 1) nsrc = in_colmap(nsrc);
#pragma unroll
    for (int i = 0; i < 8; ++i) { const int kk = 8 * i + rg; const f32x4 v = nsrc >= 0 ? *(const f32x4*)(W + (size_t)(k0 + kk) * N + nsrc) : (f32x4){0.f, 0.f, 0.f, 0.f};
        LAS float* d = scr + kk * 33 + 4 * c4; d[0] = v.x; d[1] = v.y; d[2] = v.z; d[3] = v.w; }
    LDS_WAIT();
    const int c = lane & 7;
#pragma unroll
    for (int j = 0; j < 4; ++j) { const int n = (lane >> 3) + 8 * j; const LAS float* s = scr + (8 * c) * 33 + n;
        u32x4 o; o.x = cvtpk(s[0 * 33], s[1 * 33]); o.y = cvtpk(s[2 * 33], s[3 * 33]); o.z = cvtpk(s[4 * 33], s[5 * 33]); o.w = cvtpk(s[6 * 33], s[7 * 33]);
        *(u32x4*)(WT + (size_t)(n0 + n) * K + k0 + 8 * c) = o; }
    LDS_WAIT();
}
__device__ __forceinline__ void rms_row_to_bf16(const float* xrow, const float* gain, bf16_t* orow, int lane) {
    const f32x4* xr = (const f32x4*)xrow + lane;
    f32x4 v[8]; float s = 0.f;
#pragma unroll
    for (int j = 0; j < 8; ++j) { v[j] = xr[64 * j]; s += (v[j].x * v[j].x + v[j].y * v[j].y) + (v[j].z * v[j].z + v[j].w * v[j].w); }
    const float rstd = 1.f / sqrtf(wave_sum(s) * (1.f / DM) + EPS);
    unsigned long long* o8 = (unsigned long long*)orow + lane;
#pragma unroll
    for (int j = 0; j < 8; ++j) { const f32x4 g = ((const f32x4*)gain)[lane + 64 * j]; const f32x4 y = v[j] * rstd * g;
        o8[64 * j] = (unsigned long long)cvtpk(y.x, y.y) | ((unsigned long long)cvtpk(y.z, y.w) << 32); }
}
struct RowF32 { f32x4 v[8]; };
__device__ __forceinline__ void row_load(RowF32& R, const float* xrow, int lane) {
    const f32x4* xr = (const f32x4*)xrow + lane;
#pragma unroll
    for (int j = 0; j < 8; ++j) R.v[j] = xr[64 * j];
}
__device__ __forceinline__ void rms_fin_bf16_fp8(const f32x4 (&v)[8], const float* gain, bf16_t* orow, unsigned char* o8row, int lane) {
    float s = 0.f;
#pragma unroll
    for (int j = 0; j < 8; ++j) s += (v[j].x * v[j].x + v[j].y * v[j].y) + (v[j].z * v[j].z + v[j].w * v[j].w);
    const float rstd = 1.f / sqrtf(wave_sum(s) * (1.f / DM) + EPS);
    unsigned long long* o8 = (unsigned long long*)orow + lane; unsigned* q4 = (unsigned*)o8row + lane;
#pragma unroll
    for (int j = 0; j < 8; ++j) { const f32x4 g = ((const f32x4*)gain)[lane + 64 * j]; const f32x4 y = v[j] * rstd * g;
        o8[64 * j] = (unsigned long long)cvtpk(y.x, y.y) | ((unsigned long long)cvtpk(y.z, y.w) << 32);
        int w = __builtin_amdgcn_cvt_pk_fp8_f32(__builtin_amdgcn_fmed3f(y.x, -448.f, 448.f), __builtin_amdgcn_fmed3f(y.y, -448.f, 448.f), 0, false);
        w = __builtin_amdgcn_cvt_pk_fp8_f32(__builtin_amdgcn_fmed3f(y.z, -448.f, 448.f), __builtin_amdgcn_fmed3f(y.w, -448.f, 448.f), w, true); q4[64 * j] = (unsigned)w; }
}
__device__ __forceinline__ void rms_fin_fp8_hilo(const f32x4 (&v)[8], const float* gain, unsigned char* hirow, unsigned char* lorow, int lane) {
    float s = 0.f;
#pragma unroll
    for (int j = 0; j < 8; ++j) s += (v[j].x * v[j].x + v[j].y * v[j].y) + (v[j].z * v[j].z + v[j].w * v[j].w);
    const float rstd = 1.f / sqrtf(wave_sum(s) * (1.f / DM) + EPS);
    unsigned* h4 = (unsigned*)hirow + lane; unsigned* l4 = (unsigned*)lorow + lane;
#pragma unroll
    for (int j = 0; j < 8; ++j) { const f32x4 g = ((const f32x4*)gain)[lane + 64 * j]; f32x4 y = v[j] * rstd * g;
        y.x = __builtin_amdgcn_fmed3f(y.x, -448.f, 448.f); y.y = __builtin_amdgcn_fmed3f(y.y, -448.f, 448.f); y.z = __builtin_amdgcn_fmed3f(y.z, -448.f, 448.f); y.w = __builtin_amdgcn_fmed3f(y.w, -448.f, 448.f);
        int w = __builtin_amdgcn_cvt_pk_fp8_f32(y.x, y.y, 0, false); w = __builtin_amdgcn_cvt_pk_fp8_f32(y.z, y.w, w, true);
        const f32x2 b01 = __builtin_amdgcn_cvt_pk_f32_fp8(w, false), b23 = __builtin_amdgcn_cvt_pk_f32_fp8(w, true);
        int u = __builtin_amdgcn_cvt_pk_fp8_f32(y.x - b01.x, y.y - b01.y, 0, false); u = __builtin_amdgcn_cvt_pk_fp8_f32(y.z - b23.x, y.w - b23.y, u, true);
        h4[64 * j] = (unsigned)w; l4[64 * j] = (unsigned)u; }
}
__device__ __forceinline__ void row_load_bf16(RowF32& R, const bf16_t* brow, int lane) {
    const u32x2* br = (const u32x2*)brow + lane;
#pragma unroll
    for (int j = 0; j < 8; ++j) { const u32x2 w = br[64 * j]; R.v[j] = (f32x4){bflo(w.x), bfhi(w.x), bflo(w.y), bfhi(w.y)}; }
}
__device__ __forceinline__ void row_to_fp8(const RowF32& R, unsigned char* orow, float* inv, int lane) {
    unsigned* o4 = (unsigned*)orow + lane; float am = 0.f;
#pragma unroll
    for (int j = 0; j < 8; ++j) am = fmaxf(am, fmaxf(fmaxf(fabsf(R.v[j].x), fabsf(R.v[j].y)), fmaxf(fabsf(R.v[j].z), fabsf(R.v[j].w))));
#pragma unroll
    for (int o = 1; o < 64; o <<= 1) am = fmaxf(am, __shfl_xor(am, o));
    const float sc = (am > 0.f && am < 3.0e38f) ? exp2f(floorf(log2f(224.f / am))) : 1.f;
#pragma unroll
    for (int j = 0; j < 8; ++j) { int w = __builtin_amdgcn_cvt_pk_fp8_f32(R.v[j].x * sc, R.v[j].y * sc, 0, false); w = __builtin_amdgcn_cvt_pk_fp8_f32(R.v[j].z * sc, R.v[j].w * sc, w, true); o4[64 * j] = (unsigned)w; }
    if (lane == 0) *inv = 1.f / sc;
}
__device__ __forceinline__ void row_to_fp8_sliced(const RowF32& R, unsigned char* tab, int m, float* inv, int lane) {
    float am = 0.f;
#pragma unroll
    for (int j = 0; j < 8; ++j) am = fmaxf(am, fmaxf(fmaxf(fabsf(R.v[j].x), fabsf(R.v[j].y)), fmaxf(fabsf(R.v[j].z), fabsf(R.v[j].w))));
#pragma unroll
    for (int o = 1; o < 64; o <<= 1) am = fmaxf(am, __shfl_xor(am, o));
    const float sc = (am > 0.f && am < 3.0e38f) ? exp2f(floorf(log2f(224.f / am))) : 1.f;
    unsigned char* o = tab + (size_t)(lane >> 5) * ((size_t)NEXP * 128) + (size_t)m * 128 + 4 * (lane & 31);
#pragma unroll
    for (int j = 0; j < 8; ++j) { int w = __builtin_amdgcn_cvt_pk_fp8_f32(R.v[j].x * sc, R.v[j].y * sc, 0, false); w = __builtin_amdgcn_cvt_pk_fp8_f32(R.v[j].z * sc, R.v[j].w * sc, w, true); *(unsigned*)(o + (size_t)(2 * j) * ((size_t)NEXP * 128)) = (unsigned)w; }
    if (lane == 0) *inv = 1.f / sc;
}
__device__ __forceinline__ void p0_prologue(const Frame& F, const Args& a) {
    unsigned char* ws = a.ws;
    LAS float* scr = (LAS float*)(F.lds + F.wave * 16384);
    const int gw = F.vcu * NWAVES + F.wave, NGW = F.G * NWAVES, lane = F.lane;
    bf16_t* BtIn = (bf16_t*)(ws + WS_BT_IN); bf16_t* BtOut = (bf16_t*)(ws + WS_BT_OUT); bf16_t* BtQ = (bf16_t*)(ws + WS_BT_Q); bf16_t* BtKV = (bf16_t*)(ws + WS_BT_KV);
    constexpr int I_IN = 32 * 168, I_OUT = 32 * 64, I_Q = 32 * 64, I_KV = 32 * 32;
    constexpr int NIT = I_IN + I_OUT + I_Q + I_KV;
    for (int it = gw; it < NIT; it += NGW) {
        int r = it;
        if (r < I_IN) { p0_transpose_item<1>(a.w_in, DM, IN_W, BtIn, scr, r / 168, r % 168, lane); continue; } r -= I_IN;
        if (r < I_OUT) { const int kb = r / 64; p0_transpose_item<0>(a.w_out, DM, DM, BtOut, scr, kb, r % 64, lane); continue; } r -= I_OUT;
        if (r < I_Q) { p0_transpose_item<0>(a.w_q, DM, DM, BtQ, scr, r / 64, r % 64, lane); continue; } r -= I_Q;
        p0_transpose_item<0>(a.w_kv, DM, 1024, BtKV, scr, r / 32, r % 32, lane);
    }
    { bf16_t* PWt = (bf16_t*)(ws + WS_PWT);
      for (int it = gw; it < 4 * 128; it += NGW) { const int g = it >> 7, e = it & 127; const float* pw = a.pool_w + (size_t)g * 16384 + e;
          const float v0 = pw[(size_t)(2 * lane) * 128], v1 = pw[(size_t)(2 * lane + 1) * 128]; ((unsigned*)(PWt + (size_t)it * 128))[lane] = cvtpk(v0, v1); } }
    bf16_t* XN = (bf16_t*)(ws + WS_XN); bf16_t* MN = (bf16_t*)(ws + WS_MN);
#if P1_FP8
    {
        RowF32 Ra, Rb; int m = gw;
        if (m < NTOK) row_load(Ra, a.x + (size_t)m * DM, lane);
        for (; m < NTOK; m += 2 * NGW) { const int m2 = m + NGW, m3 = m + 2 * NGW;
            if (m2 < NTOK) row_load(Rb, a.x + (size_t)m2 * DM, lane);
            rms_fin_bf16_fp8(Ra.v, a.attn_g, XN + (size_t)m * DM, ws + WS_XN8 + (size_t)m * DM, lane);
            if (m3 < NTOK) row_load(Ra, a.x + (size_t)m3 * DM, lane);
            if (m2 < NTOK) rms_fin_bf16_fp8(Rb.v, a.attn_g, XN + (size_t)m2 * DM, ws + WS_XN8 + (size_t)m2 * DM, lane); } }
#else
    for (int m = gw; m < NTOK; m += NGW) rms_row_to_bf16(a.x + (size_t)m * DM, a.attn_g, XN + (size_t)m * DM, lane);
#endif
    for (int m = gw; m < BATCH * MEMLEN; m += NGW) rms_row_to_bf16(a.mem + (size_t)m * DM, a.mem_g, MN + (size_t)m * DM, lane);
    unsigned char* UB = ws + WS_UB; unsigned char* VB = ws + WS_VB; float* RSU = (float*)(ws + WS_RSU); float* RSV = (float*)(ws + WS_RSV);
    (void)UB; (void)VB; (void)RSU; (void)RSV;
    bf16_t* PK = (bf16_t*)(ws + WS_PK);
    for (int m = gw; m < 256; m += NGW) { const float* src = (m < 128 ? a.sk1 + (size_t)m * 128 : a.sk2 + (size_t)(m - 128) * 128);
        const f32x2 v = ((const f32x2*)src)[lane]; ((unsigned*)(PK + (size_t)m * 128))[lane] = cvtpk(v.x, v.y); }
    float* RT = (float*)(ws + WS_ROPE);
    for (int p = gw; p < SEQ; p += NGW) {
        { const float invf = powf(10000.f, -(float)lane / 64.f); const float ang = (float)p * invf;
          RT[(size_t)p * 192 + lane] = cosf(ang); RT[(size_t)p * 192 + 64 + lane] = sinf(ang); }
        if (lane < 32) { const float invf = powf(10000.f, -(float)lane / 32.f); const float ang = (float)p * invf;
          RT[(size_t)p * 192 + 128 + lane] = cosf(ang); RT[(size_t)p * 192 + 160 + lane] = sinf(ang); }
    }
}

__device__ __forceinline__ void unpack8(const u32x4 w, float* x) { x[0] = bflo(w.x); x[1] = bfhi(w.x); x[2] = bflo(w.y); x[3] = bfhi(w.y); x[4] = bflo(w.z); x[5] = bfhi(w.z); x[6] = bflo(w.w); x[7] = bfhi(w.w); }
__device__ __forceinline__ u32x4 pack8(const float* x) { u32x4 w; w.x = cvtpk(x[0], x[1]); w.y = cvtpk(x[2], x[3]); w.z = cvtpk(x[4], x[5]); w.w = cvtpk(x[6], x[7]); return w; }
struct F8 { float v[8]; };
__device__ __forceinline__ F8 ld8f(const float* p) { const f32x4 a = *(const f32x4*)p, b = *(const f32x4*)(p + 4); F8 r; r.v[0] = a.x; r.v[1] = a.y; r.v[2] = a.z; r.v[3] = a.w; r.v[4] = b.x; r.v[5] = b.y; r.v[6] = b.z; r.v[7] = b.w; return r; }
__device__ __forceinline__ u32x2 pack8_fp8(const float* x) { int a = __builtin_amdgcn_cvt_pk_fp8_f32(x[0], x[1], 0, false); a = __builtin_amdgcn_cvt_pk_fp8_f32(x[2], x[3], a, true); int b = __builtin_amdgcn_cvt_pk_fp8_f32(x[4], x[5], 0, false); b = __builtin_amdgcn_cvt_pk_fp8_f32(x[6], x[7], b, true); return (u32x2){(unsigned)a, (unsigned)b}; }
template <bool NORM, bool ROPE, bool WB16 = true> __device__ __forceinline__ void head128_fin(bf16_t* base, const u32x4 wa, const u32x4 wb, int g, const F8& g1, const F8& g2, const F8& cc, const F8& sn, unsigned char* f8base = nullptr) {
    float x1[8], x2[8];
    unpack8(wa, x1); unpack8(wb, x2);
    if (NORM) {
        float ss = 0.f;
#pragma unroll
        for (int j = 0; j < 8; ++j) ss += x1[j] * x1[j] + x2[j] * x2[j];
        ss += __shfl_xor(ss, 1); ss += __shfl_xor(ss, 2); ss += __shfl_xor(ss, 4);
        const float rstd = 1.f / sqrtf(ss * (1.f / 128.f) + EPS);
#pragma unroll
        for (int j = 0; j < 8; ++j) { x1[j] = x1[j] * rstd * g1.v[j]; x2[j] = x2[j] * rstd * g2.v[j]; }
    }
    if (ROPE) {
#pragma unroll
        for (int j = 0; j < 8; ++j) { const float c = cc.v[j], sv = sn.v[j]; const float p = x1[j], q = x2[j]; x1[j] = p * c - q * sv; x2[j] = q * c + p * sv; }
    }
    if (WB16) { *(u32x4*)(base + 8 * g) = pack8(x1); *(u32x4*)(base + 64 + 8 * g) = pack8(x2); }
    if (f8base) { *(u32x2*)(f8base + 8 * g) = pack8_fp8(x1); *(u32x2*)(f8base + 64 + 8 * g) = pack8_fp8(x2); }
}
__device__ __forceinline__ void head64_fin(bf16_t* base, const u32x4 wa, const u32x4 wb, int g, const F8& cc, const F8& sn) {
    float x1[8], x2[8];
    unpack8(wa, x1); unpack8(wb, x2);
#pragma unroll
    for (int j = 0; j < 8; ++j) { const float c = cc.v[j], sv = sn.v[j]; const float p = x1[j], q = x2[j]; x1[j] = p * c - q * sv; x2[j] = q * c + p * sv; }
    *(u32x4*)(base + 8 * g) = pack8(x1); *(u32x4*)(base + 32 + 8 * g) = pack8(x2);
}
__device__ __forceinline__ void p2_post(const Frame& F, const Args& a) {
    unsigned char* ws = a.ws; const int lane = F.lane;
    const int gw = F.vcu * NWAVES + F.wave, NGW = F.G * NWAVES;
    bf16_t* Z = (bf16_t*)(ws + WS_Z); bf16_t* MIX = (bf16_t*)(ws + WS_XN); bf16_t* KVM = (bf16_t*)(ws + WS_KVM);
    const float* RT = (const float*)(ws + WS_ROPE);
    const int g8 = lane & 7, h8 = lane >> 3, g4 = lane & 3, h4 = lane >> 2;
#define P2_PL_LOAD(P, t_) do { const int pos_ = (t_) & (SEQ - 1); const int w_ = 2 << (lane >> 4); const int cnt_ = (pos_ + 1 < w_) ? pos_ + 1 : w_; const bf16_t* zr_ = Z + (size_t)(t_) * ZLD + ZC_PU + 8 * lane; \
        _Pragma("unroll") for (int j = 0; j < 16; ++j) { const int jj = j < cnt_ ? j : 0; P[j] = *(const u32x4*)(zr_ - (size_t)jj * ZLD); } } while (0)
#define P2_PL_FIN(P, t_) do { const int pos_ = (t_) & (SEQ - 1); const int w_ = 2 << (lane >> 4); const int cnt_ = (pos_ + 1 < w_) ? pos_ + 1 : w_; \
        float sum[8] = {0.f, 0.f, 0.f, 0.f, 0.f, 0.f, 0.f, 0.f}, ut[8]; unpack8(P[0], ut); \
        _Pragma("unroll") for (int j = 0; j < 16; ++j) { float v[8]; unpack8(P[j], v); const float on = j < cnt_ ? 1.f : 0.f; _Pragma("unroll") for (int e = 0; e < 8; ++e) sum[e] = fmaf(on, v[e], sum[e]); } \
        const float inv = 1.f / (float)cnt_; float d[8]; _Pragma("unroll") for (int e = 0; e < 8; ++e) d[e] = sum[e] * inv - ut[e]; \
        *(u32x4*)(MIX + (size_t)(t_) * DM + 1024 + 8 * lane) = pack8(d); } while (0)
    { u32x4 pa[16], pb[16]; int t = gw;
      if (t < NTOK) P2_PL_LOAD(pa, t);
      for (; t < NTOK; t += 2 * NGW) { const int t2 = t + NGW, t3 = t + 2 * NGW;
          if (t2 < NTOK) P2_PL_LOAD(pb, t2);
          P2_PL_FIN(pa, t);
          if (t3 < NTOK) P2_PL_LOAD(pa, t3);
          if (t2 < NTOK) P2_PL_FIN(pb, t2); } }
#undef P2_PL_LOAD
#undef P2_PL_FIN
    struct HB { u32x4 q1, q2, k1, k2, i1, i2, x1, x2, m1, m2; F8 c128, s128, c64, s64; };
    const unsigned oq = (unsigned)(ZC_Q + h8 * 128 + 8 * g8) * 2u, okk = (unsigned)(ZC_K + h8 * 128 + 8 * g8) * 2u, oi = (unsigned)(ZC_QI + h4 * 64 + 8 * g4) * 2u, oki = (unsigned)(ZC_KI + 8 * g4) * 2u,
                   om = (unsigned)(ZC_QM + (h8 & 3) * 128 + 8 * g8) * 2u, or8 = (unsigned)(8 * g8) * 4u, or4 = (unsigned)(128 + 8 * g4) * 4u;
#define P2_LDU(base, off) (*(const u32x4*)((const char*)(base) + (off)))
#define P2_LDF(base, off) ld8f((const float*)((const char*)(base) + (off)))
#define P2_HB_LOAD(H, t_) do { const char* zb_ = (const char*)(Z + (size_t)(t_) * ZLD); const char* rb_ = (const char*)(RT + (size_t)((t_) & (SEQ - 1)) * 192); \
        H.q1 = P2_LDU(zb_, oq); H.q2 = P2_LDU(zb_, oq + 128u); H.k1 = P2_LDU(zb_, okk); H.k2 = P2_LDU(zb_, okk + 128u); \
        H.i1 = P2_LDU(zb_, oi); H.i2 = P2_LDU(zb_, oi + 64u); H.x1 = P2_LDU(zb_, oki); H.x2 = P2_LDU(zb_, oki + 64u); \
        H.m1 = P2_LDU(zb_, om); H.m2 = P2_LDU(zb_, om + 128u); \
        H.c128 = P2_LDF(rb_, or8); H.s128 = P2_LDF(rb_, or8 + 256u); H.c64 = P2_LDF(rb_, or4); H.s64 = P2_LDF(rb_, or4 + 128u); } while (0)
#if QK_FP8
#define P2_QK(H, t_, zr_) { const F8 qg1 = ld8f(a.q_g + 8 * g8), qg2 = ld8f(a.q_g + 64 + 8 * g8); head128_fin<true, true, ATT_VERIFY != 0>(zr_ + ZC_Q + h8 * 128, H.q1, H.q2, g8, qg1, qg2, H.c128, H.s128, ws + WS_Q8 + (size_t)(t_) * 1024 + h8 * 128); } \
        { const F8 kg1 = ld8f(a.k_g + 8 * g8), kg2 = ld8f(a.k_g + 64 + 8 * g8); head128_fin<true, true, ATT_VERIFY != 0>(zr_ + ZC_K + h8 * 128, H.k1, H.k2, g8, kg1, kg2, H.c128, H.s128, ws + WS_K8 + (size_t)(t_) * 1024 + h8 * 128); }
#else
#define P2_QK(H, t_, zr_) { const F8 qg1 = ld8f(a.q_g + 8 * g8), qg2 = ld8f(a.q_g + 64 + 8 * g8); head128_fin<true, true>(zr_ + ZC_Q + h8 * 128, H.q1, H.q2, g8, qg1, qg2, H.c128, H.s128); } \
        { const F8 kg1 = ld8f(a.k_g + 8 * g8), kg2 = ld8f(a.k_g + 64 + 8 * g8); head128_fin<true, true>(zr_ + ZC_K + h8 * 128, H.k1, H.k2, g8, kg1, kg2, H.c128, H.s128); }
#endif
#define P2_HB_FIN(H, t_) do { bf16_t* zr_ = Z + (size_t)(t_) * ZLD; P2_QK(H, t_, zr_) \
        head64_fin(zr_ + ZC_QI + h4 * 64, H.i1, H.i2, g4, H.c64, H.s64); \
        if (lane < 4) head64_fin((bf16_t*)(ws + WS_KI) + (size_t)(t_) * 64, H.x1, H.x2, g4, H.c64, H.s64); \
        if (lane < 32) { const F8 mg1 = ld8f(a.mq_g + 8 * g8), mg2 = ld8f(a.mq_g + 64 + 8 * g8); head128_fin<true, false>(zr_ + ZC_QM + (h8 & 3) * 128, H.m1, H.m2, g8, mg1, mg2, H.c128, H.s128); } } while (0)
    { HB ha, hb; int t = gw;
      if (t < NTOK) P2_HB_LOAD(ha, t);
      for (; t < NTOK; t += 2 * NGW) { const int t2 = t + NGW, t3 = t + 2 * NGW;
          if (t2 < NTOK) P2_HB_LOAD(hb, t2);
          P2_HB_FIN(ha, t);
          if (t3 < NTOK) P2_HB_LOAD(ha, t3);
          if (t2 < NTOK) P2_HB_FIN(hb, t2); } }
#undef P2_HB_LOAD
#undef P2_LDU
#undef P2_LDF
#undef P2_HB_FIN
#undef P2_QK
    const F8 kmg1 = ld8f(a.mk_g + 8 * g8), kmg2 = ld8f(a.mk_g + 64 + 8 * g8);
    for (int r = gw; r < BATCH * MEMLEN; r += NGW) { if (lane < 32) { bf16_t* bm = KVM + (size_t)r * 1024 + (lane >> 3) * 128; const u32x4 m1 = *(const u32x4*)(bm + 8 * g8), m2 = *(const u32x4*)(bm + 64 + 8 * g8); head128_fin<true, false>(bm, m1, m2, g8, kmg1, kmg2, kmg1, kmg2); } }
}

#if PV_FP8
__device__ __forceinline__ void p2_vt(const Frame& F, const Args& a) {
    unsigned char* ws = a.ws; const int lane = F.lane;
    const int gw = F.vcu * NWAVES + F.wave, NGW = F.G * NWAVES;
    const bf16_t* Z = (const bf16_t*)(ws + WS_Z);
    {
        LAS unsigned char* tb = F.lds + F.wave * 8704; unsigned char* V8T = ws + WS_V8T;
        for (int blk = gw; blk < BATCH * 256 * 8; blk += NGW) {
            const int h = blk & 7, T = (blk >> 3) & 255, b = blk >> 11;
            const bf16_t* vrow = Z + ((size_t)b * SEQ + 64 * T + lane) * ZLD + ZC_V + h * 128;
            u32x4 w[16];
#pragma unroll
            for (int i = 0; i < 16; ++i) w[i] = *(const u32x4*)(vrow + 8 * i);
#pragma unroll
            for (int i = 0; i < 16; ++i) { float x[8]; unpack8(w[i], x);
#pragma unroll
                for (int e = 0; e < 8; ++e) x[e] = __builtin_amdgcn_fmed3f(x[e], -448.f, 448.f);
                *(LAS u32x2*)(tb + lane * 136 + 8 * i) = pack8_fp8(x); }
            LDS_WAIT();
            unsigned char* dst = V8T + ((size_t)((b * 8 + h) * 256 + T)) * 8192 + (size_t)lane * 128;
#pragma unroll
            for (int c = 0; c < 2; ++c) { const int d = 2 * lane + c;
#pragma unroll
                for (int q4 = 0; q4 < 4; ++q4) { unsigned o[4];
#pragma unroll
                    for (int qq = 0; qq < 4; ++qq) { const int pq = 4 * (4 * q4 + qq); const int key0 = 32 * ((pq >> 4) & 1) + 8 * ((pq >> 2) & 3) + 4 * (pq >> 5);
                        const unsigned b0 = tb[(key0 + 0) * 136 + d], b1 = tb[(key0 + 1) * 136 + d], b2 = tb[(key0 + 2) * 136 + d], b3 = tb[(key0 + 3) * 136 + d];
                        o[qq] = b0 | (b1 << 8) | (b2 << 16) | (b3 << 24); }
                    *(u32x4*)(dst + c * 64 + q4 * 16) = (u32x4){o[0], o[1], o[2], o[3]}; } }
            LDS_WAIT();
        }
    }
}
#endif

namespace ix {
constexpr int KP = 144, KBUF = 64 * KP;
constexpr int OFF_KI = 0, OFF_HIST = 2 * KBUF, OFF_ST = OFF_HIST + 65536, OFF_W = OFF_ST + 8192;
constexpr int CAPB = 1024;
constexpr int CAPF = 512;
enum { S_ULO = 0, S_UHI = 64, S_SH = 128, S_NEED = 192, S_FLO = 256, S_FHI = 320, S_CCNT = 384, S_ACT = 448, S_ABOVE = 512, S_COL = 576, S_FAIL = 640,
       S_PB1 = 704, S_PB2 = 768, S_PAB = 832, S_VMIN = 896, S_VMAX = 960, S_VCNT = 1024, S_ANY = 1088, S_R1 = 1089, S_R2 = 1090 };
constexpr float WSCALE = 0.25f * 0.125f;
__device__ __forceinline__ float relu_i(float x) { const int i = __float_as_int(x); return __int_as_float(i > 0 ? i : 0); }
__device__ __forceinline__ unsigned sh_for(unsigned range) { const int bits = 32 - __clz((int)range); return range == 0u ? 0u : (bits > 9 ? (unsigned)(bits - 9) : 0u); }

template <int MODE>
__device__ __forceinline__ void sweep(const Frame& F, const bf16x8 (&A)[4][4], const bf16_t* Z, unsigned* MASK, unsigned long long* CAND, size_t qrow0, size_t krow0, int NT, int t0, int stride, int vmode) {
    const int tid = F.tid, lane = F.lane, wave = F.wave, r = lane & 31, hi = lane >> 5;
    LAS unsigned char* lds = F.lds;
    volatile LAS unsigned* st = (volatile LAS unsigned*)(lds + OFF_ST);
    LAS unsigned* hist32 = (LAS unsigned*)(lds + OFF_HIST);
    unsigned qact = 0u;
    {
#pragma unroll
        for (int qp = 0; qp < 4; ++qp) { const int q0 = 8 * wave + 2 * qp; const unsigned a2 = (MODE == 0) ? (st[S_ACT + q0] | st[S_ACT + q0 + 1]) : (vmode ? 1u : (st[S_COL + q0] | st[S_COL + q0 + 1]));
            qact |= ((unsigned)__builtin_amdgcn_readfirstlane((int)a2) != 0u ? 1u : 0u) << qp; }
    }
    unsigned ccnt_[4] = {0u, 0u, 0u, 0u}, abv_[4] = {0u, 0u, 0u, 0u};
    if (MODE == 1) {
#pragma unroll
        for (int qp = 0; qp < 4; ++qp) { ccnt_[qp] = st[S_CCNT + 8 * wave + 2 * qp + hi]; abv_[qp] = st[S_ABOVE + 8 * wave + 2 * qp + hi]; }
    }
    const int srow = tid >> 3, sch = tid & 7;
    const bf16_t* KI = (const bf16_t*)((const unsigned char*)Z + (WS_KI - WS_Z));
    const bf16_t* ksrc = KI + (krow0 + srow) * 64 + sch * 8;
    u32x4 stg = *(const u32x4*)(ksrc + (size_t)t0 * 64 * 64);
    *(LAS u32x4*)(lds + OFF_KI + srow * KP + sch * 16) = stg;
    __syncthreads();
    int buf = 0;
    for (int t = t0; t < NT; t += stride) {
        const int tn = t + stride;
        if (tn < NT) stg = *(const u32x4*)(ksrc + (size_t)tn * 64 * 64);
        LAS unsigned char* kb = lds + OFF_KI + buf * KBUF;
        int lane_ = (int)threadIdx.x; asm volatile("" : "+v"(lane_)); lane_ &= 63;
        const int r = lane_ & 31, hi = lane_ >> 5;
        bf16x8 B0[4], B1[4];
#pragma unroll
        for (int ks = 0; ks < 4; ++ks) { B0[ks] = *(const LAS bf16x8*)(kb + r * KP + ks * 32 + hi * 16); B1[ks] = *(const LAS bf16x8*)(kb + (32 + r) * KP + ks * 32 + hi * 16); }
#pragma unroll
        for (int qp = 0; qp < 4; ++qp) {
            if (((qact >> qp) & 1u) == 0u) continue;
            const int ql = 8 * wave + 2 * qp + hi;
            const LAS f32x4* wq = (const LAS f32x4*)(lds + OFF_W + ql * 64);
            const f32x4 w0 = wq[0], w1 = wq[1], w2 = wq[2], w3 = wq[3];
            const unsigned sA = (MODE == 0) ? st[S_ULO + ql] : st[S_FLO + ql], sB = (MODE == 0) ? st[S_UHI + ql] : st[S_FHI + ql], sC = (MODE == 0) ? st[S_SH + ql] : st[S_COL + ql];
            f32x16 a0 = f32x16{}, a1 = f32x16{};
#pragma unroll
            for (int ks = 0; ks < 4; ++ks) { a0 = __builtin_amdgcn_mfma_f32_32x32x16_bf16(A[qp][ks], B0[ks], a0, 0, 0, 0); a1 = __builtin_amdgcn_mfma_f32_32x32x16_bf16(A[qp][ks], B1[ks], a1, 0, 0, 0); }
            float p0 = w0.x * relu_i(a0[0]), p1 = w2.x * relu_i(a0[8]), q0 = w0.x * relu_i(a1[0]), q1 = w2.x * relu_i(a1[8]);
            p0 = fmaf(w0.y, relu_i(a0[1]), p0); p1 = fmaf(w2.y, relu_i(a0[9]), p1); q0 = fmaf(w0.y, relu_i(a1[1]), q0); q1 = fmaf(w2.y, relu_i(a1[9]), q1);
            p0 = fmaf(w0.z, relu_i(a0[2]), p0); p1 = fmaf(w2.z, relu_i(a0[10]), p1); q0 = fmaf(w0.z, relu_i(a1[2]), q0); q1 = fmaf(w2.z, relu_i(a1[10]), q1);
            p0 = fmaf(w0.w, relu_i(a0[3]), p0); p1 = fmaf(w2.w, relu_i(a0[11]), p1); q0 = fmaf(w0.w, relu_i(a1[3]), q0); q1 = fmaf(w2.w, relu_i(a1[11]), q1);
            p0 = fmaf(w1.x, relu_i(a0[4]), p0); p1 = fmaf(w3.x, relu_i(a0[12]), p1); q0 = fmaf(w1.x, relu_i(a1[4]), q0); q1 = fmaf(w3.x, relu_i(a1[12]), q1);
            p0 = fmaf(w1.y, relu_i(a0[5]), p0); p1 = fmaf(w3.y, relu_i(a0[13]), p1); q0 = fmaf(w1.y, relu_i(a1[5]), q0); q1 = fmaf(w3.y, relu_i(a1[13]), q1);
            p0 = fmaf(w1.z, relu_i(a0[6]), p0); p1 = fmaf(w3.z, relu_i(a0[14]), p1); q0 = fmaf(w1.z, relu_i(a1[6]), q0); q1 = fmaf(w3.z, relu_i(a1[14]), q1);
            p0 = fmaf(w1.w, relu_i(a0[7]), p0); p1 = fmaf(w3.w, relu_i(a0[15]), p1); q0 = fmaf(w1.w, relu_i(a1[7]), q0); q1 = fmaf(w3.w, relu_i(a1[15]), q1);
            const unsigned u0 = f2ord(p0 + p1), u1 = f2ord(q0 + q1);
            if (MODE == 0) {
                const unsigned wlo = sA, whi = sB, wsh = sC;
                if (u0 >= wlo && u0 <= whi) { unsigned bin = (u0 - wlo) >> wsh; bin = bin > 511u ? 511u : bin;
                    __hip_atomic_fetch_add(hist32 + ql * 256 + (bin >> 1), 1u << ((bin & 1u) * 16u), __ATOMIC_RELAXED, __HIP_MEMORY_SCOPE_WORKGROUP); }
                if (u1 >= wlo && u1 <= whi) { unsigned bin = (u1 - wlo) >> wsh; bin = bin > 511u ? 511u : bin;
                    __hip_atomic_fetch_add(hist32 + ql * 256 + (bin >> 1), 1u << ((bin & 1u) * 16u), __ATOMIC_RELAXED, __HIP_MEMORY_SCOPE_WORKGROUP); }
            } else if (IX_VERIFY && vmode) {
                LAS unsigned* vs = (LAS unsigned*)(lds + OFF_ST) + ql;
                const unsigned long long w64 = __hip_atomic_load((const unsigned long long*)(MASK + (qrow0 + ql) * MASK_WPR + 2 * t), __ATOMIC_RELAXED, __HIP_MEMORY_SCOPE_AGENT);
                if ((w64 >> r) & 1ull) { __hip_atomic_fetch_min(vs + S_VMIN, u0, __ATOMIC_RELAXED, __HIP_MEMORY_SCOPE_WORKGROUP); __hip_atomic_fetch_add(vs + S_VCNT, 1u, __ATOMIC_RELAXED, __HIP_MEMORY_SCOPE_WORKGROUP); }
                else __hip_atomic_fetch_max(vs + S_VMAX, u0, __ATOMIC_RELAXED, __HIP_MEMORY_SCOPE_WORKGROUP);
                if ((w64 >> (32 + r)) & 1ull) { __hip_atomic_fetch_min(vs + S_VMIN, u1, __ATOMIC_RELAXED, __HIP_MEMORY_SCOPE_WORKGROUP); __hip_atomic_fetch_add(vs + S_VCNT, 1u, __ATOMIC_RELAXED, __HIP_MEMORY_SCOPE_WORKGROUP); }
                else __hip_atomic_fetch_max(vs + S_VMAX, u1, __ATOMIC_RELAXED, __HIP_MEMORY_SCOPE_WORKGROUP);
            } else {
                const unsigned flo = sA, fhi = sB; const bool col = sC != 0u;
                const unsigned long long bal0 = __ballot(col && u0 > fhi), bal1 = __ballot(col && u1 > fhi);
                const unsigned bh0 = (unsigned)(bal0 >> (32 * hi)), bh1 = (unsigned)(bal1 >> (32 * hi));
                if (col && r == 0) *(unsigned long long*)(MASK + (qrow0 + ql) * MASK_WPR + 2 * t) = (unsigned long long)bh0 | ((unsigned long long)bh1 << 32);
                abv_[qp] += __popc(bh0) + __popc(bh1);
                const bool c0 = col && (u0 >= flo) && (u0 <= fhi), c1 = col && (u1 >= flo) && (u1 <= fhi);
                const unsigned long long cb0 = __ballot(c0), cb1 = __ballot(c1);
                if (cb0 | cb1) { const unsigned h0 = (unsigned)(cb0 >> (32 * hi)), h1 = (unsigned)(cb1 >> (32 * hi)); const unsigned lt = (1u << r) - 1u;
                    const unsigned pos0 = ccnt_[qp] + __popc(h0 & lt), pos1 = ccnt_[qp] + __popc(h0) + __popc(h1 & lt);
                    if (c0 && pos0 < (unsigned)CAPB) CAND[(size_t)ql * CAPB + pos0] = (unsigned long long)u0 | ((unsigned long long)(unsigned)(64 * t + r) << 32);
                    if (c1 && pos1 < (unsigned)CAPB) CAND[(size_t)ql * CAPB + pos1] = (unsigned long long)u1 | ((unsigned long long)(unsigned)(64 * t + 32 + r) << 32);
                    ccnt_[qp] += __popc(h0) + __popc(h1); }
            }
        }
        if (tn < NT) *(LAS u32x4*)(lds + OFF_KI + (buf ^ 1) * KBUF + srow * KP + sch * 16) = stg;
        __syncthreads();
        buf ^= 1;
    }
    if (MODE == 1 && !vmode) { const int r0 = lane & 31, h0 = lane >> 5;
#pragma unroll
        for (int qp = 0; qp < 4; ++qp) { const int ql = 8 * wave + 2 * qp + h0; if (r0 == 0 && st[S_COL + ql] != 0u) { st[S_CCNT + ql] = ccnt_[qp]; st[S_ABOVE + ql] = abv_[qp]; } } }
}

__device__ __forceinline__ void resolve(const Frame& F, unsigned* MASK, const unsigned long long* CAND, size_t qrow0, int NT) {
    int lane = (int)threadIdx.x; asm volatile("" : "+v"(lane)); lane &= 63; const int wave = F.wave;
    LAS unsigned char* lds = F.lds;
    volatile LAS unsigned* st = (volatile LAS unsigned*)(lds + OFF_ST);
    LAS unsigned* wh = (LAS unsigned*)(lds + OFF_HIST + wave * 4608); LAS unsigned* bm = wh + 512; LAS unsigned long long* sl = (LAS unsigned long long*)(bm + 512);
    const unsigned long long ltm = (1ull << lane) - 1ull;
    for (int qi = 0; qi < 8; ++qi) {
        const int q = 8 * wave + qi;
        if (st[S_COL + q] == 0u) continue;
        const unsigned cnt = st[S_CCNT + q], ab = st[S_ABOVE + q];
        if (!(ab < 256u && ab + cnt >= 256u && cnt <= (unsigned)CAPB)) { if (lane == 0) st[S_FAIL + q] = 1u; continue; }
        if (lane == 0) st[S_FAIL + q] = 0u;
        unsigned need = 256u - ab, lo = st[S_FLO + q], hi = st[S_FHI + q], sh = 0u, cbin = 0u;
        const unsigned long long* cq = CAND + (size_t)q * CAPB;
#pragma unroll
        for (int i = 0; i < 8; ++i) bm[lane * 8 + i] = 0u;
        for (int lev = 0; lev < 5; ++lev) {
            sh = sh_for(hi - lo);
#pragma unroll
            for (int i = 0; i < 8; ++i) wh[lane * 8 + i] = 0u;
            LDS_WAIT();
            for (unsigned j = lane; j < cnt; j += 64) { const unsigned u = (unsigned)cq[j]; if (u >= lo && u <= hi) __hip_atomic_fetch_add(wh + ((u - lo) >> sh), 1u, __ATOMIC_RELAXED, __HIP_MEMORY_SCOPE_WORKGROUP); }
            LDS_WAIT();
            unsigned hb[8], s8 = 0u;
#pragma unroll
            for (int i = 0; i < 8; ++i) { hb[i] = wh[lane * 8 + i]; s8 += hb[i]; }
            unsigned above = 0u;
            { unsigned inc = s8;
#pragma unroll
              for (int o = 1; o < 64; o <<= 1) { const unsigned v = __shfl_down(inc, o); if (lane + o < 64) inc += v; }
              above = inc - s8; }
            const bool mine = above < need && need <= above + s8;
            unsigned bstar = 0u, run = above, cb = 0u;
            if (mine) { bool found = false;
#pragma unroll
                for (int i = 7; i >= 0; --i) { if (!found) { if (run + hb[i] >= need) { bstar = (unsigned)(lane * 8 + i); cb = hb[i]; found = true; } else run += hb[i]; } } }
            const unsigned long long mb = __ballot(mine); const int src = mb ? (int)__builtin_ctzll(mb) : 0;
            bstar = __shfl(bstar, src); run = __shfl(run, src); cbin = __shfl(cb, src);
            const unsigned nlo = lo + (bstar << sh); const unsigned long long e = (unsigned long long)nlo + ((1ull << sh) - 1ull);
            hi = e > (unsigned long long)hi ? hi : (unsigned)e; lo = nlo; need -= run;
            if (cbin <= 64u || sh == 0u) break;
        }
        const bool tiemode = cbin > 64u;
        unsigned m = 0u;
        for (unsigned j0 = 0; j0 < cnt; j0 += 64) { const unsigned j = j0 + lane; const bool vj = j < cnt; const unsigned long long e = vj ? cq[j] : 0ull; const unsigned u = (unsigned)e, key = (unsigned)(e >> 32);
            const bool inw = vj && u >= lo && u <= hi; const unsigned long long bal = __ballot(inw); const unsigned pos = m + (unsigned)__popcll(bal & ltm);
            if (vj && (u > hi || (tiemode && inw && pos < need))) __hip_atomic_fetch_or(bm + (key >> 5), 1u << (key & 31u), __ATOMIC_RELAXED, __HIP_MEMORY_SCOPE_WORKGROUP);
            if (!tiemode && inw && pos < 64u) sl[pos] = e;
            m += (unsigned)__popcll(bal); }
        LDS_WAIT();
        if (!tiemode) { if (m > 64u) m = 64u;
            if ((unsigned)lane < m) { const unsigned long long ej = sl[lane]; const unsigned uj = (unsigned)ej; unsigned rank = 0u;
                for (unsigned j2 = 0; j2 < m; ++j2) { const unsigned u2 = (unsigned)sl[j2]; rank += (u2 > uj || (u2 == uj && j2 < (unsigned)lane)) ? 1u : 0u; }
                if (rank < need) { const unsigned key = (unsigned)(ej >> 32); __hip_atomic_fetch_or(bm + (key >> 5), 1u << (key & 31u), __ATOMIC_RELAXED, __HIP_MEMORY_SCOPE_WORKGROUP); } } }
        LDS_WAIT();
        unsigned* mrow = MASK + (qrow0 + q) * MASK_WPR;
        for (int w = lane; w < 2 * NT; w += 64) { const unsigned b = bm[w]; if (b) { const unsigned old = __hip_atomic_load(mrow + w, __ATOMIC_RELAXED, __HIP_MEMORY_SCOPE_AGENT); mrow[w] = old | b; } }
        LDS_WAIT();
    }
}

__device__ __forceinline__ void unit(const Frame& F, const bf16_t* Z, unsigned* MASK, unsigned long long* CANDW, unsigned* ERR, int b, int c) {
    const int tid = F.tid, lane = F.lane, wave = F.wave, r = lane & 31, hi = lane >> 5;
    const int NT = c + 1; const size_t qrow0 = (size_t)b * SEQ + 64 * c, krow0 = (size_t)b * SEQ;
    LAS unsigned char* lds = F.lds;
    volatile LAS unsigned* st = (volatile LAS unsigned*)(lds + OFF_ST);
    LAS unsigned* hist32 = (LAS unsigned*)(lds + OFF_HIST);
    { const int tend = 4 * ((c >> 2) + 1), nz = 2 * (tend - NT);
      for (int i = tid; i < 64 * nz; i += 512) { const int q = i / nz, wi = 2 * NT + i % nz; MASK[(qrow0 + q) * MASK_WPR + wi] = 0u; } }
    if (c <= 3) {
        for (int i = tid; i < 64 * 2 * NT; i += 512) { const int q = i / (2 * NT), wi = i % (2 * NT); MASK[(qrow0 + q) * MASK_WPR + wi] = 0xFFFFFFFFu; }
        return;
    }
    bf16x8 A[4][4];
#pragma unroll
    for (int qp = 0; qp < 4; ++qp) {
        const int query = 8 * wave + 2 * qp + ((r >> 2) & 1), head = (r & 3) + 4 * (r >> 3);
        const bf16_t* src = Z + (qrow0 + query) * ZLD + ZC_QI + head * 64 + 8 * hi;
#pragma unroll
        for (int ks = 0; ks < 4; ++ks) A[qp][ks] = *(const bf16x8*)(src + ks * 16);
    }
    for (int i = tid; i < 64 * 16; i += 512) { const int q = i >> 4, hh = i & 15; ((LAS float*)(lds + OFF_W))[i] = bflo((unsigned)Z[(qrow0 + q) * ZLD + ZC_WI + hh]) * WSCALE; }
    const int stride = NT >= 32 ? 8 : (NT >= 16 ? 4 : 1), t0 = stride >> 1, nsamp = (NT - t0 + stride - 1) / stride;
    const bool pilot = stride > 1;
    int r1 = 1, r2 = 1;
    if (pilot) { const float ns = 256.f * (float)nsamp / (float)NT; const float sg = sqrtf(ns * (1.f - 1.f / (float)stride)); const int mg = (int)ceilf(5.f * sg) + 2;
        r1 = (int)floorf(ns) - mg; if (r1 < 1) r1 = 1; r2 = (int)ceilf(ns) + mg; }
    const int strideA = (pilot && NT >= 128) ? 4 * stride : stride, t0A = strideA >> 1, nsampA = (NT - t0A + strideA - 1) / strideA;
    int r1A = r1, r2A = r2;
    if (pilot && strideA != stride) { const float ns = 256.f * (float)nsampA / (float)NT; const float sg = sqrtf(ns * (1.f - 1.f / (float)strideA)); const int mg = (int)ceilf(5.f * sg) + 2;
        r1A = (int)floorf(ns) - mg; if (r1A < 1) r1A = 1; r2A = (int)ceilf(ns) + mg; }
    if (tid < 64) { st[S_ULO + tid] = 0u; st[S_UHI + tid] = 0xFFFFFFFFu; st[S_SH + tid] = 23u; st[S_NEED + tid] = 256u; st[S_ACT + tid] = 1u; st[S_CCNT + tid] = 0u; st[S_ABOVE + tid] = 0u;
                    st[S_COL + tid] = 1u; st[S_FAIL + tid] = pilot ? 0u : 1u; st[S_PB1 + tid] = 511u; st[S_PB2 + tid] = 0u; st[S_PAB + tid] = 0u; }
    __syncthreads();
    int stage = pilot ? 0 : 2; bool after_fallback = !pilot;
    for (int iter = 0; iter < 24; ++iter) {
        if (stage <= 2) {
            { int tid_ = (int)threadIdx.x; asm volatile("" : "+v"(tid_));
              for (int i = 0; i < 32; ++i) hist32[tid_ + 512 * i] = 0u;
              if (tid_ == 0) st[S_ANY] = 0u; }
            __syncthreads();
            const bool smp = stage <= 1;
            sweep<0>(F, A, Z, MASK, CANDW, qrow0, krow0, NT, smp ? (stage == 0 ? t0A : t0) : 0, smp ? (stage == 0 ? strideA : stride) : 1, 0);
            { int tid_ = (int)threadIdx.x; asm volatile("" : "+v"(tid_)); const int ln = tid_ & 63;
              const int q = tid_ >> 3, seg = tid_ & 7; const LAS unsigned* h32 = hist32 + q * 256 + seg * 32;
              unsigned cnt = 0u;
              for (int i = 0; i < 32; ++i) { const unsigned wv = h32[i]; cnt += (wv & 0xffffu) + (wv >> 16); }
              unsigned above = 0u;
#pragma unroll
              for (int k = 0; k < 8; ++k) { const unsigned ck = __shfl(cnt, (ln & ~7) + k); if (k > seg) above += ck; }
              const unsigned ulo = st[S_ULO + q], uhi = st[S_UHI + q], sh = st[S_SH + q];
              if (smp) {
                  const unsigned pab = stage == 1 ? st[S_PAB + q] : 0u;
                  const unsigned t1 = (unsigned)(stage == 0 ? r1A : r1) - (stage == 1 ? pab : 0u), t2 = (unsigned)(stage == 0 ? r2A : r2) - (stage == 1 ? pab : 0u);
#pragma unroll
                  for (int which = 0; which < 2; ++which) { const unsigned tg = which ? t2 : t1;
                      if (above < tg && tg <= above + cnt) { unsigned run = above; int bstar = -1;
                          for (int i = 31; i >= 0; --i) { const unsigned wv = h32[i]; const unsigned c1 = wv >> 16, c0 = wv & 0xffffu;
                              if (bstar < 0) { if (run + c1 >= tg) bstar = seg * 64 + 2 * i + 1; else run += c1; }
                              if (bstar < 0) { if (run + c0 >= tg) bstar = seg * 64 + 2 * i; else run += c0; } }
                          if (which == 0) { st[S_PB1 + q] = (unsigned)bstar; if (stage == 0) st[S_PAB + q] = run; } else st[S_PB2 + q] = (unsigned)bstar; } }
              } else {
                  const unsigned need = st[S_NEED + q], active = st[S_ACT + q];
                  if (active && above < need && need <= above + cnt) {
                      unsigned run = above; int bstar = -1; unsigned cbin = 0u;
                      for (int i = 31; i >= 0; --i) { const unsigned wv = h32[i]; const unsigned c1 = wv >> 16, c0 = wv & 0xffffu;
                          if (bstar < 0) { if (run + c1 >= need) { bstar = seg * 64 + 2 * i + 1; cbin = c1; } else run += c1; }
                          if (bstar < 0) { if (run + c0 >= need) { bstar = seg * 64 + 2 * i; cbin = c0; } else run += c0; } }
                      const unsigned nlo = ulo + ((unsigned)bstar << sh); const unsigned long long e = (unsigned long long)nlo + ((1ull << sh) - 1ull);
                      const unsigned nhi = e > (unsigned long long)uhi ? uhi : (unsigned)e;
                      if (cbin <= (unsigned)CAPF || sh == 0u) { st[S_FLO + q] = nlo; st[S_FHI + q] = nhi; st[S_ACT + q] = 0u; st[S_ULO + q] = 1u; st[S_UHI + q] = 0u; }
                      else { st[S_ULO + q] = nlo; st[S_UHI + q] = nhi; st[S_SH + q] = sh >= 9u ? sh - 9u : 0u; st[S_NEED + q] = need - run; st[S_ANY] = 1u; }
                  }
              } }
            __syncthreads();
            if (stage == 0) {
                if (tid < 64) { const unsigned b1 = st[S_PB1 + tid], b2 = st[S_PB2 + tid]; const unsigned lob = b2 > 0u ? b2 - 1u : 0u, hib = b1 < 510u ? b1 + 1u : 511u;
                    const unsigned nlo = lob << 23; const unsigned long long e = ((unsigned long long)(hib + 1u) << 23) - 1ull; const unsigned nhi = e > 0xFFFFFFFFull ? 0xFFFFFFFFu : (unsigned)e;
                    st[S_ULO + tid] = nlo; st[S_UHI + tid] = 0xFFFFFFFFu; st[S_SH + tid] = sh_for(nhi - nlo); st[S_PAB + tid] = 0u; st[S_PB1 + tid] = 511u; st[S_PB2 + tid] = 0u; }
                stage = 1;
            } else if (stage == 1) {
                if (tid < 64) { const unsigned b1 = st[S_PB1 + tid], b2 = st[S_PB2 + tid], ulo = st[S_ULO + tid], uhi = st[S_UHI + tid], sh = st[S_SH + tid];
                    const unsigned flo = ulo + (b2 << sh); const unsigned long long e = (unsigned long long)ulo + ((unsigned long long)(b1 + 1u) << sh) - 1ull;
                    st[S_FLO + tid] = flo; st[S_FHI + tid] = (b1 >= 511u || e > (unsigned long long)uhi) ? uhi : (unsigned)e; }
                stage = 3;
            } else { const unsigned any = st[S_ANY]; if (!any) stage = 3; }
            __syncthreads();
        } else {
            const int vm = stage == 4 ? 1 : 0;
            if (vm) { if (tid < 64) { st[S_VMIN + tid] = 0xFFFFFFFFu; st[S_VMAX + tid] = 0u; st[S_VCNT + tid] = 0u; } __syncthreads(); }
            sweep<1>(F, A, Z, MASK, CANDW, qrow0, krow0, NT, 0, 1, vm);
            VM_WAIT(); __syncthreads();
            if (vm) { if (tid < 64) { if (st[S_VCNT + tid] != 256u || st[S_VMIN + tid] < st[S_VMAX + tid]) atomicOr(ERR, 1u); } __syncthreads(); break; }
            resolve(F, MASK, CANDW, qrow0, NT);
            VM_WAIT(); __syncthreads();
            unsigned nf = 0u;
            if (!after_fallback) { if (tid < 64) nf = st[S_FAIL + tid] & st[S_COL + tid]; nf = (unsigned)__syncthreads_or((int)nf); }
            if (nf) {
                if (tid < 64) { const unsigned f = st[S_FAIL + tid] & st[S_COL + tid]; st[S_ULO + tid] = f ? 0u : 1u; st[S_UHI + tid] = f ? 0xFFFFFFFFu : 0u; st[S_SH + tid] = 23u; st[S_NEED + tid] = 256u; st[S_ACT + tid] = f;
                    st[S_COL + tid] = f; if (f) { st[S_CCNT + tid] = 0u; st[S_ABOVE + tid] = 0u; } }
                __syncthreads();
                stage = 2; after_fallback = true;
            } else { if (IX_VERIFY) stage = 4; else break; }
        }
    }
}
}

namespace peer {
constexpr int TT = 16;
constexpr int SP = 129;
constexpr int OFF_S = 0, OFF_L = 256 * SP * 4;
constexpr int OFF_A = 0;
__device__ __forceinline__ void ins16(unsigned (&L)[16], unsigned x) {
#pragma unroll
    for (int j = 0; j < 16; ++j) { const unsigned a = L[j]; const unsigned mx = a > x ? a : x; x = a > x ? x : a; L[j] = mx; }
}
__device__ __forceinline__ float dot2bf(unsigned w, unsigned x, float acc) { return __builtin_amdgcn_fdot2_f32_bf16(__builtin_bit_cast(bf16x2_t, w), __builtin_bit_cast(bf16x2_t, x), acc, false); }
__device__ __forceinline__ float gelu_erf(float h) { return 0.5f * h * (1.f + erff(h * 0.70710678118654752f)); }

__device__ __forceinline__ void fp8dot4(unsigned w, f32x2 h01, f32x2 h23, f32x2& a0, f32x2& a1) {
    const f32x2 lo = __builtin_amdgcn_cvt_pk_f32_fp8((int)w, false), hi = __builtin_amdgcn_cvt_pk_f32_fp8((int)w, true); a0 = lo * h01 + a0; a1 = hi * h23 + a1; }
__device__ __forceinline__ void fp8axpy4(unsigned w, f32x2 a2, f32x2& c01, f32x2& c23) {
    const f32x2 lo = __builtin_amdgcn_cvt_pk_f32_fp8((int)w, false), hi = __builtin_amdgcn_cvt_pk_f32_fp8((int)w, true); c01 = lo * a2 + c01; c23 = hi * a2 + c23; }
constexpr int NSL = 16, SLW = 128;
__device__ __forceinline__ float dpp_sum8(float v) {
    v += __int_as_float(__builtin_amdgcn_update_dpp(0, __float_as_int(v), 0xB1, 0xF, 0xF, true));
    v += __int_as_float(__builtin_amdgcn_update_dpp(0, __float_as_int(v), 0x4E, 0xF, 0xF, true));
    v += __int_as_float(__builtin_amdgcn_update_dpp(0, __float_as_int(v), 0x141, 0xF, 0xF, true));
    return v;
}
#define PEER_EID(V0, V1, i) ((((i) < 8 ? (V0) : (V1))[((i) & 7) >> 1] >> (16 * ((i) & 1))) & 0xffffu)

struct TabCvt { const float* pu; const float* pv; unsigned char* UB; unsigned char* VB; float* RSU; float* RSV; };
__device__ __forceinline__ const float* tab_src(const TabCvt& T, int m) { return m < NEXP ? T.pu + (size_t)m * DM : T.pv + (size_t)(m - NEXP) * DM; }
__device__ __forceinline__ void tab_finish(const TabCvt& T, const RowF32& R, int m, int lane) { if (m < NEXP) row_to_fp8_sliced(R, T.UB, m, T.RSU + m, lane); else row_to_fp8_sliced(R, T.VB, m - NEXP, T.RSV + (m - NEXP), lane); }
__device__ __forceinline__ void route_step(const Frame& F, const bf16_t* PQ, const bf16x8 (&Bf)[2][8], unsigned short* E16, float* GT, int tok0, const TabCvt& T, int m0, int m1) {
    const int tid = F.tid, lane = F.lane, wave = F.wave, r = lane & 31, hi = lane >> 5;
    LAS float* S = (LAS float*)(F.lds + OFF_S); LAS unsigned* L = (LAS unsigned*)(F.lds + OFF_L);
    RowF32 R;
    if (m0 >= 0) row_load(R, tab_src(T, m0), lane);
    { const int half = wave & 1, cp = (wave >> 1) & 1, rh = wave >> 2;
#pragma unroll
      for (int r2 = 0; r2 < 2; ++r2) {
          const int rt = 2 * rh + r2; const int pair = 32 * rt + r, tok = pair >> 3, p = pair & 7;
          const bf16_t* src = PQ + (size_t)(tok0 + tok) * DM + p * 256 + half * 128 + 8 * hi;
          bf16x8 A[8];
#pragma unroll
          for (int ks = 0; ks < 8; ++ks) A[ks] = *(const bf16x8*)(src + ks * 16);
#pragma unroll
          for (int c2 = 0; c2 < 2; ++c2) {
              f32x16 acc = f32x16{};
#pragma unroll
              for (int ks = 0; ks < 8; ++ks) acc = __builtin_amdgcn_mfma_f32_32x32x16_bf16(A[ks], Bf[c2][ks], acc, 0, 0, 0);
#pragma unroll
              for (int i = 0; i < 16; ++i) { const int row = (32 * rt + (i & 3) + 8 * (i >> 2) + 4 * hi) * 2 + half; S[row * SP + (2 * cp + c2) * 32 + r] = acc[i]; }
          } } }
    if (m0 >= 0) tab_finish(T, R, m0, lane);
    if (m1 >= 0) row_load(R, tab_src(T, m1), lane);
    __syncthreads();
    { const int row = tid >> 1, part = tid & 1; unsigned L16[16];
#pragma unroll
      for (int j = 0; j < 16; ++j) L16[j] = 0u;
#pragma unroll 4
      for (int n = 0; n < 64; ++n) { const int nn = part * 64 + n; const unsigned k = (f2ord(S[row * SP + nn]) & ~127u) | (unsigned)(127 - nn); ins16(L16, k); }
      unsigned oth[16];
#pragma unroll
      for (int j = 0; j < 16; ++j) oth[j] = __shfl_xor(L16[j], 1);
#pragma unroll
      for (int j = 0; j < 16; ++j) ins16(L16, part == 0 ? oth[j] : 0u);
      if (part == 0) {
#pragma unroll
          for (int j = 0; j < 16; ++j) L[row * 16 + j] = L16[j]; } }
    __syncthreads();
    if (tid < 128) {
        const int pair = tid; const LAS float* S1 = S + (pair * 2) * SP; const LAS float* S2 = S + (pair * 2 + 1) * SP;
        const LAS unsigned* L1 = L + (pair * 2) * 16; const LAS unsigned* L2 = L1 + 16;
        float v1[16], v2[16];
#pragma unroll
        for (int j = 0; j < 16; ++j) { v1[j] = S1[127 - (L1[j] & 127u)]; v2[j] = S2[127 - (L2[j] & 127u)]; }
        unsigned C16[16];
#pragma unroll
        for (int j = 0; j < 16; ++j) C16[j] = 0u;
#pragma unroll
        for (int i = 0; i < 16; ++i)
#pragma unroll
            for (int j = 0; j < 16; ++j) if ((i + 1) * (j + 1) <= 16) { const unsigned k = (f2ord(v1[i] + v2[j]) & ~255u) | (unsigned)(255 - (i * 16 + j)); ins16(C16, k); }
        float sc[16]; unsigned ex[16]; float mx = -3.0e38f;
#pragma unroll
        for (int q = 0; q < 16; ++q) { const unsigned ci = 255u - (C16[q] & 255u); const unsigned n1 = 127u - (L1[ci >> 4] & 127u), n2 = 127u - (L2[ci & 15u] & 127u);
            sc[q] = S1[n1] + S2[n2]; ex[q] = n1 * 128u + n2; mx = fmaxf(mx, sc[q]); }
        float sum = 0.f;
#pragma unroll
        for (int q = 0; q < 16; ++q) { sc[q] = __expf(sc[q] - mx); sum += sc[q]; }
        const float inv = 1.f / sum;
        const size_t o = (size_t)(tok0 + (pair >> 3)) * 128 + (pair & 7) * 16;
        u32x4 e0, e1; e0.x = ex[0] | (ex[1] << 16); e0.y = ex[2] | (ex[3] << 16); e0.z = ex[4] | (ex[5] << 16); e0.w = ex[6] | (ex[7] << 16);
        e1.x = ex[8] | (ex[9] << 16); e1.y = ex[10] | (ex[11] << 16); e1.z = ex[12] | (ex[13] << 16); e1.w = ex[14] | (ex[15] << 16);
        *(u32x4*)(E16 + o) = e0; *(u32x4*)(E16 + o + 8) = e1;
#pragma unroll
        for (int q = 0; q < 4; ++q) *(f32x4*)(GT + o + 4 * q) = (f32x4){sc[4 * q] * inv, sc[4 * q + 1] * inv, sc[4 * q + 2] * inv, sc[4 * q + 3] * inv};
    }
    if (m1 >= 0) tab_finish(T, R, m1, lane);
    __syncthreads();
}

__device__ __forceinline__ void udot_compute(const u32x4 (&d)[16], const u32x4 h0, const u32x4 h1, float* dst, int k, bool ok) {
    f32x2 hq[8];
    hq[0] = (f32x2){bflo(h0.x), bfhi(h0.x)}; hq[1] = (f32x2){bflo(h0.y), bfhi(h0.y)}; hq[2] = (f32x2){bflo(h0.z), bfhi(h0.z)}; hq[3] = (f32x2){bflo(h0.w), bfhi(h0.w)};
    hq[4] = (f32x2){bflo(h1.x), bfhi(h1.x)}; hq[5] = (f32x2){bflo(h1.y), bfhi(h1.y)}; hq[6] = (f32x2){bflo(h1.z), bfhi(h1.z)}; hq[7] = (f32x2){bflo(h1.w), bfhi(h1.w)};
    float keep0 = 0.f, keep1 = 0.f;
#pragma unroll
    for (int i = 0; i < 16; ++i) {
        f32x2 a0 = {0.f, 0.f}, a1 = {0.f, 0.f};
        fp8dot4(d[i].x, hq[0], hq[1], a0, a1); fp8dot4(d[i].y, hq[2], hq[3], a0, a1); fp8dot4(d[i].z, hq[4], hq[5], a0, a1); fp8dot4(d[i].w, hq[6], hq[7], a0, a1);
        const float pr = dpp_sum8((a0.x + a0.y) + (a1.x + a1.y));
        if ((i & 7) == k) { if (i < 8) keep0 = pr; else keep1 = pr; }
    }
    if (ok) { dst[0] = keep0; dst[8] = keep1; }
}
__device__ __forceinline__ void udots(const Frame& F, const bf16_t* HN, const unsigned char* UB, const unsigned short* E16, float* PART) {
    const int lane = F.lane, g = lane >> 3, k = lane & 7;
    const int ngr = (F.G % 8 == 0) ? 8 : 1, wpg = F.G / ngr, x = F.vcu / wpg, wl = (F.vcu % wpg) * NWAVES + F.wave, wst = wpg * NWAVES, spg = NSL / ngr;
    const int ntw = (NTOK - wl + wst - 1) / wst;
#define UD_T(j) ((size_t)((wl + (j) * wst) < NTOK ? (wl + (j) * wst) : (NTOK - 1)))
#define UD_IDS(j, V0, V1) { const unsigned short* ep_ = E16 + UD_T(j) * 128 + g * 16; V0 = *(const u32x4*)ep_; V1 = *(const u32x4*)(ep_ + 8); }
#define UD_HN(j, H0, H1) { const bf16_t* hp_ = HN + UD_T(j) * DM + s * SLW + k * 16; H0 = *(const u32x4*)hp_; H1 = *(const u32x4*)(hp_ + 8); }
#define UD_ROWS(D, V0, V1) { _Pragma("unroll") for (int i = 0; i < 16; ++i) D[i] = *(const u32x4*)(ub + (size_t)PEER_EID(V0, V1, i) * 128); }
    for (int rr = 0; rr < spg; ++rr) {
        const int s = x + ngr * rr;
        const unsigned char* ub = UB + (size_t)s * ((size_t)NEXP * 128) + k * 16;
        float* pb = PART + (size_t)s * NTOK * 128 + g * 16 + k;
        u32x4 dA[16], dB[16], idA0, idA1, idB0, idB1, hA0, hA1, hB0, hB1;
        UD_IDS(0, idA0, idA1) UD_HN(0, hA0, hA1) UD_ROWS(dA, idA0, idA1)
        UD_IDS(1, idB0, idB1) UD_HN(1, hB0, hB1)
        for (int j = 0; j < ntw; j += 2) {
            UD_ROWS(dB, idB0, idB1)
            UD_IDS(j + 2, idA0, idA1)
            udot_compute(dA, hA0, hA1, pb + UD_T(j) * 128, k, true);
            UD_HN(j + 2, hA0, hA1)
            UD_ROWS(dA, idA0, idA1)
            UD_IDS(j + 3, idB0, idB1)
            udot_compute(dB, hB0, hB1, pb + UD_T(j + 1) * 128, k, j + 1 < ntw);
            UD_HN(j + 3, hB0, hB1)
        }
    }
#undef UD_IDS
#undef UD_HN
#undef UD_ROWS
}
#if UDOT_MFMA
__device__ __forceinline__ void udot_mfma_compute(const u32x4 (&d)[16], const i32x8 hb, LAS unsigned char* tb, float* dst, int lane, bool ok) {
    const int g = lane >> 3, k = lane & 7, c = lane & 15, q = lane >> 4;
#pragma unroll
    for (int i = 0; i < 16; ++i) *(LAS u32x4*)(tb + (8 * i + (g ^ ((i >> 3) & 1))) * 128 + ((k ^ (i & 7)) << 4)) = d[i];
    f32x4 acc[8];
#pragma unroll
    for (int m = 0; m < 8; ++m) { LAS const unsigned char* rp = tb + (8 * c + (m ^ ((c >> 3) & 1))) * 128;
        const i32x8 a = pg8::cat8(*(LAS const bf16x8*)(rp + (((2 * q) ^ (c & 7)) << 4)), *(LAS const bf16x8*)(rp + (((2 * q + 1) ^ (c & 7)) << 4)));
        acc[m] = __builtin_amdgcn_mfma_scale_f32_16x16x128_f8f6f4(a, hb, (f32x4){0.f, 0.f, 0.f, 0.f}, 0, 0, 0, 0, 0, 0); }
    f32x4 v = acc[0];
#pragma unroll
    for (int m = 1; m < 8; ++m) { if ((c & 7) == m) v = acc[m]; }
#pragma unroll
    for (int e = 0; e < 4; ++e) v[e] += __int_as_float(__builtin_amdgcn_update_dpp(0, __float_as_int(v[e]), 0x128, 0xF, 0xF, true));
#if PART_BF16
    if (ok && c < 8) *(u32x2*)((bf16_t*)dst + 16 * c + 4 * q) = (u32x2){cvtpk(v[0], v[1]), cvtpk(v[2], v[3])};
#else
    if (ok && c < 8) *(f32x4*)(dst + 16 * c + 4 * q) = v;
#endif
}
__device__ __forceinline__ void udots_mfma(const Frame& F, const unsigned char* HNhi, const unsigned char* HNlo, const unsigned char* UB, const unsigned short* E16, float* PART) {
    const int lane = F.lane, g = lane >> 3, k = lane & 7, c = lane & 15, q = lane >> 4;
    const int ngr = (F.G % 8 == 0) ? 8 : 1, wpg = F.G / ngr, x = F.vcu / wpg, wl = (F.vcu % wpg) * NWAVES + F.wave, wst = wpg * NWAVES, spg = NSL / ngr;
    const int ntw = (NTOK - wl + wst - 1) / wst;
    LAS unsigned char* tb = F.lds + F.wave * 16384;
    const unsigned char* hsel = (c < 8) ? HNhi : HNlo;
#define UD_IDS(j, V0, V1) { const unsigned short* ep_ = E16 + UD_T(j) * 128 + g * 16; V0 = *(const u32x4*)ep_; V1 = *(const u32x4*)(ep_ + 8); }
#define UD_H8(j, H) { const unsigned char* hp_ = hsel + UD_T(j) * DM + s * SLW + q * 32; H = pg8::cat8(*(const bf16x8*)hp_, *(const bf16x8*)(hp_ + 16)); }
#define UD_ROWS(D, V0, V1) { _Pragma("unroll") for (int i = 0; i < 16; ++i) D[i] = *(const u32x4*)(ub + (size_t)PEER_EID(V0, V1, i) * 128); }
    for (int rr = 0; rr < spg; ++rr) {
        const int s = x + ngr * rr;
        const unsigned char* ub = UB + (size_t)s * ((size_t)NEXP * 128) + k * 16;
        float* pb = PART + (size_t)s * NTOK * (PART_BF16 ? 64 : 128);
        u32x4 dA[16], dB[16], idA0, idA1, idB0, idB1; i32x8 hA, hB;
        UD_IDS(0, idA0, idA1) UD_H8(0, hA) UD_ROWS(dA, idA0, idA1)
        UD_IDS(1, idB0, idB1) UD_H8(1, hB)
        for (int j = 0; j < ntw; j += 2) {
            UD_ROWS(dB, idB0, idB1)
            UD_IDS(j + 2, idA0, idA1)
            udot_mfma_compute(dA, hA, tb, pb + UD_T(j) * (PART_BF16 ? 64 : 128), lane, true);
            UD_H8(j + 2, hA)
            UD_ROWS(dA, idA0, idA1)
            UD_IDS(j + 3, idB0, idB1)
            udot_mfma_compute(dB, hB, tb, pb + UD_T(j + 1) * (PART_BF16 ? 64 : 128), lane, j + 1 < ntw);
            UD_H8(j + 3, hB)
        }
    }
#undef UD_IDS
#undef UD_H8
#undef UD_ROWS
}
#endif
__device__ __forceinline__ void combine(const Frame& F, const float* PART, const unsigned short* E16, const float* GT, const float* RSU, const float* RSV, float* AT, unsigned* A8HI = nullptr, unsigned* A8LO = nullptr, float* ASC = nullptr) {
    const size_t n4 = (size_t)NTOK * 128 / 4, stride = (size_t)F.G * NWAVES * 64;
    for (size_t i = (size_t)F.vcu * NWAVES * 64 + F.tid; i < n4; i += stride) {
        f32x4 pv[NSL];
#pragma unroll
        for (int s = 0; s < NSL; ++s) {
#if PART_BF16 && UDOT_MFMA
            const u32x2 w = *(const u32x2*)((const bf16_t*)PART + (size_t)s * n4 * 4 + i * 4); pv[s] = (f32x4){bflo(w.x), bfhi(w.x), bflo(w.y), bfhi(w.y)};
#else
            pv[s] = *(const f32x4*)(PART + (size_t)s * n4 * 4 + i * 4);
#endif
        }
        const u32x2 ee = *(const u32x2*)(E16 + i * 4); const f32x4 gg = *(const f32x4*)(GT + i * 4);
        const unsigned e0 = ee.x & 0xffffu, e1 = ee.x >> 16, e2 = ee.y & 0xffffu, e3 = ee.y >> 16;
        const float su0 = RSU[e0], su1 = RSU[e1], su2 = RSU[e2], su3 = RSU[e3], sv0 = RSV[e0], sv1 = RSV[e1], sv2 = RSV[e2], sv3 = RSV[e3];
        f32x4 sacc = pv[0];
#pragma unroll
        for (int s = 1; s < NSL; ++s) sacc += pv[s];
        f32x4 o; o.x = gg.x * gelu_erf(sacc.x * su0) * sv0; o.y = gg.y * gelu_erf(sacc.y * su1) * sv1; o.z = gg.z * gelu_erf(sacc.z * su2) * sv2; o.w = gg.w * gelu_erf(sacc.w * su3) * sv3;
        if (A8HI) {
            float am = fmaxf(fmaxf(fabsf(o.x), fabsf(o.y)), fmaxf(fabsf(o.z), fabsf(o.w)));
#pragma unroll
            for (int sh = 1; sh < 32; sh <<= 1) am = fmaxf(am, __shfl_xor(am, sh));
            const float sc = (am > 0.f && am < 3.0e38f) ? exp2f(floorf(log2f(224.f / am))) : 1.f;
            const f32x4 y = o * sc;
            int w = __builtin_amdgcn_cvt_pk_fp8_f32(y.x, y.y, 0, false); w = __builtin_amdgcn_cvt_pk_fp8_f32(y.z, y.w, w, true);
            const f32x2 b01 = __builtin_amdgcn_cvt_pk_f32_fp8(w, false), b23 = __builtin_amdgcn_cvt_pk_f32_fp8(w, true);
            int u = __builtin_amdgcn_cvt_pk_fp8_f32(y.x - b01.x, y.y - b01.y, 0, false); u = __builtin_amdgcn_cvt_pk_fp8_f32(y.z - b23.x, y.w - b23.y, u, true);
            A8HI[i] = (unsigned)w; A8LO[i] = (unsigned)u; if ((i & 31) == 0) ASC[i >> 5] = 1.f / sc;
        } else
        *(f32x4*)(AT + i * 4) = o;
    }
}
__device__ __forceinline__ void vacc_compute(const u32x4 (&d)[16], const f32x4 a0, const f32x4 a1, const f32x4 a2, const f32x4 a3, float* orow, int g, bool ok) {
    f32x2 acc[8];
#pragma unroll
    for (int c = 0; c < 8; ++c) acc[c] = (f32x2){0.f, 0.f};
    const float av[16] = {a0.x, a0.y, a0.z, a0.w, a1.x, a1.y, a1.z, a1.w, a2.x, a2.y, a2.z, a2.w, a3.x, a3.y, a3.z, a3.w};
#pragma unroll
    for (int i = 0; i < 16; ++i) { const f32x2 aa = {av[i], av[i]};
        fp8axpy4(d[i].x, aa, acc[0], acc[1]); fp8axpy4(d[i].y, aa, acc[2], acc[3]); fp8axpy4(d[i].z, aa, acc[4], acc[5]); fp8axpy4(d[i].w, aa, acc[6], acc[7]); }
    float v[16];
#pragma unroll
    for (int c = 0; c < 8; ++c) { v[2 * c] = acc[c].x; v[2 * c + 1] = acc[c].y; }
    float R[8], S4[4];
#pragma unroll
    for (int c = 0; c < 8; ++c) { auto r = __builtin_amdgcn_permlane32_swap(__float_as_uint(v[c]), __float_as_uint(v[c + 8]), false, false); R[c] = __uint_as_float(r[0]) + __uint_as_float(r[1]); }
#pragma unroll
    for (int c = 0; c < 4; ++c) { auto r = __builtin_amdgcn_permlane16_swap(__float_as_uint(R[c]), __float_as_uint(R[c + 4]), false, false); S4[c] = __uint_as_float(r[0]) + __uint_as_float(r[1]); }
    const bool b8 = (g & 1) != 0;
    float T0, T1;
    { const float keep = b8 ? S4[2] : S4[0], send = b8 ? S4[0] : S4[2]; T0 = keep + __int_as_float(__builtin_amdgcn_update_dpp(0, __float_as_int(send), 0x128, 0xF, 0xF, true)); }
    { const float keep = b8 ? S4[3] : S4[1], send = b8 ? S4[1] : S4[3]; T1 = keep + __int_as_float(__builtin_amdgcn_update_dpp(0, __float_as_int(send), 0x128, 0xF, 0xF, true)); }
    if (ok) { f32x2 o2 = *(const f32x2*)orow; o2.x += T0; o2.y += T1; *(f32x2*)orow = o2; }
}
__device__ __forceinline__ void vacc(const Frame& F, const unsigned char* VB, const unsigned short* E16, const float* AT, float* out) {
    const int lane = F.lane, g = lane >> 3, k = lane & 7;
    const int ngr = (F.G % 8 == 0) ? 8 : 1, wpg = F.G / ngr, x = F.vcu / wpg, wl = (F.vcu % wpg) * NWAVES + F.wave, wst = wpg * NWAVES, spg = NSL / ngr;
    const int ntw = (NTOK - wl + wst - 1) / wst;
#define UD_IDS(j, V0, V1) { const unsigned short* ep_ = E16 + UD_T(j) * 128 + g * 16; V0 = *(const u32x4*)ep_; V1 = *(const u32x4*)(ep_ + 8); }
#define VA_A(j, A0, A1, A2, A3) { const float* ap_ = AT + UD_T(j) * 128 + g * 16; A0 = *(const f32x4*)ap_; A1 = *(const f32x4*)(ap_ + 4); A2 = *(const f32x4*)(ap_ + 8); A3 = *(const f32x4*)(ap_ + 12); }
#define UD_ROWS(D, V0, V1) { _Pragma("unroll") for (int i = 0; i < 16; ++i) D[i] = *(const u32x4*)(vb + (size_t)PEER_EID(V0, V1, i) * 128); }
    for (int rr = 0; rr < spg; ++rr) {
        const int s = x + ngr * rr;
        const unsigned char* vb = VB + (size_t)s * ((size_t)NEXP * 128) + k * 16;
        float* ob = out + s * SLW + k * 16 + 2 * g;
        u32x4 dA[16], dB[16], idA0, idA1, idB0, idB1; f32x4 aA0, aA1, aA2, aA3, aB0, aB1, aB2, aB3;
        UD_IDS(0, idA0, idA1) VA_A(0, aA0, aA1, aA2, aA3) UD_ROWS(dA, idA0, idA1)
        UD_IDS(1, idB0, idB1) VA_A(1, aB0, aB1, aB2, aB3)
        for (int j = 0; j < ntw; j += 2) {
            UD_ROWS(dB, idB0, idB1)
            UD_IDS(j + 2, idA0, idA1)
            vacc_compute(dA, aA0, aA1, aA2, aA3, ob + UD_T(j) * DM, g, true);
            VA_A(j + 2, aA0, aA1, aA2, aA3)
            UD_ROWS(dA, idA0, idA1)
            UD_IDS(j + 3, idB0, idB1)
            vacc_compute(dB, aB0, aB1, aB2, aB3, ob + UD_T(j + 1) * DM, g, j + 1 < ntw);
            VA_A(j + 3, aB0, aB1, aB2, aB3)
        }
    }
#undef UD_T
#undef UD_IDS
#undef VA_A
#undef UD_ROWS
}
#if VACC_MFMA
__device__ __forceinline__ u32x2 tr8_read(int addr) { u32x2 r; asm volatile("ds_read_b64_tr_b8 %0, %1" : "=&v"(r) : "v"(addr) : "memory"); return r; }
__device__ __forceinline__ void vacc_mfma_compute(const u32x4 (&d)[16], const i32x8 ab, const float asc, f32x4 o4, int wk, const int (&rb)[4], float* orow, int lane, bool ok) {
    const int c = lane & 15;
#pragma unroll
    for (int i = 0; i < 16; ++i) { const int wa = (wk ^ ((i & 7) << 4)) + i * 1024; *(LAS u32x4*)(uintptr_t)wa = d[i]; }
    f32x4 acc[8];
#pragma unroll
    for (int m = 0; m < 8; ++m) {
        const u32x2 t0 = tr8_read(rb[0] ^ (m << 4)), t1 = tr8_read(rb[1] ^ (m << 4)), t2 = tr8_read(rb[2] ^ (m << 4)), t3 = tr8_read(rb[3] ^ (m << 4));
        asm volatile("s_waitcnt lgkmcnt(0)" ::: "memory");
        const i32x8 a = {(int)t0.x, (int)t0.y, (int)t1.x, (int)t1.y, (int)t2.x, (int)t2.y, (int)t3.x, (int)t3.y};
        acc[m] = __builtin_amdgcn_mfma_scale_f32_16x16x128_f8f6f4(a, ab, (f32x4){0.f, 0.f, 0.f, 0.f}, 0, 0, 0, 0, 0, 0); }
    f32x4 v = acc[0];
#pragma unroll
    for (int m = 1; m < 8; ++m) { if ((c & 7) == m) v = acc[m]; }
#pragma unroll
    for (int e = 0; e < 4; ++e) v[e] += __int_as_float(__builtin_amdgcn_update_dpp(0, __float_as_int(v[e]), 0x128, 0xF, 0xF, true));
    if (ok && c < 8) *(f32x4*)orow = o4 + v * asc;
}
__device__ __forceinline__ void vacc_mfma(const Frame& F, const unsigned char* VB, const unsigned short* E16, const unsigned char* A8HI, const unsigned char* A8LO, const float* ASC, float* out) {
    const int lane = F.lane, g = lane >> 3, k = lane & 7, c = lane & 15, q = lane >> 4;
    const int ngr = (F.G % 8 == 0) ? 8 : 1, wpg = F.G / ngr, x = F.vcu / wpg, wl = (F.vcu % wpg) * NWAVES + F.wave, wst = wpg * NWAVES, spg = NSL / ngr;
    const int ntw = (NTOK - wl + wst - 1) / wst;
    const int tile = (int)(uintptr_t)(F.lds + F.wave * 16384);
    const int wk = tile + 128 * g + 16 * k;
    int rb[4];
#pragma unroll
    for (int t = 0; t < 4; ++t) { const int r = c >> 1, cc = c & 1, phys = 64 * (t & 1) + 8 * r + 2 * q + (t >> 1); rb[t] = tile + phys * 128 + (r << 4) + 8 * cc; }
    const unsigned char* asel = (c < 8) ? A8HI : A8LO;
#define UD_T(j) ((size_t)((wl + (j) * wst) < NTOK ? (wl + (j) * wst) : (NTOK - 1)))
#define UD_IDS(j, V0, V1) { const unsigned short* ep_ = E16 + UD_T(j) * 128 + g * 16; V0 = *(const u32x4*)ep_; V1 = *(const u32x4*)(ep_ + 8); }
#define VA_A8(j, A, S, O) { const unsigned char* ap_ = asel + UD_T(j) * 128 + q * 32; A = pg8::cat8(*(const bf16x8*)ap_, *(const bf16x8*)(ap_ + 16)); S = ASC[UD_T(j)]; O = *(const f32x4*)(ob + UD_T(j) * DM); }
#define UD_ROWS(D, V0, V1) { _Pragma("unroll") for (int i = 0; i < 16; ++i) D[i] = *(const u32x4*)(vb + (size_t)PEER_EID(V0, V1, i) * 128); }
    for (int rr = 0; rr < spg; ++rr) {
        const int s = x + ngr * rr;
        const unsigned char* vb = VB + (size_t)s * ((size_t)NEXP * 128) + k * 16;
        float* ob = out + s * SLW + 16 * (c & 7) + 4 * q;
        u32x4 dA[16], dB[16], idA0, idA1, idB0, idB1; i32x8 aA, aB; float sA, sB; f32x4 oA, oB;
        UD_IDS(0, idA0, idA1) VA_A8(0, aA, sA, oA) UD_ROWS(dA, idA0, idA1)
        UD_IDS(1, idB0, idB1) VA_A8(1, aB, sB, oB)
        for (int j = 0; j < ntw; j += 2) {
            UD_ROWS(dB, idB0, idB1)
            UD_IDS(j + 2, idA0, idA1)
            vacc_mfma_compute(dA, aA, sA, oA, wk, rb, ob + UD_T(j) * DM, lane, true);
            VA_A8(j + 2, aA, sA, oA)
            UD_ROWS(dA, idA0, idA1)
            UD_IDS(j + 3, idB0, idB1)
            vacc_mfma_compute(dB, aB, sB, oB, wk, rb, ob + UD_T(j + 1) * DM, lane, j + 1 < ntw);
            VA_A8(j + 3, aB, sB, oB)
        }
    }
#undef UD_T
#undef UD_IDS
#undef VA_A8
#undef UD_ROWS
}
#endif
}

__device__ __forceinline__ void pool_unit(const Frame& F, bf16_t* MIX, const bf16_t* PWt, const float* pool_s, int tm, int g, unsigned char* MIX8 = nullptr) {
    const int lane = F.lane, r = lane & 31, hi = lane >> 5;
    bf16_t* base = MIX + (size_t)(tm * 256 + F.wave * 32) * DM + 1024 + 128 * g;
    bf16x8 A[8];
#pragma unroll
    for (int ks = 0; ks < 8; ++ks) A[ks] = *(const bf16x8*)(base + (size_t)r * DM + ks * 16 + 8 * hi);
#pragma unroll
    for (int ct = 0; ct < 4; ++ct) {
        f32x16 acc = f32x16{};
        const bf16_t* pb = PWt + (size_t)(g * 128 + ct * 32 + r) * 128 + 8 * hi;
#pragma unroll
        for (int ks = 0; ks < 8; ++ks) { const bf16x8 B = *(const bf16x8*)(pb + ks * 16); acc = __builtin_amdgcn_mfma_f32_32x32x16_bf16(A[ks], B, acc, 0, 0, 0); }
        const float sc = pool_s[128 * g + ct * 32 + r];
#pragma unroll
        for (int i = 0; i < 16; ++i) { const int row = (i & 3) + 8 * (i >> 2) + 4 * hi;
            if (MIX8) MIX8[(size_t)(tm * 256 + F.wave * 32 + row) * DM + 1024 + 128 * g + ct * 32 + r] = to_fp8(acc[i] * sc * MIX8_SCALE);
            else base[(size_t)row * DM + ct * 32 + r] = (bf16_t)(cvtpk(acc[i] * sc, 0.f) & 0xffffu); }
    }
}

__global__ void __launch_bounds__(NWAVES * 64, 2) fwd_kernel(Args args) {
    extern __shared__ __attribute__((aligned(16))) unsigned char lds[];
    Frame F;
    F.lds = (LAS unsigned char*)lds; F.ldsg = (char*)lds;
    F.tid = threadIdx.x; F.lane = F.tid & 63; F.wave = __builtin_amdgcn_readfirstlane(F.tid >> 6);
    F.G = gridDim.x; { const int bx = blockIdx.x; F.vcu = (F.G % 8 == 0) ? (bx % 8) * (F.G / 8) + bx / 8 : bx; }
    unsigned char* ws = args.ws;
    unsigned* ctl = (unsigned*)(ws + WS_CTL);
    volatile LAS unsigned* MISC = (volatile LAS unsigned*)(F.lds + MISC_OFF);
    for (int u = F.tid; u < (LDS_BYTES - LDSCTL_OFF) / 4; u += NWAVES * 64) ((LAS unsigned*)(F.lds + LDSCTL_OFF))[u] = 0u;
    __syncthreads();
    const int lo = args.ph_lo, hi = args.ph_hi;
    XcdBarrier bar; bar.bar = ctl + CW_BAR; bar.x = 0; bar.st = nullptr;
    if (hi - lo > 1) bar = xcd_barrier_post(ctl + CW_BAR, MISC + 8);
#define IN(k) (lo <= (k) && (k) < hi)
#define PHASE_BEGIN() do { int t_ = (int)threadIdx.x; asm volatile("" : "+v"(t_)); F.tid = t_; F.lane = t_ & 63; } while (0)
#define SEAM(k) do { if (IN(k) && IN((k) + 1)) xcd_barrier(bar); } while (0)

    bf16_t* Z = (bf16_t*)(ws + WS_Z); bf16_t* XN = (bf16_t*)(ws + WS_XN); bf16_t* MIX = XN;
    bf16_t* HN = (bf16_t*)(ws + WS_Z); bf16_t* PQ = (bf16_t*)(ws + WS_Z + 128 * MiB);
    bf16_t* KVM = (bf16_t*)(ws + WS_KVM); unsigned* MASK = (unsigned*)(ws + WS_MASK);

    if (IN(0)) { PHASE_BEGIN(); p0_prologue(F, args); } SEAM(0);
    if (IN(1)) { PHASE_BEGIN();
#if P1_FP8
        const int gw = F.vcu * NWAVES + F.wave, NGW = F.G * NWAVES;
        for (int i = gw; i < 4096; i += NGW) { const int n = i < 3072 ? i : i + 1024; RowF32 R; row_load_bf16(R, (const bf16_t*)(ws + WS_BT_IN) + (size_t)n * DM, F.lane); row_to_fp8(R, ws + WS_BTIN8 + (size_t)n * DM, (float*)(ws + WS_CSI) + n, F.lane); }
#endif
#if P5_FP8
        { const int gw = F.vcu * NWAVES + F.wave, NGW = F.G * NWAVES; float* cso = (float*)(ws + WS_CSO);
          for (int n = gw; n < DM; n += NGW) { RowF32 R; row_load_bf16(R, (const bf16_t*)(ws + WS_BT_OUT) + (size_t)n * DM, F.lane); row_to_fp8(R, ws + WS_BTOUT8 + (size_t)n * DM, cso + n, F.lane);
              if (F.lane == 0) cso[n] = cso[n] * (1.f / MIX8_SCALE); } }
#endif
    } SEAM(1);
    if (IN(2)) { PHASE_BEGIN();
#if P1_FP8
        { pg8::Gemm g{XN, (const bf16_t*)(ws + WS_BT_IN), NTOK, ZLD, DM}; pg8::InBf16Order S; S.init(NTOK, F.G, (int)blockIdx.x);
          pg8::EpiBf16 E{Z, ZLD}; pg8::gemm_phase<pg8::EpiBf16, pg8::InBf16Order, true, true>(F.lds, g, S, E); }
        { pg8::Gemm g{(const bf16_t*)(ws + WS_XN8), (const bf16_t*)(ws + WS_BTIN8), NTOK, ZLD, DM / 2}; pg8::InFp8Order S; S.init(NTOK, F.G, (int)blockIdx.x);
          pg8::EpiBf16S E{Z, ZLD, (const float*)(ws + WS_CSI)}; pg8::gemm_phase<pg8::EpiBf16S, pg8::InFp8Order, true, true, true>(F.lds, g, S, E); }
#else
        { pg8::Gemm g{XN, (const bf16_t*)(ws + WS_BT_IN), NTOK, ZLD, DM}; pg8::StaticOrder S; S.init(NTOK, ZLD, F.G, (int)blockIdx.x);
          pg8::EpiBf16 E{Z, ZLD}; pg8::gemm_phase<pg8::EpiBf16, pg8::StaticOrder, true, true>(F.lds, g, S, E); }
#endif
        { pg8::Gemm g{(const bf16_t*)(ws + WS_MN), (const bf16_t*)(ws + WS_BT_KV), BATCH * MEMLEN, 1024, DM}; pg8::StaticOrder S; S.init(BATCH * MEMLEN, 1024, F.G, (int)((blockIdx.x + 128) % F.G));
          pg8::EpiBf16 E{KVM, 1024}; pg8::gemm_phase<pg8::EpiBf16, pg8::StaticOrder, true, true>(F.lds, g, S, E); }
    } SEAM(2);
    if (IN(3)) { PHASE_BEGIN(); p2_post(F, args);
#if PV_FP8
        PHASE_BEGIN(); p2_vt(F, args);
#endif
    } SEAM(3);
    if (IN(4)) { PHASE_BEGIN();
        for (int i = 0; ; ++i) {
            int b, c;
            if (F.G == 256) { if (i >= 2) break; b = F.vcu >> 7; c = (i == 0) ? 255 - (F.vcu & 127) : (F.vcu & 127); }
            else { const int u = (int)blockIdx.x + i * F.G; if (u >= 512) break; b = u >> 8; c = u & 255; }
            ix::unit(F, Z, MASK, (unsigned long long*)(ws + WS_CAND) + (size_t)blockIdx.x * 64 * ix::CAPB, ctl + 2048, b, c);
            __syncthreads();
        }
    } SEAM(4);
    if (IN(5)) { PHASE_BEGIN();
        for (int u = F.vcu; u < (NTOK / 256) * 4; u += F.G) pool_unit(F, MIX, (const bf16_t*)(ws + WS_PWT), args.pool_s, u >> 2, u & 3, P5_FP8 ? ws + WS_MIX8 : nullptr);
        const int r32 = F.lane & 31;
        for (int i = 0; ; ++i) {
            int b, h, qb;
            if (F.G == 256) { if (i >= 4) break; const int bh = F.vcu >> 4, s = F.vcu & 15; b = bh >> 3; h = bh & 7; qb = (i == 0) ? 63 - s : (i == 1) ? 32 + s : (i == 2) ? 31 - s : s; }
            else { const int u = (int)blockIdx.x + i * F.G; if (u >= 1024) break; b = u >> 9; h = (u >> 6) & 7; qb = u & 63; }
            const size_t row0 = (size_t)b * SEQ + 256 * qb;
            const unsigned long long* mrow = (const unsigned long long*)MASK + (row0 + F.wave * 32 + r32) * (MASK_WPR / 2);
#if QK_FP8
            att::attn_body<true, 2, ZLD, ZLD, DM, true, PV_FP8 != 0>(Z + row0 * ZLD + ZC_Q + h * 128, Z + (size_t)b * SEQ * ZLD + ZC_K + h * 128, Z + (size_t)b * SEQ * ZLD + ZC_V + h * 128,
                                                        MIX + row0 * DM + h * 128, 256 * (qb + 1), mrow, F.ldsg, ws + WS_Q8 + row0 * 1024 + h * 128, ws + WS_K8 + (size_t)b * SEQ * 1024 + h * 128,
                                                        ws + WS_V8T + (size_t)(b * 8 + h) * 256 * 8192, P5_FP8 ? ws + WS_MIX8 + row0 * DM + h * 128 : nullptr);
#else
            att::attn_body<true, 2, ZLD, ZLD, DM>(Z + row0 * ZLD + ZC_Q + h * 128, Z + (size_t)b * SEQ * ZLD + ZC_K + h * 128, Z + (size_t)b * SEQ * ZLD + ZC_V + h * 128,
                                                  MIX + row0 * DM + h * 128, 256 * (qb + 1), mrow, F.ldsg);
#endif
        }
        for (int id = F.vcu; id < 512; id += F.G) {
            const int b2 = id >> 8, hm = (id >> 6) & 3, qb = id & 63; const size_t row0 = (size_t)b2 * SEQ + 256 * qb;
            att::attn_body<false, 1, ZLD, 1024, DM>(Z + row0 * ZLD + ZC_QM + hm * 128, KVM + (size_t)b2 * MEMLEN * 1024 + hm * 128, KVM + (size_t)b2 * MEMLEN * 1024 + 512 + hm * 128,
                                                    MIX + row0 * DM + 1536 + hm * 128, MEMLEN, nullptr, F.ldsg, nullptr, nullptr, nullptr, P5_FP8 ? ws + WS_MIX8 + row0 * DM + 1536 + hm * 128 : nullptr);
        }
    } SEAM(5);
    if (IN(6)) { PHASE_BEGIN();
#if ATT_VERIFY
        {
            const int t = (int)blockIdx.x * 128 + 77, hh = F.wave, ln = F.lane; const int bb = t / SEQ, pos = t % SEQ, N = 64 * (pos / 64 + 1);
            const bf16_t* zq = Z + (size_t)t * ZLD + ZC_Q + hh * 128 + 2 * ln; const float q0 = bflo((unsigned)zq[0]), q1 = bflo((unsigned)zq[1]);
            float m = -3.0e38f, l = 0.f, o0 = 0.f, o1 = 0.f; int nsel = 0;
            for (int w = 0; w < N / 32; ++w) { unsigned bits = __hip_atomic_load(MASK + (size_t)t * MASK_WPR + w, __ATOMIC_RELAXED, __HIP_MEMORY_SCOPE_AGENT);
                while (bits) { const int bpos = __builtin_ctz(bits); bits &= bits - 1u; const int sidx = 32 * w + bpos; ++nsel;
                    const bf16_t* zk = Z + ((size_t)bb * SEQ + sidx) * ZLD + ZC_K + hh * 128 + 2 * ln; const bf16_t* zv = Z + ((size_t)bb * SEQ + sidx) * ZLD + ZC_V + hh * 128 + 2 * ln;
                    const float lg = wave_sum(q0 * bflo((unsigned)zk[0]) + q1 * bflo((unsigned)zk[1])) * 0.088388347648318440f;
                    const float mn = fmaxf(m, lg), al = __expf(m - mn), pe = __expf(lg - mn); l = l * al + pe; o0 = o0 * al + pe * bflo((unsigned)zv[0]); o1 = o1 * al + pe * bflo((unsigned)zv[1]); m = mn; } }
            const bf16_t* mx = MIX + (size_t)t * DM + hh * 128 + 2 * ln; const float r0 = o0 / l, r1 = o1 / l;
            float er = fmaxf(fabsf(r0 - bflo((unsigned)mx[0])), fabsf(r1 - bflo((unsigned)mx[1]))), sc = fmaxf(fabsf(r0), fabsf(r1));
#pragma unroll
            for (int o = 1; o < 64; o <<= 1) { er = fmaxf(er, __shfl_xor(er, o)); sc = fmaxf(sc, __shfl_xor(sc, o)); }
            if (!(er <= (QK_FP8 ? 0.12f : 0.03f) * sc + (QK_FP8 ? 4e-3f : 1e-3f)) || nsel != (N < 256 ? N : 256)) { if (ln == 0) atomicOr(ctl + 2048, 2u); }
        }
        __syncthreads();
#endif
#if P5_FP8
        pg8::Gemm g{(const bf16_t*)(ws + WS_MIX8), (const bf16_t*)(ws + WS_BTOUT8), NTOK, DM, DM / 2}; pg8::StaticOrder S; S.init(NTOK, DM, F.G, (int)blockIdx.x);
        pg8::EpiF32ResS E{args.x, args.out, DM, (const float*)(ws + WS_CSO)}; pg8::gemm_phase<pg8::EpiF32ResS, pg8::StaticOrder, true, true, true>(F.lds, g, S, E);
#else
        pg8::Gemm g{MIX, (const bf16_t*)(ws + WS_BT_OUT), NTOK, DM, DM}; pg8::StaticOrder S; S.init(NTOK, DM, F.G, (int)blockIdx.x);
        pg8::EpiF32Res E{args.x, args.out, DM}; pg8::gemm_phase<pg8::EpiF32Res, pg8::StaticOrder, true, true>(F.lds, g, S, E);
#endif
    } SEAM(6);
    if (IN(7)) { PHASE_BEGIN(); const int gw = F.vcu * NWAVES + F.wave, NGW = F.G * NWAVES;
#if P7_FP8
        for (int n = gw; n < DM; n += NGW) { RowF32 R; row_load_bf16(R, (const bf16_t*)(ws + WS_BT_Q) + (size_t)n * DM, F.lane); row_to_fp8(R, ws + WS_BTQ8 + (size_t)n * DM, (float*)(ws + WS_CSQ) + n, F.lane); }
#if UDOT_MFMA
        { RowF32 Ra, Rb; int m = gw;
          if (m < NTOK) row_load(Ra, args.out + (size_t)m * DM, F.lane);
          for (; m < NTOK; m += 2 * NGW) { const int m2 = m + NGW, m3 = m + 2 * NGW;
              if (m2 < NTOK) row_load(Rb, args.out + (size_t)m2 * DM, F.lane);
              rms_fin_fp8_hilo(Ra.v, args.ffn_g, ws + WS_HN8 + (size_t)m * DM, ws + WS_HN8LO + (size_t)m * DM, F.lane);
              if (m3 < NTOK) row_load(Ra, args.out + (size_t)m3 * DM, F.lane);
              if (m2 < NTOK) rms_fin_fp8_hilo(Rb.v, args.ffn_g, ws + WS_HN8 + (size_t)m2 * DM, ws + WS_HN8LO + (size_t)m2 * DM, F.lane); } }
#else
        for (int m = gw; m < NTOK; m += NGW) { RowF32 R; row_load(R, args.out + (size_t)m * DM, F.lane); rms_fin_bf16_fp8(R.v, args.ffn_g, HN + (size_t)m * DM, ws + WS_HN8 + (size_t)m * DM, F.lane); }
#endif
#else
        for (int m = gw; m < NTOK; m += NGW) rms_row_to_bf16(args.out + (size_t)m * DM, args.ffn_g, HN + (size_t)m * DM, F.lane);
#endif
    } SEAM(7);
    if (IN(8)) { PHASE_BEGIN();
#if P7_FP8
        pg8::Gemm g{(const bf16_t*)(ws + WS_HN8), (const bf16_t*)(ws + WS_BTQ8), NTOK, DM, DM / 2}; pg8::StaticOrder S; S.init(NTOK, DM, F.G, (int)blockIdx.x);
        pg8::EpiBf16S E{PQ, DM, (const float*)(ws + WS_CSQ)}; pg8::gemm_phase<pg8::EpiBf16S, pg8::StaticOrder, true, true, true>(F.lds, g, S, E);
#else
        pg8::Gemm g{HN, (const bf16_t*)(ws + WS_BT_Q), NTOK, DM, DM}; pg8::StaticOrder S; S.init(NTOK, DM, F.G, (int)blockIdx.x);
        pg8::EpiBf16 E{PQ, DM}; pg8::gemm_phase<pg8::EpiBf16, pg8::StaticOrder, true, true>(F.lds, g, S, E);
#endif
    } SEAM(8);
    unsigned short* E16 = (unsigned short*)(ws + WS_XN); float* GT = (float*)(ws + WS_XN + 8 * MiB); float* AT = (float*)(ws + WS_XN + 24 * MiB);
    float* PART = (float*)(ws + WS_Z + 128 * MiB);
    if (IN(9)) { PHASE_BEGIN();
        const bf16_t* PKb = (const bf16_t*)(ws + WS_PK);
        bf16x8 Bf[2][8];
        { const int half = F.wave & 1, cp = (F.wave >> 1) & 1, r = F.lane & 31, hi = F.lane >> 5;
#pragma unroll
          for (int c2 = 0; c2 < 2; ++c2)
#pragma unroll
              for (int ks = 0; ks < 8; ++ks) Bf[c2][ks] = *(const bf16x8*)(PKb + (size_t)(half * 128 + (2 * cp + c2) * 32 + r) * 128 + 8 * hi + ks * 16); }
        const peer::TabCvt T{args.pu, args.pv, ws + WS_UB, ws + WS_VB, (float*)(ws + WS_RSU), (float*)(ws + WS_RSV)};
        const int gw = F.vcu * NWAVES + F.wave, NGW = F.G * NWAVES; int mrow = gw, nstep = 0;
        for (int it = F.vcu; it < NTOK / peer::TT; it += F.G, ++nstep) {
            const int m0 = mrow < 2 * NEXP ? mrow : -1; mrow += NGW; const int m1 = mrow < 2 * NEXP ? mrow : -1; mrow += NGW;
            peer::route_step(F, PQ, Bf, E16, GT, it * peer::TT, T, m0, m1);
        }
        for (; mrow < 2 * NEXP; mrow += NGW) { RowF32 R; row_load(R, peer::tab_src(T, mrow), F.lane); peer::tab_finish(T, R, mrow, F.lane); }
    } SEAM(9);
    if (IN(10)) { PHASE_BEGIN();
#if UDOT_MFMA
        peer::udots_mfma(F, ws + WS_HN8, ws + WS_HN8LO, ws + WS_UB, E16, PART);
#else
        peer::udots(F, HN, ws + WS_UB, E16, PART);
#endif
    } SEAM(10);
#if VACC_MFMA
    unsigned char* A8HI = ws + WS_XN + 24 * MiB; unsigned char* A8LO = ws + WS_XN + 28 * MiB; float* ASC = (float*)(ws + WS_XN + 32 * MiB);
    if (IN(11)) { PHASE_BEGIN(); peer::combine(F, PART, E16, GT, (const float*)(ws + WS_RSU), (const float*)(ws + WS_RSV), AT, (unsigned*)A8HI, (unsigned*)A8LO, ASC); } SEAM(11);
#else
    if (IN(11)) { PHASE_BEGIN(); peer::combine(F, PART, E16, GT, (const float*)(ws + WS_RSU), (const float*)(ws + WS_RSV), AT); } SEAM(11);
#endif
#if VACC_MFMA
    if (IN(12)) { PHASE_BEGIN(); peer::vacc_mfma(F, ws + WS_VB, E16, A8HI, A8LO, ASC, args.out); }
#else
    if (IN(12)) { PHASE_BEGIN(); peer::vacc(F, ws + WS_VB, E16, AT, args.out); }
#endif
#if IX_VERIFY || ATT_VERIFY
    if (IN(12)) { __syncthreads(); if (__hip_atomic_load(ctl + 2048, __ATOMIC_RELAXED, __HIP_MEMORY_SCOPE_AGENT) != 0u) { args.out[(size_t)blockIdx.x * 512 + threadIdx.x] = __builtin_nanf(""); } }
#endif
#undef IN
#undef SEAM
}

extern "C" void kernel_launch(void* const* d_in, const int* in_sizes, int n_in, void* d_out, int out_size, void* d_ws, size_t ws_size, hipStream_t stream) {
    static int grid = 0;
    if (grid == 0) {
        if (n_in != 19 || out_size != NTOK * DM || ws_size < WS_END) { fprintf(stderr, "kernel_launch: unexpected shapes (n_in %d out %d ws %zu)\n", n_in, out_size, ws_size); grid = -1; return; }
        int dev = 0, cus = 0;
        if (hipGetDevice(&dev) != hipSuccess || hipDeviceGetAttribute(&cus, hipDeviceAttributeMultiprocessorCount, dev) != hipSuccess) { grid = -1; return; }
        if (hipFuncSetAttribute((const void*)fwd_kernel, hipFuncAttributeMaxDynamicSharedMemorySize, LDS_BYTES) != hipSuccess) { fprintf(stderr, "kernel_launch: hipFuncSetAttribute failed\n"); grid = -1; return; }
        int per_cu = 0;
        if (hipOccupancyMaxActiveBlocksPerMultiprocessor(&per_cu, (const void*)fwd_kernel, NWAVES * 64, LDS_BYTES) != hipSuccess || per_cu < 1) { fprintf(stderr, "kernel_launch: occupancy query reports %d workgroups per CU for %d threads / %d B LDS; nothing launched\n", per_cu, NWAVES * 64, LDS_BYTES); grid = -1; return; }
        (void)hipGetLastError();
        grid = cus;
    }
    if (grid < 0) return;
    (void)hipMemsetAsync((char*)d_ws + WS_CTL, 0, CTL_ZERO_BYTES, stream);
    Args a{};
    a.x = (const float*)d_in[0]; a.mem = (const float*)d_in[1]; a.attn_g = (const float*)d_in[2]; a.w_in = (const float*)d_in[3]; a.q_g = (const float*)d_in[4]; a.k_g = (const float*)d_in[5];
    a.pool_w = (const float*)d_in[6]; a.pool_s = (const float*)d_in[7]; a.mem_g = (const float*)d_in[8]; a.w_kv = (const float*)d_in[9]; a.mq_g = (const float*)d_in[10]; a.mk_g = (const float*)d_in[11];
    a.w_out = (const float*)d_in[12]; a.ffn_g = (const float*)d_in[13]; a.w_q = (const float*)d_in[14]; a.sk1 = (const float*)d_in[15]; a.sk2 = (const float*)d_in[16];
    a.pu = (const float*)d_in[17]; a.pv = (const float*)d_in[18]; a.out = (float*)d_out; a.ws = (unsigned char*)d_ws;
#if MK_ONE_LAUNCH
    a.ph_lo = 0; a.ph_hi = N_PHASES;
    hipLaunchKernelGGL(fwd_kernel, dim3(grid), dim3(NWAVES * 64), LDS_BYTES, stream, a);
#else
    for (int p = 0; p < N_PHASES; ++p) { a.ph_lo = p; a.ph_hi = p + 1; for (int rep = 0; rep < ((PROBE_DUP_MASK >> p) & 1) + 1; ++rep) hipLaunchKernelGGL(fwd_kernel, dim3(grid), dim3(NWAVES * 64), LDS_BYTES, stream, a); }
#endif
}
```

```cpp
#include <hip/hip_runtime.h>
#include <hip/hip_bf16.h>
#include <cstdio>
#include <cstdint>

#ifndef IX_VERIFY
#define IX_VERIFY 0
#endif
#ifndef ATT_VERIFY
#define ATT_VERIFY 0
#endif
#ifndef PROBE_DUP_MASK
#define PROBE_DUP_MASK 0
#endif
#ifndef MK_ONE_LAUNCH
#define MK_ONE_LAUNCH 1
#endif
#ifndef P1_FP8
#define P1_FP8 1
#endif
#ifndef QK_FP8
#define QK_FP8 1
#endif
#ifndef PV_FP8
#define PV_FP8 1
#endif
#ifndef P5_FP8
#define P5_FP8 1
#endif
#ifndef UDOT_MFMA
#define UDOT_MFMA 1
#endif
#ifndef VACC_MFMA
#define VACC_MFMA 1
#endif
#ifndef PART_BF16
#define PART_BF16 1
#endif
#ifndef P7_FP8
#define P7_FP8 1
#endif

#if ATT_VERIFY && P5_FP8
#error "ATT_VERIFY reads the bf16 MIX: build it with -DP5_FP8=0"
#endif
#if PART_BF16 && !UDOT_MFMA
#error "PART_BF16 is implemented for the UDOT_MFMA path only"
#endif
#if UDOT_MFMA && !P7_FP8
#error "UDOT_MFMA drops the bf16 HN: it needs P7_FP8"
#endif
#define GAS __attribute__((address_space(1)))
#define LAS __attribute__((address_space(3)))
typedef unsigned short bf16_t;
typedef short bf16x8 __attribute__((ext_vector_type(8)));
typedef short s16x4 __attribute__((ext_vector_type(4)));
typedef float f32x4 __attribute__((ext_vector_type(4)));
typedef float f32x2 __attribute__((ext_vector_type(2)));
typedef float f32x16 __attribute__((ext_vector_type(16)));
typedef unsigned u32x4 __attribute__((ext_vector_type(4)));
typedef unsigned u32x2 __attribute__((ext_vector_type(2)));
typedef __bf16 bf16x2_t __attribute__((ext_vector_type(2)));
typedef int i32x8 __attribute__((ext_vector_type(8)));
typedef int i32x4 __attribute__((ext_vector_type(4)));

constexpr int BATCH = 2, SEQ = 16384, DM = 2048, NTOK = BATCH * SEQ, MEMLEN = 256;
constexpr int IN_W = 5200, ZLD = 5376;
constexpr int ZC_Q = 0, ZC_K = 1024, ZC_V = 2048, ZC_QI = 3072, ZC_PU = 4096, ZC_QM = 4608, ZC_KI = 5120, ZC_WI = 5184;
constexpr int NEXP = 16384;
constexpr float EPS = 1e-6f;
constexpr int MASK_WPR = 512;

constexpr size_t MiB = 1u << 20;
constexpr size_t WS_CTL = 0, CTL_ZERO_BYTES = 1 * MiB;
constexpr size_t WS_BT_IN = 2 * MiB;
constexpr size_t WS_BT_OUT = 24 * MiB;
constexpr size_t WS_BT_Q = 32 * MiB;
constexpr size_t WS_BT_KV = 40 * MiB;
constexpr size_t WS_MN = 44 * MiB;
constexpr size_t WS_KVM = 46 * MiB;
constexpr size_t WS_PK = 47 * MiB;
constexpr size_t WS_PWT = 47 * MiB + 512 * 1024;
constexpr size_t WS_XN = 48 * MiB;
constexpr size_t WS_Z = 176 * MiB;
constexpr size_t WS_MASK = 512 * MiB;
constexpr size_t WS_UB = 576 * MiB;
constexpr size_t WS_VB = 640 * MiB;
constexpr size_t WS_RSU = 47 * MiB + 128 * 1024, WS_RSV = 47 * MiB + 256 * 1024;
constexpr size_t WS_ROPE = 704 * MiB;
constexpr size_t WS_CAND = 720 * MiB;
constexpr size_t WS_Q8 = WS_UB, WS_K8 = WS_UB + 32 * MiB;
constexpr size_t WS_KI = WS_VB + 32 * MiB;
constexpr size_t WS_V8T = WS_VB;
constexpr size_t WS_XN8 = WS_CAND, WS_BTIN8 = WS_CAND + 72 * MiB, WS_CSI = WS_CAND + 84 * MiB;
constexpr size_t WS_HN8LO = WS_Z;
constexpr size_t WS_HN8 = WS_CAND, WS_BTQ8 = WS_CAND + 64 * MiB, WS_CSQ = WS_CAND + 68 * MiB;
constexpr size_t WS_BTOUT8 = 848 * MiB, WS_CSO = 852 * MiB;
constexpr size_t WS_MIX8 = WS_CAND;
constexpr float MIX8_SCALE = 16.f;
constexpr size_t WS_END = 856 * MiB;
constexpr int CW_BAR = 4096;

#define LDS_WAIT() asm volatile("s_waitcnt lgkmcnt(0)" ::: "memory")
#define VM_WAIT() asm volatile("s_waitcnt vmcnt(0)" ::: "memory")
__device__ __forceinline__ unsigned cvtpk(float lo, float hi) { f32x2 v = {lo, hi}; bf16x2_t b = __builtin_convertvector(v, bf16x2_t); return __builtin_bit_cast(unsigned, b); }
__device__ __forceinline__ float bflo(unsigned w) { return __uint_as_float(w << 16); }
__device__ __forceinline__ float bfhi(unsigned w) { return __uint_as_float(w & 0xffff0000u); }
__device__ __forceinline__ float wave_sum(float v) {
#pragma unroll
    for (int o = 1; o < 64; o <<= 1) v += __shfl_xor(v, o);
    return v;
}
__device__ __forceinline__ unsigned char to_fp8(float v) { return (unsigned char)(__builtin_amdgcn_cvt_pk_fp8_f32(__builtin_amdgcn_fmed3f(v, -448.f, 448.f), 0.f, 0, false) & 0xff); }
__device__ __forceinline__ unsigned f2ord(float s) { unsigned u = __float_as_uint(s); return u ^ (((unsigned)((int)u >> 31)) | 0x80000000u); }

namespace pg8 {
#define PG8_LAS __attribute__((address_space(3)))
constexpr int BM = 256, BK = 64, HALF = 128, HTB = HALF * BK * 2, STAGE_BYTES = 8 * HTB, NXCD = 8, WGM = 8;
__host__ __device__ __forceinline__ int lds_byte(int r, int c) { const int st = (r >> 4) * 2 + (c >> 5), rr = r & 15, cc = c & 31, ob = rr * 64 + cc * 2; return st * 1024 + (ob ^ (((ob >> 9) & 1) << 5)); }
__host__ __device__ __forceinline__ void stage_rc(int b, int& R, int& C) { const int st = b / 1024, sb = b % 1024, swz = sb ^ (((sb >> 9) & 1) << 5); R = (st >> 1) * 16 + swz / 64; C = (st & 1) * 32 + (swz % 64) / 2; }
__host__ __device__ __forceinline__ int perm32(int rho) { const int n = rho >> 4, i = rho & 15; return 8 * (i >> 2) + 4 * n + (i & 3); }
struct Unit { int pm, pn; };
struct Gemm { const bf16_t* A; const bf16_t* Bt; int M, N, K; };
struct StaticOrder {
    int nM, nN, nwg, G, c;
    __host__ __device__ void init(int M, int N, int G_, int c_) { nM = M / BM; nN = N / BM; nwg = nM * nN; G = G_; c = c_; }
    __host__ __device__ bool next(int i, Unit& u) const {
        const long L = (long)i * G + c; if (L >= nwg) return false;
        int wgid = (int)L; { const int q = nwg / NXCD, r = nwg % NXCD, xcd = wgid % NXCD, off = wgid / NXCD; wgid = (xcd < r ? xcd * (q + 1) : r * (q + 1) + (xcd - r) * q) + off; }
        const int nig = WGM * nN, gid = wgid / nig, fm = gid * WGM, gsz = (nM - fm) < WGM ? (nM - fm) : WGM;
        u.pm = fm + ((wgid % nig) % gsz); u.pn = (wgid % nig) / gsz; return true;
    }
    __device__ __forceinline__ void a_ready(const Unit&) const {}
    __device__ __forceinline__ void done(const Unit&) const {}
};
struct InBf16Order {
    StaticOrder S;
    __host__ __device__ void init(int M, int G_, int c_) { S.init(M, 5 * BM, G_, c_); }
    __host__ __device__ bool next(int i, Unit& u) const { if (!S.next(i, u)) return false; u.pn = u.pn < 4 ? 12 + u.pn : 20; return true; }
    __device__ __forceinline__ void a_ready(const Unit&) const {}
    __device__ __forceinline__ void done(const Unit&) const {}
};
struct InFp8Order {
    StaticOrder S; int G, c;
    __host__ __device__ void init(int M, int G_, int c_) { S.init(M, 16 * BM, 1, 0); G = G_; c = c_; }
    __host__ __device__ bool next(int i, Unit& u) const {
        long L;
        if (G == 256 && S.nwg == 2048) {
            if (i < 7) L = (long)i * 256 + c;
            else { const int j = i - 7; int base, cnt;
                if (c < 16) { base = c; cnt = 1; } else if (c < 136) { base = 0; cnt = 0; } else { base = 16 + (c - 136) * 2; cnt = 2; }
                if (j >= cnt) return false; L = 1792 + base + j; }
        } else { L = (long)i * G + c; if (L >= S.nwg) return false; }
        if (!S.next((int)L, u)) return false;
        u.pn = u.pn < 12 ? u.pn : u.pn + 4; return true;
    }
    __device__ __forceinline__ void a_ready(const Unit&) const {}
    __device__ __forceinline__ void done(const Unit&) const {}
};
struct EpiBf16 {
    static constexpr bool PERM = true, AFTER_DRAIN = false;
    bf16_t* O; int ldc;
    __device__ __forceinline__ void operator()(const f32x4 (&acc)[2][2][4][2], const Unit& u, int wr, int wc, int fr, int fq) const {
        const int row0 = u.pm * BM + wr * 64 + fr; const int col0 = u.pn * BM + wc * 32 + 8 * fq;
#pragma unroll
        for (int ai = 0; ai < 2; ++ai)
#pragma unroll
            for (int m = 0; m < 4; ++m) { bf16_t* rowp = O + (size_t)(row0 + ai * HALF + m * 16) * ldc + col0;
#pragma unroll
                for (int bj = 0; bj < 2; ++bj) { const f32x4 v0 = acc[ai][bj][m][0], v1 = acc[ai][bj][m][1];
                    u32x4 w; w.x = cvtpk(v0[0], v0[1]); w.y = cvtpk(v0[2], v0[3]); w.z = cvtpk(v1[0], v1[1]); w.w = cvtpk(v1[2], v1[3]);
                    *(u32x4*)(rowp + bj * HALF) = w; } }
    }
};
struct EpiBf16S {
    static constexpr bool PERM = true, AFTER_DRAIN = false;
    bf16_t* O; int ldc; const float* cs;
    __device__ __forceinline__ void operator()(const f32x4 (&acc)[2][2][4][2], const Unit& u, int wr, int wc, int fr, int fq) const {
        const int row0 = u.pm * BM + wr * 64 + fr; const int col0 = u.pn * BM + wc * 32 + 8 * fq;
        f32x4 s[2][2];
#pragma unroll
        for (int bj = 0; bj < 2; ++bj) { s[bj][0] = *(const f32x4*)(cs + col0 + bj * HALF); s[bj][1] = *(const f32x4*)(cs + col0 + bj * HALF + 4); }
#pragma unroll
        for (int ai = 0; ai < 2; ++ai)
#pragma unroll
            for (int m = 0; m < 4; ++m) { bf16_t* rowp = O + (size_t)(row0 + ai * HALF + m * 16) * ldc + col0;
#pragma unroll
                for (int bj = 0; bj < 2; ++bj) { const f32x4 v0 = acc[ai][bj][m][0] * s[bj][0], v1 = acc[ai][bj][m][1] * s[bj][1];
                    u32x4 w; w.x = cvtpk(v0[0], v0[1]); w.y = cvtpk(v0[2], v0[3]); w.z = cvtpk(v1[0], v1[1]); w.w = cvtpk(v1[2], v1[3]);
                    *(u32x4*)(rowp + bj * HALF) = w; } }
    }
};
struct EpiF32Res {
    static constexpr bool PERM = false, AFTER_DRAIN = false;
    const float* R; float* C; int ldc;
    __device__ __forceinline__ void operator()(const f32x4 (&acc)[2][2][4][2], const Unit& u, int wr, int wc, int fr, int fq) const {
        const int row0 = u.pm * BM + wr * 64 + fr, col0 = u.pn * BM + wc * 32 + 4 * fq;
#pragma unroll
        for (int ai = 0; ai < 2; ++ai)
#pragma unroll
            for (int m = 0; m < 4; ++m) { const size_t off = (size_t)(row0 + ai * HALF + m * 16) * ldc + col0;
#pragma unroll
                for (int bj = 0; bj < 2; ++bj)
#pragma unroll
                    for (int n = 0; n < 2; ++n) *(f32x4*)(C + off + bj * HALF + n * 16) = acc[ai][bj][m][n] + *(const f32x4*)(R + off + bj * HALF + n * 16); }
    }
};

struct EpiF32ResS {
    static constexpr bool PERM = false, AFTER_DRAIN = false;
    const float* R; float* C; int ldc; const float* cs;
    __device__ __forceinline__ void operator()(const f32x4 (&acc)[2][2][4][2], const Unit& u, int wr, int wc, int fr, int fq) const {
        const int row0 = u.pm * BM + wr * 64 + fr, col0 = u.pn * BM + wc * 32 + 4 * fq;
        f32x4 s[2][2];
#pragma unroll
        for (int bj = 0; bj < 2; ++bj)
#pragma unroll
            for (int n = 0; n < 2; ++n) s[bj][n] = *(const f32x4*)(cs + col0 + bj * HALF + n * 16);
#pragma unroll
        for (int ai = 0; ai < 2; ++ai)
#pragma unroll
            for (int m = 0; m < 4; ++m) { const size_t off = (size_t)(row0 + ai * HALF + m * 16) * ldc + col0;
#pragma unroll
                for (int bj = 0; bj < 2; ++bj)
#pragma unroll
                    for (int n = 0; n < 2; ++n) *(f32x4*)(C + off + bj * HALF + n * 16) = acc[ai][bj][m][n] * s[bj][n] + *(const f32x4*)(R + off + bj * HALF + n * 16); }
    }
};
__device__ __forceinline__ i32x8 cat8(bf16x8 a, bf16x8 b) { const i32x4 x = __builtin_bit_cast(i32x4, a), y = __builtin_bit_cast(i32x4, b); return __builtin_shufflevector(x, y, 0, 1, 2, 3, 4, 5, 6, 7); }
template <class Epi, class Sched, bool ALIGN_EPI = false, bool SP2 = false, bool F8 = false>
__device__ __forceinline__ void gemm_phase(PG8_LAS unsigned char* lds, const Gemm g, const Sched& S, const Epi& E) {
    const int tid = threadIdx.x, wid = __builtin_amdgcn_readfirstlane(tid >> 6), lane = tid & 63, wr = wid >> 2, wc = wid & 3, fr = lane & 15, fq = lane >> 4;
    const int K = g.K, nt = K / BK;
    unsigned voffA[2], voffB[2];
#pragma unroll
    for (int i = 0; i < 2; ++i) { int R, C; stage_rc(tid * 16 + i * 8192, R, C); const int Rb = Epi::PERM ? ((R & ~31) + perm32(R & 31)) : R;
        voffA[i] = (unsigned)(R * K + C) * 2u; voffB[i] = (unsigned)(Rb * K + C) * 2u; }
    const size_t kstep = (size_t)(BK * 2);
    const size_t hstep = (size_t)HALF * K * 2;
    const size_t tstep = 2 * hstep;
    const unsigned ldsw = (unsigned)wid * 1024u;
    const int aoff_ = lds_byte(wr * 64 + fr, fq * 8), boff_ = lds_byte(wc * 32 + fr, fq * 8);
#define PG8_SA(b, h) (((b) * 2 + (h)) * HTB)
#define PG8_SB(b, h) ((4 + (b) * 2 + (h)) * HTB)
#define PG8_STAGE(bufoff, gbase, voff) do { _Pragma("unroll") for (int _i = 0; _i < 2; ++_i) \
        __builtin_amdgcn_global_load_lds((const unsigned*)((const char*)(gbase) + (voff)[_i]), (PG8_LAS unsigned*)(lds + (bufoff) + ldsw + _i * 8192), 16, 0, 0); } while (0)
#define PG8_LD1(off) (*(const PG8_LAS bf16x8*)(lds + (off)))
#define PG8_LDA(dst, b, h) do { _Pragma("unroll") for (int m = 0; m < 4; ++m) { if constexpr (F8) dst##8[m] = cat8(PG8_LD1(PG8_SA(b, h) + aoff + m * 2048), PG8_LD1(PG8_SA(b, h) + aoff + m * 2048 + 1024)); \
        else { _Pragma("unroll") for (int k = 0; k < 2; ++k) dst[m][k] = PG8_LD1(PG8_SA(b, h) + aoff + m * 2048 + k * 1024); } } } while (0)
#define PG8_LDB(dst, b, h) do { _Pragma("unroll") for (int n = 0; n < 2; ++n) { if constexpr (F8) dst##8[n] = cat8(PG8_LD1(PG8_SB(b, h) + boff + n * 2048), PG8_LD1(PG8_SB(b, h) + boff + n * 2048 + 1024)); \
        else { _Pragma("unroll") for (int k = 0; k < 2; ++k) dst[n][k] = PG8_LD1(PG8_SB(b, h) + boff + n * 2048 + k * 1024); } } } while (0)
#define PG8_MMA(ai, bj, At, Bt) do { __builtin_amdgcn_s_setprio(1); _Pragma("unroll") for (int m = 0; m < 4; ++m) _Pragma("unroll") for (int n = 0; n < 2; ++n) { \
        if constexpr (F8) asm volatile("v_mfma_f32_16x16x128_f8f6f4 %0, %1, %2, %0" : "+v"(acc[ai][bj][m][n]) : "v"(Bt##8[n]), "v"(At##8[m])); \
        else { _Pragma("unroll") for (int k = 0; k < 2; ++k) acc[ai][bj][m][n] = __builtin_amdgcn_mfma_f32_16x16x32_bf16(Bt[n][k], At[m][k], acc[ai][bj][m][n], 0, 0, 0); } } __builtin_amdgcn_s_setprio(0); } while (0)
#define PG8_WAIT_V(n) asm volatile("s_waitcnt vmcnt(" #n ")" ::: "memory")
#define PG8_WAIT_L(n) asm volatile("s_waitcnt lgkmcnt(" #n ")" ::: "memory")
#define PG8_BAR __builtin_amdgcn_s_barrier()
#define PG8_SCHED __builtin_amdgcn_sched_barrier(0)
    Unit cur, nxt; int ui = 0;
    if (!S.next(0, cur)) return;
    f32x4 acc[2][2][4][2];
#pragma unroll
    for (int a = 0; a < 2; ++a)
#pragma unroll
        for (int b = 0; b < 2; ++b)
#pragma unroll
            for (int m = 0; m < 4; ++m)
#pragma unroll
                for (int n = 0; n < 2; ++n) acc[a][b][m][n] = (f32x4){0.f, 0.f, 0.f, 0.f};
    bf16x8 At[4][2], B0[2][2], B1[2][2]; i32x8 At8[4], B08[2], B18[2];
    const char* cA = (const char*)g.A + (size_t)cur.pm * tstep; const char* cB = (const char*)g.Bt + (size_t)cur.pn * tstep;
    S.a_ready(cur);
    if constexpr (SP2) {
        PG8_STAGE(PG8_SB(0, 0), cB, voffB); PG8_STAGE(PG8_SB(0, 1), cB + hstep, voffB); PG8_STAGE(PG8_SA(0, 0), cA, voffA); PG8_STAGE(PG8_SA(0, 1), cA + hstep, voffA);
        if (wr == 1) PG8_BAR;
        PG8_WAIT_V(2); PG8_BAR;
        PG8_STAGE(PG8_SB(1, 0), cB + kstep, voffB); PG8_STAGE(PG8_SA(1, 0), cA + kstep, voffA); PG8_STAGE(PG8_SB(1, 1), cB + hstep + kstep, voffB);
        PG8_WAIT_V(6); PG8_BAR;
    } else {
        PG8_STAGE(PG8_SB(0, 0), cB, voffB); PG8_STAGE(PG8_SA(0, 0), cA, voffA); PG8_STAGE(PG8_SB(0, 1), cB + hstep, voffB); PG8_STAGE(PG8_SA(0, 1), cA + hstep, voffA);
        if (wr == 1) PG8_BAR;
        PG8_WAIT_V(4); PG8_BAR;
        PG8_STAGE(PG8_SB(1, 0), cB + kstep, voffB); PG8_STAGE(PG8_SA(1, 0), cA + kstep, voffA); PG8_STAGE(PG8_SB(1, 1), cB + hstep + kstep, voffB);
        PG8_WAIT_V(6); PG8_BAR;
    }
    for (;;) {
        const bool has_next = S.next(ui + 1, nxt);
        const char* nA = has_next ? (const char*)g.A + (size_t)nxt.pm * tstep : cA; const char* nB = has_next ? (const char*)g.Bt + (size_t)nxt.pn * tstep : cB;
        for (int t = 0; t < nt; t += 2) {
            const bool last = (t == nt - 2);
            int aoff = aoff_, boff = boff_; if constexpr (F8) asm volatile("" : "+v"(aoff), "+v"(boff));
            const char* a1 = cA + (size_t)(t + 1) * kstep;
            const char* a2 = last ? nA : cA + (size_t)(t + 2) * kstep; const char* b2 = last ? nB : cB + (size_t)(t + 2) * kstep;
            const char* a3 = a2 + kstep; const char* b3 = b2 + kstep;
            if (last && has_next) S.a_ready(nxt);
            if constexpr (SP2) {
            PG8_LDB(B0, 0, 0); PG8_LDB(B1, 0, 1); PG8_SCHED; PG8_LDA(At, 0, 0); PG8_STAGE(PG8_SA(1, 1), a1 + hstep, voffA);
            PG8_WAIT_V(8); PG8_WAIT_L(0); PG8_BAR; PG8_MMA(0, 0, At, B0); PG8_MMA(0, 1, At, B1); PG8_BAR; PG8_SCHED;
            PG8_LDA(At, 0, 1); PG8_STAGE(PG8_SB(0, 0), b2, voffB); PG8_STAGE(PG8_SB(0, 1), b2 + hstep, voffB); PG8_STAGE(PG8_SA(0, 0), a2, voffA);
            PG8_WAIT_V(8); PG8_WAIT_L(0); PG8_BAR; PG8_MMA(1, 0, At, B0); PG8_MMA(1, 1, At, B1); PG8_BAR; PG8_SCHED;
            PG8_LDB(B0, 1, 0); PG8_LDB(B1, 1, 1); PG8_SCHED; PG8_LDA(At, 1, 0); PG8_STAGE(PG8_SA(0, 1), a2 + hstep, voffA);
            PG8_WAIT_V(8); PG8_WAIT_L(0); PG8_BAR; PG8_MMA(0, 0, At, B0); PG8_MMA(0, 1, At, B1); PG8_BAR; PG8_SCHED;
            PG8_LDA(At, 1, 1); PG8_STAGE(PG8_SB(1, 0), b3, voffB); PG8_STAGE(PG8_SB(1, 1), b3 + hstep, voffB); PG8_STAGE(PG8_SA(1, 0), a3, voffA);
            PG8_WAIT_V(8); PG8_WAIT_L(0); PG8_BAR; PG8_MMA(1, 0, At, B0); PG8_MMA(1, 1, At, B1); PG8_BAR; PG8_SCHED;
            } else {
            PG8_LDB(B0, 0, 0); PG8_SCHED; PG8_LDA(At, 0, 0); PG8_STAGE(PG8_SA(1, 1), a1 + hstep, voffA);
            PG8_WAIT_L(8); PG8_BAR; PG8_WAIT_L(0); PG8_MMA(0, 0, At, B0); PG8_BAR; PG8_SCHED;
            PG8_LDB(B1, 0, 1); PG8_STAGE(PG8_SB(0, 0), b2, voffB);
            PG8_BAR; PG8_WAIT_L(0); PG8_MMA(0, 1, At, B1); PG8_BAR;
            PG8_LDA(At, 0, 1); PG8_STAGE(PG8_SA(0, 0), a2, voffA);
            PG8_BAR; PG8_WAIT_L(0); PG8_MMA(1, 0, At, B0); PG8_BAR; PG8_SCHED;
            PG8_STAGE(PG8_SB(0, 1), b2 + hstep, voffB);
            PG8_WAIT_V(6); PG8_BAR; PG8_MMA(1, 1, At, B1); PG8_BAR;
            PG8_LDB(B0, 1, 0); PG8_SCHED; PG8_LDA(At, 1, 0); PG8_STAGE(PG8_SA(0, 1), a2 + hstep, voffA);
            PG8_WAIT_L(8); PG8_BAR; PG8_WAIT_L(0); PG8_MMA(0, 0, At, B0); PG8_BAR; PG8_SCHED;
            PG8_LDB(B1, 1, 1); PG8_STAGE(PG8_SB(1, 0), b3, voffB);
            PG8_BAR; PG8_WAIT_L(0); PG8_MMA(0, 1, At, B1); PG8_BAR;
            PG8_LDA(At, 1, 1); PG8_STAGE(PG8_SA(1, 0), a3, voffA);
            PG8_BAR; PG8_WAIT_L(0); PG8_MMA(1, 0, At, B0); PG8_BAR; PG8_SCHED;
            PG8_STAGE(PG8_SB(1, 1), b3 + hstep, voffB);
            PG8_WAIT_V(6); PG8_BAR; PG8_MMA(1, 1, At, B1); PG8_BAR;
            }
        }
        if constexpr (ALIGN_EPI) { if (wr == 0) PG8_BAR; }
        if constexpr (F8) asm volatile("s_nop 15\n\ts_nop 15" ::: "memory");
        if constexpr (!Epi::AFTER_DRAIN) { E(acc, cur, wr, wc, fr, fq); S.done(cur); }
        if (!has_next) break;
#pragma unroll
        for (int a = 0; a < 2; ++a)
#pragma unroll
            for (int b = 0; b < 2; ++b)
#pragma unroll
                for (int m = 0; m < 4; ++m)
#pragma unroll
                    for (int n = 0; n < 2; ++n) acc[a][b][m][n] = (f32x4){0.f, 0.f, 0.f, 0.f};
        cur = nxt; cA = nA; cB = nB; ++ui;
        if constexpr (ALIGN_EPI) { if (wr == 1) PG8_BAR; }
    }
    PG8_WAIT_V(0);
    if constexpr (!ALIGN_EPI) { if (wr == 0) PG8_BAR; }
    PG8_BAR;
#undef PG8_SA
#undef PG8_SB
#undef PG8_STAGE
#undef PG8_LDA
#undef PG8_LD1
#undef PG8_LDB
#undef PG8_MMA
#undef PG8_WAIT_V
#undef PG8_WAIT_L
#undef PG8_BAR
#undef PG8_SCHED
}
}

namespace att {
constexpr int D = 128, NW = 8, QBLK = 32, KVBLK = 64;
constexpr float SCALE = 0.088388347648318440f;
constexpr size_t SHM_V = KVBLK * D * 2, SHM_K = KVBLK * D * 2, SHM_ATTN = 2 * SHM_V + 2 * SHM_K + NW * 64 * 4;
#define KSWZ(row, colB) ((row) * 256 + ((colB) ^ (((row) & 7) << 4)))
#define KSWZ8(row, colB) ((row) * 128 + ((colB) ^ ((((row) >> 1) & 7) << 4)))
#define SBAR() __builtin_amdgcn_sched_barrier(0)
__device__ __forceinline__ int crow(int r, int hi) { return (r & 3) + 8 * (r >> 2) + 4 * hi; }
template <bool MASKED> __device__ __forceinline__ void mask_apply(f32x16& p, unsigned w) {
    if constexpr (MASKED) {
#pragma unroll
        for (int r = 0; r < 16; ++r) { const unsigned m = (unsigned)__builtin_amdgcn_sbfe((int)w, (unsigned)((r & 3) + 8 * (r >> 2)), 1u); p[r] = __uint_as_float((__float_as_uint(p[r]) & m) | (0xFF800000u & ~m)); }
    }
}
template <bool MASKED, bool P8 = false> __device__ __forceinline__ void partialSM(f32x16& p0, f32x16& p1, float& m_reg, float& mn, float& alpha, unsigned long long mk, int sh4) {
    constexpr float C = SCALE * 1.4426950408889634f; constexpr float THR = P8 ? 5.f : 8.f;
    float pmax = p0[0];
#pragma unroll
    for (int r = 1; r < 16; ++r) pmax = fmaxf(pmax, p0[r]);
#pragma unroll
    for (int r = 0; r < 16; ++r) pmax = fmaxf(pmax, p1[r]);
    { auto rr = __builtin_amdgcn_permlane32_swap(__float_as_uint(pmax), __float_as_uint(pmax), false, false);
      pmax = fmaxf(__uint_as_float(rr[0]), __uint_as_float(rr[1])); }
    if (__builtin_expect(__all(pmax - m_reg <= THR / SCALE), 1)) { mn = m_reg; alpha = 1.f; }
    else { mn = fmaxf(m_reg, pmax); alpha = __builtin_amdgcn_exp2f((m_reg - mn) * C); m_reg = mn; }
    const float mnC = -mn * C;
#pragma unroll
    for (int r = 0; r < 16; ++r) p0[r] = fmaf(p0[r], C, mnC);
#pragma unroll
    for (int r = 0; r < 16; ++r) p1[r] = fmaf(p1[r], C, mnC);
#pragma unroll
    for (int r = 0; r < 16; ++r) p0[r] = __builtin_amdgcn_exp2f(p0[r]);
}
template <bool MASKED> __device__ __forceinline__ void finishSM(f32x16& p0, f32x16& p1, float alpha, float& l_reg, bf16x8& pa0, bf16x8& pa1, bf16x8& pa2, bf16x8& pa3, unsigned long long mk, int sh4) {
#pragma unroll
    for (int r = 0; r < 16; ++r) p1[r] = __builtin_amdgcn_exp2f(p1[r]);
    float ps = 0;
#pragma unroll
    for (int r = 0; r < 16; ++r) ps += p0[r];
#pragma unroll
    for (int r = 0; r < 16; ++r) ps += p1[r];
    { auto rr = __builtin_amdgcn_permlane32_swap(__float_as_uint(ps), __float_as_uint(ps), false, false);
      ps = __uint_as_float(rr[0]) + __uint_as_float(rr[1]); }
    l_reg = l_reg * alpha + ps;
#define PK4(P, BASE, OUT) do { unsigned a0 = cvtpk(P[BASE + 0], P[BASE + 1]), a1 = cvtpk(P[BASE + 2], P[BASE + 3]);   \
    unsigned b0 = cvtpk(P[BASE + 4], P[BASE + 5]), b1 = cvtpk(P[BASE + 6], P[BASE + 7]);                              \
    auto r0 = __builtin_amdgcn_permlane32_swap(a0, b0, false, false); auto r1 = __builtin_amdgcn_permlane32_swap(a1, b1, false, false); \
    u32x4 w = {r0[0], r1[0], r0[1], r1[1]}; OUT = *reinterpret_cast<bf16x8*>(&w); } while (0)
    PK4(p0, 0, pa0); PK4(p0, 8, pa1); PK4(p1, 0, pa2); PK4(p1, 8, pa3);
#undef PK4
}
__device__ __forceinline__ void finishSM8(f32x16& p0, f32x16& p1, i32x8& pa) {
#pragma unroll
    for (int r = 0; r < 16; ++r) p1[r] = __builtin_amdgcn_exp2f(p1[r]);
#pragma unroll
    for (int q = 0; q < 4; ++q) { int w = __builtin_amdgcn_cvt_pk_fp8_f32(p0[4 * q], p0[4 * q + 1], 0, false); pa[q] = __builtin_amdgcn_cvt_pk_fp8_f32(p0[4 * q + 2], p0[4 * q + 3], w, true);
        int v = __builtin_amdgcn_cvt_pk_fp8_f32(p1[4 * q], p1[4 * q + 1], 0, false); pa[4 + q] = __builtin_amdgcn_cvt_pk_fp8_f32(p1[4 * q + 2], p1[4 * q + 3], v, true); }
}
#define VSWZ8(d, c) ((d) * 64 + ((((c) ^ (((d) >> 2) & 3))) << 4))
__device__ __forceinline__ void pv8(f32x16* o, f32x16& lacc, const char* ones, const char* Vt, const i32x8 pa, int r32, int hi) {
    { const i32x8 ob = pg8::cat8(*reinterpret_cast<const bf16x8*>(ones), *reinterpret_cast<const bf16x8*>(ones + 16));
      lacc = __builtin_amdgcn_mfma_scale_f32_32x32x64_f8f6f4(pa, ob, lacc, 0, 0, 0, 0, 0, 0); }
#pragma unroll
    for (int d0 = 0; d0 < 4; ++d0) { const int d = d0 * 32 + r32;
        const i32x8 vb = pg8::cat8(*reinterpret_cast<const bf16x8*>(Vt + VSWZ8(d, 2 * hi)), *reinterpret_cast<const bf16x8*>(Vt + VSWZ8(d, 2 * hi + 1)));
        o[d0] = __builtin_amdgcn_mfma_scale_f32_32x32x64_f8f6f4(pa, vb, o[d0], 0, 0, 0, 0, 0, 0); }
}
template <bool MASKED> __device__ __forceinline__ void qkt(f32x16& p0, f32x16& p1, const bf16_t* Ks, const bf16x8* qs, int r32, int hi, unsigned long long mk, int sh4, const char* lut) {
    if constexpr (MASKED) {
        const unsigned wl = (unsigned)mk >> sh4, wh = (unsigned)(mk >> 32) >> sh4;
#pragma unroll
        for (int g = 0; g < 4; ++g) { const f32x4 b0 = *(const f32x4*)(lut + ((wl >> (8 * g)) & 15u) * 16), b1 = *(const f32x4*)(lut + ((wh >> (8 * g)) & 15u) * 16);
            p0[4 * g] = b0.x; p0[4 * g + 1] = b0.y; p0[4 * g + 2] = b0.z; p0[4 * g + 3] = b0.w; p1[4 * g] = b1.x; p1[4 * g + 1] = b1.y; p1[4 * g + 2] = b1.z; p1[4 * g + 3] = b1.w; }
    } else { p0 = f32x16{}; p1 = f32x16{}; }
#pragma unroll
    for (int d0 = 0; d0 < 8; ++d0) { int cb = (d0 * 16 + hi * 8) * 2;
        bf16x8 b0 = *reinterpret_cast<const bf16x8*>((const char*)Ks + KSWZ(r32, cb));
        bf16x8 b1 = *reinterpret_cast<const bf16x8*>((const char*)Ks + KSWZ(32 + r32, cb));
        const bf16x8 qf = qs[d0 * 64];
        p0 = __builtin_amdgcn_mfma_f32_32x32x16_bf16(b0, qf, p0, 0, 0, 0);
        p1 = __builtin_amdgcn_mfma_f32_32x32x16_bf16(b1, qf, p1, 0, 0, 0); }
}
template <bool MASKED> __device__ __forceinline__ void qkt8(f32x16& p0, f32x16& p1, const char* Ks, const bf16x8* qs, int r32, int hi, unsigned long long mk, int sh4, const char* lut) {
    if constexpr (MASKED) {
        const unsigned wl = (unsigned)mk >> sh4, wh = (unsigned)(mk >> 32) >> sh4;
#pragma unroll
        for (int g = 0; g < 4; ++g) { const f32x4 b0 = *(const f32x4*)(lut + ((wl >> (8 * g)) & 15u) * 16), b1 = *(const f32x4*)(lut + ((wh >> (8 * g)) & 15u) * 16);
            p0[4 * g] = b0.x; p0[4 * g + 1] = b0.y; p0[4 * g + 2] = b0.z; p0[4 * g + 3] = b0.w; p1[4 * g] = b1.x; p1[4 * g + 1] = b1.y; p1[4 * g + 2] = b1.z; p1[4 * g + 3] = b1.w; }
    } else { p0 = f32x16{}; p1 = f32x16{}; }
#pragma unroll
    for (int s2 = 0; s2 < 2; ++s2) { const int cb = (s2 * 4 + hi * 2) * 16;
        const i32x8 a0 = pg8::cat8(*reinterpret_cast<const bf16x8*>(Ks + KSWZ8(r32, cb)), *reinterpret_cast<const bf16x8*>(Ks + KSWZ8(r32, cb + 16)));
        const i32x8 a1 = pg8::cat8(*reinterpret_cast<const bf16x8*>(Ks + KSWZ8(32 + r32, cb)), *reinterpret_cast<const bf16x8*>(Ks + KSWZ8(32 + r32, cb + 16)));
        const i32x8 qf = pg8::cat8(qs[(2 * s2) * 64], qs[(2 * s2 + 1) * 64]);
        p0 = __builtin_amdgcn_mfma_scale_f32_32x32x64_f8f6f4(a0, qf, p0, 0, 0, 0, 0, 0, 0);
        p1 = __builtin_amdgcn_mfma_scale_f32_32x32x64_f8f6f4(a1, qf, p1, 0, 0, 0, 0, 0, 0); }
}
__device__ __forceinline__ int v_st(int k, int c) { const int kk = (k & ~0xC) | ((k & 4) << 1) | ((k & 8) >> 1); return ((kk >> 3) * 4 + (c >> 5)) * 512 + ((kk & 7) * 32 + (c & 31)) * 2; }
__device__ __forceinline__ int v_rd_base(int lane) { return ((lane & 3) << 3) | (((lane >> 2) & 3) << 6) | (((lane >> 4) & 1) << 5) | (((lane >> 5) & 1) << 8); }
constexpr int v_rd_off(int d0, int ks, int half) { return d0 * 512 + ks * 4096 + half * 2048; }
template <int OFF> __device__ __forceinline__ s16x4 tr_read(int vb) {
    s16x4 r; asm volatile("ds_read_b64_tr_b16 %0, %1 offset:%2" : "=&v"(r) : "v"(vb), "i"(OFF) : "memory"); return r;
}
template <int D0> __device__ __forceinline__ void pv_one(f32x16& od, int vb, bf16x8 pa0, bf16x8 pa1, bf16x8 pa2, bf16x8 pa3) {
    const s16x4 l0 = tr_read<v_rd_off(D0, 0, 0)>(vb), h0 = tr_read<v_rd_off(D0, 0, 1)>(vb), l1 = tr_read<v_rd_off(D0, 1, 0)>(vb), h1 = tr_read<v_rd_off(D0, 1, 1)>(vb);
    const s16x4 l2 = tr_read<v_rd_off(D0, 2, 0)>(vb), h2 = tr_read<v_rd_off(D0, 2, 1)>(vb), l3 = tr_read<v_rd_off(D0, 3, 0)>(vb), h3 = tr_read<v_rd_off(D0, 3, 1)>(vb);
    asm volatile("s_waitcnt lgkmcnt(0)" ::: "memory"); SBAR();
#define PK(L, H) (bf16x8){L[0], L[1], L[2], L[3], H[0], H[1], H[2], H[3]}
    od = __builtin_amdgcn_mfma_f32_32x32x16_bf16(pa0, PK(l0, h0), od, 0, 0, 0);
    od = __builtin_amdgcn_mfma_f32_32x32x16_bf16(pa1, PK(l1, h1), od, 0, 0, 0);
    od = __builtin_amdgcn_mfma_f32_32x32x16_bf16(pa2, PK(l2, h2), od, 0, 0, 0);
    od = __builtin_amdgcn_mfma_f32_32x32x16_bf16(pa3, PK(l3, h3), od, 0, 0, 0);
#undef PK
}
__device__ __forceinline__ void pv_d0(f32x16* o, int vb, bf16x8 pa0, bf16x8 pa1, bf16x8 pa2, bf16x8 pa3) {
    pv_one<0>(o[0], vb, pa0, pa1, pa2, pa3); pv_one<1>(o[1], vb, pa0, pa1, pa2, pa3); pv_one<2>(o[2], vb, pa0, pa1, pa2, pa3); pv_one<3>(o[3], vb, pa0, pa1, pa2, pa3);
}
template <bool MASKED, int SDEPTH, int ldq, int ldk, int ldo, bool QK8 = false, bool PV8 = false>
__device__ __forceinline__ void attn_body(const bf16_t* __restrict__ Qb, const bf16_t* __restrict__ Kh, const bf16_t* __restrict__ Vh,
                                          bf16_t* __restrict__ Ob, int seq, const unsigned long long* __restrict__ mrow, char* lds,
                                          const unsigned char* __restrict__ Q8b = nullptr, const unsigned char* __restrict__ K8h = nullptr, const unsigned char* __restrict__ V8h = nullptr, unsigned char* __restrict__ O8b = nullptr) {
    int tid = (int)threadIdx.x; asm volatile("" : "+v"(tid));
    const int wid = tid >> 6, lane = tid & 63, r32 = lane & 31, hi = lane >> 5, sh4 = 4 * hi;
    bf16_t* V_lds = (bf16_t*)lds; bf16_t* K_lds = (bf16_t*)(lds + 2 * SHM_V);
    float* ws = (float*)(lds + 2 * SHM_V + 2 * SHM_K) + wid * 64; float* li_l = ws; float* al_l = ws + 32;
    float m_reg = -1e30f, l_reg = 0; f32x16 o[4] = {}; f32x16 lacc = {};
    const bf16_t* Qw = Qb + (long)(wid * QBLK + r32) * ldq + hi * 8;
    bf16x8* qr = (bf16x8*)(lds + SHM_ATTN) + wid * 512 + lane;
    if constexpr (QK8) { const unsigned char* Q8w = Q8b + (long)(wid * QBLK + r32) * 1024 + hi * 32;
#pragma unroll
        for (int j = 0; j < 4; ++j) qr[j * 64] = *reinterpret_cast<const bf16x8*>(Q8w + (j >> 1) * 64 + (j & 1) * 16);
    } else {
#pragma unroll
        for (int d0 = 0; d0 < 8; ++d0) qr[d0 * 64] = *reinterpret_cast<const bf16x8*>(Qw + d0 * 16); }
    const char* lut = lds + SHM_ATTN + 65536;
    if (MASKED && tid < 64) ((float*)(lds + SHM_ATTN + 65536))[tid] = ((tid >> 2) >> (tid & 3)) & 1 ? 0.f : -INFINITY;
    const char* ones = lds + SHM_ATTN + 65536 + 256;
    if (PV8 && tid < 8) ((unsigned*)(lds + SHM_ATTN + 65536 + 256))[tid] = 0x38383838u;
    const int sr = tid >> 4, sc = (tid & 15) * 8, vst0 = v_st(sr, sc), vst1 = v_st(32 + sr, sc);
    const int vb0 = (int)(uintptr_t)V_lds + v_rd_base(lane);
    struct { bf16x8 vs0, vs1, ks0, ks1; } sr_[SDEPTH];
    const int kr8 = tid >> 3, kc8 = (tid & 7) * 16;
#define SLOAD(i, k0) do { if constexpr (PV8) sr_[i].vs0 = *reinterpret_cast<const bf16x8*>(V8h + (long)(k0) * 128 + tid * 16); \
    else { sr_[i].vs0 = *reinterpret_cast<const bf16x8*>(&Vh[(long)((k0) + sr) * ldk + sc]); sr_[i].vs1 = *reinterpret_cast<const bf16x8*>(&Vh[(long)((k0) + 32 + sr) * ldk + sc]); } \
    if constexpr (QK8) sr_[i].ks0 = *reinterpret_cast<const bf16x8*>(K8h + (long)((k0) + kr8) * 1024 + kc8); \
    else { sr_[i].ks0 = *reinterpret_cast<const bf16x8*>(&Kh[(long)((k0) + sr) * ldk + sc]); sr_[i].ks1 = *reinterpret_cast<const bf16x8*>(&Kh[(long)((k0) + 32 + sr) * ldk + sc]); } } while (0)
#define SWRITE(b, i) do { if constexpr (PV8) *(bf16x8*)((char*)V_lds + (b) * SHM_V + VSWZ8(tid >> 2, tid & 3)) = sr_[i].vs0; \
    else { *(bf16x8*)((char*)V_lds + (b) * SHM_V + vst0) = sr_[i].vs0;          \
    *(bf16x8*)((char*)V_lds + (b) * SHM_V + vst1) = sr_[i].vs1; } int kc = sc * 2;               \
    if constexpr (QK8) *(bf16x8*)((char*)K_lds + (b) * SHM_K + KSWZ8(kr8, kc8)) = sr_[i].ks0;  \
    else { *(bf16x8*)((char*)K_lds + (b) * SHM_K + KSWZ(sr, kc)) = sr_[i].ks0;                  \
    *(bf16x8*)((char*)K_lds + (b) * SHM_K + KSWZ(32 + sr, kc)) = sr_[i].ks1; } } while (0)
#define SWAIT() do { if constexpr (SDEPTH == 2) { if constexpr (QK8 && PV8) asm volatile("s_waitcnt vmcnt(2)" ::: "memory"); else if constexpr (QK8) asm volatile("s_waitcnt vmcnt(3)" ::: "memory"); else asm volatile("s_waitcnt vmcnt(4)" ::: "memory"); } else asm volatile("s_waitcnt vmcnt(0)" ::: "memory"); } while (0)
#define FIN(P0, P1, AL, MK) do { if constexpr (PV8) finishSM8(P0, P1, pa8); else finishSM<MASKED>(P0, P1, AL, l_reg, pa0, pa1, pa2, pa3, MK, sh4); } while (0)
#define PVD(VOFF) do { if constexpr (PV8) pv8(o, lacc, ones, (const char*)V_lds + (VOFF), pa8, r32, hi); else pv_d0(o, vb0 + (int)(VOFF), pa0, pa1, pa2, pa3); } while (0)
#define QKT(P0, P1, KB, MK) do { if constexpr (QK8) qkt8<MASKED>(P0, P1, (const char*)(KB), qr, r32, hi, MK, sh4, lut); else qkt<MASKED>(P0, P1, (const bf16_t*)(KB), qr, r32, hi, MK, sh4, lut); } while (0)
#define RESC(a) do { if (__any((a) < 1.f)) { if (hi == 0) al_l[r32] = (a); asm volatile("s_waitcnt lgkmcnt(0)" ::: "memory"); \
    _Pragma("unroll") for (int d = 0; d < 4; ++d) _Pragma("unroll") for (int r = 0; r < 16; ++r) o[d][r] *= al_l[crow(r, hi)]; \
    if constexpr (PV8) { _Pragma("unroll") for (int r = 0; r < 16; ++r) lacc[r] *= al_l[crow(r, hi)]; } } } while (0)
    f32x16 pA0, pA1, pB0, pB1; float mnA, mnB, alA, alB; bf16x8 pa0, pa1, pa2, pa3; i32x8 pa8; const int NT = seq / KVBLK;
    unsigned long long mkA = 0, mkB = 0;
    constexpr int SE = 0, SO = SDEPTH - 1;
    if constexpr (MASKED) mkA = mrow[0];
    SLOAD(SE, 0); asm volatile("s_waitcnt vmcnt(0)" ::: "memory"); SWRITE(0, SE); __syncthreads();
    QKT(pA0, pA1, K_lds, mkA); partialSM<MASKED, PV8>(pA0, pA1, m_reg, mnA, alA, mkA, sh4);
    if constexpr (MASKED) mkB = mrow[1];
    SLOAD(SO, KVBLK); if constexpr (SDEPTH == 2) { if (2 < NT) SLOAD(SE, 2 * KVBLK); }
    SWAIT(); SWRITE(1, SO); __syncthreads();
    for (int j = 1; j + 1 < NT; j += 2) {
        SBAR(); QKT(pB0, pB1, (char*)K_lds + SHM_K, mkB);
        FIN(pA0, pA1, alA, mkA); SBAR();
        if constexpr (MASKED) mkA = mrow[j + 1];
        SLOAD(SO, (j + SDEPTH) * KVBLK); SBAR();
        PVD(0); partialSM<MASKED, PV8>(pB0, pB1, m_reg, mnB, alB, mkB, sh4);
        __syncthreads(); SWAIT(); SWRITE(0, SE);
        RESC(alB); __syncthreads();
        SBAR(); QKT(pA0, pA1, K_lds, mkA);
        FIN(pB0, pB1, alB, mkB); SBAR();
        if constexpr (MASKED) { if (j + 2 < NT) mkB = mrow[j + 2]; }
        if (SDEPTH == 1 || j + 3 < NT) SLOAD(SE, (j + 1 + SDEPTH) * KVBLK); SBAR();
        PVD(SHM_V); partialSM<MASKED, PV8>(pA0, pA1, m_reg, mnA, alA, mkA, sh4);
        __syncthreads(); SWAIT(); SWRITE(1, SO);
        RESC(alA); __syncthreads();
    }
    SBAR(); QKT(pB0, pB1, (char*)K_lds + SHM_K, mkB);
    FIN(pA0, pA1, alA, mkA); SBAR();
    PVD(0); partialSM<MASKED, PV8>(pB0, pB1, m_reg, mnB, alB, mkB, sh4);
    __syncthreads(); RESC(alB);
    FIN(pB0, pB1, alB, mkB); SBAR();
    PVD(SHM_V);
    float rli[16];
    if constexpr (PV8) {
#pragma unroll
        for (int r = 0; r < 16; ++r) rli[r] = __builtin_amdgcn_rcpf(lacc[r]);
    } else {
        if (hi == 0) li_l[r32] = l_reg; asm volatile("s_waitcnt lgkmcnt(0)" ::: "memory");
#pragma unroll
        for (int r = 0; r < 16; ++r) rli[r] = __builtin_amdgcn_rcpf(li_l[crow(r, hi)]); }
    if (O8b) {
        unsigned char* O8w = O8b + (long)(wid * QBLK) * ldo;
#pragma unroll
        for (int r = 0; r < 16; ++r) { const int orow = crow(r, hi); const float sc8 = rli[r] * MIX8_SCALE;
#pragma unroll
            for (int d0 = 0; d0 < 4; ++d0) O8w[(long)orow * ldo + d0 * 32 + r32] = to_fp8(o[d0][r] * sc8); }
    } else {
    bf16_t* Ow = Ob + (long)(wid * QBLK) * ldo;
#pragma unroll
    for (int r = 0; r < 16; ++r) { const int orow = crow(r, hi);
#pragma unroll
        for (int d0 = 0; d0 < 4; ++d0) Ow[(long)orow * ldo + d0 * 32 + r32] = (bf16_t)(cvtpk(o[d0][r] * rli[r], 0.f) & 0xffffu); }
    }
    __syncthreads();
#undef SLOAD
#undef SWRITE
#undef SWAIT
#undef QKT
#undef FIN
#undef PVD
#undef RESC
}
#undef KSWZ
#undef KSWZ8
#undef VSWZ8
#undef SBAR
}

#define XB_TMO      128
#define XB_XCNT(j)  (256  + 64 * (j))
#define XB_XSUB(j)  (1280 + 64 * (j))
#define XB_XGEN(j)  (2304 + 64 * (j))
#define XB_TOP      3328
#define XB_TOPGEN   3392
#define XCD_BAR_WORDS 3456
#define XB_SPIN_CAP (1u << 22)
__device__ __forceinline__ unsigned xb_ld(unsigned* p)              { return __hip_atomic_load(p, __ATOMIC_RELAXED, __HIP_MEMORY_SCOPE_AGENT); }
__device__ __forceinline__ unsigned xb_add(unsigned* p, unsigned v) { return __hip_atomic_fetch_add(p, v, __ATOMIC_RELAXED, __HIP_MEMORY_SCOPE_AGENT); }
__device__ __forceinline__ unsigned xb_xcc_id() { return (unsigned)__builtin_amdgcn_s_getreg((3 << 11) | 20) & 0xFu; }
#define XB_SPIN(cond, bar) do { unsigned _sp = 0; while (cond) { __builtin_amdgcn_s_sleep(1); \
    if ((++_sp & 255u) == 0u) { if (xb_ld(&(bar)[XB_TMO])) break; if (_sp > XB_SPIN_CAP) { atomicAdd(&(bar)[XB_TMO], 1u); break; } } } } while (0)
struct XcdBarrier { unsigned* bar; unsigned x; volatile LAS unsigned* st; };
__device__ __forceinline__ XcdBarrier xcd_barrier_post(unsigned* bar, volatile LAS unsigned* st) {
    XcdBarrier b; b.bar = bar; b.x = xb_xcc_id(); b.st = st;
    if (threadIdx.x == 0) (void)xb_add(&bar[XB_XCNT(b.x)], 1u);
    return b;
}
__device__ __forceinline__ void xcd_barrier_complete(unsigned* bar, unsigned x, unsigned& nloc, unsigned& nx) {
    const unsigned G = gridDim.x * gridDim.y * gridDim.z;
    unsigned sum, cnt, mine, sp = 0u;
    for (;;) {
        sum = 0u; cnt = 0u; mine = 0u;
#pragma unroll
        for (unsigned j = 0; j < 16; ++j) { const unsigned c = xb_ld(&bar[XB_XCNT(j)]); sum += c; cnt += (c > 0u) ? 1u : 0u; mine = (j == x) ? c : mine; }
        if (sum == G) break;
        __builtin_amdgcn_s_sleep(1);
        if ((++sp & 255u) == 0u) { if (xb_ld(&bar[XB_TMO])) break; if (sp > XB_SPIN_CAP) { atomicAdd(&bar[XB_TMO], 1u); break; } }
    }
    nloc = mine > 0u ? mine : 1u; nx = cnt > 0u ? cnt : 1u;
}
__device__ __forceinline__ void xcd_barrier(const XcdBarrier& b) {
    asm volatile("s_waitcnt vmcnt(0)" ::: "memory");
    __syncthreads();
    if (threadIdx.x == 0) {
        unsigned* bar = b.bar;
        __builtin_amdgcn_s_waitcnt(0);
        unsigned nloc = b.st[0], nx = b.st[1];
        if (nloc == 0u) { xcd_barrier_complete(bar, b.x, nloc, nx); b.st[0] = nloc; b.st[1] = nx; }
        const unsigned old = xb_add(&bar[XB_XSUB(b.x)], 1u);
        const unsigned gen = old / nloc;
        if (old + 1u == (gen + 1u) * nloc) {
            __builtin_amdgcn_fence(__ATOMIC_RELEASE, "agent");
            asm volatile("s_waitcnt vmcnt(0)" ::: "memory");
            const unsigned og = xb_add(&bar[XB_TOP], 1u);
            const unsigned tg = og / nx;
            if (og + 1u == (tg + 1u) * nx) xb_add(&bar[XB_TOPGEN], 1u);
            else XB_SPIN(xb_ld(&bar[XB_TOPGEN]) == tg, bar);
            __builtin_amdgcn_fence(__ATOMIC_ACQUIRE, "agent");
            xb_add(&bar[XB_XGEN(b.x)], 1u);
            asm volatile("s_waitcnt vmcnt(0)" ::: "memory");
        } else {
            XB_SPIN(xb_ld(&bar[XB_XGEN(b.x)]) == gen, bar);
            __builtin_amdgcn_fence(__ATOMIC_ACQUIRE, "agent");
            asm volatile("s_waitcnt vmcnt(0)" ::: "memory");
        }
    }
    __syncthreads();
}

constexpr int NWAVES = 8;
constexpr int RING_BYTES = 151 * 1024;
constexpr int LDSCTL_OFF = RING_BYTES, MISC_OFF = LDSCTL_OFF + 320;
constexpr int LDS_BYTES = 152 * 1024;
static_assert(MISC_OFF + 128 <= LDS_BYTES, "LDS map");
constexpr int N_PHASES = 13;

struct Args {
    const float* x; const float* mem; const float* attn_g; const float* w_in; const float* q_g; const float* k_g; const float* pool_w; const float* pool_s;
    const float* mem_g; const float* w_kv; const float* mq_g; const float* mk_g; const float* w_out; const float* ffn_g; const float* w_q; const float* sk1; const float* sk2;
    const float* pu; const float* pv; float* out; unsigned char* ws; int ph_lo, ph_hi;
};
struct Frame {
    LAS unsigned char* lds; char* ldsg;
    int tid, lane, wave, vcu, G;
};

__device__ __forceinline__ int in_colmap(int n) {
    if (n < 4096) return n;
    if (n < 4608) return 4176 + (n - 4096);
    if (n < 5120) return 4688 + (n - 4608);
    if (n < 5184) return 4096 + (n - 5120);
    if (n < 5200) return 4160 + (n - 5184);
    return -1;
}
template <int MAP> __device__ __forceinline__ void p0_transpose_item(const float* W, int K, int N, bf16_t* WT, LAS float* scr, int kb, int nb, int lane) {
    const int k0 = 64 * kb, n0 = 32 * nb;
    const int c4 = lane & 7, rg = lane >> 3;
    int nsrc = n0 + 4 * c4; if (MAP == 1) nsrc = in_colmap(nsrc);
#pragma unroll
    for (int i = 0; i < 8; ++i) { const int kk = 8 * i + rg; const f32x4 v = nsrc >= 0 ? *(const f32x4*)(W + (size_t)(k0 + kk) * N + nsrc) : (f32x4){0.f, 0.f, 0.f, 0.f};
        LAS float* d = scr + kk * 33 + 4 * c4; d[0] = v.x; d[1] = v.y; d[2] = v.z; d[3] = v.w; }
    LDS_WAIT();
    const int c = lane & 7;
#pragma unroll
    for (int j = 0; j < 4; ++j) { const int n = (lane >> 3) + 8 * j; const LAS float* s = scr + (8 * c) * 33 + n;
        u32x4 o; o.x = cvtpk(s[0 * 33], s[1 * 33]); o.y = cvtpk(s[2 * 33], s[3 * 33]); o.z = cvtpk(s[4 * 33], s[5 * 33]); o.w = cvtpk(s[6 * 33], s[7 * 33]);
        *(u32x4*)(WT + (size_t)(n0 + n) * K + k0 + 8 * c) = o; }
    LDS_WAIT();
}
__device__ __forceinline__ void rms_row_to_bf16(const float* xrow, const float* gain, bf16_t* orow, int lane) {
    const f32x4* xr = (const f32x4*)xrow + lane;
    f32x4 v[8]; float s = 0.f;
#pragma unroll
    for (int j = 0; j < 8; ++j) { v[j] = xr[64 * j]; s += (v[j].x * v[j].x + v[j].y * v[j].y) + (v[j].z * v[j].z + v[j].w * v[j].w); }
    const float rstd = 1.f / sqrtf(wave_sum(s) * (1.f / DM) + EPS);
    unsigned long long* o8 = (unsigned long long*)orow + lane;
#pragma unroll
    for (int j = 0; j < 8; ++j) { const f32x4 g = ((const f32x4*)gain)[lane + 64 * j]; const f32x4 y = v[j] * rstd * g;
        o8[64 * j] = (unsigned long long)cvtpk(y.x, y.y) | ((unsigned long long)cvtpk(y.z, y.w) << 32); }
}
struct RowF32 { f32x4 v[8]; };
__device__ __forceinline__ void row_load(RowF32& R, const float* xrow, int lane) {
    const f32x4* xr = (const f32x4*)xrow + lane;
#pragma unroll
    for (int j = 0; j < 8; ++j) R.v[j] = xr[64 * j];
}
__device__ __forceinline__ void rms_fin_bf16_fp8(const f32x4 (&v)[8], const float* gain, bf16_t* orow, unsigned char* o8row, int lane) {
    float s = 0.f;
#pragma unroll
    for (int j = 0; j < 8; ++j) s += (v[j].x * v[j].x + v[j].y * v[j].y) + (v[j].z * v[j].z + v[j].w * v[j].w);
    const float rstd = 1.f / sqrtf(wave_sum(s) * (1.f / DM) + EPS);
    unsigned long long* o8 = (unsigned long long*)orow + lane; unsigned* q4 = (unsigned*)o8row + lane;
#pragma unroll
    for (int j = 0; j < 8; ++j) { const f32x4 g = ((const f32x4*)gain)[lane + 64 * j]; const f32x4 y = v[j] * rstd * g;
        o8[64 * j] = (unsigned long long)cvtpk(y.x, y.y) | ((unsigned long long)cvtpk(y.z, y.w) << 32);
        int w = __builtin_amdgcn_cvt_pk_fp8_f32(__builtin_amdgcn_fmed3f(y.x, -448.f, 448.f), __builtin_amdgcn_fmed3f(y.y, -448.f, 448.f), 0, false);
        w = __builtin_amdgcn_cvt_pk_fp8_f32(__builtin_amdgcn_fmed3f(y.z, -448.f, 448.f), __builtin_amdgcn_fmed3f(y.w, -448.f, 448.f), w, true); q4[64 * j] = (unsigned)w; }
}
__device__ __forceinline__ void rms_fin_fp8_hilo(const f32x4 (&v)[8], const float* gain, unsigned char* hirow, unsigned char* lorow, int lane) {
    float s = 0.f;
#pragma unroll
    for (int j = 0; j < 8; ++j) s += (v[j].x * v[j].x + v[j].y * v[j].y) + (v[j].z * v[j].z + v[j].w * v[j].w);
    const float rstd = 1.f / sqrtf(wave_sum(s) * (1.f / DM) + EPS);
    unsigned* h4 = (unsigned*)hirow + lane; unsigned* l4 = (unsigned*)lorow + lane;
#pragma unroll
    for (int j = 0; j < 8; ++j) { const f32x4 g = ((const f32x4*)gain)[lane + 64 * j]; f32x4 y = v[j] * rstd * g;
        y.x = __builtin_amdgcn_fmed3f(y.x, -448.f, 448.f); y.y = __builtin_amdgcn_fmed3f(y.y, -448.f, 448.f); y.z = __builtin_amdgcn_fmed3f(y.z, -448.f, 448.f); y.w = __builtin_amdgcn_fmed3f(y.w, -448.f, 448.f);
        int w = __builtin_amdgcn_cvt_pk_fp8_f32(y.x, y.y, 0, false); w = __builtin_amdgcn_cvt_pk_fp8_f32(y.z, y.w, w, true);
        const f32x2 b01 = __builtin_amdgcn_cvt_pk_f32_fp8(w, false), b23 = __builtin_amdgcn_cvt_pk_f32_fp8(w, true);
        int u = __builtin_amdgcn_cvt_pk_fp8_f32(y.x - b01.x, y.y - b01.y, 0, false); u = __builtin_amdgcn_cvt_pk_fp8_f32(y.z - b23.x, y.w - b23.y, u, true);
        h4[64 * j] = (unsigned)w; l4[64 * j] = (unsigned)u; }
}
__device__ __forceinline__ void row_load_bf16(RowF32& R, const bf16_t* brow, int lane) {
    const u32x2* br = (const u32x2*)brow + lane;
#pragma unroll
    for (int j = 0; j < 8; ++j) { const u32x2 w = br[64 * j]; R.v[j] = (f32x4){bflo(w.x), bfhi(w.x), bflo(w.y), bfhi(w.y)}; }
}
__device__ __forceinline__ void row_to_fp8(const RowF32& R, unsigned char* orow, float* inv, int lane) {
    unsigned* o4 = (unsigned*)orow + lane; float am = 0.f;
#pragma unroll
    for (int j = 0; j < 8; ++j) am = fmaxf(am, fmaxf(fmaxf(fabsf(R.v[j].x), fabsf(R.v[j].y)), fmaxf(fabsf(R.v[j].z), fabsf(R.v[j].w))));
#pragma unroll
    for (int o = 1; o < 64; o <<= 1) am = fmaxf(am, __shfl_xor(am, o));
    const float sc = (am > 0.f && am < 3.0e38f) ? exp2f(floorf(log2f(224.f / am))) : 1.f;
#pragma unroll
    for (int j = 0; j < 8; ++j) { int w = __builtin_amdgcn_cvt_pk_fp8_f32(R.v[j].x * sc, R.v[j].y * sc, 0, false); w = __builtin_amdgcn_cvt_pk_fp8_f32(R.v[j].z * sc, R.v[j].w * sc, w, true); o4[64 * j] = (unsigned)w; }
    if (lane == 0) *inv = 1.f / sc;
}
__device__ __forceinline__ void row_to_fp8_sliced(const RowF32& R, unsigned char* tab, int m, float* inv, int lane) {
    float am = 0.f;
#pragma unroll
    for (int j = 0; j < 8; ++j) am = fmaxf(am, fmaxf(fmaxf(fabsf(R.v[j].x), fabsf(R.v[j].y)), fmaxf(fabsf(R.v[j].z), fabsf(R.v[j].w))));
#pragma unroll
    for (int o = 1; o < 64; o <<= 1) am = fmaxf(am, __shfl_xor(am, o));
    const float sc = (am > 0.f && am < 3.0e38f) ? exp2f(floorf(log2f(224.f / am))) : 1.f;
    unsigned char* o = tab + (size_t)(lane >> 5) * ((size_t)NEXP * 128) + (size_t)m * 128 + 4 * (lane & 31);
#pragma unroll
    for (int j = 0; j < 8; ++j) { int w = __builtin_amdgcn_cvt_pk_fp8_f32(R.v[j].x * sc, R.v[j].y * sc, 0, false); w = __builtin_amdgcn_cvt_pk_fp8_f32(R.v[j].z * sc, R.v[j].w * sc, w, true); *(unsigned*)(o + (size_t)(2 * j) * ((size_t)NEXP * 128)) = (unsigned)w; }
    if (lane == 0) *inv = 1.f / sc;
}
__device__ __forceinline__ void p0_prologue(const Frame& F, const Args& a) {
    unsigned char* ws = a.ws;
    LAS float* scr = (LAS float*)(F.lds + F.wave * 16384);
    const int gw = F.vcu * NWAVES + F.wave, NGW = F.G * NWAVES, lane = F.lane;
    bf16_t* BtIn = (bf16_t*)(ws + WS_BT_IN); bf16_t* BtOut = (bf16_t*)(ws + WS_BT_OUT); bf16_t* BtQ = (bf16_t*)(ws + WS_BT_Q); bf16_t* BtKV = (bf16_t*)(ws + WS_BT_KV);
    constexpr int I_IN = 32 * 168, I_OUT = 32 * 64, I_Q = 32 * 64, I_KV = 32 * 32;
    constexpr int NIT = I_IN + I_OUT + I_Q + I_KV;
    for (int it = gw; it < NIT; it += NGW) {
        int r = it;
        if (r < I_IN) { p0_transpose_item<1>(a.w_in, DM, IN_W, BtIn, scr, r / 168, r % 168, lane); continue; } r -= I_IN;
        if (r < I_OUT) { const int kb = r / 64; p0_transpose_item<0>(a.w_out, DM, DM, BtOut, scr, kb, r % 64, lane); continue; } r -= I_OUT;
        if (r < I_Q) { p0_transpose_item<0>(a.w_q, DM, DM, BtQ, scr, r / 64, r % 64, lane); continue; } r -= I_Q;
        p0_transpose_item<0>(a.w_kv, DM, 1024, BtKV, scr, r / 32, r % 32, lane);
    }
    { bf16_t* PWt = (bf16_t*)(ws + WS_PWT);
      for (int it = gw; it < 4 * 128; it += NGW) { const int g = it >> 7, e = it & 127; const float* pw = a.pool_w + (size_t)g * 16384 + e;
          const float v0 = pw[(size_t)(2 * lane) * 128], v1 = pw[(size_t)(2 * lane + 1) * 128]; ((unsigned*)(PWt + (size_t)it * 128))[lane] = cvtpk(v0, v1); } }
    bf16_t* XN = (bf16_t*)(ws + WS_XN); bf16_t* MN = (bf16_t*)(ws + WS_MN);
#if P1_FP8
    {
        RowF32 Ra, Rb; int m = gw;
        if (m < NTOK) row_load(Ra, a.x + (size_t)m * DM, lane);
        for (; m < NTOK; m += 2 * NGW) { const int m2 = m + NGW, m3 = m + 2 * NGW;
            if (m2 < NTOK) row_load(Rb, a.x + (size_t)m2 * DM, lane);
            rms_fin_bf16_fp8(Ra.v, a.attn_g, XN + (size_t)m * DM, ws + WS_XN8 + (size_t)m * DM, lane);
            if (m3 < NTOK) row_load(Ra, a.x + (size_t)m3 * DM, lane);
            if (m2 < NTOK) rms_fin_bf16_fp8(Rb.v, a.attn_g, XN + (size_t)m2 * DM, ws + WS_XN8 + (size_t)m2 * DM, lane); } }
#else
    for (int m = gw; m < NTOK; m += NGW) rms_row_to_bf16(a.x + (size_t)m * DM, a.attn_g, XN + (size_t)m * DM, lane);
#endif
    for (int m = gw; m < BATCH * MEMLEN; m += NGW) rms_row_to_bf16(a.mem + (size_t)m * DM, a.mem_g, MN + (size_t)m * DM, lane);
    unsigned char* UB = ws + WS_UB; unsigned char* VB = ws + WS_VB; float* RSU = (float*)(ws + WS_RSU); float* RSV = (float*)(ws + WS_RSV);
    (void)UB; (void)VB; (void)RSU; (void)RSV;
    bf16_t* PK = (bf16_t*)(ws + WS_PK);
    for (int m = gw; m < 256; m += NGW) { const float* src = (m < 128 ? a.sk1 + (size_t)m * 128 : a.sk2 + (size_t)(m - 128) * 128);
        const f32x2 v = ((const f32x2*)src)[lane]; ((unsigned*)(PK + (size_t)m * 128))[lane] = cvtpk(v.x, v.y); }
    float* RT = (float*)(ws + WS_ROPE);
    for (int p = gw; p < SEQ; p += NGW) {
        { const float invf = powf(10000.f, -(float)lane / 64.f); const float ang = (float)p * invf;
          RT[(size_t)p * 192 + lane] = cosf(ang); RT[(size_t)p * 192 + 64 + lane] = sinf(ang); }
        if (lane < 32) { const float invf = powf(10000.f, -(float)lane / 32.f); const float ang = (float)p * invf;
          RT[(size_t)p * 192 + 128 + lane] = cosf(ang); RT[(size_t)p * 192 + 160 + lane] = sinf(ang); }
    }
}

__device__ __forceinline__ void unpack8(const u32x4 w, float* x) { x[0] = bflo(w.x); x[1] = bfhi(w.x); x[2] = bflo(w.y); x[3] = bfhi(w.y); x[4] = bflo(w.z); x[5] = bfhi(w.z); x[6] = bflo(w.w); x[7] = bfhi(w.w); }
__device__ __forceinline__ u32x4 pack8(const float* x) { u32x4 w; w.x = cvtpk(x[0], x[1]); w.y = cvtpk(x[2], x[3]); w.z = cvtpk(x[4], x[5]); w.w = cvtpk(x[6], x[7]); return w; }
struct F8 { float v[8]; };
__device__ __forceinline__ F8 ld8f(const float* p) { const f32x4 a = *(const f32x4*)p, b = *(const f32x4*)(p + 4); F8 r; r.v[0] = a.x; r.v[1] = a.y; r.v[2] = a.z; r.v[3] = a.w; r.v[4] = b.x; r.v[5] = b.y; r.v[6] = b.z; r.v[7] = b.w; return r; }
__device__ __forceinline__ u32x2 pack8_fp8(const float* x) { int a = __builtin_amdgcn_cvt_pk_fp8_f32(x[0], x[1], 0, false); a = __builtin_amdgcn_cvt_pk_fp8_f32(x[2], x[3], a, true); int b = __builtin_amdgcn_cvt_pk_fp8_f32(x[4], x[5], 0, false); b = __builtin_amdgcn_cvt_pk_fp8_f32(x[6], x[7], b, true); return (u32x2){(unsigned)a, (unsigned)b}; }
template <bool NORM, bool ROPE, bool WB16 = true> __device__ __forceinline__ void head128_fin(bf16_t* base, const u32x4 wa, const u32x4 wb, int g, const F8& g1, const F8& g2, const F8& cc, const F8& sn, unsigned char* f8base = nullptr) {
    float x1[8], x2[8];
    unpack8(wa, x1); unpack8(wb, x2);
    if (NORM) {
        float ss = 0.f;
#pragma unroll
        for (int j = 0; j < 8; ++j) ss += x1[j] * x1[j] + x2[j] * x2[j];
        ss += __shfl_xor(ss, 1); ss += __shfl_xor(ss, 2); ss += __shfl_xor(ss, 4);
        const float rstd = 1.f / sqrtf(ss * (1.f / 128.f) + EPS);
#pragma unroll
        for (int j = 0; j < 8; ++j) { x1[j] = x1[j] * rstd * g1.v[j]; x2[j] = x2[j] * rstd * g2.v[j]; }
    }
    if (ROPE) {
#pragma unroll
        for (int j = 0; j < 8; ++j) { const float c = cc.v[j], sv = sn.v[j]; const float p = x1[j], q = x2[j]; x1[j] = p * c - q * sv; x2[j] = q * c + p * sv; }
    }
    if (WB16) { *(u32x4*)(base + 8 * g) = pack8(x1); *(u32x4*)(base + 64 + 8 * g) = pack8(x2); }
    if (f8base) { *(u32x2*)(f8base + 8 * g) = pack8_fp8(x1); *(u32x2*)(f8base + 64 + 8 * g) = pack8_fp8(x2); }
}
__device__ __forceinline__ void head64_fin(bf16_t* base, const u32x4 wa, const u32x4 wb, int g, const F8& cc, const F8& sn) {
    float x1[8], x2[8];
    unpack8(wa, x1); unpack8(wb, x2);
#pragma unroll
    for (int j = 0; j < 8; ++j) { const float c = cc.v[j], sv = sn.v[j]; const float p = x1[j], q = x2[j]; x1[j] = p * c - q * sv; x2[j] = q * c + p * sv; }
    *(u32x4*)(base + 8 * g) = pack8(x1); *(u32x4*)(base + 32 + 8 * g) = pack8(x2);
}
__device__ __forceinline__ void p2_post(const Frame& F, const Args& a) {
    unsigned char* ws = a.ws; const int lane = F.lane;
    const int gw = F.vcu * NWAVES + F.wave, NGW = F.G * NWAVES;
    bf16_t* Z = (bf16_t*)(ws + WS_Z); bf16_t* MIX = (bf16_t*)(ws + WS_XN); bf16_t* KVM = (bf16_t*)(ws + WS_KVM);
    const float* RT = (const float*)(ws + WS_ROPE);
    const int g8 = lane & 7, h8 = lane >> 3, g4 = lane & 3, h4 = lane >> 2;
#define P2_PL_LOAD(P, t_) do { const int pos_ = (t_) & (SEQ - 1); const int w_ = 2 << (lane >> 4); const int cnt_ = (pos_ + 1 < w_) ? pos_ + 1 : w_; const bf16_t* zr_ = Z + (size_t)(t_) * ZLD + ZC_PU + 8 * lane; \
        _Pragma("unroll") for (int j = 0; j < 16; ++j) { const int jj = j < cnt_ ? j : 0; P[j] = *(const u32x4*)(zr_ - (size_t)jj * ZLD); } } while (0)
#define P2_PL_FIN(P, t_) do { const int pos_ = (t_) & (SEQ - 1); const int w_ = 2 << (lane >> 4); const int cnt_ = (pos_ + 1 < w_) ? pos_ + 1 : w_; \
        float sum[8] = {0.f, 0.f, 0.f, 0.f, 0.f, 0.f, 0.f, 0.f}, ut[8]; unpack8(P[0], ut); \
        _Pragma("unroll") for (int j = 0; j < 16; ++j) { float v[8]; unpack8(P[j], v); const float on = j < cnt_ ? 1.f : 0.f; _Pragma("unroll") for (int e = 0; e < 8; ++e) sum[e] = fmaf(on, v[e], sum[e]); } \
        const float inv = 1.f / (float)cnt_; float d[8]; _Pragma("unroll") for (int e = 0; e < 8; ++e) d[e] = sum[e] * inv - ut[e]; \
        *(u32x4*)(MIX + (size_t)(t_) * DM + 1024 + 8 * lane) = pack8(d); } while (0)
    { u32x4 pa[16], pb[16]; int t = gw;
      if (t < NTOK) P2_PL_LOAD(pa, t);
      for (; t < NTOK; t += 2 * NGW) { const int t2 = t + NGW, t3 = t + 2 * NGW;
          if (t2 < NTOK) P2_PL_LOAD(pb, t2);
          P2_PL_FIN(pa, t);
          if (t3 < NTOK) P2_PL_LOAD(pa, t3);
          if (t2 < NTOK) P2_PL_FIN(pb, t2); } }
#undef P2_PL_LOAD
#undef P2_PL_FIN
    struct HB { u32x4 q1, q2, k1, k2, i1, i2, x1, x2, m1, m2; F8 c128, s128, c64, s64; };
    const unsigned oq = (unsigned)(ZC_Q + h8 * 128 + 8 * g8) * 2u, okk = (unsigned)(ZC_K + h8 * 128 + 8 * g8) * 2u, oi = (unsigned)(ZC_QI + h4 * 64 + 8 * g4) * 2u, oki = (unsigned)(ZC_KI + 8 * g4) * 2u,
                   om = (unsigned)(ZC_QM + (h8 & 3) * 128 + 8 * g8) * 2u, or8 = (unsigned)(8 * g8) * 4u, or4 = (unsigned)(128 + 8 * g4) * 4u;
#define P2_LDU(base, off) (*(const u32x4*)((const char*)(base) + (off)))
#define P2_LDF(base, off) ld8f((const float*)((const char*)(base) + (off)))
#define P2_HB_LOAD(H, t_) do { const char* zb_ = (const char*)(Z + (size_t)(t_) * ZLD); const char* rb_ = (const char*)(RT + (size_t)((t_) & (SEQ - 1)) * 192); \
        H.q1 = P2_LDU(zb_, oq); H.q2 = P2_LDU(zb_, oq + 128u); H.k1 = P2_LDU(zb_, okk); H.k2 = P2_LDU(zb_, okk + 128u); \
        H.i1 = P2_LDU(zb_, oi); H.i2 = P2_LDU(zb_, oi + 64u); H.x1 = P2_LDU(zb_, oki); H.x2 = P2_LDU(zb_, oki + 64u); \
        H.m1 = P2_LDU(zb_, om); H.m2 = P2_LDU(zb_, om + 128u); \
        H.c128 = P2_LDF(rb_, or8); H.s128 = P2_LDF(rb_, or8 + 256u); H.c64 = P2_LDF(rb_, or4); H.s64 = P2_LDF(rb_, or4 + 128u); } while (0)
#if QK_FP8
#define P2_QK(H, t_, zr_) { const F8 qg1 = ld8f(a.q_g + 8 * g8), qg2 = ld8f(a.q_g + 64 + 8 * g8); head128_fin<true, true, ATT_VERIFY != 0>(zr_ + ZC_Q + h8 * 128, H.q1, H.q2, g8, qg1, qg2, H.c128, H.s128, ws + WS_Q8 + (size_t)(t_) * 1024 + h8 * 128); } \
        { const F8 kg1 = ld8f(a.k_g + 8 * g8), kg2 = ld8f(a.k_g + 64 + 8 * g8); head128_fin<true, true, ATT_VERIFY != 0>(zr_ + ZC_K + h8 * 128, H.k1, H.k2, g8, kg1, kg2, H.c128, H.s128, ws + WS_K8 + (size_t)(t_) * 1024 + h8 * 128); }
#else
#define P2_QK(H, t_, zr_) { const F8 qg1 = ld8f(a.q_g + 8 * g8), qg2 = ld8f(a.q_g + 64 + 8 * g8); head128_fin<true, true>(zr_ + ZC_Q + h8 * 128, H.q1, H.q2, g8, qg1, qg2, H.c128, H.s128); } \
        { const F8 kg1 = ld8f(a.k_g + 8 * g8), kg2 = ld8f(a.k_g + 64 + 8 * g8); head128_fin<true, true>(zr_ + ZC_K + h8 * 128, H.k1, H.k2, g8, kg1, kg2, H.c128, H.s128); }
#endif
#define P2_HB_FIN(H, t_) do { bf16_t* zr_ = Z + (size_t)(t_) * ZLD; P2_QK(H, t_, zr_) \
        head64_fin(zr_ + ZC_QI + h4 * 64, H.i1, H.i2, g4, H.c64, H.s64); \
        if (lane < 4) head64_fin((bf16_t*)(ws + WS_KI) + (size_t)(t_) * 64, H.x1, H.x2, g4, H.c64, H.s64); \
        if (lane < 32) { const F8 mg1 = ld8f(a.mq_g + 8 * g8), mg2 = ld8f(a.mq_g + 64 + 8 * g8); head128_fin<true, false>(zr_ + ZC_QM + (h8 & 3) * 128, H.m1, H.m2, g8, mg1, mg2, H.c128, H.s128); } } while (0)
    { HB ha, hb; int t = gw;
      if (t < NTOK) P2_HB_LOAD(ha, t);
      for (; t < NTOK; t += 2 * NGW) { const int t2 = t + NGW, t3 = t + 2 * NGW;
          if (t2 < NTOK) P2_HB_LOAD(hb, t2);
          P2_HB_FIN(ha, t);
          if (t3 < NTOK) P2_HB_LOAD(ha, t3);
          if (t2 < NTOK) P2_HB_FIN(hb, t2); } }
#undef P2_HB_LOAD
#undef P2_LDU
#undef P2_LDF
#undef P2_HB_FIN
#undef P2_QK
    const F8 kmg1 = ld8f(a.mk_g + 8 * g8), kmg2 = ld8f(a.mk_g + 64 + 8 * g8);
    for (int r = gw; r < BATCH * MEMLEN; r += NGW) { if (lane < 32) { bf16_t* bm = KVM + (size_t)r * 1024 + (lane >> 3) * 128; const u32x4 m1 = *(const u32x4*)(bm + 8 * g8), m2 = *(const u32x4*)(bm + 64 + 8 * g8); head128_fin<true, false>(bm, m1, m2, g8, kmg1, kmg2, kmg1, kmg2); } }
}

#if PV_FP8
__device__ __forceinline__ void p2_vt(const Frame& F, const Args& a) {
    unsigned char* ws = a.ws; const int lane = F.lane;
    const int gw = F.vcu * NWAVES + F.wave, NGW = F.G * NWAVES;
    const bf16_t* Z = (const bf16_t*)(ws + WS_Z);
    {
        LAS unsigned char* tb = F.lds + F.wave * 8704; unsigned char* V8T = ws + WS_V8T;
        for (int blk = gw; blk < BATCH * 256 * 8; blk += NGW) {
            const int h = blk & 7, T = (blk >> 3) & 255, b = blk >> 11;
            const bf16_t* vrow = Z + ((size_t)b * SEQ + 64 * T + lane) * ZLD + ZC_V + h * 128;
            u32x4 w[16];
#pragma unroll
            for (int i = 0; i < 16; ++i) w[i] = *(const u32x4*)(vrow + 8 * i);
#pragma unroll
            for (int i = 0; i < 16; ++i) { float x[8]; unpack8(w[i], x);
#pragma unroll
                for (int e = 0; e < 8; ++e) x[e] = __builtin_amdgcn_fmed3f(x[e], -448.f, 448.f);
                *(LAS u32x2*)(tb + lane * 136 + 8 * i) = pack8_fp8(x); }
            LDS_WAIT();
            unsigned char* dst = V8T + ((size_t)((b * 8 + h) * 256 + T)) * 8192 + (size_t)lane * 128;
#pragma unroll
            for (int c = 0; c < 2; ++c) { const int d = 2 * lane + c;
#pragma unroll
                for (int q4 = 0; q4 < 4; ++q4) { unsigned o[4];
#pragma unroll
                    for (int qq = 0; qq < 4; ++qq) { const int pq = 4 * (4 * q4 + qq); const int key0 = 32 * ((pq >> 4) & 1) + 8 * ((pq >> 2) & 3) + 4 * (pq >> 5);
                        const unsigned b0 = tb[(key0 + 0) * 136 + d], b1 = tb[(key0 + 1) * 136 + d], b2 = tb[(key0 + 2) * 136 + d], b3 = tb[(key0 + 3) * 136 + d];
                        o[qq] = b0 | (b1 << 8) | (b2 << 16) | (b3 << 24); }
                    *(u32x4*)(dst + c * 64 + q4 * 16) = (u32x4){o[0], o[1], o[2], o[3]}; } }
            LDS_WAIT();
        }
    }
}
#endif

namespace ix {
constexpr int KP = 144, KBUF = 64 * KP;
constexpr int OFF_KI = 0, OFF_HIST = 2 * KBUF, OFF_ST = OFF_HIST + 65536, OFF_W = OFF_ST + 8192;
constexpr int CAPB = 1024;
constexpr int CAPF = 512;
enum { S_ULO = 0, S_UHI = 64, S_SH = 128, S_NEED = 192, S_FLO = 256, S_FHI = 320, S_CCNT = 384, S_ACT = 448, S_ABOVE = 512, S_COL = 576, S_FAIL = 640,
       S_PB1 = 704, S_PB2 = 768, S_PAB = 832, S_VMIN = 896, S_VMAX = 960, S_VCNT = 1024, S_ANY = 1088, S_R1 = 1089, S_R2 = 1090 };
constexpr float WSCALE = 0.25f * 0.125f;
__device__ __forceinline__ float relu_i(float x) { const int i = __float_as_int(x); return __int_as_float(i > 0 ? i : 0); }
__device__ __forceinline__ unsigned sh_for(unsigned range) { const int bits = 32 - __clz((int)range); return range == 0u ? 0u : (bits > 9 ? (unsigned)(bits - 9) : 0u); }

template <int MODE>
__device__ __forceinline__ void sweep(const Frame& F, const bf16x8 (&A)[4][4], const bf16_t* Z, unsigned* MASK, unsigned long long* CAND, size_t qrow0, size_t krow0, int NT, int t0, int stride, int vmode) {
    const int tid = F.tid, lane = F.lane, wave = F.wave, r = lane & 31, hi = lane >> 5;
    LAS unsigned char* lds = F.lds;
    volatile LAS unsigned* st = (volatile LAS unsigned*)(lds + OFF_ST);
    LAS unsigned* hist32 = (LAS unsigned*)(lds + OFF_HIST);
    unsigned qact = 0u;
    {
#pragma unroll
        for (int qp = 0; qp < 4; ++qp) { const int q0 = 8 * wave + 2 * qp; const unsigned a2 = (MODE == 0) ? (st[S_ACT + q0] | st[S_ACT + q0 + 1]) : (vmode ? 1u : (st[S_COL + q0] | st[S_COL + q0 + 1]));
            qact |= ((unsigned)__builtin_amdgcn_readfirstlane((int)a2) != 0u ? 1u : 0u) << qp; }
    }
    unsigned ccnt_[4] = {0u, 0u, 0u, 0u}, abv_[4] = {0u, 0u, 0u, 0u};
    if (MODE == 1) {
#pragma unroll
        for (int qp = 0; qp < 4; ++qp) { ccnt_[qp] = st[S_CCNT + 8 * wave + 2 * qp + hi]; abv_[qp] = st[S_ABOVE + 8 * wave + 2 * qp + hi]; }
    }
    const int srow = tid >> 3, sch = tid & 7;
    const bf16_t* KI = (const bf16_t*)((const unsigned char*)Z + (WS_KI - WS_Z));
    const bf16_t* ksrc = KI + (krow0 + srow) * 64 + sch * 8;
    u32x4 stg = *(const u32x4*)(ksrc + (size_t)t0 * 64 * 64);
    *(LAS u32x4*)(lds + OFF_KI + srow * KP + sch * 16) = stg;
    __syncthreads();
    int buf = 0;
    for (int t = t0; t < NT; t += stride) {
        const int tn = t + stride;
        if (tn < NT) stg = *(const u32x4*)(ksrc + (size_t)tn * 64 * 64);
        LAS unsigned char* kb = lds + OFF_KI + buf * KBUF;
        int lane_ = (int)threadIdx.x; asm volatile("" : "+v"(lane_)); lane_ &= 63;
        const int r = lane_ & 31, hi = lane_ >> 5;
        bf16x8 B0[4], B1[4];
#pragma unroll
        for (int ks = 0; ks < 4; ++ks) { B0[ks] = *(const LAS bf16x8*)(kb + r * KP + ks * 32 + hi * 16); B1[ks] = *(const LAS bf16x8*)(kb + (32 + r) * KP + ks * 32 + hi * 16); }
#pragma unroll
        for (int qp = 0; qp < 4; ++qp) {
            if (((qact >> qp) & 1u) == 0u) continue;
            const int ql = 8 * wave + 2 * qp + hi;
            const LAS f32x4* wq = (const LAS f32x4*)(lds + OFF_W + ql * 64);
            const f32x4 w0 = wq[0], w1 = wq[1], w2 = wq[2], w3 = wq[3];
            const unsigned sA = (MODE == 0) ? st[S_ULO + ql] : st[S_FLO + ql], sB = (MODE == 0) ? st[S_UHI + ql] : st[S_FHI + ql], sC = (MODE == 0) ? st[S_SH + ql] : st[S_COL + ql];
            f32x16 a0 = f32x16{}, a1 = f32x16{};
#pragma unroll
            for (int ks = 0; ks < 4; ++ks) { a0 = __builtin_amdgcn_mfma_f32_32x32x16_bf16(A[qp][ks], B0[ks], a0, 0, 0, 0); a1 = __builtin_amdgcn_mfma_f32_32x32x16_bf16(A[qp][ks], B1[ks], a1, 0, 0, 0); }
            float p0 = w0.x * relu_i(a0[0]), p1 = w2.x * relu_i(a0[8]), q0 = w0.x * relu_i(a1[0]), q1 = w2.x * relu_i(a1[8]);
            p0 = fmaf(w0.y, relu_i(a0[1]), p0); p1 = fmaf(w2.y, relu_i(a0[9]), p1); q0 = fmaf(w0.y, relu_i(a1[1]), q0); q1 = fmaf(w2.y, relu_i(a1[9]), q1);
            p0 = fmaf(w0.z, relu_i(a0[2]), p0); p1 = fmaf(w2.z, relu_i(a0[10]), p1); q0 = fmaf(w0.z, relu_i(a1[2]), q0); q1 = fmaf(w2.z, relu_i(a1[10]), q1);
            p0 = fmaf(w0.w, relu_i(a0[3]), p0); p1 = fmaf(w2.w, relu_i(a0[11]), p1); q0 = fmaf(w0.w, relu_i(a1[3]), q0); q1 = fmaf(w2.w, relu_i(a1[11]), q1);
            p0 = fmaf(w1.x, relu_i(a0[4]), p0); p1 = fmaf(w3.x, relu_i(a0[12]), p1); q0 = fmaf(w1.x, relu_i(a1[4]), q0); q1 = fmaf(w3.x, relu_i(a1[12]), q1);
            p0 = fmaf(w1.y, relu_i(a0[5]), p0); p1 = fmaf(w3.y, relu_i(a0[13]), p1); q0 = fmaf(w1.y, relu_i(a1[5]), q0); q1 = fmaf(w3.y, relu_i(a1[13]), q1);
            p0 = fmaf(w1.z, relu_i(a0[6]), p0); p1 = fmaf(w3.z, relu_i(a0[14]), p1); q0 = fmaf(w1.z, relu_i(a1[6]), q0); q1 = fmaf(w3.z, relu_i(a1[14]), q1);
            p0 = fmaf(w1.w, relu_i(a0[7]), p0); p1 = fmaf(w3.w, relu_i(a0[15]), p1); q0 = fmaf(w1.w, relu_i(a1[7]), q0); q1 = fmaf(w3.w, relu_i(a1[15]), q1);
            const unsigned u0 = f2ord(p0 + p1), u1 = f2ord(q0 + q1);
            if (MODE == 0) {
                const unsigned wlo = sA, whi = sB, wsh = sC;
                if (u0 >= wlo && u0 <= whi) { unsigned bin = (u0 - wlo) >> wsh; bin = bin > 511u ? 511u : bin;
                    __hip_atomic_fetch_add(hist32 + ql * 256 + (bin >> 1), 1u << ((bin & 1u) * 16u), __ATOMIC_RELAXED, __HIP_MEMORY_SCOPE_WORKGROUP); }
                if (u1 >= wlo && u1 <= whi) { unsigned bin = (u1 - wlo) >> wsh; bin = bin > 511u ? 511u : bin;
                    __hip_atomic_fetch_add(hist32 + ql * 256 + (bin >> 1), 1u << ((bin & 1u) * 16u), __ATOMIC_RELAXED, __HIP_MEMORY_SCOPE_WORKGROUP); }
            } else if (IX_VERIFY && vmode) {
                LAS unsigned* vs = (LAS unsigned*)(lds + OFF_ST) + ql;
                const unsigned long long w64 = __hip_atomic_load((const unsigned long long*)(MASK + (qrow0 + ql) * MASK_WPR + 2 * t), __ATOMIC_RELAXED, __HIP_MEMORY_SCOPE_AGENT);
                if ((w64 >> r) & 1ull) { __hip_atomic_fetch_min(vs + S_VMIN, u0, __ATOMIC_RELAXED, __HIP_MEMORY_SCOPE_WORKGROUP); __hip_atomic_fetch_add(vs + S_VCNT, 1u, __ATOMIC_RELAXED, __HIP_MEMORY_SCOPE_WORKGROUP); }
                else __hip_atomic_fetch_max(vs + S_VMAX, u0, __ATOMIC_RELAXED, __HIP_MEMORY_SCOPE_WORKGROUP);
                if ((w64 >> (32 + r)) & 1ull) { __hip_atomic_fetch_min(vs + S_VMIN, u1, __ATOMIC_RELAXED, __HIP_MEMORY_SCOPE_WORKGROUP); __hip_atomic_fetch_add(vs + S_VCNT, 1u, __ATOMIC_RELAXED, __HIP_MEMORY_SCOPE_WORKGROUP); }
                else __hip_atomic_fetch_max(vs + S_VMAX, u1, __ATOMIC_RELAXED, __HIP_MEMORY_SCOPE_WORKGROUP);
            } else {
                const unsigned flo = sA, fhi = sB; const bool col = sC != 0u;
                const unsigned long long bal0 = __ballot(col && u0 > fhi), bal1 = __ballot(col && u1 > fhi);
                const unsigned bh0 = (unsigned)(bal0 >> (32 * hi)), bh1 = (unsigned)(bal1 >> (32 * hi));
                if (col && r == 0) *(unsigned long long*)(MASK + (qrow0 + ql) * MASK_WPR + 2 * t) = (unsigned long long)bh0 | ((unsigned long long)bh1 << 32);
                abv_[qp] += __popc(bh0) + __popc(bh1);
                const bool c0 = col && (u0 >= flo) && (u0 <= fhi), c1 = col && (u1 >= flo) && (u1 <= fhi);
                const unsigned long long cb0 = __ballot(c0), cb1 = __ballot(c1);
                if (cb0 | cb1) { const unsigned h0 = (unsigned)(cb0 >> (32 * hi)), h1 = (unsigned)(cb1 >> (32 * hi)); const unsigned lt = (1u << r) - 1u;
                    const unsigned pos0 = ccnt_[qp] + __popc(h0 & lt), pos1 = ccnt_[qp] + __popc(h0) + __popc(h1 & lt);
                    if (c0 && pos0 < (unsigned)CAPB) CAND[(size_t)ql * CAPB + pos0] = (unsigned long long)u0 | ((unsigned long long)(unsigned)(64 * t + r) << 32);
                    if (c1 && pos1 < (unsigned)CAPB) CAND[(size_t)ql * CAPB + pos1] = (unsigned long long)u1 | ((unsigned long long)(unsigned)(64 * t + 32 + r) << 32);
                    ccnt_[qp] += __popc(h0) + __popc(h1); }
            }
        }
        if (tn < NT) *(LAS u32x4*)(lds + OFF_KI + (buf ^ 1) * KBUF + srow * KP + sch * 16) = stg;
        __syncthreads();
        buf ^= 1;
    }
    if (MODE == 1 && !vmode) { const int r0 = lane & 31, h0 = lane >> 5;
#pragma unroll
        for (int qp = 0; qp < 4; ++qp) { const int ql = 8 * wave + 2 * qp + h0; if (r0 == 0 && st[S_COL + ql] != 0u) { st[S_CCNT + ql] = ccnt_[qp]; st[S_ABOVE + ql] = abv_[qp]; } } }
}

__device__ __forceinline__ void resolve(const Frame& F, unsigned* MASK, const unsigned long long* CAND, size_t qrow0, int NT) {
    int lane = (int)threadIdx.x; asm volatile("" : "+v"(lane)); lane &= 63; const int wave = F.wave;
    LAS unsigned char* lds = F.lds;
    volatile LAS unsigned* st = (volatile LAS unsigned*)(lds + OFF_ST);
    LAS unsigned* wh = (LAS unsigned*)(lds + OFF_HIST + wave * 4608); LAS unsigned* bm = wh + 512; LAS unsigned long long* sl = (LAS unsigned long long*)(bm + 512);
    const unsigned long long ltm = (1ull << lane) - 1ull;
    for (int qi = 0; qi < 8; ++qi) {
        const int q = 8 * wave + qi;
        if (st[S_COL + q] == 0u) continue;
        const unsigned cnt = st[S_CCNT + q], ab = st[S_ABOVE + q];
        if (!(ab < 256u && ab + cnt >= 256u && cnt <= (unsigned)CAPB)) { if (lane == 0) st[S_FAIL + q] = 1u; continue; }
        if (lane == 0) st[S_FAIL + q] = 0u;
        unsigned need = 256u - ab, lo = st[S_FLO + q], hi = st[S_FHI + q], sh = 0u, cbin = 0u;
        const unsigned long long* cq = CAND + (size_t)q * CAPB;
#pragma unroll
        for (int i = 0; i < 8; ++i) bm[lane * 8 + i] = 0u;
        for (int lev = 0; lev < 5; ++lev) {
            sh = sh_for(hi - lo);
#pragma unroll
            for (int i = 0; i < 8; ++i) wh[lane * 8 + i] = 0u;
            LDS_WAIT();
            for (unsigned j = lane; j < cnt; j += 64) { const unsigned u = (unsigned)cq[j]; if (u >= lo && u <= hi) __hip_atomic_fetch_add(wh + ((u - lo) >> sh), 1u, __ATOMIC_RELAXED, __HIP_MEMORY_SCOPE_WORKGROUP); }
            LDS_WAIT();
            unsigned hb[8], s8 = 0u;
#pragma unroll
            for (int i = 0; i < 8; ++i) { hb[i] = wh[lane * 8 + i]; s8 += hb[i]; }
            unsigned above = 0u;
            { unsigned inc = s8;
#pragma unroll
              for (int o = 1; o < 64; o <<= 1) { const unsigned v = __shfl_down(inc, o); if (lane + o < 64) inc += v; }
              above = inc - s8; }
            const bool mine = above < need && need <= above + s8;
            unsigned bstar = 0u, run = above, cb = 0u;
            if (mine) { bool found = false;
#pragma unroll
                for (int i = 7; i >= 0; --i) { if (!found) { if (run + hb[i] >= need) { bstar = (unsigned)(lane * 8 + i); cb = hb[i]; found = true; } else run += hb[i]; } } }
            const unsigned long long mb = __ballot(mine); const int src = mb ? (int)__builtin_ctzll(mb) : 0;
            bstar = __shfl(bstar, src); run = __shfl(run, src); cbin = __shfl(cb, src);
            const unsigned nlo = lo + (bstar << sh); const unsigned long long e = (unsigned long long)nlo + ((1ull << sh) - 1ull);
            hi = e > (unsigned long long)hi ? hi : (unsigned)e; lo = nlo; need -= run;
            if (cbin <= 64u || sh == 0u) break;
        }
        const bool tiemode = cbin > 64u;
        unsigned m = 0u;
        for (unsigned j0 = 0; j0 < cnt; j0 += 64) { const unsigned j = j0 + lane; const bool vj = j < cnt; const unsigned long long e = vj ? cq[j] : 0ull; const unsigned u = (unsigned)e, key = (unsigned)(e >> 32);
            const bool inw = vj && u >= lo && u <= hi; const unsigned long long bal = __ballot(inw); const unsigned pos = m + (unsigned)__popcll(bal & ltm);
            if (vj && (u > hi || (tiemode && inw && pos < need))) __hip_atomic_fetch_or(bm + (key >> 5), 1u << (key & 31u), __ATOMIC_RELAXED, __HIP_MEMORY_SCOPE_WORKGROUP);
            if (!tiemode && inw && pos < 64u) sl[pos] = e;
            m += (unsigned)__popcll(bal); }
        LDS_WAIT();
        if (!tiemode) { if (m > 64u) m = 64u;
            if ((unsigned)lane < m) { const unsigned long long ej = sl[lane]; const unsigned uj = (unsigned)ej; unsigned rank = 0u;
                for (unsigned j2 = 0; j2 < m; ++j2) { const unsigned u2 = (unsigned)sl[j2]; rank += (u2 > uj || (u2 == uj && j2 < (unsigned)lane)) ? 1u : 0u; }
                if (rank < need) { const unsigned key = (unsigned)(ej >> 32); __hip_atomic_fetch_or(bm + (key >> 5), 1u << (key & 31u), __ATOMIC_RELAXED, __HIP_MEMORY_SCOPE_WORKGROUP); } } }
        LDS_WAIT();
        unsigned* mrow = MASK + (qrow0 + q) * MASK_WPR;
        for (int w = lane; w < 2 * NT; w += 64) { const unsigned b = bm[w]; if (b) { const unsigned old = __hip_atomic_load(mrow + w, __ATOMIC_RELAXED, __HIP_MEMORY_SCOPE_AGENT); mrow[w] = old | b; } }
        LDS_WAIT();
    }
}

__device__ __forceinline__ void unit(const Frame& F, const bf16_t* Z, unsigned* MASK, unsigned long long* CANDW, unsigned* ERR, int b, int c) {
    const int tid = F.tid, lane = F.lane, wave = F.wave, r = lane & 31, hi = lane >> 5;
    const int NT = c + 1; const size_t qrow0 = (size_t)b * SEQ + 64 * c, krow0 = (size_t)b * SEQ;
    LAS unsigned char* lds = F.lds;
    volatile LAS unsigned* st = (volatile LAS unsigned*)(lds + OFF_ST);
    LAS unsigned* hist32 = (LAS unsigned*)(lds + OFF_HIST);
    { const int tend = 4 * ((c >> 2) + 1), nz = 2 * (tend - NT);
      for (int i = tid; i < 64 * nz; i += 512) { const int q = i / nz, wi = 2 * NT + i % nz; MASK[(qrow0 + q) * MASK_WPR + wi] = 0u; } }
    if (c <= 3) {
        for (int i = tid; i < 64 * 2 * NT; i += 512) { const int q = i / (2 * NT), wi = i % (2 * NT); MASK[(qrow0 + q) * MASK_WPR + wi] = 0xFFFFFFFFu; }
        return;
    }
    bf16x8 A[4][4];
#pragma unroll
    for (int qp = 0; qp < 4; ++qp) {
        const int query = 8 * wave + 2 * qp + ((r >> 2) & 1), head = (r & 3) + 4 * (r >> 3);
        const bf16_t* src = Z + (qrow0 + query) * ZLD + ZC_QI + head * 64 + 8 * hi;
#pragma unroll
        for (int ks = 0; ks < 4; ++ks) A[qp][ks] = *(const bf16x8*)(src + ks * 16);
    }
    for (int i = tid; i < 64 * 16; i += 512) { const int q = i >> 4, hh = i & 15; ((LAS float*)(lds + OFF_W))[i] = bflo((unsigned)Z[(qrow0 + q) * ZLD + ZC_WI + hh]) * WSCALE; }
    const int stride = NT >= 32 ? 8 : (NT >= 16 ? 4 : 1), t0 = stride >> 1, nsamp = (NT - t0 + stride - 1) / stride;
    const bool pilot = stride > 1;
    int r1 = 1, r2 = 1;
    if (pilot) { const float ns = 256.f * (float)nsamp / (float)NT; const float sg = sqrtf(ns * (1.f - 1.f / (float)stride)); const int mg = (int)ceilf(5.f * sg) + 2, mgl = (int)ceilf(4.2f * sg);
        r1 = (int)floorf(ns) - mgl; if (r1 < 1) r1 = 1; r2 = (int)ceilf(ns) + mg; }
    const int strideA = (pilot && NT >= 128) ? 4 * stride : stride, t0A = strideA >> 1, nsampA = (NT - t0A + strideA - 1) / strideA;
    int r1A = r1, r2A = r2;
    if (pilot && strideA != stride) { const float ns = 256.f * (float)nsampA / (float)NT; const float sg = sqrtf(ns * (1.f - 1.f / (float)strideA)); const int mg = (int)ceilf(5.f * sg) + 2;
        r1A = (int)floorf(ns) - mg; if (r1A < 1) r1A = 1; r2A = (int)ceilf(ns) + mg; }
    if (tid < 64) { st[S_ULO + tid] = 0u; st[S_UHI + tid] = 0xFFFFFFFFu; st[S_SH + tid] = 23u; st[S_NEED + tid] = 256u; st[S_ACT + tid] = 1u; st[S_CCNT + tid] = 0u; st[S_ABOVE + tid] = 0u;
                    st[S_COL + tid] = 1u; st[S_FAIL + tid] = pilot ? 0u : 1u; st[S_PB1 + tid] = 511u; st[S_PB2 + tid] = 0u; st[S_PAB + tid] = 0u; }
    __syncthreads();
    int stage = pilot ? 0 : 2; bool after_fallback = !pilot;
    for (int iter = 0; iter < 24; ++iter) {
        if (stage <= 2) {
            { int tid_ = (int)threadIdx.x; asm volatile("" : "+v"(tid_));
              for (int i = 0; i < 32; ++i) hist32[tid_ + 512 * i] = 0u;
              if (tid_ == 0) st[S_ANY] = 0u; }
            __syncthreads();
            const bool smp = stage <= 1;
            sweep<0>(F, A, Z, MASK, CANDW, qrow0, krow0, NT, smp ? (stage == 0 ? t0A : t0) : 0, smp ? (stage == 0 ? strideA : stride) : 1, 0);
            { int tid_ = (int)threadIdx.x; asm volatile("" : "+v"(tid_)); const int ln = tid_ & 63;
              const int q = tid_ >> 3, seg = tid_ & 7; const LAS unsigned* h32 = hist32 + q * 256 + seg * 32;
              unsigned cnt = 0u;
              for (int i = 0; i < 32; ++i) { const unsigned wv = h32[i]; cnt += (wv & 0xffffu) + (wv >> 16); }
              unsigned above = 0u;
#pragma unroll
              for (int k = 0; k < 8; ++k) { const unsigned ck = __shfl(cnt, (ln & ~7) + k); if (k > seg) above += ck; }
              const unsigned ulo = st[S_ULO + q], uhi = st[S_UHI + q], sh = st[S_SH + q];
              if (smp) {
                  const unsigned pab = stage == 1 ? st[S_PAB + q] : 0u;
                  const unsigned t1 = (unsigned)(stage == 0 ? r1A : r1) - (stage == 1 ? pab : 0u), t2 = (unsigned)(stage == 0 ? r2A : r2) - (stage == 1 ? pab : 0u);
#pragma unroll
                  for (int which = 0; which < 2; ++which) { const unsigned tg = which ? t2 : t1;
                      if (above < tg && tg <= above + cnt) { unsigned run = above; int bstar = -1;
                          for (int i = 31; i >= 0; --i) { const unsigned wv = h32[i]; const unsigned c1 = wv >> 16, c0 = wv & 0xffffu;
                              if (bstar < 0) { if (run + c1 >= tg) bstar = seg * 64 + 2 * i + 1; else run += c1; }
                              if (bstar < 0) { if (run + c0 >= tg) bstar = seg * 64 + 2 * i; else run += c0; } }
                          if (which == 0) { st[S_PB1 + q] = (unsigned)bstar; if (stage == 0) st[S_PAB + q] = run; } else st[S_PB2 + q] = (unsigned)bstar; } }
              } else {
                  const unsigned need = st[S_NEED + q], active = st[S_ACT + q];
                  if (active && above < need && need <= above + cnt) {
                      unsigned run = above; int bstar = -1; unsigned cbin = 0u;
                      for (int i = 31; i >= 0; --i) { const unsigned wv = h32[i]; const unsigned c1 = wv >> 16, c0 = wv & 0xffffu;
                          if (bstar < 0) { if (run + c1 >= need) { bstar = seg * 64 + 2 * i + 1; cbin = c1; } else run += c1; }
                          if (bstar < 0) { if (run + c0 >= need) { bstar = seg * 64 + 2 * i; cbin = c0; } else run += c0; } }
                      const unsigned nlo = ulo + ((unsigned)bstar << sh); const unsigned long long e = (unsigned long long)nlo + ((1ull << sh) - 1ull);
                      const unsigned nhi = e > (unsigned long long)uhi ? uhi : (unsigned)e;
                      if (cbin <= (unsigned)CAPF || sh == 0u) { st[S_FLO + q] = nlo; st[S_FHI + q] = nhi; st[S_ACT + q] = 0u; st[S_ULO + q] = 1u; st[S_UHI + q] = 0u; }
                      else { st[S_ULO + q] = nlo; st[S_UHI + q] = nhi; st[S_SH + q] = sh >= 9u ? sh - 9u : 0u; st[S_NEED + q] = need - run; st[S_ANY] = 1u; }
                  }
              } }
            __syncthreads();
            if (stage == 0) {
                if (tid < 64) { const unsigned b1 = st[S_PB1 + tid], b2 = st[S_PB2 + tid]; const unsigned lob = b2 > 0u ? b2 - 1u : 0u, hib = b1 < 510u ? b1 + 1u : 511u;
                    const unsigned nlo = lob << 23; const unsigned long long e = ((unsigned long long)(hib + 1u) << 23) - 1ull; const unsigned nhi = e > 0xFFFFFFFFull ? 0xFFFFFFFFu : (unsigned)e;
                    st[S_ULO + tid] = nlo; st[S_UHI + tid] = 0xFFFFFFFFu; st[S_SH + tid] = sh_for(nhi - nlo); st[S_PAB + tid] = 0u; st[S_PB1 + tid] = 511u; st[S_PB2 + tid] = 0u; }
                stage = 1;
            } else if (stage == 1) {
                if (tid < 64) { const unsigned b1 = st[S_PB1 + tid], b2 = st[S_PB2 + tid], ulo = st[S_ULO + tid], uhi = st[S_UHI + tid], sh = st[S_SH + tid];
                    const unsigned flo = ulo + (b2 << sh); const unsigned long long e = (unsigned long long)ulo + ((unsigned long long)(b1 + 1u) << sh) - 1ull;
                    st[S_FLO + tid] = flo; st[S_FHI + tid] = (b1 >= 511u || e > (unsigned long long)uhi) ? uhi : (unsigned)e; }
                stage = 3;
            } else { const unsigned any = st[S_ANY]; if (!any) stage = 3; }
            __syncthreads();
        } else {
            const int vm = stage == 4 ? 1 : 0;
            if (vm) { if (tid < 64) { st[S_VMIN + tid] = 0xFFFFFFFFu; st[S_VMAX + tid] = 0u; st[S_VCNT + tid] = 0u; } __syncthreads(); }
            sweep<1>(F, A, Z, MASK, CANDW, qrow0, krow0, NT, 0, 1, vm);
            VM_WAIT(); __syncthreads();
            if (vm) { if (tid < 64) { if (st[S_VCNT + tid] != 256u || st[S_VMIN + tid] < st[S_VMAX + tid]) atomicOr(ERR, 1u); } __syncthreads(); break; }
            resolve(F, MASK, CANDW, qrow0, NT);
            VM_WAIT(); __syncthreads();
            unsigned nf = 0u;
            if (!after_fallback) { if (tid < 64) nf = st[S_FAIL + tid] & st[S_COL + tid]; nf = (unsigned)__syncthreads_or((int)nf); }
            if (nf) {
                if (tid < 64) { const unsigned f = st[S_FAIL + tid] & st[S_COL + tid]; st[S_ULO + tid] = f ? 0u : 1u; st[S_UHI + tid] = f ? 0xFFFFFFFFu : 0u; st[S_SH + tid] = 23u; st[S_NEED + tid] = 256u; st[S_ACT + tid] = f;
                    st[S_COL + tid] = f; if (f) { st[S_CCNT + tid] = 0u; st[S_ABOVE + tid] = 0u; } }
                __syncthreads();
                stage = 2; after_fallback = true;
            } else { if (IX_VERIFY) stage = 4; else break; }
        }
    }
}
}

namespace peer {
constexpr int TT = 16;
constexpr int SP = 129;
constexpr int OFF_S = 0, OFF_L = 256 * SP * 4;
constexpr int OFF_A = 0;
__device__ __forceinline__ void ins16(unsigned (&L)[16], unsigned x) {
#pragma unroll
    for (int j = 0; j < 16; ++j) { const unsigned a = L[j]; const unsigned mx = a > x ? a : x; x = a > x ? x : a; L[j] = mx; }
}
__device__ __forceinline__ float dot2bf(unsigned w, unsigned x, float acc) { return __builtin_amdgcn_fdot2_f32_bf16(__builtin_bit_cast(bf16x2_t, w), __builtin_bit_cast(bf16x2_t, x), acc, false); }
__device__ __forceinline__ float gelu_erf(float h) { return 0.5f * h * (1.f + erff(h * 0.70710678118654752f)); }

__device__ __forceinline__ void fp8dot4(unsigned w, f32x2 h01, f32x2 h23, f32x2& a0, f32x2& a1) {
    const f32x2 lo = __builtin_amdgcn_cvt_pk_f32_fp8((int)w, false), hi = __builtin_amdgcn_cvt_pk_f32_fp8((int)w, true); a0 = lo * h01 + a0; a1 = hi * h23 + a1; }
__device__ __forceinline__ void fp8axpy4(unsigned w, f32x2 a2, f32x2& c01, f32x2& c23) {
    const f32x2 lo = __builtin_amdgcn_cvt_pk_f32_fp8((int)w, false), hi = __builtin_amdgcn_cvt_pk_f32_fp8((int)w, true); c01 = lo * a2 + c01; c23 = hi * a2 + c23; }
constexpr int NSL = 16, SLW = 128;
__device__ __forceinline__ float dpp_sum8(float v) {
    v += __int_as_float(__builtin_amdgcn_update_dpp(0, __float_as_int(v), 0xB1, 0xF, 0xF, true));
    v += __int_as_float(__builtin_amdgcn_update_dpp(0, __float_as_int(v), 0x4E, 0xF, 0xF, true));
    v += __int_as_float(__builtin_amdgcn_update_dpp(0, __float_as_int(v), 0x141, 0xF, 0xF, true));
    return v;
}
#define PEER_EID(V0, V1, i) ((((i) < 8 ? (V0) : (V1))[((i) & 7) >> 1] >> (16 * ((i) & 1))) & 0xffffu)

struct TabCvt { const float* pu; const float* pv; unsigned char* UB; unsigned char* VB; float* RSU; float* RSV; };
__device__ __forceinline__ const float* tab_src(const TabCvt& T, int m) { return m < NEXP ? T.pu + (size_t)m * DM : T.pv + (size_t)(m - NEXP) * DM; }
__device__ __forceinline__ void tab_finish(const TabCvt& T, const RowF32& R, int m, int lane) { if (m < NEXP) row_to_fp8_sliced(R, T.UB, m, T.RSU + m, lane); else row_to_fp8_sliced(R, T.VB, m - NEXP, T.RSV + (m - NEXP), lane); }
__device__ __forceinline__ void route_step(const Frame& F, const bf16_t* PQ, const bf16x8 (&Bf)[2][8], unsigned short* E16, float* GT, int tok0, const TabCvt& T, int m0, int m1) {
    const int tid = F.tid, lane = F.lane, wave = F.wave, r = lane & 31, hi = lane >> 5;
    LAS float* S = (LAS float*)(F.lds + OFF_S); LAS unsigned* L = (LAS unsigned*)(F.lds + OFF_L);
    RowF32 R;
    if (m0 >= 0) row_load(R, tab_src(T, m0), lane);
    { const int half = wave & 1, cp = (wave >> 1) & 1, rh = wave >> 2;
#pragma unroll
      for (int r2 = 0; r2 < 2; ++r2) {
          const int rt = 2 * rh + r2; const int pair = 32 * rt + r, tok = pair >> 3, p = pair & 7;
          const bf16_t* src = PQ + (size_t)(tok0 + tok) * DM + p * 256 + half * 128 + 8 * hi;
          bf16x8 A[8];
#pragma unroll
          for (int ks = 0; ks < 8; ++ks) A[ks] = *(const bf16x8*)(src + ks * 16);
#pragma unroll
          for (int c2 = 0; c2 < 2; ++c2) {
              f32x16 acc = f32x16{};
#pragma unroll
              for (int ks = 0; ks < 8; ++ks) acc = __builtin_amdgcn_mfma_f32_32x32x16_bf16(A[ks], Bf[c2][ks], acc, 0, 0, 0);
#pragma unroll
              for (int i = 0; i < 16; ++i) { const int row = (32 * rt + (i & 3) + 8 * (i >> 2) + 4 * hi) * 2 + half; S[row * SP + (2 * cp + c2) * 32 + r] = acc[i]; }
          } } }
    if (m0 >= 0) tab_finish(T, R, m0, lane);
    if (m1 >= 0) row_load(R, tab_src(T, m1), lane);
    __syncthreads();
    { const int row = tid >> 1, part = tid & 1; unsigned L16[16];
#pragma unroll
      for (int j = 0; j < 16; ++j) L16[j] = 0u;
#pragma unroll 4
      for (int n = 0; n < 64; ++n) { const int nn = part * 64 + n; const unsigned k = (f2ord(S[row * SP + nn]) & ~127u) | (unsigned)(127 - nn); ins16(L16, k); }
      unsigned oth[16];
#pragma unroll
      for (int j = 0; j < 16; ++j) oth[j] = __shfl_xor(L16[j], 1);
#pragma unroll
      for (int j = 0; j < 16; ++j) ins16(L16, part == 0 ? oth[j] : 0u);
      if (part == 0) {
#pragma unroll
          for (int j = 0; j < 16; ++j) L[row * 16 + j] = L16[j]; } }
    __syncthreads();
    if (tid < 128) {
        const int pair = tid; const LAS float* S1 = S + (pair * 2) * SP; const LAS float* S2 = S + (pair * 2 + 1) * SP;
        const LAS unsigned* L1 = L + (pair * 2) * 16; const LAS unsigned* L2 = L1 + 16;
        float v1[16], v2[16];
#pragma unroll
        for (int j = 0; j < 16; ++j) { v1[j] = S1[127 - (L1[j] & 127u)]; v2[j] = S2[127 - (L2[j] & 127u)]; }
        unsigned C16[16];
#pragma unroll
        for (int j = 0; j < 16; ++j) C16[j] = 0u;
#pragma unroll
        for (int i = 0; i < 16; ++i)
#pragma unroll
            for (int j = 0; j < 16; ++j) if ((i + 1) * (j + 1) <= 16) { const unsigned k = (f2ord(v1[i] + v2[j]) & ~255u) | (unsigned)(255 - (i * 16 + j)); ins16(C16, k); }
        float sc[16]; unsigned ex[16]; float mx = -3.0e38f;
#pragma unroll
        for (int q = 0; q < 16; ++q) { const unsigned ci = 255u - (C16[q] & 255u); const unsigned n1 = 127u - (L1[ci >> 4] & 127u), n2 = 127u - (L2[ci & 15u] & 127u);
            sc[q] = S1[n1] + S2[n2]; ex[q] = n1 * 128u + n2; mx = fmaxf(mx, sc[q]); }
        float sum = 0.f;
#pragma unroll
        for (int q = 0; q < 16; ++q) { sc[q] = __expf(sc[q] - mx); sum += sc[q]; }
        const float inv = 1.f / sum;
        const size_t o = (size_t)(tok0 + (pair >> 3)) * 128 + (pair & 7) * 16;
        u32x4 e0, e1; e0.x = ex[0] | (ex[1] << 16); e0.y = ex[2] | (ex[3] << 16); e0.z = ex[4] | (ex[5] << 16); e0.w = ex[6] | (ex[7] << 16);
        e1.x = ex[8] | (ex[9] << 16); e1.y = ex[10] | (ex[11] << 16); e1.z = ex[12] | (ex[13] << 16); e1.w = ex[14] | (ex[15] << 16);
        *(u32x4*)(E16 + o) = e0; *(u32x4*)(E16 + o + 8) = e1;
#pragma unroll
        for (int q = 0; q < 4; ++q) *(f32x4*)(GT + o + 4 * q) = (f32x4){sc[4 * q] * inv, sc[4 * q + 1] * inv, sc[4 * q + 2] * inv, sc[4 * q + 3] * inv};
    }
    if (m1 >= 0) tab_finish(T, R, m1, lane);
    __syncthreads();
}

__device__ __forceinline__ void udot_compute(const u32x4 (&d)[16], const u32x4 h0, const u32x4 h1, float* dst, int k, bool ok) {
    f32x2 hq[8];
    hq[0] = (f32x2){bflo(h0.x), bfhi(h0.x)}; hq[1] = (f32x2){bflo(h0.y), bfhi(h0.y)}; hq[2] = (f32x2){bflo(h0.z), bfhi(h0.z)}; hq[3] = (f32x2){bflo(h0.w), bfhi(h0.w)};
    hq[4] = (f32x2){bflo(h1.x), bfhi(h1.x)}; hq[5] = (f32x2){bflo(h1.y), bfhi(h1.y)}; hq[6] = (f32x2){bflo(h1.z), bfhi(h1.z)}; hq[7] = (f32x2){bflo(h1.w), bfhi(h1.w)};
    float keep0 = 0.f, keep1 = 0.f;
#pragma unroll
    for (int i = 0; i < 16; ++i) {
        f32x2 a0 = {0.f, 0.f}, a1 = {0.f, 0.f};
        fp8dot4(d[i].x, hq[0], hq[1], a0, a1); fp8dot4(d[i].y, hq[2], hq[3], a0, a1); fp8dot4(d[i].z, hq[4], hq[5], a0, a1); fp8dot4(d[i].w, hq[6], hq[7], a0, a1);
        const float pr = dpp_sum8((a0.x + a0.y) + (a1.x + a1.y));
        if ((i & 7) == k) { if (i < 8) keep0 = pr; else keep1 = pr; }
    }
    if (ok) { dst[0] = keep0; dst[8] = keep1; }
}
__device__ __forceinline__ void udots(const Frame& F, const bf16_t* HN, const unsigned char* UB, const unsigned short* E16, float* PART) {
    const int lane = F.lane, g = lane >> 3, k = lane & 7;
    const int ngr = (F.G % 8 == 0) ? 8 : 1, wpg = F.G / ngr, x = F.vcu / wpg, wl = (F.vcu % wpg) * NWAVES + F.wave, wst = wpg * NWAVES, spg = NSL / ngr;
    const int ntw = (NTOK - wl + wst - 1) / wst;
#define UD_T(j) ((size_t)((wl + (j) * wst) < NTOK ? (wl + (j) * wst) : (NTOK - 1)))
#define UD_IDS(j, V0, V1) { const unsigned short* ep_ = E16 + UD_T(j) * 128 + g * 16; V0 = *(const u32x4*)ep_; V1 = *(const u32x4*)(ep_ + 8); }
#define UD_HN(j, H0, H1) { const bf16_t* hp_ = HN + UD_T(j) * DM + s * SLW + k * 16; H0 = *(const u32x4*)hp_; H1 = *(const u32x4*)(hp_ + 8); }
#define UD_ROWS(D, V0, V1) { _Pragma("unroll") for (int i = 0; i < 16; ++i) D[i] = *(const u32x4*)(ub + (size_t)PEER_EID(V0, V1, i) * 128); }
    for (int rr = 0; rr < spg; ++rr) {
        const int s = x + ngr * rr;
        const unsigned char* ub = UB + (size_t)s * ((size_t)NEXP * 128) + k * 16;
        float* pb = PART + (size_t)s * NTOK * 128 + g * 16 + k;
        u32x4 dA[16], dB[16], idA0, idA1, idB0, idB1, hA0, hA1, hB0, hB1;
        UD_IDS(0, idA0, idA1) UD_HN(0, hA0, hA1) UD_ROWS(dA, idA0, idA1)
        UD_IDS(1, idB0, idB1) UD_HN(1, hB0, hB1)
        for (int j = 0; j < ntw; j += 2) {
            UD_ROWS(dB, idB0, idB1)
            UD_IDS(j + 2, idA0, idA1)
            udot_compute(dA, hA0, hA1, pb + UD_T(j) * 128, k, true);
            UD_HN(j + 2, hA0, hA1)
            UD_ROWS(dA, idA0, idA1)
            UD_IDS(j + 3, idB0, idB1)
            udot_compute(dB, hB0, hB1, pb + UD_T(j + 1) * 128, k, j + 1 < ntw);
            UD_HN(j + 3, hB0, hB1)
        }
    }
#undef UD_IDS
#undef UD_HN
#undef UD_ROWS
}
#if UDOT_MFMA
__device__ __forceinline__ void udot_mfma_compute(const u32x4 (&d)[16], const i32x8 hb, LAS unsigned char* tb, float* dst, int lane, bool ok) {
    const int g = lane >> 3, k = lane & 7, c = lane & 15, q = lane >> 4;
#pragma unroll
    for (int i = 0; i < 16; ++i) *(LAS u32x4*)(tb + (8 * i + (g ^ ((i >> 3) & 1))) * 128 + ((k ^ (i & 7)) << 4)) = d[i];
    f32x4 acc[8];
#pragma unroll
    for (int m = 0; m < 8; ++m) { LAS const unsigned char* rp = tb + (8 * c + (m ^ ((c >> 3) & 1))) * 128;
        const i32x8 a = pg8::cat8(*(LAS const bf16x8*)(rp + (((2 * q) ^ (c & 7)) << 4)), *(LAS const bf16x8*)(rp + (((2 * q + 1) ^ (c & 7)) << 4)));
        acc[m] = __builtin_amdgcn_mfma_scale_f32_16x16x128_f8f6f4(a, hb, (f32x4){0.f, 0.f, 0.f, 0.f}, 0, 0, 0, 0, 0, 0); }
    f32x4 v = acc[0];
#pragma unroll
    for (int m = 1; m < 8; ++m) { if ((c & 7) == m) v = acc[m]; }
#pragma unroll
    for (int e = 0; e < 4; ++e) v[e] += __int_as_float(__builtin_amdgcn_update_dpp(0, __float_as_int(v[e]), 0x128, 0xF, 0xF, true));
#if PART_BF16
    if (ok && c < 8) *(u32x2*)((bf16_t*)dst + 16 * c + 4 * q) = (u32x2){cvtpk(v[0], v[1]), cvtpk(v[2], v[3])};
#else
    if (ok && c < 8) *(f32x4*)(dst + 16 * c + 4 * q) = v;
#endif
}
__device__ __forceinline__ void udots_mfma(const Frame& F, const unsigned char* HNhi, const unsigned char* HNlo, const unsigned char* UB, const unsigned short* E16, float* PART) {
    const int lane = F.lane, g = lane >> 3, k = lane & 7, c = lane & 15, q = lane >> 4;
    const int ngr = (F.G % 8 == 0) ? 8 : 1, wpg = F.G / ngr, x = F.vcu / wpg, wl = (F.vcu % wpg) * NWAVES + F.wave, wst = wpg * NWAVES, spg = NSL / ngr;
    const int ntw = (NTOK - wl + wst - 1) / wst;
    LAS unsigned char* tb = F.lds + F.wave * 16384;
    const unsigned char* hsel = (c < 8) ? HNhi : HNlo;
#define UD_IDS(j, V0, V1) { const unsigned short* ep_ = E16 + UD_T(j) * 128 + g * 16; V0 = *(const u32x4*)ep_; V1 = *(const u32x4*)(ep_ + 8); }
#define UD_H8(j, H) { const unsigned char* hp_ = hsel + UD_T(j) * DM + s * SLW + q * 32; H = pg8::cat8(*(const bf16x8*)hp_, *(const bf16x8*)(hp_ + 16)); }
#define UD_ROWS(D, V0, V1) { _Pragma("unroll") for (int i = 0; i < 16; ++i) D[i] = *(const u32x4*)(ub + (size_t)PEER_EID(V0, V1, i) * 128); }
    for (int rr = 0; rr < spg; ++rr) {
        const int s = x + ngr * rr;
        const unsigned char* ub = UB + (size_t)s * ((size_t)NEXP * 128) + k * 16;
        float* pb = PART + (size_t)s * NTOK * (PART_BF16 ? 64 : 128);
        u32x4 dA[16], dB[16], idA0, idA1, idB0, idB1; i32x8 hA, hB;
        UD_IDS(0, idA0, idA1) UD_H8(0, hA) UD_ROWS(dA, idA0, idA1)
        UD_IDS(1, idB0, idB1) UD_H8(1, hB)
        for (int j = 0; j < ntw; j += 2) {
            UD_ROWS(dB, idB0, idB1)
            UD_IDS(j + 2, idA0, idA1)
            udot_mfma_compute(dA, hA, tb, pb + UD_T(j) * (PART_BF16 ? 64 : 128), lane, true);
            UD_H8(j + 2, hA)
            UD_ROWS(dA, idA0, idA1)
            UD_IDS(j + 3, idB0, idB1)
            udot_mfma_compute(dB, hB, tb, pb + UD_T(j + 1) * (PART_BF16 ? 64 : 128), lane, j + 1 < ntw);
            UD_H8(j + 3, hB)
        }
    }
#undef UD_IDS
#undef UD_H8
#undef UD_ROWS
}
#endif
__device__ __forceinline__ void combine(const Frame& F, const float* PART, const unsigned short* E16, const float* GT, const float* RSU, const float* RSV, float* AT, unsigned* A8HI = nullptr, unsigned* A8LO = nullptr, float* ASC = nullptr) {
    const size_t n4 = (size_t)NTOK * 128 / 4, stride = (size_t)F.G * NWAVES * 64;
    for (size_t i = (size_t)F.vcu * NWAVES * 64 + F.tid; i < n4; i += stride) {
        f32x4 pv[NSL];
#pragma unroll
        for (int s = 0; s < NSL; ++s) {
#if PART_BF16 && UDOT_MFMA
            const u32x2 w = *(const u32x2*)((const bf16_t*)PART + (size_t)s * n4 * 4 + i * 4); pv[s] = (f32x4){bflo(w.x), bfhi(w.x), bflo(w.y), bfhi(w.y)};
#else
            pv[s] = *(const f32x4*)(PART + (size_t)s * n4 * 4 + i * 4);
#endif
        }
        const u32x2 ee = *(const u32x2*)(E16 + i * 4); const f32x4 gg = *(const f32x4*)(GT + i * 4);
        const unsigned e0 = ee.x & 0xffffu, e1 = ee.x >> 16, e2 = ee.y & 0xffffu, e3 = ee.y >> 16;
        const float su0 = RSU[e0], su1 = RSU[e1], su2 = RSU[e2], su3 = RSU[e3], sv0 = RSV[e0], sv1 = RSV[e1], sv2 = RSV[e2], sv3 = RSV[e3];
        f32x4 sacc = pv[0];
#pragma unroll
        for (int s = 1; s < NSL; ++s) sacc += pv[s];
        f32x4 o; o.x = gg.x * gelu_erf(sacc.x * su0) * sv0; o.y = gg.y * gelu_erf(sacc.y * su1) * sv1; o.z = gg.z * gelu_erf(sacc.z * su2) * sv2; o.w = gg.w * gelu_erf(sacc.w * su3) * sv3;
        if (A8HI) {
            float am = fmaxf(fmaxf(fabsf(o.x), fabsf(o.y)), fmaxf(fabsf(o.z), fabsf(o.w)));
#pragma unroll
            for (int sh = 1; sh < 32; sh <<= 1) am = fmaxf(am, __shfl_xor(am, sh));
            const float sc = (am > 0.f && am < 3.0e38f) ? exp2f(floorf(log2f(224.f / am))) : 1.f;
            const f32x4 y = o * sc;
            int w = __builtin_amdgcn_cvt_pk_fp8_f32(y.x, y.y, 0, false); w = __builtin_amdgcn_cvt_pk_fp8_f32(y.z, y.w, w, true);
            const f32x2 b01 = __builtin_amdgcn_cvt_pk_f32_fp8(w, false), b23 = __builtin_amdgcn_cvt_pk_f32_fp8(w, true);
            int u = __builtin_amdgcn_cvt_pk_fp8_f32(y.x - b01.x, y.y - b01.y, 0, false); u = __builtin_amdgcn_cvt_pk_fp8_f32(y.z - b23.x, y.w - b23.y, u, true);
            A8HI[i] = (unsigned)w; A8LO[i] = (unsigned)u; if ((i & 31) == 0) ASC[i >> 5] = 1.f / sc;
        } else
        *(f32x4*)(AT + i * 4) = o;
    }
}
__device__ __forceinline__ void vacc_compute(const u32x4 (&d)[16], const f32x4 a0, const f32x4 a1, const f32x4 a2, const f32x4 a3, float* orow, int g, bool ok) {
    f32x2 acc[8];
#pragma unroll
    for (int c = 0; c < 8; ++c) acc[c] = (f32x2){0.f, 0.f};
    const float av[16] = {a0.x, a0.y, a0.z, a0.w, a1.x, a1.y, a1.z, a1.w, a2.x, a2.y, a2.z, a2.w, a3.x, a3.y, a3.z, a3.w};
#pragma unroll
    for (int i = 0; i < 16; ++i) { const f32x2 aa = {av[i], av[i]};
        fp8axpy4(d[i].x, aa, acc[0], acc[1]); fp8axpy4(d[i].y, aa, acc[2], acc[3]); fp8axpy4(d[i].z, aa, acc[4], acc[5]); fp8axpy4(d[i].w, aa, acc[6], acc[7]); }
    float v[16];
#pragma unroll
    for (int c = 0; c < 8; ++c) { v[2 * c] = acc[c].x; v[2 * c + 1] = acc[c].y; }
    float R[8], S4[4];
#pragma unroll
    for (int c = 0; c < 8; ++c) { auto r = __builtin_amdgcn_permlane32_swap(__float_as_uint(v[c]), __float_as_uint(v[c + 8]), false, false); R[c] = __uint_as_float(r[0]) + __uint_as_float(r[1]); }
#pragma unroll
    for (int c = 0; c < 4; ++c) { auto r = __builtin_amdgcn_permlane16_swap(__float_as_uint(R[c]), __float_as_uint(R[c + 4]), false, false); S4[c] = __uint_as_float(r[0]) + __uint_as_float(r[1]); }
    const bool b8 = (g & 1) != 0;
    float T0, T1;
    { const float keep = b8 ? S4[2] : S4[0], send = b8 ? S4[0] : S4[2]; T0 = keep + __int_as_float(__builtin_amdgcn_update_dpp(0, __float_as_int(send), 0x128, 0xF, 0xF, true)); }
    { const float keep = b8 ? S4[3] : S4[1], send = b8 ? S4[1] : S4[3]; T1 = keep + __int_as_float(__builtin_amdgcn_update_dpp(0, __float_as_int(send), 0x128, 0xF, 0xF, true)); }
    if (ok) { f32x2 o2 = *(const f32x2*)orow; o2.x += T0; o2.y += T1; *(f32x2*)orow = o2; }
}
__device__ __forceinline__ void vacc(const Frame& F, const unsigned char* VB, const unsigned short* E16, const float* AT, float* out) {
    const int lane = F.lane, g = lane >> 3, k = lane & 7;
    const int ngr = (F.G % 8 == 0) ? 8 : 1, wpg = F.G / ngr, x = F.vcu / wpg, wl = (F.vcu % wpg) * NWAVES + F.wave, wst = wpg * NWAVES, spg = NSL / ngr;
    const int ntw = (NTOK - wl + wst - 1) / wst;
#define UD_IDS(j, V0, V1) { const unsigned short* ep_ = E16 + UD_T(j) * 128 + g * 16; V0 = *(const u32x4*)ep_; V1 = *(const u32x4*)(ep_ + 8); }
#define VA_A(j, A0, A1, A2, A3) { const float* ap_ = AT + UD_T(j) * 128 + g * 16; A0 = *(const f32x4*)ap_; A1 = *(const f32x4*)(ap_ + 4); A2 = *(const f32x4*)(ap_ + 8); A3 = *(const f32x4*)(ap_ + 12); }
#define UD_ROWS(D, V0, V1) { _Pragma("unroll") for (int i = 0; i < 16; ++i) D[i] = *(const u32x4*)(vb + (size_t)PEER_EID(V0, V1, i) * 128); }
    for (int rr = 0; rr < spg; ++rr) {
        const int s = x + ngr * rr;
        const unsigned char* vb = VB + (size_t)s * ((size_t)NEXP * 128) + k * 16;
        float* ob = out + s * SLW + k * 16 + 2 * g;
        u32x4 dA[16], dB[16], idA0, idA1, idB0, idB1; f32x4 aA0, aA1, aA2, aA3, aB0, aB1, aB2, aB3;
        UD_IDS(0, idA0, idA1) VA_A(0, aA0, aA1, aA2, aA3) UD_ROWS(dA, idA0, idA1)
        UD_IDS(1, idB0, idB1) VA_A(1, aB0, aB1, aB2, aB3)
        for (int j = 0; j < ntw; j += 2) {
            UD_ROWS(dB, idB0, idB1)
            UD_IDS(j + 2, idA0, idA1)
            vacc_compute(dA, aA0, aA1, aA2, aA3, ob + UD_T(j) * DM, g, true);
            VA_A(j + 2, aA0, aA1, aA2, aA3)
            UD_ROWS(dA, idA0, idA1)
            UD_IDS(j + 3, idB0, idB1)
            vacc_compute(dB, aB0, aB1, aB2, aB3, ob + UD_T(j + 1) * DM, g, j + 1 < ntw);
            VA_A(j + 3, aB0, aB1, aB2, aB3)
        }
    }
#undef UD_T
#undef UD_IDS
#undef VA_A
#undef UD_ROWS
}
#if VACC_MFMA
__device__ __forceinline__ u32x2 tr8_read(int addr) { u32x2 r; asm volatile("ds_read_b64_tr_b8 %0, %1" : "=&v"(r) : "v"(addr) : "memory"); return r; }
__device__ __forceinline__ void vacc_mfma_compute(const u32x4 (&d)[16], const i32x8 ab, const float asc, f32x4 o4, int wk, const int (&rb)[4], float* orow, int lane, bool ok) {
    const int c = lane & 15;
#pragma unroll
    for (int i = 0; i < 16; ++i) { const int wa = (wk ^ ((i & 7) << 4)) + i * 1024; *(LAS u32x4*)(uintptr_t)wa = d[i]; }
    f32x4 acc[8];
#pragma unroll
    for (int m = 0; m < 8; ++m) {
        const u32x2 t0 = tr8_read(rb[0] ^ (m << 4)), t1 = tr8_read(rb[1] ^ (m << 4)), t2 = tr8_read(rb[2] ^ (m << 4)), t3 = tr8_read(rb[3] ^ (m << 4));
        asm volatile("s_waitcnt lgkmcnt(0)" ::: "memory");
        const i32x8 a = {(int)t0.x, (int)t0.y, (int)t1.x, (int)t1.y, (int)t2.x, (int)t2.y, (int)t3.x, (int)t3.y};
        acc[m] = __builtin_amdgcn_mfma_scale_f32_16x16x128_f8f6f4(a, ab, (f32x4){0.f, 0.f, 0.f, 0.f}, 0, 0, 0, 0, 0, 0); }
    f32x4 v = acc[0];
#pragma unroll
    for (int m = 1; m < 8; ++m) { if ((c & 7) == m) v = acc[m]; }
#pragma unroll
    for (int e = 0; e < 4; ++e) v[e] += __int_as_float(__builtin_amdgcn_update_dpp(0, __float_as_int(v[e]), 0x128, 0xF, 0xF, true));
    if (ok && c < 8) *(f32x4*)orow = o4 + v * asc;
}
__device__ __forceinline__ void vacc_mfma(const Frame& F, const unsigned char* VB, const unsigned short* E16, const unsigned char* A8HI, const unsigned char* A8LO, const float* ASC, float* out) {
    const int lane = F.lane, g = lane >> 3, k = lane & 7, c = lane & 15, q = lane >> 4;
    const int ngr = (F.G % 8 == 0) ? 8 : 1, wpg = F.G / ngr, x = F.vcu / wpg, wl = (F.vcu % wpg) * NWAVES + F.wave, wst = wpg * NWAVES, spg = NSL / ngr;
    const int ntw = (NTOK - wl + wst - 1) / wst;
    const int tile = (int)(uintptr_t)(F.lds + F.wave * 16384);
    const int wk = tile + 128 * g + 16 * k;
    int rb[4];
#pragma unroll
    for (int t = 0; t < 4; ++t) { const int r = c >> 1, cc = c & 1, phys = 64 * (t & 1) + 8 * r + 2 * q + (t >> 1); rb[t] = tile + phys * 128 + (r << 4) + 8 * cc; }
    const unsigned char* asel = (c < 8) ? A8HI : A8LO;
#define UD_T(j) ((size_t)((wl + (j) * wst) < NTOK ? (wl + (j) * wst) : (NTOK - 1)))
#define UD_IDS(j, V0, V1) { const unsigned short* ep_ = E16 + UD_T(j) * 128 + g * 16; V0 = *(const u32x4*)ep_; V1 = *(const u32x4*)(ep_ + 8); }
#define VA_A8(j, A, S, O) { const unsigned char* ap_ = asel + UD_T(j) * 128 + q * 32; A = pg8::cat8(*(const bf16x8*)ap_, *(const bf16x8*)(ap_ + 16)); S = ASC[UD_T(j)]; O = *(const f32x4*)(ob + UD_T(j) * DM); }
#define UD_ROWS(D, V0, V1) { _Pragma("unroll") for (int i = 0; i < 16; ++i) D[i] = *(const u32x4*)(vb + (size_t)PEER_EID(V0, V1, i) * 128); }
    for (int rr = 0; rr < spg; ++rr) {
        const int s = x + ngr * rr;
        const unsigned char* vb = VB + (size_t)s * ((size_t)NEXP * 128) + k * 16;
        float* ob = out + s * SLW + 16 * (c & 7) + 4 * q;
        u32x4 dA[16], dB[16], idA0, idA1, idB0, idB1; i32x8 aA, aB; float sA, sB; f32x4 oA, oB;
        UD_IDS(0, idA0, idA1) VA_A8(0, aA, sA, oA) UD_ROWS(dA, idA0, idA1)
        UD_IDS(1, idB0, idB1) VA_A8(1, aB, sB, oB)
        for (int j = 0; j < ntw; j += 2) {
            UD_ROWS(dB, idB0, idB1)
            UD_IDS(j + 2, idA0, idA1)
            vacc_mfma_compute(dA, aA, sA, oA, wk, rb, ob + UD_T(j) * DM, lane, true);
            VA_A8(j + 2, aA, sA, oA)
            UD_ROWS(dA, idA0, idA1)
            UD_IDS(j + 3, idB0, idB1)
            vacc_mfma_compute(dB, aB, sB, oB, wk, rb, ob + UD_T(j + 1) * DM, lane, j + 1 < ntw);
            VA_A8(j + 3, aB, sB, oB)
        }
    }
#undef UD_T
#undef UD_IDS
#undef VA_A8
#undef UD_ROWS
}
#endif
}

__device__ __forceinline__ void pool_unit(const Frame& F, bf16_t* MIX, const bf16_t* PWt, const float* pool_s, int tm, int g, unsigned char* MIX8 = nullptr) {
    const int lane = F.lane, r = lane & 31, hi = lane >> 5;
    bf16_t* base = MIX + (size_t)(tm * 256 + F.wave * 32) * DM + 1024 + 128 * g;
    bf16x8 A[8];
#pragma unroll
    for (int ks = 0; ks < 8; ++ks) A[ks] = *(const bf16x8*)(base + (size_t)r * DM + ks * 16 + 8 * hi);
#pragma unroll
    for (int ct = 0; ct < 4; ++ct) {
        f32x16 acc = f32x16{};
        const bf16_t* pb = PWt + (size_t)(g * 128 + ct * 32 + r) * 128 + 8 * hi;
#pragma unroll
        for (int ks = 0; ks < 8; ++ks) { const bf16x8 B = *(const bf16x8*)(pb + ks * 16); acc = __builtin_amdgcn_mfma_f32_32x32x16_bf16(A[ks], B, acc, 0, 0, 0); }
        const float sc = pool_s[128 * g + ct * 32 + r];
#pragma unroll
        for (int i = 0; i < 16; ++i) { const int row = (i & 3) + 8 * (i >> 2) + 4 * hi;
            if (MIX8) MIX8[(size_t)(tm * 256 + F.wave * 32 + row) * DM + 1024 + 128 * g + ct * 32 + r] = to_fp8(acc[i] * sc * MIX8_SCALE);
            else base[(size_t)row * DM + ct * 32 + r] = (bf16_t)(cvtpk(acc[i] * sc, 0.f) & 0xffffu); }
    }
}

__global__ void __launch_bounds__(NWAVES * 64, 2) fwd_kernel(Args args) {
    extern __shared__ __attribute__((aligned(16))) unsigned char lds[];
    Frame F;
    F.lds = (LAS unsigned char*)lds; F.ldsg = (char*)lds;
    F.tid = threadIdx.x; F.lane = F.tid & 63; F.wave = __builtin_amdgcn_readfirstlane(F.tid >> 6);
    F.G = gridDim.x; { const int bx = blockIdx.x; F.vcu = (F.G % 8 == 0) ? (bx % 8) * (F.G / 8) + bx / 8 : bx; }
    unsigned char* ws = args.ws;
    unsigned* ctl = (unsigned*)(ws + WS_CTL);
    volatile LAS unsigned* MISC = (volatile LAS unsigned*)(F.lds + MISC_OFF);
    for (int u = F.tid; u < (LDS_BYTES - LDSCTL_OFF) / 4; u += NWAVES * 64) ((LAS unsigned*)(F.lds + LDSCTL_OFF))[u] = 0u;
    __syncthreads();
    const int lo = args.ph_lo, hi = args.ph_hi;
    XcdBarrier bar; bar.bar = ctl + CW_BAR; bar.x = 0; bar.st = nullptr;
    if (hi - lo > 1) bar = xcd_barrier_post(ctl + CW_BAR, MISC + 8);
#define IN(k) (lo <= (k) && (k) < hi)
#define PHASE_BEGIN() do { int t_ = (int)threadIdx.x; asm volatile("" : "+v"(t_)); F.tid = t_; F.lane = t_ & 63; } while (0)
#define SEAM(k) do { if (IN(k) && IN((k) + 1)) xcd_barrier(bar); } while (0)

    bf16_t* Z = (bf16_t*)(ws + WS_Z); bf16_t* XN = (bf16_t*)(ws + WS_XN); bf16_t* MIX = XN;
    bf16_t* HN = (bf16_t*)(ws + WS_Z); bf16_t* PQ = (bf16_t*)(ws + WS_Z + 128 * MiB);
    bf16_t* KVM = (bf16_t*)(ws + WS_KVM); unsigned* MASK = (unsigned*)(ws + WS_MASK);

    if (IN(0)) { PHASE_BEGIN(); p0_prologue(F, args); } SEAM(0);
    if (IN(1)) { PHASE_BEGIN();
#if P1_FP8
        const int gw = F.vcu * NWAVES + F.wave, NGW = F.G * NWAVES;
        for (int i = gw; i < 4096; i += NGW) { const int n = i < 3072 ? i : i + 1024; RowF32 R; row_load_bf16(R, (const bf16_t*)(ws + WS_BT_IN) + (size_t)n * DM, F.lane); row_to_fp8(R, ws + WS_BTIN8 + (size_t)n * DM, (float*)(ws + WS_CSI) + n, F.lane); }
#endif
#if P5_FP8
        { const int gw = F.vcu * NWAVES + F.wave, NGW = F.G * NWAVES; float* cso = (float*)(ws + WS_CSO);
          for (int n = gw; n < DM; n += NGW) { RowF32 R; row_load_bf16(R, (const bf16_t*)(ws + WS_BT_OUT) + (size_t)n * DM, F.lane); row_to_fp8(R, ws + WS_BTOUT8 + (size_t)n * DM, cso + n, F.lane);
              if (F.lane == 0) cso[n] = cso[n] * (1.f / MIX8_SCALE); } }
#endif
    } SEAM(1);
    if (IN(2)) { PHASE_BEGIN();
#if P1_FP8
        { pg8::Gemm g{XN, (const bf16_t*)(ws + WS_BT_IN), NTOK, ZLD, DM}; pg8::InBf16Order S; S.init(NTOK, F.G, (int)blockIdx.x);
          pg8::EpiBf16 E{Z, ZLD}; pg8::gemm_phase<pg8::EpiBf16, pg8::InBf16Order, true, true>(F.lds, g, S, E); }
        { pg8::Gemm g{(const bf16_t*)(ws + WS_XN8), (const bf16_t*)(ws + WS_BTIN8), NTOK, ZLD, DM / 2}; pg8::InFp8Order S; S.init(NTOK, F.G, (int)blockIdx.x);
          pg8::EpiBf16S E{Z, ZLD, (const float*)(ws + WS_CSI)}; pg8::gemm_phase<pg8::EpiBf16S, pg8::InFp8Order, true, true, true>(F.lds, g, S, E); }
#else
        { pg8::Gemm g{XN, (const bf16_t*)(ws + WS_BT_IN), NTOK, ZLD, DM}; pg8::StaticOrder S; S.init(NTOK, ZLD, F.G, (int)blockIdx.x);
          pg8::EpiBf16 E{Z, ZLD}; pg8::gemm_phase<pg8::EpiBf16, pg8::StaticOrder, true, true>(F.lds, g, S, E); }
#endif
        { pg8::Gemm g{(const bf16_t*)(ws + WS_MN), (const bf16_t*)(ws + WS_BT_KV), BATCH * MEMLEN, 1024, DM}; pg8::StaticOrder S; S.init(BATCH * MEMLEN, 1024, F.G, (int)((blockIdx.x + 128) % F.G));
          pg8::EpiBf16 E{KVM, 1024}; pg8::gemm_phase<pg8::EpiBf16, pg8::StaticOrder, true, true>(F.lds, g, S, E); }
    } SEAM(2);
    if (IN(3)) { PHASE_BEGIN(); p2_post(F, args);
#if PV_FP8
        PHASE_BEGIN(); p2_vt(F, args);
#endif
    } SEAM(3);
    if (IN(4)) { PHASE_BEGIN();
        for (int i = 0; ; ++i) {
            int b, c;
            if (F.G == 256) { if (i >= 2) break; b = F.vcu >> 7; c = (i == 0) ? 255 - (F.vcu & 127) : (F.vcu & 127); }
            else { const int u = (int)blockIdx.x + i * F.G; if (u >= 512) break; b = u >> 8; c = u & 255; }
            ix::unit(F, Z, MASK, (unsigned long long*)(ws + WS_CAND) + (size_t)blockIdx.x * 64 * ix::CAPB, ctl + 2048, b, c);
            __syncthreads();
        }
    } SEAM(4);
    if (IN(5)) { PHASE_BEGIN();
        for (int u = F.vcu; u < (NTOK / 256) * 4; u += F.G) pool_unit(F, MIX, (const bf16_t*)(ws + WS_PWT), args.pool_s, u >> 2, u & 3, P5_FP8 ? ws + WS_MIX8 : nullptr);
        const int r32 = F.lane & 31;
        for (int i = 0; ; ++i) {
            int b, h, qb;
            if (F.G == 256) { if (i >= 4) break; const int bh = F.vcu >> 4, s = F.vcu & 15; b = bh >> 3; h = bh & 7; qb = (i == 0) ? 63 - s : (i == 1) ? 32 + s : (i == 2) ? 31 - s : s; }
            else { const int u = (int)blockIdx.x + i * F.G; if (u >= 1024) break; b = u >> 9; h = (u >> 6) & 7; qb = u & 63; }
            const size_t row0 = (size_t)b * SEQ + 256 * qb;
            const unsigned long long* mrow = (const unsigned long long*)MASK + (row0 + F.wave * 32 + r32) * (MASK_WPR / 2);
#if QK_FP8
            att::attn_body<true, 2, ZLD, ZLD, DM, true, PV_FP8 != 0>(Z + row0 * ZLD + ZC_Q + h * 128, Z + (size_t)b * SEQ * ZLD + ZC_K + h * 128, Z + (size_t)b * SEQ * ZLD + ZC_V + h * 128,
                                                        MIX + row0 * DM + h * 128, 256 * (qb + 1), mrow, F.ldsg, ws + WS_Q8 + row0 * 1024 + h * 128, ws + WS_K8 + (size_t)b * SEQ * 1024 + h * 128,
                                                        ws + WS_V8T + (size_t)(b * 8 + h) * 256 * 8192, P5_FP8 ? ws + WS_MIX8 + row0 * DM + h * 128 : nullptr);
#else
            att::attn_body<true, 2, ZLD, ZLD, DM>(Z + row0 * ZLD + ZC_Q + h * 128, Z + (size_t)b * SEQ * ZLD + ZC_K + h * 128, Z + (size_t)b * SEQ * ZLD + ZC_V + h * 128,
                                                  MIX + row0 * DM + h * 128, 256 * (qb + 1), mrow, F.ldsg);
#endif
        }
        for (int id = F.vcu; id < 512; id += F.G) {
            const int b2 = id >> 8, hm = (id >> 6) & 3, qb = id & 63; const size_t row0 = (size_t)b2 * SEQ + 256 * qb;
            att::attn_body<false, 1, ZLD, 1024, DM>(Z + row0 * ZLD + ZC_QM + hm * 128, KVM + (size_t)b2 * MEMLEN * 1024 + hm * 128, KVM + (size_t)b2 * MEMLEN * 1024 + 512 + hm * 128,
                                                    MIX + row0 * DM + 1536 + hm * 128, MEMLEN, nullptr, F.ldsg, nullptr, nullptr, nullptr, P5_FP8 ? ws + WS_MIX8 + row0 * DM + 1536 + hm * 128 : nullptr);
        }
    } SEAM(5);
    if (IN(6)) { PHASE_BEGIN();
#if ATT_VERIFY
        {
            const int t = (int)blockIdx.x * 128 + 77, hh = F.wave, ln = F.lane; const int bb = t / SEQ, pos = t % SEQ, N = 64 * (pos / 64 + 1);
            const bf16_t* zq = Z + (size_t)t * ZLD + ZC_Q + hh * 128 + 2 * ln; const float q0 = bflo((unsigned)zq[0]), q1 = bflo((unsigned)zq[1]);
            float m = -3.0e38f, l = 0.f, o0 = 0.f, o1 = 0.f; int nsel = 0;
            for (int w = 0; w < N / 32; ++w) { unsigned bits = __hip_atomic_load(MASK + (size_t)t * MASK_WPR + w, __ATOMIC_RELAXED, __HIP_MEMORY_SCOPE_AGENT);
                while (bits) { const int bpos = __builtin_ctz(bits); bits &= bits - 1u; const int sidx = 32 * w + bpos; ++nsel;
                    const bf16_t* zk = Z + ((size_t)bb * SEQ + sidx) * ZLD + ZC_K + hh * 128 + 2 * ln; const bf16_t* zv = Z + ((size_t)bb * SEQ + sidx) * ZLD + ZC_V + hh * 128 + 2 * ln;
                    const float lg = wave_sum(q0 * bflo((unsigned)zk[0]) + q1 * bflo((unsigned)zk[1])) * 0.088388347648318440f;
                    const float mn = fmaxf(m, lg), al = __expf(m - mn), pe = __expf(lg - mn); l = l * al + pe; o0 = o0 * al + pe * bflo((unsigned)zv[0]); o1 = o1 * al + pe * bflo((unsigned)zv[1]); m = mn; } }
            const bf16_t* mx = MIX + (size_t)t * DM + hh * 128 + 2 * ln; const float r0 = o0 / l, r1 = o1 / l;
            float er = fmaxf(fabsf(r0 - bflo((unsigned)mx[0])), fabsf(r1 - bflo((unsigned)mx[1]))), sc = fmaxf(fabsf(r0), fabsf(r1));
#pragma unroll
            for (int o = 1; o < 64; o <<= 1) { er = fmaxf(er, __shfl_xor(er, o)); sc = fmaxf(sc, __shfl_xor(sc, o)); }
            if (!(er <= (QK_FP8 ? 0.12f : 0.03f) * sc + (QK_FP8 ? 4e-3f : 1e-3f)) || nsel != (N < 256 ? N : 256)) { if (ln == 0) atomicOr(ctl + 2048, 2u); }
        }
        __syncthreads();
#endif
#if P5_FP8
        pg8::Gemm g{(const bf16_t*)(ws + WS_MIX8), (const bf16_t*)(ws + WS_BTOUT8), NTOK, DM, DM / 2}; pg8::StaticOrder S; S.init(NTOK, DM, F.G, (int)blockIdx.x);
        pg8::EpiF32ResS E{args.x, args.out, DM, (const float*)(ws + WS_CSO)}; pg8::gemm_phase<pg8::EpiF32ResS, pg8::StaticOrder, true, true, true>(F.lds, g, S, E);
#else
        pg8::Gemm g{MIX, (const bf16_t*)(ws + WS_BT_OUT), NTOK, DM, DM}; pg8::StaticOrder S; S.init(NTOK, DM, F.G, (int)blockIdx.x);
        pg8::EpiF32Res E{args.x, args.out, DM}; pg8::gemm_phase<pg8::EpiF32Res, pg8::StaticOrder, true, true>(F.lds, g, S, E);
#endif
    } SEAM(6);
    if (IN(7)) { PHASE_BEGIN(); const int gw = F.vcu * NWAVES + F.wave, NGW = F.G * NWAVES;
#if P7_FP8
        for (int n = gw; n < DM; n += NGW) { RowF32 R; row_load_bf16(R, (const bf16_t*)(ws + WS_BT_Q) + (size_t)n * DM, F.lane); row_to_fp8(R, ws + WS_BTQ8 + (size_t)n * DM, (float*)(ws + WS_CSQ) + n, F.lane); }
#if UDOT_MFMA
        { RowF32 Ra, Rb; int m = gw;
          if (m < NTOK) row_load(Ra, args.out + (size_t)m * DM, F.lane);
          for (; m < NTOK; m += 2 * NGW) { const int m2 = m + NGW, m3 = m + 2 * NGW;
              if (m2 < NTOK) row_load(Rb, args.out + (size_t)m2 * DM, F.lane);
              rms_fin_fp8_hilo(Ra.v, args.ffn_g, ws + WS_HN8 + (size_t)m * DM, ws + WS_HN8LO + (size_t)m * DM, F.lane);
              if (m3 < NTOK) row_load(Ra, args.out + (size_t)m3 * DM, F.lane);
              if (m2 < NTOK) rms_fin_fp8_hilo(Rb.v, args.ffn_g, ws + WS_HN8 + (size_t)m2 * DM, ws + WS_HN8LO + (size_t)m2 * DM, F.lane); } }
#else
        for (int m = gw; m < NTOK; m += NGW) { RowF32 R; row_load(R, args.out + (size_t)m * DM, F.lane); rms_fin_bf16_fp8(R.v, args.ffn_g, HN + (size_t)m * DM, ws + WS_HN8 + (size_t)m * DM, F.lane); }
#endif
#else
        for (int m = gw; m < NTOK; m += NGW) rms_row_to_bf16(args.out + (size_t)m * DM, args.ffn_g, HN + (size_t)m * DM, F.lane);
#endif
    } SEAM(7);
    if (IN(8)) { PHASE_BEGIN();
#if P7_FP8
        pg8::Gemm g{(const bf16_t*)(ws + WS_HN8), (const bf16_t*)(ws + WS_BTQ8), NTOK, DM, DM / 2}; pg8::StaticOrder S; S.init(NTOK, DM, F.G, (int)blockIdx.x);
        pg8::EpiBf16S E{PQ, DM, (const float*)(ws + WS_CSQ)}; pg8::gemm_phase<pg8::EpiBf16S, pg8::StaticOrder, true, true, true>(F.lds, g, S, E);
#else
        pg8::Gemm g{HN, (const bf16_t*)(ws + WS_BT_Q), NTOK, DM, DM}; pg8::StaticOrder S; S.init(NTOK, DM, F.G, (int)blockIdx.x);
        pg8::EpiBf16 E{PQ, DM}; pg8::gemm_phase<pg8::EpiBf16, pg8::StaticOrder, true, true>(F.lds, g, S, E);
#endif
    } SEAM(8);
    unsigned short* E16 = (unsigned short*)(ws + WS_XN); float* GT = (float*)(ws + WS_XN + 8 * MiB); float* AT = (float*)(ws + WS_XN + 24 * MiB);
    float* PART = (float*)(ws + WS_Z + 128 * MiB);
    if (IN(9)) { PHASE_BEGIN();
        const bf16_t* PKb = (const bf16_t*)(ws + WS_PK);
        bf16x8 Bf[2][8];
        { const int half = F.wave & 1, cp = (F.wave >> 1) & 1, r = F.lane & 31, hi = F.lane >> 5;
#pragma unroll
          for (int c2 = 0; c2 < 2; ++c2)
#pragma unroll
              for (int ks = 0; ks < 8; ++ks) Bf[c2][ks] = *(const bf16x8*)(PKb + (size_t)(half * 128 + (2 * cp + c2) * 32 + r) * 128 + 8 * hi + ks * 16); }
        const peer::TabCvt T{args.pu, args.pv, ws + WS_UB, ws + WS_VB, (float*)(ws + WS_RSU), (float*)(ws + WS_RSV)};
        const int gw = F.vcu * NWAVES + F.wave, NGW = F.G * NWAVES; int mrow = gw, nstep = 0;
        for (int it = F.vcu; it < NTOK / peer::TT; it += F.G, ++nstep) {
            const int m0 = mrow < 2 * NEXP ? mrow : -1; mrow += NGW; const int m1 = mrow < 2 * NEXP ? mrow : -1; mrow += NGW;
            peer::route_step(F, PQ, Bf, E16, GT, it * peer::TT, T, m0, m1);
        }
        for (; mrow < 2 * NEXP; mrow += NGW) { RowF32 R; row_load(R, peer::tab_src(T, mrow), F.lane); peer::tab_finish(T, R, mrow, F.lane); }
    } SEAM(9);
    if (IN(10)) { PHASE_BEGIN();
#if UDOT_MFMA
        peer::udots_mfma(F, ws + WS_HN8, ws + WS_HN8LO, ws + WS_UB, E16, PART);
#else
        peer::udots(F, HN, ws + WS_UB, E16, PART);
#endif
    } SEAM(10);
#if VACC_MFMA
    unsigned char* A8HI = ws + WS_XN + 24 * MiB; unsigned char* A8LO = ws + WS_XN + 28 * MiB; float* ASC = (float*)(ws + WS_XN + 32 * MiB);
    if (IN(11)) { PHASE_BEGIN(); peer::combine(F, PART, E16, GT, (const float*)(ws + WS_RSU), (const float*)(ws + WS_RSV), AT, (unsigned*)A8HI, (unsigned*)A8LO, ASC); } SEAM(11);
#else
    if (IN(11)) { PHASE_BEGIN(); peer::combine(F, PART, E16, GT, (const float*)(ws + WS_RSU), (const float*)(ws + WS_RSV), AT); } SEAM(11);
#endif
#if VACC_MFMA
    if (IN(12)) { PHASE_BEGIN(); peer::vacc_mfma(F, ws + WS_VB, E16, A8HI, A8LO, ASC, args.out); }
#else
    if (IN(12)) { PHASE_BEGIN(); peer::vacc(F, ws + WS_VB, E16, AT, args.out); }
#endif
#if IX_VERIFY || ATT_VERIFY
    if (IN(12)) { __syncthreads(); if (__hip_atomic_load(ctl + 2048, __ATOMIC_RELAXED, __HIP_MEMORY_SCOPE_AGENT) != 0u) { args.out[(size_t)blockIdx.x * 512 + threadIdx.x] = __builtin_nanf(""); } }
#endif
#undef IN
#undef SEAM
}

extern "C" void kernel_launch(void* const* d_in, const int* in_sizes, int n_in, void* d_out, int out_size, void* d_ws, size_t ws_size, hipStream_t stream) {
    static int grid = 0;
    if (grid == 0) {
        if (n_in != 19 || out_size != NTOK * DM || ws_size < WS_END) { fprintf(stderr, "kernel_launch: unexpected shapes (n_in %d out %d ws %zu)\n", n_in, out_size, ws_size); grid = -1; return; }
        int dev = 0, cus = 0;
        if (hipGetDevice(&dev) != hipSuccess || hipDeviceGetAttribute(&cus, hipDeviceAttributeMultiprocessorCount, dev) != hipSuccess) { grid = -1; return; }
        if (hipFuncSetAttribute((const void*)fwd_kernel, hipFuncAttributeMaxDynamicSharedMemorySize, LDS_BYTES) != hipSuccess) { fprintf(stderr, "kernel_launch: hipFuncSetAttribute failed\n"); grid = -1; return; }
        int per_cu = 0;
        if (hipOccupancyMaxActiveBlocksPerMultiprocessor(&per_cu, (const void*)fwd_kernel, NWAVES * 64, LDS_BYTES) != hipSuccess || per_cu < 1) { fprintf(stderr, "kernel_launch: occupancy query reports %d workgroups per CU for %d threads / %d B LDS; nothing launched\n", per_cu, NWAVES * 64, LDS_BYTES); grid = -1; return; }
        (void)hipGetLastError();
        grid = cus;
    }
    if (grid < 0) return;
    (void)hipMemsetAsync((char*)d_ws + WS_CTL, 0, CTL_ZERO_BYTES, stream);
    Args a{};
    a.x = (const float*)d_in[0]; a.mem = (const float*)d_in[1]; a.attn_g = (const float*)d_in[2]; a.w_in = (const float*)d_in[3]; a.q_g = (const float*)d_in[4]; a.k_g = (const float*)d_in[5];
    a.pool_w = (const float*)d_in[6]; a.pool_s = (const float*)d_in[7]; a.mem_g = (const float*)d_in[8]; a.w_kv = (const float*)d_in[9]; a.mq_g = (const float*)d_in[10]; a.mk_g = (const float*)d_in[11];
    a.w_out = (const float*)d_in[12]; a.ffn_g = (const float*)d_in[13]; a.w_q = (const float*)d_in[14]; a.sk1 = (const float*)d_in[15]; a.sk2 = (const float*)d_in[16];
    a.pu = (const float*)d_in[17]; a.pv = (const float*)d_in[18]; a.out = (float*)d_out; a.ws = (unsigned char*)d_ws;
#if MK_ONE_LAUNCH
    a.ph_lo = 0; a.ph_hi = N_PHASES;
    hipLaunchKernelGGL(fwd_kernel, dim3(grid), dim3(NWAVES * 64), LDS_BYTES, stream, a);
#else
    for (int p = 0; p < N_PHASES; ++p) { a.ph_lo = p; a.ph_hi = p + 1; for (int rep = 0; rep < ((PROBE_DUP_MASK >> p) & 1) + 1; ++rep) hipLaunchKernelGGL(fwd_kernel, dim3(grid), dim3(NWAVES * 64), LDS_BYTES, stream, a); }
#endif
}
```

```cpp
#include <hip/hip_runtime.h>
#include <hip/hip_bf16.h>
#include <cstdio>
#include <cstdint>

#ifndef IX_VERIFY
#define IX_VERIFY 0
#endif
#ifndef ATT_VERIFY
#define ATT_VERIFY 0
#endif
#ifndef PROBE_DUP_MASK
#define PROBE_DUP_MASK 0
#endif
#ifndef MK_ONE_LAUNCH
#define MK_ONE_LAUNCH 1
#endif
#ifndef P1_FP8
#define P1_FP8 1
#endif
#ifndef QK_FP8
#define QK_FP8 1
#endif
#ifndef PV_FP8
#define PV_FP8 1
#endif
#ifndef P5_FP8
#define P5_FP8 1
#endif
#ifndef UDOT_MFMA
#define UDOT_MFMA 1
#endif
#ifndef VACC_MFMA
#define VACC_MFMA 1
#endif
#ifndef PART_BF16
#define PART_BF16 1
#endif
#ifndef P7_FP8
#define P7_FP8 1
#endif

#if ATT_VERIFY && P5_FP8
#error "ATT_VERIFY reads the bf16 MIX: build it with -DP5_FP8=0"
#endif
#if PART_BF16 && !UDOT_MFMA
#error "PART_BF16 is implemented for the UDOT_MFMA path only"
#endif
#if UDOT_MFMA && !P7_FP8
#error "UDOT_MFMA drops the bf16 HN: it needs P7_FP8"
#endif
#define GAS __attribute__((address_space(1)))
#define LAS __attribute__((address_space(3)))
typedef unsigned short bf16_t;
typedef short bf16x8 __attribute__((ext_vector_type(8)));
typedef short s16x4 __attribute__((ext_vector_type(4)));
typedef float f32x4 __attribute__((ext_vector_type(4)));
typedef float f32x2 __attribute__((ext_vector_type(2)));
typedef float f32x16 __attribute__((ext_vector_type(16)));
typedef unsigned u32x4 __attribute__((ext_vector_type(4)));
typedef unsigned u32x2 __attribute__((ext_vector_type(2)));
typedef __bf16 bf16x2_t __attribute__((ext_vector_type(2)));
typedef short s16x2 __attribute__((ext_vector_type(2)));
typedef int i32x8 __attribute__((ext_vector_type(8)));
typedef int i32x4 __attribute__((ext_vector_type(4)));

constexpr int BATCH = 2, SEQ = 16384, DM = 2048, NTOK = BATCH * SEQ, MEMLEN = 256;
constexpr int IN_W = 5200, ZLD = 5376;
constexpr int ZC_Q = 0, ZC_K = 1024, ZC_V = 2048, ZC_QI = 3072, ZC_PU = 4096, ZC_QM = 4608, ZC_KI = 5120, ZC_WI = 5184;
constexpr int NEXP = 16384;
constexpr float EPS = 1e-6f;
constexpr int MASK_WPR = 512;

constexpr size_t MiB = 1u << 20;
constexpr size_t WS_CTL = 0, CTL_ZERO_BYTES = 1 * MiB;
constexpr size_t WS_BT_IN = 2 * MiB;
constexpr size_t WS_BT_OUT = 24 * MiB;
constexpr size_t WS_BT_Q = 32 * MiB;
constexpr size_t WS_BT_KV = 40 * MiB;
constexpr size_t WS_MN = 44 * MiB;
constexpr size_t WS_KVM = 46 * MiB;
constexpr size_t WS_PK = 47 * MiB;
constexpr size_t WS_PWT = 47 * MiB + 512 * 1024;
constexpr size_t WS_XN = 48 * MiB;
constexpr size_t WS_Z = 176 * MiB;
constexpr size_t WS_MASK = 512 * MiB;
constexpr size_t WS_UB = 576 * MiB;
constexpr size_t WS_VB = 640 * MiB;
constexpr size_t WS_RSU = 47 * MiB + 128 * 1024, WS_RSV = 47 * MiB + 256 * 1024;
constexpr size_t WS_ROPE = 704 * MiB;
constexpr size_t WS_CAND = 720 * MiB;
constexpr size_t WS_Q8 = WS_UB, WS_K8 = WS_UB + 32 * MiB;
constexpr size_t WS_KI = WS_VB + 32 * MiB;
constexpr size_t WS_V8T = WS_VB;
constexpr size_t WS_XN8 = WS_CAND, WS_BTIN8 = WS_CAND + 72 * MiB, WS_CSI = WS_CAND + 84 * MiB;
constexpr size_t WS_HN8LO = WS_Z;
constexpr size_t WS_HN8 = WS_CAND, WS_BTQ8 = WS_CAND + 64 * MiB, WS_CSQ = WS_CAND + 68 * MiB;
constexpr size_t WS_BTOUT8 = 848 * MiB, WS_CSO = 852 * MiB;
constexpr size_t WS_MIX8 = WS_CAND;
constexpr float MIX8_SCALE = 16.f;
constexpr size_t WS_END = 856 * MiB;
constexpr int CW_BAR = 4096;

#define LDS_WAIT() asm volatile("s_waitcnt lgkmcnt(0)" ::: "memory")
#define VM_WAIT() asm volatile("s_waitcnt vmcnt(0)" ::: "memory")
__device__ __forceinline__ unsigned cvtpk(float lo, float hi) { f32x2 v = {lo, hi}; bf16x2_t b = __builtin_convertvector(v, bf16x2_t); return __builtin_bit_cast(unsigned, b); }
__device__ __forceinline__ float bflo(unsigned w) { return __uint_as_float(w << 16); }
__device__ __forceinline__ float bfhi(unsigned w) { return __uint_as_float(w & 0xffff0000u); }
__device__ __forceinline__ float wave_sum(float v) {
#pragma unroll
    for (int o = 1; o < 64; o <<= 1) v += __shfl_xor(v, o);
    return v;
}
__device__ __forceinline__ unsigned char to_fp8(float v) { return (unsigned char)(__builtin_amdgcn_cvt_pk_fp8_f32(__builtin_amdgcn_fmed3f(v, -448.f, 448.f), 0.f, 0, false) & 0xff); }
__device__ __forceinline__ unsigned f2ord(float s) { unsigned u = __float_as_uint(s); return u ^ (((unsigned)((int)u >> 31)) | 0x80000000u); }

namespace pg8 {
#define PG8_LAS __attribute__((address_space(3)))
constexpr int BM = 256, BK = 64, HALF = 128, HTB = HALF * BK * 2, STAGE_BYTES = 8 * HTB, NXCD = 8, WGM = 8;
__host__ __device__ __forceinline__ int lds_byte(int r, int c) { const int st = (r >> 4) * 2 + (c >> 5), rr = r & 15, cc = c & 31, ob = rr * 64 + cc * 2; return st * 1024 + (ob ^ (((ob >> 9) & 1) << 5)); }
__host__ __device__ __forceinline__ void stage_rc(int b, int& R, int& C) { const int st = b / 1024, sb = b % 1024, swz = sb ^ (((sb >> 9) & 1) << 5); R = (st >> 1) * 16 + swz / 64; C = (st & 1) * 32 + (swz % 64) / 2; }
__host__ __device__ __forceinline__ int perm32(int rho) { const int n = rho >> 4, i = rho & 15; return 8 * (i >> 2) + 4 * n + (i & 3); }
struct Unit { int pm, pn; };
struct Gemm { const bf16_t* A; const bf16_t* Bt; int M, N, K; };
struct StaticOrder {
    int nM, nN, nwg, G, c;
    __host__ __device__ void init(int M, int N, int G_, int c_) { nM = M / BM; nN = N / BM; nwg = nM * nN; G = G_; c = c_; }
    __host__ __device__ bool next(int i, Unit& u) const {
        const long L = (long)i * G + c; if (L >= nwg) return false;
        int wgid = (int)L; { const int q = nwg / NXCD, r = nwg % NXCD, xcd = wgid % NXCD, off = wgid / NXCD; wgid = (xcd < r ? xcd * (q + 1) : r * (q + 1) + (xcd - r) * q) + off; }
        const int nig = WGM * nN, gid = wgid / nig, fm = gid * WGM, gsz = (nM - fm) < WGM ? (nM - fm) : WGM;
        u.pm = fm + ((wgid % nig) % gsz); u.pn = (wgid % nig) / gsz; return true;
    }
    __device__ __forceinline__ void a_ready(const Unit&) const {}
    __device__ __forceinline__ void done(const Unit&) const {}
};
struct InBf16Order {
    StaticOrder S;
    __host__ __device__ void init(int M, int G_, int c_) { S.init(M, 5 * BM, G_, c_); }
    __host__ __device__ bool next(int i, Unit& u) const { if (!S.next(i, u)) return false; u.pn = u.pn < 4 ? 12 + u.pn : 20; return true; }
    __device__ __forceinline__ void a_ready(const Unit&) const {}
    __device__ __forceinline__ void done(const Unit&) const {}
};
struct InFp8Order {
    StaticOrder S; int G, c;
    __host__ __device__ void init(int M, int G_, int c_) { S.init(M, 16 * BM, 1, 0); G = G_; c = c_; }
    __host__ __device__ bool next(int i, Unit& u) const {
        long L;
        if (G == 256 && S.nwg == 2048) {
            if (i < 7) L = (long)i * 256 + c;
            else { const int j = i - 7; int base, cnt;
                if (c < 16) { base = c; cnt = 1; } else if (c < 136) { base = 0; cnt = 0; } else { base = 16 + (c - 136) * 2; cnt = 2; }
                if (j >= cnt) return false; L = 1792 + base + j; }
        } else { L = (long)i * G + c; if (L >= S.nwg) return false; }
        if (!S.next((int)L, u)) return false;
        u.pn = u.pn < 12 ? u.pn : u.pn + 4; return true;
    }
    __device__ __forceinline__ void a_ready(const Unit&) const {}
    __device__ __forceinline__ void done(const Unit&) const {}
};
struct EpiBf16 {
    static constexpr bool PERM = true, AFTER_DRAIN = false;
    bf16_t* O; int ldc;
    __device__ __forceinline__ void operator()(const f32x4 (&acc)[2][2][4][2], const Unit& u, int wr, int wc, int fr, int fq) const {
        const int row0 = u.pm * BM + wr * 64 + fr; const int col0 = u.pn * BM + wc * 32 + 8 * fq;
#pragma unroll
        for (int ai = 0; ai < 2; ++ai)
#pragma unroll
            for (int m = 0; m < 4; ++m) { bf16_t* rowp = O + (size_t)(row0 + ai * HALF + m * 16) * ldc + col0;
#pragma unroll
                for (int bj = 0; bj < 2; ++bj) { const f32x4 v0 = acc[ai][bj][m][0], v1 = acc[ai][bj][m][1];
                    u32x4 w; w.x = cvtpk(v0[0], v0[1]); w.y = cvtpk(v0[2], v0[3]); w.z = cvtpk(v1[0], v1[1]); w.w = cvtpk(v1[2], v1[3]);
                    *(u32x4*)(rowp + bj * HALF) = w; } }
    }
};
struct EpiBf16S {
    static constexpr bool PERM = true, AFTER_DRAIN = false;
    bf16_t* O; int ldc; const float* cs;
    __device__ __forceinline__ void operator()(const f32x4 (&acc)[2][2][4][2], const Unit& u, int wr, int wc, int fr, int fq) const {
        const int row0 = u.pm * BM + wr * 64 + fr; const int col0 = u.pn * BM + wc * 32 + 8 * fq;
        f32x4 s[2][2];
#pragma unroll
        for (int bj = 0; bj < 2; ++bj) { s[bj][0] = *(const f32x4*)(cs + col0 + bj * HALF); s[bj][1] = *(const f32x4*)(cs + col0 + bj * HALF + 4); }
#pragma unroll
        for (int ai = 0; ai < 2; ++ai)
#pragma unroll
            for (int m = 0; m < 4; ++m) { bf16_t* rowp = O + (size_t)(row0 + ai * HALF + m * 16) * ldc + col0;
#pragma unroll
                for (int bj = 0; bj < 2; ++bj) { const f32x4 v0 = acc[ai][bj][m][0] * s[bj][0], v1 = acc[ai][bj][m][1] * s[bj][1];
                    u32x4 w; w.x = cvtpk(v0[0], v0[1]); w.y = cvtpk(v0[2], v0[3]); w.z = cvtpk(v1[0], v1[1]); w.w = cvtpk(v1[2], v1[3]);
                    *(u32x4*)(rowp + bj * HALF) = w; } }
    }
};
struct EpiF32Res {
    static constexpr bool PERM = false, AFTER_DRAIN = false;
    const float* R; float* C; int ldc;
    __device__ __forceinline__ void operator()(const f32x4 (&acc)[2][2][4][2], const Unit& u, int wr, int wc, int fr, int fq) const {
        const int row0 = u.pm * BM + wr * 64 + fr, col0 = u.pn * BM + wc * 32 + 4 * fq;
#pragma unroll
        for (int ai = 0; ai < 2; ++ai)
#pragma unroll
            for (int m = 0; m < 4; ++m) { const size_t off = (size_t)(row0 + ai * HALF + m * 16) * ldc + col0;
#pragma unroll
                for (int bj = 0; bj < 2; ++bj)
#pragma unroll
                    for (int n = 0; n < 2; ++n) *(f32x4*)(C + off + bj * HALF + n * 16) = acc[ai][bj][m][n] + *(const f32x4*)(R + off + bj * HALF + n * 16); }
    }
};

struct EpiF32ResS {
    static constexpr bool PERM = false, AFTER_DRAIN = false;
    const float* R; float* C; int ldc; const float* cs;
    __device__ __forceinline__ void operator()(const f32x4 (&acc)[2][2][4][2], const Unit& u, int wr, int wc, int fr, int fq) const {
        const int row0 = u.pm * BM + wr * 64 + fr, col0 = u.pn * BM + wc * 32 + 4 * fq;
        f32x4 s[2][2];
#pragma unroll
        for (int bj = 0; bj < 2; ++bj)
#pragma unroll
            for (int n = 0; n < 2; ++n) s[bj][n] = *(const f32x4*)(cs + col0 + bj * HALF + n * 16);
#pragma unroll
        for (int ai = 0; ai < 2; ++ai)
#pragma unroll
            for (int m = 0; m < 4; ++m) { const size_t off = (size_t)(row0 + ai * HALF + m * 16) * ldc + col0;
#pragma unroll
                for (int bj = 0; bj < 2; ++bj)
#pragma unroll
                    for (int n = 0; n < 2; ++n) *(f32x4*)(C + off + bj * HALF + n * 16) = acc[ai][bj][m][n] * s[bj][n] + *(const f32x4*)(R + off + bj * HALF + n * 16); }
    }
};
__device__ __forceinline__ i32x8 cat8(bf16x8 a, bf16x8 b) { const i32x4 x = __builtin_bit_cast(i32x4, a), y = __builtin_bit_cast(i32x4, b); return __builtin_shufflevector(x, y, 0, 1, 2, 3, 4, 5, 6, 7); }
template <class Epi, class Sched, bool ALIGN_EPI = false, bool SP2 = false, bool F8 = false>
__device__ __forceinline__ void gemm_phase(PG8_LAS unsigned char* lds, const Gemm g, const Sched& S, const Epi& E) {
    const int tid = threadIdx.x, wid = __builtin_amdgcn_readfirstlane(tid >> 6), lane = tid & 63, wr = wid >> 2, wc = wid & 3, fr = lane & 15, fq = lane >> 4;
    const int K = g.K, nt = K / BK;
    unsigned voffA[2], voffB[2];
#pragma unroll
    for (int i = 0; i < 2; ++i) { int R, C; stage_rc(tid * 16 + i * 8192, R, C); const int Rb = Epi::PERM ? ((R & ~31) + perm32(R & 31)) : R;
        voffA[i] = (unsigned)(R * K + C) * 2u; voffB[i] = (unsigned)(Rb * K + C) * 2u; }
    const size_t kstep = (size_t)(BK * 2);
    const size_t hstep = (size_t)HALF * K * 2;
    const size_t tstep = 2 * hstep;
    const unsigned ldsw = (unsigned)wid * 1024u;
    const int aoff_ = lds_byte(wr * 64 + fr, fq * 8), boff_ = lds_byte(wc * 32 + fr, fq * 8);
#define PG8_SA(b, h) (((b) * 2 + (h)) * HTB)
#define PG8_SB(b, h) ((4 + (b) * 2 + (h)) * HTB)
#define PG8_STAGE(bufoff, gbase, voff) do { _Pragma("unroll") for (int _i = 0; _i < 2; ++_i) \
        __builtin_amdgcn_global_load_lds((const unsigned*)((const char*)(gbase) + (voff)[_i]), (PG8_LAS unsigned*)(lds + (bufoff) + ldsw + _i * 8192), 16, 0, 0); } while (0)
#define PG8_LD1(off) (*(const PG8_LAS bf16x8*)(lds + (off)))
#define PG8_LDA(dst, b, h) do { _Pragma("unroll") for (int m = 0; m < 4; ++m) { if constexpr (F8) dst##8[m] = cat8(PG8_LD1(PG8_SA(b, h) + aoff + m * 2048), PG8_LD1(PG8_SA(b, h) + aoff + m * 2048 + 1024)); \
        else { _Pragma("unroll") for (int k = 0; k < 2; ++k) dst[m][k] = PG8_LD1(PG8_SA(b, h) + aoff + m * 2048 + k * 1024); } } } while (0)
#define PG8_LDB(dst, b, h) do { _Pragma("unroll") for (int n = 0; n < 2; ++n) { if constexpr (F8) dst##8[n] = cat8(PG8_LD1(PG8_SB(b, h) + boff + n * 2048), PG8_LD1(PG8_SB(b, h) + boff + n * 2048 + 1024)); \
        else { _Pragma("unroll") for (int k = 0; k < 2; ++k) dst[n][k] = PG8_LD1(PG8_SB(b, h) + boff + n * 2048 + k * 1024); } } } while (0)
#define PG8_MMA(ai, bj, At, Bt) do { __builtin_amdgcn_s_setprio(1); _Pragma("unroll") for (int m = 0; m < 4; ++m) _Pragma("unroll") for (int n = 0; n < 2; ++n) { \
        if constexpr (F8) asm volatile("v_mfma_f32_16x16x128_f8f6f4 %0, %1, %2, %0" : "+v"(acc[ai][bj][m][n]) : "v"(Bt##8[n]), "v"(At##8[m])); \
        else { _Pragma("unroll") for (int k = 0; k < 2; ++k) acc[ai][bj][m][n] = __builtin_amdgcn_mfma_f32_16x16x32_bf16(Bt[n][k], At[m][k], acc[ai][bj][m][n], 0, 0, 0); } } __builtin_amdgcn_s_setprio(0); } while (0)
#define PG8_WAIT_V(n) asm volatile("s_waitcnt vmcnt(" #n ")" ::: "memory")
#define PG8_WAIT_L(n) asm volatile("s_waitcnt lgkmcnt(" #n ")" ::: "memory")
#define PG8_BAR __builtin_amdgcn_s_barrier()
#define PG8_SCHED __builtin_amdgcn_sched_barrier(0)
    Unit cur, nxt; int ui = 0;
    if (!S.next(0, cur)) return;
    f32x4 acc[2][2][4][2];
#pragma unroll
    for (int a = 0; a < 2; ++a)
#pragma unroll
        for (int b = 0; b < 2; ++b)
#pragma unroll
            for (int m = 0; m < 4; ++m)
#pragma unroll
                for (int n = 0; n < 2; ++n) acc[a][b][m][n] = (f32x4){0.f, 0.f, 0.f, 0.f};
    bf16x8 At[4][2], B0[2][2], B1[2][2]; i32x8 At8[4], B08[2], B18[2];
    const char* cA = (const char*)g.A + (size_t)cur.pm * tstep; const char* cB = (const char*)g.Bt + (size_t)cur.pn * tstep;
    S.a_ready(cur);
    if constexpr (SP2) {
        PG8_STAGE(PG8_SB(0, 0), cB, voffB); PG8_STAGE(PG8_SB(0, 1), cB + hstep, voffB); PG8_STAGE(PG8_SA(0, 0), cA, voffA); PG8_STAGE(PG8_SA(0, 1), cA + hstep, voffA);
        if (wr == 1) PG8_BAR;
        PG8_WAIT_V(2); PG8_BAR;
        PG8_STAGE(PG8_SB(1, 0), cB + kstep, voffB); PG8_STAGE(PG8_SA(1, 0), cA + kstep, voffA); PG8_STAGE(PG8_SB(1, 1), cB + hstep + kstep, voffB);
        PG8_WAIT_V(6); PG8_BAR;
    } else {
        PG8_STAGE(PG8_SB(0, 0), cB, voffB); PG8_STAGE(PG8_SA(0, 0), cA, voffA); PG8_STAGE(PG8_SB(0, 1), cB + hstep, voffB); PG8_STAGE(PG8_SA(0, 1), cA + hstep, voffA);
        if (wr == 1) PG8_BAR;
        PG8_WAIT_V(4); PG8_BAR;
        PG8_STAGE(PG8_SB(1, 0), cB + kstep, voffB); PG8_STAGE(PG8_SA(1, 0), cA + kstep, voffA); PG8_STAGE(PG8_SB(1, 1), cB + hstep + kstep, voffB);
        PG8_WAIT_V(6); PG8_BAR;
    }
    for (;;) {
        const bool has_next = S.next(ui + 1, nxt);
        const char* nA = has_next ? (const char*)g.A + (size_t)nxt.pm * tstep : cA; const char* nB = has_next ? (const char*)g.Bt + (size_t)nxt.pn * tstep : cB;
        for (int t = 0; t < nt; t += 2) {
            const bool last = (t == nt - 2);
            int aoff = aoff_, boff = boff_; if constexpr (F8) asm volatile("" : "+v"(aoff), "+v"(boff));
            const char* a1 = cA + (size_t)(t + 1) * kstep;
            const char* a2 = last ? nA : cA + (size_t)(t + 2) * kstep; const char* b2 = last ? nB : cB + (size_t)(t + 2) * kstep;
            const char* a3 = a2 + kstep; const char* b3 = b2 + kstep;
            if (last && has_next) S.a_ready(nxt);
            if constexpr (SP2) {
            PG8_LDB(B0, 0, 0); PG8_LDB(B1, 0, 1); PG8_SCHED; PG8_LDA(At, 0, 0); PG8_STAGE(PG8_SA(1, 1), a1 + hstep, voffA);
            PG8_WAIT_V(8); PG8_WAIT_L(0); PG8_BAR; PG8_MMA(0, 0, At, B0); PG8_MMA(0, 1, At, B1); PG8_BAR; PG8_SCHED;
            PG8_LDA(At, 0, 1); PG8_STAGE(PG8_SB(0, 0), b2, voffB); PG8_STAGE(PG8_SB(0, 1), b2 + hstep, voffB); PG8_STAGE(PG8_SA(0, 0), a2, voffA);
            PG8_WAIT_V(8); PG8_WAIT_L(0); PG8_BAR; PG8_MMA(1, 0, At, B0); PG8_MMA(1, 1, At, B1); PG8_BAR; PG8_SCHED;
            PG8_LDB(B0, 1, 0); PG8_LDB(B1, 1, 1); PG8_SCHED; PG8_LDA(At, 1, 0); PG8_STAGE(PG8_SA(0, 1), a2 + hstep, voffA);
            PG8_WAIT_V(8); PG8_WAIT_L(0); PG8_BAR; PG8_MMA(0, 0, At, B0); PG8_MMA(0, 1, At, B1); PG8_BAR; PG8_SCHED;
            PG8_LDA(At, 1, 1); PG8_STAGE(PG8_SB(1, 0), b3, voffB); PG8_STAGE(PG8_SB(1, 1), b3 + hstep, voffB); PG8_STAGE(PG8_SA(1, 0), a3, voffA);
            PG8_WAIT_V(8); PG8_WAIT_L(0); PG8_BAR; PG8_MMA(1, 0, At, B0); PG8_MMA(1, 1, At, B1); PG8_BAR; PG8_SCHED;
            } else {
            PG8_LDB(B0, 0, 0); PG8_SCHED; PG8_LDA(At, 0, 0); PG8_STAGE(PG8_SA(1, 1), a1 + hstep, voffA);
            PG8_WAIT_L(8); PG8_BAR; PG8_WAIT_L(0); PG8_MMA(0, 0, At, B0); PG8_BAR; PG8_SCHED;
            PG8_LDB(B1, 0, 1); PG8_STAGE(PG8_SB(0, 0), b2, voffB);
            PG8_BAR; PG8_WAIT_L(0); PG8_MMA(0, 1, At, B1); PG8_BAR;
            PG8_LDA(At, 0, 1); PG8_STAGE(PG8_SA(0, 0), a2, voffA);
            PG8_BAR; PG8_WAIT_L(0); PG8_MMA(1, 0, At, B0); PG8_BAR; PG8_SCHED;
            PG8_STAGE(PG8_SB(0, 1), b2 + hstep, voffB);
            PG8_WAIT_V(6); PG8_BAR; PG8_MMA(1, 1, At, B1); PG8_BAR;
            PG8_LDB(B0, 1, 0); PG8_SCHED; PG8_LDA(At, 1, 0); PG8_STAGE(PG8_SA(0, 1), a2 + hstep, voffA);
            PG8_WAIT_L(8); PG8_BAR; PG8_WAIT_L(0); PG8_MMA(0, 0, At, B0); PG8_BAR; PG8_SCHED;
            PG8_LDB(B1, 1, 1); PG8_STAGE(PG8_SB(1, 0), b3, voffB);
            PG8_BAR; PG8_WAIT_L(0); PG8_MMA(0, 1, At, B1); PG8_BAR;
            PG8_LDA(At, 1, 1); PG8_STAGE(PG8_SA(1, 0), a3, voffA);
            PG8_BAR; PG8_WAIT_L(0); PG8_MMA(1, 0, At, B0); PG8_BAR; PG8_SCHED;
            PG8_STAGE(PG8_SB(1, 1), b3 + hstep, voffB);
            PG8_WAIT_V(6); PG8_BAR; PG8_MMA(1, 1, At, B1); PG8_BAR;
            }
        }
        if constexpr (ALIGN_EPI) { if (wr == 0) PG8_BAR; }
        if constexpr (F8) asm volatile("s_nop 15\n\ts_nop 15" ::: "memory");
        if constexpr (!Epi::AFTER_DRAIN) { E(acc, cur, wr, wc, fr, fq); S.done(cur); }
        if (!has_next) break;
#pragma unroll
        for (int a = 0; a < 2; ++a)
#pragma unroll
            for (int b = 0; b < 2; ++b)
#pragma unroll
                for (int m = 0; m < 4; ++m)
#pragma unroll
                    for (int n = 0; n < 2; ++n) acc[a][b][m][n] = (f32x4){0.f, 0.f, 0.f, 0.f};
        cur = nxt; cA = nA; cB = nB; ++ui;
        if constexpr (ALIGN_EPI) { if (wr == 1) PG8_BAR; }
    }
    PG8_WAIT_V(0);
    if constexpr (!ALIGN_EPI) { if (wr == 0) PG8_BAR; }
    PG8_BAR;
#undef PG8_SA
#undef PG8_SB
#undef PG8_STAGE
#undef PG8_LDA
#undef PG8_LD1
#undef PG8_LDB
#undef PG8_MMA
#undef PG8_WAIT_V
#undef PG8_WAIT_L
#undef PG8_BAR
#undef PG8_SCHED
}
}

namespace att {
constexpr int D = 128, NW = 8, QBLK = 32, KVBLK = 64;
constexpr float SCALE = 0.088388347648318440f;
constexpr size_t SHM_V = KVBLK * D * 2, SHM_K = KVBLK * D * 2, SHM_ATTN = 2 * SHM_V + 2 * SHM_K + NW * 64 * 4;
#define KSWZ(row, colB) ((row) * 256 + ((colB) ^ (((row) & 7) << 4)))
#define KSWZ8(row, colB) ((row) * 128 + ((colB) ^ ((((row) >> 1) & 7) << 4)))
#define SBAR() __builtin_amdgcn_sched_barrier(0)
__device__ __forceinline__ int crow(int r, int hi) { return (r & 3) + 8 * (r >> 2) + 4 * hi; }
template <bool MASKED> __device__ __forceinline__ void mask_apply(f32x16& p, unsigned w) {
    if constexpr (MASKED) {
#pragma unroll
        for (int r = 0; r < 16; ++r) { const unsigned m = (unsigned)__builtin_amdgcn_sbfe((int)w, (unsigned)((r & 3) + 8 * (r >> 2)), 1u); p[r] = __uint_as_float((__float_as_uint(p[r]) & m) | (0xFF800000u & ~m)); }
    }
}
template <bool MASKED, bool P8 = false> __device__ __forceinline__ void partialSM(f32x16& p0, f32x16& p1, float& m_reg, float& mn, float& alpha, unsigned long long mk, int sh4) {
    constexpr float C = SCALE * 1.4426950408889634f; constexpr float THR = P8 ? 5.f : 8.f;
    float pmax = p0[0];
#pragma unroll
    for (int r = 1; r < 16; ++r) pmax = fmaxf(pmax, p0[r]);
#pragma unroll
    for (int r = 0; r < 16; ++r) pmax = fmaxf(pmax, p1[r]);
    { auto rr = __builtin_amdgcn_permlane32_swap(__float_as_uint(pmax), __float_as_uint(pmax), false, false);
      pmax = fmaxf(__uint_as_float(rr[0]), __uint_as_float(rr[1])); }
    if (__builtin_expect(__all(pmax - m_reg <= THR / SCALE), 1)) { mn = m_reg; alpha = 1.f; }
    else { mn = fmaxf(m_reg, pmax); alpha = __builtin_amdgcn_exp2f((m_reg - mn) * C); m_reg = mn; }
    const float mnC = -mn * C;
#pragma unroll
    for (int r = 0; r < 16; ++r) p0[r] = fmaf(p0[r], C, mnC);
#pragma unroll
    for (int r = 0; r < 16; ++r) p1[r] = fmaf(p1[r], C, mnC);
#pragma unroll
    for (int r = 0; r < 16; ++r) p0[r] = __builtin_amdgcn_exp2f(p0[r]);
}
template <bool MASKED> __device__ __forceinline__ void finishSM(f32x16& p0, f32x16& p1, float alpha, float& l_reg, bf16x8& pa0, bf16x8& pa1, bf16x8& pa2, bf16x8& pa3, unsigned long long mk, int sh4) {
#pragma unroll
    for (int r = 0; r < 16; ++r) p1[r] = __builtin_amdgcn_exp2f(p1[r]);
    float ps = 0;
#pragma unroll
    for (int r = 0; r < 16; ++r) ps += p0[r];
#pragma unroll
    for (int r = 0; r < 16; ++r) ps += p1[r];
    { auto rr = __builtin_amdgcn_permlane32_swap(__float_as_uint(ps), __float_as_uint(ps), false, false);
      ps = __uint_as_float(rr[0]) + __uint_as_float(rr[1]); }
    l_reg = l_reg * alpha + ps;
#define PK4(P, BASE, OUT) do { unsigned a0 = cvtpk(P[BASE + 0], P[BASE + 1]), a1 = cvtpk(P[BASE + 2], P[BASE + 3]);   \
    unsigned b0 = cvtpk(P[BASE + 4], P[BASE + 5]), b1 = cvtpk(P[BASE + 6], P[BASE + 7]);                              \
    auto r0 = __builtin_amdgcn_permlane32_swap(a0, b0, false, false); auto r1 = __builtin_amdgcn_permlane32_swap(a1, b1, false, false); \
    u32x4 w = {r0[0], r1[0], r0[1], r1[1]}; OUT = *reinterpret_cast<bf16x8*>(&w); } while (0)
    PK4(p0, 0, pa0); PK4(p0, 8, pa1); PK4(p1, 0, pa2); PK4(p1, 8, pa3);
#undef PK4
}
__device__ __forceinline__ void finishSM8(f32x16& p0, f32x16& p1, i32x8& pa) {
#pragma unroll
    for (int r = 0; r < 16; ++r) p1[r] = __builtin_amdgcn_exp2f(p1[r]);
#pragma unroll
    for (int q = 0; q < 4; ++q) { int w = __builtin_amdgcn_cvt_pk_fp8_f32(p0[4 * q], p0[4 * q + 1], 0, false); pa[q] = __builtin_amdgcn_cvt_pk_fp8_f32(p0[4 * q + 2], p0[4 * q + 3], w, true);
        int v = __builtin_amdgcn_cvt_pk_fp8_f32(p1[4 * q], p1[4 * q + 1], 0, false); pa[4 + q] = __builtin_amdgcn_cvt_pk_fp8_f32(p1[4 * q + 2], p1[4 * q + 3], v, true); }
}
#define VSWZ8(d, c) ((d) * 64 + ((((c) ^ (((d) >> 2) & 3))) << 4))
__device__ __forceinline__ void pv8(f32x16* o, f32x16& lacc, const char* ones, const char* Vt, const i32x8 pa, int r32, int hi) {
    { const i32x8 ob = pg8::cat8(*reinterpret_cast<const bf16x8*>(ones), *reinterpret_cast<const bf16x8*>(ones + 16));
      lacc = __builtin_amdgcn_mfma_scale_f32_32x32x64_f8f6f4(pa, ob, lacc, 0, 0, 0, 0, 0, 0); }
#pragma unroll
    for (int d0 = 0; d0 < 4; ++d0) { const int d = d0 * 32 + r32;
        const i32x8 vb = pg8::cat8(*reinterpret_cast<const bf16x8*>(Vt + VSWZ8(d, 2 * hi)), *reinterpret_cast<const bf16x8*>(Vt + VSWZ8(d, 2 * hi + 1)));
        o[d0] = __builtin_amdgcn_mfma_scale_f32_32x32x64_f8f6f4(pa, vb, o[d0], 0, 0, 0, 0, 0, 0); }
}
template <bool MASKED> __device__ __forceinline__ void qkt(f32x16& p0, f32x16& p1, const bf16_t* Ks, const bf16x8* qs, int r32, int hi, unsigned long long mk, int sh4, const char* lut) {
    if constexpr (MASKED) {
        const unsigned wl = (unsigned)mk >> sh4, wh = (unsigned)(mk >> 32) >> sh4;
#pragma unroll
        for (int g = 0; g < 4; ++g) { const f32x4 b0 = *(const f32x4*)(lut + ((wl >> (8 * g)) & 15u) * 16), b1 = *(const f32x4*)(lut + ((wh >> (8 * g)) & 15u) * 16);
            p0[4 * g] = b0.x; p0[4 * g + 1] = b0.y; p0[4 * g + 2] = b0.z; p0[4 * g + 3] = b0.w; p1[4 * g] = b1.x; p1[4 * g + 1] = b1.y; p1[4 * g + 2] = b1.z; p1[4 * g + 3] = b1.w; }
    } else { p0 = f32x16{}; p1 = f32x16{}; }
#pragma unroll
    for (int d0 = 0; d0 < 8; ++d0) { int cb = (d0 * 16 + hi * 8) * 2;
        bf16x8 b0 = *reinterpret_cast<const bf16x8*>((const char*)Ks + KSWZ(r32, cb));
        bf16x8 b1 = *reinterpret_cast<const bf16x8*>((const char*)Ks + KSWZ(32 + r32, cb));
        const bf16x8 qf = qs[d0 * 64];
        p0 = __builtin_amdgcn_mfma_f32_32x32x16_bf16(b0, qf, p0, 0, 0, 0);
        p1 = __builtin_amdgcn_mfma_f32_32x32x16_bf16(b1, qf, p1, 0, 0, 0); }
}
template <bool MASKED> __device__ __forceinline__ void qkt8(f32x16& p0, f32x16& p1, const char* Ks, const bf16x8* qs, int r32, int hi, unsigned long long mk, int sh4, const char* lut) {
    if constexpr (MASKED) {
        const unsigned wl = (unsigned)mk >> sh4, wh = (unsigned)(mk >> 32) >> sh4;
#pragma unroll
        for (int g = 0; g < 4; ++g) { const f32x4 b0 = *(const f32x4*)(lut + ((wl >> (8 * g)) & 15u) * 16), b1 = *(const f32x4*)(lut + ((wh >> (8 * g)) & 15u) * 16);
            p0[4 * g] = b0.x; p0[4 * g + 1] = b0.y; p0[4 * g + 2] = b0.z; p0[4 * g + 3] = b0.w; p1[4 * g] = b1.x; p1[4 * g + 1] = b1.y; p1[4 * g + 2] = b1.z; p1[4 * g + 3] = b1.w; }
    } else { p0 = f32x16{}; p1 = f32x16{}; }
#pragma unroll
    for (int s2 = 0; s2 < 2; ++s2) { const int cb = (s2 * 4 + hi * 2) * 16;
        const i32x8 a0 = pg8::cat8(*reinterpret_cast<const bf16x8*>(Ks + KSWZ8(r32, cb)), *reinterpret_cast<const bf16x8*>(Ks + KSWZ8(r32, cb + 16)));
        const i32x8 a1 = pg8::cat8(*reinterpret_cast<const bf16x8*>(Ks + KSWZ8(32 + r32, cb)), *reinterpret_cast<const bf16x8*>(Ks + KSWZ8(32 + r32, cb + 16)));
        const i32x8 qf = pg8::cat8(qs[(2 * s2) * 64], qs[(2 * s2 + 1) * 64]);
        p0 = __builtin_amdgcn_mfma_scale_f32_32x32x64_f8f6f4(a0, qf, p0, 0, 0, 0, 0, 0, 0);
        p1 = __builtin_amdgcn_mfma_scale_f32_32x32x64_f8f6f4(a1, qf, p1, 0, 0, 0, 0, 0, 0); }
}
__device__ __forceinline__ int v_st(int k, int c) { const int kk = (k & ~0xC) | ((k & 4) << 1) | ((k & 8) >> 1); return ((kk >> 3) * 4 + (c >> 5)) * 512 + ((kk & 7) * 32 + (c & 31)) * 2; }
__device__ __forceinline__ int v_rd_base(int lane) { return ((lane & 3) << 3) | (((lane >> 2) & 3) << 6) | (((lane >> 4) & 1) << 5) | (((lane >> 5) & 1) << 8); }
constexpr int v_rd_off(int d0, int ks, int half) { return d0 * 512 + ks * 4096 + half * 2048; }
template <int OFF> __device__ __forceinline__ s16x4 tr_read(int vb) {
    s16x4 r; asm volatile("ds_read_b64_tr_b16 %0, %1 offset:%2" : "=&v"(r) : "v"(vb), "i"(OFF) : "memory"); return r;
}
template <int D0> __device__ __forceinline__ void pv_one(f32x16& od, int vb, bf16x8 pa0, bf16x8 pa1, bf16x8 pa2, bf16x8 pa3) {
    const s16x4 l0 = tr_read<v_rd_off(D0, 0, 0)>(vb), h0 = tr_read<v_rd_off(D0, 0, 1)>(vb), l1 = tr_read<v_rd_off(D0, 1, 0)>(vb), h1 = tr_read<v_rd_off(D0, 1, 1)>(vb);
    const s16x4 l2 = tr_read<v_rd_off(D0, 2, 0)>(vb), h2 = tr_read<v_rd_off(D0, 2, 1)>(vb), l3 = tr_read<v_rd_off(D0, 3, 0)>(vb), h3 = tr_read<v_rd_off(D0, 3, 1)>(vb);
    asm volatile("s_waitcnt lgkmcnt(0)" ::: "memory"); SBAR();
#define PK(L, H) (bf16x8){L[0], L[1], L[2], L[3], H[0], H[1], H[2], H[3]}
    od = __builtin_amdgcn_mfma_f32_32x32x16_bf16(pa0, PK(l0, h0), od, 0, 0, 0);
    od = __builtin_amdgcn_mfma_f32_32x32x16_bf16(pa1, PK(l1, h1), od, 0, 0, 0);
    od = __builtin_amdgcn_mfma_f32_32x32x16_bf16(pa2, PK(l2, h2), od, 0, 0, 0);
    od = __builtin_amdgcn_mfma_f32_32x32x16_bf16(pa3, PK(l3, h3), od, 0, 0, 0);
#undef PK
}
__device__ __forceinline__ void pv_d0(f32x16* o, int vb, bf16x8 pa0, bf16x8 pa1, bf16x8 pa2, bf16x8 pa3) {
    pv_one<0>(o[0], vb, pa0, pa1, pa2, pa3); pv_one<1>(o[1], vb, pa0, pa1, pa2, pa3); pv_one<2>(o[2], vb, pa0, pa1, pa2, pa3); pv_one<3>(o[3], vb, pa0, pa1, pa2, pa3);
}
template <bool MASKED, int SDEPTH, int ldq, int ldk, int ldo, bool QK8 = false, bool PV8 = false>
__device__ __forceinline__ void attn_body(const bf16_t* __restrict__ Qb, const bf16_t* __restrict__ Kh, const bf16_t* __restrict__ Vh,
                                          bf16_t* __restrict__ Ob, int seq, const unsigned long long* __restrict__ mrow, char* lds,
                                          const unsigned char* __restrict__ Q8b = nullptr, const unsigned char* __restrict__ K8h = nullptr, const unsigned char* __restrict__ V8h = nullptr, unsigned char* __restrict__ O8b = nullptr) {
    int tid = (int)threadIdx.x; asm volatile("" : "+v"(tid));
    const int wid = tid >> 6, lane = tid & 63, r32 = lane & 31, hi = lane >> 5, sh4 = 4 * hi;
    bf16_t* V_lds = (bf16_t*)lds; bf16_t* K_lds = (bf16_t*)(lds + 2 * SHM_V);
    float* ws = (float*)(lds + 2 * SHM_V + 2 * SHM_K) + wid * 64; float* li_l = ws; float* al_l = ws + 32;
    float m_reg = -1e30f, l_reg = 0; f32x16 o[4] = {}; f32x16 lacc = {};
    const bf16_t* Qw = Qb + (long)(wid * QBLK + r32) * ldq + hi * 8;
    bf16x8* qr = (bf16x8*)(lds + SHM_ATTN) + wid * 512 + lane;
    if constexpr (QK8) { const unsigned char* Q8w = Q8b + (long)(wid * QBLK + r32) * 1024 + hi * 32;
#pragma unroll
        for (int j = 0; j < 4; ++j) qr[j * 64] = *reinterpret_cast<const bf16x8*>(Q8w + (j >> 1) * 64 + (j & 1) * 16);
    } else {
#pragma unroll
        for (int d0 = 0; d0 < 8; ++d0) qr[d0 * 64] = *reinterpret_cast<const bf16x8*>(Qw + d0 * 16); }
    const char* lut = lds + SHM_ATTN + 65536;
    if (MASKED && tid < 64) ((float*)(lds + SHM_ATTN + 65536))[tid] = ((tid >> 2) >> (tid & 3)) & 1 ? 0.f : -INFINITY;
    const char* ones = lds + SHM_ATTN + 65536 + 256;
    if (PV8 && tid < 8) ((unsigned*)(lds + SHM_ATTN + 65536 + 256))[tid] = 0x38383838u;
    const int sr = tid >> 4, sc = (tid & 15) * 8, vst0 = v_st(sr, sc), vst1 = v_st(32 + sr, sc);
    const int vb0 = (int)(uintptr_t)V_lds + v_rd_base(lane);
    struct { bf16x8 vs0, vs1, ks0, ks1; } sr_[SDEPTH];
    const int kr8 = tid >> 3, kc8 = (tid & 7) * 16;
#define SLOAD(i, k0) do { if constexpr (PV8) sr_[i].vs0 = *reinterpret_cast<const bf16x8*>(V8h + (long)(k0) * 128 + tid * 16); \
    else { sr_[i].vs0 = *reinterpret_cast<const bf16x8*>(&Vh[(long)((k0) + sr) * ldk + sc]); sr_[i].vs1 = *reinterpret_cast<const bf16x8*>(&Vh[(long)((k0) + 32 + sr) * ldk + sc]); } \
    if constexpr (QK8) sr_[i].ks0 = *reinterpret_cast<const bf16x8*>(K8h + (long)((k0) + kr8) * 1024 + kc8); \
    else { sr_[i].ks0 = *reinterpret_cast<const bf16x8*>(&Kh[(long)((k0) + sr) * ldk + sc]); sr_[i].ks1 = *reinterpret_cast<const bf16x8*>(&Kh[(long)((k0) + 32 + sr) * ldk + sc]); } } while (0)
#define SWRITE(b, i) do { if constexpr (PV8) *(bf16x8*)((char*)V_lds + (b) * SHM_V + VSWZ8(tid >> 2, tid & 3)) = sr_[i].vs0; \
    else { *(bf16x8*)((char*)V_lds + (b) * SHM_V + vst0) = sr_[i].vs0;          \
    *(bf16x8*)((char*)V_lds + (b) * SHM_V + vst1) = sr_[i].vs1; } int kc = sc * 2;               \
    if constexpr (QK8) *(bf16x8*)((char*)K_lds + (b) * SHM_K + KSWZ8(kr8, kc8)) = sr_[i].ks0;  \
    else { *(bf16x8*)((char*)K_lds + (b) * SHM_K + KSWZ(sr, kc)) = sr_[i].ks0;                  \
    *(bf16x8*)((char*)K_lds + (b) * SHM_K + KSWZ(32 + sr, kc)) = sr_[i].ks1; } } while (0)
#define SWAIT() do { if constexpr (SDEPTH == 2) { if constexpr (QK8 && PV8) asm volatile("s_waitcnt vmcnt(2)" ::: "memory"); else if constexpr (QK8) asm volatile("s_waitcnt vmcnt(3)" ::: "memory"); else asm volatile("s_waitcnt vmcnt(4)" ::: "memory"); } else asm volatile("s_waitcnt vmcnt(0)" ::: "memory"); } while (0)
#define FIN(P0, P1, AL, MK) do { if constexpr (PV8) finishSM8(P0, P1, pa8); else finishSM<MASKED>(P0, P1, AL, l_reg, pa0, pa1, pa2, pa3, MK, sh4); } while (0)
#define PVD(VOFF) do { if constexpr (PV8) pv8(o, lacc, ones, (const char*)V_lds + (VOFF), pa8, r32, hi); else pv_d0(o, vb0 + (int)(VOFF), pa0, pa1, pa2, pa3); } while (0)
#define QKT(P0, P1, KB, MK) do { if constexpr (QK8) qkt8<MASKED>(P0, P1, (const char*)(KB), qr, r32, hi, MK, sh4, lut); else qkt<MASKED>(P0, P1, (const bf16_t*)(KB), qr, r32, hi, MK, sh4, lut); } while (0)
#define RESC(a) do { if (__any((a) < 1.f)) { if (hi == 0) al_l[r32] = (a); asm volatile("s_waitcnt lgkmcnt(0)" ::: "memory"); \
    _Pragma("unroll") for (int d = 0; d < 4; ++d) _Pragma("unroll") for (int r = 0; r < 16; ++r) o[d][r] *= al_l[crow(r, hi)]; \
    if constexpr (PV8) { _Pragma("unroll") for (int r = 0; r < 16; ++r) lacc[r] *= al_l[crow(r, hi)]; } } } while (0)
    f32x16 pA0, pA1, pB0, pB1; float mnA, mnB, alA, alB; bf16x8 pa0, pa1, pa2, pa3; i32x8 pa8; const int NT = seq / KVBLK;
    unsigned long long mkA = 0, mkB = 0;
    constexpr int SE = 0, SO = SDEPTH - 1;
    if constexpr (MASKED) mkA = mrow[0];
    SLOAD(SE, 0); asm volatile("s_waitcnt vmcnt(0)" ::: "memory"); SWRITE(0, SE); __syncthreads();
    QKT(pA0, pA1, K_lds, mkA); partialSM<MASKED, PV8>(pA0, pA1, m_reg, mnA, alA, mkA, sh4);
    if constexpr (MASKED) mkB = mrow[1];
    SLOAD(SO, KVBLK); if constexpr (SDEPTH == 2) { if (2 < NT) SLOAD(SE, 2 * KVBLK); }
    SWAIT(); SWRITE(1, SO); __syncthreads();
    for (int j = 1; j + 1 < NT; j += 2) {
        SBAR(); QKT(pB0, pB1, (char*)K_lds + SHM_K, mkB);
        FIN(pA0, pA1, alA, mkA); SBAR();
        if constexpr (MASKED) mkA = mrow[j + 1];
        SLOAD(SO, (j + SDEPTH) * KVBLK); SBAR();
        PVD(0); partialSM<MASKED, PV8>(pB0, pB1, m_reg, mnB, alB, mkB, sh4);
        __syncthreads(); SWAIT(); SWRITE(0, SE);
        RESC(alB); __syncthreads();
        SBAR(); QKT(pA0, pA1, K_lds, mkA);
        FIN(pB0, pB1, alB, mkB); SBAR();
        if constexpr (MASKED) mkB = mrow[j + 2 < NT ? j + 2 : NT - 1];
        SLOAD(SE, ((SDEPTH == 1 || j + 3 < NT) ? (j + 1 + SDEPTH) : (NT - 1)) * KVBLK); SBAR();
        PVD(SHM_V); partialSM<MASKED, PV8>(pA0, pA1, m_reg, mnA, alA, mkA, sh4);
        __syncthreads(); SWAIT(); SWRITE(1, SO);
        RESC(alA); __syncthreads();
    }
    SBAR(); QKT(pB0, pB1, (char*)K_lds + SHM_K, mkB);
    FIN(pA0, pA1, alA, mkA); SBAR();
    PVD(0); partialSM<MASKED, PV8>(pB0, pB1, m_reg, mnB, alB, mkB, sh4);
    __syncthreads(); RESC(alB);
    FIN(pB0, pB1, alB, mkB); SBAR();
    PVD(SHM_V);
    float rli[16];
    if constexpr (PV8) {
#pragma unroll
        for (int r = 0; r < 16; ++r) rli[r] = __builtin_amdgcn_rcpf(lacc[r]);
    } else {
        if (hi == 0) li_l[r32] = l_reg; asm volatile("s_waitcnt lgkmcnt(0)" ::: "memory");
#pragma unroll
        for (int r = 0; r < 16; ++r) rli[r] = __builtin_amdgcn_rcpf(li_l[crow(r, hi)]); }
    if (O8b) {
        unsigned char* O8w = O8b + (long)(wid * QBLK) * ldo;
#pragma unroll
        for (int r = 0; r < 16; ++r) { const int orow = crow(r, hi); const float sc8 = rli[r] * MIX8_SCALE;
#pragma unroll
            for (int d0 = 0; d0 < 4; ++d0) O8w[(long)orow * ldo + d0 * 32 + r32] = to_fp8(o[d0][r] * sc8); }
    } else {
    bf16_t* Ow = Ob + (long)(wid * QBLK) * ldo;
#pragma unroll
    for (int r = 0; r < 16; ++r) { const int orow = crow(r, hi);
#pragma unroll
        for (int d0 = 0; d0 < 4; ++d0) Ow[(long)orow * ldo + d0 * 32 + r32] = (bf16_t)(cvtpk(o[d0][r] * rli[r], 0.f) & 0xffffu); }
    }
    __syncthreads();
#undef SLOAD
#undef SWRITE
#undef SWAIT
#undef QKT
#undef FIN
#undef PVD
#undef RESC
}
#undef KSWZ
#undef KSWZ8
#undef VSWZ8
#undef SBAR
}

#define XB_TMO      128
#define XB_XCNT(j)  (256  + 64 * (j))
#define XB_XSUB(j)  (1280 + 64 * (j))
#define XB_XGEN(j)  (2304 + 64 * (j))
#define XB_TOP      3328
#define XB_TOPGEN   3392
#define XCD_BAR_WORDS 3456
#define XB_SPIN_CAP (1u << 22)
__device__ __forceinline__ unsigned xb_ld(unsigned* p)              { return __hip_atomic_load(p, __ATOMIC_RELAXED, __HIP_MEMORY_SCOPE_AGENT); }
__device__ __forceinline__ unsigned xb_add(unsigned* p, unsigned v) { return __hip_atomic_fetch_add(p, v, __ATOMIC_RELAXED, __HIP_MEMORY_SCOPE_AGENT); }
__device__ __forceinline__ unsigned xb_xcc_id() { return (unsigned)__builtin_amdgcn_s_getreg((3 << 11) | 20) & 0xFu; }
#define XB_SPIN(cond, bar) do { unsigned _sp = 0; while (cond) { __builtin_amdgcn_s_sleep(1); \
    if ((++_sp & 255u) == 0u) { if (xb_ld(&(bar)[XB_TMO])) break; if (_sp > XB_SPIN_CAP) { atomicAdd(&(bar)[XB_TMO], 1u); break; } } } } while (0)
struct XcdBarrier { unsigned* bar; unsigned x; volatile LAS unsigned* st; };
__device__ __forceinline__ XcdBarrier xcd_barrier_post(unsigned* bar, volatile LAS unsigned* st) {
    XcdBarrier b; b.bar = bar; b.x = xb_xcc_id(); b.st = st;
    if (threadIdx.x == 0) (void)xb_add(&bar[XB_XCNT(b.x)], 1u);
    return b;
}
__device__ __forceinline__ void xcd_barrier_complete(unsigned* bar, unsigned x, unsigned& nloc, unsigned& nx) {
    const unsigned G = gridDim.x * gridDim.y * gridDim.z;
    unsigned sum, cnt, mine, sp = 0u;
    for (;;) {
        sum = 0u; cnt = 0u; mine = 0u;
#pragma unroll
        for (unsigned j = 0; j < 16; ++j) { const unsigned c = xb_ld(&bar[XB_XCNT(j)]); sum += c; cnt += (c > 0u) ? 1u : 0u; mine = (j == x) ? c : mine; }
        if (sum == G) break;
        __builtin_amdgcn_s_sleep(1);
        if ((++sp & 255u) == 0u) { if (xb_ld(&bar[XB_TMO])) break; if (sp > XB_SPIN_CAP) { atomicAdd(&bar[XB_TMO], 1u); break; } }
    }
    nloc = mine > 0u ? mine : 1u; nx = cnt > 0u ? cnt : 1u;
}
__device__ __forceinline__ void xcd_barrier(const XcdBarrier& b) {
    asm volatile("s_waitcnt vmcnt(0)" ::: "memory");
    __syncthreads();
    if (threadIdx.x == 0) {
        unsigned* bar = b.bar;
        __builtin_amdgcn_s_waitcnt(0);
        unsigned nloc = b.st[0], nx = b.st[1];
        if (nloc == 0u) { xcd_barrier_complete(bar, b.x, nloc, nx); b.st[0] = nloc; b.st[1] = nx; }
        const unsigned old = xb_add(&bar[XB_XSUB(b.x)], 1u);
        const unsigned gen = old / nloc;
        if (old + 1u == (gen + 1u) * nloc) {
            __builtin_amdgcn_fence(__ATOMIC_RELEASE, "agent");
            asm volatile("s_waitcnt vmcnt(0)" ::: "memory");
            const unsigned og = xb_add(&bar[XB_TOP], 1u);
            const unsigned tg = og / nx;
            if (og + 1u == (tg + 1u) * nx) xb_add(&bar[XB_TOPGEN], 1u);
            else XB_SPIN(xb_ld(&bar[XB_TOPGEN]) == tg, bar);
            __builtin_amdgcn_fence(__ATOMIC_ACQUIRE, "agent");
            xb_add(&bar[XB_XGEN(b.x)], 1u);
            asm volatile("s_waitcnt vmcnt(0)" ::: "memory");
        } else {
            XB_SPIN(xb_ld(&bar[XB_XGEN(b.x)]) == gen, bar);
            __builtin_amdgcn_fence(__ATOMIC_ACQUIRE, "agent");
            asm volatile("s_waitcnt vmcnt(0)" ::: "memory");
        }
    }
    __syncthreads();
}

constexpr int NWAVES = 8;
constexpr int RING_BYTES = 151 * 1024;
constexpr int LDSCTL_OFF = RING_BYTES, MISC_OFF = LDSCTL_OFF + 320;
constexpr int LDS_BYTES = 152 * 1024;
static_assert(MISC_OFF + 128 <= LDS_BYTES, "LDS map");
constexpr int N_PHASES = 13;

struct Args {
    const float* x; const float* mem; const float* attn_g; const float* w_in; const float* q_g; const float* k_g; const float* pool_w; const float* pool_s;
    const float* mem_g; const float* w_kv; const float* mq_g; const float* mk_g; const float* w_out; const float* ffn_g; const float* w_q; const float* sk1; const float* sk2;
    const float* pu; const float* pv; float* out; unsigned char* ws; int ph_lo, ph_hi;
};
struct Frame {
    LAS unsigned char* lds; char* ldsg;
    int tid, lane, wave, vcu, G;
};

__device__ __forceinline__ int in_colmap(int n) {
    if (n < 4096) return n;
    if (n < 4608) return 4176 + (n - 4096);
    if (n < 5120) return 4688 + (n - 4608);
    if (n < 5184) return 4096 + (n - 5120);
    if (n < 5200) return 4160 + (n - 5184);
    return -1;
}
template <int MAP> __device__ __forceinline__ void p0_transpose_item(const float* W, int K, int N, bf16_t* WT, LAS float* scr, int kb, int nb, int lane) {
    const int k0 = 64 * kb, n0 = 32 * nb;
    const int c4 = lane & 7, rg = lane >> 3;
    int nsrc = n0 + 4 * c4; if (MAP == 1) nsrc = in_colmap(nsrc);
#pragma unroll
    for (int i = 0; i < 8; ++i) { const int kk = 8 * i + rg; const f32x4 v = nsrc >= 0 ? *(const f32x4*)(W + (size_t)(k0 + kk) * N + nsrc) : (f32x4){0.f, 0.f, 0.f, 0.f};
        LAS float* d = scr + kk * 33 + 4 * c4; d[0] = v.x; d[1] = v.y; d[2] = v.z; d[3] = v.w; }
    LDS_WAIT();
    const int c = lane & 7;
#pragma unroll
    for (int j = 0; j < 4; ++j) { const int n = (lane >> 3) + 8 * j; const LAS float* s = scr + (8 * c) * 33 + n;
        u32x4 o; o.x = cvtpk(s[0 * 33], s[1 * 33]); o.y = cvtpk(s[2 * 33], s[3 * 33]); o.z = cvtpk(s[4 * 33], s[5 * 33]); o.w = cvtpk(s[6 * 33], s[7 * 33]);
        *(u32x4*)(WT + (size_t)(n0 + n) * K + k0 + 8 * c) = o; }
    LDS_WAIT();
}
__device__ __forceinline__ void rms_row_to_bf16(const float* xrow, const float* gain, bf16_t* orow, int lane) {
    const f32x4* xr = (const f32x4*)xrow + lane;
    f32x4 v[8]; float s = 0.f;
#pragma unroll
    for (int j = 0; j < 8; ++j) { v[j] = xr[64 * j]; s += (v[j].x * v[j].x + v[j].y * v[j].y) + (v[j].z * v[j].z + v[j].w * v[j].w); }
    const float rstd = 1.f / sqrtf(wave_sum(s) * (1.f / DM) + EPS);
    unsigned long long* o8 = (unsigned long long*)orow + lane;
#pragma unroll
    for (int j = 0; j < 8; ++j) { const f32x4 g = ((const f32x4*)gain)[lane + 64 * j]; const f32x4 y = v[j] * rstd * g;
        o8[64 * j] = (unsigned long long)cvtpk(y.x, y.y) | ((unsigned long long)cvtpk(y.z, y.w) << 32); }
}
struct RowF32 { f32x4 v[8]; };
__device__ __forceinline__ void row_load(RowF32& R, const float* xrow, int lane) {
    const f32x4* xr = (const f32x4*)xrow + lane;
#pragma unroll
    for (int j = 0; j < 8; ++j) R.v[j] = xr[64 * j];
}
__device__ __forceinline__ void rms_fin_bf16_fp8(const f32x4 (&v)[8], const float* gain, bf16_t* orow, unsigned char* o8row, int lane) {
    float s = 0.f;
#pragma unroll
    for (int j = 0; j < 8; ++j) s += (v[j].x * v[j].x + v[j].y * v[j].y) + (v[j].z * v[j].z + v[j].w * v[j].w);
    const float rstd = 1.f / sqrtf(wave_sum(s) * (1.f / DM) + EPS);
    unsigned long long* o8 = (unsigned long long*)orow + lane; unsigned* q4 = (unsigned*)o8row + lane;
#pragma unroll
    for (int j = 0; j < 8; ++j) { const f32x4 g = ((const f32x4*)gain)[lane + 64 * j]; const f32x4 y = v[j] * rstd * g;
        o8[64 * j] = (unsigned long long)cvtpk(y.x, y.y) | ((unsigned long long)cvtpk(y.z, y.w) << 32);
        int w = __builtin_amdgcn_cvt_pk_fp8_f32(__builtin_amdgcn_fmed3f(y.x, -448.f, 448.f), __builtin_amdgcn_fmed3f(y.y, -448.f, 448.f), 0, false);
        w = __builtin_amdgcn_cvt_pk_fp8_f32(__builtin_amdgcn_fmed3f(y.z, -448.f, 448.f), __builtin_amdgcn_fmed3f(y.w, -448.f, 448.f), w, true); q4[64 * j] = (unsigned)w; }
}
__device__ __forceinline__ void rms_fin_fp8_hilo(const f32x4 (&v)[8], const float* gain, unsigned char* hirow, unsigned char* lorow, int lane) {
    float s = 0.f;
#pragma unroll
    for (int j = 0; j < 8; ++j) s += (v[j].x * v[j].x + v[j].y * v[j].y) + (v[j].z * v[j].z + v[j].w * v[j].w);
    const float rstd = 1.f / sqrtf(wave_sum(s) * (1.f / DM) + EPS);
    unsigned* h4 = (unsigned*)hirow + lane; unsigned* l4 = (unsigned*)lorow + lane;
#pragma unroll
    for (int j = 0; j < 8; ++j) { const f32x4 g = ((const f32x4*)gain)[lane + 64 * j]; f32x4 y = v[j] * rstd * g;
        y.x = __builtin_amdgcn_fmed3f(y.x, -448.f, 448.f); y.y = __builtin_amdgcn_fmed3f(y.y, -448.f, 448.f); y.z = __builtin_amdgcn_fmed3f(y.z, -448.f, 448.f); y.w = __builtin_amdgcn_fmed3f(y.w, -448.f, 448.f);
        int w = __builtin_amdgcn_cvt_pk_fp8_f32(y.x, y.y, 0, false); w = __builtin_amdgcn_cvt_pk_fp8_f32(y.z, y.w, w, true);
        const f32x2 b01 = __builtin_amdgcn_cvt_pk_f32_fp8(w, false), b23 = __builtin_amdgcn_cvt_pk_f32_fp8(w, true);
        int u = __builtin_amdgcn_cvt_pk_fp8_f32(y.x - b01.x, y.y - b01.y, 0, false); u = __builtin_amdgcn_cvt_pk_fp8_f32(y.z - b23.x, y.w - b23.y, u, true);
        h4[64 * j] = (unsigned)w; l4[64 * j] = (unsigned)u; }
}
__device__ __forceinline__ void row_load_bf16(RowF32& R, const bf16_t* brow, int lane) {
    const u32x2* br = (const u32x2*)brow + lane;
#pragma unroll
    for (int j = 0; j < 8; ++j) { const u32x2 w = br[64 * j]; R.v[j] = (f32x4){bflo(w.x), bfhi(w.x), bflo(w.y), bfhi(w.y)}; }
}
__device__ __forceinline__ void row_to_fp8(const RowF32& R, unsigned char* orow, float* inv, int lane) {
    unsigned* o4 = (unsigned*)orow + lane; float am = 0.f;
#pragma unroll
    for (int j = 0; j < 8; ++j) am = fmaxf(am, fmaxf(fmaxf(fabsf(R.v[j].x), fabsf(R.v[j].y)), fmaxf(fabsf(R.v[j].z), fabsf(R.v[j].w))));
#pragma unroll
    for (int o = 1; o < 64; o <<= 1) am = fmaxf(am, __shfl_xor(am, o));
    const float sc = (am > 0.f && am < 3.0e38f) ? exp2f(floorf(log2f(224.f / am))) : 1.f;
#pragma unroll
    for (int j = 0; j < 8; ++j) { int w = __builtin_amdgcn_cvt_pk_fp8_f32(R.v[j].x * sc, R.v[j].y * sc, 0, false); w = __builtin_amdgcn_cvt_pk_fp8_f32(R.v[j].z * sc, R.v[j].w * sc, w, true); o4[64 * j] = (unsigned)w; }
    if (lane == 0) *inv = 1.f / sc;
}
__device__ __forceinline__ void row_to_fp8_sliced(const RowF32& R, unsigned char* tab, int m, float* inv, int lane) {
    float am = 0.f;
#pragma unroll
    for (int j = 0; j < 8; ++j) am = fmaxf(am, fmaxf(fmaxf(fabsf(R.v[j].x), fabsf(R.v[j].y)), fmaxf(fabsf(R.v[j].z), fabsf(R.v[j].w))));
#pragma unroll
    for (int o = 1; o < 64; o <<= 1) am = fmaxf(am, __shfl_xor(am, o));
    const float sc = (am > 0.f && am < 3.0e38f) ? exp2f(floorf(log2f(224.f / am))) : 1.f;
    unsigned char* o = tab + (size_t)(lane >> 5) * ((size_t)NEXP * 128) + (size_t)m * 128 + 4 * (lane & 31);
#pragma unroll
    for (int j = 0; j < 8; ++j) { int w = __builtin_amdgcn_cvt_pk_fp8_f32(R.v[j].x * sc, R.v[j].y * sc, 0, false); w = __builtin_amdgcn_cvt_pk_fp8_f32(R.v[j].z * sc, R.v[j].w * sc, w, true); *(unsigned*)(o + (size_t)(2 * j) * ((size_t)NEXP * 128)) = (unsigned)w; }
    if (lane == 0) *inv = 1.f / sc;
}
__device__ __forceinline__ void p0_prologue(const Frame& F, const Args& a) {
    unsigned char* ws = a.ws;
    LAS float* scr = (LAS float*)(F.lds + F.wave * 16384);
    const int gw = F.vcu * NWAVES + F.wave, NGW = F.G * NWAVES, lane = F.lane;
    bf16_t* BtIn = (bf16_t*)(ws + WS_BT_IN); bf16_t* BtOut = (bf16_t*)(ws + WS_BT_OUT); bf16_t* BtQ = (bf16_t*)(ws + WS_BT_Q); bf16_t* BtKV = (bf16_t*)(ws + WS_BT_KV);
    constexpr int I_IN = 32 * 168, I_OUT = 32 * 64, I_Q = 32 * 64, I_KV = 32 * 32;
    constexpr int NIT = I_IN + I_OUT + I_Q + I_KV;
    for (int it = gw; it < NIT; it += NGW) {
        int r = it;
        if (r < I_IN) { p0_transpose_item<1>(a.w_in, DM, IN_W, BtIn, scr, r / 168, r % 168, lane); continue; } r -= I_IN;
        if (r < I_OUT) { const int kb = r / 64; p0_transpose_item<0>(a.w_out, DM, DM, BtOut, scr, kb, r % 64, lane); continue; } r -= I_OUT;
        if (r < I_Q) { p0_transpose_item<0>(a.w_q, DM, DM, BtQ, scr, r / 64, r % 64, lane); continue; } r -= I_Q;
        p0_transpose_item<0>(a.w_kv, DM, 1024, BtKV, scr, r / 32, r % 32, lane);
    }
    { bf16_t* PWt = (bf16_t*)(ws + WS_PWT);
      for (int it = gw; it < 4 * 128; it += NGW) { const int g = it >> 7, e = it & 127; const float* pw = a.pool_w + (size_t)g * 16384 + e;
          const float v0 = pw[(size_t)(2 * lane) * 128], v1 = pw[(size_t)(2 * lane + 1) * 128]; ((unsigned*)(PWt + (size_t)it * 128))[lane] = cvtpk(v0, v1); } }
    bf16_t* XN = (bf16_t*)(ws + WS_XN); bf16_t* MN = (bf16_t*)(ws + WS_MN);
#if P1_FP8
    {
        RowF32 Ra, Rb; int m = gw;
        if (m < NTOK) row_load(Ra, a.x + (size_t)m * DM, lane);
        for (; m < NTOK; m += 2 * NGW) { const int m2 = m + NGW, m3 = m + 2 * NGW;
            if (m2 < NTOK) row_load(Rb, a.x + (size_t)m2 * DM, lane);
            rms_fin_bf16_fp8(Ra.v, a.attn_g, XN + (size_t)m * DM, ws + WS_XN8 + (size_t)m * DM, lane);
            if (m3 < NTOK) row_load(Ra, a.x + (size_t)m3 * DM, lane);
            if (m2 < NTOK) rms_fin_bf16_fp8(Rb.v, a.attn_g, XN + (size_t)m2 * DM, ws + WS_XN8 + (size_t)m2 * DM, lane); } }
#else
    for (int m = gw; m < NTOK; m += NGW) rms_row_to_bf16(a.x + (size_t)m * DM, a.attn_g, XN + (size_t)m * DM, lane);
#endif
    for (int m = gw; m < BATCH * MEMLEN; m += NGW) rms_row_to_bf16(a.mem + (size_t)m * DM, a.mem_g, MN + (size_t)m * DM, lane);
    unsigned char* UB = ws + WS_UB; unsigned char* VB = ws + WS_VB; float* RSU = (float*)(ws + WS_RSU); float* RSV = (float*)(ws + WS_RSV);
    (void)UB; (void)VB; (void)RSU; (void)RSV;
    bf16_t* PK = (bf16_t*)(ws + WS_PK);
    for (int m = gw; m < 256; m += NGW) { const float* src = (m < 128 ? a.sk1 + (size_t)m * 128 : a.sk2 + (size_t)(m - 128) * 128);
        const f32x2 v = ((const f32x2*)src)[lane]; ((unsigned*)(PK + (size_t)m * 128))[lane] = cvtpk(v.x, v.y); }
    float* RT = (float*)(ws + WS_ROPE);
    for (int p = gw; p < SEQ; p += NGW) {
        { const float invf = powf(10000.f, -(float)lane / 64.f); const float ang = (float)p * invf;
          RT[(size_t)p * 192 + lane] = cosf(ang); RT[(size_t)p * 192 + 64 + lane] = sinf(ang); }
        if (lane < 32) { const float invf = powf(10000.f, -(float)lane / 32.f); const float ang = (float)p * invf;
          RT[(size_t)p * 192 + 128 + lane] = cosf(ang); RT[(size_t)p * 192 + 160 + lane] = sinf(ang); }
    }
}

__device__ __forceinline__ void unpack8(const u32x4 w, float* x) { x[0] = bflo(w.x); x[1] = bfhi(w.x); x[2] = bflo(w.y); x[3] = bfhi(w.y); x[4] = bflo(w.z); x[5] = bfhi(w.z); x[6] = bflo(w.w); x[7] = bfhi(w.w); }
__device__ __forceinline__ u32x4 pack8(const float* x) { u32x4 w; w.x = cvtpk(x[0], x[1]); w.y = cvtpk(x[2], x[3]); w.z = cvtpk(x[4], x[5]); w.w = cvtpk(x[6], x[7]); return w; }
struct F8 { float v[8]; };
__device__ __forceinline__ F8 ld8f(const float* p) { const f32x4 a = *(const f32x4*)p, b = *(const f32x4*)(p + 4); F8 r; r.v[0] = a.x; r.v[1] = a.y; r.v[2] = a.z; r.v[3] = a.w; r.v[4] = b.x; r.v[5] = b.y; r.v[6] = b.z; r.v[7] = b.w; return r; }
__device__ __forceinline__ u32x2 pack8_fp8(const float* x) { int a = __builtin_amdgcn_cvt_pk_fp8_f32(x[0], x[1], 0, false); a = __builtin_amdgcn_cvt_pk_fp8_f32(x[2], x[3], a, true); int b = __builtin_amdgcn_cvt_pk_fp8_f32(x[4], x[5], 0, false); b = __builtin_amdgcn_cvt_pk_fp8_f32(x[6], x[7], b, true); return (u32x2){(unsigned)a, (unsigned)b}; }
template <bool NORM, bool ROPE, bool WB16 = true> __device__ __forceinline__ void head128_fin(bf16_t* base, const u32x4 wa, const u32x4 wb, int g, const F8& g1, const F8& g2, const F8& cc, const F8& sn, unsigned char* f8base = nullptr) {
    float x1[8], x2[8];
    unpack8(wa, x1); unpack8(wb, x2);
    if (NORM) {
        float ss = 0.f;
#pragma unroll
        for (int j = 0; j < 8; ++j) ss += x1[j] * x1[j] + x2[j] * x2[j];
        ss += __shfl_xor(ss, 1); ss += __shfl_xor(ss, 2); ss += __shfl_xor(ss, 4);
        const float rstd = 1.f / sqrtf(ss * (1.f / 128.f) + EPS);
#pragma unroll
        for (int j = 0; j < 8; ++j) { x1[j] = x1[j] * rstd * g1.v[j]; x2[j] = x2[j] * rstd * g2.v[j]; }
    }
    if (ROPE) {
#pragma unroll
        for (int j = 0; j < 8; ++j) { const float c = cc.v[j], sv = sn.v[j]; const float p = x1[j], q = x2[j]; x1[j] = p * c - q * sv; x2[j] = q * c + p * sv; }
    }
    if (WB16) { *(u32x4*)(base + 8 * g) = pack8(x1); *(u32x4*)(base + 64 + 8 * g) = pack8(x2); }
    if (f8base) { *(u32x2*)(f8base + 8 * g) = pack8_fp8(x1); *(u32x2*)(f8base + 64 + 8 * g) = pack8_fp8(x2); }
}
namespace ix { constexpr float QI_SCALE = 1.f / 512.f; }
__device__ __forceinline__ void head64_fin(bf16_t* base, const u32x4 wa, const u32x4 wb, int g, const F8& cc, const F8& sn, float osc = 1.f) {
    float x1[8], x2[8];
    unpack8(wa, x1); unpack8(wb, x2);
#pragma unroll
    for (int j = 0; j < 8; ++j) { const float c = cc.v[j], sv = sn.v[j]; const float p = x1[j], q = x2[j]; x1[j] = (p * c - q * sv) * osc; x2[j] = (q * c + p * sv) * osc; }
    *(u32x4*)(base + 8 * g) = pack8(x1); *(u32x4*)(base + 32 + 8 * g) = pack8(x2);
}
__device__ __forceinline__ void p2_post(const Frame& F, const Args& a) {
    unsigned char* ws = a.ws; const int lane = F.lane;
    const int gw = F.vcu * NWAVES + F.wave, NGW = F.G * NWAVES;
    bf16_t* Z = (bf16_t*)(ws + WS_Z); bf16_t* MIX = (bf16_t*)(ws + WS_XN); bf16_t* KVM = (bf16_t*)(ws + WS_KVM);
    const float* RT = (const float*)(ws + WS_ROPE);
    const int g8 = lane & 7, h8 = lane >> 3, g4 = lane & 3, h4 = lane >> 2;
    { const int wsel = lane >> 4, w = 2 << wsel;
      for (int ch = gw; ch < NTOK / 16; ch += NGW) {
          const int t0 = 16 * ch, pos0 = t0 & (SEQ - 1);
          const bf16_t* zp = Z + (size_t)t0 * ZLD + ZC_PU + 8 * lane;
          u32x4 rows[32];
#pragma unroll
          for (int j = 0; j < 16; ++j) rows[j] = pos0 ? *(const u32x4*)(zp - (size_t)(16 - j) * ZLD) : (u32x4){0u, 0u, 0u, 0u};
#pragma unroll
          for (int j = 0; j < 16; ++j) rows[16 + j] = *(const u32x4*)(zp + (size_t)j * ZLD);
          float S[8] = {0.f, 0.f, 0.f, 0.f, 0.f, 0.f, 0.f, 0.f};
#pragma unroll
          for (int j = 1; j < 16; ++j) { float v[8]; unpack8(rows[16 - j], v); const float on = j < w ? 1.f : 0.f;
#pragma unroll
              for (int e = 0; e < 8; ++e) S[e] = fmaf(on, v[e], S[e]); }
#pragma unroll
          for (int i = 0; i < 16; ++i) {
              const u32x4 o2 = rows[15 + i], o4 = rows[13 + i], o8 = rows[9 + i], o16 = rows[1 + i];
              const u32x4 lv = wsel == 0 ? o2 : (wsel == 1 ? o4 : (wsel == 2 ? o8 : o16));
              float un[8], uo[8]; unpack8(rows[16 + i], un); unpack8(lv, uo);
              const int pc = pos0 + i + 1; const float inv = 1.f / (float)(pc < w ? pc : w);
              float d[8];
#pragma unroll
              for (int e = 0; e < 8; ++e) { S[e] += un[e]; d[e] = S[e] * inv - un[e]; S[e] -= uo[e]; }
              *(u32x4*)(MIX + (size_t)(t0 + i) * DM + 1024 + 8 * lane) = pack8(d); } } }
    struct HB { u32x4 q1, q2, k1, k2, i1, i2, x1, x2, m1, m2; F8 c128, s128, c64, s64; };
    const unsigned oq = (unsigned)(ZC_Q + h8 * 128 + 8 * g8) * 2u, okk = (unsigned)(ZC_K + h8 * 128 + 8 * g8) * 2u, oi = (unsigned)(ZC_QI + h4 * 64 + 8 * g4) * 2u, oki = (unsigned)(ZC_KI + 8 * g4) * 2u,
                   om = (unsigned)(ZC_QM + (h8 & 3) * 128 + 8 * g8) * 2u, or8 = (unsigned)(8 * g8) * 4u, or4 = (unsigned)(128 + 8 * g4) * 4u;
#define P2_LDU(base, off) (*(const u32x4*)((const char*)(base) + (off)))
#define P2_LDF(base, off) ld8f((const float*)((const char*)(base) + (off)))
#define P2_HB_LOAD(H, t_) do { const char* zb_ = (const char*)(Z + (size_t)(t_) * ZLD); const char* rb_ = (const char*)(RT + (size_t)((t_) & (SEQ - 1)) * 192); \
        H.q1 = P2_LDU(zb_, oq); H.q2 = P2_LDU(zb_, oq + 128u); H.k1 = P2_LDU(zb_, okk); H.k2 = P2_LDU(zb_, okk + 128u); \
        H.i1 = P2_LDU(zb_, oi); H.i2 = P2_LDU(zb_, oi + 64u); H.x1 = P2_LDU(zb_, oki); H.x2 = P2_LDU(zb_, oki + 64u); \
        H.m1 = P2_LDU(zb_, om); H.m2 = P2_LDU(zb_, om + 128u); \
        H.c128 = P2_LDF(rb_, or8); H.s128 = P2_LDF(rb_, or8 + 256u); H.c64 = P2_LDF(rb_, or4); H.s64 = P2_LDF(rb_, or4 + 128u); } while (0)
#if QK_FP8
#define P2_QK(H, t_, zr_) { const F8 qg1 = ld8f(a.q_g + 8 * g8), qg2 = ld8f(a.q_g + 64 + 8 * g8); head128_fin<true, true, ATT_VERIFY != 0>(zr_ + ZC_Q + h8 * 128, H.q1, H.q2, g8, qg1, qg2, H.c128, H.s128, ws + WS_Q8 + (size_t)(t_) * 1024 + h8 * 128); } \
        { const F8 kg1 = ld8f(a.k_g + 8 * g8), kg2 = ld8f(a.k_g + 64 + 8 * g8); head128_fin<true, true, ATT_VERIFY != 0>(zr_ + ZC_K + h8 * 128, H.k1, H.k2, g8, kg1, kg2, H.c128, H.s128, ws + WS_K8 + (size_t)(t_) * 1024 + h8 * 128); }
#else
#define P2_QK(H, t_, zr_) { const F8 qg1 = ld8f(a.q_g + 8 * g8), qg2 = ld8f(a.q_g + 64 + 8 * g8); head128_fin<true, true>(zr_ + ZC_Q + h8 * 128, H.q1, H.q2, g8, qg1, qg2, H.c128, H.s128); } \
        { const F8 kg1 = ld8f(a.k_g + 8 * g8), kg2 = ld8f(a.k_g + 64 + 8 * g8); head128_fin<true, true>(zr_ + ZC_K + h8 * 128, H.k1, H.k2, g8, kg1, kg2, H.c128, H.s128); }
#endif
#define P2_HB_FIN(H, t_) do { bf16_t* zr_ = Z + (size_t)(t_) * ZLD; P2_QK(H, t_, zr_) \
        head64_fin(zr_ + ZC_QI + h4 * 64, H.i1, H.i2, g4, H.c64, H.s64, ix::QI_SCALE); \
        if (lane < 4) head64_fin((bf16_t*)(ws + WS_KI) + (size_t)(t_) * 64, H.x1, H.x2, g4, H.c64, H.s64); \
        if (lane < 32) { const F8 mg1 = ld8f(a.mq_g + 8 * g8), mg2 = ld8f(a.mq_g + 64 + 8 * g8); head128_fin<true, false>(zr_ + ZC_QM + (h8 & 3) * 128, H.m1, H.m2, g8, mg1, mg2, H.c128, H.s128); } } while (0)
    { HB ha, hb; int t = gw;
      if (t < NTOK) P2_HB_LOAD(ha, t);
      for (; t < NTOK; t += 2 * NGW) { const int t2 = t + NGW, t3 = t + 2 * NGW;
          if (t2 < NTOK) P2_HB_LOAD(hb, t2);
          P2_HB_FIN(ha, t);
          if (t3 < NTOK) P2_HB_LOAD(ha, t3);
          if (t2 < NTOK) P2_HB_FIN(hb, t2); } }
#undef P2_HB_LOAD
#undef P2_LDU
#undef P2_LDF
#undef P2_HB_FIN
#undef P2_QK
    const F8 kmg1 = ld8f(a.mk_g + 8 * g8), kmg2 = ld8f(a.mk_g + 64 + 8 * g8);
    for (int r = gw; r < BATCH * MEMLEN; r += NGW) { if (lane < 32) { bf16_t* bm = KVM + (size_t)r * 1024 + (lane >> 3) * 128; const u32x4 m1 = *(const u32x4*)(bm + 8 * g8), m2 = *(const u32x4*)(bm + 64 + 8 * g8); head128_fin<true, false>(bm, m1, m2, g8, kmg1, kmg2, kmg1, kmg2); } }
}

#if PV_FP8
__device__ __forceinline__ void p2_vt(const Frame& F, const Args& a) {
    unsigned char* ws = a.ws; const int lane = F.lane;
    const int gw = F.vcu * NWAVES + F.wave, NGW = F.G * NWAVES;
    const bf16_t* Z = (const bf16_t*)(ws + WS_Z);
    {
        LAS unsigned char* tb = F.lds + F.wave * 8704; unsigned char* V8T = ws + WS_V8T;
        for (int blk = gw; blk < BATCH * 256 * 8; blk += NGW) {
            const int h = blk & 7, T = (blk >> 3) & 255, b = blk >> 11;
            const bf16_t* vrow = Z + ((size_t)b * SEQ + 64 * T + lane) * ZLD + ZC_V + h * 128;
            u32x4 w[16];
#pragma unroll
            for (int i = 0; i < 16; ++i) w[i] = *(const u32x4*)(vrow + 8 * i);
#pragma unroll
            for (int i = 0; i < 16; ++i) { float x[8]; unpack8(w[i], x);
#pragma unroll
                for (int e = 0; e < 8; ++e) x[e] = __builtin_amdgcn_fmed3f(x[e], -448.f, 448.f);
                *(LAS u32x2*)(tb + lane * 136 + 8 * i) = pack8_fp8(x); }
            LDS_WAIT();
            unsigned char* dst = V8T + ((size_t)((b * 8 + h) * 256 + T)) * 8192 + (size_t)lane * 128;
#pragma unroll
            for (int c = 0; c < 2; ++c) { const int d = 2 * lane + c;
#pragma unroll
                for (int q4 = 0; q4 < 4; ++q4) { unsigned o[4];
#pragma unroll
                    for (int qq = 0; qq < 4; ++qq) { const int pq = 4 * (4 * q4 + qq); const int key0 = 32 * ((pq >> 4) & 1) + 8 * ((pq >> 2) & 3) + 4 * (pq >> 5);
                        const unsigned b0 = tb[(key0 + 0) * 136 + d], b1 = tb[(key0 + 1) * 136 + d], b2 = tb[(key0 + 2) * 136 + d], b3 = tb[(key0 + 3) * 136 + d];
                        o[qq] = b0 | (b1 << 8) | (b2 << 16) | (b3 << 24); }
                    *(u32x4*)(dst + c * 64 + q4 * 16) = (u32x4){o[0], o[1], o[2], o[3]}; } }
            LDS_WAIT();
        }
    }
}
#endif

namespace ix {
constexpr int KP = 144, KBUF = 64 * KP;
constexpr int OFF_KI = 0, OFF_HIST = 2 * KBUF, OFF_ST = OFF_HIST + 65536, OFF_W = OFF_ST + 8192;
constexpr int CAPB = 1024;
constexpr int CAPF = 512;
enum { S_ULO = 0, S_UHI = 64, S_SH = 128, S_NEED = 192, S_FLO = 256, S_FHI = 320, S_CCNT = 384, S_ACT = 448, S_ABOVE = 512, S_COL = 576, S_FAIL = 640,
       S_PB1 = 704, S_PB2 = 768, S_PAB = 832, S_VMIN = 896, S_VMAX = 960, S_VCNT = 1024, S_ANY = 1088, S_R1 = 1089, S_R2 = 1090 };
constexpr float WSCALE = 0.25f * 0.125f;
__device__ __forceinline__ float relu_i(float x) { const int i = __float_as_int(x); return __int_as_float(i > 0 ? i : 0); }
__device__ __forceinline__ unsigned sh_for(unsigned range) { const int bits = 32 - __clz((int)range); return range == 0u ? 0u : (bits > 9 ? (unsigned)(bits - 9) : 0u); }

template <int MODE>
__device__ __forceinline__ void sweep(const Frame& F, const bf16x8 (&A)[4][4], const bf16_t* Z, unsigned* MASK, unsigned long long* CAND, size_t qrow0, size_t krow0, int NT, int t0, int stride, int vmode) {
    const int tid = F.tid, lane = F.lane, wave = F.wave, r = lane & 31, hi = lane >> 5;
    LAS unsigned char* lds = F.lds;
    volatile LAS unsigned* st = (volatile LAS unsigned*)(lds + OFF_ST);
    LAS unsigned* hist32 = (LAS unsigned*)(lds + OFF_HIST);
    unsigned qact = 0u;
    {
#pragma unroll
        for (int qp = 0; qp < 4; ++qp) { const int q0 = 8 * wave + 2 * qp; const unsigned a2 = (MODE == 0) ? (st[S_ACT + q0] | st[S_ACT + q0 + 1]) : (vmode ? 1u : (st[S_COL + q0] | st[S_COL + q0 + 1]));
            qact |= ((unsigned)__builtin_amdgcn_readfirstlane((int)a2) != 0u ? 1u : 0u) << qp; }
    }
    unsigned ccnt_[4] = {0u, 0u, 0u, 0u}, abv_[4] = {0u, 0u, 0u, 0u};
    if (MODE == 1) {
#pragma unroll
        for (int qp = 0; qp < 4; ++qp) { ccnt_[qp] = st[S_CCNT + 8 * wave + 2 * qp + hi]; abv_[qp] = st[S_ABOVE + 8 * wave + 2 * qp + hi]; }
    }
    const int srow = tid >> 3, sch = tid & 7;
    const bf16_t* KI = (const bf16_t*)((const unsigned char*)Z + (WS_KI - WS_Z));
    const bf16_t* ksrc = KI + (krow0 + srow) * 64 + sch * 8;
    u32x4 stg = *(const u32x4*)(ksrc + (size_t)t0 * 64 * 64);
    *(LAS u32x4*)(lds + OFF_KI + srow * KP + sch * 16) = stg;
    __syncthreads();
    int buf = 0;
    for (int t = t0; t < NT; t += stride) {
        const int tn = t + stride;
        if (tn < NT) stg = *(const u32x4*)(ksrc + (size_t)tn * 64 * 64);
        LAS unsigned char* kb = lds + OFF_KI + buf * KBUF;
        int lane_ = (int)threadIdx.x; asm volatile("" : "+v"(lane_)); lane_ &= 63;
        const int r = lane_ & 31, hi = lane_ >> 5;
        bf16x8 B0[4], B1[4];
#pragma unroll
        for (int ks = 0; ks < 4; ++ks) { B0[ks] = *(const LAS bf16x8*)(kb + r * KP + ks * 32 + hi * 16); B1[ks] = *(const LAS bf16x8*)(kb + (32 + r) * KP + ks * 32 + hi * 16); }
#pragma unroll
        for (int qp = 0; qp < 4; ++qp) {
            if (((qact >> qp) & 1u) == 0u) continue;
            const int ql = 8 * wave + 2 * qp + hi;
            const LAS u32x4* wq = (const LAS u32x4*)(lds + OFF_W + ql * 64);
            const u32x4 wd0 = wq[0], wd1 = wq[1];
            const unsigned sA = (MODE == 0) ? st[S_ULO + ql] : st[S_FLO + ql], sB = (MODE == 0) ? st[S_UHI + ql] : st[S_FHI + ql], sC = (MODE == 0) ? st[S_SH + ql] : st[S_COL + ql];
            f32x16 a0 = f32x16{}, a1 = f32x16{};
#pragma unroll
            for (int ks = 0; ks < 4; ++ks) { a0 = __builtin_amdgcn_mfma_f32_32x32x16_bf16(A[qp][ks], B0[ks], a0, 0, 0, 0); a1 = __builtin_amdgcn_mfma_f32_32x32x16_bf16(A[qp][ks], B1[ks], a1, 0, 0, 0); }
            int sa0 = 0, sb0 = 0, sa1 = 0, sb1 = 0;
#define IX_PK(A, j) __builtin_bit_cast(s16x2, __builtin_amdgcn_cvt_pknorm_u16(A[2 * (j)], A[2 * (j) + 1]))
#define IX_W(j) __builtin_bit_cast(s16x2, (j) < 4 ? wd0[(j)] : wd1[(j) - 4])
#pragma unroll
            for (int j = 0; j < 8; j += 2) {
                sa0 = __builtin_amdgcn_sdot2(IX_PK(a0, j), IX_W(j), sa0, true); sa1 = __builtin_amdgcn_sdot2(IX_PK(a1, j), IX_W(j), sa1, true);
                sb0 = __builtin_amdgcn_sdot2(IX_PK(a0, j + 1), IX_W(j + 1), sb0, true); sb1 = __builtin_amdgcn_sdot2(IX_PK(a1, j + 1), IX_W(j + 1), sb1, true); }
#undef IX_PK
#undef IX_W
            const unsigned u0 = (unsigned)(sa0 + sb0) ^ 0x80000000u, u1 = (unsigned)(sa1 + sb1) ^ 0x80000000u;
            if (MODE == 0) {
                const unsigned wlo = sA, whi = sB, wsh = sC;
                if (u0 >= wlo && u0 <= whi) { unsigned bin = (u0 - wlo) >> wsh; bin = bin > 511u ? 511u : bin;
                    __hip_atomic_fetch_add(hist32 + ql * 256 + (bin >> 1), 1u << ((bin & 1u) * 16u), __ATOMIC_RELAXED, __HIP_MEMORY_SCOPE_WORKGROUP); }
                if (u1 >= wlo && u1 <= whi) { unsigned bin = (u1 - wlo) >> wsh; bin = bin > 511u ? 511u : bin;
                    __hip_atomic_fetch_add(hist32 + ql * 256 + (bin >> 1), 1u << ((bin & 1u) * 16u), __ATOMIC_RELAXED, __HIP_MEMORY_SCOPE_WORKGROUP); }
            } else if (IX_VERIFY && vmode) {
                LAS unsigned* vs = (LAS unsigned*)(lds + OFF_ST) + ql;
                const unsigned long long w64 = __hip_atomic_load((const unsigned long long*)(MASK + (qrow0 + ql) * MASK_WPR + 2 * t), __ATOMIC_RELAXED, __HIP_MEMORY_SCOPE_AGENT);
                if ((w64 >> r) & 1ull) { __hip_atomic_fetch_min(vs + S_VMIN, u0, __ATOMIC_RELAXED, __HIP_MEMORY_SCOPE_WORKGROUP); __hip_atomic_fetch_add(vs + S_VCNT, 1u, __ATOMIC_RELAXED, __HIP_MEMORY_SCOPE_WORKGROUP); }
                else __hip_atomic_fetch_max(vs + S_VMAX, u0, __ATOMIC_RELAXED, __HIP_MEMORY_SCOPE_WORKGROUP);
                if ((w64 >> (32 + r)) & 1ull) { __hip_atomic_fetch_min(vs + S_VMIN, u1, __ATOMIC_RELAXED, __HIP_MEMORY_SCOPE_WORKGROUP); __hip_atomic_fetch_add(vs + S_VCNT, 1u, __ATOMIC_RELAXED, __HIP_MEMORY_SCOPE_WORKGROUP); }
                else __hip_atomic_fetch_max(vs + S_VMAX, u1, __ATOMIC_RELAXED, __HIP_MEMORY_SCOPE_WORKGROUP);
            } else {
                const unsigned flo = sA, fhi = sB; const bool col = sC != 0u;
                const unsigned long long bal0 = __ballot(col && u0 > fhi), bal1 = __ballot(col && u1 > fhi);
                const unsigned bh0 = (unsigned)(bal0 >> (32 * hi)), bh1 = (unsigned)(bal1 >> (32 * hi));
                if (col && r == 0) *(unsigned long long*)(MASK + (qrow0 + ql) * MASK_WPR + 2 * t) = (unsigned long long)bh0 | ((unsigned long long)bh1 << 32);
                abv_[qp] += __popc(bh0) + __popc(bh1);
                const bool c0 = col && (u0 >= flo) && (u0 <= fhi), c1 = col && (u1 >= flo) && (u1 <= fhi);
                const unsigned long long cb0 = __ballot(c0), cb1 = __ballot(c1);
                if (cb0 | cb1) { const unsigned h0 = (unsigned)(cb0 >> (32 * hi)), h1 = (unsigned)(cb1 >> (32 * hi)); const unsigned lt = (1u << r) - 1u;
                    const unsigned pos0 = ccnt_[qp] + __popc(h0 & lt), pos1 = ccnt_[qp] + __popc(h0) + __popc(h1 & lt);
                    if (c0 && pos0 < (unsigned)CAPB) CAND[(size_t)ql * CAPB + pos0] = (unsigned long long)u0 | ((unsigned long long)(unsigned)(64 * t + r) << 32);
                    if (c1 && pos1 < (unsigned)CAPB) CAND[(size_t)ql * CAPB + pos1] = (unsigned long long)u1 | ((unsigned long long)(unsigned)(64 * t + 32 + r) << 32);
                    ccnt_[qp] += __popc(h0) + __popc(h1); }
            }
        }
        if (tn < NT) *(LAS u32x4*)(lds + OFF_KI + (buf ^ 1) * KBUF + srow * KP + sch * 16) = stg;
        __syncthreads();
        buf ^= 1;
    }
    if (MODE == 1 && !vmode) { const int r0 = lane & 31, h0 = lane >> 5;
#pragma unroll
        for (int qp = 0; qp < 4; ++qp) { const int ql = 8 * wave + 2 * qp + h0; if (r0 == 0 && st[S_COL + ql] != 0u) { st[S_CCNT + ql] = ccnt_[qp]; st[S_ABOVE + ql] = abv_[qp]; } } }
}

__device__ __forceinline__ void resolve(const Frame& F, unsigned* MASK, const unsigned long long* CAND, size_t qrow0, int NT) {
    int lane = (int)threadIdx.x; asm volatile("" : "+v"(lane)); lane &= 63; const int wave = F.wave;
    LAS unsigned char* lds = F.lds;
    volatile LAS unsigned* st = (volatile LAS unsigned*)(lds + OFF_ST);
    LAS unsigned* wh = (LAS unsigned*)(lds + OFF_HIST + wave * 4608); LAS unsigned* bm = wh + 512; LAS unsigned long long* sl = (LAS unsigned long long*)(bm + 512);
    const unsigned long long ltm = (1ull << lane) - 1ull;
    for (int qi = 0; qi < 8; ++qi) {
        const int q = 8 * wave + qi;
        if (st[S_COL + q] == 0u) continue;
        const unsigned cnt = st[S_CCNT + q], ab = st[S_ABOVE + q];
        if (!(ab < 256u && ab + cnt >= 256u && cnt <= (unsigned)CAPB)) { if (lane == 0) st[S_FAIL + q] = 1u; continue; }
        if (lane == 0) st[S_FAIL + q] = 0u;
        unsigned need = 256u - ab, lo = st[S_FLO + q], hi = st[S_FHI + q], sh = 0u, cbin = 0u;
        const unsigned long long* cq = CAND + (size_t)q * CAPB;
#pragma unroll
        for (int i = 0; i < 8; ++i) bm[lane * 8 + i] = 0u;
        for (int lev = 0; lev < 5; ++lev) {
            sh = sh_for(hi - lo);
#pragma unroll
            for (int i = 0; i < 8; ++i) wh[lane * 8 + i] = 0u;
            LDS_WAIT();
            for (unsigned j = lane; j < cnt; j += 64) { const unsigned u = (unsigned)cq[j]; if (u >= lo && u <= hi) __hip_atomic_fetch_add(wh + ((u - lo) >> sh), 1u, __ATOMIC_RELAXED, __HIP_MEMORY_SCOPE_WORKGROUP); }
            LDS_WAIT();
            unsigned hb[8], s8 = 0u;
#pragma unroll
            for (int i = 0; i < 8; ++i) { hb[i] = wh[lane * 8 + i]; s8 += hb[i]; }
            unsigned above = 0u;
            { unsigned inc = s8;
#pragma unroll
              for (int o = 1; o < 64; o <<= 1) { const unsigned v = __shfl_down(inc, o); if (lane + o < 64) inc += v; }
              above = inc - s8; }
            const bool mine = above < need && need <= above + s8;
            unsigned bstar = 0u, run = above, cb = 0u;
            if (mine) { bool found = false;
#pragma unroll
                for (int i = 7; i >= 0; --i) { if (!found) { if (run + hb[i] >= need) { bstar = (unsigned)(lane * 8 + i); cb = hb[i]; found = true; } else run += hb[i]; } } }
            const unsigned long long mb = __ballot(mine); const int src = mb ? (int)__builtin_ctzll(mb) : 0;
            bstar = __shfl(bstar, src); run = __shfl(run, src); cbin = __shfl(cb, src);
            const unsigned nlo = lo + (bstar << sh); const unsigned long long e = (unsigned long long)nlo + ((1ull << sh) - 1ull);
            hi = e > (unsigned long long)hi ? hi : (unsigned)e; lo = nlo; need -= run;
            if (cbin <= 64u || sh == 0u) break;
        }
        const bool tiemode = cbin > 64u;
        unsigned m = 0u;
        for (unsigned j0 = 0; j0 < cnt; j0 += 64) { const unsigned j = j0 + lane; const bool vj = j < cnt; const unsigned long long e = vj ? cq[j] : 0ull; const unsigned u = (unsigned)e, key = (unsigned)(e >> 32);
            const bool inw = vj && u >= lo && u <= hi; const unsigned long long bal = __ballot(inw); const unsigned pos = m + (unsigned)__popcll(bal & ltm);
            if (vj && (u > hi || (tiemode && inw && pos < need))) __hip_atomic_fetch_or(bm + (key >> 5), 1u << (key & 31u), __ATOMIC_RELAXED, __HIP_MEMORY_SCOPE_WORKGROUP);
            if (!tiemode && inw && pos < 64u) sl[pos] = e;
            m += (unsigned)__popcll(bal); }
        LDS_WAIT();
        if (!tiemode) { if (m > 64u) m = 64u;
            if ((unsigned)lane < m) { const unsigned long long ej = sl[lane]; const unsigned uj = (unsigned)ej; unsigned rank = 0u;
                for (unsigned j2 = 0; j2 < m; ++j2) { const unsigned u2 = (unsigned)sl[j2]; rank += (u2 > uj || (u2 == uj && j2 < (unsigned)lane)) ? 1u : 0u; }
                if (rank < need) { const unsigned key = (unsigned)(ej >> 32); __hip_atomic_fetch_or(bm + (key >> 5), 1u << (key & 31u), __ATOMIC_RELAXED, __HIP_MEMORY_SCOPE_WORKGROUP); } } }
        LDS_WAIT();
        unsigned* mrow = MASK + (qrow0 + q) * MASK_WPR;
        for (int w = lane; w < 2 * NT; w += 64) { const unsigned b = bm[w]; if (b) { const unsigned old = __hip_atomic_load(mrow + w, __ATOMIC_RELAXED, __HIP_MEMORY_SCOPE_AGENT); mrow[w] = old | b; } }
        LDS_WAIT();
    }
}

__device__ __forceinline__ void unit(const Frame& F, const bf16_t* Z, unsigned* MASK, unsigned long long* CANDW, unsigned* ERR, int b, int c) {
    const int tid = F.tid, lane = F.lane, wave = F.wave, r = lane & 31, hi = lane >> 5;
    const int NT = c + 1; const size_t qrow0 = (size_t)b * SEQ + 64 * c, krow0 = (size_t)b * SEQ;
    LAS unsigned char* lds = F.lds;
    volatile LAS unsigned* st = (volatile LAS unsigned*)(lds + OFF_ST);
    LAS unsigned* hist32 = (LAS unsigned*)(lds + OFF_HIST);
    { const int tend = 4 * ((c >> 2) + 1), nz = 2 * (tend - NT);
      for (int i = tid; i < 64 * nz; i += 512) { const int q = i / nz, wi = 2 * NT + i % nz; MASK[(qrow0 + q) * MASK_WPR + wi] = 0u; } }
    if (c <= 3) {
        for (int i = tid; i < 64 * 2 * NT; i += 512) { const int q = i / (2 * NT), wi = i % (2 * NT); MASK[(qrow0 + q) * MASK_WPR + wi] = 0xFFFFFFFFu; }
        return;
    }
    bf16x8 A[4][4];
#pragma unroll
    for (int qp = 0; qp < 4; ++qp) {
        const int query = 8 * wave + 2 * qp + ((r >> 2) & 1), head = (r & 3) + 4 * (r >> 3);
        const bf16_t* src = Z + (qrow0 + query) * ZLD + ZC_QI + head * 64 + 8 * hi;
#pragma unroll
        for (int ks = 0; ks < 4; ++ks) A[qp][ks] = *(const bf16x8*)(src + ks * 16);
    }
    for (int i = tid; i < 64 * 16; i += 512) { const int q = i >> 4, hh = i & 15; int wi = (int)rintf(bflo((unsigned)Z[(qrow0 + q) * ZLD + ZC_WI + hh]) * 1024.f); wi = wi > 32767 ? 32767 : (wi < -32767 ? -32767 : wi); ((LAS short*)(lds + OFF_W))[q * 32 + hh] = (short)wi; }
    const int stride = NT >= 32 ? 8 : (NT >= 16 ? 4 : 1), t0 = stride >> 1, nsamp = (NT - t0 + stride - 1) / stride;
    const bool pilot = stride > 1;
    int r1 = 1, r2 = 1;
    if (pilot) { const float ns = 256.f * (float)nsamp / (float)NT; const float sg = sqrtf(ns * (1.f - 1.f / (float)stride)); const int mg = (int)ceilf(5.f * sg) + 2, mgl = (int)ceilf(4.2f * sg);
        r1 = (int)floorf(ns) - mgl; if (r1 < 1) r1 = 1; r2 = (int)ceilf(ns) + mg; }
    const int strideA = (pilot && NT >= 128) ? 4 * stride : stride, t0A = strideA >> 1, nsampA = (NT - t0A + strideA - 1) / strideA;
    int r1A = r1, r2A = r2;
    if (pilot && strideA != stride) { const float ns = 256.f * (float)nsampA / (float)NT; const float sg = sqrtf(ns * (1.f - 1.f / (float)strideA)); const int mg = (int)ceilf(5.f * sg) + 2;
        r1A = (int)floorf(ns) - mg; if (r1A < 1) r1A = 1; r2A = (int)ceilf(ns) + mg; }
    if (tid < 64) { st[S_ULO + tid] = 0u; st[S_UHI + tid] = 0xFFFFFFFFu; st[S_SH + tid] = 23u; st[S_NEED + tid] = 256u; st[S_ACT + tid] = 1u; st[S_CCNT + tid] = 0u; st[S_ABOVE + tid] = 0u;
                    st[S_COL + tid] = 1u; st[S_FAIL + tid] = pilot ? 0u : 1u; st[S_PB1 + tid] = 511u; st[S_PB2 + tid] = 0u; st[S_PAB + tid] = 0u; }
    __syncthreads();
    int stage = pilot ? 0 : 2; bool after_fallback = !pilot;
    for (int iter = 0; iter < 24; ++iter) {
        if (stage <= 2) {
            { int tid_ = (int)threadIdx.x; asm volatile("" : "+v"(tid_));
              for (int i = 0; i < 32; ++i) hist32[tid_ + 512 * i] = 0u;
              if (tid_ == 0) st[S_ANY] = 0u; }
            __syncthreads();
            const bool smp = stage <= 1;
            sweep<0>(F, A, Z, MASK, CANDW, qrow0, krow0, NT, smp ? (stage == 0 ? t0A : t0) : 0, smp ? (stage == 0 ? strideA : stride) : 1, 0);
            { int tid_ = (int)threadIdx.x; asm volatile("" : "+v"(tid_)); const int ln = tid_ & 63;
              const int q = tid_ >> 3, seg = tid_ & 7; const LAS unsigned* h32 = hist32 + q * 256 + seg * 32;
              unsigned cnt = 0u;
              for (int i = 0; i < 32; ++i) { const unsigned wv = h32[i]; cnt += (wv & 0xffffu) + (wv >> 16); }
              unsigned above = 0u;
#pragma unroll
              for (int k = 0; k < 8; ++k) { const unsigned ck = __shfl(cnt, (ln & ~7) + k); if (k > seg) above += ck; }
              const unsigned ulo = st[S_ULO + q], uhi = st[S_UHI + q], sh = st[S_SH + q];
              if (smp) {
                  const unsigned pab = stage == 1 ? st[S_PAB + q] : 0u;
                  const unsigned t1 = (unsigned)(stage == 0 ? r1A : r1) - (stage == 1 ? pab : 0u), t2 = (unsigned)(stage == 0 ? r2A : r2) - (stage == 1 ? pab : 0u);
#pragma unroll
                  for (int which = 0; which < 2; ++which) { const unsigned tg = which ? t2 : t1;
                      if (above < tg && tg <= above + cnt) { unsigned run = above; int bstar = -1;
                          for (int i = 31; i >= 0; --i) { const unsigned wv = h32[i]; const unsigned c1 = wv >> 16, c0 = wv & 0xffffu;
                              if (bstar < 0) { if (run + c1 >= tg) bstar = seg * 64 + 2 * i + 1; else run += c1; }
                              if (bstar < 0) { if (run + c0 >= tg) bstar = seg * 64 + 2 * i; else run += c0; } }
                          if (which == 0) { st[S_PB1 + q] = (unsigned)bstar; if (stage == 0) st[S_PAB + q] = run; } else st[S_PB2 + q] = (unsigned)bstar; } }
              } else {
                  const unsigned need = st[S_NEED + q], active = st[S_ACT + q];
                  if (active && above < need && need <= above + cnt) {
                      unsigned run = above; int bstar = -1; unsigned cbin = 0u;
                      for (int i = 31; i >= 0; --i) { const unsigned wv = h32[i]; const unsigned c1 = wv >> 16, c0 = wv & 0xffffu;
                          if (bstar < 0) { if (run + c1 >= need) { bstar = seg * 64 + 2 * i + 1; cbin = c1; } else run += c1; }
                          if (bstar < 0) { if (run + c0 >= need) { bstar = seg * 64 + 2 * i; cbin = c0; } else run += c0; } }
                      const unsigned nlo = ulo + ((unsigned)bstar << sh); const unsigned long long e = (unsigned long long)nlo + ((1ull << sh) - 1ull);
                      const unsigned nhi = e > (unsigned long long)uhi ? uhi : (unsigned)e;
                      if (cbin <= (unsigned)CAPF || sh == 0u) { st[S_FLO + q] = nlo; st[S_FHI + q] = nhi; st[S_ACT + q] = 0u; st[S_ULO + q] = 1u; st[S_UHI + q] = 0u; }
                      else { st[S_ULO + q] = nlo; st[S_UHI + q] = nhi; st[S_SH + q] = sh >= 9u ? sh - 9u : 0u; st[S_NEED + q] = need - run; st[S_ANY] = 1u; }
                  }
              } }
            __syncthreads();
            if (stage == 0) {
                if (tid < 64) { const unsigned b1 = st[S_PB1 + tid], b2 = st[S_PB2 + tid]; const unsigned lob = b2 > 0u ? b2 - 1u : 0u, hib = b1 < 510u ? b1 + 1u : 511u;
                    const unsigned nlo = lob << 23; const unsigned long long e = ((unsigned long long)(hib + 1u) << 23) - 1ull; const unsigned nhi = e > 0xFFFFFFFFull ? 0xFFFFFFFFu : (unsigned)e;
                    st[S_ULO + tid] = nlo; st[S_UHI + tid] = 0xFFFFFFFFu; st[S_SH + tid] = sh_for(nhi - nlo); st[S_PAB + tid] = 0u; st[S_PB1 + tid] = 511u; st[S_PB2 + tid] = 0u; }
                stage = 1;
            } else if (stage == 1) {
                if (tid < 64) { const unsigned b1 = st[S_PB1 + tid], b2 = st[S_PB2 + tid], ulo = st[S_ULO + tid], uhi = st[S_UHI + tid], sh = st[S_SH + tid];
                    const unsigned flo = ulo + (b2 << sh); const unsigned long long e = (unsigned long long)ulo + ((unsigned long long)(b1 + 1u) << sh) - 1ull;
                    st[S_FLO + tid] = flo; st[S_FHI + tid] = (b1 >= 511u || e > (unsigned long long)uhi) ? uhi : (unsigned)e; }
                stage = 3;
            } else { const unsigned any = st[S_ANY]; if (!any) stage = 3; }
            __syncthreads();
        } else {
            const int vm = stage == 4 ? 1 : 0;
            if (vm) { if (tid < 64) { st[S_VMIN + tid] = 0xFFFFFFFFu; st[S_VMAX + tid] = 0u; st[S_VCNT + tid] = 0u; } __syncthreads(); }
            sweep<1>(F, A, Z, MASK, CANDW, qrow0, krow0, NT, 0, 1, vm);
            VM_WAIT(); __syncthreads();
            if (vm) { if (tid < 64) { if (st[S_VCNT + tid] != 256u || st[S_VMIN + tid] < st[S_VMAX + tid]) atomicOr(ERR, 1u); } __syncthreads(); break; }
            resolve(F, MASK, CANDW, qrow0, NT);
            VM_WAIT(); __syncthreads();
            unsigned nf = 0u;
            if (!after_fallback) { if (tid < 64) nf = st[S_FAIL + tid] & st[S_COL + tid]; nf = (unsigned)__syncthreads_or((int)nf); }
            if (nf) {
                if (tid < 64) { const unsigned f = st[S_FAIL + tid] & st[S_COL + tid]; st[S_ULO + tid] = f ? 0u : 1u; st[S_UHI + tid] = f ? 0xFFFFFFFFu : 0u; st[S_SH + tid] = 23u; st[S_NEED + tid] = 256u; st[S_ACT + tid] = f;
                    st[S_COL + tid] = f; if (f) { st[S_CCNT + tid] = 0u; st[S_ABOVE + tid] = 0u; } }
                __syncthreads();
                stage = 2; after_fallback = true;
            } else { if (IX_VERIFY) stage = 4; else break; }
        }
    }
}
}

namespace peer {
constexpr int TT = 16;
constexpr int SP = 129;
constexpr int OFF_S = 0, OFF_L = 256 * SP * 4;
constexpr int OFF_A = 0;
__device__ __forceinline__ unsigned umed3(unsigned a, unsigned b, unsigned c) { const unsigned mx = a > b ? a : b, mn = a > b ? b : a; const unsigned t = mn > c ? mn : c; return mx < t ? mx : t; }
__device__ __forceinline__ void ins16(unsigned (&L)[16], unsigned x) {
#pragma unroll
    for (int j = 15; j >= 1; --j) L[j] = umed3(L[j - 1], L[j], x);
    L[0] = L[0] > x ? L[0] : x;
}
__device__ __forceinline__ float dot2bf(unsigned w, unsigned x, float acc) { return __builtin_amdgcn_fdot2_f32_bf16(__builtin_bit_cast(bf16x2_t, w), __builtin_bit_cast(bf16x2_t, x), acc, false); }
__device__ __forceinline__ float gelu_erf(float h) { return 0.5f * h * (1.f + erff(h * 0.70710678118654752f)); }

__device__ __forceinline__ void fp8dot4(unsigned w, f32x2 h01, f32x2 h23, f32x2& a0, f32x2& a1) {
    const f32x2 lo = __builtin_amdgcn_cvt_pk_f32_fp8((int)w, false), hi = __builtin_amdgcn_cvt_pk_f32_fp8((int)w, true); a0 = lo * h01 + a0; a1 = hi * h23 + a1; }
__device__ __forceinline__ void fp8axpy4(unsigned w, f32x2 a2, f32x2& c01, f32x2& c23) {
    const f32x2 lo = __builtin_amdgcn_cvt_pk_f32_fp8((int)w, false), hi = __builtin_amdgcn_cvt_pk_f32_fp8((int)w, true); c01 = lo * a2 + c01; c23 = hi * a2 + c23; }
constexpr int NSL = 16, SLW = 128;
__device__ __forceinline__ float dpp_sum8(float v) {
    v += __int_as_float(__builtin_amdgcn_update_dpp(0, __float_as_int(v), 0xB1, 0xF, 0xF, true));
    v += __int_as_float(__builtin_amdgcn_update_dpp(0, __float_as_int(v), 0x4E, 0xF, 0xF, true));
    v += __int_as_float(__builtin_amdgcn_update_dpp(0, __float_as_int(v), 0x141, 0xF, 0xF, true));
    return v;
}
#define PEER_EID(V0, V1, i) ((((i) < 8 ? (V0) : (V1))[((i) & 7) >> 1] >> (16 * ((i) & 1))) & 0xffffu)

struct TabCvt { const float* pu; const float* pv; unsigned char* UB; unsigned char* VB; float* RSU; float* RSV; };
__device__ __forceinline__ const float* tab_src(const TabCvt& T, int m) { return m < NEXP ? T.pu + (size_t)m * DM : T.pv + (size_t)(m - NEXP) * DM; }
__device__ __forceinline__ void tab_finish(const TabCvt& T, const RowF32& R, int m, int lane) { if (m < NEXP) row_to_fp8_sliced(R, T.UB, m, T.RSU + m, lane); else row_to_fp8_sliced(R, T.VB, m - NEXP, T.RSV + (m - NEXP), lane); }
__device__ __forceinline__ void route_step(const Frame& F, const bf16_t* PQ, const bf16x8 (&Bf)[2][8], unsigned short* E16, float* GT, int tok0, const TabCvt& T, int m0, int m1) {
    const int tid = F.tid, lane = F.lane, wave = F.wave, r = lane & 31, hi = lane >> 5;
    LAS float* S = (LAS float*)(F.lds + OFF_S); LAS unsigned* L = (LAS unsigned*)(F.lds + OFF_L);
    RowF32 R;
    if (m0 >= 0) row_load(R, tab_src(T, m0), lane);
    { const int half = wave & 1, cp = (wave >> 1) & 1, rh = wave >> 2;
#pragma unroll
      for (int r2 = 0; r2 < 2; ++r2) {
          const int rt = 2 * rh + r2; const int pair = 32 * rt + r, tok = pair >> 3, p = pair & 7;
          const bf16_t* src = PQ + (size_t)(tok0 + tok) * DM + p * 256 + half * 128 + 8 * hi;
          bf16x8 A[8];
#pragma unroll
          for (int ks = 0; ks < 8; ++ks) A[ks] = *(const bf16x8*)(src + ks * 16);
#pragma unroll
          for (int c2 = 0; c2 < 2; ++c2) {
              f32x16 acc = f32x16{};
#pragma unroll
              for (int ks = 0; ks < 8; ++ks) acc = __builtin_amdgcn_mfma_f32_32x32x16_bf16(A[ks], Bf[c2][ks], acc, 0, 0, 0);
#pragma unroll
              for (int i = 0; i < 16; ++i) { const int row = (32 * rt + (i & 3) + 8 * (i >> 2) + 4 * hi) * 2 + half; S[row * SP + (2 * cp + c2) * 32 + r] = acc[i]; }
          } } }
    if (m0 >= 0) tab_finish(T, R, m0, lane);
    if (m1 >= 0) row_load(R, tab_src(T, m1), lane);
    __syncthreads();
    { const int row = tid >> 1, part = tid & 1; unsigned L16[16];
#pragma unroll
      for (int j = 0; j < 16; ++j) L16[j] = 0u;
#pragma unroll 4
      for (int n = 0; n < 64; ++n) { const int nn = part * 64 + n; const unsigned k = (f2ord(S[row * SP + nn]) & ~127u) | (unsigned)(127 - nn); ins16(L16, k); }
      unsigned oth[16];
#pragma unroll
      for (int j = 0; j < 16; ++j) oth[j] = __shfl_xor(L16[j], 1);
#pragma unroll
      for (int j = 0; j < 16; ++j) ins16(L16, part == 0 ? oth[j] : 0u);
      if (part == 0) {
#pragma unroll
          for (int j = 0; j < 16; ++j) L[row * 16 + j] = L16[j]; } }
    __syncthreads();
    if (tid < 128) {
        const int pair = tid; const LAS float* S1 = S + (pair * 2) * SP; const LAS float* S2 = S + (pair * 2 + 1) * SP;
        const LAS unsigned* L1 = L + (pair * 2) * 16; const LAS unsigned* L2 = L1 + 16;
        float v1[16], v2[16];
#pragma unroll
        for (int j = 0; j < 16; ++j) { v1[j] = S1[127 - (L1[j] & 127u)]; v2[j] = S2[127 - (L2[j] & 127u)]; }
        unsigned C16[16];
#pragma unroll
        for (int j = 0; j < 16; ++j) C16[j] = (f2ord(v1[0] + v2[j]) & ~255u) | (unsigned)(255 - j);
#pragma unroll
        for (int i = 1; i < 16; ++i)
#pragma unroll
            for (int j = 0; j < 16; ++j) if ((i + 1) * (j + 1) <= 16) { const unsigned k = (f2ord(v1[i] + v2[j]) & ~255u) | (unsigned)(255 - (i * 16 + j)); ins16(C16, k); }
        float sc[16]; unsigned ex[16]; float mx = -3.0e38f;
#pragma unroll
        for (int q = 0; q < 16; ++q) { const unsigned ci = 255u - (C16[q] & 255u); const unsigned n1 = 127u - (L1[ci >> 4] & 127u), n2 = 127u - (L2[ci & 15u] & 127u);
            sc[q] = S1[n1] + S2[n2]; ex[q] = n1 * 128u + n2; mx = fmaxf(mx, sc[q]); }
        float sum = 0.f;
#pragma unroll
        for (int q = 0; q < 16; ++q) { sc[q] = __expf(sc[q] - mx); sum += sc[q]; }
        const float inv = 1.f / sum;
        const size_t o = (size_t)(tok0 + (pair >> 3)) * 128 + (pair & 7) * 16;
        u32x4 e0, e1; e0.x = ex[0] | (ex[1] << 16); e0.y = ex[2] | (ex[3] << 16); e0.z = ex[4] | (ex[5] << 16); e0.w = ex[6] | (ex[7] << 16);
        e1.x = ex[8] | (ex[9] << 16); e1.y = ex[10] | (ex[11] << 16); e1.z = ex[12] | (ex[13] << 16); e1.w = ex[14] | (ex[15] << 16);
        *(u32x4*)(E16 + o) = e0; *(u32x4*)(E16 + o + 8) = e1;
#pragma unroll
        for (int q = 0; q < 4; ++q) *(f32x4*)(GT + o + 4 * q) = (f32x4){sc[4 * q] * inv, sc[4 * q + 1] * inv, sc[4 * q + 2] * inv, sc[4 * q + 3] * inv};
    }
    if (m1 >= 0) tab_finish(T, R, m1, lane);
    __syncthreads();
}

__device__ __forceinline__ void udot_compute(const u32x4 (&d)[16], const u32x4 h0, const u32x4 h1, float* dst, int k, bool ok) {
    f32x2 hq[8];
    hq[0] = (f32x2){bflo(h0.x), bfhi(h0.x)}; hq[1] = (f32x2){bflo(h0.y), bfhi(h0.y)}; hq[2] = (f32x2){bflo(h0.z), bfhi(h0.z)}; hq[3] = (f32x2){bflo(h0.w), bfhi(h0.w)};
    hq[4] = (f32x2){bflo(h1.x), bfhi(h1.x)}; hq[5] = (f32x2){bflo(h1.y), bfhi(h1.y)}; hq[6] = (f32x2){bflo(h1.z), bfhi(h1.z)}; hq[7] = (f32x2){bflo(h1.w), bfhi(h1.w)};
    float keep0 = 0.f, keep1 = 0.f;
#pragma unroll
    for (int i = 0; i < 16; ++i) {
        f32x2 a0 = {0.f, 0.f}, a1 = {0.f, 0.f};
        fp8dot4(d[i].x, hq[0], hq[1], a0, a1); fp8dot4(d[i].y, hq[2], hq[3], a0, a1); fp8dot4(d[i].z, hq[4], hq[5], a0, a1); fp8dot4(d[i].w, hq[6], hq[7], a0, a1);
        const float pr = dpp_sum8((a0.x + a0.y) + (a1.x + a1.y));
        if ((i & 7) == k) { if (i < 8) keep0 = pr; else keep1 = pr; }
    }
    if (ok) { dst[0] = keep0; dst[8] = keep1; }
}
__device__ __forceinline__ void udots(const Frame& F, const bf16_t* HN, const unsigned char* UB, const unsigned short* E16, float* PART) {
    const int lane = F.lane, g = lane >> 3, k = lane & 7;
    const int ngr = (F.G % 8 == 0) ? 8 : 1, wpg = F.G / ngr, x = F.vcu / wpg, wl = (F.vcu % wpg) * NWAVES + F.wave, wst = wpg * NWAVES, spg = NSL / ngr;
    const int ntw = (NTOK - wl + wst - 1) / wst;
#define UD_T(j) ((size_t)((wl + (j) * wst) < NTOK ? (wl + (j) * wst) : (NTOK - 1)))
#define UD_IDS(j, V0, V1) { const unsigned short* ep_ = E16 + UD_T(j) * 128 + g * 16; V0 = *(const u32x4*)ep_; V1 = *(const u32x4*)(ep_ + 8); }
#define UD_HN(j, H0, H1) { const bf16_t* hp_ = HN + UD_T(j) * DM + s * SLW + k * 16; H0 = *(const u32x4*)hp_; H1 = *(const u32x4*)(hp_ + 8); }
#define UD_ROWS(D, V0, V1) { _Pragma("unroll") for (int i = 0; i < 16; ++i) D[i] = *(const u32x4*)(ub + (size_t)PEER_EID(V0, V1, i) * 128); }
    for (int rr = 0; rr < spg; ++rr) {
        const int s = x + ngr * rr;
        const unsigned char* ub = UB + (size_t)s * ((size_t)NEXP * 128) + k * 16;
        float* pb = PART + (size_t)s * NTOK * 128 + g * 16 + k;
        u32x4 dA[16], dB[16], idA0, idA1, idB0, idB1, hA0, hA1, hB0, hB1;
        UD_IDS(0, idA0, idA1) UD_HN(0, hA0, hA1) UD_ROWS(dA, idA0, idA1)
        UD_IDS(1, idB0, idB1) UD_HN(1, hB0, hB1)
        for (int j = 0; j < ntw; j += 2) {
            UD_ROWS(dB, idB0, idB1)
            UD_IDS(j + 2, idA0, idA1)
            udot_compute(dA, hA0, hA1, pb + UD_T(j) * 128, k, true);
            UD_HN(j + 2, hA0, hA1)
            UD_ROWS(dA, idA0, idA1)
            UD_IDS(j + 3, idB0, idB1)
            udot_compute(dB, hB0, hB1, pb + UD_T(j + 1) * 128, k, j + 1 < ntw);
            UD_HN(j + 3, hB0, hB1)
        }
    }
#undef UD_IDS
#undef UD_HN
#undef UD_ROWS
}
#if UDOT_MFMA
__device__ __forceinline__ void udot_mfma_compute(const u32x4 (&d)[16], const i32x8 hb, LAS unsigned char* tb, float* dst, int lane, bool ok) {
    const int g = lane >> 3, k = lane & 7, c = lane & 15, q = lane >> 4;
#pragma unroll
    for (int i = 0; i < 16; ++i) *(LAS u32x4*)(tb + (8 * i + (g ^ ((i >> 3) & 1))) * 128 + ((k ^ (i & 7)) << 4)) = d[i];
    f32x4 acc[8];
#pragma unroll
    for (int m = 0; m < 8; ++m) { LAS const unsigned char* rp = tb + (8 * c + (m ^ ((c >> 3) & 1))) * 128;
        const i32x8 a = pg8::cat8(*(LAS const bf16x8*)(rp + (((2 * q) ^ (c & 7)) << 4)), *(LAS const bf16x8*)(rp + (((2 * q + 1) ^ (c & 7)) << 4)));
        acc[m] = __builtin_amdgcn_mfma_scale_f32_16x16x128_f8f6f4(a, hb, (f32x4){0.f, 0.f, 0.f, 0.f}, 0, 0, 0, 0, 0, 0); }
    f32x4 v = acc[0];
#pragma unroll
    for (int m = 1; m < 8; ++m) { if ((c & 7) == m) v = acc[m]; }
#pragma unroll
    for (int e = 0; e < 4; ++e) v[e] += __int_as_float(__builtin_amdgcn_update_dpp(0, __float_as_int(v[e]), 0x128, 0xF, 0xF, true));
    (void)ok;
#if PART_BF16
    *(u32x2*)((bf16_t*)dst + 16 * (c & 7) + 4 * q) = (u32x2){cvtpk(v[0], v[1]), cvtpk(v[2], v[3])};
#else
    *(f32x4*)(dst + 16 * (c & 7) + 4 * q) = v;
#endif
}
__device__ __forceinline__ void udots_mfma(const Frame& F, const unsigned char* HNhi, const unsigned char* HNlo, const unsigned char* UB, const unsigned short* E16, float* PART, float* dump) {
    const int lane = F.lane, g = lane >> 3, k = lane & 7, c = lane & 15, q = lane >> 4;
    const int ngr = (F.G % 8 == 0) ? 8 : 1, wpg = F.G / ngr, x = F.vcu / wpg, wl = (F.vcu % wpg) * NWAVES + F.wave, wst = wpg * NWAVES, spg = NSL / ngr;
    const int ntw = (NTOK - wl + wst - 1) / wst;
    LAS unsigned char* tb = F.lds + F.wave * 16384;
    const unsigned char* hsel = (c < 8) ? HNhi : HNlo;
#define UD_IDS(j, V0, V1) { const unsigned short* ep_ = E16 + UD_T(j) * 128 + g * 16; V0 = *(const u32x4*)ep_; V1 = *(const u32x4*)(ep_ + 8); }
#define UD_H8(j, H) { const unsigned char* hp_ = hsel + UD_T(j) * DM + s * SLW + q * 32; H = pg8::cat8(*(const bf16x8*)hp_, *(const bf16x8*)(hp_ + 16)); }
#define UD_ROWS(D, V0, V1) { _Pragma("unroll") for (int i = 0; i < 16; ++i) D[i] = *(const u32x4*)(ub + (size_t)PEER_EID(V0, V1, i) * 128); }
    for (int rr = 0; rr < spg; ++rr) {
        const int s = x + ngr * rr;
        const unsigned char* ub = UB + (size_t)s * ((size_t)NEXP * 128) + k * 16;
        float* pb = PART + (size_t)s * NTOK * (PART_BF16 ? 64 : 128);
        u32x4 dA[16], dB[16], idA0, idA1, idB0, idB1; i32x8 hA, hB;
        UD_IDS(0, idA0, idA1) UD_IDS(1, idB0, idB1) __builtin_amdgcn_sched_barrier(0); UD_H8(0, hA) UD_ROWS(dA, idA0, idA1) __builtin_amdgcn_sched_barrier(0); UD_H8(1, hB) __builtin_amdgcn_sched_barrier(0);
        for (int j = 0; j < ntw; j += 2) {
            UD_IDS(j + 2, idA0, idA1) __builtin_amdgcn_sched_barrier(0);
            UD_ROWS(dB, idB0, idB1) __builtin_amdgcn_sched_barrier(0);
            udot_mfma_compute(dA, hA, tb, pb + UD_T(j) * (PART_BF16 ? 64 : 128), lane, true);
            UD_H8(j + 2, hA)
            UD_IDS(j + 3, idB0, idB1) __builtin_amdgcn_sched_barrier(0);
            UD_ROWS(dA, idA0, idA1) __builtin_amdgcn_sched_barrier(0);
            udot_mfma_compute(dB, hB, tb, (j + 1 < ntw) ? pb + UD_T(j + 1) * (PART_BF16 ? 64 : 128) : dump, lane, true);
            UD_H8(j + 3, hB)
        }
    }
#undef UD_IDS
#undef UD_H8
#undef UD_ROWS
}
#endif
__device__ __forceinline__ void combine(const Frame& F, const float* PART, const unsigned short* E16, const float* GT, const float* RSU, const float* RSV, float* AT, unsigned* A8HI = nullptr, unsigned* A8LO = nullptr, float* ASC = nullptr) {
    const size_t n4 = (size_t)NTOK * 128 / 4, stride = (size_t)F.G * NWAVES * 64;
    for (size_t i = (size_t)F.vcu * NWAVES * 64 + F.tid; i < n4; i += stride) {
        f32x4 pv[NSL];
#pragma unroll
        for (int s = 0; s < NSL; ++s) {
#if PART_BF16 && UDOT_MFMA
            const u32x2 w = *(const u32x2*)((const bf16_t*)PART + (size_t)s * n4 * 4 + i * 4); pv[s] = (f32x4){bflo(w.x), bfhi(w.x), bflo(w.y), bfhi(w.y)};
#else
            pv[s] = *(const f32x4*)(PART + (size_t)s * n4 * 4 + i * 4);
#endif
        }
        const u32x2 ee = *(const u32x2*)(E16 + i * 4); const f32x4 gg = *(const f32x4*)(GT + i * 4);
        const unsigned e0 = ee.x & 0xffffu, e1 = ee.x >> 16, e2 = ee.y & 0xffffu, e3 = ee.y >> 16;
        const float su0 = RSU[e0], su1 = RSU[e1], su2 = RSU[e2], su3 = RSU[e3], sv0 = RSV[e0], sv1 = RSV[e1], sv2 = RSV[e2], sv3 = RSV[e3];
        f32x4 sacc = pv[0];
#pragma unroll
        for (int s = 1; s < NSL; ++s) sacc += pv[s];
        f32x4 o; o.x = gg.x * gelu_erf(sacc.x * su0) * sv0; o.y = gg.y * gelu_erf(sacc.y * su1) * sv1; o.z = gg.z * gelu_erf(sacc.z * su2) * sv2; o.w = gg.w * gelu_erf(sacc.w * su3) * sv3;
        if (A8HI) {
            float am = fmaxf(fmaxf(fabsf(o.x), fabsf(o.y)), fmaxf(fabsf(o.z), fabsf(o.w)));
#pragma unroll
            for (int sh = 1; sh < 32; sh <<= 1) am = fmaxf(am, __shfl_xor(am, sh));
            const float sc = (am > 0.f && am < 3.0e38f) ? exp2f(floorf(log2f(224.f / am))) : 1.f;
            const f32x4 y = o * sc;
            int w = __builtin_amdgcn_cvt_pk_fp8_f32(y.x, y.y, 0, false); w = __builtin_amdgcn_cvt_pk_fp8_f32(y.z, y.w, w, true);
            const f32x2 b01 = __builtin_amdgcn_cvt_pk_f32_fp8(w, false), b23 = __builtin_amdgcn_cvt_pk_f32_fp8(w, true);
            int u = __builtin_amdgcn_cvt_pk_fp8_f32(y.x - b01.x, y.y - b01.y, 0, false); u = __builtin_amdgcn_cvt_pk_fp8_f32(y.z - b23.x, y.w - b23.y, u, true);
            A8HI[i] = (unsigned)w; A8LO[i] = (unsigned)u; if ((i & 31) == 0) ASC[i >> 5] = 1.f / sc;
        } else
        *(f32x4*)(AT + i * 4) = o;
    }
}
__device__ __forceinline__ void vacc_compute(const u32x4 (&d)[16], const f32x4 a0, const f32x4 a1, const f32x4 a2, const f32x4 a3, float* orow, int g, bool ok) {
    f32x2 acc[8];
#pragma unroll
    for (int c = 0; c < 8; ++c) acc[c] = (f32x2){0.f, 0.f};
    const float av[16] = {a0.x, a0.y, a0.z, a0.w, a1.x, a1.y, a1.z, a1.w, a2.x, a2.y, a2.z, a2.w, a3.x, a3.y, a3.z, a3.w};
#pragma unroll
    for (int i = 0; i < 16; ++i) { const f32x2 aa = {av[i], av[i]};
        fp8axpy4(d[i].x, aa, acc[0], acc[1]); fp8axpy4(d[i].y, aa, acc[2], acc[3]); fp8axpy4(d[i].z, aa, acc[4], acc[5]); fp8axpy4(d[i].w, aa, acc[6], acc[7]); }
    float v[16];
#pragma unroll
    for (int c = 0; c < 8; ++c) { v[2 * c] = acc[c].x; v[2 * c + 1] = acc[c].y; }
    float R[8], S4[4];
#pragma unroll
    for (int c = 0; c < 8; ++c) { auto r = __builtin_amdgcn_permlane32_swap(__float_as_uint(v[c]), __float_as_uint(v[c + 8]), false, false); R[c] = __uint_as_float(r[0]) + __uint_as_float(r[1]); }
#pragma unroll
    for (int c = 0; c < 4; ++c) { auto r = __builtin_amdgcn_permlane16_swap(__float_as_uint(R[c]), __float_as_uint(R[c + 4]), false, false); S4[c] = __uint_as_float(r[0]) + __uint_as_float(r[1]); }
    const bool b8 = (g & 1) != 0;
    float T0, T1;
    { const float keep = b8 ? S4[2] : S4[0], send = b8 ? S4[0] : S4[2]; T0 = keep + __int_as_float(__builtin_amdgcn_update_dpp(0, __float_as_int(send), 0x128, 0xF, 0xF, true)); }
    { const float keep = b8 ? S4[3] : S4[1], send = b8 ? S4[1] : S4[3]; T1 = keep + __int_as_float(__builtin_amdgcn_update_dpp(0, __float_as_int(send), 0x128, 0xF, 0xF, true)); }
    if (ok) { f32x2 o2 = *(const f32x2*)orow; o2.x += T0; o2.y += T1; *(f32x2*)orow = o2; }
}
__device__ __forceinline__ void vacc(const Frame& F, const unsigned char* VB, const unsigned short* E16, const float* AT, float* out) {
    const int lane = F.lane, g = lane >> 3, k = lane & 7;
    const int ngr = (F.G % 8 == 0) ? 8 : 1, wpg = F.G / ngr, x = F.vcu / wpg, wl = (F.vcu % wpg) * NWAVES + F.wave, wst = wpg * NWAVES, spg = NSL / ngr;
    const int ntw = (NTOK - wl + wst - 1) / wst;
#define UD_IDS(j, V0, V1) { const unsigned short* ep_ = E16 + UD_T(j) * 128 + g * 16; V0 = *(const u32x4*)ep_; V1 = *(const u32x4*)(ep_ + 8); }
#define VA_A(j, A0, A1, A2, A3) { const float* ap_ = AT + UD_T(j) * 128 + g * 16; A0 = *(const f32x4*)ap_; A1 = *(const f32x4*)(ap_ + 4); A2 = *(const f32x4*)(ap_ + 8); A3 = *(const f32x4*)(ap_ + 12); }
#define UD_ROWS(D, V0, V1) { _Pragma("unroll") for (int i = 0; i < 16; ++i) D[i] = *(const u32x4*)(vb + (size_t)PEER_EID(V0, V1, i) * 128); }
    for (int rr = 0; rr < spg; ++rr) {
        const int s = x + ngr * rr;
        const unsigned char* vb = VB + (size_t)s * ((size_t)NEXP * 128) + k * 16;
        float* ob = out + s * SLW + k * 16 + 2 * g;
        u32x4 dA[16], dB[16], idA0, idA1, idB0, idB1; f32x4 aA0, aA1, aA2, aA3, aB0, aB1, aB2, aB3;
        UD_IDS(0, idA0, idA1) VA_A(0, aA0, aA1, aA2, aA3) UD_ROWS(dA, idA0, idA1)
        UD_IDS(1, idB0, idB1) VA_A(1, aB0, aB1, aB2, aB3)
        for (int j = 0; j < ntw; j += 2) {
            UD_ROWS(dB, idB0, idB1)
            UD_IDS(j + 2, idA0, idA1)
            vacc_compute(dA, aA0, aA1, aA2, aA3, ob + UD_T(j) * DM, g, true);
            VA_A(j + 2, aA0, aA1, aA2, aA3)
            UD_ROWS(dA, idA0, idA1)
            UD_IDS(j + 3, idB0, idB1)
            vacc_compute(dB, aB0, aB1, aB2, aB3, ob + UD_T(j + 1) * DM, g, j + 1 < ntw);
            VA_A(j + 3, aB0, aB1, aB2, aB3)
        }
    }
#undef UD_T
#undef UD_IDS
#undef VA_A
#undef UD_ROWS
}
#if VACC_MFMA
__device__ __forceinline__ u32x2 tr8_read(int addr) { u32x2 r; asm volatile("ds_read_b64_tr_b8 %0, %1" : "=&v"(r) : "v"(addr) : "memory"); return r; }
__device__ __forceinline__ void vacc_mfma_compute(const u32x4 (&d)[16], const i32x8 ab, const float asc, f32x4 o4, int wk, const int (&rb)[4], float* orow, int lane, bool ok) {
    const int c = lane & 15;
#pragma unroll
    for (int i = 0; i < 16; ++i) { const int wa = (wk ^ ((i & 7) << 4)) + i * 1024; *(LAS u32x4*)(uintptr_t)wa = d[i]; }
    f32x4 acc[8];
#pragma unroll
    for (int m = 0; m < 8; ++m) {
        const u32x2 t0 = tr8_read(rb[0] ^ (m << 4)), t1 = tr8_read(rb[1] ^ (m << 4)), t2 = tr8_read(rb[2] ^ (m << 4)), t3 = tr8_read(rb[3] ^ (m << 4));
        asm volatile("s_waitcnt lgkmcnt(0)" ::: "memory");
        const i32x8 a = {(int)t0.x, (int)t0.y, (int)t1.x, (int)t1.y, (int)t2.x, (int)t2.y, (int)t3.x, (int)t3.y};
        acc[m] = __builtin_amdgcn_mfma_scale_f32_16x16x128_f8f6f4(a, ab, (f32x4){0.f, 0.f, 0.f, 0.f}, 0, 0, 0, 0, 0, 0); }
    f32x4 v = acc[0];
#pragma unroll
    for (int m = 1; m < 8; ++m) { if ((c & 7) == m) v = acc[m]; }
#pragma unroll
    for (int e = 0; e < 4; ++e) v[e] += __int_as_float(__builtin_amdgcn_update_dpp(0, __float_as_int(v[e]), 0x128, 0xF, 0xF, true));
    (void)ok; *(f32x4*)orow = o4 + v * asc;
}
__device__ __forceinline__ void vacc_mfma(const Frame& F, const unsigned char* VB, const unsigned short* E16, const unsigned char* A8HI, const unsigned char* A8LO, const float* ASC, float* out, float* dump) {
    const int lane = F.lane, g = lane >> 3, k = lane & 7, c = lane & 15, q = lane >> 4;
    const int ngr = (F.G % 8 == 0) ? 8 : 1, wpg = F.G / ngr, x = F.vcu / wpg, wl = (F.vcu % wpg) * NWAVES + F.wave, wst = wpg * NWAVES, spg = NSL / ngr;
    const int ntw = (NTOK - wl + wst - 1) / wst;
    const int tile = (int)(uintptr_t)(F.lds + F.wave * 16384);
    const int wk = tile + 128 * g + 16 * k;
    int rb[4];
#pragma unroll
    for (int t = 0; t < 4; ++t) { const int r = c >> 1, cc = c & 1, phys = 64 * (t & 1) + 8 * r + 2 * q + (t >> 1); rb[t] = tile + phys * 128 + (r << 4) + 8 * cc; }
    const unsigned char* asel = (c < 8) ? A8HI : A8LO;
#define UD_T(j) ((size_t)((wl + (j) * wst) < NTOK ? (wl + (j) * wst) : (NTOK - 1)))
#define UD_IDS(j, V0, V1) { const unsigned short* ep_ = E16 + UD_T(j) * 128 + g * 16; V0 = *(const u32x4*)ep_; V1 = *(const u32x4*)(ep_ + 8); }
#define VA_A8(j, A, S, O) { const unsigned char* ap_ = asel + UD_T(j) * 128 + q * 32; A = pg8::cat8(*(const bf16x8*)ap_, *(const bf16x8*)(ap_ + 16)); S = ASC[UD_T(j)]; O = *(const f32x4*)(ob + UD_T(j) * DM); }
#define UD_ROWS(D, V0, V1) { _Pragma("unroll") for (int i = 0; i < 16; ++i) D[i] = *(const u32x4*)(vb + (size_t)PEER_EID(V0, V1, i) * 128); }
    for (int rr = 0; rr < spg; ++rr) {
        const int s = x + ngr * rr;
        const unsigned char* vb = VB + (size_t)s * ((size_t)NEXP * 128) + k * 16;
        float* ob = out + s * SLW + 16 * (c & 7) + 4 * q;
        u32x4 dA[16], dB[16], idA0, idA1, idB0, idB1; i32x8 aA, aB; float sA, sB; f32x4 oA, oB;
        UD_IDS(0, idA0, idA1) UD_IDS(1, idB0, idB1) __builtin_amdgcn_sched_barrier(0); VA_A8(0, aA, sA, oA) UD_ROWS(dA, idA0, idA1) __builtin_amdgcn_sched_barrier(0); VA_A8(1, aB, sB, oB) __builtin_amdgcn_sched_barrier(0);
        for (int j = 0; j < ntw; j += 2) {
            UD_IDS(j + 2, idA0, idA1) __builtin_amdgcn_sched_barrier(0);
            UD_ROWS(dB, idB0, idB1) __builtin_amdgcn_sched_barrier(0);
            vacc_mfma_compute(dA, aA, sA, oA, wk, rb, ob + UD_T(j) * DM, lane, true);
            VA_A8(j + 2, aA, sA, oA)
            UD_IDS(j + 3, idB0, idB1) __builtin_amdgcn_sched_barrier(0);
            UD_ROWS(dA, idA0, idA1) __builtin_amdgcn_sched_barrier(0);
            vacc_mfma_compute(dB, aB, sB, oB, wk, rb, (j + 1 < ntw) ? ob + UD_T(j + 1) * DM : dump + 4 * lane, lane, true);
            VA_A8(j + 3, aB, sB, oB)
        }
    }
#undef UD_T
#undef UD_IDS
#undef VA_A8
#undef UD_ROWS
}
#endif
}

__device__ __forceinline__ void pool_unit(const Frame& F, bf16_t* MIX, const bf16_t* PWt, const float* pool_s, int tm, int g, unsigned char* MIX8 = nullptr) {
    const int lane = F.lane, r = lane & 31, hi = lane >> 5;
    bf16_t* base = MIX + (size_t)(tm * 256 + F.wave * 32) * DM + 1024 + 128 * g;
    bf16x8 A[8];
#pragma unroll
    for (int ks = 0; ks < 8; ++ks) A[ks] = *(const bf16x8*)(base + (size_t)r * DM + ks * 16 + 8 * hi);
#pragma unroll
    for (int ct = 0; ct < 4; ++ct) {
        f32x16 acc = f32x16{};
        const bf16_t* pb = PWt + (size_t)(g * 128 + ct * 32 + r) * 128 + 8 * hi;
#pragma unroll
        for (int ks = 0; ks < 8; ++ks) { const bf16x8 B = *(const bf16x8*)(pb + ks * 16); acc = __builtin_amdgcn_mfma_f32_32x32x16_bf16(A[ks], B, acc, 0, 0, 0); }
        const float sc = pool_s[128 * g + ct * 32 + r];
#pragma unroll
        for (int i = 0; i < 16; ++i) { const int row = (i & 3) + 8 * (i >> 2) + 4 * hi;
            if (MIX8) MIX8[(size_t)(tm * 256 + F.wave * 32 + row) * DM + 1024 + 128 * g + ct * 32 + r] = to_fp8(acc[i] * sc * MIX8_SCALE);
            else base[(size_t)row * DM + ct * 32 + r] = (bf16_t)(cvtpk(acc[i] * sc, 0.f) & 0xffffu); }
    }
}

__global__ void __launch_bounds__(NWAVES * 64, 2) fwd_kernel(Args args) {
    extern __shared__ __attribute__((aligned(16))) unsigned char lds[];
    Frame F;
    F.lds = (LAS unsigned char*)lds; F.ldsg = (char*)lds;
    F.tid = threadIdx.x; F.lane = F.tid & 63; F.wave = __builtin_amdgcn_readfirstlane(F.tid >> 6);
    F.G = gridDim.x; { const int bx = blockIdx.x; F.vcu = (F.G % 8 == 0) ? (bx % 8) * (F.G / 8) + bx / 8 : bx; }
    unsigned char* ws = args.ws;
    unsigned* ctl = (unsigned*)(ws + WS_CTL);
    volatile LAS unsigned* MISC = (volatile LAS unsigned*)(F.lds + MISC_OFF);
    for (int u = F.tid; u < (LDS_BYTES - LDSCTL_OFF) / 4; u += NWAVES * 64) ((LAS unsigned*)(F.lds + LDSCTL_OFF))[u] = 0u;
    __syncthreads();
    const int lo = args.ph_lo, hi = args.ph_hi;
    XcdBarrier bar; bar.bar = ctl + CW_BAR; bar.x = 0; bar.st = nullptr;
    if (hi - lo > 1) bar = xcd_barrier_post(ctl + CW_BAR, MISC + 8);
#define IN(k) (lo <= (k) && (k) < hi)
#define PHASE_BEGIN() do { int t_ = (int)threadIdx.x; asm volatile("" : "+v"(t_)); F.tid = t_; F.lane = t_ & 63; } while (0)
#define SEAM(k) do { if (IN(k) && IN((k) + 1)) xcd_barrier(bar); } while (0)

    bf16_t* Z = (bf16_t*)(ws + WS_Z); bf16_t* XN = (bf16_t*)(ws + WS_XN); bf16_t* MIX = XN;
    bf16_t* HN = (bf16_t*)(ws + WS_Z); bf16_t* PQ = (bf16_t*)(ws + WS_Z + 128 * MiB);
    bf16_t* KVM = (bf16_t*)(ws + WS_KVM); unsigned* MASK = (unsigned*)(ws + WS_MASK);

    if (IN(0)) { PHASE_BEGIN(); p0_prologue(F, args); } SEAM(0);
    if (IN(1)) { PHASE_BEGIN();
#if P1_FP8
        const int gw = F.vcu * NWAVES + F.wave, NGW = F.G * NWAVES;
        for (int i = gw; i < 4096; i += NGW) { const int n = i < 3072 ? i : i + 1024; RowF32 R; row_load_bf16(R, (const bf16_t*)(ws + WS_BT_IN) + (size_t)n * DM, F.lane); row_to_fp8(R, ws + WS_BTIN8 + (size_t)n * DM, (float*)(ws + WS_CSI) + n, F.lane); }
#endif
#if P5_FP8
        { const int gw = F.vcu * NWAVES + F.wave, NGW = F.G * NWAVES; float* cso = (float*)(ws + WS_CSO);
          for (int n = gw; n < DM; n += NGW) { RowF32 R; row_load_bf16(R, (const bf16_t*)(ws + WS_BT_OUT) + (size_t)n * DM, F.lane); row_to_fp8(R, ws + WS_BTOUT8 + (size_t)n * DM, cso + n, F.lane);
              if (F.lane == 0) cso[n] = cso[n] * (1.f / MIX8_SCALE); } }
#endif
    } SEAM(1);
    if (IN(2)) { PHASE_BEGIN();
#if P1_FP8
        { pg8::Gemm g{XN, (const bf16_t*)(ws + WS_BT_IN), NTOK, ZLD, DM}; pg8::InBf16Order S; S.init(NTOK, F.G, (int)blockIdx.x);
          pg8::EpiBf16 E{Z, ZLD}; pg8::gemm_phase<pg8::EpiBf16, pg8::InBf16Order, true, true>(F.lds, g, S, E); }
        { pg8::Gemm g{(const bf16_t*)(ws + WS_XN8), (const bf16_t*)(ws + WS_BTIN8), NTOK, ZLD, DM / 2}; pg8::InFp8Order S; S.init(NTOK, F.G, (int)blockIdx.x);
          pg8::EpiBf16S E{Z, ZLD, (const float*)(ws + WS_CSI)}; pg8::gemm_phase<pg8::EpiBf16S, pg8::InFp8Order, true, true, true>(F.lds, g, S, E); }
#else
        { pg8::Gemm g{XN, (const bf16_t*)(ws + WS_BT_IN), NTOK, ZLD, DM}; pg8::StaticOrder S; S.init(NTOK, ZLD, F.G, (int)blockIdx.x);
          pg8::EpiBf16 E{Z, ZLD}; pg8::gemm_phase<pg8::EpiBf16, pg8::StaticOrder, true, true>(F.lds, g, S, E); }
#endif
        { pg8::Gemm g{(const bf16_t*)(ws + WS_MN), (const bf16_t*)(ws + WS_BT_KV), BATCH * MEMLEN, 1024, DM}; pg8::StaticOrder S; S.init(BATCH * MEMLEN, 1024, F.G, (int)((blockIdx.x + 128) % F.G));
          pg8::EpiBf16 E{KVM, 1024}; pg8::gemm_phase<pg8::EpiBf16, pg8::StaticOrder, true, true>(F.lds, g, S, E); }
    } SEAM(2);
    if (IN(3)) { PHASE_BEGIN(); p2_post(F, args);
#if PV_FP8
        PHASE_BEGIN(); p2_vt(F, args);
#endif
    } SEAM(3);
    if (IN(4)) { PHASE_BEGIN();
        for (int i = 0; ; ++i) {
            int b, c;
            if (F.G == 256) { if (i >= 2) break; b = F.vcu >> 7; c = (i == 0) ? 255 - (F.vcu & 127) : (F.vcu & 127); }
            else { const int u = (int)blockIdx.x + i * F.G; if (u >= 512) break; b = u >> 8; c = u & 255; }
            ix::unit(F, Z, MASK, (unsigned long long*)(ws + WS_CAND) + (size_t)blockIdx.x * 64 * ix::CAPB, ctl + 2048, b, c);
            __syncthreads();
        }
    } SEAM(4);
    if (IN(5)) { PHASE_BEGIN();
        for (int u = F.vcu; u < (NTOK / 256) * 4; u += F.G) pool_unit(F, MIX, (const bf16_t*)(ws + WS_PWT), args.pool_s, u >> 2, u & 3, P5_FP8 ? ws + WS_MIX8 : nullptr);
        const int r32 = F.lane & 31;
        for (int i = 0; ; ++i) {
            int b, h, qb;
            if (F.G == 256) { if (i >= 4) break; const int bh = F.vcu >> 4, s = F.vcu & 15; b = bh >> 3; h = bh & 7; qb = (i == 0) ? 63 - s : (i == 1) ? 32 + s : (i == 2) ? 31 - s : s; }
            else { const int u = (int)blockIdx.x + i * F.G; if (u >= 1024) break; b = u >> 9; h = (u >> 6) & 7; qb = u & 63; }
            const size_t row0 = (size_t)b * SEQ + 256 * qb;
            const unsigned long long* mrow = (const unsigned long long*)MASK + (row0 + F.wave * 32 + r32) * (MASK_WPR / 2);
#if QK_FP8
            att::attn_body<true, 2, ZLD, ZLD, DM, true, PV_FP8 != 0>(Z + row0 * ZLD + ZC_Q + h * 128, Z + (size_t)b * SEQ * ZLD + ZC_K + h * 128, Z + (size_t)b * SEQ * ZLD + ZC_V + h * 128,
                                                        MIX + row0 * DM + h * 128, 256 * (qb + 1), mrow, F.ldsg, ws + WS_Q8 + row0 * 1024 + h * 128, ws + WS_K8 + (size_t)b * SEQ * 1024 + h * 128,
                                                        ws + WS_V8T + (size_t)(b * 8 + h) * 256 * 8192, P5_FP8 ? ws + WS_MIX8 + row0 * DM + h * 128 : nullptr);
#else
            att::attn_body<true, 2, ZLD, ZLD, DM>(Z + row0 * ZLD + ZC_Q + h * 128, Z + (size_t)b * SEQ * ZLD + ZC_K + h * 128, Z + (size_t)b * SEQ * ZLD + ZC_V + h * 128,
                                                  MIX + row0 * DM + h * 128, 256 * (qb + 1), mrow, F.ldsg);
#endif
        }
        for (int id = F.vcu; id < 512; id += F.G) {
            const int b2 = id >> 8, hm = (id >> 6) & 3, qb = id & 63; const size_t row0 = (size_t)b2 * SEQ + 256 * qb;
            att::attn_body<false, 1, ZLD, 1024, DM>(Z + row0 * ZLD + ZC_QM + hm * 128, KVM + (size_t)b2 * MEMLEN * 1024 + hm * 128, KVM + (size_t)b2 * MEMLEN * 1024 + 512 + hm * 128,
                                                    MIX + row0 * DM + 1536 + hm * 128, MEMLEN, nullptr, F.ldsg, nullptr, nullptr, nullptr, P5_FP8 ? ws + WS_MIX8 + row0 * DM + 1536 + hm * 128 : nullptr);
        }
    } SEAM(5);
    if (IN(6)) { PHASE_BEGIN();
#if ATT_VERIFY
        {
            const int t = (int)blockIdx.x * 128 + 77, hh = F.wave, ln = F.lane; const int bb = t / SEQ, pos = t % SEQ, N = 64 * (pos / 64 + 1);
            const bf16_t* zq = Z + (size_t)t * ZLD + ZC_Q + hh * 128 + 2 * ln; const float q0 = bflo((unsigned)zq[0]), q1 = bflo((unsigned)zq[1]);
            float m = -3.0e38f, l = 0.f, o0 = 0.f, o1 = 0.f; int nsel = 0;
            for (int w = 0; w < N / 32; ++w) { unsigned bits = __hip_atomic_load(MASK + (size_t)t * MASK_WPR + w, __ATOMIC_RELAXED, __HIP_MEMORY_SCOPE_AGENT);
                while (bits) { const int bpos = __builtin_ctz(bits); bits &= bits - 1u; const int sidx = 32 * w + bpos; ++nsel;
                    const bf16_t* zk = Z + ((size_t)bb * SEQ + sidx) * ZLD + ZC_K + hh * 128 + 2 * ln; const bf16_t* zv = Z + ((size_t)bb * SEQ + sidx) * ZLD + ZC_V + hh * 128 + 2 * ln;
                    const float lg = wave_sum(q0 * bflo((unsigned)zk[0]) + q1 * bflo((unsigned)zk[1])) * 0.088388347648318440f;
                    const float mn = fmaxf(m, lg), al = __expf(m - mn), pe = __expf(lg - mn); l = l * al + pe; o0 = o0 * al + pe * bflo((unsigned)zv[0]); o1 = o1 * al + pe * bflo((unsigned)zv[1]); m = mn; } }
            const bf16_t* mx = MIX + (size_t)t * DM + hh * 128 + 2 * ln; const float r0 = o0 / l, r1 = o1 / l;
            float er = fmaxf(fabsf(r0 - bflo((unsigned)mx[0])), fabsf(r1 - bflo((unsigned)mx[1]))), sc = fmaxf(fabsf(r0), fabsf(r1));
#pragma unroll
            for (int o = 1; o < 64; o <<= 1) { er = fmaxf(er, __shfl_xor(er, o)); sc = fmaxf(sc, __shfl_xor(sc, o)); }
            if (!(er <= (QK_FP8 ? 0.12f : 0.03f) * sc + (QK_FP8 ? 4e-3f : 1e-3f)) || nsel != (N < 256 ? N : 256)) { if (ln == 0) atomicOr(ctl + 2048, 2u); }
        }
        __syncthreads();
#endif
#if P5_FP8
        pg8::Gemm g{(const bf16_t*)(ws + WS_MIX8), (const bf16_t*)(ws + WS_BTOUT8), NTOK, DM, DM / 2}; pg8::StaticOrder S; S.init(NTOK, DM, F.G, (int)blockIdx.x);
        pg8::EpiF32ResS E{args.x, args.out, DM, (const float*)(ws + WS_CSO)}; pg8::gemm_phase<pg8::EpiF32ResS, pg8::StaticOrder, true, true, true>(F.lds, g, S, E);
#else
        pg8::Gemm g{MIX, (const bf16_t*)(ws + WS_BT_OUT), NTOK, DM, DM}; pg8::StaticOrder S; S.init(NTOK, DM, F.G, (int)blockIdx.x);
        pg8::EpiF32Res E{args.x, args.out, DM}; pg8::gemm_phase<pg8::EpiF32Res, pg8::StaticOrder, true, true>(F.lds, g, S, E);
#endif
    } SEAM(6);
    if (IN(7)) { PHASE_BEGIN(); const int gw = F.vcu * NWAVES + F.wave, NGW = F.G * NWAVES;
#if P7_FP8
        for (int n = gw; n < DM; n += NGW) { RowF32 R; row_load_bf16(R, (const bf16_t*)(ws + WS_BT_Q) + (size_t)n * DM, F.lane); row_to_fp8(R, ws + WS_BTQ8 + (size_t)n * DM, (float*)(ws + WS_CSQ) + n, F.lane); }
#if UDOT_MFMA
        { RowF32 Ra, Rb; int m = gw;
          if (m < NTOK) row_load(Ra, args.out + (size_t)m * DM, F.lane);
          for (; m < NTOK; m += 2 * NGW) { const int m2 = m + NGW, m3 = m + 2 * NGW;
              if (m2 < NTOK) row_load(Rb, args.out + (size_t)m2 * DM, F.lane);
              rms_fin_fp8_hilo(Ra.v, args.ffn_g, ws + WS_HN8 + (size_t)m * DM, ws + WS_HN8LO + (size_t)m * DM, F.lane);
              if (m3 < NTOK) row_load(Ra, args.out + (size_t)m3 * DM, F.lane);
              if (m2 < NTOK) rms_fin_fp8_hilo(Rb.v, args.ffn_g, ws + WS_HN8 + (size_t)m2 * DM, ws + WS_HN8LO + (size_t)m2 * DM, F.lane); } }
#else
        for (int m = gw; m < NTOK; m += NGW) { RowF32 R; row_load(R, args.out + (size_t)m * DM, F.lane); rms_fin_bf16_fp8(R.v, args.ffn_g, HN + (size_t)m * DM, ws + WS_HN8 + (size_t)m * DM, F.lane); }
#endif
#else
        for (int m = gw; m < NTOK; m += NGW) rms_row_to_bf16(args.out + (size_t)m * DM, args.ffn_g, HN + (size_t)m * DM, F.lane);
#endif
    } SEAM(7);
    if (IN(8)) { PHASE_BEGIN();
#if P7_FP8
        pg8::Gemm g{(const bf16_t*)(ws + WS_HN8), (const bf16_t*)(ws + WS_BTQ8), NTOK, DM, DM / 2}; pg8::StaticOrder S; S.init(NTOK, DM, F.G, (int)blockIdx.x);
        pg8::EpiBf16S E{PQ, DM, (const float*)(ws + WS_CSQ)}; pg8::gemm_phase<pg8::EpiBf16S, pg8::StaticOrder, true, true, true>(F.lds, g, S, E);
#else
        pg8::Gemm g{HN, (const bf16_t*)(ws + WS_BT_Q), NTOK, DM, DM}; pg8::StaticOrder S; S.init(NTOK, DM, F.G, (int)blockIdx.x);
        pg8::EpiBf16 E{PQ, DM}; pg8::gemm_phase<pg8::EpiBf16, pg8::StaticOrder, true, true>(F.lds, g, S, E);
#endif
    } SEAM(8);
    unsigned short* E16 = (unsigned short*)(ws + WS_XN); float* GT = (float*)(ws + WS_XN + 8 * MiB); float* AT = (float*)(ws + WS_XN + 24 * MiB);
    float* PART = (float*)(ws + WS_Z + 128 * MiB);
    if (IN(9)) { PHASE_BEGIN();
        const bf16_t* PKb = (const bf16_t*)(ws + WS_PK);
        bf16x8 Bf[2][8];
        { const int half = F.wave & 1, cp = (F.wave >> 1) & 1, r = F.lane & 31, hi = F.lane >> 5;
#pragma unroll
          for (int c2 = 0; c2 < 2; ++c2)
#pragma unroll
              for (int ks = 0; ks < 8; ++ks) Bf[c2][ks] = *(const bf16x8*)(PKb + (size_t)(half * 128 + (2 * cp + c2) * 32 + r) * 128 + 8 * hi + ks * 16); }
        const peer::TabCvt T{args.pu, args.pv, ws + WS_UB, ws + WS_VB, (float*)(ws + WS_RSU), (float*)(ws + WS_RSV)};
        const int gw = F.vcu * NWAVES + F.wave, NGW = F.G * NWAVES; int mrow = gw, nstep = 0;
        for (int it = F.vcu; it < NTOK / peer::TT; it += F.G, ++nstep) {
            const int m0 = mrow < 2 * NEXP ? mrow : -1; mrow += NGW; const int m1 = mrow < 2 * NEXP ? mrow : -1; mrow += NGW;
            peer::route_step(F, PQ, Bf, E16, GT, it * peer::TT, T, m0, m1);
        }
        for (; mrow < 2 * NEXP; mrow += NGW) { RowF32 R; row_load(R, peer::tab_src(T, mrow), F.lane); peer::tab_finish(T, R, mrow, F.lane); }
    } SEAM(9);
    if (IN(10)) { PHASE_BEGIN();
#if UDOT_MFMA
        peer::udots_mfma(F, ws + WS_HN8, ws + WS_HN8LO, ws + WS_UB, E16, PART, (float*)(ws + WS_ROPE));
#else
        peer::udots(F, HN, ws + WS_UB, E16, PART);
#endif
    } SEAM(10);
#if VACC_MFMA
    unsigned char* A8HI = ws + WS_XN + 24 * MiB; unsigned char* A8LO = ws + WS_XN + 28 * MiB; float* ASC = (float*)(ws + WS_XN + 32 * MiB);
    if (IN(11)) { PHASE_BEGIN(); peer::combine(F, PART, E16, GT, (const float*)(ws + WS_RSU), (const float*)(ws + WS_RSV), AT, (unsigned*)A8HI, (unsigned*)A8LO, ASC); } SEAM(11);
#else
    if (IN(11)) { PHASE_BEGIN(); peer::combine(F, PART, E16, GT, (const float*)(ws + WS_RSU), (const float*)(ws + WS_RSV), AT); } SEAM(11);
#endif
#if VACC_MFMA
    if (IN(12)) { PHASE_BEGIN(); peer::vacc_mfma(F, ws + WS_VB, E16, A8HI, A8LO, ASC, args.out, (float*)(ws + WS_ROPE)); }
#else
    if (IN(12)) { PHASE_BEGIN(); peer::vacc(F, ws + WS_VB, E16, AT, args.out); }
#endif
#if IX_VERIFY || ATT_VERIFY
    if (IN(12)) { __syncthreads(); if (__hip_atomic_load(ctl + 2048, __ATOMIC_RELAXED, __HIP_MEMORY_SCOPE_AGENT) != 0u) { args.out[(size_t)blockIdx.x * 512 + threadIdx.x] = __builtin_nanf(""); } }
#endif
#undef IN
#undef SEAM
}

extern "C" void kernel_launch(void* const* d_in, const int* in_sizes, int n_in, void* d_out, int out_size, void* d_ws, size_t ws_size, hipStream_t stream) {
    static int grid = 0;
    if (grid == 0) {
        if (n_in != 19 || out_size != NTOK * DM || ws_size < WS_END) { fprintf(stderr, "kernel_launch: unexpected shapes (n_in %d out %d ws %zu)\n", n_in, out_size, ws_size); grid = -1; return; }
        int dev = 0, cus = 0;
        if (hipGetDevice(&dev) != hipSuccess || hipDeviceGetAttribute(&cus, hipDeviceAttributeMultiprocessorCount, dev) != hipSuccess) { grid = -1; return; }
        if (hipFuncSetAttribute((const void*)fwd_kernel, hipFuncAttributeMaxDynamicSharedMemorySize, LDS_BYTES) != hipSuccess) { fprintf(stderr, "kernel_launch: hipFuncSetAttribute failed\n"); grid = -1; return; }
        int per_cu = 0;
        if (hipOccupancyMaxActiveBlocksPerMultiprocessor(&per_cu, (const void*)fwd_kernel, NWAVES * 64, LDS_BYTES) != hipSuccess || per_cu < 1) { fprintf(stderr, "kernel_launch: occupancy query reports %d workgroups per CU for %d threads / %d B LDS; nothing launched\n", per_cu, NWAVES * 64, LDS_BYTES); grid = -1; return; }
        (void)hipGetLastError();
        grid = cus;
    }
    if (grid < 0) return;
    (void)hipMemsetAsync((char*)d_ws + WS_CTL, 0, CTL_ZERO_BYTES, stream);
    Args a{};
    a.x = (const float*)d_in[0]; a.mem = (const float*)d_in[1]; a.attn_g = (const float*)d_in[2]; a.w_in = (const float*)d_in[3]; a.q_g = (const float*)d_in[4]; a.k_g = (const float*)d_in[5];
    a.pool_w = (const float*)d_in[6]; a.pool_s = (const float*)d_in[7]; a.mem_g = (const float*)d_in[8]; a.w_kv = (const float*)d_in[9]; a.mq_g = (const float*)d_in[10]; a.mk_g = (const float*)d_in[11];
    a.w_out = (const float*)d_in[12]; a.ffn_g = (const float*)d_in[13]; a.w_q = (const float*)d_in[14]; a.sk1 = (const float*)d_in[15]; a.sk2 = (const float*)d_in[16];
    a.pu = (const float*)d_in[17]; a.pv = (const float*)d_in[18]; a.out = (float*)d_out; a.ws = (unsigned char*)d_ws;
#if MK_ONE_LAUNCH
    a.ph_lo = 0; a.ph_hi = N_PHASES;
    hipLaunchKernelGGL(fwd_kernel, dim3(grid), dim3(NWAVES * 64), LDS_BYTES, stream, a);
#else
    for (int p = 0; p < N_PHASES; ++p) { a.ph_lo = p; a.ph_hi = p + 1; for (int rep = 0; rep < ((PROBE_DUP_MASK >> p) & 1) + 1; ++rep) hipLaunchKernelGGL(fwd_kernel, dim3(grid), dim3(NWAVES * 64), LDS_BYTES, stream, a); }
#endif
}
```
